# Optimizing an MI355X kernel written in HIP

```python
import jax
import jax.numpy as jnp
from jax import lax
import numpy as np


D_MODEL = 1024
BATCH = 8
SEQ = 4096
DEPTH = 4

GRID_W = 64
CTX_LEN = 256
N_MIXERS = 2
EPS = 1e-6
F32 = jnp.float32

NA_HEADS = 16
NA_HEAD_DIM = D_MODEL // NA_HEADS
NA_KR = 8
NA_KC = 16

ML_HEADS = 8
ML_DV = D_MODEL // ML_HEADS
ML_DQK = ML_DV // 2
ML_CHUNK = 64
ML_GATE_CAP = 15.0
ML_FGATE_BIAS = 3.0
ML_IN = 2 * ML_HEADS * ML_DQK + ML_HEADS * ML_DV + D_MODEL + 4 * ML_HEADS
ROPE_THETA = 10000.0

N_EXPERTS = 32
TOP_K = 4
D_FF = D_MODEL
SWIGLU_LIMIT = 7.0
SWIGLU_ALPHA = 1.702

kernel_name = 'hybrid_na_mlstm_moe_dit'


def rmsnorm(z, gain):
    zf = z.astype(F32)
    return (zf * lax.rsqrt(jnp.mean(zf * zf, axis=-1, keepdims=True) + EPS)).astype(z.dtype) * gain


def modulate(h, shift, scale):
    return h * (1 + scale) + shift


def axial_rope(z, row, col):
    half = z.shape[-1] // 2

    def rope_1d(u, pos):
        n = u.shape[-1] // 2
        inv = ROPE_THETA ** (-jnp.arange(n, dtype=F32) / n)
        ang = pos.astype(F32)[:, None] * inv
        cos, sin = jnp.cos(ang), jnp.sin(ang)
        u1, u2 = u[..., :n], u[..., n:]
        return jnp.concatenate([u1 * cos - u2 * sin, u1 * sin + u2 * cos], axis=-1)

    return jnp.concatenate([rope_1d(z[..., :half], row), rope_1d(z[..., half:], col)], axis=-1)


def na_mixer(h_lat, h_ctx, w_qkv, q_gain, k_gain, rpb, w_o, ctx_out):
    bsz, seq, _ = h_lat.shape
    rows = seq // GRID_W
    kr = min(NA_KR, rows)

    def split_heads(h):
        t = h.shape[1]
        qkv = (h @ w_qkv).reshape(bsz, t, 3, NA_HEADS, NA_HEAD_DIM)
        qkv = jnp.transpose(qkv, (2, 0, 3, 1, 4))
        q = rmsnorm(qkv[0], q_gain) * (NA_HEAD_DIM ** -0.5)
        k = rmsnorm(qkv[1], k_gain)
        return q, k, qkv[2]

    q_l, k_l, v_l = split_heads(h_lat)
    q_c, k_c, v_c = split_heads(h_ctx)

    def grid(t):
        return t.reshape(bsz, NA_HEADS, rows, GRID_W, NA_HEAD_DIM)

    k_g, v_g = grid(k_l), grid(v_l)
    q_rows = jnp.moveaxis(grid(q_l), 2, 0)
    row_start = jnp.clip(jnp.arange(rows) - kr // 2, 0, rows - kr)
    cols = jnp.arange(GRID_W)
    col_idx = jnp.clip(cols - NA_KC // 2, 0, GRID_W - NA_KC)[:, None] + jnp.arange(NA_KC)
    rpb_cols = rpb[:, :, col_idx - cols[:, None] + NA_KC - 1]
    n_win = kr * NA_KC

    def row_block(args):
        r, q_r = args
        r0 = row_start[r]
        k_win = lax.dynamic_slice_in_dim(k_g, r0, kr, axis=2)[:, :, :, col_idx]
        v_win = lax.dynamic_slice_in_dim(v_g, r0, kr, axis=2)[:, :, :, col_idx]
        bias = jnp.transpose(rpb_cols[:, r0 + jnp.arange(kr) - r + NA_KR - 1], (0, 2, 1, 3))
        s_win = jnp.einsum('bhqd,bhiqjd->bhqij', q_r, k_win).astype(F32) + bias.astype(F32)
        s_ctx = jnp.einsum('bhqd,bhkd->bhqk', q_r, k_c).astype(F32)
        s = jnp.concatenate([s_win.reshape(bsz, NA_HEADS, GRID_W, n_win), s_ctx], axis=-1)
        p = jax.nn.softmax(s, axis=-1).astype(v_g.dtype)
        p_win = p[..., :n_win].reshape(bsz, NA_HEADS, GRID_W, kr, NA_KC)
        return (jnp.einsum('bhqij,bhiqjd->bhqd', p_win, v_win)
                + jnp.einsum('bhqk,bhkd->bhqd', p[..., n_win:], v_c))

    o = lax.map(row_block, (jnp.arange(rows), q_rows))
    y_lat = jnp.transpose(o, (1, 0, 3, 2, 4)).reshape(bsz, seq, D_MODEL) @ w_o
    if not ctx_out:
        return y_lat, None
    s_cc = jnp.einsum('bhqd,bhkd->bhqk', q_c, k_c).astype(F32)
    o_c = jnp.einsum('bhqk,bhkd->bhqd', jax.nn.softmax(s_cc, axis=-1).astype(v_c.dtype), v_c)
    y_ctx = jnp.transpose(o_c, (0, 2, 1, 3)).reshape(bsz, h_ctx.shape[1], D_MODEL) @ w_o
    return y_lat, y_ctx


def mlstm_chunkwise(q, k, v, i_pre, log_f):
    bsz, nh, t, dk = q.shape
    dv = v.shape[-1]
    nc = t // ML_CHUNK
    q = q.reshape(bsz, nh, nc, ML_CHUNK, dk) * (dk ** -0.5)
    k = k.reshape(bsz, nh, nc, ML_CHUNK, dk)
    v = v.reshape(bsz, nh, nc, ML_CHUNK, dv)
    ig = i_pre.reshape(bsz, nh, nc, ML_CHUNK)
    cum_f = jnp.cumsum(log_f.reshape(bsz, nh, nc, ML_CHUNK), axis=-1)
    cum_last = cum_f[..., -1]
    w_end = cum_last[..., None] - cum_f + ig
    m_loc = jnp.max(w_end, axis=-1)
    e_end = jnp.exp(w_end - m_loc[..., None])
    d_c = jnp.einsum('bhcs,bhcsv,bhcsk->cbhvk', e_end, v, k)
    d_n = jnp.einsum('bhcs,bhcsk->cbhk', e_end, k)

    def step(carry, inp):
        c_st, n_st, m_st = carry
        dc_c, dn_c, cl_c, ml_c = inp
        m_new = jnp.maximum(cl_c + m_st, ml_c)
        a = jnp.exp(cl_c + m_st - m_new)
        g = jnp.exp(ml_c - m_new)
        c_new = a[..., None, None] * c_st + g[..., None, None] * dc_c
        n_new = a[..., None] * n_st + g[..., None] * dn_c
        return (c_new, n_new, m_new), (c_st, n_st, m_st)

    init = (jnp.zeros((bsz, nh, dv, dk), F32), jnp.zeros((bsz, nh, dk), F32), jnp.zeros((bsz, nh), F32))
    _, (c0, n0, m0) = lax.scan(step, init, (d_c, d_n, jnp.moveaxis(cum_last, 2, 0), jnp.moveaxis(m_loc, 2, 0)))
    log_inter = cum_f + jnp.moveaxis(m0, 0, 2)[..., None]
    causal = jnp.tril(jnp.ones((ML_CHUNK, ML_CHUNK), dtype=bool))
    d_mat = jnp.where(causal, cum_f[..., :, None] - cum_f[..., None, :] + ig[..., None, :], -jnp.inf)
    m_comb = jnp.maximum(log_inter, jnp.max(d_mat, axis=-1))
    w_inter = jnp.exp(log_inter - m_comb)
    s = jnp.einsum('bhctk,bhcsk->bhcts', q, k) * jnp.exp(d_mat - m_comb[..., None])
    num = (jnp.einsum('bhcts,bhcsv->bhctv', s, v)
           + w_inter[..., None] * jnp.einsum('cbhvk,bhctk->bhctv', c0, q))
    den = jnp.sum(s, axis=-1) + w_inter * jnp.einsum('cbhk,bhctk->bhct', n0, q)
    h_out = num / jnp.maximum(jnp.abs(den), jnp.exp(-m_comb))[..., None]
    return h_out.reshape(bsz, nh, t, dv)


def mlstm_mixer(h_lat, h_ctx, w_in, b_gate, mh_gain, w_o, ctx_out):
    bsz, seq, _ = h_lat.shape
    n_ctx = h_ctx.shape[1]
    t = n_ctx + seq
    proj = jnp.concatenate([h_ctx, h_lat], axis=1) @ w_in
    nq = ML_HEADS * ML_DQK
    nv = ML_HEADS * ML_DV
    q, k, v, og, gate_pre = jnp.split(proj, [nq, 2 * nq, 2 * nq + nv, 2 * nq + nv + D_MODEL], axis=-1)

    def heads(z, d):
        return jnp.transpose(z.reshape(bsz, t, ML_HEADS, d), (0, 2, 1, 3)).astype(F32)

    q, k, v = heads(q, ML_DQK), heads(k, ML_DQK), heads(v, ML_DV)
    pos = jnp.arange(seq)

    def rot(z):
        return jnp.concatenate([z[:, :, :n_ctx], axial_rope(z[:, :, n_ctx:], pos // GRID_W, pos % GRID_W)], axis=2)

    q, k = rot(q), rot(k)
    gates = ML_GATE_CAP * jnp.tanh((gate_pre.astype(F32) + b_gate) / ML_GATE_CAP)
    gates = jnp.transpose(gates.reshape(bsz, t, 4, ML_HEADS), (2, 0, 3, 1))
    i_fw, f_fw, i_bw, f_bw = gates[0], gates[1], gates[2], gates[3]

    def flip(z):
        return jnp.concatenate([jnp.flip(z[:, :, :n_ctx], axis=2), jnp.flip(z[:, :, n_ctx:], axis=2)], axis=2)

    h_fw = mlstm_chunkwise(q, k, v, i_fw, jax.nn.log_sigmoid(f_fw))
    h_bw = flip(mlstm_chunkwise(flip(q), flip(k), flip(v), flip(i_bw), flip(jax.nn.log_sigmoid(f_bw))))
    h_sum = h_fw + h_bw
    h_n = h_sum * lax.rsqrt(jnp.mean(h_sum * h_sum, axis=-1, keepdims=True) + EPS)
    h_n = (jnp.transpose(h_n, (0, 2, 1, 3)).reshape(bsz, t, nv) * mh_gain).astype(h_lat.dtype)
    out = h_n * jax.nn.sigmoid(og)
    y_lat = out[:, n_ctx:] @ w_o
    if not ctx_out:
        return y_lat, None
    return y_lat, out[:, :n_ctx] @ w_o


def moe_ffn(h, w_router, b_router, w1, b1, w2, b2):
    n = h.shape[0]
    logits = (h @ w_router + b_router).astype(F32)
    top_val, top_idx = lax.top_k(logits, TOP_K)
    weights = jax.nn.softmax(top_val, axis=-1)
    gate = jnp.einsum('nk,nke->en', weights, jax.nn.one_hot(top_idx, N_EXPERTS, dtype=F32))
    acc = jnp.zeros((n, D_MODEL), F32)
    for e in range(N_EXPERTS):
        u = h @ w1[e] + b1[e]
        glu = jnp.minimum(u[:, :D_FF], SWIGLU_LIMIT)
        lin = jnp.clip(u[:, D_FF:], -SWIGLU_LIMIT, SWIGLU_LIMIT)
        act = glu * jax.nn.sigmoid(SWIGLU_ALPHA * glu) * (lin + 1)
        acc = acc + gate[e][:, None] * (act @ w2[e] + b2[e]).astype(F32)
    return acc.astype(h.dtype)


def setup_inputs(seed: int = 0) -> dict:
    key = jax.random.key(seed)
    ks = jax.random.split(key, 24)
    d = D_MODEL
    n_na = (DEPTH + N_MIXERS - 1) // N_MIXERS
    n_ml = DEPTH // N_MIXERS

    def nrm(k, shape, scale):
        return scale * jax.random.normal(k, shape, F32)

    gate_offsets = jnp.repeat(jnp.array([0.0, ML_FGATE_BIAS, 0.0, ML_FGATE_BIAS], F32), ML_HEADS)
    return {
        'x': nrm(ks[0], (BATCH, SEQ, d), 1.0),
        'c': nrm(ks[1], (BATCH, d), 1.0),
        'ctx': nrm(ks[2], (BATCH, CTX_LEN, d), 1.0),
        'c_ctx': nrm(ks[3], (d,), 1.0),
        'w_ada': nrm(ks[4], (DEPTH, d, 6 * d), 0.5 * d ** -0.5),
        'b_ada': nrm(ks[5], (DEPTH, 6 * d), 0.02),
        'g_norm_mix': 1.0 + nrm(ks[6], (DEPTH, d), 0.05),
        'g_norm_ffn': 1.0 + nrm(ks[7], (DEPTH, d), 0.05),
        'na_w_qkv': nrm(ks[8], (n_na, d, 3 * d), d ** -0.5),
        'na_q_gain': 1.0 + nrm(ks[9], (n_na, NA_HEAD_DIM), 0.05),
        'na_k_gain': 1.0 + nrm(ks[10], (n_na, NA_HEAD_DIM), 0.05),
        'na_rpb': nrm(ks[11], (n_na, NA_HEADS, 2 * NA_KR - 1, 2 * NA_KC - 1), 0.5),
        'na_w_o': nrm(ks[12], (n_na, d, d), d ** -0.5),
        'ml_w_in': nrm(ks[13], (n_ml, d, ML_IN), d ** -0.5),
        'ml_b_gate': gate_offsets + nrm(ks[14], (n_ml, 4 * ML_HEADS), 0.1),
        'ml_mh_gain': 1.0 + nrm(ks[15], (n_ml, ML_HEADS * ML_DV), 0.05),
        'ml_w_o': nrm(ks[16], (n_ml, ML_HEADS * ML_DV, d), (ML_HEADS * ML_DV) ** -0.5),
        'moe_w_router': nrm(ks[17], (DEPTH, d, N_EXPERTS), d ** -0.5),
        'moe_b_router': nrm(ks[18], (DEPTH, N_EXPERTS), 0.01),
        'moe_w1': nrm(ks[19], (DEPTH, N_EXPERTS, d, 2 * D_FF), d ** -0.5),
        'moe_b1': nrm(ks[20], (DEPTH, N_EXPERTS, 2 * D_FF), 0.02),
        'moe_w2': nrm(ks[21], (DEPTH, N_EXPERTS, D_FF, d), D_FF ** -0.5),
        'moe_b2': nrm(ks[22], (DEPTH, N_EXPERTS, d), 0.02),
    }


def reference(x, c, ctx, c_ctx, w_ada, b_ada, g_norm_mix, g_norm_ffn,
              na_w_qkv, na_q_gain, na_k_gain, na_rpb, na_w_o,
              ml_w_in, ml_b_gate, ml_mh_gain, ml_w_o,
              moe_w_router, moe_b_router, moe_w1, moe_b1, moe_w2, moe_b2):
    bsz = x.shape[0]
    n_ctx_tok = bsz * ctx.shape[1]
    for i in range(DEPTH):
        last = i == DEPTH - 1
        j = i // N_MIXERS
        mod_lat = jax.nn.silu(c) @ w_ada[i] + b_ada[i]
        mod_ctx = jax.nn.silu(c_ctx) @ w_ada[i] + b_ada[i]
        sh1_l, sc1_l, g1_l, sh2_l, sc2_l, g2_l = jnp.split(mod_lat[:, None, :], 6, axis=-1)
        sh1_c, sc1_c, g1_c, sh2_c, sc2_c, g2_c = jnp.split(mod_ctx, 6, axis=-1)

        h_l = modulate(rmsnorm(x, g_norm_mix[i]), sh1_l, sc1_l)
        h_c = modulate(rmsnorm(ctx, g_norm_mix[i]), sh1_c, sc1_c)
        if i % N_MIXERS == 0:
            y_l, y_c = na_mixer(h_l, h_c, na_w_qkv[j], na_q_gain[j], na_k_gain[j], na_rpb[j], na_w_o[j],
                                ctx_out=not last)
        else:
            y_l, y_c = mlstm_mixer(h_l, h_c, ml_w_in[j], ml_b_gate[j], ml_mh_gain[j], ml_w_o[j],
                                   ctx_out=not last)
        x = x + g1_l * y_l

        h_l = modulate(rmsnorm(x, g_norm_ffn[i]), sh2_l, sc2_l)
        if last:
            f_l = moe_ffn(h_l.reshape(-1, D_MODEL), moe_w_router[i], moe_b_router[i],
                          moe_w1[i], moe_b1[i], moe_w2[i], moe_b2[i])
            x = x + g2_l * f_l.reshape(x.shape)
        else:
            ctx = ctx + g1_c * y_c
            h_c = modulate(rmsnorm(ctx, g_norm_ffn[i]), sh2_c, sc2_c)
            h_all = jnp.concatenate([h_c.reshape(-1, D_MODEL), h_l.reshape(-1, D_MODEL)], axis=0)
            f_all = moe_ffn(h_all, moe_w_router[i], moe_b_router[i],
                            moe_w1[i], moe_b1[i], moe_w2[i], moe_b2[i])
            ctx = ctx + g2_c * f_all[:n_ctx_tok].reshape(ctx.shape)
            x = x + g2_l * f_all[n_ctx_tok:].reshape(x.shape)
    return x
```

```cpp
#include <hip/hip_runtime.h>
#include <cstdio>
#include <cstdint>

#ifndef MK_ONE_LAUNCH
#define MK_ONE_LAUNCH 0
#endif

#define LAS __attribute__((address_space(3)))
#define GAS __attribute__((address_space(1)))
typedef unsigned short bf16_t;
typedef short bf16x8 __attribute__((ext_vector_type(8)));
typedef short bf16x4 __attribute__((ext_vector_type(4)));
typedef float f32x4 __attribute__((ext_vector_type(4)));
typedef float f32x2 __attribute__((ext_vector_type(2)));
typedef unsigned u32x4 __attribute__((ext_vector_type(4)));
typedef unsigned u32x2 __attribute__((ext_vector_type(2)));

constexpr int D = 1024, NB = 8, SEQ = 4096, NCTX = 256, TT = NCTX + SEQ  , DEPTH = 4;
constexpr int ROWS_CTX = NB * NCTX  , ROWS = ROWS_CTX + NB * SEQ  ;
constexpr int NH_NA = 16, DH_NA = 64;
constexpr int NH_ML = 8, DV_ML = 128, DK_ML = 64, ML_IN = 3104, ML_INP = 3328;
constexpr int NE = 32, TOPK = 4, DFF = 1024;
constexpr int MAXTILES = (ROWS * TOPK) / 256 + NE  , MAXROWS = MAXTILES * 256;
constexpr float EPS = 1e-6f;
constexpr int NWAVES = 8, NTHREADS = 512;

constexpr size_t MiB = 1u << 20;
constexpr size_t al256(size_t x) { return (x + 255) & ~(size_t)255; }
constexpr size_t WS_CTL = 0, CTL_BYTES = 1 * MiB;
constexpr size_t WS_MOD = WS_CTL + CTL_BYTES;
constexpr size_t WS_ROPE = WS_MOD + al256((size_t)DEPTH * 9 * 6 * D * 4);
constexpr size_t WS_WQKV = WS_ROPE + al256(64 * 16 * 2 * 4);
constexpr size_t WS_WONA = WS_WQKV + (size_t)2 * 3072 * D * 2;
constexpr size_t WS_WIN = WS_WONA + (size_t)2 * D * D * 2;
constexpr size_t WS_WOML = WS_WIN + (size_t)2 * ML_INP * D * 2;
constexpr size_t WS_W1T = WS_WOML + (size_t)2 * D * D * 2;
constexpr size_t WS_W2T = WS_W1T + (size_t)DEPTH * NE * 2048 * D * 2;
constexpr size_t WS_XS = WS_W2T + (size_t)DEPTH * NE * D * D * 2;
constexpr size_t WS_HB = WS_XS + (size_t)ROWS * D * 4;
constexpr size_t WS_PROJ = WS_HB + (size_t)ROWS * D * 2;
constexpr size_t WS_QN = WS_PROJ + (size_t)ROWS * ML_INP * 2;
constexpr size_t WS_KN = WS_QN + (size_t)ROWS * D * 2;
constexpr size_t WS_VT = WS_KN + (size_t)ROWS * D * 2;
constexpr size_t WS_AO = WS_VT + (size_t)ROWS * D * 2;
constexpr size_t WS_HDIR = WS_QN;
constexpr size_t WS_GATES = WS_AO + (size_t)ROWS * D * 2;
constexpr size_t WS_TOPE = WS_GATES + al256((size_t)4 * NB * NH_ML * TT * 4);
constexpr size_t WS_TOPW = WS_TOPE + (size_t)ROWS * 4 * 4;
constexpr size_t WS_POS = WS_TOPW + (size_t)ROWS * 4 * 4;
constexpr size_t WS_TOKMAP = WS_POS + (size_t)ROWS * 4 * 4;
constexpr size_t WS_CNT = WS_TOKMAP + (size_t)MAXROWS * 4;
constexpr size_t WS_META = WS_CNT + (size_t)1024 * 32 * 4;
constexpr size_t WS_ACT = WS_META + 256;
constexpr size_t WS_Y = WS_ACT + (size_t)MAXROWS * D * 2;
constexpr size_t WS_END = WS_Y + (size_t)MAXROWS * D * 2;
static_assert(WS_XS % 256 == 0 && WS_ACT % 256 == 0 && WS_TOPE % 256 == 0, "ws alignment");

constexpr int CW_BAR = 4096;

constexpr int LDS_BYTES = 160 * 1024;
constexpr int LDS_CTL_OFF = LDS_BYTES - 1024;
constexpr int LDS_WORK = LDS_CTL_OFF;

#define LDS_WAIT() asm volatile("s_waitcnt lgkmcnt(0)" ::: "memory")
#define VM_WAIT() asm volatile("s_waitcnt vmcnt(0)" ::: "memory")
__device__ __forceinline__ unsigned f2bf(float f) { unsigned u = __builtin_bit_cast(unsigned, f); return (u + 0x7fffu + ((u >> 16) & 1u)) >> 16; }
__device__ __forceinline__ unsigned pk2(float lo, float hi) { return f2bf(lo) | (f2bf(hi) << 16); }
__device__ __forceinline__ float bf2f(unsigned short b) { return __builtin_bit_cast(float, ((unsigned)b) << 16); }
__device__ __forceinline__ float bflo(unsigned w) { return __builtin_bit_cast(float, w << 16); }
__device__ __forceinline__ float bfhi(unsigned w) { return __builtin_bit_cast(float, w & 0xffff0000u); }
__device__ __forceinline__ float wave_sum(float v) {
#pragma unroll
    for (int o = 1; o < 64; o <<= 1) v += __shfl_xor(v, o);
    return v;
}
__device__ __forceinline__ float wave_max(float v) {
#pragma unroll
    for (int o = 1; o < 64; o <<= 1) v = fmaxf(v, __shfl_xor(v, o));
    return v;
}
__device__ __forceinline__ float sigmoidf_(float x) { return 1.f / (1.f + __expf(-x)); }

namespace pg8 {
constexpr int BM = 256, BK = 64, HALF = 128, HTB = HALF * BK * 2  , STAGE_BYTES = 8 * HTB;
__host__ __device__ __forceinline__ int lds_byte(int r, int c) { const int st = (r >> 4) * 2 + (c >> 5), rr = r & 15, cc = c & 31, ob = rr * 64 + cc * 2; return st * 1024 + (ob ^ (((ob >> 9) & 1) << 5)); }
__host__ __device__ __forceinline__ void stage_rc(int b, int& R, int& C) { const int st = b / 1024, sb = b % 1024, swz = sb ^ (((sb >> 9) & 1) << 5); R = (st >> 1) * 16 + swz / 64; C = (st & 1) * 32 + (swz % 64) / 2; }
__host__ __device__ __forceinline__ int perm32(int rho) { const int n = rho >> 4, i = rho & 15; return 8 * (i >> 2) + 4 * n + (i & 3); }

struct Unit { int pm, pn, e; };

__device__ __forceinline__ unsigned cvt_pk_bf16(float lo, float hi) { unsigned r; asm volatile("v_cvt_pk_bf16_f32 %0, %1, %2" : "=v"(r) : "v"(lo), "v"(hi)); return r; }

template <class Epi, class Sched, bool GATHER>
__device__ __forceinline__ void gemm_phase(LAS unsigned char* lds, const int tid, const int K, const Sched& S, const Epi& E) {
    const int wid = __builtin_amdgcn_readfirstlane(tid >> 6), lane = tid & 63, wr = wid >> 2, wc = wid & 3, fr = lane & 15, fq = lane >> 4;
    const int nt = K / BK;
    int RA[2], CA[2];
    unsigned voffB[2], voffA[2][2];
#pragma unroll
    for (int i = 0; i < 2; ++i) { int R, C; stage_rc(tid * 16 + i * 8192, R, C); const int Rb = Epi::PERM ? ((R & ~31) + perm32(R & 31)) : R;
        RA[i] = R; CA[i] = C; voffB[i] = (unsigned)(Rb * K + C) * 2u; }
    const size_t kstep = (size_t)(BK * 2);
    const size_t hstep = (size_t)HALF * K * 2;
    const unsigned ldsw = (unsigned)wid * 1024u;
    const int aoff = lds_byte(wr * 64 + fr, fq * 8), boff = lds_byte(wc * 32 + fr, fq * 8);
#define PG8_SA(b, h) (((b) * 2 + (h)) * HTB)
#define PG8_SB(b, h) ((4 + (b) * 2 + (h)) * HTB)
#define PG8_STAGE(bufoff, gbase, voff) do { _Pragma("unroll") for (int _i = 0; _i < 2; ++_i) \
        __builtin_amdgcn_global_load_lds((const unsigned*)((const char*)(gbase) + (voff)[_i]), (LAS unsigned*)(lds + (bufoff) + ldsw + _i * 8192), 16, 0, 0); } while (0)
#define PG8_LDA(dst, b, h) do { _Pragma("unroll") for (int m = 0; m < 4; ++m) _Pragma("unroll") for (int k = 0; k < 2; ++k) dst[m][k] = *(const LAS bf16x8*)(lds + PG8_SA(b, h) + aoff + m * 2048 + k * 1024); } while (0)
#define PG8_LDB(dst, b, h) do { _Pragma("unroll") for (int n = 0; n < 2; ++n) _Pragma("unroll") for (int k = 0; k < 2; ++k) dst[n][k] = *(const LAS bf16x8*)(lds + PG8_SB(b, h) + boff + n * 2048 + k * 1024); } while (0)
#define PG8_MMA(ai, bj, At, Bt) do { __builtin_amdgcn_s_setprio(1); _Pragma("unroll") for (int m = 0; m < 4; ++m) _Pragma("unroll") for (int n = 0; n < 2; ++n) _Pragma("unroll") for (int k = 0; k < 2; ++k) \
        acc[ai][bj][m][n] = __builtin_amdgcn_mfma_f32_16x16x32_bf16(Bt[n][k], At[m][k], acc[ai][bj][m][n], 0, 0, 0); __builtin_amdgcn_s_setprio(0); } while (0)
#define PG8_WAIT_V(n) asm volatile("s_waitcnt vmcnt(" #n ")" ::: "memory")
#define PG8_WAIT_L(n) asm volatile("s_waitcnt lgkmcnt(" #n ")" ::: "memory")
#define PG8_BAR __builtin_amdgcn_s_barrier()
#define PG8_SCHED __builtin_amdgcn_sched_barrier(0)
#define PG8_SETVOFF(u) do { _Pragma("unroll") for (int _h = 0; _h < 2; ++_h) _Pragma("unroll") for (int _i = 0; _i < 2; ++_i) { \
        if constexpr (GATHER) voffA[_h][_i] = ((unsigned)S.a_row(u, _h * HALF + RA[_i]) * (unsigned)K + (unsigned)CA[_i]) * 2u; \
        else voffA[_h][_i] = ((unsigned)(_h * HALF + RA[_i]) * (unsigned)K + (unsigned)CA[_i]) * 2u; } } while (0)
    Unit cur, nxt; int ui = 0;
    if (!S.next(0, cur)) return;
    f32x4 acc[2][2][4][2];
#pragma unroll
    for (int a = 0; a < 2; ++a)
#pragma unroll
        for (int b = 0; b < 2; ++b)
#pragma unroll
            for (int m = 0; m < 4; ++m)
#pragma unroll
                for (int n = 0; n < 2; ++n) acc[a][b][m][n] = (f32x4){0.f, 0.f, 0.f, 0.f};
    bf16x8 At[4][2], B0[2][2], B1[2][2];
    const char* cA = S.a_base(cur); const char* cB = S.b_base(cur);
    PG8_SETVOFF(cur);
    PG8_STAGE(PG8_SB(0, 0), cB, voffB); PG8_STAGE(PG8_SB(0, 1), cB + hstep, voffB); PG8_STAGE(PG8_SA(0, 0), cA, voffA[0]); PG8_STAGE(PG8_SA(0, 1), cA, voffA[1]);
    if (wr == 1) PG8_BAR;
    PG8_WAIT_V(2); PG8_BAR;
    PG8_STAGE(PG8_SB(1, 0), cB + kstep, voffB); PG8_STAGE(PG8_SA(1, 0), cA + kstep, voffA[0]); PG8_STAGE(PG8_SB(1, 1), cB + hstep + kstep, voffB);
    PG8_WAIT_V(6); PG8_BAR;
    for (;;) {
        const bool has_next = S.next(ui + 1, nxt);
        const char* nA = has_next ? S.a_base(nxt) : cA; const char* nB = has_next ? S.b_base(nxt) : cB;
        for (int t = 0; t < nt; t += 2) {
            const bool last = (t == nt - 2);
            const char* a1 = cA + (size_t)(t + 1) * kstep;
            const char* a2 = last ? nA : cA + (size_t)(t + 2) * kstep; const char* b2 = last ? nB : cB + (size_t)(t + 2) * kstep;
            const char* a3 = a2 + kstep; const char* b3 = b2 + kstep;
            PG8_LDB(B0, 0, 0); PG8_LDB(B1, 0, 1); PG8_SCHED; PG8_LDA(At, 0, 0); PG8_STAGE(PG8_SA(1, 1), a1, voffA[1]);
            if constexpr (GATHER) { if (last && has_next) PG8_SETVOFF(nxt); }
            PG8_WAIT_V(8); PG8_WAIT_L(0); PG8_BAR; PG8_MMA(0, 0, At, B0); PG8_MMA(0, 1, At, B1); PG8_BAR; PG8_SCHED;
            PG8_LDA(At, 0, 1); PG8_STAGE(PG8_SB(0, 0), b2, voffB); PG8_STAGE(PG8_SB(0, 1), b2 + hstep, voffB); PG8_STAGE(PG8_SA(0, 0), a2, voffA[0]);
            PG8_WAIT_V(8); PG8_WAIT_L(0); PG8_BAR; PG8_MMA(1, 0, At, B0); PG8_MMA(1, 1, At, B1); PG8_BAR; PG8_SCHED;
            PG8_LDB(B0, 1, 0); PG8_LDB(B1, 1, 1); PG8_SCHED; PG8_LDA(At, 1, 0); PG8_STAGE(PG8_SA(0, 1), a2, voffA[1]);
            PG8_WAIT_V(8); PG8_WAIT_L(0); PG8_BAR; PG8_MMA(0, 0, At, B0); PG8_MMA(0, 1, At, B1); PG8_BAR; PG8_SCHED;
            PG8_LDA(At, 1, 1); PG8_STAGE(PG8_SB(1, 0), b3, voffB); PG8_STAGE(PG8_SB(1, 1), b3 + hstep, voffB); PG8_STAGE(PG8_SA(1, 0), a3, voffA[0]);
            PG8_WAIT_V(8); PG8_WAIT_L(0); PG8_BAR; PG8_MMA(1, 0, At, B0); PG8_MMA(1, 1, At, B1); PG8_BAR; PG8_SCHED;
        }
        if (wr == 0) PG8_BAR;
        E(acc, cur, wr, wc, fr, fq);
        if (!has_next) break;
#pragma unroll
        for (int a = 0; a < 2; ++a)
#pragma unroll
            for (int b = 0; b < 2; ++b)
#pragma unroll
                for (int m = 0; m < 4; ++m)
#pragma unroll
                    for (int n = 0; n < 2; ++n) acc[a][b][m][n] = (f32x4){0.f, 0.f, 0.f, 0.f};
        cur = nxt; cA = nA; cB = nB; ++ui;
        if (wr == 1) PG8_BAR;
    }
    PG8_WAIT_V(0);
    PG8_BAR;
#undef PG8_SA
#undef PG8_SB
#undef PG8_STAGE
#undef PG8_LDA
#undef PG8_LDB
#undef PG8_MMA
#undef PG8_WAIT_V
#undef PG8_WAIT_L
#undef PG8_BAR
#undef PG8_SCHED
#undef PG8_SETVOFF
}
}

#define XB_TMO      128
#define XB_XCNT(j)  (256  + 64 * (j))
#define XB_XSUB(j)  (1280 + 64 * (j))
#define XB_XGEN(j)  (2304 + 64 * (j))
#define XB_TOP      3328
#define XB_TOPGEN   3392
#define XCD_BAR_WORDS 3456
#define XB_SPIN_CAP (1u << 18)

__device__ __forceinline__ unsigned xb_ld(unsigned* p)              { return __hip_atomic_load(p, __ATOMIC_RELAXED, __HIP_MEMORY_SCOPE_AGENT); }
__device__ __forceinline__ unsigned xb_add(unsigned* p, unsigned v) { return __hip_atomic_fetch_add(p, v, __ATOMIC_RELAXED, __HIP_MEMORY_SCOPE_AGENT); }
__device__ __forceinline__ unsigned xb_xcc_id() { return (unsigned)__builtin_amdgcn_s_getreg((3 << 11) | 20) & 0xFu; }
#define XB_SPIN(cond, bar) do { unsigned _sp = 0; while (cond) { __builtin_amdgcn_s_sleep(1); \
    if ((++_sp & 255u) == 0u) { if (xb_ld(&(bar)[XB_TMO])) break; if (_sp > XB_SPIN_CAP) { atomicAdd(&(bar)[XB_TMO], 1u); break; } } } } while (0)

struct XcdBarrier {
    unsigned* bar; unsigned x;
    volatile LAS unsigned* st;
};

__device__ __forceinline__ XcdBarrier xcd_barrier_post(unsigned* bar, volatile LAS unsigned* st) {
    XcdBarrier b; b.bar = bar; b.x = xb_xcc_id(); b.st = st;
    if (threadIdx.x == 0) (void)xb_add(&bar[XB_XCNT(b.x)], 1u);
    return b;
}
__device__ __forceinline__ void xcd_barrier_complete(unsigned* bar, unsigned x, unsigned& nloc, unsigned& nx) {
    const unsigned G = gridDim.x * gridDim.y * gridDim.z;
    unsigned sum, cnt, mine, sp = 0u;
    for (;;) {
        sum = 0u; cnt = 0u; mine = 0u;
#pragma unroll
        for (unsigned j = 0; j < 16; ++j) { const unsigned c = xb_ld(&bar[XB_XCNT(j)]); sum += c; cnt += (c > 0u) ? 1u : 0u; mine = (j == x) ? c : mine; }
        if (sum == G) break;
        __builtin_amdgcn_s_sleep(1);
        if ((++sp & 255u) == 0u) { if (xb_ld(&bar[XB_TMO])) break; if (sp > XB_SPIN_CAP) { atomicAdd(&bar[XB_TMO], 1u); break; } }
    }
    nloc = mine > 0u ? mine : 1u; nx = cnt > 0u ? cnt : 1u;
}

__device__ __forceinline__ void xcd_barrier(const XcdBarrier& b) {
    asm volatile("s_waitcnt vmcnt(0)" ::: "memory");
    __syncthreads();
    if (threadIdx.x == 0) {
        unsigned* bar = b.bar;
        __builtin_amdgcn_s_waitcnt(0);
        unsigned nloc = b.st[0], nx = b.st[1];
        if (nloc == 0u) { xcd_barrier_complete(bar, b.x, nloc, nx); b.st[0] = nloc; b.st[1] = nx; }
        const unsigned old = xb_add(&bar[XB_XSUB(b.x)], 1u);
        const unsigned gen = old / nloc;
        if (old + 1u == (gen + 1u) * nloc) {
            __builtin_amdgcn_fence(__ATOMIC_RELEASE, "agent");
            asm volatile("s_waitcnt vmcnt(0)" ::: "memory");
            const unsigned og = xb_add(&bar[XB_TOP], 1u);
            const unsigned tg = og / nx;
            if (og + 1u == (tg + 1u) * nx) xb_add(&bar[XB_TOPGEN], 1u);
            else XB_SPIN(xb_ld(&bar[XB_TOPGEN]) == tg, bar);
            __builtin_amdgcn_fence(__ATOMIC_ACQUIRE, "agent");
            xb_add(&bar[XB_XGEN(b.x)], 1u);
            asm volatile("s_waitcnt vmcnt(0)" ::: "memory");
        } else {
            XB_SPIN(xb_ld(&bar[XB_XGEN(b.x)]) == gen, bar);
            __builtin_amdgcn_fence(__ATOMIC_ACQUIRE, "agent");
            asm volatile("s_waitcnt vmcnt(0)" ::: "memory");
        }
    }
    __syncthreads();
}

struct Args { const float* in[23]; float* out; unsigned char* ws; int ph_lo, ph_hi; };
struct Frame {
    LAS unsigned char* lds;
    volatile LAS int* LCTL;
    int tid, lane, wave, vcu, G;
};
__device__ __forceinline__ unsigned long long ptr_get(const Frame& F, int i) {
    const unsigned lo = (unsigned)F.LCTL[128 + 2 * i], hi = (unsigned)F.LCTL[129 + 2 * i];
    return ((unsigned long long)(unsigned)__builtin_amdgcn_readfirstlane((int)hi) << 32) | (unsigned long long)(unsigned)__builtin_amdgcn_readfirstlane((int)lo);
}
__device__ __forceinline__ const float* inp(const Frame& F, int i) { return (const float*)ptr_get(F, i); }
__device__ __forceinline__ unsigned char* wsp(const Frame& F) { return (unsigned char*)ptr_get(F, 23); }
__device__ __forceinline__ float* outp(const Frame& F) { return (float*)ptr_get(F, 24); }
enum { I_X = 0, I_C, I_CTX, I_CCTX, I_WADA, I_BADA, I_GMIX, I_GFFN, I_WQKV, I_QGAIN, I_KGAIN, I_RPB, I_WONA, I_WIN, I_BGATE, I_MHGAIN, I_WOML,
       I_WR, I_BR, I_W1, I_B1, I_W2, I_B2 };

struct DenseOrder {
    int nM, nN, nwg, G, c, pm0, K; const char* A; const char* Bt;
    __device__ __forceinline__ void init(int pm0_, int nM_, int nN_, int G_, int c_, const void* A_, const void* Bt_, int K_) { pm0 = pm0_; nM = nM_; nN = nN_; nwg = nM * nN; G = G_; c = c_; A = (const char*)A_; Bt = (const char*)Bt_; K = K_; }
    __device__ __forceinline__ bool next(int i, pg8::Unit& u) const {
        const long L = (long)i * G + c; if (L >= nwg) return false;
        int wgid = (int)L; { const int q = nwg / 8, r = nwg % 8, xcd = wgid % 8, off = wgid / 8; wgid = (xcd < r ? xcd * (q + 1) : r * (q + 1) + (xcd - r) * q) + off; }
        const int nig = 8 * nN, gid = wgid / nig, fm = gid * 8, gsz = (nM - fm) < 8 ? (nM - fm) : 8;
        u.pm = pm0 + fm + ((wgid % nig) % gsz); u.pn = (wgid % nig) / gsz; u.e = 0; return true;
    }
    __device__ __forceinline__ const char* a_base(const pg8::Unit& u) const { return A + (size_t)u.pm * 256 * K * 2; }
    __device__ __forceinline__ const char* b_base(const pg8::Unit& u) const { return Bt + (size_t)u.pn * 256 * K * 2; }
    __device__ __forceinline__ int a_row(const pg8::Unit&, int) const { return 0; }
};
struct MoeOrder {
    int NT, nunits, G, c, K; const char* A; const char* W; size_t estride; const int* tokmap; volatile LAS int* prefix; bool gather;
    __device__ __forceinline__ bool next(int i, pg8::Unit& u) const {
        const long L = (long)i * G + c; if (L >= nunits) return false;
        int wgid = (int)L; { const int q = nunits / 8, r = nunits % 8, xcd = wgid % 8, off = wgid / 8; wgid = (xcd < r ? xcd * (q + 1) : r * (q + 1) + (xcd - r) * q) + off; }
        const int tile = wgid / NT; u.pm = tile; u.pn = wgid - tile * NT;
        int e = 0;
#pragma unroll 1
        for (int j = 1; j < NE; ++j) e += (prefix[j] <= tile) ? 1 : 0;
        u.e = e; return true;
    }
    __device__ __forceinline__ const char* a_base(const pg8::Unit& u) const { return gather ? A : A + (size_t)u.pm * 256 * K * 2; }
    __device__ __forceinline__ const char* b_base(const pg8::Unit& u) const { return W + (size_t)u.e * estride + (size_t)u.pn * 256 * K * 2; }
    __device__ __forceinline__ int a_row(const pg8::Unit& u, int r) const { return tokmap[u.pm * 256 + r]; }
};

typedef f32x4 AccT[2][2][4][2];
struct EpiStoreBf16 {
    static constexpr bool PERM = true;
    bf16_t* O; int ldc;
    __device__ __forceinline__ void operator()(const AccT& acc, const pg8::Unit& u, int wr, int wc, int fr, int fq) const {
        const int row0 = u.pm * 256 + wr * 64 + fr, col0 = u.pn * 256 + wc * 32 + 8 * fq;
#pragma unroll
        for (int ai = 0; ai < 2; ++ai)
#pragma unroll
            for (int m = 0; m < 4; ++m) { bf16_t* rowp = O + (size_t)(row0 + ai * 128 + m * 16) * ldc + col0;
#pragma unroll
                for (int bj = 0; bj < 2; ++bj) { const f32x4 v0 = acc[ai][bj][m][0], v1 = acc[ai][bj][m][1];
                    u32x4 w; w.x = pg8::cvt_pk_bf16(v0[0], v0[1]); w.y = pg8::cvt_pk_bf16(v0[2], v0[3]); w.z = pg8::cvt_pk_bf16(v1[0], v1[1]); w.w = pg8::cvt_pk_bf16(v1[2], v1[3]);
                    *(u32x4*)(rowp + bj * 128) = w; } }
    }
};
struct EpiY {
    static constexpr bool PERM = true;
    bf16_t* O; const float* b2;
    __device__ __forceinline__ void operator()(const AccT& acc, const pg8::Unit& u, int wr, int wc, int fr, int fq) const {
        const int row0 = u.pm * 256 + wr * 64 + fr, col0 = u.pn * 256 + wc * 32 + 8 * fq;
        const float* bp = b2 + (size_t)u.e * D + col0;
        f32x4 bv[2][2];
#pragma unroll
        for (int bj = 0; bj < 2; ++bj)
#pragma unroll
            for (int n = 0; n < 2; ++n) bv[bj][n] = *(const f32x4*)(bp + bj * 128 + 4 * n);
#pragma unroll
        for (int ai = 0; ai < 2; ++ai)
#pragma unroll
            for (int m = 0; m < 4; ++m) { bf16_t* rowp = O + (size_t)(row0 + ai * 128 + m * 16) * D + col0;
#pragma unroll
                for (int bj = 0; bj < 2; ++bj) { const f32x4 v0 = acc[ai][bj][m][0] + bv[bj][0], v1 = acc[ai][bj][m][1] + bv[bj][1];
                    u32x4 w; w.x = pg8::cvt_pk_bf16(v0[0], v0[1]); w.y = pg8::cvt_pk_bf16(v0[2], v0[3]); w.z = pg8::cvt_pk_bf16(v1[0], v1[1]); w.w = pg8::cvt_pk_bf16(v1[2], v1[3]);
                    *(u32x4*)(rowp + bj * 128) = w; } }
    }
};
struct EpiSwiglu {
    static constexpr bool PERM = true;
    bf16_t* O; const float* b1;
    __device__ __forceinline__ void operator()(const AccT& acc, const pg8::Unit& u, int wr, int wc, int fr, int fq) const {
        const int row0 = u.pm * 256 + wr * 64 + fr, cc0 = u.pn * 128 + wc * 32 + 8 * fq;
        const float* bp = b1 + (size_t)u.e * 2048 + cc0;
        f32x4 bg[2], bl[2];
#pragma unroll
        for (int n = 0; n < 2; ++n) { bg[n] = *(const f32x4*)(bp + 4 * n); bl[n] = *(const f32x4*)(bp + 1024 + 4 * n); }
#pragma unroll
        for (int ai = 0; ai < 2; ++ai)
#pragma unroll
            for (int m = 0; m < 4; ++m) { bf16_t* rowp = O + (size_t)(row0 + ai * 128 + m * 16) * D + cc0;
                float o[8];
#pragma unroll
                for (int n = 0; n < 2; ++n) { const f32x4 gl = acc[ai][0][m][n] + bg[n], li = acc[ai][1][m][n] + bl[n];
#pragma unroll
                    for (int j = 0; j < 4; ++j) { const float g = fminf(gl[j], 7.0f), l = fminf(fmaxf(li[j], -7.0f), 7.0f);
                        o[4 * n + j] = g * sigmoidf_(1.702f * g) * (l + 1.0f); } }
                u32x4 w; w.x = pg8::cvt_pk_bf16(o[0], o[1]); w.y = pg8::cvt_pk_bf16(o[2], o[3]); w.z = pg8::cvt_pk_bf16(o[4], o[5]); w.w = pg8::cvt_pk_bf16(o[6], o[7]);
                *(u32x4*)rowp = w; }
    }
};
struct EpiResid {
    static constexpr bool PERM = false;
    float* xs; const float* g;
    __device__ __forceinline__ void operator()(const AccT& acc, const pg8::Unit& u, int wr, int wc, int fr, int fq) const {
        const int row0 = u.pm * 256 + wr * 64 + fr, col0 = u.pn * 256 + wc * 32 + 4 * fq;
        const int mb = u.pm < 8 ? 8 : ((u.pm - 8) >> 4);
        const float* gp = g + (size_t)mb * 6144 + col0;
        f32x4 gv[2][2];
#pragma unroll
        for (int bj = 0; bj < 2; ++bj)
#pragma unroll
            for (int n = 0; n < 2; ++n) gv[bj][n] = *(const f32x4*)(gp + bj * 128 + n * 16);
#pragma unroll
        for (int ai = 0; ai < 2; ++ai)
#pragma unroll
            for (int m = 0; m < 4; ++m) { float* rowp = xs + (size_t)(row0 + ai * 128 + m * 16) * D + col0;
#pragma unroll
                for (int bj = 0; bj < 2; ++bj)
#pragma unroll
                    for (int n = 0; n < 2; ++n) { f32x4* p = (f32x4*)(rowp + bj * 128 + n * 16); *p = *p + gv[bj][n] * acc[ai][bj][m][n]; } }
    }
};

__device__ __forceinline__ const float* modp(const Frame& F, int l, int mb, int chunk) { return (const float*)(wsp(F) + WS_MOD) + ((size_t)(l * 9 + mb) * 6 + chunk) * D; }
__device__ __forceinline__ int row_mb(int row) { return row < ROWS_CTX ? 8 : ((row - ROWS_CTX) >> 12); }

__device__ __forceinline__ void transpose_item(const float* W, int N, int Nvalid, bf16_t* WT, int k0, int n0, LAS float* scr, int lane) {
    const int nn = 4 * (lane & 15);
    const bool ok = (n0 + nn) < Nvalid;
    f32x4 v[16];
#pragma unroll
    for (int i = 0; i < 16; ++i) { const int kk = 4 * i + (lane >> 4);
        v[i] = ok ? *(const f32x4*)(W + (size_t)(k0 + kk) * N + n0 + nn) : (f32x4){0.f, 0.f, 0.f, 0.f}; }
#pragma unroll
    for (int i = 0; i < 16; ++i) { const int kk = 4 * i + (lane >> 4); LAS float* s = scr + kk * 65 + nn;
        s[0] = v[i][0]; s[1] = v[i][1]; s[2] = v[i][2]; s[3] = v[i][3]; }
    LDS_WAIT(); asm volatile("" ::: "memory");
    const int c = lane & 7;
#pragma unroll
    for (int j = 0; j < 8; ++j) { const int n = (lane >> 3) + 8 * j; const LAS float* s = scr + (8 * c) * 65 + n;
        u32x4 o; o.x = pk2(s[0 * 65], s[1 * 65]); o.y = pk2(s[2 * 65], s[3 * 65]); o.z = pk2(s[4 * 65], s[5 * 65]); o.w = pk2(s[6 * 65], s[7 * 65]);
        *(u32x4*)(WT + (size_t)n * D + k0 + 8 * c) = o; }
    LDS_WAIT(); asm volatile("" ::: "memory");
}
__device__ __forceinline__ void phase0(Frame& F) {
    const int tid = F.tid, lane = F.lane, wave = F.wave;
    {
        LAS float* sT = (LAS float*)F.lds;
        LAS float* red = (LAS float*)(F.lds + 40960);
        const float* c = inp(F, I_C); const float* cctx = inp(F, I_CCTX);
        for (int idx = tid; idx < 9 * D; idx += NTHREADS) { const int mb = idx >> 10, k = idx & 1023; const float cv = mb < 8 ? c[mb * D + k] : cctx[k]; sT[idx] = cv / (1.f + __expf(-cv)); }
        __syncthreads();
        float* mod = (float*)(wsp(F) + WS_MOD);
        for (int task = F.vcu; task < DEPTH * 96; task += F.G) {
            const int l = task / 96, cb = task % 96;
            const float* wp = inp(F, I_WADA) + ((size_t)l * D + wave * 128) * 6144 + cb * 64 + lane;
            float acc[9];
#pragma unroll
            for (int mb = 0; mb < 9; ++mb) acc[mb] = 0.f;
#pragma unroll 8
            for (int k = 0; k < 128; ++k) { const float wv = wp[(size_t)k * 6144];
#pragma unroll
                for (int mb = 0; mb < 9; ++mb) acc[mb] += sT[mb * D + wave * 128 + k] * wv; }
#pragma unroll
            for (int mb = 0; mb < 9; ++mb) red[(wave * 9 + mb) * 64 + lane] = acc[mb];
            __syncthreads();
            for (int idx = tid; idx < 9 * 64; idx += NTHREADS) { const int mb = idx >> 6, ln = idx & 63; float s = 0.f;
#pragma unroll
                for (int w = 0; w < 8; ++w) s += red[(w * 9 + mb) * 64 + ln];
                const int col = cb * 64 + ln;
                mod[(size_t)(l * 9 + mb) * 6144 + col] = s + inp(F, I_BADA)[l * 6144 + col]; }
            __syncthreads();
        }
        if (blockIdx.x == 0) {
            float* rope = (float*)(wsp(F) + WS_ROPE);
            for (int idx = tid; idx < 64 * 16; idx += NTHREADS) { const int pos = idx >> 4, i = idx & 15; const float inv = powf(10000.0f, -(float)i / 16.0f); const float ang = (float)pos * inv;
                rope[idx * 2] = cosf(ang); rope[idx * 2 + 1] = sinf(ang); }
        }
        __syncthreads();
    }
    {
        LAS float* scr = (LAS float*)(F.lds + wave * 16640);
        const int gw = F.vcu * NWAVES + wave, NGW = F.G * NWAVES;
        constexpr int I_QKV = 2 * 16 * 48, I_WO = 4 * 16 * 16, I_IN = 2 * 16 * 52, I_1 = DEPTH * NE * 16 * 32, I_2 = DEPTH * NE * 16 * 16;
        for (int it0 = gw; it0 < I_QKV + I_WO + I_IN + I_1 + I_2; it0 += NGW) {
            int it = it0;
            if (it < I_QKV) { const int j = it / 768, r = it % 768, kb = r / 48, nb = r % 48;
                transpose_item(inp(F, I_WQKV) + (size_t)j * D * 3072, 3072, 3072, (bf16_t*)(wsp(F) + WS_WQKV) + ((size_t)j * 3072 + nb * 64) * D, kb * 64, nb * 64, scr, lane); continue; }
            it -= I_QKV;
            if (it < I_WO) { const int m = it / 256, r = it % 256, kb = r / 16, nb = r % 16;
                const float* W = (m < 2) ? inp(F, I_WONA) + (size_t)m * D * D : inp(F, I_WOML) + (size_t)(m - 2) * D * D;
                bf16_t* dst = (m < 2) ? (bf16_t*)(wsp(F) + WS_WONA) + (size_t)m * D * D : (bf16_t*)(wsp(F) + WS_WOML) + (size_t)(m - 2) * D * D;
                transpose_item(W, D, D, dst + (size_t)nb * 64 * D, kb * 64, nb * 64, scr, lane); continue; }
            it -= I_WO;
            if (it < I_IN) { const int j = it / 832, r = it % 832, kb = r / 52, nb = r % 52;
                transpose_item(inp(F, I_WIN) + (size_t)j * D * ML_IN, ML_IN, ML_IN, (bf16_t*)(wsp(F) + WS_WIN) + ((size_t)j * ML_INP + nb * 64) * D, kb * 64, nb * 64, scr, lane); continue; }
            it -= I_IN;
            if (it < I_1) { const int le = it / 512, r = it % 512, kb = r / 32, nb = r % 32;
                const int n0 = nb * 64, bj = n0 >> 10, j0 = n0 & 1023, pn = j0 >> 7, jj0 = j0 & 127, drow = pn * 256 + bj * 128 + jj0;
                transpose_item(inp(F, I_W1) + (size_t)le * D * 2048, 2048, 2048, (bf16_t*)(wsp(F) + WS_W1T) + ((size_t)le * 2048 + drow) * D, kb * 64, n0, scr, lane); continue; }
            it -= I_1;
            { const int le = it / 256, r = it % 256, kb = r / 16, nb = r % 16;
                transpose_item(inp(F, I_W2) + (size_t)le * D * D, D, D, (bf16_t*)(wsp(F) + WS_W2T) + ((size_t)le * D + nb * 64) * D, kb * 64, nb * 64, scr, lane); }
        }
    }
}

__device__ __forceinline__ void moe_combine(const Frame& F, int row, int lprev, int mb, f32x4 (&v)[4]) {
    const int* pos = (const int*)(wsp(F) + WS_POS) + (size_t)row * 4;
    const float* tw = (const float*)(wsp(F) + WS_TOPW) + (size_t)row * 4;
    const bf16_t* Y = (const bf16_t*)(wsp(F) + WS_Y);
    f32x4 a[4];
#pragma unroll
    for (int j = 0; j < 4; ++j) a[j] = (f32x4){0.f, 0.f, 0.f, 0.f};
#pragma unroll
    for (int k = 0; k < 4; ++k) { const int p = pos[k]; const float w = tw[k]; const u32x2* yp = (const u32x2*)(Y + (size_t)p * D) + F.lane;
#pragma unroll
        for (int j = 0; j < 4; ++j) { const u32x2 y = yp[64 * j]; a[j] = a[j] + w * (f32x4){bflo(y.x), bfhi(y.x), bflo(y.y), bfhi(y.y)}; } }
    const f32x4* g2 = (const f32x4*)modp(F, lprev, mb, 5) + F.lane;
#pragma unroll
    for (int j = 0; j < 4; ++j) v[j] = v[j] + g2[64 * j] * a[j];
}

__device__ __forceinline__ void phase_norm1(Frame& F, int l) {
    const int gw = F.vcu * NWAVES + F.wave, NGW = F.G * NWAVES, lane = F.lane;
    float* xs = (float*)(wsp(F) + WS_XS); bf16_t* hb = (bf16_t*)(wsp(F) + WS_HB);
    const f32x4* gm = (const f32x4*)(inp(F, I_GMIX) + l * D) + lane;
    for (int row = gw; row < ROWS; row += NGW) {
        const int mb = row_mb(row);
        const float* src = (l == 0) ? (row < ROWS_CTX ? inp(F, I_CTX) + (size_t)row * D : inp(F, I_X) + (size_t)(row - ROWS_CTX) * D) : xs + (size_t)row * D;
        const f32x4* xr = (const f32x4*)src + lane;
        f32x4 v[4];
#pragma unroll
        for (int j = 0; j < 4; ++j) v[j] = xr[64 * j];
        if (l > 0) moe_combine(F, row, l - 1, mb, v);
        f32x4* xw = (f32x4*)(xs + (size_t)row * D) + lane;
        float ss = 0.f;
#pragma unroll
        for (int j = 0; j < 4; ++j) { xw[64 * j] = v[j]; ss += (v[j][0] * v[j][0] + v[j][1] * v[j][1]) + (v[j][2] * v[j][2] + v[j][3] * v[j][3]); }
        const float rs = 1.0f / sqrtf(wave_sum(ss) * (1.f / D) + EPS);
        const f32x4* sh = (const f32x4*)modp(F, l, mb, 0) + lane; const f32x4* sc = (const f32x4*)modp(F, l, mb, 1) + lane;
        u32x2* o8 = (u32x2*)(hb + (size_t)row * D) + lane;
#pragma unroll
        for (int j = 0; j < 4; ++j) { const f32x4 h = (v[j] * rs) * gm[64 * j] * (sc[64 * j] + 1.0f) + sh[64 * j];
            u32x2 w; w.x = pk2(h[0], h[1]); w.y = pk2(h[2], h[3]); o8[64 * j] = w; }
    }
}
__device__ __forceinline__ void phase_final(Frame& F) {
    const int gw = F.vcu * NWAVES + F.wave, NGW = F.G * NWAVES, lane = F.lane;
    const float* xs = (const float*)(wsp(F) + WS_XS);
    for (int row = ROWS_CTX + gw; row < ROWS; row += NGW) {
        const int mb = row_mb(row);
        const f32x4* xr = (const f32x4*)(xs + (size_t)row * D) + lane;
        f32x4 v[4];
#pragma unroll
        for (int j = 0; j < 4; ++j) v[j] = xr[64 * j];
        moe_combine(F, row, DEPTH - 1, mb, v);
        f32x4* o = (f32x4*)(outp(F) + (size_t)(row - ROWS_CTX) * D) + lane;
#pragma unroll
        for (int j = 0; j < 4; ++j) o[64 * j] = v[j];
    }
}

__device__ __forceinline__ void phase_na_post(Frame& F, int jn) {
    const int gw = F.vcu * NWAVES + F.wave, NGW = F.G * NWAVES, lane = F.lane;
    const bf16_t* proj = (const bf16_t*)(wsp(F) + WS_PROJ);
    bf16_t* QN = (bf16_t*)(wsp(F) + WS_QN); bf16_t* KN = (bf16_t*)(wsp(F) + WS_KN); bf16_t* VT = (bf16_t*)(wsp(F) + WS_VT);
    LAS bf16_t* vs = (LAS bf16_t*)(F.lds + F.wave * (64 * 72 * 2));
    const int c8 = lane & 7, rl = lane >> 3;
    float qg[8], kg[8];
#pragma unroll
    for (int e = 0; e < 8; ++e) { qg[e] = inp(F, I_QGAIN)[jn * 64 + c8 * 8 + e] * 0.125f; kg[e] = inp(F, I_KGAIN)[jn * 64 + c8 * 8 + e]; }
    for (int item = gw; item < (ROWS / 64) * NH_NA; item += NGW) {
        const int rb = item >> 4, h = item & 15, row0 = rb * 64;
        int b, tp0;
        if (row0 < ROWS_CTX) { b = row0 >> 8; tp0 = row0 & 255; } else { b = (row0 - ROWS_CTX) >> 12; tp0 = NCTX + ((row0 - ROWS_CTX) & 4095); }
        const size_t seqbase = ((size_t)(b * NH_NA + h) * TT + tp0) * 64;
#pragma unroll
        for (int i = 0; i < 8; ++i) {
            const int r = i * 8 + rl;
            const bf16_t* pr = proj + (size_t)(row0 + r) * 3072 + h * 64 + c8 * 8;
            const u32x4 qv = *(const u32x4*)pr, kv = *(const u32x4*)(pr + 1024), vv = *(const u32x4*)(pr + 2048);
            float q[8] = {bflo(qv.x), bfhi(qv.x), bflo(qv.y), bfhi(qv.y), bflo(qv.z), bfhi(qv.z), bflo(qv.w), bfhi(qv.w)};
            float k[8] = {bflo(kv.x), bfhi(kv.x), bflo(kv.y), bfhi(kv.y), bflo(kv.z), bfhi(kv.z), bflo(kv.w), bfhi(kv.w)};
            float sq = 0.f, sk = 0.f;
#pragma unroll
            for (int e = 0; e < 8; ++e) { sq += q[e] * q[e]; sk += k[e] * k[e]; }
            sq += __shfl_xor(sq, 1); sq += __shfl_xor(sq, 2); sq += __shfl_xor(sq, 4);
            sk += __shfl_xor(sk, 1); sk += __shfl_xor(sk, 2); sk += __shfl_xor(sk, 4);
            const float rq = 1.0f / sqrtf(sq * (1.f / 64) + EPS), rk = 1.0f / sqrtf(sk * (1.f / 64) + EPS);
            u32x4 qo, ko;
            qo.x = pk2(q[0] * rq * qg[0], q[1] * rq * qg[1]); qo.y = pk2(q[2] * rq * qg[2], q[3] * rq * qg[3]); qo.z = pk2(q[4] * rq * qg[4], q[5] * rq * qg[5]); qo.w = pk2(q[6] * rq * qg[6], q[7] * rq * qg[7]);
            ko.x = pk2(k[0] * rk * kg[0], k[1] * rk * kg[1]); ko.y = pk2(k[2] * rk * kg[2], k[3] * rk * kg[3]); ko.z = pk2(k[4] * rk * kg[4], k[5] * rk * kg[5]); ko.w = pk2(k[6] * rk * kg[6], k[7] * rk * kg[7]);
            *(u32x4*)(QN + seqbase + (size_t)r * 64 + c8 * 8) = qo;
            *(u32x4*)(KN + seqbase + (size_t)r * 64 + c8 * 8) = ko;
            *(LAS u32x4*)(vs + r * 72 + c8 * 8) = vv;
        }
        LDS_WAIT(); asm volatile("" ::: "memory");
#pragma unroll
        for (int j = 0; j < 8; ++j) {
            const int d = rl + 8 * j;
            const LAS bf16_t* s = vs + (8 * c8) * 72 + d;
            u32x4 o;
            o.x = (unsigned)s[0 * 72] | ((unsigned)s[1 * 72] << 16); o.y = (unsigned)s[2 * 72] | ((unsigned)s[3 * 72] << 16);
            o.z = (unsigned)s[4 * 72] | ((unsigned)s[5 * 72] << 16); o.w = (unsigned)s[6 * 72] | ((unsigned)s[7 * 72] << 16);
            *(u32x4*)(VT + ((size_t)(b * NH_NA + h) * 64 + d) * TT + tp0 + 8 * c8) = o;
        }
        LDS_WAIT(); asm volatile("" ::: "memory");
    }
}

__device__ __forceinline__ bf16x8 ld_bf16x8(const bf16_t* p) { return *(const bf16x8*)p; }
__device__ __forceinline__ void na_wave_task(const Frame& F, int jn, int b, int h, bool ctxq, int cb, int r, int qw) {
    const int lane = F.lane, q16 = lane & 15, g = lane >> 4;
    const bf16_t* Qb = (const bf16_t*)(wsp(F) + WS_QN) + (size_t)(b * NH_NA + h) * TT * 64;
    const bf16_t* Kb = (const bf16_t*)(wsp(F) + WS_KN) + (size_t)(b * NH_NA + h) * TT * 64;
    const bf16_t* Vb = (const bf16_t*)(wsp(F) + WS_VT) + (size_t)(b * NH_NA + h) * 64 * TT;
    const float* rpb = inp(F, I_RPB) + (size_t)(jn * NH_NA + h) * 15 * 31;
    const int qc = qw * 16 + q16;
    const int qtp = ctxq ? cb * 16 + q16 : NCTX + r * 64 + qc;
    const bf16x8 qf0 = ld_bf16x8(Qb + (size_t)qtp * 64 + 8 * g), qf1 = ld_bf16x8(Qb + (size_t)qtp * 64 + 32 + 8 * g);
    f32x4 o[4];
#pragma unroll
    for (int j = 0; j < 4; ++j) o[j] = (f32x4){0.f, 0.f, 0.f, 0.f};
    float m = -1e30f, lsum = 0.f;
    const int r0 = min(max(r - 4, 0), 56), c0 = min(max(qc - 8, 0), 48);
    const int lo = min(max(16 * qw - 8, 0), 48), hi = min(max(16 * qw + 7, 0), 48) + 15;
    const int nwin = ctxq ? 0 : 16;
    for (int blk = 0; blk < 8 + nwin; ++blk) {
        int tok0, kbcol = 0, dr = 0; bool win = false;
        if (blk < 8) tok0 = blk * 32;
        else { const int wi = (blk - 8) >> 1; kbcol = ((blk - 8) & 1) * 32; win = true;
            if (kbcol == 0 ? (lo >= 32) : (hi < 32)) continue;
            const int kr = r0 + wi; dr = kr - r + 7; tok0 = NCTX + kr * 64 + kbcol; }
        f32x4 s0 = (f32x4){0.f, 0.f, 0.f, 0.f}, s1 = (f32x4){0.f, 0.f, 0.f, 0.f};
        const bf16_t* kp = Kb + (size_t)(tok0 + q16) * 64 + 8 * g;
        const bf16x8 ka0 = ld_bf16x8(kp), ka1 = ld_bf16x8(kp + 32), kb0 = ld_bf16x8(kp + 16 * 64), kb1 = ld_bf16x8(kp + 16 * 64 + 32);
        bf16x8 vf[4];
#pragma unroll
        for (int j4 = 0; j4 < 4; ++j4) { const bf16_t* vp = Vb + (size_t)(16 * j4 + q16) * TT + tok0 + 4 * g;
            const bf16x4 va = *(const bf16x4*)vp, vb = *(const bf16x4*)(vp + 16);
            vf[j4] = (bf16x8){va[0], va[1], va[2], va[3], vb[0], vb[1], vb[2], vb[3]}; }
        s0 = __builtin_amdgcn_mfma_f32_16x16x32_bf16(ka0, qf0, s0, 0, 0, 0); s0 = __builtin_amdgcn_mfma_f32_16x16x32_bf16(ka1, qf1, s0, 0, 0, 0);
        s1 = __builtin_amdgcn_mfma_f32_16x16x32_bf16(kb0, qf0, s1, 0, 0, 0); s1 = __builtin_amdgcn_mfma_f32_16x16x32_bf16(kb1, qf1, s1, 0, 0, 0);
        float sv[8] = {s0[0], s0[1], s0[2], s0[3], s1[0], s1[1], s1[2], s1[3]};
        if (win) {
#pragma unroll
            for (int e = 0; e < 8; ++e) { const int kc = kbcol + 16 * (e >> 2) + 4 * g + (e & 3);
                const bool valid = (kc >= c0) && (kc <= c0 + 15);
                const int idx = min(max(kc - qc + 15, 0), 30);
                const float bias = rpb[dr * 31 + idx];
                sv[e] = valid ? sv[e] + bias : -1e30f; }
        }
        float bm = fmaxf(fmaxf(fmaxf(sv[0], sv[1]), fmaxf(sv[2], sv[3])), fmaxf(fmaxf(sv[4], sv[5]), fmaxf(sv[6], sv[7])));
        bm = fmaxf(bm, __shfl_xor(bm, 16)); bm = fmaxf(bm, __shfl_xor(bm, 32));
        const float mn = fmaxf(m, bm), alpha = __expf(m - mn);
        float p[8], ps = 0.f;
#pragma unroll
        for (int e = 0; e < 8; ++e) { p[e] = __expf(sv[e] - mn); ps += p[e]; }
        lsum = lsum * alpha + ps; m = mn;
#pragma unroll
        for (int j = 0; j < 4; ++j) o[j] = o[j] * alpha;
        union { u32x4 u; bf16x8 v; } pf;
        pf.u.x = pk2(p[0], p[1]); pf.u.y = pk2(p[2], p[3]); pf.u.z = pk2(p[4], p[5]); pf.u.w = pk2(p[6], p[7]);
#pragma unroll
        for (int j4 = 0; j4 < 4; ++j4) o[j4] = __builtin_amdgcn_mfma_f32_16x16x32_bf16(vf[j4], pf.v, o[j4], 0, 0, 0);
    }
    lsum += __shfl_xor(lsum, 16); lsum += __shfl_xor(lsum, 32);
    const float inv = 1.0f / lsum;
    const int row = ctxq ? b * NCTX + cb * 16 + q16 : ROWS_CTX + b * SEQ + r * 64 + qc;
    bf16_t* op = (bf16_t*)(wsp(F) + WS_AO) + (size_t)row * D + h * 64 + 4 * g;
#pragma unroll
    for (int j4 = 0; j4 < 4; ++j4) { u32x2 w; w.x = pk2(o[j4][0] * inv, o[j4][1] * inv); w.y = pk2(o[j4][2] * inv, o[j4][3] * inv); *(u32x2*)(op + 16 * j4) = w; }
}
__device__ __forceinline__ void phase_na_attn(Frame& F, int jn) {
    for (int bt = F.vcu; bt < NB * NH_NA * 32; bt += F.G) {
        const int bh = bt >> 5, p = bt & 31;
        na_wave_task(F, jn, bh >> 4, bh & 15, false, 0, 2 * p + (F.wave >> 2), F.wave & 3);
    }
    for (int wt = F.vcu * NWAVES + F.wave; wt < NB * NH_NA * 16; wt += F.G * NWAVES) {
        const int bh = wt >> 4, cb = wt & 15;
        na_wave_task(F, jn, bh >> 4, bh & 15, true, cb, 0, 0);
    }
}

__device__ __forceinline__ void row_decode(int row, int& b, int& tp) {
    if (row < ROWS_CTX) { b = row >> 8; tp = row & 255; } else { b = (row - ROWS_CTX) >> 12; tp = NCTX + ((row - ROWS_CTX) & 4095); }
}
__device__ __forceinline__ void unpack8(const u32x4 v, float (&f)[8]) { f[0] = bflo(v.x); f[1] = bfhi(v.x); f[2] = bflo(v.y); f[3] = bfhi(v.y); f[4] = bflo(v.z); f[5] = bfhi(v.z); f[6] = bflo(v.w); f[7] = bfhi(v.w); }
__device__ __forceinline__ u32x4 pack8(const float (&f)[8]) { u32x4 o; o.x = pk2(f[0], f[1]); o.y = pk2(f[2], f[3]); o.z = pk2(f[4], f[5]); o.w = pk2(f[6], f[7]); return o; }
__device__ __forceinline__ void phase_ml_post(Frame& F, int jm) {
    const int gw = F.vcu * NWAVES + F.wave, NGW = F.G * NWAVES, lane = F.lane;
    bf16_t* proj = (bf16_t*)(wsp(F) + WS_PROJ);
    const float* rope = (const float*)(wsp(F) + WS_ROPE);
    float* gates = (float*)(wsp(F) + WS_GATES);
    const int t16 = lane >> 2, sub = lane & 3, hf = sub >> 1, i0 = 8 * (sub & 1), cbase = t16 * 64 + 32 * hf + i0;
    const float scale = t16 < 8 ? 0.125f : 1.0f;
    for (int row = gw; row < ROWS; row += NGW) {
        int b, tp; row_decode(row, b, tp);
        bf16_t* pr = proj + (size_t)row * ML_INP;
        float a[8], c[8], o1[8], o2[8];
        unpack8(*(const u32x4*)(pr + cbase), a); unpack8(*(const u32x4*)(pr + cbase + 16), c);
        if (tp >= NCTX) {
            const int s = tp - NCTX, pos = hf ? (s & 63) : (s >> 6);
            const float* rp = rope + (pos * 16 + i0) * 2;
#pragma unroll
            for (int e = 0; e < 8; ++e) { const float cs = rp[2 * e], sn = rp[2 * e + 1]; o1[e] = (a[e] * cs - c[e] * sn) * scale; o2[e] = (a[e] * sn + c[e] * cs) * scale; }
        } else {
#pragma unroll
            for (int e = 0; e < 8; ++e) { o1[e] = a[e] * scale; o2[e] = c[e] * scale; }
        }
        float gv = 0.f;
        if (lane < 32) gv = bf2f(pr[3072 + lane]);
        *(u32x4*)(pr + cbase) = pack8(o1); *(u32x4*)(pr + cbase + 16) = pack8(o2);
        if (lane < 32) {
            float v = gv + inp(F, I_BGATE)[jm * 32 + lane];
            v = 15.0f * tanhf(v * (1.0f / 15.0f));
            const int gi = lane >> 3, hh = lane & 7;
            if (gi & 1) v = fminf(v, 0.f) - log1pf(__expf(-fabsf(v)));
            gates[((size_t)(gi * NB + b) * NH_ML + hh) * TT + tp] = v;
        }
    }
}

constexpr int ML_LD = 72;
constexpr int ML_QL = 0, ML_KL = 9216, ML_KET = 18432, ML_VTL = 27648, ML_SDL = 36864, ML_C0L = 46080, ML_N0L = 55296, ML_DENL = 55552;
__device__ __forceinline__ float wave_prefix_sum(float v, int lane) {
#pragma unroll
    for (int o = 1; o < 64; o <<= 1) { const float t = __shfl_up(v, o); if (lane >= o) v += t; }
    return v;
}
__device__ __forceinline__ float wave_prefix_max(float v, int lane) {
#pragma unroll
    for (int o = 1; o < 64; o <<= 1) { const float t = __shfl_up(v, o); if (lane >= o) v = fmaxf(v, t); }
    return v;
}
__device__ __forceinline__ int ml_grow(int b, int tp) { return tp < NCTX ? b * NCTX + tp : ROWS_CTX + b * SEQ + (tp - NCTX); }
__device__ __forceinline__ void ml_task(Frame& F, int b, int hh, int dir, int vh) {
    const int tid = F.tid, lane = F.lane, w = F.wave, l15 = lane & 15, g = lane >> 4;
    LAS bf16_t* QL = (LAS bf16_t*)(F.lds + ML_QL); LAS bf16_t* KL = (LAS bf16_t*)(F.lds + ML_KL); LAS bf16_t* KET = (LAS bf16_t*)(F.lds + ML_KET);
    LAS bf16_t* VTL = (LAS bf16_t*)(F.lds + ML_VTL); LAS bf16_t* SDL = (LAS bf16_t*)(F.lds + ML_SDL); LAS bf16_t* C0L = (LAS bf16_t*)(F.lds + ML_C0L);
    LAS float* n0L = (LAS float*)(F.lds + ML_N0L); LAS float* denL = (LAS float*)(F.lds + ML_DENL);
    const bf16_t* proj = (const bf16_t*)(wsp(F) + WS_PROJ);
    const float* gI = (const float*)(wsp(F) + WS_GATES) + ((size_t)((dir * 2 + 0) * NB + b) * NH_ML + hh) * TT;
    const float* gF = (const float*)(wsp(F) + WS_GATES) + ((size_t)((dir * 2 + 1) * NB + b) * NH_ML + hh) * TT;
    bf16_t* hout = (bf16_t*)(wsp(F) + WS_HDIR) + (size_t)dir * ROWS * D + hh * DV_ML + vh * 64;
    const int r = tid >> 3, c8 = tid & 7, sr = dir ? 63 - r : r;
    const int bt = w >> 1, bc0 = 2 * (w & 1);
    for (int i = tid; i < 64 * ML_LD / 2; i += NTHREADS) ((LAS unsigned*)C0L)[i] = 0u;
    if (w == 0) n0L[lane] = 0.f;
    f32x4 Cst[2]; Cst[0] = (f32x4){0.f, 0.f, 0.f, 0.f}; Cst[1] = (f32x4){0.f, 0.f, 0.f, 0.f};
    float nst = 0.f, m0 = 0.f;
    u32x4 qv, kv, vv; float igv, lfv;
    {
        const int tb = dir ? 192 : 0;
        const bf16_t* pr = proj + (size_t)ml_grow(b, tb + r) * ML_INP;
        qv = *(const u32x4*)(pr + hh * 64 + c8 * 8); kv = *(const u32x4*)(pr + 512 + hh * 64 + c8 * 8); vv = *(const u32x4*)(pr + 1024 + hh * DV_ML + vh * 64 + c8 * 8);
        const int tpg = dir ? tb + 63 - lane : tb + lane;
        igv = gI[tpg]; lfv = gF[tpg];
    }
    __syncthreads();
    for (int c = 0; c < TT / 64; ++c) {
        const int tb = dir ? (c < 4 ? 192 - 64 * c : 4544 - 64 * c) : 64 * c;
        const float cum = wave_prefix_sum(lfv, lane);
        const float av = igv - cum;
        const float pmax = wave_prefix_max(av, lane);
        const float cl = __shfl(cum, 63);
        const float wend = cl - cum + igv;
        const float ml = wave_max(wend);
        const float eend = __expf(wend - ml);
        const float Mv = fmaxf(m0, pmax);
        const float winter = __expf(m0 - Mv);
        const float floorv = __expf(-(cum + Mv));
        const float mnew = fmaxf(cl + m0, ml);
        const float Ac = __expf(cl + m0 - mnew), Gc = __expf(ml - mnew);
        *(LAS u32x4*)(QL + sr * ML_LD + c8 * 8) = qv;
        *(LAS u32x4*)(KL + sr * ML_LD + c8 * 8) = kv;
        {
            const float es = __shfl(eend, sr);
            float kf[8]; unpack8(kv, kf);
            const unsigned vw[4] = {vv.x, vv.y, vv.z, vv.w};
#pragma unroll
            for (int e = 0; e < 8; ++e) { KET[(c8 * 8 + e) * ML_LD + sr] = (bf16_t)f2bf(kf[e] * es); VTL[(c8 * 8 + e) * ML_LD + sr] = (bf16_t)((vw[e >> 1] >> (16 * (e & 1))) & 0xffffu); }
        }
        if (c + 1 < TT / 64) {
            const int cn = c + 1, tbn = dir ? (cn < 4 ? 192 - 64 * cn : 4544 - 64 * cn) : 64 * cn;
            const bf16_t* pr = proj + (size_t)ml_grow(b, tbn + r) * ML_INP;
            qv = *(const u32x4*)(pr + hh * 64 + c8 * 8); kv = *(const u32x4*)(pr + 512 + hh * 64 + c8 * 8); vv = *(const u32x4*)(pr + 1024 + hh * DV_ML + vh * 64 + c8 * 8);
            const int tpg = dir ? tbn + 63 - lane : tbn + lane;
            igv = gI[tpg]; lfv = gF[tpg];
        }
        __syncthreads();
#pragma unroll
        for (int x = 0; x < 2; ++x) {
            const int bs = bc0 + x;
            f32x4 acc = (f32x4){0.f, 0.f, 0.f, 0.f};
            if (bs <= bt) {
#pragma unroll
                for (int ks = 0; ks < 2; ++ks) { const bf16x8 af = *(const LAS bf16x8*)(QL + (16 * bt + l15) * ML_LD + 32 * ks + 8 * g), bfv = *(const LAS bf16x8*)(KL + (16 * bs + l15) * ML_LD + 32 * ks + 8 * g);
                    acc = __builtin_amdgcn_mfma_f32_16x16x32_bf16(af, bfv, acc, 0, 0, 0); }
            }
            const int s = 16 * bs + l15;
            const float a_s = __shfl(av, s);
#pragma unroll
            for (int rg = 0; rg < 4; ++rg) { const int t = 16 * bt + 4 * g + rg; const float M_t = __shfl(Mv, t);
                const float val = (s <= t) ? acc[rg] * __expf(a_s - M_t) : 0.f;
                SDL[t * ML_LD + s] = (bf16_t)f2bf(val); }
        }
        __syncthreads();
        if (w == 0) {
            float rs = 0.f, qn = 0.f;
#pragma unroll
            for (int j = 0; j < 8; ++j) { float sd[8], qf[8]; unpack8(*(const LAS u32x4*)(SDL + lane * ML_LD + 8 * j), sd); unpack8(*(const LAS u32x4*)(QL + lane * ML_LD + 8 * j), qf);
                const f32x4 n0a = *(const LAS f32x4*)(n0L + 8 * j), n0b = *(const LAS f32x4*)(n0L + 8 * j + 4);
                rs += ((sd[0] + sd[1]) + (sd[2] + sd[3])) + ((sd[4] + sd[5]) + (sd[6] + sd[7]));
                qn += qf[0] * n0a[0] + qf[1] * n0a[1] + qf[2] * n0a[2] + qf[3] * n0a[3] + qf[4] * n0b[0] + qf[5] * n0b[1] + qf[6] * n0b[2] + qf[7] * n0b[3]; }
            denL[lane] = rs + winter * qn;
            float dn = 0.f;
#pragma unroll
            for (int j = 0; j < 8; ++j) { float kf[8]; unpack8(*(const LAS u32x4*)(KET + lane * ML_LD + 8 * j), kf); dn += ((kf[0] + kf[1]) + (kf[2] + kf[3])) + ((kf[4] + kf[5]) + (kf[6] + kf[7])); }
            nst = Ac * nst + Gc * dn;
            LDS_WAIT();
            n0L[lane] = nst;
        }
        f32x4 nin[2], nit[2];
#pragma unroll
        for (int x = 0; x < 2; ++x) {
            const int bv = bc0 + x;
            f32x4 a1 = (f32x4){0.f, 0.f, 0.f, 0.f}, a2 = (f32x4){0.f, 0.f, 0.f, 0.f}, a3 = (f32x4){0.f, 0.f, 0.f, 0.f};
#pragma unroll
            for (int ks = 0; ks < 2; ++ks) {
                const bf16x8 sdf = *(const LAS bf16x8*)(SDL + (16 * bt + l15) * ML_LD + 32 * ks + 8 * g), vtf = *(const LAS bf16x8*)(VTL + (16 * bv + l15) * ML_LD + 32 * ks + 8 * g);
                const bf16x8 qf = *(const LAS bf16x8*)(QL + (16 * bt + l15) * ML_LD + 32 * ks + 8 * g), c0f = *(const LAS bf16x8*)(C0L + (16 * bv + l15) * ML_LD + 32 * ks + 8 * g);
                const bf16x8 vt2 = *(const LAS bf16x8*)(VTL + (16 * bt + l15) * ML_LD + 32 * ks + 8 * g), kef = *(const LAS bf16x8*)(KET + (16 * bv + l15) * ML_LD + 32 * ks + 8 * g);
                a1 = __builtin_amdgcn_mfma_f32_16x16x32_bf16(sdf, vtf, a1, 0, 0, 0);
                a2 = __builtin_amdgcn_mfma_f32_16x16x32_bf16(qf, c0f, a2, 0, 0, 0);
                a3 = __builtin_amdgcn_mfma_f32_16x16x32_bf16(vt2, kef, a3, 0, 0, 0);
            }
            nin[x] = a1; nit[x] = a2;
            Cst[x] = Cst[x] * Ac + a3 * Gc;
        }
        __syncthreads();
#pragma unroll
        for (int x = 0; x < 2; ++x) {
            const int bv = bc0 + x;
#pragma unroll
            for (int rg = 0; rg < 4; ++rg) { const int t = 16 * bt + 4 * g + rg;
                const float den = denL[t], w_t = __shfl(winter, t), fl_t = __shfl(floorv, t);
                const float hv = (nin[x][rg] + w_t * nit[x][rg]) / fmaxf(fabsf(den), fl_t);
                const int rr = dir ? 63 - t : t;
                hout[(size_t)ml_grow(b, tb + rr) * D + 16 * bv + l15] = (bf16_t)f2bf(hv);
                C0L[(16 * bt + 4 * g + rg) * ML_LD + 16 * bv + l15] = (bf16_t)f2bf(Cst[x][rg]); }
        }
        m0 = mnew;
    }
    __syncthreads();
}
__device__ __forceinline__ void phase_ml_scan(Frame& F) {
    for (int task = F.vcu; task < NB * NH_ML * 4; task += F.G) {
        const int vh = task & 1, dir = (task >> 1) & 1, bh = task >> 2;
        ml_task(F, bh >> 3, bh & 7, dir, vh);
    }
}

__device__ __forceinline__ void phase_ml_final(Frame& F, int jm) {
    const int gw = F.vcu * NWAVES + F.wave, NGW = F.G * NWAVES, lane = F.lane;
    const bf16_t* hfw = (const bf16_t*)(wsp(F) + WS_HDIR); const bf16_t* hbw = hfw + (size_t)ROWS * D;
    const bf16_t* proj = (const bf16_t*)(wsp(F) + WS_PROJ);
    bf16_t* ao = (bf16_t*)(wsp(F) + WS_AO);
    const float* gain = inp(F, I_MHGAIN) + jm * D + lane * 16;
    for (int row = gw; row < ROWS; row += NGW) {
        const size_t off = (size_t)row * D + lane * 16;
        float a0[8], a1[8], b0[8], b1[8], g0[8], g1[8];
        unpack8(*(const u32x4*)(hfw + off), a0); unpack8(*(const u32x4*)(hfw + off + 8), a1);
        unpack8(*(const u32x4*)(hbw + off), b0); unpack8(*(const u32x4*)(hbw + off + 8), b1);
        const bf16_t* ogp = proj + (size_t)row * ML_INP + 2048 + lane * 16;
        unpack8(*(const u32x4*)ogp, g0); unpack8(*(const u32x4*)(ogp + 8), g1);
        float ss = 0.f;
#pragma unroll
        for (int e = 0; e < 8; ++e) { a0[e] += b0[e]; a1[e] += b1[e]; ss += a0[e] * a0[e] + a1[e] * a1[e]; }
        ss += __shfl_xor(ss, 1); ss += __shfl_xor(ss, 2); ss += __shfl_xor(ss, 4);
        const float rs = 1.0f / sqrtf(ss * (1.f / DV_ML) + EPS);
        float o0[8], o1[8];
#pragma unroll
        for (int e = 0; e < 8; ++e) { o0[e] = a0[e] * rs * gain[e] * sigmoidf_(g0[e]); o1[e] = a1[e] * rs * gain[8 + e] * sigmoidf_(g1[e]); }
        *(u32x4*)(ao + off) = pack8(o0); *(u32x4*)(ao + off + 8) = pack8(o1);
    }
}

constexpr int RT_LD = 36;
__device__ __forceinline__ void phase_norm2_router(Frame& F, int l, int first_row) {
    const int tid = F.tid, lane = F.lane;
    LAS float* wr = (LAS float*)F.lds;
    volatile LAS int* cntL = F.LCTL + 64;
    const float* wg = inp(F, I_WR) + (size_t)l * D * NE;
    for (int idx = tid; idx < D * NE; idx += NTHREADS) { const int k = idx >> 5, e = idx & 31; const int ln = (k & 255) >> 2, j = k >> 8, i = k & 3;
        wr[((4 * j + i) * 64 + ln) * RT_LD + e] = wg[idx]; }
    if (tid < NE) cntL[tid] = 0;
    __syncthreads();
    const float* xs = (const float*)(wsp(F) + WS_XS); bf16_t* hb = (bf16_t*)(wsp(F) + WS_HB);
    int* tope = (int*)(wsp(F) + WS_TOPE); float* topw = (float*)(wsp(F) + WS_TOPW);
    const f32x4* gm = (const f32x4*)(inp(F, I_GFFN) + l * D) + lane;
    const float brl = inp(F, I_BR)[l * NE + (lane >> 1)];
    for (int row = first_row + F.vcu * NWAVES + F.wave; row < ROWS; row += F.G * NWAVES) {
        const int mb = row_mb(row);
        const f32x4* xr = (const f32x4*)(xs + (size_t)row * D) + lane;
        f32x4 v[4]; float ss = 0.f;
#pragma unroll
        for (int j = 0; j < 4; ++j) { v[j] = xr[64 * j]; ss += (v[j][0] * v[j][0] + v[j][1] * v[j][1]) + (v[j][2] * v[j][2] + v[j][3] * v[j][3]); }
        const float rs = 1.0f / sqrtf(wave_sum(ss) * (1.f / D) + EPS);
        const f32x4* sh = (const f32x4*)modp(F, l, mb, 3) + lane; const f32x4* sc = (const f32x4*)modp(F, l, mb, 4) + lane;
        u32x2* o8 = (u32x2*)(hb + (size_t)row * D) + lane;
        float a[32];
#pragma unroll
        for (int e = 0; e < 32; ++e) a[e] = 0.f;
#pragma unroll
        for (int j = 0; j < 4; ++j) { const f32x4 h = (v[j] * rs) * gm[64 * j] * (sc[64 * j] + 1.0f) + sh[64 * j];
            u32x2 wv; wv.x = pk2(h[0], h[1]); wv.y = pk2(h[2], h[3]); o8[64 * j] = wv;
#pragma unroll
            for (int i = 0; i < 4; ++i) { const LAS f32x4* wrow = (const LAS f32x4*)(wr + ((4 * j + i) * 64 + lane) * RT_LD);
#pragma unroll
                for (int q = 0; q < 8; ++q) { const f32x4 ww = wrow[q]; a[4 * q] += h[i] * ww[0]; a[4 * q + 1] += h[i] * ww[1]; a[4 * q + 2] += h[i] * ww[2]; a[4 * q + 3] += h[i] * ww[3]; } } }
#pragma unroll
        for (int e = 0; e < 16; ++e) { const float send = (lane & 32) ? a[e] : a[e + 16], keep = (lane & 32) ? a[e + 16] : a[e]; a[e] = keep + __shfl_xor(send, 32); }
#pragma unroll
        for (int e = 0; e < 8; ++e) { const float send = (lane & 16) ? a[e] : a[e + 8], keep = (lane & 16) ? a[e + 8] : a[e]; a[e] = keep + __shfl_xor(send, 16); }
#pragma unroll
        for (int e = 0; e < 4; ++e) { const float send = (lane & 8) ? a[e] : a[e + 4], keep = (lane & 8) ? a[e + 4] : a[e]; a[e] = keep + __shfl_xor(send, 8); }
#pragma unroll
        for (int e = 0; e < 2; ++e) { const float send = (lane & 4) ? a[e] : a[e + 2], keep = (lane & 4) ? a[e + 2] : a[e]; a[e] = keep + __shfl_xor(send, 4); }
        { const float send = (lane & 2) ? a[0] : a[1], keep = (lane & 2) ? a[1] : a[0]; a[0] = keep + __shfl_xor(send, 2); }
        const float logit = a[0] + __shfl_xor(a[0], 1) + brl;
        const int myidx = lane >> 1;
        int sel[4]; float sv[4]; unsigned used = 0u;
#pragma unroll
        for (int k = 0; k < 4; ++k) { float bv = ((used >> myidx) & 1u) ? -3.0e38f : logit; int bi = myidx;
#pragma unroll
            for (int o = 2; o < 64; o <<= 1) { const float ov = __shfl_xor(bv, o); const int oi = __shfl_xor(bi, o); const bool take = (ov > bv) || (ov == bv && oi < bi); bv = take ? ov : bv; bi = take ? oi : bi; }
            used |= 1u << bi; sel[k] = bi; sv[k] = bv; }
        const float e1 = __expf(sv[1] - sv[0]), e2 = __expf(sv[2] - sv[0]), e3 = __expf(sv[3] - sv[0]);
        const float inv = 1.0f / (1.0f + e1 + e2 + e3);
        if (lane == 0) {
            *(int4*)(tope + (size_t)row * 4) = make_int4(sel[0], sel[1], sel[2], sel[3]);
            *(float4*)(topw + (size_t)row * 4) = make_float4(inv, e1 * inv, e2 * inv, e3 * inv);
#pragma unroll
            for (int k = 0; k < 4; ++k) __hip_atomic_fetch_add((LAS int*)&cntL[sel[k]], 1, __ATOMIC_RELAXED, __HIP_MEMORY_SCOPE_WORKGROUP);
        }
    }
    __syncthreads();
    if (tid < NE) ((int*)(wsp(F) + WS_CNT))[F.vcu * NE + tid] = cntL[tid];
}

__device__ __forceinline__ void phase_positions(Frame& F, int first_row) {
    const int tid = F.tid, lane = F.lane;
    LAS int* tot = (LAS int*)F.lds;
    LAS int* bef = tot + 512;
    LAS int* baseL = bef + 512;
    LAS int* totL = baseL + 32;
    const int* cnt = (const int*)(wsp(F) + WS_CNT);
    {
        const int e = tid & 31, part = tid >> 5;
        int s = 0, sb = 0;
        for (int j = part; j < F.G; j += 16) { const int cv = cnt[j * NE + e]; s += cv; sb += (j < F.vcu) ? cv : 0; }
        tot[part * 32 + e] = s; bef[part * 32 + e] = sb;
    }
    __syncthreads();
    if (tid < NE) { int s = 0, sb = 0;
        for (int p = 0; p < 16; ++p) { s += tot[p * 32 + tid]; sb += bef[p * 32 + tid]; }
        totL[tid] = s; baseL[tid] = sb; }
    __syncthreads();
    if (tid == 0) { int acc = 0;
        for (int e = 0; e < NE; ++e) { F.LCTL[8 + e] = acc; acc += (totL[e] + 255) >> 8; }
        F.LCTL[8 + NE] = acc; F.LCTL[48] = acc; }
    __syncthreads();
    int* tokmap = (int*)(wsp(F) + WS_TOKMAP);
    if (F.vcu == 0) {
        int* meta = (int*)(wsp(F) + WS_META);
        if (tid <= NE) meta[tid] = F.LCTL[8 + tid];
        if (tid == 0) meta[33] = F.LCTL[48];
        for (int e = 0; e < NE; ++e) { const int rb = 256 * F.LCTL[8 + e], n = totL[e], cap = 256 * (F.LCTL[8 + e + 1] - F.LCTL[8 + e]);
            for (int rr = n + tid; rr < cap; rr += NTHREADS) tokmap[rb + rr] = first_row; }
    }
    if (F.wave == 0) {
        const int* tope = (const int*)(wsp(F) + WS_TOPE); int* pos = (int*)(wsp(F) + WS_POS);
        int basereg = (lane < NE) ? 256 * F.LCTL[8 + lane] + baseL[lane] : 0;
        const int nwv = F.G * NWAVES;
        const int maxn = (ROWS - first_row + nwv - 1) / nwv;
        for (int ch = 0; ch * 2 < maxn; ++ch) {
            const int ord = ch * 16 + (lane >> 2), k = lane & 3, n = ord >> 3, ww = ord & 7;
            const int row = first_row + F.vcu * NWAVES + ww + n * nwv;
            const bool valid = row < ROWS;
            const int e = valid ? tope[(size_t)row * 4 + k] : -1;
            int p = 0;
#pragma unroll 1
            for (int ee = 0; ee < NE; ++ee) {
                const unsigned long long mask = __ballot(e == ee);
                const int b0 = __shfl(basereg, ee);
                if (e == ee) p = b0 + __popcll(mask & ((1ull << lane) - 1ull));
                if (lane == ee) basereg += __popcll(mask);
            }
            if (valid) { pos[(size_t)row * 4 + k] = p; tokmap[p] = row; }
        }
    }
}

#ifndef PMASK
#define PMASK 0xFFFF
#endif
#define PE(k) (((PMASK) >> (k)) & 1)
constexpr int NPH_LAYER = 10, GP_FINAL = 1 + DEPTH * NPH_LAYER, NPHASES = GP_FINAL + 1;
__global__ void __launch_bounds__(NTHREADS, 2) mega_fwd(Args args) {
    extern __shared__ __attribute__((aligned(16))) unsigned char lds_raw[];
    Frame F0;
    Frame& F = F0;
    F.lds = (LAS unsigned char*)lds_raw;
    F.LCTL = (volatile LAS int*)(F.lds + LDS_CTL_OFF);
    F.tid = threadIdx.x; F.lane = F.tid & 63; F.wave = __builtin_amdgcn_readfirstlane(F.tid >> 6);
    F.G = gridDim.x; { const int bx = blockIdx.x; F.vcu = (F.G % 8 == 0) ? (bx % 8) * (F.G / 8) + bx / 8 : bx; }
    if (F.tid < 128) F.LCTL[F.tid] = 0;
    if (F.tid == 0) {
#pragma unroll
        for (int i = 0; i < 23; ++i) { const unsigned long long p = (unsigned long long)args.in[i]; F.LCTL[128 + 2 * i] = (int)(unsigned)p; F.LCTL[129 + 2 * i] = (int)(unsigned)(p >> 32); }
        { const unsigned long long p = (unsigned long long)args.ws; F.LCTL[128 + 46] = (int)(unsigned)p; F.LCTL[129 + 46] = (int)(unsigned)(p >> 32); }
        { const unsigned long long p = (unsigned long long)args.out; F.LCTL[128 + 48] = (int)(unsigned)p; F.LCTL[129 + 48] = (int)(unsigned)(p >> 32); }
    }
    __syncthreads();
    const int lo = args.ph_lo, hi = args.ph_hi;
    XcdBarrier bar; bar.bar = (unsigned*)(wsp(F) + WS_CTL) + CW_BAR; bar.x = 0; bar.st = nullptr;
    if (hi - lo > 1) bar = xcd_barrier_post((unsigned*)(wsp(F) + WS_CTL) + CW_BAR, (volatile LAS unsigned*)F.LCTL);
#define IN(k) (lo <= (k) && (k) < hi)
#define FRESH(FN) Frame FN = F0; { int tz_ = F0.tid, vc_ = F0.vcu, g_ = F0.G; asm volatile("" : "+v"(tz_)); asm volatile("" : "+s"(vc_), "+s"(g_)); FN.tid = tz_; FN.lane = tz_ & 63; FN.wave = __builtin_amdgcn_readfirstlane(tz_ >> 6); FN.vcu = vc_; FN.G = g_; }
#define SEAM(k) do { if (IN(k) && IN((k) + 1)) xcd_barrier(bar); } while (0)

    if (PE(0) && IN(0)) { FRESH(P); phase0(P); }
    SEAM(0);
    for (int l = 0; l < DEPTH; ++l) {
        const int base = 1 + l * NPH_LAYER; const bool na = (l & 1) == 0, last = (l == DEPTH - 1); const int jj = l >> 1;
        if (PE(1) && IN(base + 0)) { FRESH(P); phase_norm1(P, l); }
        SEAM(base + 0);
        if (PE(2) && IN(base + 1)) {
            FRESH(P);
            const int Np = na ? 3072 : ML_INP;
            const bf16_t* Bt = na ? (const bf16_t*)(wsp(P) + WS_WQKV) + (size_t)jj * 3072 * D : (const bf16_t*)(wsp(P) + WS_WIN) + (size_t)jj * ML_INP * D;
            DenseOrder S; S.init(0, ROWS / 256, Np / 256, P.G, (int)blockIdx.x, wsp(P) + WS_HB, Bt, D);
            EpiStoreBf16 E{(bf16_t*)(wsp(P) + WS_PROJ), Np};
            pg8::gemm_phase<EpiStoreBf16, DenseOrder, false>(P.lds, P.tid, D, S, E);
        }
        SEAM(base + 1);
        if (IN(base + 2)) { if (na) { if (PE(3)) { FRESH(P); phase_na_post(P, jj); } } else { if (PE(4)) { FRESH(P); phase_ml_post(P, jj); } } }
        SEAM(base + 2);
        if (IN(base + 3)) { if (na) { if (PE(5)) { FRESH(P); phase_na_attn(P, jj); } } else { if (PE(6)) { FRESH(P); phase_ml_scan(P); } } }
        SEAM(base + 3);
        if (PE(7) && IN(base + 4)) { if (!na) { FRESH(P); phase_ml_final(P, jj); } }
        if (!na) SEAM(base + 4);
        if (PE(8) && IN(base + 5)) {
            FRESH(P);
            const bf16_t* Bt = na ? (const bf16_t*)(wsp(P) + WS_WONA) + (size_t)jj * D * D : (const bf16_t*)(wsp(P) + WS_WOML) + (size_t)jj * D * D;
            DenseOrder S; S.init(last ? ROWS_CTX / 256 : 0, last ? (ROWS - ROWS_CTX) / 256 : ROWS / 256, D / 256, P.G, (int)blockIdx.x, wsp(P) + WS_AO, Bt, D);
            EpiResid E{(float*)(wsp(P) + WS_XS), (const float*)(wsp(P) + WS_MOD) + (size_t)l * 9 * 6144 + 2 * D};
            pg8::gemm_phase<EpiResid, DenseOrder, false>(P.lds, P.tid, D, S, E);
        }
        SEAM(base + 5);
        if (PE(9) && IN(base + 6)) { FRESH(P); phase_norm2_router(P, l, last ? ROWS_CTX : 0); }
        SEAM(base + 6);
        if (PE(10) && IN(base + 7)) { FRESH(P); phase_positions(P, last ? ROWS_CTX : 0); }
        SEAM(base + 7);
        if (PE(11) && IN(base + 8)) {
            FRESH(P);
            if (P.tid < 34) P.LCTL[8 + P.tid] = ((const int*)(wsp(P) + WS_META))[P.tid];
            __syncthreads();
            const int ntiles = P.LCTL[8 + NE];
            MoeOrder S; S.NT = 8; S.nunits = ntiles * 8; S.G = P.G; S.c = (int)blockIdx.x; S.K = D; S.A = (const char*)(wsp(P) + WS_HB);
            S.W = (const char*)(wsp(P) + WS_W1T) + (size_t)l * NE * 2048 * D * 2; S.estride = (size_t)2048 * D * 2; S.tokmap = (const int*)(wsp(P) + WS_TOKMAP); S.prefix = P.LCTL + 8; S.gather = true;
            EpiSwiglu E{(bf16_t*)(wsp(P) + WS_ACT), inp(P, I_B1) + (size_t)l * NE * 2048};
            pg8::gemm_phase<EpiSwiglu, MoeOrder, true>(P.lds, P.tid, D, S, E);
        }
        SEAM(base + 8);
        if (PE(12) && IN(base + 9)) {
            FRESH(P);
            if (P.tid < 34) P.LCTL[8 + P.tid] = ((const int*)(wsp(P) + WS_META))[P.tid];
            __syncthreads();
            const int ntiles = P.LCTL[8 + NE];
            MoeOrder S; S.NT = 4; S.nunits = ntiles * 4; S.G = P.G; S.c = (int)blockIdx.x; S.K = D; S.A = (const char*)(wsp(P) + WS_ACT);
            S.W = (const char*)(wsp(P) + WS_W2T) + (size_t)l * NE * D * D * 2; S.estride = (size_t)D * D * 2; S.tokmap = (const int*)(wsp(P) + WS_TOKMAP); S.prefix = P.LCTL + 8; S.gather = false;
            EpiY E{(bf16_t*)(wsp(P) + WS_Y), inp(P, I_B2) + (size_t)l * NE * D};
            pg8::gemm_phase<EpiY, MoeOrder, false>(P.lds, P.tid, D, S, E);
        }
        SEAM(base + 9);
    }
    if (PE(13) && IN(GP_FINAL)) { FRESH(P); phase_final(P); }
#undef IN
#undef SEAM
}

extern "C" void kernel_launch(void* const* d_in, const int* in_sizes, int n_in, void* d_out, int out_size, void* d_ws, size_t ws_size, hipStream_t stream) {
    static int grid = 0;
    if (grid == 0) {
        if (n_in != 23 || ws_size < WS_END) { fprintf(stderr, "kernel_launch: expected 23 inputs and >= %zu bytes of workspace (got %d, %zu)\n", (size_t)WS_END, n_in, ws_size); grid = -1; return; }
        int dev = 0, cus = 0, per_cu = 0;
        if (hipGetDevice(&dev) != hipSuccess || hipDeviceGetAttribute(&cus, hipDeviceAttributeMultiprocessorCount, dev) != hipSuccess) { grid = -1; return; }
        if (hipFuncSetAttribute((const void*)mega_fwd, hipFuncAttributeMaxDynamicSharedMemorySize, LDS_BYTES) != hipSuccess) { fprintf(stderr, "kernel_launch: hipFuncSetAttribute failed\n"); grid = -1; return; }
        if (hipOccupancyMaxActiveBlocksPerMultiprocessor(&per_cu, (const void*)mega_fwd, NTHREADS, LDS_BYTES) != hipSuccess || per_cu < 1)
            fprintf(stderr, "kernel_launch: occupancy query reports %d workgroups per CU\n", per_cu);
        (void)hipGetLastError();
        grid = cus;
        if (grid > 1024) grid = 1024;
    }
    if (grid < 0) return;
    (void)hipMemsetAsync((char*)d_ws + WS_CTL, 0, CTL_BYTES, stream);
    Args a{};
    for (int i = 0; i < 23; ++i) a.in[i] = (const float*)d_in[i];
    a.out = (float*)d_out; a.ws = (unsigned char*)d_ws;
#if MK_ONE_LAUNCH
    a.ph_lo = 0; a.ph_hi = NPHASES;
    hipLaunchKernelGGL(mega_fwd, dim3(grid), dim3(NTHREADS), LDS_BYTES, stream, a);
#else
    for (int gp = 0; gp < NPHASES; ++gp) {
        if (gp >= 1 && gp < GP_FINAL) { const int l = (gp - 1) / NPH_LAYER, p = (gp - 1) % NPH_LAYER; if (p == 4 && (l & 1) == 0) continue; }
        a.ph_lo = gp; a.ph_hi = gp + 1;
        hipLaunchKernelGGL(mega_fwd, dim3(grid), dim3(NTHREADS), LDS_BYTES, stream, a);
    }
#endif
    const hipError_t le = hipPeekAtLastError();
    if (le != hipSuccess) fprintf(stderr, "kernel_launch: launch failed: %s\n", hipGetErrorName(le));
}
```

```cpp
#include <hip/hip_runtime.h>
#include <cstdio>
#include <cstdint>

#ifndef MK_ONE_LAUNCH
#define MK_ONE_LAUNCH 1
#endif

#define LAS __attribute__((address_space(3)))
#define GAS __attribute__((address_space(1)))
typedef unsigned short bf16_t;
typedef short bf16x8 __attribute__((ext_vector_type(8)));
typedef short bf16x4 __attribute__((ext_vector_type(4)));
typedef float f32x4 __attribute__((ext_vector_type(4)));
typedef float f32x2 __attribute__((ext_vector_type(2)));
typedef unsigned u32x4 __attribute__((ext_vector_type(4)));
typedef unsigned u32x2 __attribute__((ext_vector_type(2)));

constexpr int D = 1024, NB = 8, SEQ = 4096, NCTX = 256, TT = NCTX + SEQ  , DEPTH = 4;
constexpr int ROWS_CTX = NB * NCTX  , ROWS = ROWS_CTX + NB * SEQ  ;
constexpr int NH_NA = 16, DH_NA = 64;
constexpr int NH_ML = 8, DV_ML = 128, DK_ML = 64, ML_IN = 3104, ML_INP = 3328;
constexpr int NE = 32, TOPK = 4, DFF = 1024;
constexpr int MAXTILES = (ROWS * TOPK) / 256 + NE  , MAXROWS = MAXTILES * 256;
constexpr float EPS = 1e-6f;
constexpr int NWAVES = 8, NTHREADS = 512;

constexpr size_t MiB = 1u << 20;
constexpr size_t al256(size_t x) { return (x + 255) & ~(size_t)255; }
constexpr size_t WS_CTL = 0, CTL_BYTES = 1 * MiB;
constexpr size_t WS_MOD = WS_CTL + CTL_BYTES;
constexpr size_t WS_ROPE = WS_MOD + al256((size_t)DEPTH * 9 * 6 * D * 4);
constexpr size_t WS_WQKV = WS_ROPE + al256(64 * 16 * 2 * 4);
constexpr size_t WS_WONA = WS_WQKV + (size_t)2 * 3072 * D * 2;
constexpr size_t WS_WIN = WS_WONA + (size_t)2 * D * D * 2;
constexpr size_t WS_WOML = WS_WIN + (size_t)2 * ML_INP * D * 2;
constexpr size_t WS_W1T = WS_WOML + (size_t)2 * D * D * 2;
constexpr size_t WS_W2T = WS_W1T + (size_t)DEPTH * NE * 2048 * D * 2;
constexpr size_t WS_XS = WS_W2T + (size_t)DEPTH * NE * D * D * 2;
constexpr size_t WS_HB = WS_XS + (size_t)ROWS * D * 4;
constexpr size_t WS_PROJ = WS_HB + (size_t)ROWS * D * 2;
constexpr size_t WS_QN = WS_PROJ + (size_t)ROWS * ML_INP * 2;
constexpr size_t WS_KN = WS_QN + (size_t)ROWS * D * 2;
constexpr size_t WS_VT = WS_KN + (size_t)ROWS * D * 2;
constexpr size_t WS_AO = WS_VT + (size_t)ROWS * D * 2;
constexpr size_t WS_HDIR = WS_QN;
constexpr size_t WS_GATES = WS_AO + (size_t)ROWS * D * 2;
constexpr size_t WS_TOPE = WS_GATES + al256((size_t)4 * NB * NH_ML * TT * 4);
constexpr size_t WS_TOPW = WS_TOPE + (size_t)ROWS * 4 * 4;
constexpr size_t WS_POS = WS_TOPW + (size_t)ROWS * 4 * 4;
constexpr size_t WS_TOKMAP = WS_POS + (size_t)ROWS * 4 * 4;
constexpr size_t WS_CNT = WS_TOKMAP + (size_t)MAXROWS * 4;
constexpr size_t WS_META = WS_CNT + (size_t)1024 * 32 * 4;
constexpr size_t WS_ACT = WS_META + 256;
constexpr size_t WS_Y = WS_ACT + (size_t)MAXROWS * D * 2;
constexpr size_t WS_END = WS_Y + (size_t)MAXROWS * D * 2;
static_assert(WS_XS % 256 == 0 && WS_ACT % 256 == 0 && WS_TOPE % 256 == 0, "ws alignment");

constexpr int CW_BAR = 4096;

constexpr int LDS_BYTES = 160 * 1024;
constexpr int LDS_CTL_OFF = LDS_BYTES - 1024;
constexpr int LDS_WORK = LDS_CTL_OFF;

#define LDS_WAIT() asm volatile("s_waitcnt lgkmcnt(0)" ::: "memory")
#define VM_WAIT() asm volatile("s_waitcnt vmcnt(0)" ::: "memory")
__device__ __forceinline__ unsigned f2bf(float f) { unsigned u = __builtin_bit_cast(unsigned, f); return (u + 0x7fffu + ((u >> 16) & 1u)) >> 16; }
__device__ __forceinline__ unsigned pk2(float lo, float hi) { return f2bf(lo) | (f2bf(hi) << 16); }
__device__ __forceinline__ float bf2f(unsigned short b) { return __builtin_bit_cast(float, ((unsigned)b) << 16); }
__device__ __forceinline__ float bflo(unsigned w) { return __builtin_bit_cast(float, w << 16); }
__device__ __forceinline__ float bfhi(unsigned w) { return __builtin_bit_cast(float, w & 0xffff0000u); }
__device__ __forceinline__ float wave_sum(float v) {
#pragma unroll
    for (int o = 1; o < 64; o <<= 1) v += __shfl_xor(v, o);
    return v;
}
__device__ __forceinline__ float wave_max(float v) {
#pragma unroll
    for (int o = 1; o < 64; o <<= 1) v = fmaxf(v, __shfl_xor(v, o));
    return v;
}
__device__ __forceinline__ float sigmoidf_(float x) { return 1.f / (1.f + __expf(-x)); }

namespace pg8 {
constexpr int BM = 256, BK = 64, HALF = 128, HTB = HALF * BK * 2  , STAGE_BYTES = 8 * HTB;
__host__ __device__ __forceinline__ int lds_byte(int r, int c) { const int st = (r >> 4) * 2 + (c >> 5), rr = r & 15, cc = c & 31, ob = rr * 64 + cc * 2; return st * 1024 + (ob ^ (((ob >> 9) & 1) << 5)); }
__host__ __device__ __forceinline__ void stage_rc(int b, int& R, int& C) { const int st = b / 1024, sb = b % 1024, swz = sb ^ (((sb >> 9) & 1) << 5); R = (st >> 1) * 16 + swz / 64; C = (st & 1) * 32 + (swz % 64) / 2; }
__host__ __device__ __forceinline__ int perm32(int rho) { const int n = rho >> 4, i = rho & 15; return 8 * (i >> 2) + 4 * n + (i & 3); }

struct Unit { int pm, pn, e; };

__device__ __forceinline__ unsigned cvt_pk_bf16(float lo, float hi) { unsigned r; asm volatile("v_cvt_pk_bf16_f32 %0, %1, %2" : "=v"(r) : "v"(lo), "v"(hi)); return r; }

template <class Epi, class Sched, bool GATHER>
__device__ __forceinline__ void gemm_phase(LAS unsigned char* lds, const int tid, const int K, const Sched& S, const Epi& E) {
    const int wid = __builtin_amdgcn_readfirstlane(tid >> 6), lane = tid & 63, wr = wid >> 2, wc = wid & 3, fr = lane & 15, fq = lane >> 4;
    const int nt = K / BK;
    int RA[2], CA[2];
    unsigned voffB[2], voffA[2][2];
#pragma unroll
    for (int i = 0; i < 2; ++i) { int R, C; stage_rc(tid * 16 + i * 8192, R, C); const int Rb = Epi::PERM ? ((R & ~31) + perm32(R & 31)) : R;
        RA[i] = R; CA[i] = C; voffB[i] = (unsigned)(Rb * K + C) * 2u; }
    const size_t kstep = (size_t)(BK * 2);
    const size_t hstep = (size_t)HALF * K * 2;
    const unsigned ldsw = (unsigned)wid * 1024u;
    const int aoff = lds_byte(wr * 64 + fr, fq * 8), boff = lds_byte(wc * 32 + fr, fq * 8);
#define PG8_SA(b, h) (((b) * 2 + (h)) * HTB)
#define PG8_SB(b, h) ((4 + (b) * 2 + (h)) * HTB)
#define PG8_STAGE(bufoff, gbase, voff) do { _Pragma("unroll") for (int _i = 0; _i < 2; ++_i) \
        __builtin_amdgcn_global_load_lds((const unsigned*)((const char*)(gbase) + (voff)[_i]), (LAS unsigned*)(lds + (bufoff) + ldsw + _i * 8192), 16, 0, 0); } while (0)
#define PG8_LDA(dst, b, h) do { _Pragma("unroll") for (int m = 0; m < 4; ++m) _Pragma("unroll") for (int k = 0; k < 2; ++k) dst[m][k] = *(const LAS bf16x8*)(lds + PG8_SA(b, h) + aoff + m * 2048 + k * 1024); } while (0)
#define PG8_LDB(dst, b, h) do { _Pragma("unroll") for (int n = 0; n < 2; ++n) _Pragma("unroll") for (int k = 0; k < 2; ++k) dst[n][k] = *(const LAS bf16x8*)(lds + PG8_SB(b, h) + boff + n * 2048 + k * 1024); } while (0)
#define PG8_MMA(ai, bj, At, Bt) do { __builtin_amdgcn_s_setprio(1); _Pragma("unroll") for (int m = 0; m < 4; ++m) _Pragma("unroll") for (int n = 0; n < 2; ++n) _Pragma("unroll") for (int k = 0; k < 2; ++k) \
        acc[ai][bj][m][n] = __builtin_amdgcn_mfma_f32_16x16x32_bf16(Bt[n][k], At[m][k], acc[ai][bj][m][n], 0, 0, 0); __builtin_amdgcn_s_setprio(0); } while (0)
#define PG8_WAIT_V(n) asm volatile("s_waitcnt vmcnt(" #n ")" ::: "memory")
#define PG8_WAIT_L(n) asm volatile("s_waitcnt lgkmcnt(" #n ")" ::: "memory")
#define PG8_BAR __builtin_amdgcn_s_barrier()
#define PG8_SCHED __builtin_amdgcn_sched_barrier(0)
#define PG8_SETVOFF(u) do { _Pragma("unroll") for (int _h = 0; _h < 2; ++_h) _Pragma("unroll") for (int _i = 0; _i < 2; ++_i) { \
        if constexpr (GATHER) voffA[_h][_i] = ((unsigned)S.a_row(u, _h * HALF + RA[_i]) * (unsigned)K + (unsigned)CA[_i]) * 2u; \
        else voffA[_h][_i] = ((unsigned)(_h * HALF + RA[_i]) * (unsigned)K + (unsigned)CA[_i]) * 2u; } } while (0)
    Unit cur, nxt; int ui = 0;
    if (!S.next(0, cur)) return;
    f32x4 acc[2][2][4][2];
#pragma unroll
    for (int a = 0; a < 2; ++a)
#pragma unroll
        for (int b = 0; b < 2; ++b)
#pragma unroll
            for (int m = 0; m < 4; ++m)
#pragma unroll
                for (int n = 0; n < 2; ++n) acc[a][b][m][n] = (f32x4){0.f, 0.f, 0.f, 0.f};
    bf16x8 At[4][2], B0[2][2], B1[2][2];
    const char* cA = S.a_base(cur); const char* cB = S.b_base(cur);
    PG8_SETVOFF(cur);
    PG8_STAGE(PG8_SB(0, 0), cB, voffB); PG8_STAGE(PG8_SB(0, 1), cB + hstep, voffB); PG8_STAGE(PG8_SA(0, 0), cA, voffA[0]); PG8_STAGE(PG8_SA(0, 1), cA, voffA[1]);
    if (wr == 1) PG8_BAR;
    PG8_WAIT_V(2); PG8_BAR;
    PG8_STAGE(PG8_SB(1, 0), cB + kstep, voffB); PG8_STAGE(PG8_SA(1, 0), cA + kstep, voffA[0]); PG8_STAGE(PG8_SB(1, 1), cB + hstep + kstep, voffB);
    PG8_WAIT_V(6); PG8_BAR;
    for (;;) {
        const bool has_next = S.next(ui + 1, nxt);
        const char* nA = has_next ? S.a_base(nxt) : cA; const char* nB = has_next ? S.b_base(nxt) : cB;
        for (int t = 0; t < nt; t += 2) {
            const bool last = (t == nt - 2);
            const char* a1 = cA + (size_t)(t + 1) * kstep;
            const char* a2 = last ? nA : cA + (size_t)(t + 2) * kstep; const char* b2 = last ? nB : cB + (size_t)(t + 2) * kstep;
            const char* a3 = a2 + kstep; const char* b3 = b2 + kstep;
            PG8_LDB(B0, 0, 0); PG8_LDB(B1, 0, 1); PG8_SCHED; PG8_LDA(At, 0, 0); PG8_STAGE(PG8_SA(1, 1), a1, voffA[1]);
            if constexpr (GATHER) { if (last && has_next) PG8_SETVOFF(nxt); }
            PG8_WAIT_V(8); PG8_WAIT_L(0); PG8_BAR; PG8_MMA(0, 0, At, B0); PG8_MMA(0, 1, At, B1); PG8_BAR; PG8_SCHED;
            PG8_LDA(At, 0, 1); PG8_STAGE(PG8_SB(0, 0), b2, voffB); PG8_STAGE(PG8_SB(0, 1), b2 + hstep, voffB); PG8_STAGE(PG8_SA(0, 0), a2, voffA[0]);
            PG8_WAIT_V(8); PG8_WAIT_L(0); PG8_BAR; PG8_MMA(1, 0, At, B0); PG8_MMA(1, 1, At, B1); PG8_BAR; PG8_SCHED;
            PG8_LDB(B0, 1, 0); PG8_LDB(B1, 1, 1); PG8_SCHED; PG8_LDA(At, 1, 0); PG8_STAGE(PG8_SA(0, 1), a2, voffA[1]);
            PG8_WAIT_V(8); PG8_WAIT_L(0); PG8_BAR; PG8_MMA(0, 0, At, B0); PG8_MMA(0, 1, At, B1); PG8_BAR; PG8_SCHED;
            PG8_LDA(At, 1, 1); PG8_STAGE(PG8_SB(1, 0), b3, voffB); PG8_STAGE(PG8_SB(1, 1), b3 + hstep, voffB); PG8_STAGE(PG8_SA(1, 0), a3, voffA[0]);
            PG8_WAIT_V(8); PG8_WAIT_L(0); PG8_BAR; PG8_MMA(1, 0, At, B0); PG8_MMA(1, 1, At, B1); PG8_BAR; PG8_SCHED;
        }
        if (wr == 0) PG8_BAR;
        E(acc, cur, wr, wc, fr, fq);
        if (!has_next) break;
#pragma unroll
        for (int a = 0; a < 2; ++a)
#pragma unroll
            for (int b = 0; b < 2; ++b)
#pragma unroll
                for (int m = 0; m < 4; ++m)
#pragma unroll
                    for (int n = 0; n < 2; ++n) acc[a][b][m][n] = (f32x4){0.f, 0.f, 0.f, 0.f};
        cur = nxt; cA = nA; cB = nB; ++ui;
        if (wr == 1) PG8_BAR;
    }
    PG8_WAIT_V(0);
    PG8_BAR;
#undef PG8_SA
#undef PG8_SB
#undef PG8_STAGE
#undef PG8_LDA
#undef PG8_LDB
#undef PG8_MMA
#undef PG8_WAIT_V
#undef PG8_WAIT_L
#undef PG8_BAR
#undef PG8_SCHED
#undef PG8_SETVOFF
}
}

#define XB_TMO      128
#define XB_XCNT(j)  (256  + 64 * (j))
#define XB_XSUB(j)  (1280 + 64 * (j))
#define XB_XGEN(j)  (2304 + 64 * (j))
#define XB_TOP      3328
#define XB_TOPGEN   3392
#define XCD_BAR_WORDS 3456
#define XB_SPIN_CAP (1u << 18)

__device__ __forceinline__ unsigned xb_ld(unsigned* p)              { return __hip_atomic_load(p, __ATOMIC_RELAXED, __HIP_MEMORY_SCOPE_AGENT); }
__device__ __forceinline__ unsigned xb_add(unsigned* p, unsigned v) { return __hip_atomic_fetch_add(p, v, __ATOMIC_RELAXED, __HIP_MEMORY_SCOPE_AGENT); }
__device__ __forceinline__ unsigned xb_xcc_id() { return (unsigned)__builtin_amdgcn_s_getreg((3 << 11) | 20) & 0xFu; }
#define XB_SPIN(cond, bar) do { unsigned _sp = 0; while (cond) { __builtin_amdgcn_s_sleep(1); \
    if ((++_sp & 255u) == 0u) { if (xb_ld(&(bar)[XB_TMO])) break; if (_sp > XB_SPIN_CAP) { atomicAdd(&(bar)[XB_TMO], 1u); break; } } } } while (0)

struct XcdBarrier {
    unsigned* bar; unsigned x;
    volatile LAS unsigned* st;
};

__device__ __forceinline__ XcdBarrier xcd_barrier_post(unsigned* bar, volatile LAS unsigned* st) {
    XcdBarrier b; b.bar = bar; b.x = xb_xcc_id(); b.st = st;
    if (threadIdx.x == 0) (void)xb_add(&bar[XB_XCNT(b.x)], 1u);
    return b;
}
__device__ __forceinline__ void xcd_barrier_complete(unsigned* bar, unsigned x, unsigned& nloc, unsigned& nx) {
    const unsigned G = gridDim.x * gridDim.y * gridDim.z;
    unsigned sum, cnt, mine, sp = 0u;
    for (;;) {
        sum = 0u; cnt = 0u; mine = 0u;
#pragma unroll
        for (unsigned j = 0; j < 16; ++j) { const unsigned c = xb_ld(&bar[XB_XCNT(j)]); sum += c; cnt += (c > 0u) ? 1u : 0u; mine = (j == x) ? c : mine; }
        if (sum == G) break;
        __builtin_amdgcn_s_sleep(1);
        if ((++sp & 255u) == 0u) { if (xb_ld(&bar[XB_TMO])) break; if (sp > XB_SPIN_CAP) { atomicAdd(&bar[XB_TMO], 1u); break; } }
    }
    nloc = mine > 0u ? mine : 1u; nx = cnt > 0u ? cnt : 1u;
}

__device__ __forceinline__ void xcd_barrier(const XcdBarrier& b) {
    asm volatile("s_waitcnt vmcnt(0)" ::: "memory");
    __syncthreads();
    if (threadIdx.x == 0) {
        unsigned* bar = b.bar;
        __builtin_amdgcn_s_waitcnt(0);
        unsigned nloc = b.st[0], nx = b.st[1];
        if (nloc == 0u) { xcd_barrier_complete(bar, b.x, nloc, nx); b.st[0] = nloc; b.st[1] = nx; }
        const unsigned old = xb_add(&bar[XB_XSUB(b.x)], 1u);
        const unsigned gen = old / nloc;
        if (old + 1u == (gen + 1u) * nloc) {
            __builtin_amdgcn_fence(__ATOMIC_RELEASE, "agent");
            asm volatile("s_waitcnt vmcnt(0)" ::: "memory");
            const unsigned og = xb_add(&bar[XB_TOP], 1u);
            const unsigned tg = og / nx;
            if (og + 1u == (tg + 1u) * nx) xb_add(&bar[XB_TOPGEN], 1u);
            else XB_SPIN(xb_ld(&bar[XB_TOPGEN]) == tg, bar);
            __builtin_amdgcn_fence(__ATOMIC_ACQUIRE, "agent");
            xb_add(&bar[XB_XGEN(b.x)], 1u);
            asm volatile("s_waitcnt vmcnt(0)" ::: "memory");
        } else {
            XB_SPIN(xb_ld(&bar[XB_XGEN(b.x)]) == gen, bar);
            __builtin_amdgcn_fence(__ATOMIC_ACQUIRE, "agent");
            asm volatile("s_waitcnt vmcnt(0)" ::: "memory");
        }
    }
    __syncthreads();
}

struct Args { const float* in[23]; float* out; unsigned char* ws; int ph_lo, ph_hi; };
struct Frame {
    LAS unsigned char* lds;
    volatile LAS int* LCTL;
    int tid, lane, wave, vcu, G;
};
__device__ __forceinline__ unsigned long long ptr_get(const Frame& F, int i) {
    const unsigned lo = (unsigned)F.LCTL[128 + 2 * i], hi = (unsigned)F.LCTL[129 + 2 * i];
    return ((unsigned long long)(unsigned)__builtin_amdgcn_readfirstlane((int)hi) << 32) | (unsigned long long)(unsigned)__builtin_amdgcn_readfirstlane((int)lo);
}
__device__ __forceinline__ const float* inp(const Frame& F, int i) { return (const float*)ptr_get(F, i); }
__device__ __forceinline__ unsigned char* wsp(const Frame& F) { return (unsigned char*)ptr_get(F, 23); }
__device__ __forceinline__ float* outp(const Frame& F) { return (float*)ptr_get(F, 24); }
enum { I_X = 0, I_C, I_CTX, I_CCTX, I_WADA, I_BADA, I_GMIX, I_GFFN, I_WQKV, I_QGAIN, I_KGAIN, I_RPB, I_WONA, I_WIN, I_BGATE, I_MHGAIN, I_WOML,
       I_WR, I_BR, I_W1, I_B1, I_W2, I_B2 };

struct DenseOrder {
    int nM, nN, nwg, G, c, pm0, K; const char* A; const char* Bt;
    __device__ __forceinline__ void init(int pm0_, int nM_, int nN_, int G_, int c_, const void* A_, const void* Bt_, int K_) { pm0 = pm0_; nM = nM_; nN = nN_; nwg = nM * nN; G = G_; c = c_; A = (const char*)A_; Bt = (const char*)Bt_; K = K_; }
    __device__ __forceinline__ bool next(int i, pg8::Unit& u) const {
        const long L = (long)i * G + c; if (L >= nwg) return false;
        int wgid = (int)L; { const int q = nwg / 8, r = nwg % 8, xcd = wgid % 8, off = wgid / 8; wgid = (xcd < r ? xcd * (q + 1) : r * (q + 1) + (xcd - r) * q) + off; }
        const int nig = 8 * nN, gid = wgid / nig, fm = gid * 8, gsz = (nM - fm) < 8 ? (nM - fm) : 8;
        u.pm = pm0 + fm + ((wgid % nig) % gsz); u.pn = (wgid % nig) / gsz; u.e = 0; return true;
    }
    __device__ __forceinline__ const char* a_base(const pg8::Unit& u) const { return A + (size_t)u.pm * 256 * K * 2; }
    __device__ __forceinline__ const char* b_base(const pg8::Unit& u) const { return Bt + (size_t)u.pn * 256 * K * 2; }
    __device__ __forceinline__ int a_row(const pg8::Unit&, int) const { return 0; }
};
struct MoeOrder {
    int NT, nunits, G, c, K; const char* A; const char* W; size_t estride; const int* tokmap; volatile LAS int* prefix; bool gather;
    __device__ __forceinline__ bool next(int i, pg8::Unit& u) const {
        const long L = (long)i * G + c; if (L >= nunits) return false;
        int wgid = (int)L; { const int q = nunits / 8, r = nunits % 8, xcd = wgid % 8, off = wgid / 8; wgid = (xcd < r ? xcd * (q + 1) : r * (q + 1) + (xcd - r) * q) + off; }
        const int tile = wgid / NT; u.pm = tile; u.pn = wgid - tile * NT;
        int e = 0;
#pragma unroll 1
        for (int j = 1; j < NE; ++j) e += (prefix[j] <= tile) ? 1 : 0;
        u.e = e; return true;
    }
    __device__ __forceinline__ const char* a_base(const pg8::Unit& u) const { return gather ? A : A + (size_t)u.pm * 256 * K * 2; }
    __device__ __forceinline__ const char* b_base(const pg8::Unit& u) const { return W + (size_t)u.e * estride + (size_t)u.pn * 256 * K * 2; }
    __device__ __forceinline__ int a_row(const pg8::Unit& u, int r) const { return tokmap[u.pm * 256 + r]; }
};

typedef f32x4 AccT[2][2][4][2];
struct EpiStoreBf16 {
    static constexpr bool PERM = true;
    bf16_t* O; int ldc;
    __device__ __forceinline__ void operator()(const AccT& acc, const pg8::Unit& u, int wr, int wc, int fr, int fq) const {
        const int row0 = u.pm * 256 + wr * 64 + fr, col0 = u.pn * 256 + wc * 32 + 8 * fq;
#pragma unroll
        for (int ai = 0; ai < 2; ++ai)
#pragma unroll
            for (int m = 0; m < 4; ++m) { bf16_t* rowp = O + (size_t)(row0 + ai * 128 + m * 16) * ldc + col0;
#pragma unroll
                for (int bj = 0; bj < 2; ++bj) { const f32x4 v0 = acc[ai][bj][m][0], v1 = acc[ai][bj][m][1];
                    u32x4 w; w.x = pg8::cvt_pk_bf16(v0[0], v0[1]); w.y = pg8::cvt_pk_bf16(v0[2], v0[3]); w.z = pg8::cvt_pk_bf16(v1[0], v1[1]); w.w = pg8::cvt_pk_bf16(v1[2], v1[3]);
                    *(u32x4*)(rowp + bj * 128) = w; } }
    }
};
struct EpiY {
    static constexpr bool PERM = true;
    bf16_t* O; const float* b2;
    __device__ __forceinline__ void operator()(const AccT& acc, const pg8::Unit& u, int wr, int wc, int fr, int fq) const {
        const int row0 = u.pm * 256 + wr * 64 + fr, col0 = u.pn * 256 + wc * 32 + 8 * fq;
        const float* bp = b2 + (size_t)u.e * D + col0;
        f32x4 bv[2][2];
#pragma unroll
        for (int bj = 0; bj < 2; ++bj)
#pragma unroll
            for (int n = 0; n < 2; ++n) bv[bj][n] = *(const f32x4*)(bp + bj * 128 + 4 * n);
#pragma unroll
        for (int ai = 0; ai < 2; ++ai)
#pragma unroll
            for (int m = 0; m < 4; ++m) { bf16_t* rowp = O + (size_t)(row0 + ai * 128 + m * 16) * D + col0;
#pragma unroll
                for (int bj = 0; bj < 2; ++bj) { const f32x4 v0 = acc[ai][bj][m][0] + bv[bj][0], v1 = acc[ai][bj][m][1] + bv[bj][1];
                    u32x4 w; w.x = pg8::cvt_pk_bf16(v0[0], v0[1]); w.y = pg8::cvt_pk_bf16(v0[2], v0[3]); w.z = pg8::cvt_pk_bf16(v1[0], v1[1]); w.w = pg8::cvt_pk_bf16(v1[2], v1[3]);
                    *(u32x4*)(rowp + bj * 128) = w; } }
    }
};
struct EpiSwiglu {
    static constexpr bool PERM = true;
    bf16_t* O; const float* b1;
    __device__ __forceinline__ void operator()(const AccT& acc, const pg8::Unit& u, int wr, int wc, int fr, int fq) const {
        const int row0 = u.pm * 256 + wr * 64 + fr, cc0 = u.pn * 128 + wc * 32 + 8 * fq;
        const float* bp = b1 + (size_t)u.e * 2048 + cc0;
        f32x4 bg[2], bl[2];
#pragma unroll
        for (int n = 0; n < 2; ++n) { bg[n] = *(const f32x4*)(bp + 4 * n); bl[n] = *(const f32x4*)(bp + 1024 + 4 * n); }
#pragma unroll
        for (int ai = 0; ai < 2; ++ai)
#pragma unroll
            for (int m = 0; m < 4; ++m) { bf16_t* rowp = O + (size_t)(row0 + ai * 128 + m * 16) * D + cc0;
                float o[8];
#pragma unroll
                for (int n = 0; n < 2; ++n) { const f32x4 gl = acc[ai][0][m][n] + bg[n], li = acc[ai][1][m][n] + bl[n];
#pragma unroll
                    for (int j = 0; j < 4; ++j) { const float g = fminf(gl[j], 7.0f), l = fminf(fmaxf(li[j], -7.0f), 7.0f);
                        o[4 * n + j] = g * sigmoidf_(1.702f * g) * (l + 1.0f); } }
                u32x4 w; w.x = pg8::cvt_pk_bf16(o[0], o[1]); w.y = pg8::cvt_pk_bf16(o[2], o[3]); w.z = pg8::cvt_pk_bf16(o[4], o[5]); w.w = pg8::cvt_pk_bf16(o[6], o[7]);
                *(u32x4*)rowp = w; }
    }
};
struct EpiResid {
    static constexpr bool PERM = false;
    float* xs; const float* g;
    __device__ __forceinline__ void operator()(const AccT& acc, const pg8::Unit& u, int wr, int wc, int fr, int fq) const {
        const int row0 = u.pm * 256 + wr * 64 + fr, col0 = u.pn * 256 + wc * 32 + 4 * fq;
        const int mb = u.pm < 8 ? 8 : ((u.pm - 8) >> 4);
        const float* gp = g + (size_t)mb * 6144 + col0;
        f32x4 gv[2][2];
#pragma unroll
        for (int bj = 0; bj < 2; ++bj)
#pragma unroll
            for (int n = 0; n < 2; ++n) gv[bj][n] = *(const f32x4*)(gp + bj * 128 + n * 16);
#pragma unroll
        for (int ai = 0; ai < 2; ++ai)
#pragma unroll
            for (int m = 0; m < 4; ++m) { float* rowp = xs + (size_t)(row0 + ai * 128 + m * 16) * D + col0;
#pragma unroll
                for (int bj = 0; bj < 2; ++bj)
#pragma unroll
                    for (int n = 0; n < 2; ++n) { f32x4* p = (f32x4*)(rowp + bj * 128 + n * 16); *p = *p + gv[bj][n] * acc[ai][bj][m][n]; } }
    }
};

__device__ __forceinline__ const float* modp(const Frame& F, int l, int mb, int chunk) { return (const float*)(wsp(F) + WS_MOD) + ((size_t)(l * 9 + mb) * 6 + chunk) * D; }
__device__ __forceinline__ int row_mb(int row) { return row < ROWS_CTX ? 8 : ((row - ROWS_CTX) >> 12); }

__device__ __forceinline__ void transpose_item(const float* W, int N, int Nvalid, bf16_t* WT, int k0, int n0, LAS float* scr, int lane) {
    const int nn = 4 * (lane & 15);
    const bool ok = (n0 + nn) < Nvalid;
    f32x4 v[16];
#pragma unroll
    for (int i = 0; i < 16; ++i) { const int kk = 4 * i + (lane >> 4);
        v[i] = ok ? *(const f32x4*)(W + (size_t)(k0 + kk) * N + n0 + nn) : (f32x4){0.f, 0.f, 0.f, 0.f}; }
#pragma unroll
    for (int i = 0; i < 16; ++i) { const int kk = 4 * i + (lane >> 4); LAS float* s = scr + kk * 65 + nn;
        s[0] = v[i][0]; s[1] = v[i][1]; s[2] = v[i][2]; s[3] = v[i][3]; }
    LDS_WAIT(); asm volatile("" ::: "memory");
    const int c = lane & 7;
#pragma unroll
    for (int j = 0; j < 8; ++j) { const int n = (lane >> 3) + 8 * j; const LAS float* s = scr + (8 * c) * 65 + n;
        u32x4 o; o.x = pk2(s[0 * 65], s[1 * 65]); o.y = pk2(s[2 * 65], s[3 * 65]); o.z = pk2(s[4 * 65], s[5 * 65]); o.w = pk2(s[6 * 65], s[7 * 65]);
        *(u32x4*)(WT + (size_t)n * D + k0 + 8 * c) = o; }
    LDS_WAIT(); asm volatile("" ::: "memory");
}
__device__ __forceinline__ void phase0(Frame& F) {
    const int tid = F.tid, lane = F.lane, wave = F.wave;
    {
        LAS float* sT = (LAS float*)F.lds;
        LAS float* red = (LAS float*)(F.lds + 40960);
        const float* c = inp(F, I_C); const float* cctx = inp(F, I_CCTX);
        for (int idx = tid; idx < 9 * D; idx += NTHREADS) { const int mb = idx >> 10, k = idx & 1023; const float cv = mb < 8 ? c[mb * D + k] : cctx[k]; sT[idx] = cv / (1.f + __expf(-cv)); }
        __syncthreads();
        float* mod = (float*)(wsp(F) + WS_MOD);
        for (int task = F.vcu; task < DEPTH * 96; task += F.G) {
            const int l = task / 96, cb = task % 96;
            const float* wp = inp(F, I_WADA) + ((size_t)l * D + wave * 128) * 6144 + cb * 64 + lane;
            float acc[9];
#pragma unroll
            for (int mb = 0; mb < 9; ++mb) acc[mb] = 0.f;
#pragma unroll 8
            for (int k = 0; k < 128; ++k) { const float wv = wp[(size_t)k * 6144];
#pragma unroll
                for (int mb = 0; mb < 9; ++mb) acc[mb] += sT[mb * D + wave * 128 + k] * wv; }
#pragma unroll
            for (int mb = 0; mb < 9; ++mb) red[(wave * 9 + mb) * 64 + lane] = acc[mb];
            __syncthreads();
            for (int idx = tid; idx < 9 * 64; idx += NTHREADS) { const int mb = idx >> 6, ln = idx & 63; float s = 0.f;
#pragma unroll
                for (int w = 0; w < 8; ++w) s += red[(w * 9 + mb) * 64 + ln];
                const int col = cb * 64 + ln;
                mod[(size_t)(l * 9 + mb) * 6144 + col] = s + inp(F, I_BADA)[l * 6144 + col]; }
            __syncthreads();
        }
        if (blockIdx.x == 0) {
            float* rope = (float*)(wsp(F) + WS_ROPE);
            for (int idx = tid; idx < 64 * 16; idx += NTHREADS) { const int pos = idx >> 4, i = idx & 15; const float inv = powf(10000.0f, -(float)i / 16.0f); const float ang = (float)pos * inv;
                rope[idx * 2] = cosf(ang); rope[idx * 2 + 1] = sinf(ang); }
        }
        __syncthreads();
    }
    {
        LAS float* scr = (LAS float*)(F.lds + wave * 16640);
        const int gw = F.vcu * NWAVES + wave, NGW = F.G * NWAVES;
        constexpr int I_QKV = 2 * 16 * 48, I_WO = 4 * 16 * 16, I_IN = 2 * 16 * 52, I_1 = DEPTH * NE * 16 * 32, I_2 = DEPTH * NE * 16 * 16;
        for (int it0 = gw; it0 < I_QKV + I_WO + I_IN + I_1 + I_2; it0 += NGW) {
            int it = it0;
            if (it < I_QKV) { const int j = it / 768, r = it % 768, kb = r / 48, nb = r % 48;
                transpose_item(inp(F, I_WQKV) + (size_t)j * D * 3072, 3072, 3072, (bf16_t*)(wsp(F) + WS_WQKV) + ((size_t)j * 3072 + nb * 64) * D, kb * 64, nb * 64, scr, lane); continue; }
            it -= I_QKV;
            if (it < I_WO) { const int m = it / 256, r = it % 256, kb = r / 16, nb = r % 16;
                const float* W = (m < 2) ? inp(F, I_WONA) + (size_t)m * D * D : inp(F, I_WOML) + (size_t)(m - 2) * D * D;
                bf16_t* dst = (m < 2) ? (bf16_t*)(wsp(F) + WS_WONA) + (size_t)m * D * D : (bf16_t*)(wsp(F) + WS_WOML) + (size_t)(m - 2) * D * D;
                transpose_item(W, D, D, dst + (size_t)nb * 64 * D, kb * 64, nb * 64, scr, lane); continue; }
            it -= I_WO;
            if (it < I_IN) { const int j = it / 832, r = it % 832, kb = r / 52, nb = r % 52;
                transpose_item(inp(F, I_WIN) + (size_t)j * D * ML_IN, ML_IN, ML_IN, (bf16_t*)(wsp(F) + WS_WIN) + ((size_t)j * ML_INP + nb * 64) * D, kb * 64, nb * 64, scr, lane); continue; }
            it -= I_IN;
            if (it < I_1) { const int le = it / 512, r = it % 512, kb = r / 32, nb = r % 32;
                const int n0 = nb * 64, bj = n0 >> 10, j0 = n0 & 1023, pn = j0 >> 7, jj0 = j0 & 127, drow = pn * 256 + bj * 128 + jj0;
                transpose_item(inp(F, I_W1) + (size_t)le * D * 2048, 2048, 2048, (bf16_t*)(wsp(F) + WS_W1T) + ((size_t)le * 2048 + drow) * D, kb * 64, n0, scr, lane); continue; }
            it -= I_1;
            { const int le = it / 256, r = it % 256, kb = r / 16, nb = r % 16;
                transpose_item(inp(F, I_W2) + (size_t)le * D * D, D, D, (bf16_t*)(wsp(F) + WS_W2T) + ((size_t)le * D + nb * 64) * D, kb * 64, nb * 64, scr, lane); }
        }
    }
}

__device__ __forceinline__ void moe_combine(const Frame& F, int row, int lprev, int mb, f32x4 (&v)[4]) {
    const int* pos = (const int*)(wsp(F) + WS_POS) + (size_t)row * 4;
    const float* tw = (const float*)(wsp(F) + WS_TOPW) + (size_t)row * 4;
    const bf16_t* Y = (const bf16_t*)(wsp(F) + WS_Y);
    f32x4 a[4];
#pragma unroll
    for (int j = 0; j < 4; ++j) a[j] = (f32x4){0.f, 0.f, 0.f, 0.f};
#pragma unroll
    for (int k = 0; k < 4; ++k) { const int p = pos[k]; const float w = tw[k]; const u32x2* yp = (const u32x2*)(Y + (size_t)p * D) + F.lane;
#pragma unroll
        for (int j = 0; j < 4; ++j) { const u32x2 y = yp[64 * j]; a[j] = a[j] + w * (f32x4){bflo(y.x), bfhi(y.x), bflo(y.y), bfhi(y.y)}; } }
    const f32x4* g2 = (const f32x4*)modp(F, lprev, mb, 5) + F.lane;
#pragma unroll
    for (int j = 0; j < 4; ++j) v[j] = v[j] + g2[64 * j] * a[j];
}

__device__ __forceinline__ void phase_norm1(Frame& F, int l) {
    const int gw = F.vcu * NWAVES + F.wave, NGW = F.G * NWAVES, lane = F.lane;
    float* xs = (float*)(wsp(F) + WS_XS); bf16_t* hb = (bf16_t*)(wsp(F) + WS_HB);
    const f32x4* gm = (const f32x4*)(inp(F, I_GMIX) + l * D) + lane;
    for (int row = gw; row < ROWS; row += NGW) {
        const int mb = row_mb(row);
        const float* src = (l == 0) ? (row < ROWS_CTX ? inp(F, I_CTX) + (size_t)row * D : inp(F, I_X) + (size_t)(row - ROWS_CTX) * D) : xs + (size_t)row * D;
        const f32x4* xr = (const f32x4*)src + lane;
        f32x4 v[4];
#pragma unroll
        for (int j = 0; j < 4; ++j) v[j] = xr[64 * j];
        if (l > 0) moe_combine(F, row, l - 1, mb, v);
        f32x4* xw = (f32x4*)(xs + (size_t)row * D) + lane;
        float ss = 0.f;
#pragma unroll
        for (int j = 0; j < 4; ++j) { xw[64 * j] = v[j]; ss += (v[j][0] * v[j][0] + v[j][1] * v[j][1]) + (v[j][2] * v[j][2] + v[j][3] * v[j][3]); }
        const float rs = 1.0f / sqrtf(wave_sum(ss) * (1.f / D) + EPS);
        const f32x4* sh = (const f32x4*)modp(F, l, mb, 0) + lane; const f32x4* sc = (const f32x4*)modp(F, l, mb, 1) + lane;
        u32x2* o8 = (u32x2*)(hb + (size_t)row * D) + lane;
#pragma unroll
        for (int j = 0; j < 4; ++j) { const f32x4 h = (v[j] * rs) * gm[64 * j] * (sc[64 * j] + 1.0f) + sh[64 * j];
            u32x2 w; w.x = pk2(h[0], h[1]); w.y = pk2(h[2], h[3]); o8[64 * j] = w; }
    }
}
__device__ __forceinline__ void phase_final(Frame& F) {
    const int gw = F.vcu * NWAVES + F.wave, NGW = F.G * NWAVES, lane = F.lane;
    const float* xs = (const float*)(wsp(F) + WS_XS);
    for (int row = ROWS_CTX + gw; row < ROWS; row += NGW) {
        const int mb = row_mb(row);
        const f32x4* xr = (const f32x4*)(xs + (size_t)row * D) + lane;
        f32x4 v[4];
#pragma unroll
        for (int j = 0; j < 4; ++j) v[j] = xr[64 * j];
        moe_combine(F, row, DEPTH - 1, mb, v);
        f32x4* o = (f32x4*)(outp(F) + (size_t)(row - ROWS_CTX) * D) + lane;
#pragma unroll
        for (int j = 0; j < 4; ++j) o[64 * j] = v[j];
    }
}

__device__ __forceinline__ void phase_na_post(Frame& F, int jn) {
    const int gw = F.vcu * NWAVES + F.wave, NGW = F.G * NWAVES, lane = F.lane;
    const bf16_t* proj = (const bf16_t*)(wsp(F) + WS_PROJ);
    bf16_t* QN = (bf16_t*)(wsp(F) + WS_QN); bf16_t* KN = (bf16_t*)(wsp(F) + WS_KN); bf16_t* VT = (bf16_t*)(wsp(F) + WS_VT);
    LAS bf16_t* vs = (LAS bf16_t*)(F.lds + F.wave * (64 * 72 * 2));
    const int c8 = lane & 7, rl = lane >> 3;
    float qg[8], kg[8];
#pragma unroll
    for (int e = 0; e < 8; ++e) { qg[e] = inp(F, I_QGAIN)[jn * 64 + c8 * 8 + e] * 0.125f; kg[e] = inp(F, I_KGAIN)[jn * 64 + c8 * 8 + e]; }
    for (int item = gw; item < (ROWS / 64) * NH_NA; item += NGW) {
        const int rb = item >> 4, h = item & 15, row0 = rb * 64;
        int b, tp0;
        if (row0 < ROWS_CTX) { b = row0 >> 8; tp0 = row0 & 255; } else { b = (row0 - ROWS_CTX) >> 12; tp0 = NCTX + ((row0 - ROWS_CTX) & 4095); }
        const size_t seqbase = ((size_t)(b * NH_NA + h) * TT + tp0) * 64;
#pragma unroll
        for (int i = 0; i < 8; ++i) {
            const int r = i * 8 + rl;
            const bf16_t* pr = proj + (size_t)(row0 + r) * 3072 + h * 64 + c8 * 8;
            const u32x4 qv = *(const u32x4*)pr, kv = *(const u32x4*)(pr + 1024), vv = *(const u32x4*)(pr + 2048);
            float q[8] = {bflo(qv.x), bfhi(qv.x), bflo(qv.y), bfhi(qv.y), bflo(qv.z), bfhi(qv.z), bflo(qv.w), bfhi(qv.w)};
            float k[8] = {bflo(kv.x), bfhi(kv.x), bflo(kv.y), bfhi(kv.y), bflo(kv.z), bfhi(kv.z), bflo(kv.w), bfhi(kv.w)};
            float sq = 0.f, sk = 0.f;
#pragma unroll
            for (int e = 0; e < 8; ++e) { sq += q[e] * q[e]; sk += k[e] * k[e]; }
            sq += __shfl_xor(sq, 1); sq += __shfl_xor(sq, 2); sq += __shfl_xor(sq, 4);
            sk += __shfl_xor(sk, 1); sk += __shfl_xor(sk, 2); sk += __shfl_xor(sk, 4);
            const float rq = 1.0f / sqrtf(sq * (1.f / 64) + EPS), rk = 1.0f / sqrtf(sk * (1.f / 64) + EPS);
            u32x4 qo, ko;
            qo.x = pk2(q[0] * rq * qg[0], q[1] * rq * qg[1]); qo.y = pk2(q[2] * rq * qg[2], q[3] * rq * qg[3]); qo.z = pk2(q[4] * rq * qg[4], q[5] * rq * qg[5]); qo.w = pk2(q[6] * rq * qg[6], q[7] * rq * qg[7]);
            ko.x = pk2(k[0] * rk * kg[0], k[1] * rk * kg[1]); ko.y = pk2(k[2] * rk * kg[2], k[3] * rk * kg[3]); ko.z = pk2(k[4] * rk * kg[4], k[5] * rk * kg[5]); ko.w = pk2(k[6] * rk * kg[6], k[7] * rk * kg[7]);
            *(u32x4*)(QN + seqbase + (size_t)r * 64 + c8 * 8) = qo;
            *(u32x4*)(KN + seqbase + (size_t)r * 64 + c8 * 8) = ko;
            *(LAS u32x4*)(vs + r * 72 + c8 * 8) = vv;
        }
        LDS_WAIT(); asm volatile("" ::: "memory");
#pragma unroll
        for (int j = 0; j < 8; ++j) {
            const int d = rl + 8 * j;
            const LAS bf16_t* s = vs + (8 * c8) * 72 + d;
            u32x4 o;
            o.x = (unsigned)s[0 * 72] | ((unsigned)s[1 * 72] << 16); o.y = (unsigned)s[2 * 72] | ((unsigned)s[3 * 72] << 16);
            o.z = (unsigned)s[4 * 72] | ((unsigned)s[5 * 72] << 16); o.w = (unsigned)s[6 * 72] | ((unsigned)s[7 * 72] << 16);
            *(u32x4*)(VT + ((size_t)(b * NH_NA + h) * 64 + d) * TT + tp0 + 8 * c8) = o;
        }
        LDS_WAIT(); asm volatile("" ::: "memory");
    }
}

__device__ __forceinline__ bf16x8 ld_bf16x8(const bf16_t* p) { return *(const bf16x8*)p; }
__device__ __forceinline__ void na_wave_task(const Frame& F, int jn, int b, int h, bool ctxq, int cb, int r, int qw) {
    const int lane = F.lane, q16 = lane & 15, g = lane >> 4;
    const bf16_t* Qb = (const bf16_t*)(wsp(F) + WS_QN) + (size_t)(b * NH_NA + h) * TT * 64;
    const bf16_t* Kb = (const bf16_t*)(wsp(F) + WS_KN) + (size_t)(b * NH_NA + h) * TT * 64;
    const bf16_t* Vb = (const bf16_t*)(wsp(F) + WS_VT) + (size_t)(b * NH_NA + h) * 64 * TT;
    const float* rpb = inp(F, I_RPB) + (size_t)(jn * NH_NA + h) * 15 * 31;
    const int qc = qw * 16 + q16;
    const int qtp = ctxq ? cb * 16 + q16 : NCTX + r * 64 + qc;
    const bf16x8 qf0 = ld_bf16x8(Qb + (size_t)qtp * 64 + 8 * g), qf1 = ld_bf16x8(Qb + (size_t)qtp * 64 + 32 + 8 * g);
    f32x4 o[4];
#pragma unroll
    for (int j = 0; j < 4; ++j) o[j] = (f32x4){0.f, 0.f, 0.f, 0.f};
    float m = -1e30f, lsum = 0.f;
    const int r0 = min(max(r - 4, 0), 56), c0 = min(max(qc - 8, 0), 48);
    const int lo = min(max(16 * qw - 8, 0), 48), hi = min(max(16 * qw + 7, 0), 48) + 15;
    const int nwin = ctxq ? 0 : 16;
    for (int blk = 0; blk < 8 + nwin; ++blk) {
        int tok0, kbcol = 0, dr = 0; bool win = false;
        if (blk < 8) tok0 = blk * 32;
        else { const int wi = (blk - 8) >> 1; kbcol = ((blk - 8) & 1) * 32; win = true;
            if (kbcol == 0 ? (lo >= 32) : (hi < 32)) continue;
            const int kr = r0 + wi; dr = kr - r + 7; tok0 = NCTX + kr * 64 + kbcol; }
        f32x4 s0 = (f32x4){0.f, 0.f, 0.f, 0.f}, s1 = (f32x4){0.f, 0.f, 0.f, 0.f};
        const bf16_t* kp = Kb + (size_t)(tok0 + q16) * 64 + 8 * g;
        const bf16x8 ka0 = ld_bf16x8(kp), ka1 = ld_bf16x8(kp + 32), kb0 = ld_bf16x8(kp + 16 * 64), kb1 = ld_bf16x8(kp + 16 * 64 + 32);
        bf16x8 vf[4];
#pragma unroll
        for (int j4 = 0; j4 < 4; ++j4) { const bf16_t* vp = Vb + (size_t)(16 * j4 + q16) * TT + tok0 + 4 * g;
            const bf16x4 va = *(const bf16x4*)vp, vb = *(const bf16x4*)(vp + 16);
            vf[j4] = (bf16x8){va[0], va[1], va[2], va[3], vb[0], vb[1], vb[2], vb[3]}; }
        s0 = __builtin_amdgcn_mfma_f32_16x16x32_bf16(ka0, qf0, s0, 0, 0, 0); s0 = __builtin_amdgcn_mfma_f32_16x16x32_bf16(ka1, qf1, s0, 0, 0, 0);
        s1 = __builtin_amdgcn_mfma_f32_16x16x32_bf16(kb0, qf0, s1, 0, 0, 0); s1 = __builtin_amdgcn_mfma_f32_16x16x32_bf16(kb1, qf1, s1, 0, 0, 0);
        float sv[8] = {s0[0], s0[1], s0[2], s0[3], s1[0], s1[1], s1[2], s1[3]};
        if (win) {
#pragma unroll
            for (int e = 0; e < 8; ++e) { const int kc = kbcol + 16 * (e >> 2) + 4 * g + (e & 3);
                const bool valid = (kc >= c0) && (kc <= c0 + 15);
                const int idx = min(max(kc - qc + 15, 0), 30);
                const float bias = rpb[dr * 31 + idx];
                sv[e] = valid ? sv[e] + bias : -1e30f; }
        }
        float bm = fmaxf(fmaxf(fmaxf(sv[0], sv[1]), fmaxf(sv[2], sv[3])), fmaxf(fmaxf(sv[4], sv[5]), fmaxf(sv[6], sv[7])));
        bm = fmaxf(bm, __shfl_xor(bm, 16)); bm = fmaxf(bm, __shfl_xor(bm, 32));
        const float mn = fmaxf(m, bm), alpha = __expf(m - mn);
        float p[8], ps = 0.f;
#pragma unroll
        for (int e = 0; e < 8; ++e) { p[e] = __expf(sv[e] - mn); ps += p[e]; }
        lsum = lsum * alpha + ps; m = mn;
#pragma unroll
        for (int j = 0; j < 4; ++j) o[j] = o[j] * alpha;
        union { u32x4 u; bf16x8 v; } pf;
        pf.u.x = pk2(p[0], p[1]); pf.u.y = pk2(p[2], p[3]); pf.u.z = pk2(p[4], p[5]); pf.u.w = pk2(p[6], p[7]);
#pragma unroll
        for (int j4 = 0; j4 < 4; ++j4) o[j4] = __builtin_amdgcn_mfma_f32_16x16x32_bf16(vf[j4], pf.v, o[j4], 0, 0, 0);
    }
    lsum += __shfl_xor(lsum, 16); lsum += __shfl_xor(lsum, 32);
    const float inv = 1.0f / lsum;
    const int row = ctxq ? b * NCTX + cb * 16 + q16 : ROWS_CTX + b * SEQ + r * 64 + qc;
    bf16_t* op = (bf16_t*)(wsp(F) + WS_AO) + (size_t)row * D + h * 64 + 4 * g;
#pragma unroll
    for (int j4 = 0; j4 < 4; ++j4) { u32x2 w; w.x = pk2(o[j4][0] * inv, o[j4][1] * inv); w.y = pk2(o[j4][2] * inv, o[j4][3] * inv); *(u32x2*)(op + 16 * j4) = w; }
}
__device__ __forceinline__ void phase_na_attn(Frame& F, int jn) {
    for (int bt = F.vcu; bt < NB * NH_NA * 32; bt += F.G) {
        const int bh = bt >> 5, p = bt & 31;
        na_wave_task(F, jn, bh >> 4, bh & 15, false, 0, 2 * p + (F.wave >> 2), F.wave & 3);
    }
    for (int wt = F.vcu * NWAVES + F.wave; wt < NB * NH_NA * 16; wt += F.G * NWAVES) {
        const int bh = wt >> 4, cb = wt & 15;
        na_wave_task(F, jn, bh >> 4, bh & 15, true, cb, 0, 0);
    }
}

__device__ __forceinline__ void row_decode(int row, int& b, int& tp) {
    if (row < ROWS_CTX) { b = row >> 8; tp = row & 255; } else { b = (row - ROWS_CTX) >> 12; tp = NCTX + ((row - ROWS_CTX) & 4095); }
}
__device__ __forceinline__ void unpack8(const u32x4 v, float (&f)[8]) { f[0] = bflo(v.x); f[1] = bfhi(v.x); f[2] = bflo(v.y); f[3] = bfhi(v.y); f[4] = bflo(v.z); f[5] = bfhi(v.z); f[6] = bflo(v.w); f[7] = bfhi(v.w); }
__device__ __forceinline__ u32x4 pack8(const float (&f)[8]) { u32x4 o; o.x = pk2(f[0], f[1]); o.y = pk2(f[2], f[3]); o.z = pk2(f[4], f[5]); o.w = pk2(f[6], f[7]); return o; }
__device__ __forceinline__ void phase_ml_post(Frame& F, int jm) {
    const int gw = F.vcu * NWAVES + F.wave, NGW = F.G * NWAVES, lane = F.lane;
    bf16_t* proj = (bf16_t*)(wsp(F) + WS_PROJ);
    const float* rope = (const float*)(wsp(F) + WS_ROPE);
    float* gates = (float*)(wsp(F) + WS_GATES);
    const int t16 = lane >> 2, sub = lane & 3, hf = sub >> 1, i0 = 8 * (sub & 1), cbase = t16 * 64 + 32 * hf + i0;
    const float scale = t16 < 8 ? 0.125f : 1.0f;
    for (int row = gw; row < ROWS; row += NGW) {
        int b, tp; row_decode(row, b, tp);
        bf16_t* pr = proj + (size_t)row * ML_INP;
        float a[8], c[8], o1[8], o2[8];
        unpack8(*(const u32x4*)(pr + cbase), a); unpack8(*(const u32x4*)(pr + cbase + 16), c);
        if (tp >= NCTX) {
            const int s = tp - NCTX, pos = hf ? (s & 63) : (s >> 6);
            const float* rp = rope + (pos * 16 + i0) * 2;
#pragma unroll
            for (int e = 0; e < 8; ++e) { const float cs = rp[2 * e], sn = rp[2 * e + 1]; o1[e] = (a[e] * cs - c[e] * sn) * scale; o2[e] = (a[e] * sn + c[e] * cs) * scale; }
        } else {
#pragma unroll
            for (int e = 0; e < 8; ++e) { o1[e] = a[e] * scale; o2[e] = c[e] * scale; }
        }
        float gv = 0.f;
        if (lane < 32) gv = bf2f(pr[3072 + lane]);
        *(u32x4*)(pr + cbase) = pack8(o1); *(u32x4*)(pr + cbase + 16) = pack8(o2);
        if (lane < 32) {
            float v = gv + inp(F, I_BGATE)[jm * 32 + lane];
            v = 15.0f * tanhf(v * (1.0f / 15.0f));
            const int gi = lane >> 3, hh = lane & 7;
            if (gi & 1) v = fminf(v, 0.f) - log1pf(__expf(-fabsf(v)));
            gates[((size_t)(gi * NB + b) * NH_ML + hh) * TT + tp] = v;
        }
    }
}

constexpr int ML_LD = 72;
constexpr int ML_QL = 0, ML_KL = 9216, ML_KET = 18432, ML_VTL = 27648, ML_SDL = 36864, ML_C0L = 46080, ML_N0L = 55296, ML_DENL = 55552;
__device__ __forceinline__ float wave_prefix_sum(float v, int lane) {
#pragma unroll
    for (int o = 1; o < 64; o <<= 1) { const float t = __shfl_up(v, o); if (lane >= o) v += t; }
    return v;
}
__device__ __forceinline__ float wave_prefix_max(float v, int lane) {
#pragma unroll
    for (int o = 1; o < 64; o <<= 1) { const float t = __shfl_up(v, o); if (lane >= o) v = fmaxf(v, t); }
    return v;
}
__device__ __forceinline__ int ml_grow(int b, int tp) { return tp < NCTX ? b * NCTX + tp : ROWS_CTX + b * SEQ + (tp - NCTX); }
__device__ __forceinline__ void ml_task(Frame& F, int b, int hh, int dir, int vh) {
    const int tid = F.tid, lane = F.lane, w = F.wave, l15 = lane & 15, g = lane >> 4;
    LAS bf16_t* QL = (LAS bf16_t*)(F.lds + ML_QL); LAS bf16_t* KL = (LAS bf16_t*)(F.lds + ML_KL); LAS bf16_t* KET = (LAS bf16_t*)(F.lds + ML_KET);
    LAS bf16_t* VTL = (LAS bf16_t*)(F.lds + ML_VTL); LAS bf16_t* SDL = (LAS bf16_t*)(F.lds + ML_SDL); LAS bf16_t* C0L = (LAS bf16_t*)(F.lds + ML_C0L);
    LAS float* n0L = (LAS float*)(F.lds + ML_N0L); LAS float* denL = (LAS float*)(F.lds + ML_DENL);
    const bf16_t* proj = (const bf16_t*)(wsp(F) + WS_PROJ);
    const float* gI = (const float*)(wsp(F) + WS_GATES) + ((size_t)((dir * 2 + 0) * NB + b) * NH_ML + hh) * TT;
    const float* gF = (const float*)(wsp(F) + WS_GATES) + ((size_t)((dir * 2 + 1) * NB + b) * NH_ML + hh) * TT;
    bf16_t* hout = (bf16_t*)(wsp(F) + WS_HDIR) + (size_t)dir * ROWS * D + hh * DV_ML + vh * 64;
    const int r = tid >> 3, c8 = tid & 7, sr = dir ? 63 - r : r;
    const int bt = w >> 1, bc0 = 2 * (w & 1);
    for (int i = tid; i < 64 * ML_LD / 2; i += NTHREADS) ((LAS unsigned*)C0L)[i] = 0u;
    if (w == 0) n0L[lane] = 0.f;
    f32x4 Cst[2]; Cst[0] = (f32x4){0.f, 0.f, 0.f, 0.f}; Cst[1] = (f32x4){0.f, 0.f, 0.f, 0.f};
    float nst = 0.f, m0 = 0.f;
    u32x4 qv, kv, vv; float igv, lfv;
    {
        const int tb = dir ? 192 : 0;
        const bf16_t* pr = proj + (size_t)ml_grow(b, tb + r) * ML_INP;
        qv = *(const u32x4*)(pr + hh * 64 + c8 * 8); kv = *(const u32x4*)(pr + 512 + hh * 64 + c8 * 8); vv = *(const u32x4*)(pr + 1024 + hh * DV_ML + vh * 64 + c8 * 8);
        const int tpg = dir ? tb + 63 - lane : tb + lane;
        igv = gI[tpg]; lfv = gF[tpg];
    }
    __syncthreads();
    for (int c = 0; c < TT / 64; ++c) {
        const int tb = dir ? (c < 4 ? 192 - 64 * c : 4544 - 64 * c) : 64 * c;
        const float cum = wave_prefix_sum(lfv, lane);
        const float av = igv - cum;
        const float pmax = wave_prefix_max(av, lane);
        const float cl = __shfl(cum, 63);
        const float wend = cl - cum + igv;
        const float ml = wave_max(wend);
        const float eend = __expf(wend - ml);
        const float Mv = fmaxf(m0, pmax);
        const float winter = __expf(m0 - Mv);
        const float floorv = __expf(-(cum + Mv));
        const float mnew = fmaxf(cl + m0, ml);
        const float Ac = __expf(cl + m0 - mnew), Gc = __expf(ml - mnew);
        *(LAS u32x4*)(QL + sr * ML_LD + c8 * 8) = qv;
        *(LAS u32x4*)(KL + sr * ML_LD + c8 * 8) = kv;
        {
            const float es = __shfl(eend, sr);
            float kf[8]; unpack8(kv, kf);
            const unsigned vw[4] = {vv.x, vv.y, vv.z, vv.w};
#pragma unroll
            for (int e = 0; e < 8; ++e) { KET[(c8 * 8 + e) * ML_LD + sr] = (bf16_t)f2bf(kf[e] * es); VTL[(c8 * 8 + e) * ML_LD + sr] = (bf16_t)((vw[e >> 1] >> (16 * (e & 1))) & 0xffffu); }
        }
        if (c + 1 < TT / 64) {
            const int cn = c + 1, tbn = dir ? (cn < 4 ? 192 - 64 * cn : 4544 - 64 * cn) : 64 * cn;
            const bf16_t* pr = proj + (size_t)ml_grow(b, tbn + r) * ML_INP;
            qv = *(const u32x4*)(pr + hh * 64 + c8 * 8); kv = *(const u32x4*)(pr + 512 + hh * 64 + c8 * 8); vv = *(const u32x4*)(pr + 1024 + hh * DV_ML + vh * 64 + c8 * 8);
            const int tpg = dir ? tbn + 63 - lane : tbn + lane;
            igv = gI[tpg]; lfv = gF[tpg];
        }
        __syncthreads();
#pragma unroll
        for (int x = 0; x < 2; ++x) {
            const int bs = bc0 + x;
            f32x4 acc = (f32x4){0.f, 0.f, 0.f, 0.f};
            if (bs <= bt) {
#pragma unroll
                for (int ks = 0; ks < 2; ++ks) { const bf16x8 af = *(const LAS bf16x8*)(QL + (16 * bt + l15) * ML_LD + 32 * ks + 8 * g), bfv = *(const LAS bf16x8*)(KL + (16 * bs + l15) * ML_LD + 32 * ks + 8 * g);
                    acc = __builtin_amdgcn_mfma_f32_16x16x32_bf16(af, bfv, acc, 0, 0, 0); }
            }
            const int s = 16 * bs + l15;
            const float a_s = __shfl(av, s);
#pragma unroll
            for (int rg = 0; rg < 4; ++rg) { const int t = 16 * bt + 4 * g + rg; const float M_t = __shfl(Mv, t);
                const float val = (s <= t) ? acc[rg] * __expf(a_s - M_t) : 0.f;
                SDL[t * ML_LD + s] = (bf16_t)f2bf(val); }
        }
        __syncthreads();
        if (w == 0) {
            float rs = 0.f, qn = 0.f;
#pragma unroll
            for (int j = 0; j < 8; ++j) { float sd[8], qf[8]; unpack8(*(const LAS u32x4*)(SDL + lane * ML_LD + 8 * j), sd); unpack8(*(const LAS u32x4*)(QL + lane * ML_LD + 8 * j), qf);
                const f32x4 n0a = *(const LAS f32x4*)(n0L + 8 * j), n0b = *(const LAS f32x4*)(n0L + 8 * j + 4);
                rs += ((sd[0] + sd[1]) + (sd[2] + sd[3])) + ((sd[4] + sd[5]) + (sd[6] + sd[7]));
                qn += qf[0] * n0a[0] + qf[1] * n0a[1] + qf[2] * n0a[2] + qf[3] * n0a[3] + qf[4] * n0b[0] + qf[5] * n0b[1] + qf[6] * n0b[2] + qf[7] * n0b[3]; }
            denL[lane] = rs + winter * qn;
            float dn = 0.f;
#pragma unroll
            for (int j = 0; j < 8; ++j) { float kf[8]; unpack8(*(const LAS u32x4*)(KET + lane * ML_LD + 8 * j), kf); dn += ((kf[0] + kf[1]) + (kf[2] + kf[3])) + ((kf[4] + kf[5]) + (kf[6] + kf[7])); }
            nst = Ac * nst + Gc * dn;
            LDS_WAIT();
            n0L[lane] = nst;
        }
        f32x4 nin[2], nit[2];
#pragma unroll
        for (int x = 0; x < 2; ++x) {
            const int bv = bc0 + x;
            f32x4 a1 = (f32x4){0.f, 0.f, 0.f, 0.f}, a2 = (f32x4){0.f, 0.f, 0.f, 0.f}, a3 = (f32x4){0.f, 0.f, 0.f, 0.f};
#pragma unroll
            for (int ks = 0; ks < 2; ++ks) {
                const bf16x8 sdf = *(const LAS bf16x8*)(SDL + (16 * bt + l15) * ML_LD + 32 * ks + 8 * g), vtf = *(const LAS bf16x8*)(VTL + (16 * bv + l15) * ML_LD + 32 * ks + 8 * g);
                const bf16x8 qf = *(const LAS bf16x8*)(QL + (16 * bt + l15) * ML_LD + 32 * ks + 8 * g), c0f = *(const LAS bf16x8*)(C0L + (16 * bv + l15) * ML_LD + 32 * ks + 8 * g);
                const bf16x8 vt2 = *(const LAS bf16x8*)(VTL + (16 * bt + l15) * ML_LD + 32 * ks + 8 * g), kef = *(const LAS bf16x8*)(KET + (16 * bv + l15) * ML_LD + 32 * ks + 8 * g);
                a1 = __builtin_amdgcn_mfma_f32_16x16x32_bf16(sdf, vtf, a1, 0, 0, 0);
                a2 = __builtin_amdgcn_mfma_f32_16x16x32_bf16(qf, c0f, a2, 0, 0, 0);
                a3 = __builtin_amdgcn_mfma_f32_16x16x32_bf16(vt2, kef, a3, 0, 0, 0);
            }
            nin[x] = a1; nit[x] = a2;
            Cst[x] = Cst[x] * Ac + a3 * Gc;
        }
        __syncthreads();
#pragma unroll
        for (int x = 0; x < 2; ++x) {
            const int bv = bc0 + x;
#pragma unroll
            for (int rg = 0; rg < 4; ++rg) { const int t = 16 * bt + 4 * g + rg;
                const float den = denL[t], w_t = __shfl(winter, t), fl_t = __shfl(floorv, t);
                const float hv = (nin[x][rg] + w_t * nit[x][rg]) / fmaxf(fabsf(den), fl_t);
                const int rr = dir ? 63 - t : t;
                hout[(size_t)ml_grow(b, tb + rr) * D + 16 * bv + l15] = (bf16_t)f2bf(hv);
                C0L[(16 * bt + 4 * g + rg) * ML_LD + 16 * bv + l15] = (bf16_t)f2bf(Cst[x][rg]); }
        }
        m0 = mnew;
    }
    __syncthreads();
}
__device__ __forceinline__ void phase_ml_scan(Frame& F) {
    for (int task = F.vcu; task < NB * NH_ML * 4; task += F.G) {
        const int vh = task & 1, dir = (task >> 1) & 1, bh = task >> 2;
        ml_task(F, bh >> 3, bh & 7, dir, vh);
    }
}

__device__ __forceinline__ void phase_ml_final(Frame& F, int jm) {
    const int gw = F.vcu * NWAVES + F.wave, NGW = F.G * NWAVES, lane = F.lane;
    const bf16_t* hfw = (const bf16_t*)(wsp(F) + WS_HDIR); const bf16_t* hbw = hfw + (size_t)ROWS * D;
    const bf16_t* proj = (const bf16_t*)(wsp(F) + WS_PROJ);
    bf16_t* ao = (bf16_t*)(wsp(F) + WS_AO);
    const float* gain = inp(F, I_MHGAIN) + jm * D + lane * 16;
    for (int row = gw; row < ROWS; row += NGW) {
        const size_t off = (size_t)row * D + lane * 16;
        float a0[8], a1[8], b0[8], b1[8], g0[8], g1[8];
        unpack8(*(const u32x4*)(hfw + off), a0); unpack8(*(const u32x4*)(hfw + off + 8), a1);
        unpack8(*(const u32x4*)(hbw + off), b0); unpack8(*(const u32x4*)(hbw + off + 8), b1);
        const bf16_t* ogp = proj + (size_t)row * ML_INP + 2048 + lane * 16;
        unpack8(*(const u32x4*)ogp, g0); unpack8(*(const u32x4*)(ogp + 8), g1);
        float ss = 0.f;
#pragma unroll
        for (int e = 0; e < 8; ++e) { a0[e] += b0[e]; a1[e] += b1[e]; ss += a0[e] * a0[e] + a1[e] * a1[e]; }
        ss += __shfl_xor(ss, 1); ss += __shfl_xor(ss, 2); ss += __shfl_xor(ss, 4);
        const float rs = 1.0f / sqrtf(ss * (1.f / DV_ML) + EPS);
        float o0[8], o1[8];
#pragma unroll
        for (int e = 0; e < 8; ++e) { o0[e] = a0[e] * rs * gain[e] * sigmoidf_(g0[e]); o1[e] = a1[e] * rs * gain[8 + e] * sigmoidf_(g1[e]); }
        *(u32x4*)(ao + off) = pack8(o0); *(u32x4*)(ao + off + 8) = pack8(o1);
    }
}

constexpr int RT_LD = 36;
__device__ __forceinline__ void phase_norm2_router(Frame& F, int l, int first_row) {
    const int tid = F.tid, lane = F.lane;
    LAS float* wr = (LAS float*)F.lds;
    volatile LAS int* cntL = F.LCTL + 64;
    const float* wg = inp(F, I_WR) + (size_t)l * D * NE;
    for (int idx = tid; idx < D * NE; idx += NTHREADS) { const int k = idx >> 5, e = idx & 31; const int ln = (k & 255) >> 2, j = k >> 8, i = k & 3;
        wr[((4 * j + i) * 64 + ln) * RT_LD + e] = wg[idx]; }
    if (tid < NE) cntL[tid] = 0;
    __syncthreads();
    const float* xs = (const float*)(wsp(F) + WS_XS); bf16_t* hb = (bf16_t*)(wsp(F) + WS_HB);
    int* tope = (int*)(wsp(F) + WS_TOPE); float* topw = (float*)(wsp(F) + WS_TOPW);
    const f32x4* gm = (const f32x4*)(inp(F, I_GFFN) + l * D) + lane;
    const float brl = inp(F, I_BR)[l * NE + (lane >> 1)];
    for (int row = first_row + F.vcu * NWAVES + F.wave; row < ROWS; row += F.G * NWAVES) {
        const int mb = row_mb(row);
        const f32x4* xr = (const f32x4*)(xs + (size_t)row * D) + lane;
        f32x4 v[4]; float ss = 0.f;
#pragma unroll
        for (int j = 0; j < 4; ++j) { v[j] = xr[64 * j]; ss += (v[j][0] * v[j][0] + v[j][1] * v[j][1]) + (v[j][2] * v[j][2] + v[j][3] * v[j][3]); }
        const float rs = 1.0f / sqrtf(wave_sum(ss) * (1.f / D) + EPS);
        const f32x4* sh = (const f32x4*)modp(F, l, mb, 3) + lane; const f32x4* sc = (const f32x4*)modp(F, l, mb, 4) + lane;
        u32x2* o8 = (u32x2*)(hb + (size_t)row * D) + lane;
        float a[32];
#pragma unroll
        for (int e = 0; e < 32; ++e) a[e] = 0.f;
#pragma unroll
        for (int j = 0; j < 4; ++j) { const f32x4 h = (v[j] * rs) * gm[64 * j] * (sc[64 * j] + 1.0f) + sh[64 * j];
            u32x2 wv; wv.x = pk2(h[0], h[1]); wv.y = pk2(h[2], h[3]); o8[64 * j] = wv;
#pragma unroll
            for (int i = 0; i < 4; ++i) { const LAS f32x4* wrow = (const LAS f32x4*)(wr + ((4 * j + i) * 64 + lane) * RT_LD);
#pragma unroll
                for (int q = 0; q < 8; ++q) { const f32x4 ww = wrow[q]; a[4 * q] += h[i] * ww[0]; a[4 * q + 1] += h[i] * ww[1]; a[4 * q + 2] += h[i] * ww[2]; a[4 * q + 3] += h[i] * ww[3]; } } }
#pragma unroll
        for (int e = 0; e < 16; ++e) { const float send = (lane & 32) ? a[e] : a[e + 16], keep = (lane & 32) ? a[e + 16] : a[e]; a[e] = keep + __shfl_xor(send, 32); }
#pragma unroll
        for (int e = 0; e < 8; ++e) { const float send = (lane & 16) ? a[e] : a[e + 8], keep = (lane & 16) ? a[e + 8] : a[e]; a[e] = keep + __shfl_xor(send, 16); }
#pragma unroll
        for (int e = 0; e < 4; ++e) { const float send = (lane & 8) ? a[e] : a[e + 4], keep = (lane & 8) ? a[e + 4] : a[e]; a[e] = keep + __shfl_xor(send, 8); }
#pragma unroll
        for (int e = 0; e < 2; ++e) { const float send = (lane & 4) ? a[e] : a[e + 2], keep = (lane & 4) ? a[e + 2] : a[e]; a[e] = keep + __shfl_xor(send, 4); }
        { const float send = (lane & 2) ? a[0] : a[1], keep = (lane & 2) ? a[1] : a[0]; a[0] = keep + __shfl_xor(send, 2); }
        const float logit = a[0] + __shfl_xor(a[0], 1) + brl;
        const int myidx = lane >> 1;
        int sel[4]; float sv[4]; unsigned used = 0u;
#pragma unroll
        for (int k = 0; k < 4; ++k) { float bv = ((used >> myidx) & 1u) ? -3.0e38f : logit; int bi = myidx;
#pragma unroll
            for (int o = 2; o < 64; o <<= 1) { const float ov = __shfl_xor(bv, o); const int oi = __shfl_xor(bi, o); const bool take = (ov > bv) || (ov == bv && oi < bi); bv = take ? ov : bv; bi = take ? oi : bi; }
            used |= 1u << bi; sel[k] = bi; sv[k] = bv; }
        const float e1 = __expf(sv[1] - sv[0]), e2 = __expf(sv[2] - sv[0]), e3 = __expf(sv[3] - sv[0]);
        const float inv = 1.0f / (1.0f + e1 + e2 + e3);
        if (lane == 0) {
            *(int4*)(tope + (size_t)row * 4) = make_int4(sel[0], sel[1], sel[2], sel[3]);
            *(float4*)(topw + (size_t)row * 4) = make_float4(inv, e1 * inv, e2 * inv, e3 * inv);
#pragma unroll
            for (int k = 0; k < 4; ++k) __hip_atomic_fetch_add((LAS int*)&cntL[sel[k]], 1, __ATOMIC_RELAXED, __HIP_MEMORY_SCOPE_WORKGROUP);
        }
    }
    __syncthreads();
    if (tid < NE) ((int*)(wsp(F) + WS_CNT))[F.vcu * NE + tid] = cntL[tid];
}

__device__ __forceinline__ void phase_positions(Frame& F, int first_row) {
    const int tid = F.tid, lane = F.lane;
    LAS int* tot = (LAS int*)F.lds;
    LAS int* bef = tot + 512;
    LAS int* baseL = bef + 512;
    LAS int* totL = baseL + 32;
    const int* cnt = (const int*)(wsp(F) + WS_CNT);
    {
        const int e = tid & 31, part = tid >> 5;
        int s = 0, sb = 0;
        for (int j = part; j < F.G; j += 16) { const int cv = cnt[j * NE + e]; s += cv; sb += (j < F.vcu) ? cv : 0; }
        tot[part * 32 + e] = s; bef[part * 32 + e] = sb;
    }
    __syncthreads();
    if (tid < NE) { int s = 0, sb = 0;
        for (int p = 0; p < 16; ++p) { s += tot[p * 32 + tid]; sb += bef[p * 32 + tid]; }
        totL[tid] = s; baseL[tid] = sb; }
    __syncthreads();
    if (tid == 0) { int acc = 0;
        for (int e = 0; e < NE; ++e) { F.LCTL[8 + e] = acc; acc += (totL[e] + 255) >> 8; }
        F.LCTL[8 + NE] = acc; F.LCTL[48] = acc; }
    __syncthreads();
    int* tokmap = (int*)(wsp(F) + WS_TOKMAP);
    if (F.vcu == 0) {
        int* meta = (int*)(wsp(F) + WS_META);
        if (tid <= NE) meta[tid] = F.LCTL[8 + tid];
        if (tid == 0) meta[33] = F.LCTL[48];
        for (int e = 0; e < NE; ++e) { const int rb = 256 * F.LCTL[8 + e], n = totL[e], cap = 256 * (F.LCTL[8 + e + 1] - F.LCTL[8 + e]);
            for (int rr = n + tid; rr < cap; rr += NTHREADS) tokmap[rb + rr] = first_row; }
    }
    if (F.wave == 0) {
        const int* tope = (const int*)(wsp(F) + WS_TOPE); int* pos = (int*)(wsp(F) + WS_POS);
        int basereg = (lane < NE) ? 256 * F.LCTL[8 + lane] + baseL[lane] : 0;
        const int nwv = F.G * NWAVES;
        const int maxn = (ROWS - first_row + nwv - 1) / nwv;
        for (int ch = 0; ch * 2 < maxn; ++ch) {
            const int ord = ch * 16 + (lane >> 2), k = lane & 3, n = ord >> 3, ww = ord & 7;
            const int row = first_row + F.vcu * NWAVES + ww + n * nwv;
            const bool valid = row < ROWS;
            const int e = valid ? tope[(size_t)row * 4 + k] : -1;
            int p = 0;
#pragma unroll 1
            for (int ee = 0; ee < NE; ++ee) {
                const unsigned long long mask = __ballot(e == ee);
                const int b0 = __shfl(basereg, ee);
                if (e == ee) p = b0 + __popcll(mask & ((1ull << lane) - 1ull));
                if (lane == ee) basereg += __popcll(mask);
            }
            if (valid) { pos[(size_t)row * 4 + k] = p; tokmap[p] = row; }
        }
    }
}

#ifndef PMASK
#define PMASK 0xFFFF
#endif
#define PE(k) (((PMASK) >> (k)) & 1)
constexpr int NPH_LAYER = 10, GP_FINAL = 1 + DEPTH * NPH_LAYER, NPHASES = GP_FINAL + 1;
__global__ void __launch_bounds__(NTHREADS, 2) mega_fwd(Args args) {
    extern __shared__ __attribute__((aligned(16))) unsigned char lds_raw[];
    Frame F0;
    Frame& F = F0;
    F.lds = (LAS unsigned char*)lds_raw;
    F.LCTL = (volatile LAS int*)(F.lds + LDS_CTL_OFF);
    F.tid = threadIdx.x; F.lane = F.tid & 63; F.wave = __builtin_amdgcn_readfirstlane(F.tid >> 6);
    F.G = gridDim.x; { const int bx = blockIdx.x; F.vcu = (F.G % 8 == 0) ? (bx % 8) * (F.G / 8) + bx / 8 : bx; }
    if (F.tid < 128) F.LCTL[F.tid] = 0;
    if (F.tid == 0) {
#pragma unroll
        for (int i = 0; i < 23; ++i) { const unsigned long long p = (unsigned long long)args.in[i]; F.LCTL[128 + 2 * i] = (int)(unsigned)p; F.LCTL[129 + 2 * i] = (int)(unsigned)(p >> 32); }
        { const unsigned long long p = (unsigned long long)args.ws; F.LCTL[128 + 46] = (int)(unsigned)p; F.LCTL[129 + 46] = (int)(unsigned)(p >> 32); }
        { const unsigned long long p = (unsigned long long)args.out; F.LCTL[128 + 48] = (int)(unsigned)p; F.LCTL[129 + 48] = (int)(unsigned)(p >> 32); }
    }
    __syncthreads();
    const int lo = args.ph_lo, hi = args.ph_hi;
    XcdBarrier bar; bar.bar = (unsigned*)(wsp(F) + WS_CTL) + CW_BAR; bar.x = 0; bar.st = nullptr;
    if (hi - lo > 1) bar = xcd_barrier_post((unsigned*)(wsp(F) + WS_CTL) + CW_BAR, (volatile LAS unsigned*)F.LCTL);
#define IN(k) (lo <= (k) && (k) < hi)
#define FRESH(FN) Frame FN = F0; { int tz_ = F0.tid, vc_ = F0.vcu, g_ = F0.G; asm volatile("" : "+v"(tz_)); asm volatile("" : "+s"(vc_), "+s"(g_)); FN.tid = tz_; FN.lane = tz_ & 63; FN.wave = __builtin_amdgcn_readfirstlane(tz_ >> 6); FN.vcu = vc_; FN.G = g_; }
#define SEAM(k) do { if (IN(k) && IN((k) + 1)) xcd_barrier(bar); } while (0)

    if (PE(0) && IN(0)) { FRESH(P); phase0(P); }
    SEAM(0);
    for (int l = 0; l < DEPTH; ++l) {
        const int base = 1 + l * NPH_LAYER; const bool na = (l & 1) == 0, last = (l == DEPTH - 1); const int jj = l >> 1;
        if (PE(1) && IN(base + 0)) { FRESH(P); phase_norm1(P, l); }
        SEAM(base + 0);
        if (PE(2) && IN(base + 1)) {
            FRESH(P);
            const int Np = na ? 3072 : ML_INP;
            const bf16_t* Bt = na ? (const bf16_t*)(wsp(P) + WS_WQKV) + (size_t)jj * 3072 * D : (const bf16_t*)(wsp(P) + WS_WIN) + (size_t)jj * ML_INP * D;
            DenseOrder S; S.init(0, ROWS / 256, Np / 256, P.G, (int)blockIdx.x, wsp(P) + WS_HB, Bt, D);
            EpiStoreBf16 E{(bf16_t*)(wsp(P) + WS_PROJ), Np};
            pg8::gemm_phase<EpiStoreBf16, DenseOrder, false>(P.lds, P.tid, D, S, E);
        }
        SEAM(base + 1);
        if (IN(base + 2)) { if (na) { if (PE(3)) { FRESH(P); phase_na_post(P, jj); } } else { if (PE(4)) { FRESH(P); phase_ml_post(P, jj); } } }
        SEAM(base + 2);
        if (IN(base + 3)) { if (na) { if (PE(5)) { FRESH(P); phase_na_attn(P, jj); } } else { if (PE(6)) { FRESH(P); phase_ml_scan(P); } } }
        SEAM(base + 3);
        if (PE(7) && IN(base + 4)) { if (!na) { FRESH(P); phase_ml_final(P, jj); } }
        if (!na) SEAM(base + 4);
        if (PE(8) && IN(base + 5)) {
            FRESH(P);
            const bf16_t* Bt = na ? (const bf16_t*)(wsp(P) + WS_WONA) + (size_t)jj * D * D : (const bf16_t*)(wsp(P) + WS_WOML) + (size_t)jj * D * D;
            DenseOrder S; S.init(last ? ROWS_CTX / 256 : 0, last ? (ROWS - ROWS_CTX) / 256 : ROWS / 256, D / 256, P.G, (int)blockIdx.x, wsp(P) + WS_AO, Bt, D);
            EpiResid E{(float*)(wsp(P) + WS_XS), (const float*)(wsp(P) + WS_MOD) + (size_t)l * 9 * 6144 + 2 * D};
            pg8::gemm_phase<EpiResid, DenseOrder, false>(P.lds, P.tid, D, S, E);
        }
        SEAM(base + 5);
        if (PE(9) && IN(base + 6)) { FRESH(P); phase_norm2_router(P, l, last ? ROWS_CTX : 0); }
        SEAM(base + 6);
        if (PE(10) && IN(base + 7)) { FRESH(P); phase_positions(P, last ? ROWS_CTX : 0); }
        SEAM(base + 7);
        if (PE(11) && IN(base + 8)) {
            FRESH(P);
            if (P.tid < 34) P.LCTL[8 + P.tid] = ((const int*)(wsp(P) + WS_META))[P.tid];
            __syncthreads();
            const int ntiles = P.LCTL[8 + NE];
            MoeOrder S; S.NT = 8; S.nunits = ntiles * 8; S.G = P.G; S.c = (int)blockIdx.x; S.K = D; S.A = (const char*)(wsp(P) + WS_HB);
            S.W = (const char*)(wsp(P) + WS_W1T) + (size_t)l * NE * 2048 * D * 2; S.estride = (size_t)2048 * D * 2; S.tokmap = (const int*)(wsp(P) + WS_TOKMAP); S.prefix = P.LCTL + 8; S.gather = true;
            EpiSwiglu E{(bf16_t*)(wsp(P) + WS_ACT), inp(P, I_B1) + (size_t)l * NE * 2048};
            pg8::gemm_phase<EpiSwiglu, MoeOrder, true>(P.lds, P.tid, D, S, E);
        }
        SEAM(base + 8);
        if (PE(12) && IN(base + 9)) {
            FRESH(P);
            if (P.tid < 34) P.LCTL[8 + P.tid] = ((const int*)(wsp(P) + WS_META))[P.tid];
            __syncthreads();
            const int ntiles = P.LCTL[8 + NE];
            MoeOrder S; S.NT = 4; S.nunits = ntiles * 4; S.G = P.G; S.c = (int)blockIdx.x; S.K = D; S.A = (const char*)(wsp(P) + WS_ACT);
            S.W = (const char*)(wsp(P) + WS_W2T) + (size_t)l * NE * D * D * 2; S.estride = (size_t)D * D * 2; S.tokmap = (const int*)(wsp(P) + WS_TOKMAP); S.prefix = P.LCTL + 8; S.gather = false;
            EpiY E{(bf16_t*)(wsp(P) + WS_Y), inp(P, I_B2) + (size_t)l * NE * D};
            pg8::gemm_phase<EpiY, MoeOrder, false>(P.lds, P.tid, D, S, E);
        }
        SEAM(base + 9);
    }
    if (PE(13) && IN(GP_FINAL)) { FRESH(P); phase_final(P); }
#undef IN
#undef SEAM
}

extern "C" void kernel_launch(void* const* d_in, const int* in_sizes, int n_in, void* d_out, int out_size, void* d_ws, size_t ws_size, hipStream_t stream) {
    static int grid = 0;
    if (grid == 0) {
        if (n_in != 23 || ws_size < WS_END) { fprintf(stderr, "kernel_launch: expected 23 inputs and >= %zu bytes of workspace (got %d, %zu)\n", (size_t)WS_END, n_in, ws_size); grid = -1; return; }
        int dev = 0, cus = 0, per_cu = 0;
        if (hipGetDevice(&dev) != hipSuccess || hipDeviceGetAttribute(&cus, hipDeviceAttributeMultiprocessorCount, dev) != hipSuccess) { grid = -1; return; }
        if (hipFuncSetAttribute((const void*)mega_fwd, hipFuncAttributeMaxDynamicSharedMemorySize, LDS_BYTES) != hipSuccess) { fprintf(stderr, "kernel_launch: hipFuncSetAttribute failed\n"); grid = -1; return; }
        if (hipOccupancyMaxActiveBlocksPerMultiprocessor(&per_cu, (const void*)mega_fwd, NTHREADS, LDS_BYTES) != hipSuccess || per_cu < 1)
            fprintf(stderr, "kernel_launch: occupancy query reports %d workgroups per CU\n", per_cu);
        (void)hipGetLastError();
        grid = cus;
        if (grid > 1024) grid = 1024;
    }
    if (grid < 0) return;
    (void)hipMemsetAsync((char*)d_ws + WS_CTL, 0, CTL_BYTES, stream);
    Args a{};
    for (int i = 0; i < 23; ++i) a.in[i] = (const float*)d_in[i];
    a.out = (float*)d_out; a.ws = (unsigned char*)d_ws;
#if MK_ONE_LAUNCH
    a.ph_lo = 0; a.ph_hi = NPHASES;
    hipLaunchKernelGGL(mega_fwd, dim3(grid), dim3(NTHREADS), LDS_BYTES, stream, a);
#else
    for (int gp = 0; gp < NPHASES; ++gp) {
        if (gp >= 1 && gp < GP_FINAL) { const int l = (gp - 1) / NPH_LAYER, p = (gp - 1) % NPH_LAYER; if (p == 4 && (l & 1) == 0) continue; }
        a.ph_lo = gp; a.ph_hi = gp + 1;
        hipLaunchKernelGGL(mega_fwd, dim3(grid), dim3(NTHREADS), LDS_BYTES, stream, a);
    }
#endif
    const hipError_t le = hipPeekAtLastError();
    if (le != hipSuccess) fprintf(stderr, "kernel_launch: launch failed: %s\n", hipGetErrorName(le));
}
```

```cpp
#include <hip/hip_runtime.h>
#include <cstdio>
#include <cstdint>

#ifndef MK_ONE_LAUNCH
#define MK_ONE_LAUNCH 1
#endif

#define LAS __attribute__((address_space(3)))
#define GAS __attribute__((address_space(1)))
typedef unsigned short bf16_t;
typedef short bf16x8 __attribute__((ext_vector_type(8)));
typedef short bf16x4 __attribute__((ext_vector_type(4)));
typedef float f32x4 __attribute__((ext_vector_type(4)));
typedef float f32x2 __attribute__((ext_vector_type(2)));
typedef unsigned u32x4 __attribute__((ext_vector_type(4)));
typedef unsigned u32x2 __attribute__((ext_vector_type(2)));

constexpr int D = 1024, NB = 8, SEQ = 4096, NCTX = 256, TT = NCTX + SEQ  , DEPTH = 4;
constexpr int ROWS_CTX = NB * NCTX  , ROWS = ROWS_CTX + NB * SEQ  ;
constexpr int NH_NA = 16, DH_NA = 64;
constexpr int NH_ML = 8, DV_ML = 128, DK_ML = 64, ML_IN = 3104, ML_INP = 3328;
constexpr int NE = 32, TOPK = 4, DFF = 1024;
constexpr int MAXTILES = (ROWS * TOPK) / 256 + NE  , MAXROWS = MAXTILES * 256;
constexpr float EPS = 1e-6f;
constexpr int NWAVES = 8, NTHREADS = 512;

constexpr size_t MiB = 1u << 20;
constexpr size_t al256(size_t x) { return (x + 255) & ~(size_t)255; }
constexpr size_t WS_CTL = 0, CTL_BYTES = 1 * MiB;
constexpr size_t WS_MOD = WS_CTL + CTL_BYTES;
constexpr size_t WS_ROPE = WS_MOD + al256((size_t)DEPTH * 9 * 6 * D * 4);
constexpr size_t WS_WQKV = WS_ROPE + al256(64 * 16 * 2 * 4);
constexpr size_t WS_WONA = WS_WQKV + (size_t)2 * 3072 * D * 2;
constexpr size_t WS_WIN = WS_WONA + (size_t)2 * D * D * 2;
constexpr size_t WS_WOML = WS_WIN + (size_t)2 * ML_INP * D * 2;
constexpr size_t WS_W1T = WS_WOML + (size_t)2 * D * D * 2;
constexpr size_t WS_W2T = WS_W1T + (size_t)DEPTH * NE * 2048 * D * 2;
constexpr size_t WS_XS = WS_W2T + (size_t)DEPTH * NE * D * D * 2;
constexpr size_t WS_HB = WS_XS + (size_t)ROWS * D * 4;
constexpr size_t WS_PROJ = WS_HB + (size_t)ROWS * D * 2;
constexpr size_t WS_QN = WS_PROJ + (size_t)ROWS * ML_INP * 2;
constexpr size_t WS_KN = WS_QN + (size_t)ROWS * D * 2;
constexpr size_t WS_VT = WS_KN + (size_t)ROWS * D * 2;
constexpr size_t WS_AO = WS_VT + (size_t)ROWS * D * 2;
constexpr size_t WS_HDIR = WS_QN;
constexpr size_t WS_GATES = WS_AO + (size_t)ROWS * D * 2;
constexpr size_t WS_TOPE = WS_GATES + al256((size_t)4 * NB * NH_ML * TT * 4);
constexpr size_t WS_TOPW = WS_TOPE + (size_t)ROWS * 4 * 4;
constexpr size_t WS_POS = WS_TOPW + (size_t)ROWS * 4 * 4;
constexpr size_t WS_TOKMAP = WS_POS + (size_t)ROWS * 4 * 4;
constexpr size_t WS_CNT = WS_TOKMAP + (size_t)MAXROWS * 4;
constexpr size_t WS_META = WS_CNT + (size_t)1024 * 32 * 4;
constexpr size_t WS_ACT = WS_META + 256;
constexpr size_t WS_Y = WS_ACT + (size_t)MAXROWS * D * 2;
constexpr size_t WS_END = WS_Y + (size_t)MAXROWS * D * 2;
static_assert(WS_XS % 256 == 0 && WS_ACT % 256 == 0 && WS_TOPE % 256 == 0, "ws alignment");

constexpr int CW_BAR = 4096;

constexpr int LDS_BYTES = 160 * 1024;
constexpr int LDS_CTL_OFF = LDS_BYTES - 1024;
constexpr int LDS_WORK = LDS_CTL_OFF;

#define LDS_WAIT() asm volatile("s_waitcnt lgkmcnt(0)" ::: "memory")
#define VM_WAIT() asm volatile("s_waitcnt vmcnt(0)" ::: "memory")
__device__ __forceinline__ unsigned f2bf(float f) { unsigned u = __builtin_bit_cast(unsigned, f); return (u + 0x7fffu + ((u >> 16) & 1u)) >> 16; }
__device__ __forceinline__ unsigned pk2(float lo, float hi) { unsigned r; asm volatile("v_cvt_pk_bf16_f32 %0, %1, %2" : "=v"(r) : "v"(lo), "v"(hi)); return r; }
__device__ __forceinline__ float bf2f(unsigned short b) { return __builtin_bit_cast(float, ((unsigned)b) << 16); }
__device__ __forceinline__ float bflo(unsigned w) { return __builtin_bit_cast(float, w << 16); }
__device__ __forceinline__ float bfhi(unsigned w) { return __builtin_bit_cast(float, w & 0xffff0000u); }
__device__ __forceinline__ float wave_sum(float v) {
#pragma unroll
    for (int o = 1; o < 64; o <<= 1) v += __shfl_xor(v, o);
    return v;
}
__device__ __forceinline__ float wave_max(float v) {
#pragma unroll
    for (int o = 1; o < 64; o <<= 1) v = fmaxf(v, __shfl_xor(v, o));
    return v;
}
__device__ __forceinline__ float sigmoidf_(float x) { return 1.f / (1.f + __expf(-x)); }

namespace pg8 {
constexpr int BM = 256, BK = 64, HALF = 128, HTB = HALF * BK * 2  , STAGE_BYTES = 8 * HTB;
__host__ __device__ __forceinline__ int lds_byte(int r, int c) { const int st = (r >> 4) * 2 + (c >> 5), rr = r & 15, cc = c & 31, ob = rr * 64 + cc * 2; return st * 1024 + (ob ^ (((ob >> 9) & 1) << 5)); }
__host__ __device__ __forceinline__ void stage_rc(int b, int& R, int& C) { const int st = b / 1024, sb = b % 1024, swz = sb ^ (((sb >> 9) & 1) << 5); R = (st >> 1) * 16 + swz / 64; C = (st & 1) * 32 + (swz % 64) / 2; }
__host__ __device__ __forceinline__ int perm32(int rho) { const int n = rho >> 4, i = rho & 15; return 8 * (i >> 2) + 4 * n + (i & 3); }

struct Unit { int pm, pn, e; };

__device__ __forceinline__ unsigned cvt_pk_bf16(float lo, float hi) { unsigned r; asm volatile("v_cvt_pk_bf16_f32 %0, %1, %2" : "=v"(r) : "v"(lo), "v"(hi)); return r; }

template <class Epi, class Sched, bool GATHER>
__device__ __forceinline__ void gemm_phase(LAS unsigned char* lds, const int tid, const int K, const Sched& S, const Epi& E) {
    const int wid = __builtin_amdgcn_readfirstlane(tid >> 6), lane = tid & 63, wr = wid >> 2, wc = wid & 3, fr = lane & 15, fq = lane >> 4;
    const int nt = K / BK;
    int RA[2], CA[2];
    unsigned voffB[2], voffA[2][2];
#pragma unroll
    for (int i = 0; i < 2; ++i) { int R, C; stage_rc(tid * 16 + i * 8192, R, C); const int Rb = Epi::PERM ? ((R & ~31) + perm32(R & 31)) : R;
        RA[i] = R; CA[i] = C; voffB[i] = (unsigned)(Rb * K + C) * 2u; }
    const size_t kstep = (size_t)(BK * 2);
    const size_t hstep = (size_t)HALF * K * 2;
    const unsigned ldsw = (unsigned)wid * 1024u;
    const int aoff = lds_byte(wr * 64 + fr, fq * 8), boff = lds_byte(wc * 32 + fr, fq * 8);
#define PG8_SA(b, h) (((b) * 2 + (h)) * HTB)
#define PG8_SB(b, h) ((4 + (b) * 2 + (h)) * HTB)
#define PG8_STAGE(bufoff, gbase, voff) do { _Pragma("unroll") for (int _i = 0; _i < 2; ++_i) \
        __builtin_amdgcn_global_load_lds((const unsigned*)((const char*)(gbase) + (voff)[_i]), (LAS unsigned*)(lds + (bufoff) + ldsw + _i * 8192), 16, 0, 0); } while (0)
#define PG8_LDA(dst, b, h) do { _Pragma("unroll") for (int m = 0; m < 4; ++m) _Pragma("unroll") for (int k = 0; k < 2; ++k) dst[m][k] = *(const LAS bf16x8*)(lds + PG8_SA(b, h) + aoff + m * 2048 + k * 1024); } while (0)
#define PG8_LDB(dst, b, h) do { _Pragma("unroll") for (int n = 0; n < 2; ++n) _Pragma("unroll") for (int k = 0; k < 2; ++k) dst[n][k] = *(const LAS bf16x8*)(lds + PG8_SB(b, h) + boff + n * 2048 + k * 1024); } while (0)
#define PG8_MMA(ai, bj, At, Bt) do { __builtin_amdgcn_s_setprio(1); _Pragma("unroll") for (int m = 0; m < 4; ++m) _Pragma("unroll") for (int n = 0; n < 2; ++n) _Pragma("unroll") for (int k = 0; k < 2; ++k) \
        acc[ai][bj][m][n] = __builtin_amdgcn_mfma_f32_16x16x32_bf16(Bt[n][k], At[m][k], acc[ai][bj][m][n], 0, 0, 0); __builtin_amdgcn_s_setprio(0); } while (0)
#define PG8_WAIT_V(n) asm volatile("s_waitcnt vmcnt(" #n ")" ::: "memory")
#define PG8_WAIT_L(n) asm volatile("s_waitcnt lgkmcnt(" #n ")" ::: "memory")
#define PG8_BAR __builtin_amdgcn_s_barrier()
#define PG8_SCHED __builtin_amdgcn_sched_barrier(0)
#define PG8_SETVOFF(u) do { _Pragma("unroll") for (int _h = 0; _h < 2; ++_h) _Pragma("unroll") for (int _i = 0; _i < 2; ++_i) { \
        if constexpr (GATHER) voffA[_h][_i] = ((unsigned)S.a_row(u, _h * HALF + RA[_i]) * (unsigned)K + (unsigned)CA[_i]) * 2u; \
        else voffA[_h][_i] = ((unsigned)(_h * HALF + RA[_i]) * (unsigned)K + (unsigned)CA[_i]) * 2u; } } while (0)
    Unit cur, nxt; int ui = 0;
    if (!S.next(0, cur)) return;
    f32x4 acc[2][2][4][2];
#pragma unroll
    for (int a = 0; a < 2; ++a)
#pragma unroll
        for (int b = 0; b < 2; ++b)
#pragma unroll
            for (int m = 0; m < 4; ++m)
#pragma unroll
                for (int n = 0; n < 2; ++n) acc[a][b][m][n] = (f32x4){0.f, 0.f, 0.f, 0.f};
    bf16x8 At[4][2], B0[2][2], B1[2][2];
    const char* cA = S.a_base(cur); const char* cB = S.b_base(cur);
    PG8_SETVOFF(cur);
    PG8_STAGE(PG8_SB(0, 0), cB, voffB); PG8_STAGE(PG8_SB(0, 1), cB + hstep, voffB); PG8_STAGE(PG8_SA(0, 0), cA, voffA[0]); PG8_STAGE(PG8_SA(0, 1), cA, voffA[1]);
    if (wr == 1) PG8_BAR;
    PG8_WAIT_V(2); PG8_BAR;
    PG8_STAGE(PG8_SB(1, 0), cB + kstep, voffB); PG8_STAGE(PG8_SA(1, 0), cA + kstep, voffA[0]); PG8_STAGE(PG8_SB(1, 1), cB + hstep + kstep, voffB);
    PG8_WAIT_V(6); PG8_BAR;
    for (;;) {
        const bool has_next = S.next(ui + 1, nxt);
        const char* nA = has_next ? S.a_base(nxt) : cA; const char* nB = has_next ? S.b_base(nxt) : cB;
        for (int t = 0; t < nt; t += 2) {
            const bool last = (t == nt - 2);
            const char* a1 = cA + (size_t)(t + 1) * kstep;
            const char* a2 = last ? nA : cA + (size_t)(t + 2) * kstep; const char* b2 = last ? nB : cB + (size_t)(t + 2) * kstep;
            const char* a3 = a2 + kstep; const char* b3 = b2 + kstep;
            PG8_LDB(B0, 0, 0); PG8_LDB(B1, 0, 1); PG8_SCHED; PG8_LDA(At, 0, 0); PG8_STAGE(PG8_SA(1, 1), a1, voffA[1]);
            if constexpr (GATHER) { if (last && has_next) PG8_SETVOFF(nxt); }
            PG8_WAIT_V(8); PG8_WAIT_L(0); PG8_BAR; PG8_MMA(0, 0, At, B0); PG8_MMA(0, 1, At, B1); PG8_BAR; PG8_SCHED;
            PG8_LDA(At, 0, 1); PG8_STAGE(PG8_SB(0, 0), b2, voffB); PG8_STAGE(PG8_SB(0, 1), b2 + hstep, voffB); PG8_STAGE(PG8_SA(0, 0), a2, voffA[0]);
            PG8_WAIT_V(8); PG8_WAIT_L(0); PG8_BAR; PG8_MMA(1, 0, At, B0); PG8_MMA(1, 1, At, B1); PG8_BAR; PG8_SCHED;
            PG8_LDB(B0, 1, 0); PG8_LDB(B1, 1, 1); PG8_SCHED; PG8_LDA(At, 1, 0); PG8_STAGE(PG8_SA(0, 1), a2, voffA[1]);
            PG8_WAIT_V(8); PG8_WAIT_L(0); PG8_BAR; PG8_MMA(0, 0, At, B0); PG8_MMA(0, 1, At, B1); PG8_BAR; PG8_SCHED;
            PG8_LDA(At, 1, 1); PG8_STAGE(PG8_SB(1, 0), b3, voffB); PG8_STAGE(PG8_SB(1, 1), b3 + hstep, voffB); PG8_STAGE(PG8_SA(1, 0), a3, voffA[0]);
            PG8_WAIT_V(8); PG8_WAIT_L(0); PG8_BAR; PG8_MMA(1, 0, At, B0); PG8_MMA(1, 1, At, B1); PG8_BAR; PG8_SCHED;
        }
        if (wr == 0) PG8_BAR;
        E(acc, cur, wr, wc, fr, fq);
        if (!has_next) break;
#pragma unroll
        for (int a = 0; a < 2; ++a)
#pragma unroll
            for (int b = 0; b < 2; ++b)
#pragma unroll
                for (int m = 0; m < 4; ++m)
#pragma unroll
                    for (int n = 0; n < 2; ++n) acc[a][b][m][n] = (f32x4){0.f, 0.f, 0.f, 0.f};
        cur = nxt; cA = nA; cB = nB; ++ui;
        if (wr == 1) PG8_BAR;
    }
    PG8_WAIT_V(0);
    PG8_BAR;
#undef PG8_SA
#undef PG8_SB
#undef PG8_STAGE
#undef PG8_LDA
#undef PG8_LDB
#undef PG8_MMA
#undef PG8_WAIT_V
#undef PG8_WAIT_L
#undef PG8_BAR
#undef PG8_SCHED
#undef PG8_SETVOFF
}
}

#define XB_TMO      128
#define XB_XCNT(j)  (256  + 64 * (j))
#define XB_XSUB(j)  (1280 + 64 * (j))
#define XB_XGEN(j)  (2304 + 64 * (j))
#define XB_TOP      3328
#define XB_TOPGEN   3392
#define XCD_BAR_WORDS 3456
#define XB_SPIN_CAP (1u << 18)

__device__ __forceinline__ unsigned xb_ld(unsigned* p)              { return __hip_atomic_load(p, __ATOMIC_RELAXED, __HIP_MEMORY_SCOPE_AGENT); }
__device__ __forceinline__ unsigned xb_add(unsigned* p, unsigned v) { return __hip_atomic_fetch_add(p, v, __ATOMIC_RELAXED, __HIP_MEMORY_SCOPE_AGENT); }
__device__ __forceinline__ unsigned xb_xcc_id() { return (unsigned)__builtin_amdgcn_s_getreg((3 << 11) | 20) & 0xFu; }
#define XB_SPIN(cond, bar) do { unsigned _sp = 0; while (cond) { __builtin_amdgcn_s_sleep(1); \
    if ((++_sp & 255u) == 0u) { if (xb_ld(&(bar)[XB_TMO])) break; if (_sp > XB_SPIN_CAP) { atomicAdd(&(bar)[XB_TMO], 1u); break; } } } } while (0)

struct XcdBarrier {
    unsigned* bar; unsigned x;
    volatile LAS unsigned* st;
};

__device__ __forceinline__ XcdBarrier xcd_barrier_post(unsigned* bar, volatile LAS unsigned* st) {
    XcdBarrier b; b.bar = bar; b.x = xb_xcc_id(); b.st = st;
    if (threadIdx.x == 0) (void)xb_add(&bar[XB_XCNT(b.x)], 1u);
    return b;
}
__device__ __forceinline__ void xcd_barrier_complete(unsigned* bar, unsigned x, unsigned& nloc, unsigned& nx) {
    const unsigned G = gridDim.x * gridDim.y * gridDim.z;
    unsigned sum, cnt, mine, sp = 0u;
    for (;;) {
        sum = 0u; cnt = 0u; mine = 0u;
#pragma unroll
        for (unsigned j = 0; j < 16; ++j) { const unsigned c = xb_ld(&bar[XB_XCNT(j)]); sum += c; cnt += (c > 0u) ? 1u : 0u; mine = (j == x) ? c : mine; }
        if (sum == G) break;
        __builtin_amdgcn_s_sleep(1);
        if ((++sp & 255u) == 0u) { if (xb_ld(&bar[XB_TMO])) break; if (sp > XB_SPIN_CAP) { atomicAdd(&bar[XB_TMO], 1u); break; } }
    }
    nloc = mine > 0u ? mine : 1u; nx = cnt > 0u ? cnt : 1u;
}

__device__ __forceinline__ void xcd_barrier(const XcdBarrier& b) {
    asm volatile("s_waitcnt vmcnt(0)" ::: "memory");
    __syncthreads();
    if (threadIdx.x == 0) {
        unsigned* bar = b.bar;
        __builtin_amdgcn_s_waitcnt(0);
        unsigned nloc = b.st[0], nx = b.st[1];
        if (nloc == 0u) { xcd_barrier_complete(bar, b.x, nloc, nx); b.st[0] = nloc; b.st[1] = nx; }
        const unsigned old = xb_add(&bar[XB_XSUB(b.x)], 1u);
        const unsigned gen = old / nloc;
        if (old + 1u == (gen + 1u) * nloc) {
            __builtin_amdgcn_fence(__ATOMIC_RELEASE, "agent");
            asm volatile("s_waitcnt vmcnt(0)" ::: "memory");
            const unsigned og = xb_add(&bar[XB_TOP], 1u);
            const unsigned tg = og / nx;
            if (og + 1u == (tg + 1u) * nx) xb_add(&bar[XB_TOPGEN], 1u);
            else XB_SPIN(xb_ld(&bar[XB_TOPGEN]) == tg, bar);
            __builtin_amdgcn_fence(__ATOMIC_ACQUIRE, "agent");
            xb_add(&bar[XB_XGEN(b.x)], 1u);
            asm volatile("s_waitcnt vmcnt(0)" ::: "memory");
        } else {
            XB_SPIN(xb_ld(&bar[XB_XGEN(b.x)]) == gen, bar);
            __builtin_amdgcn_fence(__ATOMIC_ACQUIRE, "agent");
            asm volatile("s_waitcnt vmcnt(0)" ::: "memory");
        }
    }
    __syncthreads();
}

struct Args { const float* in[23]; float* out; unsigned char* ws; int ph_lo, ph_hi; };
struct Frame {
    LAS unsigned char* lds;
    volatile LAS int* LCTL;
    int tid, lane, wave, vcu, G;
};
__device__ __forceinline__ unsigned long long ptr_get(const Frame& F, int i) {
    const unsigned lo = (unsigned)F.LCTL[128 + 2 * i], hi = (unsigned)F.LCTL[129 + 2 * i];
    return ((unsigned long long)(unsigned)__builtin_amdgcn_readfirstlane((int)hi) << 32) | (unsigned long long)(unsigned)__builtin_amdgcn_readfirstlane((int)lo);
}
__device__ __forceinline__ const float* inp(const Frame& F, int i) { return (const float*)ptr_get(F, i); }
__device__ __forceinline__ unsigned char* wsp(const Frame& F) { return (unsigned char*)ptr_get(F, 23); }
__device__ __forceinline__ float* outp(const Frame& F) { return (float*)ptr_get(F, 24); }
enum { I_X = 0, I_C, I_CTX, I_CCTX, I_WADA, I_BADA, I_GMIX, I_GFFN, I_WQKV, I_QGAIN, I_KGAIN, I_RPB, I_WONA, I_WIN, I_BGATE, I_MHGAIN, I_WOML,
       I_WR, I_BR, I_W1, I_B1, I_W2, I_B2 };

struct DenseOrder {
    int nM, nN, nwg, G, c, pm0, K; const char* A; const char* Bt;
    __device__ __forceinline__ void init(int pm0_, int nM_, int nN_, int G_, int c_, const void* A_, const void* Bt_, int K_) { pm0 = pm0_; nM = nM_; nN = nN_; nwg = nM * nN; G = G_; c = c_; A = (const char*)A_; Bt = (const char*)Bt_; K = K_; }
    __device__ __forceinline__ bool next(int i, pg8::Unit& u) const {
        const long L = (long)i * G + c; if (L >= nwg) return false;
        int wgid = (int)L; { const int q = nwg / 8, r = nwg % 8, xcd = wgid % 8, off = wgid / 8; wgid = (xcd < r ? xcd * (q + 1) : r * (q + 1) + (xcd - r) * q) + off; }
        const int nig = 8 * nN, gid = wgid / nig, fm = gid * 8, gsz = (nM - fm) < 8 ? (nM - fm) : 8;
        u.pm = pm0 + fm + ((wgid % nig) % gsz); u.pn = (wgid % nig) / gsz; u.e = 0; return true;
    }
    __device__ __forceinline__ const char* a_base(const pg8::Unit& u) const { return A + (size_t)u.pm * 256 * K * 2; }
    __device__ __forceinline__ const char* b_base(const pg8::Unit& u) const { return Bt + (size_t)u.pn * 256 * K * 2; }
    __device__ __forceinline__ int a_row(const pg8::Unit&, int) const { return 0; }
};
struct MoeOrder {
    int NT, nunits, G, c, K; const char* A; const char* W; size_t estride; const int* tokmap; volatile LAS int* prefix; bool gather;
    __device__ __forceinline__ bool next(int i, pg8::Unit& u) const {
        const long L = (long)i * G + c; if (L >= nunits) return false;
        int wgid = (int)L; { const int q = nunits / 8, r = nunits % 8, xcd = wgid % 8, off = wgid / 8; wgid = (xcd < r ? xcd * (q + 1) : r * (q + 1) + (xcd - r) * q) + off; }
        const int tile = wgid / NT; u.pm = tile; u.pn = wgid - tile * NT;
        int e = 0;
#pragma unroll 1
        for (int j = 1; j < NE; ++j) e += (prefix[j] <= tile) ? 1 : 0;
        u.e = e; return true;
    }
    __device__ __forceinline__ const char* a_base(const pg8::Unit& u) const { return gather ? A : A + (size_t)u.pm * 256 * K * 2; }
    __device__ __forceinline__ const char* b_base(const pg8::Unit& u) const { return W + (size_t)u.e * estride + (size_t)u.pn * 256 * K * 2; }
    __device__ __forceinline__ int a_row(const pg8::Unit& u, int r) const { return tokmap[u.pm * 256 + r]; }
};

typedef f32x4 AccT[2][2][4][2];
struct EpiStoreBf16 {
    static constexpr bool PERM = true;
    bf16_t* O; int ldc;
    __device__ __forceinline__ void operator()(const AccT& acc, const pg8::Unit& u, int wr, int wc, int fr, int fq) const {
        const int row0 = u.pm * 256 + wr * 64 + fr, col0 = u.pn * 256 + wc * 32 + 8 * fq;
#pragma unroll
        for (int ai = 0; ai < 2; ++ai)
#pragma unroll
            for (int m = 0; m < 4; ++m) { bf16_t* rowp = O + (size_t)(row0 + ai * 128 + m * 16) * ldc + col0;
#pragma unroll
                for (int bj = 0; bj < 2; ++bj) { const f32x4 v0 = acc[ai][bj][m][0], v1 = acc[ai][bj][m][1];
                    u32x4 w; w.x = pg8::cvt_pk_bf16(v0[0], v0[1]); w.y = pg8::cvt_pk_bf16(v0[2], v0[3]); w.z = pg8::cvt_pk_bf16(v1[0], v1[1]); w.w = pg8::cvt_pk_bf16(v1[2], v1[3]);
                    *(u32x4*)(rowp + bj * 128) = w; } }
    }
};
struct EpiY {
    static constexpr bool PERM = true;
    bf16_t* O; const float* b2;
    __device__ __forceinline__ void operator()(const AccT& acc, const pg8::Unit& u, int wr, int wc, int fr, int fq) const {
        const int row0 = u.pm * 256 + wr * 64 + fr, col0 = u.pn * 256 + wc * 32 + 8 * fq;
        const float* bp = b2 + (size_t)u.e * D + col0;
        f32x4 bv[2][2];
#pragma unroll
        for (int bj = 0; bj < 2; ++bj)
#pragma unroll
            for (int n = 0; n < 2; ++n) bv[bj][n] = *(const f32x4*)(bp + bj * 128 + 4 * n);
#pragma unroll
        for (int ai = 0; ai < 2; ++ai)
#pragma unroll
            for (int m = 0; m < 4; ++m) { bf16_t* rowp = O + (size_t)(row0 + ai * 128 + m * 16) * D + col0;
#pragma unroll
                for (int bj = 0; bj < 2; ++bj) { const f32x4 v0 = acc[ai][bj][m][0] + bv[bj][0], v1 = acc[ai][bj][m][1] + bv[bj][1];
                    u32x4 w; w.x = pg8::cvt_pk_bf16(v0[0], v0[1]); w.y = pg8::cvt_pk_bf16(v0[2], v0[3]); w.z = pg8::cvt_pk_bf16(v1[0], v1[1]); w.w = pg8::cvt_pk_bf16(v1[2], v1[3]);
                    *(u32x4*)(rowp + bj * 128) = w; } }
    }
};
struct EpiSwiglu {
    static constexpr bool PERM = true;
    bf16_t* O; const float* b1;
    __device__ __forceinline__ void operator()(const AccT& acc, const pg8::Unit& u, int wr, int wc, int fr, int fq) const {
        const int row0 = u.pm * 256 + wr * 64 + fr, cc0 = u.pn * 128 + wc * 32 + 8 * fq;
        const float* bp = b1 + (size_t)u.e * 2048 + cc0;
        f32x4 bg[2], bl[2];
#pragma unroll
        for (int n = 0; n < 2; ++n) { bg[n] = *(const f32x4*)(bp + 4 * n); bl[n] = *(const f32x4*)(bp + 1024 + 4 * n); }
#pragma unroll
        for (int ai = 0; ai < 2; ++ai)
#pragma unroll
            for (int m = 0; m < 4; ++m) { bf16_t* rowp = O + (size_t)(row0 + ai * 128 + m * 16) * D + cc0;
                float o[8];
#pragma unroll
                for (int n = 0; n < 2; ++n) { const f32x4 gl = acc[ai][0][m][n] + bg[n], li = acc[ai][1][m][n] + bl[n];
#pragma unroll
                    for (int j = 0; j < 4; ++j) { const float g = fminf(gl[j], 7.0f), l = fminf(fmaxf(li[j], -7.0f), 7.0f);
                        o[4 * n + j] = g * sigmoidf_(1.702f * g) * (l + 1.0f); } }
                u32x4 w; w.x = pg8::cvt_pk_bf16(o[0], o[1]); w.y = pg8::cvt_pk_bf16(o[2], o[3]); w.z = pg8::cvt_pk_bf16(o[4], o[5]); w.w = pg8::cvt_pk_bf16(o[6], o[7]);
                *(u32x4*)rowp = w; }
    }
};
struct EpiResid {
    static constexpr bool PERM = false;
    float* xs; const float* g;
    __device__ __forceinline__ void operator()(const AccT& acc, const pg8::Unit& u, int wr, int wc, int fr, int fq) const {
        const int row0 = u.pm * 256 + wr * 64 + fr, col0 = u.pn * 256 + wc * 32 + 4 * fq;
        const int mb = u.pm < 8 ? 8 : ((u.pm - 8) >> 4);
        const float* gp = g + (size_t)mb * 6144 + col0;
        f32x4 gv[2][2];
#pragma unroll
        for (int bj = 0; bj < 2; ++bj)
#pragma unroll
            for (int n = 0; n < 2; ++n) gv[bj][n] = *(const f32x4*)(gp + bj * 128 + n * 16);
#pragma unroll
        for (int ai = 0; ai < 2; ++ai)
#pragma unroll
            for (int m = 0; m < 4; ++m) { float* rowp = xs + (size_t)(row0 + ai * 128 + m * 16) * D + col0;
#pragma unroll
                for (int bj = 0; bj < 2; ++bj)
#pragma unroll
                    for (int n = 0; n < 2; ++n) { f32x4* p = (f32x4*)(rowp + bj * 128 + n * 16); *p = *p + gv[bj][n] * acc[ai][bj][m][n]; } }
    }
};

__device__ __forceinline__ const float* modp(const Frame& F, int l, int mb, int chunk) { return (const float*)(wsp(F) + WS_MOD) + ((size_t)(l * 9 + mb) * 6 + chunk) * D; }
__device__ __forceinline__ int row_mb(int row) { return row < ROWS_CTX ? 8 : ((row - ROWS_CTX) >> 12); }

__device__ __forceinline__ void transpose_item(const float* W, int N, int Nvalid, bf16_t* WT, int k0, int n0, LAS float* scr, int lane) {
    const int nn = 4 * (lane & 15);
    const bool ok = (n0 + nn) < Nvalid;
    f32x4 v[16];
#pragma unroll
    for (int i = 0; i < 16; ++i) { const int kk = 4 * i + (lane >> 4);
        v[i] = ok ? *(const f32x4*)(W + (size_t)(k0 + kk) * N + n0 + nn) : (f32x4){0.f, 0.f, 0.f, 0.f}; }
#pragma unroll
    for (int i = 0; i < 16; ++i) { const int kk = 4 * i + (lane >> 4); LAS float* s = scr + kk * 65 + nn;
        s[0] = v[i][0]; s[1] = v[i][1]; s[2] = v[i][2]; s[3] = v[i][3]; }
    LDS_WAIT(); asm volatile("" ::: "memory");
    const int c = lane & 7;
#pragma unroll
    for (int j = 0; j < 8; ++j) { const int n = (lane >> 3) + 8 * j; const LAS float* s = scr + (8 * c) * 65 + n;
        u32x4 o; o.x = pk2(s[0 * 65], s[1 * 65]); o.y = pk2(s[2 * 65], s[3 * 65]); o.z = pk2(s[4 * 65], s[5 * 65]); o.w = pk2(s[6 * 65], s[7 * 65]);
        *(u32x4*)(WT + (size_t)n * D + k0 + 8 * c) = o; }
    LDS_WAIT(); asm volatile("" ::: "memory");
}
__device__ __forceinline__ void phase0(Frame& F) {
    const int tid = F.tid, lane = F.lane, wave = F.wave;
    {
        LAS float* sT = (LAS float*)F.lds;
        LAS float* red = (LAS float*)(F.lds + 40960);
        const float* c = inp(F, I_C); const float* cctx = inp(F, I_CCTX);
        for (int idx = tid; idx < 9 * D; idx += NTHREADS) { const int mb = idx >> 10, k = idx & 1023; const float cv = mb < 8 ? c[mb * D + k] : cctx[k]; sT[idx] = cv / (1.f + __expf(-cv)); }
        __syncthreads();
        float* mod = (float*)(wsp(F) + WS_MOD);
        for (int task = F.vcu; task < DEPTH * 96; task += F.G) {
            const int l = task / 96, cb = task % 96;
            const float* wp = inp(F, I_WADA) + ((size_t)l * D + wave * 128) * 6144 + cb * 64 + lane;
            float acc[9];
#pragma unroll
            for (int mb = 0; mb < 9; ++mb) acc[mb] = 0.f;
#pragma unroll 8
            for (int k = 0; k < 128; ++k) { const float wv = wp[(size_t)k * 6144];
#pragma unroll
                for (int mb = 0; mb < 9; ++mb) acc[mb] += sT[mb * D + wave * 128 + k] * wv; }
#pragma unroll
            for (int mb = 0; mb < 9; ++mb) red[(wave * 9 + mb) * 64 + lane] = acc[mb];
            __syncthreads();
            for (int idx = tid; idx < 9 * 64; idx += NTHREADS) { const int mb = idx >> 6, ln = idx & 63; float s = 0.f;
#pragma unroll
                for (int w = 0; w < 8; ++w) s += red[(w * 9 + mb) * 64 + ln];
                const int col = cb * 64 + ln;
                mod[(size_t)(l * 9 + mb) * 6144 + col] = s + inp(F, I_BADA)[l * 6144 + col]; }
            __syncthreads();
        }
        if (blockIdx.x == 0) {
            float* rope = (float*)(wsp(F) + WS_ROPE);
            for (int idx = tid; idx < 64 * 16; idx += NTHREADS) { const int pos = idx >> 4, i = idx & 15; const float inv = powf(10000.0f, -(float)i / 16.0f); const float ang = (float)pos * inv;
                rope[idx * 2] = cosf(ang); rope[idx * 2 + 1] = sinf(ang); }
        }
        __syncthreads();
    }
    {
        LAS float* scr = (LAS float*)(F.lds + wave * 16640);
        const int gw = F.vcu * NWAVES + wave, NGW = F.G * NWAVES;
        constexpr int I_QKV = 2 * 16 * 48, I_WO = 4 * 16 * 16, I_IN = 2 * 16 * 52, I_1 = DEPTH * NE * 16 * 32, I_2 = DEPTH * NE * 16 * 16;
        for (int it0 = gw; it0 < I_QKV + I_WO + I_IN + I_1 + I_2; it0 += NGW) {
            int it = it0;
            if (it < I_QKV) { const int j = it / 768, r = it % 768, kb = r / 48, nb = r % 48;
                transpose_item(inp(F, I_WQKV) + (size_t)j * D * 3072, 3072, 3072, (bf16_t*)(wsp(F) + WS_WQKV) + ((size_t)j * 3072 + nb * 64) * D, kb * 64, nb * 64, scr, lane); continue; }
            it -= I_QKV;
            if (it < I_WO) { const int m = it / 256, r = it % 256, kb = r / 16, nb = r % 16;
                const float* W = (m < 2) ? inp(F, I_WONA) + (size_t)m * D * D : inp(F, I_WOML) + (size_t)(m - 2) * D * D;
                bf16_t* dst = (m < 2) ? (bf16_t*)(wsp(F) + WS_WONA) + (size_t)m * D * D : (bf16_t*)(wsp(F) + WS_WOML) + (size_t)(m - 2) * D * D;
                transpose_item(W, D, D, dst + (size_t)nb * 64 * D, kb * 64, nb * 64, scr, lane); continue; }
            it -= I_WO;
            if (it < I_IN) { const int j = it / 832, r = it % 832, kb = r / 52, nb = r % 52;
                transpose_item(inp(F, I_WIN) + (size_t)j * D * ML_IN, ML_IN, ML_IN, (bf16_t*)(wsp(F) + WS_WIN) + ((size_t)j * ML_INP + nb * 64) * D, kb * 64, nb * 64, scr, lane); continue; }
            it -= I_IN;
            if (it < I_1) { const int le = it / 512, r = it % 512, kb = r / 32, nb = r % 32;
                const int n0 = nb * 64, bj = n0 >> 10, j0 = n0 & 1023, pn = j0 >> 7, jj0 = j0 & 127, drow = pn * 256 + bj * 128 + jj0;
                transpose_item(inp(F, I_W1) + (size_t)le * D * 2048, 2048, 2048, (bf16_t*)(wsp(F) + WS_W1T) + ((size_t)le * 2048 + drow) * D, kb * 64, n0, scr, lane); continue; }
            it -= I_1;
            { const int le = it / 256, r = it % 256, kb = r / 16, nb = r % 16;
                transpose_item(inp(F, I_W2) + (size_t)le * D * D, D, D, (bf16_t*)(wsp(F) + WS_W2T) + ((size_t)le * D + nb * 64) * D, kb * 64, nb * 64, scr, lane); }
        }
    }
}

__device__ __forceinline__ void moe_combine(const Frame& F, int row, int lprev, int mb, f32x4 (&v)[4]) {
    const int* pos = (const int*)(wsp(F) + WS_POS) + (size_t)row * 4;
    const float* tw = (const float*)(wsp(F) + WS_TOPW) + (size_t)row * 4;
    const bf16_t* Y = (const bf16_t*)(wsp(F) + WS_Y);
    f32x4 a[4];
#pragma unroll
    for (int j = 0; j < 4; ++j) a[j] = (f32x4){0.f, 0.f, 0.f, 0.f};
#pragma unroll
    for (int k = 0; k < 4; ++k) { const int p = pos[k]; const float w = tw[k]; const u32x2* yp = (const u32x2*)(Y + (size_t)p * D) + F.lane;
#pragma unroll
        for (int j = 0; j < 4; ++j) { const u32x2 y = yp[64 * j]; a[j] = a[j] + w * (f32x4){bflo(y.x), bfhi(y.x), bflo(y.y), bfhi(y.y)}; } }
    const f32x4* g2 = (const f32x4*)modp(F, lprev, mb, 5) + F.lane;
#pragma unroll
    for (int j = 0; j < 4; ++j) v[j] = v[j] + g2[64 * j] * a[j];
}

__device__ __forceinline__ void phase_norm1(Frame& F, int l) {
    const int gw = F.vcu * NWAVES + F.wave, NGW = F.G * NWAVES, lane = F.lane;
    float* xs = (float*)(wsp(F) + WS_XS); bf16_t* hb = (bf16_t*)(wsp(F) + WS_HB);
    const f32x4* gm = (const f32x4*)(inp(F, I_GMIX) + l * D) + lane;
    for (int row = gw; row < ROWS; row += NGW) {
        const int mb = row_mb(row);
        const float* src = (l == 0) ? (row < ROWS_CTX ? inp(F, I_CTX) + (size_t)row * D : inp(F, I_X) + (size_t)(row - ROWS_CTX) * D) : xs + (size_t)row * D;
        const f32x4* xr = (const f32x4*)src + lane;
        f32x4 v[4];
#pragma unroll
        for (int j = 0; j < 4; ++j) v[j] = xr[64 * j];
        if (l > 0) moe_combine(F, row, l - 1, mb, v);
        f32x4* xw = (f32x4*)(xs + (size_t)row * D) + lane;
        float ss = 0.f;
#pragma unroll
        for (int j = 0; j < 4; ++j) { xw[64 * j] = v[j]; ss += (v[j][0] * v[j][0] + v[j][1] * v[j][1]) + (v[j][2] * v[j][2] + v[j][3] * v[j][3]); }
        const float rs = 1.0f / sqrtf(wave_sum(ss) * (1.f / D) + EPS);
        const f32x4* sh = (const f32x4*)modp(F, l, mb, 0) + lane; const f32x4* sc = (const f32x4*)modp(F, l, mb, 1) + lane;
        u32x2* o8 = (u32x2*)(hb + (size_t)row * D) + lane;
#pragma unroll
        for (int j = 0; j < 4; ++j) { const f32x4 h = (v[j] * rs) * gm[64 * j] * (sc[64 * j] + 1.0f) + sh[64 * j];
            u32x2 w; w.x = pk2(h[0], h[1]); w.y = pk2(h[2], h[3]); o8[64 * j] = w; }
    }
}
__device__ __forceinline__ void phase_final(Frame& F) {
    const int gw = F.vcu * NWAVES + F.wave, NGW = F.G * NWAVES, lane = F.lane;
    const float* xs = (const float*)(wsp(F) + WS_XS);
    for (int row = ROWS_CTX + gw; row < ROWS; row += NGW) {
        const int mb = row_mb(row);
        const f32x4* xr = (const f32x4*)(xs + (size_t)row * D) + lane;
        f32x4 v[4];
#pragma unroll
        for (int j = 0; j < 4; ++j) v[j] = xr[64 * j];
        moe_combine(F, row, DEPTH - 1, mb, v);
        f32x4* o = (f32x4*)(outp(F) + (size_t)(row - ROWS_CTX) * D) + lane;
#pragma unroll
        for (int j = 0; j < 4; ++j) o[64 * j] = v[j];
    }
}

__device__ __forceinline__ void phase_na_post(Frame& F, int jn) {
    const int gw = F.vcu * NWAVES + F.wave, NGW = F.G * NWAVES, lane = F.lane;
    const bf16_t* proj = (const bf16_t*)(wsp(F) + WS_PROJ);
    bf16_t* QN = (bf16_t*)(wsp(F) + WS_QN); bf16_t* KN = (bf16_t*)(wsp(F) + WS_KN); bf16_t* VT = (bf16_t*)(wsp(F) + WS_VT);
    LAS bf16_t* vs = (LAS bf16_t*)(F.lds + F.wave * (64 * 72 * 2));
    const int c8 = lane & 7, rl = lane >> 3;
    float qg[8], kg[8];
#pragma unroll
    for (int e = 0; e < 8; ++e) { qg[e] = inp(F, I_QGAIN)[jn * 64 + c8 * 8 + e] * (0.125f * 1.44269504f); kg[e] = inp(F, I_KGAIN)[jn * 64 + c8 * 8 + e]; }
    for (int item = gw; item < (ROWS / 64) * NH_NA; item += NGW) {
        const int rb = item >> 4, h = item & 15, row0 = rb * 64;
        int b, tp0;
        if (row0 < ROWS_CTX) { b = row0 >> 8; tp0 = row0 & 255; } else { b = (row0 - ROWS_CTX) >> 12; tp0 = NCTX + ((row0 - ROWS_CTX) & 4095); }
        const size_t seqbase = ((size_t)(b * NH_NA + h) * TT + tp0) * 64;
#pragma unroll
        for (int i = 0; i < 8; ++i) {
            const int r = i * 8 + rl;
            const bf16_t* pr = proj + (size_t)(row0 + r) * 3072 + h * 64 + c8 * 8;
            const u32x4 qv = *(const u32x4*)pr, kv = *(const u32x4*)(pr + 1024), vv = *(const u32x4*)(pr + 2048);
            float q[8] = {bflo(qv.x), bfhi(qv.x), bflo(qv.y), bfhi(qv.y), bflo(qv.z), bfhi(qv.z), bflo(qv.w), bfhi(qv.w)};
            float k[8] = {bflo(kv.x), bfhi(kv.x), bflo(kv.y), bfhi(kv.y), bflo(kv.z), bfhi(kv.z), bflo(kv.w), bfhi(kv.w)};
            float sq = 0.f, sk = 0.f;
#pragma unroll
            for (int e = 0; e < 8; ++e) { sq += q[e] * q[e]; sk += k[e] * k[e]; }
            sq += __shfl_xor(sq, 1); sq += __shfl_xor(sq, 2); sq += __shfl_xor(sq, 4);
            sk += __shfl_xor(sk, 1); sk += __shfl_xor(sk, 2); sk += __shfl_xor(sk, 4);
            const float rq = 1.0f / sqrtf(sq * (1.f / 64) + EPS), rk = 1.0f / sqrtf(sk * (1.f / 64) + EPS);
            u32x4 qo, ko;
            qo.x = pk2(q[0] * rq * qg[0], q[1] * rq * qg[1]); qo.y = pk2(q[2] * rq * qg[2], q[3] * rq * qg[3]); qo.z = pk2(q[4] * rq * qg[4], q[5] * rq * qg[5]); qo.w = pk2(q[6] * rq * qg[6], q[7] * rq * qg[7]);
            ko.x = pk2(k[0] * rk * kg[0], k[1] * rk * kg[1]); ko.y = pk2(k[2] * rk * kg[2], k[3] * rk * kg[3]); ko.z = pk2(k[4] * rk * kg[4], k[5] * rk * kg[5]); ko.w = pk2(k[6] * rk * kg[6], k[7] * rk * kg[7]);
            *(u32x4*)(QN + seqbase + (size_t)r * 64 + c8 * 8) = qo;
            *(u32x4*)(KN + seqbase + (size_t)r * 64 + c8 * 8) = ko;
            *(LAS u32x4*)(vs + r * 72 + c8 * 8) = vv;
        }
        LDS_WAIT(); asm volatile("" ::: "memory");
#pragma unroll
        for (int j = 0; j < 8; ++j) {
            const int d = rl + 8 * j;
            const LAS bf16_t* s = vs + (8 * c8) * 72 + d;
            u32x4 o;
            o.x = (unsigned)s[0 * 72] | ((unsigned)s[1 * 72] << 16); o.y = (unsigned)s[2 * 72] | ((unsigned)s[3 * 72] << 16);
            o.z = (unsigned)s[4 * 72] | ((unsigned)s[5 * 72] << 16); o.w = (unsigned)s[6 * 72] | ((unsigned)s[7 * 72] << 16);
            *(u32x4*)(VT + ((size_t)(b * NH_NA + h) * 64 + d) * TT + tp0 + 8 * c8) = o;
        }
        LDS_WAIT(); asm volatile("" ::: "memory");
    }
}

__device__ __forceinline__ bf16x8 ld_bf16x8(const bf16_t* p) { return *(const bf16x8*)p; }
constexpr int NA_LD = 72;
constexpr int NA_TILE = 64 * NA_LD * 2;
struct NaState { f32x4 o[4]; float m, lsum; };
constexpr int NA_RING = 2 * 2 * 64 * NA_LD * 2;
constexpr int NA_BT_LD = 128, NA_BT_OFF = 48;
template <bool H0, bool H1, bool WIN>
__device__ __forceinline__ void na_tile(NaState& st, const LAS bf16_t* KL, const LAS bf16_t* VL, const bf16x8 qf0, const bf16x8 qf1,
                                        const LAS float* brow, const float (&madd)[16], int q16, int g) {
    constexpr int NH = (H0 ? 1 : 0) + (H1 ? 1 : 0), HB = H0 ? 0 : 1;
    f32x4 s[2 * NH];
    bf16x8 vf[NH][4];
#pragma unroll
    for (int hh = 0; hh < NH; ++hh) { const int half = HB + hh;
#pragma unroll
        for (int nb = 0; nb < 2; ++nb) { f32x4 init = (f32x4){0.f, 0.f, 0.f, 0.f};
            if (WIN) {
#pragma unroll
                for (int rg = 0; rg < 4; ++rg) init[rg] = brow[32 * half + 16 * nb + rg] + madd[8 * half + 4 * nb + rg]; }
            const LAS bf16_t* kp = KL + (half * 32 + 16 * nb + q16) * NA_LD + 8 * g;
            init = __builtin_amdgcn_mfma_f32_16x16x32_bf16(*(const LAS bf16x8*)kp, qf0, init, 0, 0, 0);
            s[2 * hh + nb] = __builtin_amdgcn_mfma_f32_16x16x32_bf16(*(const LAS bf16x8*)(kp + 32), qf1, init, 0, 0, 0); }
#pragma unroll
        for (int j4 = 0; j4 < 4; ++j4) { const LAS bf16_t* vp = VL + (16 * j4 + q16) * NA_LD + half * 32 + 4 * g;
            const bf16x4 va = *(const LAS bf16x4*)vp, vb = *(const LAS bf16x4*)(vp + 16);
            vf[hh][j4] = (bf16x8){va[0], va[1], va[2], va[3], vb[0], vb[1], vb[2], vb[3]}; } }
    float bm = fmaxf(fmaxf(s[0][0], s[0][1]), fmaxf(s[0][2], s[0][3]));
#pragma unroll
    for (int i = 1; i < 2 * NH; ++i) bm = fmaxf(bm, fmaxf(fmaxf(s[i][0], s[i][1]), fmaxf(s[i][2], s[i][3])));
    bm = fmaxf(bm, __shfl_xor(bm, 16)); bm = fmaxf(bm, __shfl_xor(bm, 32));
    float ps = 0.f;
    if (__all(bm <= st.m)) {
        const float mn = st.m;
#pragma unroll
        for (int i = 0; i < 2 * NH; ++i)
#pragma unroll
            for (int rg = 0; rg < 4; ++rg) { s[i][rg] = __builtin_amdgcn_exp2f(s[i][rg] - mn); ps += s[i][rg]; }
        st.lsum += ps;
    } else {
        const float mn = fmaxf(st.m, bm), alpha = __builtin_amdgcn_exp2f(st.m - mn);
#pragma unroll
        for (int i = 0; i < 2 * NH; ++i)
#pragma unroll
            for (int rg = 0; rg < 4; ++rg) { s[i][rg] = __builtin_amdgcn_exp2f(s[i][rg] - mn); ps += s[i][rg]; }
        st.lsum = st.lsum * alpha + ps; st.m = mn;
#pragma unroll
        for (int j = 0; j < 4; ++j) st.o[j] = st.o[j] * alpha;
    }
#pragma unroll
    for (int hh = 0; hh < NH; ++hh) { union { u32x4 u; bf16x8 v; } pf;
        pf.u.x = pg8::cvt_pk_bf16(s[2 * hh][0], s[2 * hh][1]); pf.u.y = pg8::cvt_pk_bf16(s[2 * hh][2], s[2 * hh][3]); pf.u.z = pg8::cvt_pk_bf16(s[2 * hh + 1][0], s[2 * hh + 1][1]); pf.u.w = pg8::cvt_pk_bf16(s[2 * hh + 1][2], s[2 * hh + 1][3]);
#pragma unroll
        for (int j4 = 0; j4 < 4; ++j4) st.o[j4] = __builtin_amdgcn_mfma_f32_16x16x32_bf16(vf[hh][j4], pf.v, st.o[j4], 0, 0, 0); }
}
__device__ __forceinline__ void na_block_task(const Frame& F, int jn, int b, int h, bool ctxq, int p) {
    const int tid = F.tid, lane = F.lane, wave = F.wave, q16 = lane & 15, g = lane >> 4;
    const bf16_t* Qb = (const bf16_t*)(wsp(F) + WS_QN) + (size_t)(b * NH_NA + h) * TT * 64;
    const bf16_t* Kb = (const bf16_t*)(wsp(F) + WS_KN) + (size_t)(b * NH_NA + h) * TT * 64;
    const bf16_t* Vb = (const bf16_t*)(wsp(F) + WS_VT) + (size_t)(b * NH_NA + h) * 64 * TT;
    const float* rpb = inp(F, I_RPB) + (size_t)(jn * NH_NA + h) * 15 * 31;
    const int rw = 2 * p + (wave >> 2), qw = wave & 3, qc = qw * 16 + q16;
    const int qtp = ctxq ? p * 128 + wave * 16 + q16 : NCTX + rw * 64 + qc;
    const bf16x8 qf0 = ld_bf16x8(Qb + (size_t)qtp * 64 + 8 * g), qf1 = ld_bf16x8(Qb + (size_t)qtp * 64 + 32 + 8 * g);
    NaState st;
#pragma unroll
    for (int j = 0; j < 4; ++j) st.o[j] = (f32x4){0.f, 0.f, 0.f, 0.f};
    st.m = -1e30f; st.lsum = 0.f;
    const int r0w = min(max(rw - 4, 0), 56), c0 = min(max(qc - 8, 0), 48);
    const int kr_lo = min(max(2 * p - 4, 0), 56), kr_hi = min(max(2 * p + 1 - 4, 0), 56) + 7;
    const int ntile = ctxq ? 4 : 4 + (kr_hi - kr_lo + 1);
    LAS bf16_t* ring = (LAS bf16_t*)F.lds;
    LAS float* btab = (LAS float*)(F.lds + NA_RING);
    if (!ctxq) { for (int i = tid; i < 15 * NA_BT_LD; i += NTHREADS) { const int dr = i >> 7, c = (i & 127) - NA_BT_OFF; btab[i] = (c >= 0 && c < 31) ? rpb[dr * 31 + c] * 1.44269504f : 0.f; } }
    float madd[16];
#pragma unroll
    for (int e = 0; e < 16; ++e) { const int kc = 32 * (e >> 3) + 16 * ((e >> 2) & 1) + 4 * g + (e & 3); madd[e] = (kc >= c0 && kc <= c0 + 15) ? 0.f : -1e30f; }
    const int bcol = NA_BT_OFF + 4 * g - qc + 15;
    const int r = tid >> 3, c8 = tid & 7;
    u32x4 kA, vA, kB, vB;
#define NA_TOK0(t) ((t) < 4 ? 64 * (t) : NCTX + 64 * (kr_lo + (t) - 4))
#define NA_LOAD(t, kk, vv) do { const int tok0_ = NA_TOK0(t); kk = *(const u32x4*)(Kb + (size_t)(tok0_ + r) * 64 + 8 * c8); vv = *(const u32x4*)(Vb + (size_t)r * TT + tok0_ + 8 * c8); } while (0)
#define NA_WRITE(bufi, kk, vv) do { LAS bf16_t* dst_ = ring + (bufi) * (2 * 64 * NA_LD); *(LAS u32x4*)(dst_ + r * NA_LD + 8 * c8) = kk; *(LAS u32x4*)(dst_ + 64 * NA_LD + r * NA_LD + 8 * c8) = vv; } while (0)
#define NA_TILE(t, bufi) do { const LAS bf16_t* KL = ring + (bufi) * (2 * 64 * NA_LD); const LAS bf16_t* VL = KL + 64 * NA_LD; \
        if ((t) < 4) na_tile<true, true, false>(st, KL, VL, qf0, qf1, btab, madd, q16, g); \
        else if (!ctxq) { const int kr = kr_lo + (t) - 4; \
            if (kr >= r0w && kr <= r0w + 7) { const LAS float* brow = btab + (kr - rw + 7) * NA_BT_LD + bcol; \
                if (qw == 0) na_tile<true, false, true>(st, KL, VL, qf0, qf1, brow, madd, q16, g); \
                else if (qw == 3) na_tile<false, true, true>(st, KL, VL, qf0, qf1, brow, madd, q16, g); \
                else na_tile<true, true, true>(st, KL, VL, qf0, qf1, brow, madd, q16, g); } } } while (0)
    NA_LOAD(0, kA, vA); NA_LOAD(1, kB, vB);
    NA_WRITE(0, kA, vA);
    __syncthreads();
    NA_LOAD(2, kA, vA);
    for (int t = 0; t < ntile; t += 2) {
        NA_TILE(t, 0);
        if (t + 1 < ntile) NA_WRITE(1, kB, vB);
        __syncthreads();
        if (t + 3 < ntile) NA_LOAD(t + 3, kB, vB);
        if (t + 1 >= ntile) break;
        NA_TILE(t + 1, 1);
        if (t + 2 < ntile) NA_WRITE(0, kA, vA);
        __syncthreads();
        if (t + 4 < ntile) NA_LOAD(t + 4, kA, vA);
    }
#undef NA_TOK0
#undef NA_LOAD
#undef NA_WRITE
#undef NA_TILE
    float lsum = st.lsum; lsum += __shfl_xor(lsum, 16); lsum += __shfl_xor(lsum, 32);
    const float inv = 1.0f / lsum;
    const int row = ctxq ? b * NCTX + p * 128 + wave * 16 + q16 : ROWS_CTX + b * SEQ + rw * 64 + qc;
    bf16_t* op = (bf16_t*)(wsp(F) + WS_AO) + (size_t)row * D + h * 64 + 4 * g;
#pragma unroll
    for (int j4 = 0; j4 < 4; ++j4) { u32x2 w; w.x = pk2(st.o[j4][0] * inv, st.o[j4][1] * inv); w.y = pk2(st.o[j4][2] * inv, st.o[j4][3] * inv); *(u32x2*)(op + 16 * j4) = w; }
}
__device__ __forceinline__ void phase_na_attn(Frame& F, int jn) {
    constexpr int NLAT = NB * NH_NA * 32, NCTXT = NB * NH_NA * 2;
    for (int bt = F.vcu; bt < NLAT + NCTXT; bt += F.G) {
        if (bt < NLAT) { const int bh = bt >> 5, p = bt & 31; na_block_task(F, jn, bh >> 4, bh & 15, false, p); }
        else { const int u = bt - NLAT, bh = u >> 1; na_block_task(F, jn, bh >> 4, bh & 15, true, u & 1); }
    }
}

__device__ __forceinline__ void row_decode(int row, int& b, int& tp) {
    if (row < ROWS_CTX) { b = row >> 8; tp = row & 255; } else { b = (row - ROWS_CTX) >> 12; tp = NCTX + ((row - ROWS_CTX) & 4095); }
}
__device__ __forceinline__ void unpack8(const u32x4 v, float (&f)[8]) { f[0] = bflo(v.x); f[1] = bfhi(v.x); f[2] = bflo(v.y); f[3] = bfhi(v.y); f[4] = bflo(v.z); f[5] = bfhi(v.z); f[6] = bflo(v.w); f[7] = bfhi(v.w); }
__device__ __forceinline__ u32x4 pack8(const float (&f)[8]) { u32x4 o; o.x = pk2(f[0], f[1]); o.y = pk2(f[2], f[3]); o.z = pk2(f[4], f[5]); o.w = pk2(f[6], f[7]); return o; }
__device__ __forceinline__ void phase_ml_post(Frame& F, int jm) {
    const int gw = F.vcu * NWAVES + F.wave, NGW = F.G * NWAVES, lane = F.lane;
    bf16_t* proj = (bf16_t*)(wsp(F) + WS_PROJ);
    const float* rope = (const float*)(wsp(F) + WS_ROPE);
    float* gates = (float*)(wsp(F) + WS_GATES);
    const int t16 = lane >> 2, sub = lane & 3, hf = sub >> 1, i0 = 8 * (sub & 1), cbase = t16 * 64 + 32 * hf + i0;
    const float scale = t16 < 8 ? 0.125f : 1.0f;
    for (int row = gw; row < ROWS; row += NGW) {
        int b, tp; row_decode(row, b, tp);
        bf16_t* pr = proj + (size_t)row * ML_INP;
        float a[8], c[8], o1[8], o2[8];
        unpack8(*(const u32x4*)(pr + cbase), a); unpack8(*(const u32x4*)(pr + cbase + 16), c);
        if (tp >= NCTX) {
            const int s = tp - NCTX, pos = hf ? (s & 63) : (s >> 6);
            const float* rp = rope + (pos * 16 + i0) * 2;
#pragma unroll
            for (int e = 0; e < 8; ++e) { const float cs = rp[2 * e], sn = rp[2 * e + 1]; o1[e] = (a[e] * cs - c[e] * sn) * scale; o2[e] = (a[e] * sn + c[e] * cs) * scale; }
        } else {
#pragma unroll
            for (int e = 0; e < 8; ++e) { o1[e] = a[e] * scale; o2[e] = c[e] * scale; }
        }
        float gv = 0.f;
        if (lane < 32) gv = bf2f(pr[3072 + lane]);
        *(u32x4*)(pr + cbase) = pack8(o1); *(u32x4*)(pr + cbase + 16) = pack8(o2);
        if (lane < 32) {
            float v = gv + inp(F, I_BGATE)[jm * 32 + lane];
            v = 15.0f * tanhf(v * (1.0f / 15.0f));
            const int gi = lane >> 3, hh = lane & 7;
            if (gi & 1) v = fminf(v, 0.f) - log1pf(__expf(-fabsf(v)));
            gates[((size_t)(gi * NB + b) * NH_ML + hh) * TT + tp] = v;
        }
    }
}

constexpr int ML_LD = 72;
constexpr int ML_QL = 0, ML_KL = 9216, ML_KET = 18432, ML_VTL = 27648, ML_SDL = 36864, ML_C0L = 46080, ML_N0L = 55296, ML_DENL = 55552;
__device__ __forceinline__ float wave_prefix_sum(float v, int lane) {
#pragma unroll
    for (int o = 1; o < 64; o <<= 1) { const float t = __shfl_up(v, o); if (lane >= o) v += t; }
    return v;
}
__device__ __forceinline__ float wave_prefix_max(float v, int lane) {
#pragma unroll
    for (int o = 1; o < 64; o <<= 1) { const float t = __shfl_up(v, o); if (lane >= o) v = fmaxf(v, t); }
    return v;
}
__device__ __forceinline__ int ml_grow(int b, int tp) { return tp < NCTX ? b * NCTX + tp : ROWS_CTX + b * SEQ + (tp - NCTX); }
__device__ __forceinline__ void ml_task(Frame& F, int b, int hh, int dir, int vh) {
    const int tid = F.tid, lane = F.lane, w = F.wave, l15 = lane & 15, g = lane >> 4;
    LAS bf16_t* QL = (LAS bf16_t*)(F.lds + ML_QL); LAS bf16_t* KL = (LAS bf16_t*)(F.lds + ML_KL); LAS bf16_t* KET = (LAS bf16_t*)(F.lds + ML_KET);
    LAS bf16_t* VTL = (LAS bf16_t*)(F.lds + ML_VTL); LAS bf16_t* SDL = (LAS bf16_t*)(F.lds + ML_SDL); LAS bf16_t* C0L = (LAS bf16_t*)(F.lds + ML_C0L);
    LAS float* n0L = (LAS float*)(F.lds + ML_N0L); LAS float* denL = (LAS float*)(F.lds + ML_DENL);
    const bf16_t* proj = (const bf16_t*)(wsp(F) + WS_PROJ);
    const float* gI = (const float*)(wsp(F) + WS_GATES) + ((size_t)((dir * 2 + 0) * NB + b) * NH_ML + hh) * TT;
    const float* gF = (const float*)(wsp(F) + WS_GATES) + ((size_t)((dir * 2 + 1) * NB + b) * NH_ML + hh) * TT;
    bf16_t* hout = (bf16_t*)(wsp(F) + WS_HDIR) + (size_t)dir * ROWS * D + hh * DV_ML + vh * 64;
    const int r = tid >> 3, c8 = tid & 7, sr = dir ? 63 - r : r;
    const int bt = w >> 1, bc0 = 2 * (w & 1);
    for (int i = tid; i < 64 * ML_LD / 2; i += NTHREADS) ((LAS unsigned*)C0L)[i] = 0u;
    if (w == 0) n0L[lane] = 0.f;
    f32x4 Cst[2]; Cst[0] = (f32x4){0.f, 0.f, 0.f, 0.f}; Cst[1] = (f32x4){0.f, 0.f, 0.f, 0.f};
    float nst = 0.f, m0 = 0.f;
    u32x4 qv, kv, vv; float igv, lfv;
    {
        const int tb = dir ? 192 : 0;
        const bf16_t* pr = proj + (size_t)ml_grow(b, tb + r) * ML_INP;
        qv = *(const u32x4*)(pr + hh * 64 + c8 * 8); kv = *(const u32x4*)(pr + 512 + hh * 64 + c8 * 8); vv = *(const u32x4*)(pr + 1024 + hh * DV_ML + vh * 64 + c8 * 8);
        const int tpg = dir ? tb + 63 - lane : tb + lane;
        igv = gI[tpg]; lfv = gF[tpg];
    }
    __syncthreads();
    for (int c = 0; c < TT / 64; ++c) {
        const int tb = dir ? (c < 4 ? 192 - 64 * c : 4544 - 64 * c) : 64 * c;
        const float cum = wave_prefix_sum(lfv, lane);
        const float av = igv - cum;
        const float pmax = wave_prefix_max(av, lane);
        const float cl = __shfl(cum, 63);
        const float wend = cl - cum + igv;
        const float ml = wave_max(wend);
        const float eend = __expf(wend - ml);
        const float Mv = fmaxf(m0, pmax);
        const float winter = __expf(m0 - Mv);
        const float floorv = __expf(-(cum + Mv));
        const float mnew = fmaxf(cl + m0, ml);
        const float Ac = __expf(cl + m0 - mnew), Gc = __expf(ml - mnew);
        *(LAS u32x4*)(QL + sr * ML_LD + c8 * 8) = qv;
        *(LAS u32x4*)(KL + sr * ML_LD + c8 * 8) = kv;
        {
            const float es = __shfl(eend, sr);
            float kf[8]; unpack8(kv, kf);
            const unsigned vw[4] = {vv.x, vv.y, vv.z, vv.w};
#pragma unroll
            for (int e = 0; e < 8; ++e) { KET[(c8 * 8 + e) * ML_LD + sr] = (bf16_t)f2bf(kf[e] * es); VTL[(c8 * 8 + e) * ML_LD + sr] = (bf16_t)((vw[e >> 1] >> (16 * (e & 1))) & 0xffffu); }
        }
        if (c + 1 < TT / 64) {
            const int cn = c + 1, tbn = dir ? (cn < 4 ? 192 - 64 * cn : 4544 - 64 * cn) : 64 * cn;
            const bf16_t* pr = proj + (size_t)ml_grow(b, tbn + r) * ML_INP;
            qv = *(const u32x4*)(pr + hh * 64 + c8 * 8); kv = *(const u32x4*)(pr + 512 + hh * 64 + c8 * 8); vv = *(const u32x4*)(pr + 1024 + hh * DV_ML + vh * 64 + c8 * 8);
            const int tpg = dir ? tbn + 63 - lane : tbn + lane;
            igv = gI[tpg]; lfv = gF[tpg];
        }
        __syncthreads();
#pragma unroll
        for (int x = 0; x < 2; ++x) {
            const int bs = bc0 + x;
            f32x4 acc = (f32x4){0.f, 0.f, 0.f, 0.f};
            if (bs <= bt) {
#pragma unroll
                for (int ks = 0; ks < 2; ++ks) { const bf16x8 af = *(const LAS bf16x8*)(QL + (16 * bt + l15) * ML_LD + 32 * ks + 8 * g), bfv = *(const LAS bf16x8*)(KL + (16 * bs + l15) * ML_LD + 32 * ks + 8 * g);
                    acc = __builtin_amdgcn_mfma_f32_16x16x32_bf16(af, bfv, acc, 0, 0, 0); }
            }
            const int s = 16 * bs + l15;
            const float a_s = __shfl(av, s);
#pragma unroll
            for (int rg = 0; rg < 4; ++rg) { const int t = 16 * bt + 4 * g + rg; const float M_t = __shfl(Mv, t);
                const float val = (s <= t) ? acc[rg] * __expf(a_s - M_t) : 0.f;
                SDL[t * ML_LD + s] = (bf16_t)f2bf(val); }
        }
        __syncthreads();
        if (w == 0) {
            float rs = 0.f, qn = 0.f;
#pragma unroll
            for (int j = 0; j < 8; ++j) { float sd[8], qf[8]; unpack8(*(const LAS u32x4*)(SDL + lane * ML_LD + 8 * j), sd); unpack8(*(const LAS u32x4*)(QL + lane * ML_LD + 8 * j), qf);
                const f32x4 n0a = *(const LAS f32x4*)(n0L + 8 * j), n0b = *(const LAS f32x4*)(n0L + 8 * j + 4);
                rs += ((sd[0] + sd[1]) + (sd[2] + sd[3])) + ((sd[4] + sd[5]) + (sd[6] + sd[7]));
                qn += qf[0] * n0a[0] + qf[1] * n0a[1] + qf[2] * n0a[2] + qf[3] * n0a[3] + qf[4] * n0b[0] + qf[5] * n0b[1] + qf[6] * n0b[2] + qf[7] * n0b[3]; }
            denL[lane] = rs + winter * qn;
            float dn = 0.f;
#pragma unroll
            for (int j = 0; j < 8; ++j) { float kf[8]; unpack8(*(const LAS u32x4*)(KET + lane * ML_LD + 8 * j), kf); dn += ((kf[0] + kf[1]) + (kf[2] + kf[3])) + ((kf[4] + kf[5]) + (kf[6] + kf[7])); }
            nst = Ac * nst + Gc * dn;
            LDS_WAIT();
            n0L[lane] = nst;
        }
        f32x4 nin[2], nit[2];
#pragma unroll
        for (int x = 0; x < 2; ++x) {
            const int bv = bc0 + x;
            f32x4 a1 = (f32x4){0.f, 0.f, 0.f, 0.f}, a2 = (f32x4){0.f, 0.f, 0.f, 0.f}, a3 = (f32x4){0.f, 0.f, 0.f, 0.f};
#pragma unroll
            for (int ks = 0; ks < 2; ++ks) {
                const bf16x8 sdf = *(const LAS bf16x8*)(SDL + (16 * bt + l15) * ML_LD + 32 * ks + 8 * g), vtf = *(const LAS bf16x8*)(VTL + (16 * bv + l15) * ML_LD + 32 * ks + 8 * g);
                const bf16x8 qf = *(const LAS bf16x8*)(QL + (16 * bt + l15) * ML_LD + 32 * ks + 8 * g), c0f = *(const LAS bf16x8*)(C0L + (16 * bv + l15) * ML_LD + 32 * ks + 8 * g);
                const bf16x8 vt2 = *(const LAS bf16x8*)(VTL + (16 * bt + l15) * ML_LD + 32 * ks + 8 * g), kef = *(const LAS bf16x8*)(KET + (16 * bv + l15) * ML_LD + 32 * ks + 8 * g);
                a1 = __builtin_amdgcn_mfma_f32_16x16x32_bf16(sdf, vtf, a1, 0, 0, 0);
                a2 = __builtin_amdgcn_mfma_f32_16x16x32_bf16(qf, c0f, a2, 0, 0, 0);
                a3 = __builtin_amdgcn_mfma_f32_16x16x32_bf16(vt2, kef, a3, 0, 0, 0);
            }
            nin[x] = a1; nit[x] = a2;
            Cst[x] = Cst[x] * Ac + a3 * Gc;
        }
        __syncthreads();
#pragma unroll
        for (int x = 0; x < 2; ++x) {
            const int bv = bc0 + x;
#pragma unroll
            for (int rg = 0; rg < 4; ++rg) { const int t = 16 * bt + 4 * g + rg;
                const float den = denL[t], w_t = __shfl(winter, t), fl_t = __shfl(floorv, t);
                const float hv = (nin[x][rg] + w_t * nit[x][rg]) / fmaxf(fabsf(den), fl_t);
                const int rr = dir ? 63 - t : t;
                hout[(size_t)ml_grow(b, tb + rr) * D + 16 * bv + l15] = (bf16_t)f2bf(hv);
                C0L[(16 * bt + 4 * g + rg) * ML_LD + 16 * bv + l15] = (bf16_t)f2bf(Cst[x][rg]); }
        }
        m0 = mnew;
    }
    __syncthreads();
}
__device__ __forceinline__ void phase_ml_scan(Frame& F) {
    for (int task = F.vcu; task < NB * NH_ML * 4; task += F.G) {
        const int vh = task & 1, dir = (task >> 1) & 1, bh = task >> 2;
        ml_task(F, bh >> 3, bh & 7, dir, vh);
    }
}

__device__ __forceinline__ void phase_ml_final(Frame& F, int jm) {
    const int gw = F.vcu * NWAVES + F.wave, NGW = F.G * NWAVES, lane = F.lane;
    const bf16_t* hfw = (const bf16_t*)(wsp(F) + WS_HDIR); const bf16_t* hbw = hfw + (size_t)ROWS * D;
    const bf16_t* proj = (const bf16_t*)(wsp(F) + WS_PROJ);
    bf16_t* ao = (bf16_t*)(wsp(F) + WS_AO);
    const float* gain = inp(F, I_MHGAIN) + jm * D + lane * 16;
    for (int row = gw; row < ROWS; row += NGW) {
        const size_t off = (size_t)row * D + lane * 16;
        float a0[8], a1[8], b0[8], b1[8], g0[8], g1[8];
        unpack8(*(const u32x4*)(hfw + off), a0); unpack8(*(const u32x4*)(hfw + off + 8), a1);
        unpack8(*(const u32x4*)(hbw + off), b0); unpack8(*(const u32x4*)(hbw + off + 8), b1);
        const bf16_t* ogp = proj + (size_t)row * ML_INP + 2048 + lane * 16;
        unpack8(*(const u32x4*)ogp, g0); unpack8(*(const u32x4*)(ogp + 8), g1);
        float ss = 0.f;
#pragma unroll
        for (int e = 0; e < 8; ++e) { a0[e] += b0[e]; a1[e] += b1[e]; ss += a0[e] * a0[e] + a1[e] * a1[e]; }
        ss += __shfl_xor(ss, 1); ss += __shfl_xor(ss, 2); ss += __shfl_xor(ss, 4);
        const float rs = 1.0f / sqrtf(ss * (1.f / DV_ML) + EPS);
        float o0[8], o1[8];
#pragma unroll
        for (int e = 0; e < 8; ++e) { o0[e] = a0[e] * rs * gain[e] * sigmoidf_(g0[e]); o1[e] = a1[e] * rs * gain[8 + e] * sigmoidf_(g1[e]); }
        *(u32x4*)(ao + off) = pack8(o0); *(u32x4*)(ao + off + 8) = pack8(o1);
    }
}

constexpr int RT_LD = 1032;
constexpr int RT_HI = 0, RT_LO = NE * RT_LD * 2, RT_LG = 2 * NE * RT_LD * 2;
__device__ __forceinline__ int rows_per_block(int first_row, int G) { return (ROWS - first_row + G - 1) / G; }
__device__ __forceinline__ void phase_norm2_router(Frame& F, int l, int first_row) {
    const int tid = F.tid, lane = F.lane, wave = F.wave, l15 = lane & 15, g = lane >> 4;
    LAS bf16_t* whi = (LAS bf16_t*)(F.lds + RT_HI); LAS bf16_t* wlo = (LAS bf16_t*)(F.lds + RT_LO);
    LAS float* lgs = (LAS float*)(F.lds + RT_LG) + wave * (16 * 33);
    volatile LAS int* cntL = F.LCTL + 64;
    const float* wg = inp(F, I_WR) + (size_t)l * D * NE;
    for (int idx = tid; idx < D * NE; idx += NTHREADS) { const int k = idx >> 5, e = idx & 31; const float w = wg[idx];
        const unsigned hb16 = f2bf(w); const float hf = __builtin_bit_cast(float, hb16 << 16);
        whi[e * RT_LD + k] = (bf16_t)hb16; wlo[e * RT_LD + k] = (bf16_t)f2bf(w - hf); }
    if (tid < NE) cntL[tid] = 0;
    const float* xs = (const float*)(wsp(F) + WS_XS); bf16_t* hb = (bf16_t*)(wsp(F) + WS_HB);
    int* tope = (int*)(wsp(F) + WS_TOPE); float* topw = (float*)(wsp(F) + WS_TOPW);
    const f32x4* gm = (const f32x4*)(inp(F, I_GFFN) + l * D) + lane;
    const int RPB = rows_per_block(first_row, F.G);
    const int rbeg = first_row + F.vcu * RPB, rend = min(rbeg + RPB, ROWS);
    for (int row = rbeg + wave; row < rend; row += NWAVES) {
        const int mb = row_mb(row);
        const f32x4* xr = (const f32x4*)(xs + (size_t)row * D) + lane;
        f32x4 v[4]; float ss = 0.f;
#pragma unroll
        for (int j = 0; j < 4; ++j) { v[j] = xr[64 * j]; ss += (v[j][0] * v[j][0] + v[j][1] * v[j][1]) + (v[j][2] * v[j][2] + v[j][3] * v[j][3]); }
        const float rs = 1.0f / sqrtf(wave_sum(ss) * (1.f / D) + EPS);
        const f32x4* sh = (const f32x4*)modp(F, l, mb, 3) + lane; const f32x4* sc = (const f32x4*)modp(F, l, mb, 4) + lane;
        u32x2* o8 = (u32x2*)(hb + (size_t)row * D) + lane;
#pragma unroll
        for (int j = 0; j < 4; ++j) { const f32x4 h = (v[j] * rs) * gm[64 * j] * (sc[64 * j] + 1.0f) + sh[64 * j];
            u32x2 wv; wv.x = pk2(h[0], h[1]); wv.y = pk2(h[2], h[3]); o8[64 * j] = wv; }
    }
    VM_WAIT();
    __syncthreads();
    const float br0 = inp(F, I_BR)[l * NE + l15], br1 = inp(F, I_BR)[l * NE + 16 + l15];
    for (int g0 = rbeg + 16 * wave; g0 < rend; g0 += 16 * NWAVES) {
        const int arow = min(g0 + l15, rend - 1);
        const bf16_t* ap = hb + (size_t)arow * D + 8 * g;
        f32x4 acc0 = (f32x4){0.f, 0.f, 0.f, 0.f}, acc1 = (f32x4){0.f, 0.f, 0.f, 0.f};
#pragma unroll 8
        for (int ks = 0; ks < 32; ++ks) {
            const bf16x8 af = *(const bf16x8*)(ap + 32 * ks);
            const bf16x8 h0 = *(const LAS bf16x8*)(whi + l15 * RT_LD + 32 * ks + 8 * g), h1 = *(const LAS bf16x8*)(whi + (16 + l15) * RT_LD + 32 * ks + 8 * g);
            const bf16x8 l0 = *(const LAS bf16x8*)(wlo + l15 * RT_LD + 32 * ks + 8 * g), l1 = *(const LAS bf16x8*)(wlo + (16 + l15) * RT_LD + 32 * ks + 8 * g);
            acc0 = __builtin_amdgcn_mfma_f32_16x16x32_bf16(af, h0, acc0, 0, 0, 0); acc1 = __builtin_amdgcn_mfma_f32_16x16x32_bf16(af, h1, acc1, 0, 0, 0);
            acc0 = __builtin_amdgcn_mfma_f32_16x16x32_bf16(af, l0, acc0, 0, 0, 0); acc1 = __builtin_amdgcn_mfma_f32_16x16x32_bf16(af, l1, acc1, 0, 0, 0);
        }
#pragma unroll
        for (int rg = 0; rg < 4; ++rg) { lgs[(4 * g + rg) * 33 + l15] = acc0[rg] + br0; lgs[(4 * g + rg) * 33 + 16 + l15] = acc1[rg] + br1; }
        LDS_WAIT(); asm volatile("" ::: "memory");
        const int row = g0 + lane;
        if (lane < 16 && row < rend) {
            float lg[32];
#pragma unroll
            for (int e = 0; e < 32; ++e) lg[e] = lgs[lane * 33 + e];
            int sel[4]; float sv[4]; unsigned used = 0u;
#pragma unroll
            for (int k = 0; k < 4; ++k) { float best = -3.0e38f; int bi = 0;
#pragma unroll
                for (int e = 0; e < 32; ++e) { const bool take = !((used >> e) & 1u) && (lg[e] > best); best = take ? lg[e] : best; bi = take ? e : bi; }
                used |= 1u << bi; sel[k] = bi; sv[k] = best; }
            const float e1 = __expf(sv[1] - sv[0]), e2 = __expf(sv[2] - sv[0]), e3 = __expf(sv[3] - sv[0]);
            const float inv = 1.0f / (1.0f + e1 + e2 + e3);
            *(int4*)(tope + (size_t)row * 4) = make_int4(sel[0], sel[1], sel[2], sel[3]);
            *(float4*)(topw + (size_t)row * 4) = make_float4(inv, e1 * inv, e2 * inv, e3 * inv);
#pragma unroll
            for (int k = 0; k < 4; ++k) __hip_atomic_fetch_add((LAS int*)&cntL[sel[k]], 1, __ATOMIC_RELAXED, __HIP_MEMORY_SCOPE_WORKGROUP);
        }
        LDS_WAIT(); asm volatile("" ::: "memory");
    }
    __syncthreads();
    if (tid < NE) ((int*)(wsp(F) + WS_CNT))[F.vcu * NE + tid] = cntL[tid];
}

__device__ __forceinline__ void phase_positions(Frame& F, int first_row) {
    const int tid = F.tid, lane = F.lane;
    LAS int* tot = (LAS int*)F.lds;
    LAS int* bef = tot + 512;
    LAS int* baseL = bef + 512;
    LAS int* totL = baseL + 32;
    const int* cnt = (const int*)(wsp(F) + WS_CNT);
    {
        const int e = tid & 31, part = tid >> 5;
        int s = 0, sb = 0;
        for (int j = part; j < F.G; j += 16) { const int cv = cnt[j * NE + e]; s += cv; sb += (j < F.vcu) ? cv : 0; }
        tot[part * 32 + e] = s; bef[part * 32 + e] = sb;
    }
    __syncthreads();
    if (tid < NE) { int s = 0, sb = 0;
        for (int p = 0; p < 16; ++p) { s += tot[p * 32 + tid]; sb += bef[p * 32 + tid]; }
        totL[tid] = s; baseL[tid] = sb; }
    __syncthreads();
    if (tid == 0) { int acc = 0;
        for (int e = 0; e < NE; ++e) { F.LCTL[8 + e] = acc; acc += (totL[e] + 255) >> 8; }
        F.LCTL[8 + NE] = acc; F.LCTL[48] = acc; }
    __syncthreads();
    int* tokmap = (int*)(wsp(F) + WS_TOKMAP);
    if (F.vcu == 0) {
        int* meta = (int*)(wsp(F) + WS_META);
        if (tid <= NE) meta[tid] = F.LCTL[8 + tid];
        if (tid == 0) meta[33] = F.LCTL[48];
        for (int e = 0; e < NE; ++e) { const int rb = 256 * F.LCTL[8 + e], n = totL[e], cap = 256 * (F.LCTL[8 + e + 1] - F.LCTL[8 + e]);
            for (int rr = n + tid; rr < cap; rr += NTHREADS) tokmap[rb + rr] = first_row; }
    }
    if (F.wave == 0) {
        const int* tope = (const int*)(wsp(F) + WS_TOPE); int* pos = (int*)(wsp(F) + WS_POS);
        int basereg = (lane < NE) ? 256 * F.LCTL[8 + lane] + baseL[lane] : 0;
        const int RPB = rows_per_block(first_row, F.G);
        const int rbeg = first_row + F.vcu * RPB, rend = min(rbeg + RPB, ROWS);
        for (int r0 = rbeg; r0 < rend; r0 += 16) {
            const int row = r0 + (lane >> 2), k = lane & 3;
            const bool valid = row < rend;
            const int e = valid ? tope[(size_t)row * 4 + k] : -1;
            int p = 0;
#pragma unroll 1
            for (int ee = 0; ee < NE; ++ee) {
                const unsigned long long mask = __ballot(e == ee);
                const int b0 = __shfl(basereg, ee);
                if (e == ee) p = b0 + __popcll(mask & ((1ull << lane) - 1ull));
                if (lane == ee) basereg += __popcll(mask);
            }
            if (valid) { pos[(size_t)row * 4 + k] = p; tokmap[p] = row; }
        }
    }
}

#ifndef PMASK
#define PMASK 0xFFFF
#endif
#define PE(k) (((PMASK) >> (k)) & 1)
#ifndef RMASK
#define RMASK 0
#endif
#define RP(k) for (int rep_ = 0; rep_ < ((((RMASK) >> (k)) & 1) ? 2 : 1); ++rep_, __syncthreads())
constexpr int NPH_LAYER = 10, GP_FINAL = 1 + DEPTH * NPH_LAYER, NPHASES = GP_FINAL + 1;
__global__ void __launch_bounds__(NTHREADS, 2) mega_fwd(Args args) {
    extern __shared__ __attribute__((aligned(16))) unsigned char lds_raw[];
    Frame F0;
    Frame& F = F0;
    F.lds = (LAS unsigned char*)lds_raw;
    F.LCTL = (volatile LAS int*)(F.lds + LDS_CTL_OFF);
    F.tid = threadIdx.x; F.lane = F.tid & 63; F.wave = __builtin_amdgcn_readfirstlane(F.tid >> 6);
    F.G = gridDim.x; { const int bx = blockIdx.x; F.vcu = (F.G % 8 == 0) ? (bx % 8) * (F.G / 8) + bx / 8 : bx; }
    if (F.tid < 128) F.LCTL[F.tid] = 0;
    if (F.tid == 0) {
#pragma unroll
        for (int i = 0; i < 23; ++i) { const unsigned long long p = (unsigned long long)args.in[i]; F.LCTL[128 + 2 * i] = (int)(unsigned)p; F.LCTL[129 + 2 * i] = (int)(unsigned)(p >> 32); }
        { const unsigned long long p = (unsigned long long)args.ws; F.LCTL[128 + 46] = (int)(unsigned)p; F.LCTL[129 + 46] = (int)(unsigned)(p >> 32); }
        { const unsigned long long p = (unsigned long long)args.out; F.LCTL[128 + 48] = (int)(unsigned)p; F.LCTL[129 + 48] = (int)(unsigned)(p >> 32); }
    }
    __syncthreads();
    const int lo = args.ph_lo, hi = args.ph_hi;
    XcdBarrier bar; bar.bar = (unsigned*)(wsp(F) + WS_CTL) + CW_BAR; bar.x = 0; bar.st = nullptr;
    if (hi - lo > 1) bar = xcd_barrier_post((unsigned*)(wsp(F) + WS_CTL) + CW_BAR, (volatile LAS unsigned*)F.LCTL);
#define IN(k) (lo <= (k) && (k) < hi)
#define FRESH(FN) Frame FN = F0; { int tz_ = F0.tid, vc_ = F0.vcu, g_ = F0.G; asm volatile("" : "+v"(tz_)); asm volatile("" : "+s"(vc_), "+s"(g_)); FN.tid = tz_; FN.lane = tz_ & 63; FN.wave = __builtin_amdgcn_readfirstlane(tz_ >> 6); FN.vcu = vc_; FN.G = g_; }
#define SEAM(k) do { if (IN(k) && IN((k) + 1)) xcd_barrier(bar); } while (0)

    if (PE(0) && IN(0)) RP(0) { FRESH(P); phase0(P); }
    SEAM(0);
    for (int l = 0; l < DEPTH; ++l) {
        const int base = 1 + l * NPH_LAYER; const bool na = (l & 1) == 0, last = (l == DEPTH - 1); const int jj = l >> 1;
        if (PE(1) && IN(base + 0)) { FRESH(P); phase_norm1(P, l); }
        SEAM(base + 0);
        if (PE(2) && IN(base + 1)) RP(2) {
            FRESH(P);
            const int Np = na ? 3072 : ML_INP;
            const bf16_t* Bt = na ? (const bf16_t*)(wsp(P) + WS_WQKV) + (size_t)jj * 3072 * D : (const bf16_t*)(wsp(P) + WS_WIN) + (size_t)jj * ML_INP * D;
            DenseOrder S; S.init(0, ROWS / 256, Np / 256, P.G, (int)blockIdx.x, wsp(P) + WS_HB, Bt, D);
            EpiStoreBf16 E{(bf16_t*)(wsp(P) + WS_PROJ), Np};
            pg8::gemm_phase<EpiStoreBf16, DenseOrder, false>(P.lds, P.tid, D, S, E);
        }
        SEAM(base + 1);
        if (IN(base + 2)) { if (na) { if (PE(3)) RP(3) { FRESH(P); phase_na_post(P, jj); } } else { if (PE(4)) { FRESH(P); phase_ml_post(P, jj); } } }
        SEAM(base + 2);
        if (IN(base + 3)) { if (na) { if (PE(5)) RP(5) { FRESH(P); phase_na_attn(P, jj); } } else { if (PE(6)) RP(6) { FRESH(P); phase_ml_scan(P); } } }
        SEAM(base + 3);
        if (PE(7) && IN(base + 4)) { if (!na) RP(7) { FRESH(P); phase_ml_final(P, jj); } }
        if (!na) SEAM(base + 4);
        if (PE(8) && IN(base + 5)) {
            FRESH(P);
            const bf16_t* Bt = na ? (const bf16_t*)(wsp(P) + WS_WONA) + (size_t)jj * D * D : (const bf16_t*)(wsp(P) + WS_WOML) + (size_t)jj * D * D;
            DenseOrder S; S.init(last ? ROWS_CTX / 256 : 0, last ? (ROWS - ROWS_CTX) / 256 : ROWS / 256, D / 256, P.G, (int)blockIdx.x, wsp(P) + WS_AO, Bt, D);
            EpiResid E{(float*)(wsp(P) + WS_XS), (const float*)(wsp(P) + WS_MOD) + (size_t)l * 9 * 6144 + 2 * D};
            pg8::gemm_phase<EpiResid, DenseOrder, false>(P.lds, P.tid, D, S, E);
        }
        SEAM(base + 5);
        if (PE(9) && IN(base + 6)) RP(9) { FRESH(P); phase_norm2_router(P, l, last ? ROWS_CTX : 0); }
        SEAM(base + 6);
        if (PE(10) && IN(base + 7)) RP(10) { FRESH(P); phase_positions(P, last ? ROWS_CTX : 0); }
        SEAM(base + 7);
        if (PE(11) && IN(base + 8)) RP(11) {
            FRESH(P);
            if (P.tid < 34) P.LCTL[8 + P.tid] = ((const int*)(wsp(P) + WS_META))[P.tid];
            __syncthreads();
            const int ntiles = P.LCTL[8 + NE];
            MoeOrder S; S.NT = 8; S.nunits = ntiles * 8; S.G = P.G; S.c = (int)blockIdx.x; S.K = D; S.A = (const char*)(wsp(P) + WS_HB);
            S.W = (const char*)(wsp(P) + WS_W1T) + (size_t)l * NE * 2048 * D * 2; S.estride = (size_t)2048 * D * 2; S.tokmap = (const int*)(wsp(P) + WS_TOKMAP); S.prefix = P.LCTL + 8; S.gather = true;
            EpiSwiglu E{(bf16_t*)(wsp(P) + WS_ACT), inp(P, I_B1) + (size_t)l * NE * 2048};
            pg8::gemm_phase<EpiSwiglu, MoeOrder, true>(P.lds, P.tid, D, S, E);
        }
        SEAM(base + 8);
        if (PE(12) && IN(base + 9)) RP(12) {
            FRESH(P);
            if (P.tid < 34) P.LCTL[8 + P.tid] = ((const int*)(wsp(P) + WS_META))[P.tid];
            __syncthreads();
            const int ntiles = P.LCTL[8 + NE];
            MoeOrder S; S.NT = 4; S.nunits = ntiles * 4; S.G = P.G; S.c = (int)blockIdx.x; S.K = D; S.A = (const char*)(wsp(P) + WS_ACT);
            S.W = (const char*)(wsp(P) + WS_W2T) + (size_t)l * NE * D * D * 2; S.estride = (size_t)D * D * 2; S.tokmap = (const int*)(wsp(P) + WS_TOKMAP); S.prefix = P.LCTL + 8; S.gather = false;
            EpiY E{(bf16_t*)(wsp(P) + WS_Y), inp(P, I_B2) + (size_t)l * NE * D};
            pg8::gemm_phase<EpiY, MoeOrder, false>(P.lds, P.tid, D, S, E);
        }
        SEAM(base + 9);
    }
    if (PE(13) && IN(GP_FINAL)) RP(13) { FRESH(P); phase_final(P); }
#undef IN
#undef SEAM
}

extern "C" void kernel_launch(void* const* d_in, const int* in_sizes, int n_in, void* d_out, int out_size, void* d_ws, size_t ws_size, hipStream_t stream) {
    static int grid = 0;
    if (grid == 0) {
        if (n_in != 23 || ws_size < WS_END) { fprintf(stderr, "kernel_launch: expected 23 inputs and >= %zu bytes of workspace (got %d, %zu)\n", (size_t)WS_END, n_in, ws_size); grid = -1; return; }
        int dev = 0, cus = 0, per_cu = 0;
        if (hipGetDevice(&dev) != hipSuccess || hipDeviceGetAttribute(&cus, hipDeviceAttributeMultiprocessorCount, dev) != hipSuccess) { grid = -1; return; }
        if (hipFuncSetAttribute((const void*)mega_fwd, hipFuncAttributeMaxDynamicSharedMemorySize, LDS_BYTES) != hipSuccess) { fprintf(stderr, "kernel_launch: hipFuncSetAttribute failed\n"); grid = -1; return; }
        if (hipOccupancyMaxActiveBlocksPerMultiprocessor(&per_cu, (const void*)mega_fwd, NTHREADS, LDS_BYTES) != hipSuccess || per_cu < 1)
            fprintf(stderr, "kernel_launch: occupancy query reports %d workgroups per CU\n", per_cu);
        (void)hipGetLastError();
        grid = cus;
        if (grid > 1024) grid = 1024;
    }
    if (grid < 0) return;
    (void)hipMemsetAsync((char*)d_ws + WS_CTL, 0, CTL_BYTES, stream);
    Args a{};
    for (int i = 0; i < 23; ++i) a.in[i] = (const float*)d_in[i];
    a.out = (float*)d_out; a.ws = (unsigned char*)d_ws;
#if MK_ONE_LAUNCH
    a.ph_lo = 0; a.ph_hi = NPHASES;
    hipLaunchKernelGGL(mega_fwd, dim3(grid), dim3(NTHREADS), LDS_BYTES, stream, a);
#else
    for (int gp = 0; gp < NPHASES; ++gp) {
        if (gp >= 1 && gp < GP_FINAL) { const int l = (gp - 1) / NPH_LAYER, p = (gp - 1) % NPH_LAYER; if (p == 4 && (l & 1) == 0) continue; }
        a.ph_lo = gp; a.ph_hi = gp + 1;
        hipLaunchKernelGGL(mega_fwd, dim3(grid), dim3(NTHREADS), LDS_BYTES, stream, a);
    }
#endif
    const hipError_t le = hipPeekAtLastError();
    if (le != hipSuccess) fprintf(stderr, "kernel_launch: launch failed: %s\n", hipGetErrorName(le));
}
```

```cpp
#include <hip/hip_runtime.h>
#include <cstdio>
#include <cstdint>

#ifndef MK_ONE_LAUNCH
#define MK_ONE_LAUNCH 1
#endif

#define LAS __attribute__((address_space(3)))
#define GAS __attribute__((address_space(1)))
typedef unsigned short bf16_t;
typedef short bf16x8 __attribute__((ext_vector_type(8)));
typedef short bf16x4 __attribute__((ext_vector_type(4)));
typedef float f32x4 __attribute__((ext_vector_type(4)));
typedef float f32x2 __attribute__((ext_vector_type(2)));
typedef unsigned u32x4 __attribute__((ext_vector_type(4)));
typedef unsigned u32x2 __attribute__((ext_vector_type(2)));

constexpr int D = 1024, NB = 8, SEQ = 4096, NCTX = 256, TT = NCTX + SEQ  , DEPTH = 4;
constexpr int ROWS_CTX = NB * NCTX  , ROWS = ROWS_CTX + NB * SEQ  ;
constexpr int NH_NA = 16, DH_NA = 64;
constexpr int NH_ML = 8, DV_ML = 128, DK_ML = 64, ML_IN = 3104, ML_INP = 3328;
constexpr int NE = 32, TOPK = 4, DFF = 1024;
constexpr int MAXTILES = (ROWS * TOPK) / 256 + NE  , MAXROWS = MAXTILES * 256;
constexpr float EPS = 1e-6f;
constexpr int NWAVES = 8, NTHREADS = 512;

constexpr size_t MiB = 1u << 20;
constexpr size_t al256(size_t x) { return (x + 255) & ~(size_t)255; }
constexpr size_t WS_CTL = 0, CTL_BYTES = 1 * MiB;
constexpr size_t WS_MOD = WS_CTL + CTL_BYTES;
constexpr size_t WS_ROPE = WS_MOD + al256((size_t)DEPTH * 9 * 6 * D * 4);
constexpr size_t WS_WQKV = WS_ROPE + al256(64 * 16 * 2 * 4);
constexpr size_t WS_WONA = WS_WQKV + (size_t)2 * 3072 * D * 2;
constexpr size_t WS_WIN = WS_WONA + (size_t)2 * D * D * 2;
constexpr size_t WS_WOML = WS_WIN + (size_t)2 * ML_INP * D * 2;
constexpr size_t WS_W1T = WS_WOML + (size_t)2 * D * D * 2;
constexpr size_t WS_W2T = WS_W1T + (size_t)DEPTH * NE * 2048 * D * 2;
constexpr size_t WS_XS = WS_W2T + (size_t)DEPTH * NE * D * D * 2;
constexpr size_t WS_HB = WS_XS + (size_t)ROWS * D * 4;
constexpr size_t WS_PROJ = WS_HB + (size_t)ROWS * D * 2;
constexpr size_t WS_QN = WS_PROJ + (size_t)ROWS * ML_INP * 2;
constexpr size_t WS_KN = WS_QN + (size_t)ROWS * D * 2;
constexpr size_t WS_VT = WS_KN + (size_t)ROWS * D * 2;
constexpr size_t WS_AO = WS_VT + (size_t)ROWS * D * 2;
constexpr size_t WS_HDIR = WS_QN;
constexpr size_t WS_GATES = WS_AO + (size_t)ROWS * D * 2;
constexpr size_t WS_TOPE = WS_GATES + al256((size_t)4 * NB * NH_ML * TT * 4);
constexpr size_t WS_TOPW = WS_TOPE + (size_t)ROWS * 4 * 4;
constexpr size_t WS_POS = WS_TOPW + (size_t)ROWS * 4 * 4;
constexpr size_t WS_TOKMAP = WS_POS + (size_t)ROWS * 4 * 4;
constexpr size_t WS_CNT = WS_TOKMAP + (size_t)MAXROWS * 4;
constexpr size_t WS_META = WS_CNT + (size_t)1024 * 32 * 4;
constexpr size_t WS_ACT = WS_META + 256;
constexpr size_t WS_Y = WS_ACT + (size_t)MAXROWS * D * 2;
constexpr size_t WS_HB8 = WS_Y + (size_t)MAXROWS * D * 2;
constexpr size_t WS_END = WS_HB8 + (size_t)ROWS * D;
static_assert(WS_XS % 256 == 0 && WS_ACT % 256 == 0 && WS_TOPE % 256 == 0, "ws alignment");

constexpr int CW_BAR = 4096;

constexpr int LDS_BYTES = 160 * 1024;
constexpr int LDS_CTL_OFF = LDS_BYTES - 1024;
constexpr int LDS_WORK = LDS_CTL_OFF;

#define LDS_WAIT() asm volatile("s_waitcnt lgkmcnt(0)" ::: "memory")
#define VM_WAIT() asm volatile("s_waitcnt vmcnt(0)" ::: "memory")
__device__ __forceinline__ unsigned f2bf(float f) { unsigned u = __builtin_bit_cast(unsigned, f); return (u + 0x7fffu + ((u >> 16) & 1u)) >> 16; }
__device__ __forceinline__ unsigned pk2(float lo, float hi) { unsigned r; asm volatile("v_cvt_pk_bf16_f32 %0, %1, %2" : "=v"(r) : "v"(lo), "v"(hi)); return r; }
__device__ __forceinline__ float bf2f(unsigned short b) { return __builtin_bit_cast(float, ((unsigned)b) << 16); }
__device__ __forceinline__ float bflo(unsigned w) { return __builtin_bit_cast(float, w << 16); }
__device__ __forceinline__ float bfhi(unsigned w) { return __builtin_bit_cast(float, w & 0xffff0000u); }
__device__ __forceinline__ float wave_sum(float v) {
#pragma unroll
    for (int o = 1; o < 64; o <<= 1) v += __shfl_xor(v, o);
    return v;
}
__device__ __forceinline__ float wave_max(float v) {
#pragma unroll
    for (int o = 1; o < 64; o <<= 1) v = fmaxf(v, __shfl_xor(v, o));
    return v;
}
__device__ __forceinline__ float sigmoidf_(float x) { return 1.f / (1.f + __expf(-x)); }

namespace pg8 {
constexpr int BM = 256, BK = 64, HALF = 128, HTB = HALF * BK * 2  , STAGE_BYTES = 8 * HTB;
__host__ __device__ __forceinline__ int lds_byte(int r, int c) { const int st = (r >> 4) * 2 + (c >> 5), rr = r & 15, cc = c & 31, ob = rr * 64 + cc * 2; return st * 1024 + (ob ^ (((ob >> 9) & 1) << 5)); }
__host__ __device__ __forceinline__ void stage_rc(int b, int& R, int& C) { const int st = b / 1024, sb = b % 1024, swz = sb ^ (((sb >> 9) & 1) << 5); R = (st >> 1) * 16 + swz / 64; C = (st & 1) * 32 + (swz % 64) / 2; }
__host__ __device__ __forceinline__ int perm32(int rho) { const int n = rho >> 4, i = rho & 15; return 8 * (i >> 2) + 4 * n + (i & 3); }

struct Unit { int pm, pn, e; };

typedef int v8i32 __attribute__((ext_vector_type(8)));
__device__ __forceinline__ v8i32 cat8(const bf16x8 a, const bf16x8 b) { union { bf16x8 h[2]; v8i32 v; } u; u.h[0] = a; u.h[1] = b; return u.v; }
__device__ __forceinline__ unsigned cvt_pk_bf16(float lo, float hi) { unsigned r; asm volatile("v_cvt_pk_bf16_f32 %0, %1, %2" : "=v"(r) : "v"(lo), "v"(hi)); return r; }

template <class Epi, class Sched, bool GATHER, bool FP8 = false>
__device__ __forceinline__ void gemm_phase(LAS unsigned char* lds, const int tid, const int K, const Sched& S, const Epi& E) {
    const int wid = __builtin_amdgcn_readfirstlane(tid >> 6), lane = tid & 63, wr = wid >> 2, wc = wid & 3, fr = lane & 15, fq = lane >> 4;
    const int nt = K / BK;
    int RA[2], CA[2];
    unsigned voffB[2], voffA[2][2];
#pragma unroll
    for (int i = 0; i < 2; ++i) { int R, C; stage_rc(tid * 16 + i * 8192, R, C); const int Rb = Epi::PERM ? ((R & ~31) + perm32(R & 31)) : R;
        RA[i] = R; CA[i] = C; voffB[i] = (unsigned)(Rb * K + C) * 2u; }
    const size_t kstep = (size_t)(BK * 2);
    const size_t hstep = (size_t)HALF * K * 2;
    const unsigned ldsw = (unsigned)wid * 1024u;
    const int aoff = lds_byte(wr * 64 + fr, fq * 8), boff = lds_byte(wc * 32 + fr, fq * 8);
#define PG8_SA(b, h) (((b) * 2 + (h)) * HTB)
#define PG8_SB(b, h) ((4 + (b) * 2 + (h)) * HTB)
#define PG8_STAGE(bufoff, gbase, voff) do { _Pragma("unroll") for (int _i = 0; _i < 2; ++_i) \
        __builtin_amdgcn_global_load_lds((const unsigned*)((const char*)(gbase) + (voff)[_i]), (LAS unsigned*)(lds + (bufoff) + ldsw + _i * 8192), 16, 0, 0); } while (0)
#define PG8_LDA(dst, b, h) do { _Pragma("unroll") for (int m = 0; m < 4; ++m) _Pragma("unroll") for (int k = 0; k < 2; ++k) dst[m][k] = *(const LAS bf16x8*)(lds + PG8_SA(b, h) + aoff + m * 2048 + k * 1024); } while (0)
#define PG8_LDB(dst, b, h) do { _Pragma("unroll") for (int n = 0; n < 2; ++n) _Pragma("unroll") for (int k = 0; k < 2; ++k) dst[n][k] = *(const LAS bf16x8*)(lds + PG8_SB(b, h) + boff + n * 2048 + k * 1024); } while (0)
#define PG8_MMA(ai, bj, At, Bt) do { __builtin_amdgcn_s_setprio(1); _Pragma("unroll") for (int m = 0; m < 4; ++m) _Pragma("unroll") for (int n = 0; n < 2; ++n) { \
        if constexpr (FP8) { acc[ai][bj][m][n] = __builtin_amdgcn_mfma_scale_f32_16x16x128_f8f6f4(cat8(Bt[n][0], Bt[n][1]), cat8(At[m][0], At[m][1]), acc[ai][bj][m][n], 0, 0, 0, 0x7f7f7f7f, 0, 0x7f7f7f7f); } \
        else { _Pragma("unroll") for (int k = 0; k < 2; ++k) acc[ai][bj][m][n] = __builtin_amdgcn_mfma_f32_16x16x32_bf16(Bt[n][k], At[m][k], acc[ai][bj][m][n], 0, 0, 0); } } \
        __builtin_amdgcn_s_setprio(0); } while (0)
#define PG8_WAIT_V(n) asm volatile("s_waitcnt vmcnt(" #n ")" ::: "memory")
#define PG8_WAIT_L(n) asm volatile("s_waitcnt lgkmcnt(" #n ")" ::: "memory")
#define PG8_BAR __builtin_amdgcn_s_barrier()
#define PG8_SCHED __builtin_amdgcn_sched_barrier(0)
#define PG8_SETVOFF(u) do { _Pragma("unroll") for (int _h = 0; _h < 2; ++_h) _Pragma("unroll") for (int _i = 0; _i < 2; ++_i) { \
        if constexpr (GATHER) voffA[_h][_i] = ((unsigned)S.a_row(u, _h * HALF + RA[_i]) * (unsigned)K + (unsigned)CA[_i]) * 2u; \
        else voffA[_h][_i] = ((unsigned)(_h * HALF + RA[_i]) * (unsigned)K + (unsigned)CA[_i]) * 2u; } } while (0)
    Unit cur, nxt; int ui = 0;
    if (!S.next(0, cur)) return;
    f32x4 acc[2][2][4][2];
#pragma unroll
    for (int a = 0; a < 2; ++a)
#pragma unroll
        for (int b = 0; b < 2; ++b)
#pragma unroll
            for (int m = 0; m < 4; ++m)
#pragma unroll
                for (int n = 0; n < 2; ++n) acc[a][b][m][n] = (f32x4){0.f, 0.f, 0.f, 0.f};
    bf16x8 At[4][2], B0[2][2], B1[2][2];
    const char* cA = S.a_base(cur); const char* cB = S.b_base(cur);
    PG8_SETVOFF(cur);
    PG8_STAGE(PG8_SB(0, 0), cB, voffB); PG8_STAGE(PG8_SB(0, 1), cB + hstep, voffB); PG8_STAGE(PG8_SA(0, 0), cA, voffA[0]); PG8_STAGE(PG8_SA(0, 1), cA, voffA[1]);
    if (wr == 1) PG8_BAR;
    PG8_WAIT_V(2); PG8_BAR;
    PG8_STAGE(PG8_SB(1, 0), cB + kstep, voffB); PG8_STAGE(PG8_SA(1, 0), cA + kstep, voffA[0]); PG8_STAGE(PG8_SB(1, 1), cB + hstep + kstep, voffB);
    PG8_WAIT_V(6); PG8_BAR;
    for (;;) {
        const bool has_next = S.next(ui + 1, nxt);
        const char* nA = has_next ? S.a_base(nxt) : cA; const char* nB = has_next ? S.b_base(nxt) : cB;
        for (int t = 0; t < nt; t += 2) {
            const bool last = (t == nt - 2);
            const char* a1 = cA + (size_t)(t + 1) * kstep;
            const char* a2 = last ? nA : cA + (size_t)(t + 2) * kstep; const char* b2 = last ? nB : cB + (size_t)(t + 2) * kstep;
            const char* a3 = a2 + kstep; const char* b3 = b2 + kstep;
            PG8_LDB(B0, 0, 0); PG8_LDB(B1, 0, 1); PG8_SCHED; PG8_LDA(At, 0, 0); PG8_STAGE(PG8_SA(1, 1), a1, voffA[1]);
            if constexpr (GATHER) { if (last && has_next) PG8_SETVOFF(nxt); }
            PG8_WAIT_V(8); PG8_WAIT_L(0); PG8_BAR; PG8_MMA(0, 0, At, B0); PG8_MMA(0, 1, At, B1); PG8_BAR; PG8_SCHED;
            PG8_LDA(At, 0, 1); PG8_STAGE(PG8_SB(0, 0), b2, voffB); PG8_STAGE(PG8_SB(0, 1), b2 + hstep, voffB); PG8_STAGE(PG8_SA(0, 0), a2, voffA[0]);
            PG8_WAIT_V(8); PG8_WAIT_L(0); PG8_BAR; PG8_MMA(1, 0, At, B0); PG8_MMA(1, 1, At, B1); PG8_BAR; PG8_SCHED;
            PG8_LDB(B0, 1, 0); PG8_LDB(B1, 1, 1); PG8_SCHED; PG8_LDA(At, 1, 0); PG8_STAGE(PG8_SA(0, 1), a2, voffA[1]);
            PG8_WAIT_V(8); PG8_WAIT_L(0); PG8_BAR; PG8_MMA(0, 0, At, B0); PG8_MMA(0, 1, At, B1); PG8_BAR; PG8_SCHED;
            PG8_LDA(At, 1, 1); PG8_STAGE(PG8_SB(1, 0), b3, voffB); PG8_STAGE(PG8_SB(1, 1), b3 + hstep, voffB); PG8_STAGE(PG8_SA(1, 0), a3, voffA[0]);
            PG8_WAIT_V(8); PG8_WAIT_L(0); PG8_BAR; PG8_MMA(1, 0, At, B0); PG8_MMA(1, 1, At, B1); PG8_BAR; PG8_SCHED;
        }
        if (wr == 0) PG8_BAR;
        E(acc, cur, wr, wc, fr, fq);
        if (!has_next) break;
#pragma unroll
        for (int a = 0; a < 2; ++a)
#pragma unroll
            for (int b = 0; b < 2; ++b)
#pragma unroll
                for (int m = 0; m < 4; ++m)
#pragma unroll
                    for (int n = 0; n < 2; ++n) acc[a][b][m][n] = (f32x4){0.f, 0.f, 0.f, 0.f};
        cur = nxt; cA = nA; cB = nB; ++ui;
        if (wr == 1) PG8_BAR;
    }
    PG8_WAIT_V(0);
    PG8_BAR;
#undef PG8_SA
#undef PG8_SB
#undef PG8_STAGE
#undef PG8_LDA
#undef PG8_LDB
#undef PG8_MMA
#undef PG8_WAIT_V
#undef PG8_WAIT_L
#undef PG8_BAR
#undef PG8_SCHED
#undef PG8_SETVOFF
}
}

#define XB_TMO      128
#define XB_XCNT(j)  (256  + 64 * (j))
#define XB_XSUB(j)  (1280 + 64 * (j))
#define XB_XGEN(j)  (2304 + 64 * (j))
#define XB_TOP      3328
#define XB_TOPGEN   3392
#define XCD_BAR_WORDS 3456
#define XB_SPIN_CAP (1u << 18)

__device__ __forceinline__ unsigned xb_ld(unsigned* p)              { return __hip_atomic_load(p, __ATOMIC_RELAXED, __HIP_MEMORY_SCOPE_AGENT); }
__device__ __forceinline__ unsigned xb_add(unsigned* p, unsigned v) { return __hip_atomic_fetch_add(p, v, __ATOMIC_RELAXED, __HIP_MEMORY_SCOPE_AGENT); }
__device__ __forceinline__ unsigned xb_xcc_id() { return (unsigned)__builtin_amdgcn_s_getreg((3 << 11) | 20) & 0xFu; }
#define XB_SPIN(cond, bar) do { unsigned _sp = 0; while (cond) { __builtin_amdgcn_s_sleep(1); \
    if ((++_sp & 255u) == 0u) { if (xb_ld(&(bar)[XB_TMO])) break; if (_sp > XB_SPIN_CAP) { atomicAdd(&(bar)[XB_TMO], 1u); break; } } } } while (0)

struct XcdBarrier {
    unsigned* bar; unsigned x;
    volatile LAS unsigned* st;
};

__device__ __forceinline__ XcdBarrier xcd_barrier_post(unsigned* bar, volatile LAS unsigned* st) {
    XcdBarrier b; b.bar = bar; b.x = xb_xcc_id(); b.st = st;
    if (threadIdx.x == 0) (void)xb_add(&bar[XB_XCNT(b.x)], 1u);
    return b;
}
__device__ __forceinline__ void xcd_barrier_complete(unsigned* bar, unsigned x, unsigned& nloc, unsigned& nx) {
    const unsigned G = gridDim.x * gridDim.y * gridDim.z;
    unsigned sum, cnt, mine, sp = 0u;
    for (;;) {
        sum = 0u; cnt = 0u; mine = 0u;
#pragma unroll
        for (unsigned j = 0; j < 16; ++j) { const unsigned c = xb_ld(&bar[XB_XCNT(j)]); sum += c; cnt += (c > 0u) ? 1u : 0u; mine = (j == x) ? c : mine; }
        if (sum == G) break;
        __builtin_amdgcn_s_sleep(1);
        if ((++sp & 255u) == 0u) { if (xb_ld(&bar[XB_TMO])) break; if (sp > XB_SPIN_CAP) { atomicAdd(&bar[XB_TMO], 1u); break; } }
    }
    nloc = mine > 0u ? mine : 1u; nx = cnt > 0u ? cnt : 1u;
}

__device__ __forceinline__ void xcd_barrier(const XcdBarrier& b) {
    asm volatile("s_waitcnt vmcnt(0)" ::: "memory");
    __syncthreads();
    if (threadIdx.x == 0) {
        unsigned* bar = b.bar;
        __builtin_amdgcn_s_waitcnt(0);
        unsigned nloc = b.st[0], nx = b.st[1];
        if (nloc == 0u) { xcd_barrier_complete(bar, b.x, nloc, nx); b.st[0] = nloc; b.st[1] = nx; }
        const unsigned old = xb_add(&bar[XB_XSUB(b.x)], 1u);
        const unsigned gen = old / nloc;
        if (old + 1u == (gen + 1u) * nloc) {
            __builtin_amdgcn_fence(__ATOMIC_RELEASE, "agent");
            asm volatile("s_waitcnt vmcnt(0)" ::: "memory");
            const unsigned og = xb_add(&bar[XB_TOP], 1u);
            const unsigned tg = og / nx;
            if (og + 1u == (tg + 1u) * nx) xb_add(&bar[XB_TOPGEN], 1u);
            else XB_SPIN(xb_ld(&bar[XB_TOPGEN]) == tg, bar);
            __builtin_amdgcn_fence(__ATOMIC_ACQUIRE, "agent");
            xb_add(&bar[XB_XGEN(b.x)], 1u);
            asm volatile("s_waitcnt vmcnt(0)" ::: "memory");
        } else {
            XB_SPIN(xb_ld(&bar[XB_XGEN(b.x)]) == gen, bar);
            __builtin_amdgcn_fence(__ATOMIC_ACQUIRE, "agent");
            asm volatile("s_waitcnt vmcnt(0)" ::: "memory");
        }
    }
    __syncthreads();
}

struct Args { const float* in[23]; float* out; unsigned char* ws; int ph_lo, ph_hi; };
struct Frame {
    LAS unsigned char* lds;
    volatile LAS int* LCTL;
    int tid, lane, wave, vcu, G;
};
__device__ __forceinline__ unsigned long long ptr_get(const Frame& F, int i) {
    const unsigned lo = (unsigned)F.LCTL[128 + 2 * i], hi = (unsigned)F.LCTL[129 + 2 * i];
    return ((unsigned long long)(unsigned)__builtin_amdgcn_readfirstlane((int)hi) << 32) | (unsigned long long)(unsigned)__builtin_amdgcn_readfirstlane((int)lo);
}
__device__ __forceinline__ const float* inp(const Frame& F, int i) { return (const float*)ptr_get(F, i); }
__device__ __forceinline__ unsigned char* wsp(const Frame& F) { return (unsigned char*)ptr_get(F, 23); }
__device__ __forceinline__ float* outp(const Frame& F) { return (float*)ptr_get(F, 24); }
enum { I_X = 0, I_C, I_CTX, I_CCTX, I_WADA, I_BADA, I_GMIX, I_GFFN, I_WQKV, I_QGAIN, I_KGAIN, I_RPB, I_WONA, I_WIN, I_BGATE, I_MHGAIN, I_WOML,
       I_WR, I_BR, I_W1, I_B1, I_W2, I_B2 };

struct DenseOrder {
    int nM, nN, nwg, G, c, pm0, K; const char* A; const char* Bt;
    __device__ __forceinline__ void init(int pm0_, int nM_, int nN_, int G_, int c_, const void* A_, const void* Bt_, int K_) { pm0 = pm0_; nM = nM_; nN = nN_; nwg = nM * nN; G = G_; c = c_; A = (const char*)A_; Bt = (const char*)Bt_; K = K_; }
    __device__ __forceinline__ bool next(int i, pg8::Unit& u) const {
        const long L = (long)i * G + c; if (L >= nwg) return false;
        int wgid = (int)L; { const int q = nwg / 8, r = nwg % 8, xcd = wgid % 8, off = wgid / 8; wgid = (xcd < r ? xcd * (q + 1) : r * (q + 1) + (xcd - r) * q) + off; }
        const int nig = 8 * nN, gid = wgid / nig, fm = gid * 8, gsz = (nM - fm) < 8 ? (nM - fm) : 8;
        u.pm = pm0 + fm + ((wgid % nig) % gsz); u.pn = (wgid % nig) / gsz; u.e = 0; return true;
    }
    __device__ __forceinline__ const char* a_base(const pg8::Unit& u) const { return A + (size_t)u.pm * 256 * K * 2; }
    __device__ __forceinline__ const char* b_base(const pg8::Unit& u) const { return Bt + (size_t)u.pn * 256 * K * 2; }
    __device__ __forceinline__ int a_row(const pg8::Unit&, int) const { return 0; }
};
struct MoeOrder {
    int NT, nunits, G, c, K; const char* A; const char* W; size_t estride; const int* tokmap; volatile LAS int* prefix; bool gather;
    __device__ __forceinline__ bool next(int i, pg8::Unit& u) const {
        const long L = (long)i * G + c; if (L >= nunits) return false;
        int wgid = (int)L; { const int q = nunits / 8, r = nunits % 8, xcd = wgid % 8, off = wgid / 8; wgid = (xcd < r ? xcd * (q + 1) : r * (q + 1) + (xcd - r) * q) + off; }
        const int tile = wgid / NT; u.pm = tile; u.pn = wgid - tile * NT;
        int e = 0;
#pragma unroll 1
        for (int j = 1; j < NE; ++j) e += (prefix[j] <= tile) ? 1 : 0;
        u.e = e; return true;
    }
    __device__ __forceinline__ const char* a_base(const pg8::Unit& u) const { return gather ? A : A + (size_t)u.pm * 256 * K * 2; }
    __device__ __forceinline__ const char* b_base(const pg8::Unit& u) const { return W + (size_t)u.e * estride + (size_t)u.pn * 256 * K * 2; }
    __device__ __forceinline__ int a_row(const pg8::Unit& u, int r) const { return tokmap[u.pm * 256 + r]; }
};

typedef f32x4 AccT[2][2][4][2];
struct EpiStoreBf16 {
    static constexpr bool PERM = true;
    bf16_t* O; int ldc;
    __device__ __forceinline__ void operator()(const AccT& acc, const pg8::Unit& u, int wr, int wc, int fr, int fq) const {
        const int row0 = u.pm * 256 + wr * 64 + fr, col0 = u.pn * 256 + wc * 32 + 8 * fq;
#pragma unroll
        for (int ai = 0; ai < 2; ++ai)
#pragma unroll
            for (int m = 0; m < 4; ++m) { bf16_t* rowp = O + (size_t)(row0 + ai * 128 + m * 16) * ldc + col0;
#pragma unroll
                for (int bj = 0; bj < 2; ++bj) { const f32x4 v0 = acc[ai][bj][m][0], v1 = acc[ai][bj][m][1];
                    u32x4 w; w.x = pg8::cvt_pk_bf16(v0[0], v0[1]); w.y = pg8::cvt_pk_bf16(v0[2], v0[3]); w.z = pg8::cvt_pk_bf16(v1[0], v1[1]); w.w = pg8::cvt_pk_bf16(v1[2], v1[3]);
                    *(u32x4*)(rowp + bj * 128) = w; } }
    }
};
struct EpiY {
    static constexpr bool PERM = true;
    bf16_t* O; const float* b2;
    __device__ __forceinline__ void operator()(const AccT& acc, const pg8::Unit& u, int wr, int wc, int fr, int fq) const {
        const int row0 = u.pm * 256 + wr * 64 + fr, col0 = u.pn * 256 + wc * 32 + 8 * fq;
        const float* bp = b2 + (size_t)u.e * D + col0;
        f32x4 bv[2][2];
#pragma unroll
        for (int bj = 0; bj < 2; ++bj)
#pragma unroll
            for (int n = 0; n < 2; ++n) bv[bj][n] = *(const f32x4*)(bp + bj * 128 + 4 * n);
#pragma unroll
        for (int ai = 0; ai < 2; ++ai)
#pragma unroll
            for (int m = 0; m < 4; ++m) { bf16_t* rowp = O + (size_t)(row0 + ai * 128 + m * 16) * D + col0;
#pragma unroll
                for (int bj = 0; bj < 2; ++bj) { const f32x4 v0 = acc[ai][bj][m][0] + bv[bj][0], v1 = acc[ai][bj][m][1] + bv[bj][1];
                    u32x4 w; w.x = pg8::cvt_pk_bf16(v0[0], v0[1]); w.y = pg8::cvt_pk_bf16(v0[2], v0[3]); w.z = pg8::cvt_pk_bf16(v1[0], v1[1]); w.w = pg8::cvt_pk_bf16(v1[2], v1[3]);
                    *(u32x4*)(rowp + bj * 128) = w; } }
    }
};
struct EpiSwiglu {
    static constexpr bool PERM = true;
    bf16_t* O; const float* b1;
    __device__ __forceinline__ void operator()(const AccT& acc, const pg8::Unit& u, int wr, int wc, int fr, int fq) const {
        const int row0 = u.pm * 256 + wr * 64 + fr, cc0 = u.pn * 128 + wc * 32 + 8 * fq;
        const float* bp = b1 + (size_t)u.e * 2048 + cc0;
        f32x4 bg[2], bl[2];
#pragma unroll
        for (int n = 0; n < 2; ++n) { bg[n] = *(const f32x4*)(bp + 4 * n); bl[n] = *(const f32x4*)(bp + 1024 + 4 * n); }
#pragma unroll
        for (int ai = 0; ai < 2; ++ai)
#pragma unroll
            for (int m = 0; m < 4; ++m) { bf16_t* rowp = O + (size_t)(row0 + ai * 128 + m * 16) * D + cc0;
                float o[8];
#pragma unroll
                for (int n = 0; n < 2; ++n) { const f32x4 gl = acc[ai][0][m][n] * (1.0f / 2048.0f) + bg[n], li = acc[ai][1][m][n] * (1.0f / 2048.0f) + bl[n];
#pragma unroll
                    for (int j = 0; j < 4; ++j) { const float g = fminf(gl[j], 7.0f), l = fminf(fmaxf(li[j], -7.0f), 7.0f);
                        o[4 * n + j] = g * sigmoidf_(1.702f * g) * (l + 1.0f); } }
                u32x4 w; w.x = pg8::cvt_pk_bf16(o[0], o[1]); w.y = pg8::cvt_pk_bf16(o[2], o[3]); w.z = pg8::cvt_pk_bf16(o[4], o[5]); w.w = pg8::cvt_pk_bf16(o[6], o[7]);
                *(u32x4*)rowp = w; }
    }
};
struct EpiResid {
    static constexpr bool PERM = false;
    float* xs; const float* g;
    __device__ __forceinline__ void operator()(const AccT& acc, const pg8::Unit& u, int wr, int wc, int fr, int fq) const {
        const int row0 = u.pm * 256 + wr * 64 + fr, col0 = u.pn * 256 + wc * 32 + 4 * fq;
        const int mb = u.pm < 8 ? 8 : ((u.pm - 8) >> 4);
        const float* gp = g + (size_t)mb * 6144 + col0;
        f32x4 gv[2][2];
#pragma unroll
        for (int bj = 0; bj < 2; ++bj)
#pragma unroll
            for (int n = 0; n < 2; ++n) gv[bj][n] = *(const f32x4*)(gp + bj * 128 + n * 16);
#pragma unroll
        for (int ai = 0; ai < 2; ++ai)
#pragma unroll
            for (int m = 0; m < 4; ++m) { float* rowp = xs + (size_t)(row0 + ai * 128 + m * 16) * D + col0;
#pragma unroll
                for (int bj = 0; bj < 2; ++bj)
#pragma unroll
                    for (int n = 0; n < 2; ++n) { f32x4* p = (f32x4*)(rowp + bj * 128 + n * 16); *p = *p + gv[bj][n] * acc[ai][bj][m][n]; } }
    }
};

__device__ __forceinline__ const float* modp(const Frame& F, int l, int mb, int chunk) { return (const float*)(wsp(F) + WS_MOD) + ((size_t)(l * 9 + mb) * 6 + chunk) * D; }
__device__ __forceinline__ int row_mb(int row) { return row < ROWS_CTX ? 8 : ((row - ROWS_CTX) >> 12); }

__device__ __forceinline__ void transpose_item(const float* W, int N, int Nvalid, bf16_t* WT, int k0, int n0, LAS float* scr, int lane) {
    const int nn = 4 * (lane & 15);
    const bool ok = (n0 + nn) < Nvalid;
    f32x4 v[16];
#pragma unroll
    for (int i = 0; i < 16; ++i) { const int kk = 4 * i + (lane >> 4);
        v[i] = ok ? *(const f32x4*)(W + (size_t)(k0 + kk) * N + n0 + nn) : (f32x4){0.f, 0.f, 0.f, 0.f}; }
#pragma unroll
    for (int i = 0; i < 16; ++i) { const int kk = 4 * i + (lane >> 4); LAS float* s = scr + kk * 65 + nn;
        s[0] = v[i][0]; s[1] = v[i][1]; s[2] = v[i][2]; s[3] = v[i][3]; }
    LDS_WAIT(); asm volatile("" ::: "memory");
    const int c = lane & 7;
#pragma unroll
    for (int j = 0; j < 8; ++j) { const int n = (lane >> 3) + 8 * j; const LAS float* s = scr + (8 * c) * 65 + n;
        u32x4 o; o.x = pk2(s[0 * 65], s[1 * 65]); o.y = pk2(s[2 * 65], s[3 * 65]); o.z = pk2(s[4 * 65], s[5 * 65]); o.w = pk2(s[6 * 65], s[7 * 65]);
        *(u32x4*)(WT + (size_t)n * D + k0 + 8 * c) = o; }
    LDS_WAIT(); asm volatile("" ::: "memory");
}
__device__ __forceinline__ unsigned pk4_fp8(float a, float b, float c, float d) { int p = __builtin_amdgcn_cvt_pk_fp8_f32(a, b, 0, false); p = __builtin_amdgcn_cvt_pk_fp8_f32(c, d, p, true); return (unsigned)p; }
__device__ __forceinline__ void transpose_item_f8(const float* W, int N, unsigned char* WT, int k0, int n0, LAS float* scr, int lane, float scale) {
    const int nn = 4 * (lane & 15);
    f32x4 v[16];
#pragma unroll
    for (int i = 0; i < 16; ++i) { const int kk = 4 * i + (lane >> 4); v[i] = *(const f32x4*)(W + (size_t)(k0 + kk) * N + n0 + nn); }
#pragma unroll
    for (int i = 0; i < 16; ++i) { const int kk = 4 * i + (lane >> 4); LAS float* s = scr + kk * 65 + nn;
        s[0] = v[i][0] * scale; s[1] = v[i][1] * scale; s[2] = v[i][2] * scale; s[3] = v[i][3] * scale; }
    LDS_WAIT(); asm volatile("" ::: "memory");
    const int c = lane & 3;
#pragma unroll
    for (int j = 0; j < 4; ++j) { const int n = (lane >> 2) + 16 * j; const LAS float* s = scr + (16 * c) * 65 + n;
        u32x4 o; o.x = pk4_fp8(s[0 * 65], s[1 * 65], s[2 * 65], s[3 * 65]); o.y = pk4_fp8(s[4 * 65], s[5 * 65], s[6 * 65], s[7 * 65]);
        o.z = pk4_fp8(s[8 * 65], s[9 * 65], s[10 * 65], s[11 * 65]); o.w = pk4_fp8(s[12 * 65], s[13 * 65], s[14 * 65], s[15 * 65]);
        *(u32x4*)(WT + (size_t)n * D + k0 + 16 * c) = o; }
    LDS_WAIT(); asm volatile("" ::: "memory");
}
__device__ __forceinline__ void phase0(Frame& F) {
    const int tid = F.tid, lane = F.lane, wave = F.wave;
    {
        LAS float* sT = (LAS float*)F.lds;
        LAS float* red = (LAS float*)(F.lds + 40960);
        const float* c = inp(F, I_C); const float* cctx = inp(F, I_CCTX);
        for (int idx = tid; idx < 9 * D; idx += NTHREADS) { const int mb = idx >> 10, k = idx & 1023; const float cv = mb < 8 ? c[mb * D + k] : cctx[k]; sT[idx] = cv / (1.f + __expf(-cv)); }
        __syncthreads();
        float* mod = (float*)(wsp(F) + WS_MOD);
        for (int task = F.vcu; task < DEPTH * 96; task += F.G) {
            const int l = task / 96, cb = task % 96;
            const float* wp = inp(F, I_WADA) + ((size_t)l * D + wave * 128) * 6144 + cb * 64 + lane;
            float acc[9];
#pragma unroll
            for (int mb = 0; mb < 9; ++mb) acc[mb] = 0.f;
#pragma unroll 8
            for (int k = 0; k < 128; ++k) { const float wv = wp[(size_t)k * 6144];
#pragma unroll
                for (int mb = 0; mb < 9; ++mb) acc[mb] += sT[mb * D + wave * 128 + k] * wv; }
#pragma unroll
            for (int mb = 0; mb < 9; ++mb) red[(wave * 9 + mb) * 64 + lane] = acc[mb];
            __syncthreads();
            for (int idx = tid; idx < 9 * 64; idx += NTHREADS) { const int mb = idx >> 6, ln = idx & 63; float s = 0.f;
#pragma unroll
                for (int w = 0; w < 8; ++w) s += red[(w * 9 + mb) * 64 + ln];
                const int col = cb * 64 + ln;
                mod[(size_t)(l * 9 + mb) * 6144 + col] = s + inp(F, I_BADA)[l * 6144 + col]; }
            __syncthreads();
        }
        if (blockIdx.x == 0) {
            float* rope = (float*)(wsp(F) + WS_ROPE);
            for (int idx = tid; idx < 64 * 16; idx += NTHREADS) { const int pos = idx >> 4, i = idx & 15; const float inv = powf(10000.0f, -(float)i / 16.0f); const float ang = (float)pos * inv;
                rope[idx * 2] = cosf(ang); rope[idx * 2 + 1] = sinf(ang); }
        }
        __syncthreads();
    }
    {
        LAS float* scr = (LAS float*)(F.lds + wave * 16640);
        const int gw = F.vcu * NWAVES + wave, NGW = F.G * NWAVES;
        constexpr int I_QKV = 2 * 16 * 48, I_WO = 4 * 16 * 16, I_IN = 2 * 16 * 52, I_1 = DEPTH * NE * 16 * 32, I_2 = DEPTH * NE * 16 * 16;
        for (int it0 = gw; it0 < I_QKV + I_WO + I_IN + I_1 + I_2; it0 += NGW) {
            int it = it0;
            if (it < I_QKV) { const int j = it / 768, r = it % 768, kb = r / 48, nb = r % 48;
                transpose_item(inp(F, I_WQKV) + (size_t)j * D * 3072, 3072, 3072, (bf16_t*)(wsp(F) + WS_WQKV) + ((size_t)j * 3072 + nb * 64) * D, kb * 64, nb * 64, scr, lane); continue; }
            it -= I_QKV;
            if (it < I_WO) { const int m = it / 256, r = it % 256, kb = r / 16, nb = r % 16;
                const float* W = (m < 2) ? inp(F, I_WONA) + (size_t)m * D * D : inp(F, I_WOML) + (size_t)(m - 2) * D * D;
                bf16_t* dst = (m < 2) ? (bf16_t*)(wsp(F) + WS_WONA) + (size_t)m * D * D : (bf16_t*)(wsp(F) + WS_WOML) + (size_t)(m - 2) * D * D;
                transpose_item(W, D, D, dst + (size_t)nb * 64 * D, kb * 64, nb * 64, scr, lane); continue; }
            it -= I_WO;
            if (it < I_IN) { const int j = it / 832, r = it % 832, kb = r / 52, nb = r % 52;
                transpose_item(inp(F, I_WIN) + (size_t)j * D * ML_IN, ML_IN, ML_IN, (bf16_t*)(wsp(F) + WS_WIN) + ((size_t)j * ML_INP + nb * 64) * D, kb * 64, nb * 64, scr, lane); continue; }
            it -= I_IN;
            if (it < I_1) { const int le = it / 512, r = it % 512, kb = r / 32, nb = r % 32;
                const int n0 = nb * 64, bj = n0 >> 10, j0 = n0 & 1023, pn = j0 >> 7, jj0 = j0 & 127, drow = pn * 256 + bj * 128 + jj0;
                transpose_item_f8(inp(F, I_W1) + (size_t)le * D * 2048, 2048, (unsigned char*)(wsp(F) + WS_W1T) + ((size_t)le * 2048 + drow) * D, kb * 64, n0, scr, lane, 128.0f); continue; }
            it -= I_1;
            { const int le = it / 256, r = it % 256, kb = r / 16, nb = r % 16;
                transpose_item(inp(F, I_W2) + (size_t)le * D * D, D, D, (bf16_t*)(wsp(F) + WS_W2T) + ((size_t)le * D + nb * 64) * D, kb * 64, nb * 64, scr, lane); }
        }
    }
}

__device__ __forceinline__ void moe_combine(const Frame& F, int row, int lprev, int mb, f32x4 (&v)[4]) {
    const int* pos = (const int*)(wsp(F) + WS_POS) + (size_t)row * 4;
    const float* tw = (const float*)(wsp(F) + WS_TOPW) + (size_t)row * 4;
    const bf16_t* Y = (const bf16_t*)(wsp(F) + WS_Y);
    f32x4 a[4];
#pragma unroll
    for (int j = 0; j < 4; ++j) a[j] = (f32x4){0.f, 0.f, 0.f, 0.f};
#pragma unroll
    for (int k = 0; k < 4; ++k) { const int p = pos[k]; const float w = tw[k]; const u32x2* yp = (const u32x2*)(Y + (size_t)p * D) + F.lane;
#pragma unroll
        for (int j = 0; j < 4; ++j) { const u32x2 y = yp[64 * j]; a[j] = a[j] + w * (f32x4){bflo(y.x), bfhi(y.x), bflo(y.y), bfhi(y.y)}; } }
    const f32x4* g2 = (const f32x4*)modp(F, lprev, mb, 5) + F.lane;
#pragma unroll
    for (int j = 0; j < 4; ++j) v[j] = v[j] + g2[64 * j] * a[j];
}

__device__ __forceinline__ void phase_norm1(Frame& F, int l) {
    const int gw = F.vcu * NWAVES + F.wave, NGW = F.G * NWAVES, lane = F.lane;
    float* xs = (float*)(wsp(F) + WS_XS); bf16_t* hb = (bf16_t*)(wsp(F) + WS_HB);
    const f32x4* gm = (const f32x4*)(inp(F, I_GMIX) + l * D) + lane;
    for (int row = gw; row < ROWS; row += NGW) {
        const int mb = row_mb(row);
        const float* src = (l == 0) ? (row < ROWS_CTX ? inp(F, I_CTX) + (size_t)row * D : inp(F, I_X) + (size_t)(row - ROWS_CTX) * D) : xs + (size_t)row * D;
        const f32x4* xr = (const f32x4*)src + lane;
        f32x4 v[4];
#pragma unroll
        for (int j = 0; j < 4; ++j) v[j] = xr[64 * j];
        if (l > 0) moe_combine(F, row, l - 1, mb, v);
        f32x4* xw = (f32x4*)(xs + (size_t)row * D) + lane;
        float ss = 0.f;
#pragma unroll
        for (int j = 0; j < 4; ++j) { xw[64 * j] = v[j]; ss += (v[j][0] * v[j][0] + v[j][1] * v[j][1]) + (v[j][2] * v[j][2] + v[j][3] * v[j][3]); }
        const float rs = 1.0f / sqrtf(wave_sum(ss) * (1.f / D) + EPS);
        const f32x4* sh = (const f32x4*)modp(F, l, mb, 0) + lane; const f32x4* sc = (const f32x4*)modp(F, l, mb, 1) + lane;
        u32x2* o8 = (u32x2*)(hb + (size_t)row * D) + lane;
#pragma unroll
        for (int j = 0; j < 4; ++j) { const f32x4 h = (v[j] * rs) * gm[64 * j] * (sc[64 * j] + 1.0f) + sh[64 * j];
            u32x2 w; w.x = pk2(h[0], h[1]); w.y = pk2(h[2], h[3]); o8[64 * j] = w; }
    }
}
__device__ __forceinline__ void phase_final(Frame& F) {
    const int gw = F.vcu * NWAVES + F.wave, NGW = F.G * NWAVES, lane = F.lane;
    const float* xs = (const float*)(wsp(F) + WS_XS);
    for (int row = ROWS_CTX + gw; row < ROWS; row += NGW) {
        const int mb = row_mb(row);
        const f32x4* xr = (const f32x4*)(xs + (size_t)row * D) + lane;
        f32x4 v[4];
#pragma unroll
        for (int j = 0; j < 4; ++j) v[j] = xr[64 * j];
        moe_combine(F, row, DEPTH - 1, mb, v);
        f32x4* o = (f32x4*)(outp(F) + (size_t)(row - ROWS_CTX) * D) + lane;
#pragma unroll
        for (int j = 0; j < 4; ++j) o[64 * j] = v[j];
    }
}

__device__ __forceinline__ void phase_na_post(Frame& F, int jn) {
    const int gw = F.vcu * NWAVES + F.wave, NGW = F.G * NWAVES, lane = F.lane;
    const bf16_t* proj = (const bf16_t*)(wsp(F) + WS_PROJ);
    bf16_t* QN = (bf16_t*)(wsp(F) + WS_QN); bf16_t* KN = (bf16_t*)(wsp(F) + WS_KN); bf16_t* VT = (bf16_t*)(wsp(F) + WS_VT);
    LAS bf16_t* vs = (LAS bf16_t*)(F.lds + F.wave * (64 * 72 * 2));
    const int c8 = lane & 7, rl = lane >> 3;
    float qg[8], kg[8];
#pragma unroll
    for (int e = 0; e < 8; ++e) { qg[e] = inp(F, I_QGAIN)[jn * 64 + c8 * 8 + e] * (0.125f * 1.44269504f); kg[e] = inp(F, I_KGAIN)[jn * 64 + c8 * 8 + e]; }
    for (int item = gw; item < (ROWS / 64) * NH_NA; item += NGW) {
        const int rb = item >> 4, h = item & 15, row0 = rb * 64;
        int b, tp0;
        if (row0 < ROWS_CTX) { b = row0 >> 8; tp0 = row0 & 255; } else { b = (row0 - ROWS_CTX) >> 12; tp0 = NCTX + ((row0 - ROWS_CTX) & 4095); }
        const size_t seqbase = ((size_t)(b * NH_NA + h) * TT + tp0) * 64;
#pragma unroll
        for (int i = 0; i < 8; ++i) {
            const int r = i * 8 + rl;
            const bf16_t* pr = proj + (size_t)(row0 + r) * 3072 + h * 64 + c8 * 8;
            const u32x4 qv = *(const u32x4*)pr, kv = *(const u32x4*)(pr + 1024), vv = *(const u32x4*)(pr + 2048);
            float q[8] = {bflo(qv.x), bfhi(qv.x), bflo(qv.y), bfhi(qv.y), bflo(qv.z), bfhi(qv.z), bflo(qv.w), bfhi(qv.w)};
            float k[8] = {bflo(kv.x), bfhi(kv.x), bflo(kv.y), bfhi(kv.y), bflo(kv.z), bfhi(kv.z), bflo(kv.w), bfhi(kv.w)};
            float sq = 0.f, sk = 0.f;
#pragma unroll
            for (int e = 0; e < 8; ++e) { sq += q[e] * q[e]; sk += k[e] * k[e]; }
            sq += __shfl_xor(sq, 1); sq += __shfl_xor(sq, 2); sq += __shfl_xor(sq, 4);
            sk += __shfl_xor(sk, 1); sk += __shfl_xor(sk, 2); sk += __shfl_xor(sk, 4);
            const float rq = 1.0f / sqrtf(sq * (1.f / 64) + EPS), rk = 1.0f / sqrtf(sk * (1.f / 64) + EPS);
            u32x4 qo, ko;
            qo.x = pk2(q[0] * rq * qg[0], q[1] * rq * qg[1]); qo.y = pk2(q[2] * rq * qg[2], q[3] * rq * qg[3]); qo.z = pk2(q[4] * rq * qg[4], q[5] * rq * qg[5]); qo.w = pk2(q[6] * rq * qg[6], q[7] * rq * qg[7]);
            ko.x = pk2(k[0] * rk * kg[0], k[1] * rk * kg[1]); ko.y = pk2(k[2] * rk * kg[2], k[3] * rk * kg[3]); ko.z = pk2(k[4] * rk * kg[4], k[5] * rk * kg[5]); ko.w = pk2(k[6] * rk * kg[6], k[7] * rk * kg[7]);
            *(u32x4*)(QN + seqbase + (size_t)r * 64 + c8 * 8) = qo;
            *(u32x4*)(KN + seqbase + (size_t)r * 64 + c8 * 8) = ko;
            *(LAS u32x4*)(vs + r * 72 + c8 * 8) = vv;
        }
        LDS_WAIT(); asm volatile("" ::: "memory");
#pragma unroll
        for (int j = 0; j < 8; ++j) {
            const int d = rl + 8 * j;
            const LAS bf16_t* s = vs + (8 * c8) * 72 + d;
            u32x4 o;
            o.x = (unsigned)s[0 * 72] | ((unsigned)s[1 * 72] << 16); o.y = (unsigned)s[2 * 72] | ((unsigned)s[3 * 72] << 16);
            o.z = (unsigned)s[4 * 72] | ((unsigned)s[5 * 72] << 16); o.w = (unsigned)s[6 * 72] | ((unsigned)s[7 * 72] << 16);
            *(u32x4*)(VT + ((size_t)(b * NH_NA + h) * 64 + d) * TT + tp0 + 8 * c8) = o;
        }
        LDS_WAIT(); asm volatile("" ::: "memory");
    }
}

__device__ __forceinline__ bf16x8 ld_bf16x8(const bf16_t* p) { return *(const bf16x8*)p; }
constexpr int NA_LD = 72;
constexpr int NA_TILE = 64 * NA_LD * 2;
struct NaState { f32x4 o[4]; float m, lsum; };
constexpr int NA_RING = 2 * 2 * 64 * NA_LD * 2;
constexpr int NA_BT_LD = 128, NA_BT_OFF = 48;
template <bool H0, bool H1, bool WIN>
__device__ __forceinline__ void na_tile(NaState& st, const LAS bf16_t* KL, const LAS bf16_t* VL, const bf16x8 qf0, const bf16x8 qf1,
                                        const LAS float* brow, const float (&madd)[16], int q16, int g) {
    constexpr int NH = (H0 ? 1 : 0) + (H1 ? 1 : 0), HB = H0 ? 0 : 1;
    f32x4 s[2 * NH];
    bf16x8 vf[NH][4];
#pragma unroll
    for (int hh = 0; hh < NH; ++hh) { const int half = HB + hh;
#pragma unroll
        for (int nb = 0; nb < 2; ++nb) { f32x4 init = (f32x4){0.f, 0.f, 0.f, 0.f};
            if (WIN) {
#pragma unroll
                for (int rg = 0; rg < 4; ++rg) init[rg] = brow[32 * half + 16 * nb + rg] + madd[8 * half + 4 * nb + rg]; }
            const LAS bf16_t* kp = KL + (half * 32 + 16 * nb + q16) * NA_LD + 8 * g;
            init = __builtin_amdgcn_mfma_f32_16x16x32_bf16(*(const LAS bf16x8*)kp, qf0, init, 0, 0, 0);
            s[2 * hh + nb] = __builtin_amdgcn_mfma_f32_16x16x32_bf16(*(const LAS bf16x8*)(kp + 32), qf1, init, 0, 0, 0); }
#pragma unroll
        for (int j4 = 0; j4 < 4; ++j4) { const LAS bf16_t* vp = VL + (16 * j4 + q16) * NA_LD + half * 32 + 4 * g;
            const bf16x4 va = *(const LAS bf16x4*)vp, vb = *(const LAS bf16x4*)(vp + 16);
            vf[hh][j4] = (bf16x8){va[0], va[1], va[2], va[3], vb[0], vb[1], vb[2], vb[3]}; } }
    float bm = fmaxf(fmaxf(s[0][0], s[0][1]), fmaxf(s[0][2], s[0][3]));
#pragma unroll
    for (int i = 1; i < 2 * NH; ++i) bm = fmaxf(bm, fmaxf(fmaxf(s[i][0], s[i][1]), fmaxf(s[i][2], s[i][3])));
    bm = fmaxf(bm, __shfl_xor(bm, 16)); bm = fmaxf(bm, __shfl_xor(bm, 32));
    float ps = 0.f;
    if (__all(bm <= st.m)) {
        const float mn = st.m;
#pragma unroll
        for (int i = 0; i < 2 * NH; ++i)
#pragma unroll
            for (int rg = 0; rg < 4; ++rg) { s[i][rg] = __builtin_amdgcn_exp2f(s[i][rg] - mn); ps += s[i][rg]; }
        st.lsum += ps;
    } else {
        const float mn = fmaxf(st.m, bm), alpha = __builtin_amdgcn_exp2f(st.m - mn);
#pragma unroll
        for (int i = 0; i < 2 * NH; ++i)
#pragma unroll
            for (int rg = 0; rg < 4; ++rg) { s[i][rg] = __builtin_amdgcn_exp2f(s[i][rg] - mn); ps += s[i][rg]; }
        st.lsum = st.lsum * alpha + ps; st.m = mn;
#pragma unroll
        for (int j = 0; j < 4; ++j) st.o[j] = st.o[j] * alpha;
    }
#pragma unroll
    for (int hh = 0; hh < NH; ++hh) { union { u32x4 u; bf16x8 v; } pf;
        pf.u.x = pg8::cvt_pk_bf16(s[2 * hh][0], s[2 * hh][1]); pf.u.y = pg8::cvt_pk_bf16(s[2 * hh][2], s[2 * hh][3]); pf.u.z = pg8::cvt_pk_bf16(s[2 * hh + 1][0], s[2 * hh + 1][1]); pf.u.w = pg8::cvt_pk_bf16(s[2 * hh + 1][2], s[2 * hh + 1][3]);
#pragma unroll
        for (int j4 = 0; j4 < 4; ++j4) st.o[j4] = __builtin_amdgcn_mfma_f32_16x16x32_bf16(vf[hh][j4], pf.v, st.o[j4], 0, 0, 0); }
}
__device__ __forceinline__ void na_block_task(const Frame& F, int jn, int b, int h, bool ctxq, int p) {
    const int tid = F.tid, lane = F.lane, wave = F.wave, q16 = lane & 15, g = lane >> 4;
    const bf16_t* Qb = (const bf16_t*)(wsp(F) + WS_QN) + (size_t)(b * NH_NA + h) * TT * 64;
    const bf16_t* Kb = (const bf16_t*)(wsp(F) + WS_KN) + (size_t)(b * NH_NA + h) * TT * 64;
    const bf16_t* Vb = (const bf16_t*)(wsp(F) + WS_VT) + (size_t)(b * NH_NA + h) * 64 * TT;
    const float* rpb = inp(F, I_RPB) + (size_t)(jn * NH_NA + h) * 15 * 31;
    const int rw = 2 * p + (wave >> 2), qw = wave & 3, qc = qw * 16 + q16;
    const int qtp = ctxq ? p * 128 + wave * 16 + q16 : NCTX + rw * 64 + qc;
    const bf16x8 qf0 = ld_bf16x8(Qb + (size_t)qtp * 64 + 8 * g), qf1 = ld_bf16x8(Qb + (size_t)qtp * 64 + 32 + 8 * g);
    NaState st;
#pragma unroll
    for (int j = 0; j < 4; ++j) st.o[j] = (f32x4){0.f, 0.f, 0.f, 0.f};
    st.m = -1e30f; st.lsum = 0.f;
    const int r0w = min(max(rw - 4, 0), 56), c0 = min(max(qc - 8, 0), 48);
    const int kr_lo = min(max(2 * p - 4, 0), 56), kr_hi = min(max(2 * p + 1 - 4, 0), 56) + 7;
    const int ntile = ctxq ? 4 : 4 + (kr_hi - kr_lo + 1);
    LAS bf16_t* ring = (LAS bf16_t*)F.lds;
    LAS float* btab = (LAS float*)(F.lds + NA_RING);
    if (!ctxq) { for (int i = tid; i < 15 * NA_BT_LD; i += NTHREADS) { const int dr = i >> 7, c = (i & 127) - NA_BT_OFF; btab[i] = (c >= 0 && c < 31) ? rpb[dr * 31 + c] * 1.44269504f : 0.f; } }
    float madd[16];
#pragma unroll
    for (int e = 0; e < 16; ++e) { const int kc = 32 * (e >> 3) + 16 * ((e >> 2) & 1) + 4 * g + (e & 3); madd[e] = (kc >= c0 && kc <= c0 + 15) ? 0.f : -1e30f; }
    const int bcol = NA_BT_OFF + 4 * g - qc + 15;
    const int r = tid >> 3, c8 = tid & 7;
    u32x4 kA, vA, kB, vB;
#define NA_TOK0(t) ((t) < 4 ? 64 * (t) : NCTX + 64 * (kr_lo + (t) - 4))
#define NA_LOAD(t, kk, vv) do { const int tok0_ = NA_TOK0(t); kk = *(const u32x4*)(Kb + (size_t)(tok0_ + r) * 64 + 8 * c8); vv = *(const u32x4*)(Vb + (size_t)r * TT + tok0_ + 8 * c8); } while (0)
#define NA_WRITE(bufi, kk, vv) do { LAS bf16_t* dst_ = ring + (bufi) * (2 * 64 * NA_LD); *(LAS u32x4*)(dst_ + r * NA_LD + 8 * c8) = kk; *(LAS u32x4*)(dst_ + 64 * NA_LD + r * NA_LD + 8 * c8) = vv; } while (0)
#define NA_TILE(t, bufi) do { const LAS bf16_t* KL = ring + (bufi) * (2 * 64 * NA_LD); const LAS bf16_t* VL = KL + 64 * NA_LD; \
        if ((t) < 4) na_tile<true, true, false>(st, KL, VL, qf0, qf1, btab, madd, q16, g); \
        else if (!ctxq) { const int kr = kr_lo + (t) - 4; \
            if (kr >= r0w && kr <= r0w + 7) { const LAS float* brow = btab + (kr - rw + 7) * NA_BT_LD + bcol; \
                if (qw == 0) na_tile<true, false, true>(st, KL, VL, qf0, qf1, brow, madd, q16, g); \
                else if (qw == 3) na_tile<false, true, true>(st, KL, VL, qf0, qf1, brow, madd, q16, g); \
                else na_tile<true, true, true>(st, KL, VL, qf0, qf1, brow, madd, q16, g); } } } while (0)
    NA_LOAD(0, kA, vA); NA_LOAD(1, kB, vB);
    NA_WRITE(0, kA, vA);
    __syncthreads();
    NA_LOAD(2, kA, vA);
    for (int t = 0; t < ntile; t += 2) {
        NA_TILE(t, 0);
        if (t + 1 < ntile) NA_WRITE(1, kB, vB);
        __syncthreads();
        if (t + 3 < ntile) NA_LOAD(t + 3, kB, vB);
        if (t + 1 >= ntile) break;
        NA_TILE(t + 1, 1);
        if (t + 2 < ntile) NA_WRITE(0, kA, vA);
        __syncthreads();
        if (t + 4 < ntile) NA_LOAD(t + 4, kA, vA);
    }
#undef NA_TOK0
#undef NA_LOAD
#undef NA_WRITE
#undef NA_TILE
    float lsum = st.lsum; lsum += __shfl_xor(lsum, 16); lsum += __shfl_xor(lsum, 32);
    const float inv = 1.0f / lsum;
    const int row = ctxq ? b * NCTX + p * 128 + wave * 16 + q16 : ROWS_CTX + b * SEQ + rw * 64 + qc;
    bf16_t* op = (bf16_t*)(wsp(F) + WS_AO) + (size_t)row * D + h * 64 + 4 * g;
#pragma unroll
    for (int j4 = 0; j4 < 4; ++j4) { u32x2 w; w.x = pk2(st.o[j4][0] * inv, st.o[j4][1] * inv); w.y = pk2(st.o[j4][2] * inv, st.o[j4][3] * inv); *(u32x2*)(op + 16 * j4) = w; }
}
__device__ __forceinline__ void phase_na_attn(Frame& F, int jn) {
    constexpr int NLAT = NB * NH_NA * 32, NCTXT = NB * NH_NA * 2;
    for (int bt = F.vcu; bt < NLAT + NCTXT; bt += F.G) {
        if (bt < NLAT) { const int bh = bt >> 5, p = bt & 31; na_block_task(F, jn, bh >> 4, bh & 15, false, p); }
        else { const int u = bt - NLAT, bh = u >> 1; na_block_task(F, jn, bh >> 4, bh & 15, true, u & 1); }
    }
}

__device__ __forceinline__ void row_decode(int row, int& b, int& tp) {
    if (row < ROWS_CTX) { b = row >> 8; tp = row & 255; } else { b = (row - ROWS_CTX) >> 12; tp = NCTX + ((row - ROWS_CTX) & 4095); }
}
__device__ __forceinline__ void unpack8(const u32x4 v, float (&f)[8]) { f[0] = bflo(v.x); f[1] = bfhi(v.x); f[2] = bflo(v.y); f[3] = bfhi(v.y); f[4] = bflo(v.z); f[5] = bfhi(v.z); f[6] = bflo(v.w); f[7] = bfhi(v.w); }
__device__ __forceinline__ u32x4 pack8(const float (&f)[8]) { u32x4 o; o.x = pk2(f[0], f[1]); o.y = pk2(f[2], f[3]); o.z = pk2(f[4], f[5]); o.w = pk2(f[6], f[7]); return o; }
__device__ __forceinline__ void phase_ml_post(Frame& F, int jm) {
    const int gw = F.vcu * NWAVES + F.wave, NGW = F.G * NWAVES, lane = F.lane;
    bf16_t* proj = (bf16_t*)(wsp(F) + WS_PROJ);
    const float* rope = (const float*)(wsp(F) + WS_ROPE);
    float* gates = (float*)(wsp(F) + WS_GATES);
    const int t16 = lane >> 2, sub = lane & 3, hf = sub >> 1, i0 = 8 * (sub & 1), cbase = t16 * 64 + 32 * hf + i0;
    const float scale = t16 < 8 ? 0.125f : 1.0f;
    for (int row = gw; row < ROWS; row += NGW) {
        int b, tp; row_decode(row, b, tp);
        bf16_t* pr = proj + (size_t)row * ML_INP;
        float a[8], c[8], o1[8], o2[8];
        unpack8(*(const u32x4*)(pr + cbase), a); unpack8(*(const u32x4*)(pr + cbase + 16), c);
        if (tp >= NCTX) {
            const int s = tp - NCTX, pos = hf ? (s & 63) : (s >> 6);
            const float* rp = rope + (pos * 16 + i0) * 2;
#pragma unroll
            for (int e = 0; e < 8; ++e) { const float cs = rp[2 * e], sn = rp[2 * e + 1]; o1[e] = (a[e] * cs - c[e] * sn) * scale; o2[e] = (a[e] * sn + c[e] * cs) * scale; }
        } else {
#pragma unroll
            for (int e = 0; e < 8; ++e) { o1[e] = a[e] * scale; o2[e] = c[e] * scale; }
        }
        float gv = 0.f;
        if (lane < 32) gv = bf2f(pr[3072 + lane]);
        *(u32x4*)(pr + cbase) = pack8(o1); *(u32x4*)(pr + cbase + 16) = pack8(o2);
        if (lane < 32) {
            float v = gv + inp(F, I_BGATE)[jm * 32 + lane];
            v = 15.0f * tanhf(v * (1.0f / 15.0f));
            const int gi = lane >> 3, hh = lane & 7;
            if (gi & 1) v = fminf(v, 0.f) - log1pf(__expf(-fabsf(v)));
            gates[((size_t)(gi * NB + b) * NH_ML + hh) * TT + tp] = v;
        }
    }
}

constexpr int ML_LD = 72;
constexpr int ML_QL = 0, ML_KL = 9216, ML_KET = 18432, ML_VTL = 27648, ML_SDL = 36864, ML_C0L = 46080, ML_N0L = 55296, ML_DENL = 55552;
__device__ __forceinline__ float wave_prefix_sum(float v, int lane) {
#pragma unroll
    for (int o = 1; o < 64; o <<= 1) { const float t = __shfl_up(v, o); if (lane >= o) v += t; }
    return v;
}
__device__ __forceinline__ float wave_prefix_max(float v, int lane) {
#pragma unroll
    for (int o = 1; o < 64; o <<= 1) { const float t = __shfl_up(v, o); if (lane >= o) v = fmaxf(v, t); }
    return v;
}
__device__ __forceinline__ int ml_grow(int b, int tp) { return tp < NCTX ? b * NCTX + tp : ROWS_CTX + b * SEQ + (tp - NCTX); }
__device__ __forceinline__ void ml_task(Frame& F, int b, int hh, int dir, int vh) {
    const int tid = F.tid, lane = F.lane, w = F.wave, l15 = lane & 15, g = lane >> 4;
    LAS bf16_t* QL = (LAS bf16_t*)(F.lds + ML_QL); LAS bf16_t* KL = (LAS bf16_t*)(F.lds + ML_KL); LAS bf16_t* KET = (LAS bf16_t*)(F.lds + ML_KET);
    LAS bf16_t* VTL = (LAS bf16_t*)(F.lds + ML_VTL); LAS bf16_t* SDL = (LAS bf16_t*)(F.lds + ML_SDL); LAS bf16_t* C0L = (LAS bf16_t*)(F.lds + ML_C0L);
    LAS float* n0L = (LAS float*)(F.lds + ML_N0L); LAS float* denL = (LAS float*)(F.lds + ML_DENL);
    const bf16_t* proj = (const bf16_t*)(wsp(F) + WS_PROJ);
    const float* gI = (const float*)(wsp(F) + WS_GATES) + ((size_t)((dir * 2 + 0) * NB + b) * NH_ML + hh) * TT;
    const float* gF = (const float*)(wsp(F) + WS_GATES) + ((size_t)((dir * 2 + 1) * NB + b) * NH_ML + hh) * TT;
    bf16_t* hout = (bf16_t*)(wsp(F) + WS_HDIR) + (size_t)dir * ROWS * D + hh * DV_ML + vh * 64;
    const int r = tid >> 3, c8 = tid & 7, sr = dir ? 63 - r : r;
    const int bt = w >> 1, bc0 = 2 * (w & 1);
    for (int i = tid; i < 64 * ML_LD / 2; i += NTHREADS) ((LAS unsigned*)C0L)[i] = 0u;
    if (w == 0) n0L[lane] = 0.f;
    f32x4 Cst[2]; Cst[0] = (f32x4){0.f, 0.f, 0.f, 0.f}; Cst[1] = (f32x4){0.f, 0.f, 0.f, 0.f};
    float nst = 0.f, m0 = 0.f;
    u32x4 qv, kv, vv; float igv, lfv;
    {
        const int tb = dir ? 192 : 0;
        const bf16_t* pr = proj + (size_t)ml_grow(b, tb + r) * ML_INP;
        qv = *(const u32x4*)(pr + hh * 64 + c8 * 8); kv = *(const u32x4*)(pr + 512 + hh * 64 + c8 * 8); vv = *(const u32x4*)(pr + 1024 + hh * DV_ML + vh * 64 + c8 * 8);
        const int tpg = dir ? tb + 63 - lane : tb + lane;
        igv = gI[tpg]; lfv = gF[tpg];
    }
    __syncthreads();
    for (int c = 0; c < TT / 64; ++c) {
        const int tb = dir ? (c < 4 ? 192 - 64 * c : 4544 - 64 * c) : 64 * c;
        const float cum = wave_prefix_sum(lfv, lane);
        const float av = igv - cum;
        const float pmax = wave_prefix_max(av, lane);
        const float cl = __shfl(cum, 63);
        const float wend = cl - cum + igv;
        const float ml = wave_max(wend);
        const float eend = __expf(wend - ml);
        const float Mv = fmaxf(m0, pmax);
        const float winter = __expf(m0 - Mv);
        const float floorv = __expf(-(cum + Mv));
        const float mnew = fmaxf(cl + m0, ml);
        const float Ac = __expf(cl + m0 - mnew), Gc = __expf(ml - mnew);
        *(LAS u32x4*)(QL + sr * ML_LD + c8 * 8) = qv;
        *(LAS u32x4*)(KL + sr * ML_LD + c8 * 8) = kv;
        {
            const float es = __shfl(eend, sr);
            float kf[8]; unpack8(kv, kf);
            const unsigned vw[4] = {vv.x, vv.y, vv.z, vv.w};
#pragma unroll
            for (int e = 0; e < 8; ++e) { KET[(c8 * 8 + e) * ML_LD + sr] = (bf16_t)f2bf(kf[e] * es); VTL[(c8 * 8 + e) * ML_LD + sr] = (bf16_t)((vw[e >> 1] >> (16 * (e & 1))) & 0xffffu); }
        }
        if (c + 1 < TT / 64) {
            const int cn = c + 1, tbn = dir ? (cn < 4 ? 192 - 64 * cn : 4544 - 64 * cn) : 64 * cn;
            const bf16_t* pr = proj + (size_t)ml_grow(b, tbn + r) * ML_INP;
            qv = *(const u32x4*)(pr + hh * 64 + c8 * 8); kv = *(const u32x4*)(pr + 512 + hh * 64 + c8 * 8); vv = *(const u32x4*)(pr + 1024 + hh * DV_ML + vh * 64 + c8 * 8);
            const int tpg = dir ? tbn + 63 - lane : tbn + lane;
            igv = gI[tpg]; lfv = gF[tpg];
        }
        __syncthreads();
#pragma unroll
        for (int x = 0; x < 2; ++x) {
            const int bs = bc0 + x;
            f32x4 acc = (f32x4){0.f, 0.f, 0.f, 0.f};
            if (bs <= bt) {
#pragma unroll
                for (int ks = 0; ks < 2; ++ks) { const bf16x8 af = *(const LAS bf16x8*)(QL + (16 * bt + l15) * ML_LD + 32 * ks + 8 * g), bfv = *(const LAS bf16x8*)(KL + (16 * bs + l15) * ML_LD + 32 * ks + 8 * g);
                    acc = __builtin_amdgcn_mfma_f32_16x16x32_bf16(af, bfv, acc, 0, 0, 0); }
            }
            const int s = 16 * bs + l15;
            const float a_s = __shfl(av, s);
#pragma unroll
            for (int rg = 0; rg < 4; ++rg) { const int t = 16 * bt + 4 * g + rg; const float M_t = __shfl(Mv, t);
                const float val = (s <= t) ? acc[rg] * __expf(a_s - M_t) : 0.f;
                SDL[t * ML_LD + s] = (bf16_t)f2bf(val); }
        }
        __syncthreads();
        if (w == 0) {
            float rs = 0.f, qn = 0.f;
#pragma unroll
            for (int j = 0; j < 8; ++j) { float sd[8], qf[8]; unpack8(*(const LAS u32x4*)(SDL + lane * ML_LD + 8 * j), sd); unpack8(*(const LAS u32x4*)(QL + lane * ML_LD + 8 * j), qf);
                const f32x4 n0a = *(const LAS f32x4*)(n0L + 8 * j), n0b = *(const LAS f32x4*)(n0L + 8 * j + 4);
                rs += ((sd[0] + sd[1]) + (sd[2] + sd[3])) + ((sd[4] + sd[5]) + (sd[6] + sd[7]));
                qn += qf[0] * n0a[0] + qf[1] * n0a[1] + qf[2] * n0a[2] + qf[3] * n0a[3] + qf[4] * n0b[0] + qf[5] * n0b[1] + qf[6] * n0b[2] + qf[7] * n0b[3]; }
            denL[lane] = rs + winter * qn;
            float dn = 0.f;
#pragma unroll
            for (int j = 0; j < 8; ++j) { float kf[8]; unpack8(*(const LAS u32x4*)(KET + lane * ML_LD + 8 * j), kf); dn += ((kf[0] + kf[1]) + (kf[2] + kf[3])) + ((kf[4] + kf[5]) + (kf[6] + kf[7])); }
            nst = Ac * nst + Gc * dn;
            LDS_WAIT();
            n0L[lane] = nst;
        }
        f32x4 nin[2], nit[2];
#pragma unroll
        for (int x = 0; x < 2; ++x) {
            const int bv = bc0 + x;
            f32x4 a1 = (f32x4){0.f, 0.f, 0.f, 0.f}, a2 = (f32x4){0.f, 0.f, 0.f, 0.f}, a3 = (f32x4){0.f, 0.f, 0.f, 0.f};
#pragma unroll
            for (int ks = 0; ks < 2; ++ks) {
                const bf16x8 sdf = *(const LAS bf16x8*)(SDL + (16 * bt + l15) * ML_LD + 32 * ks + 8 * g), vtf = *(const LAS bf16x8*)(VTL + (16 * bv + l15) * ML_LD + 32 * ks + 8 * g);
                const bf16x8 qf = *(const LAS bf16x8*)(QL + (16 * bt + l15) * ML_LD + 32 * ks + 8 * g), c0f = *(const LAS bf16x8*)(C0L + (16 * bv + l15) * ML_LD + 32 * ks + 8 * g);
                const bf16x8 vt2 = *(const LAS bf16x8*)(VTL + (16 * bt + l15) * ML_LD + 32 * ks + 8 * g), kef = *(const LAS bf16x8*)(KET + (16 * bv + l15) * ML_LD + 32 * ks + 8 * g);
                a1 = __builtin_amdgcn_mfma_f32_16x16x32_bf16(sdf, vtf, a1, 0, 0, 0);
                a2 = __builtin_amdgcn_mfma_f32_16x16x32_bf16(qf, c0f, a2, 0, 0, 0);
                a3 = __builtin_amdgcn_mfma_f32_16x16x32_bf16(vt2, kef, a3, 0, 0, 0);
            }
            nin[x] = a1; nit[x] = a2;
            Cst[x] = Cst[x] * Ac + a3 * Gc;
        }
        __syncthreads();
#pragma unroll
        for (int x = 0; x < 2; ++x) {
            const int bv = bc0 + x;
#pragma unroll
            for (int rg = 0; rg < 4; ++rg) { const int t = 16 * bt + 4 * g + rg;
                const float den = denL[t], w_t = __shfl(winter, t), fl_t = __shfl(floorv, t);
                const float hv = (nin[x][rg] + w_t * nit[x][rg]) / fmaxf(fabsf(den), fl_t);
                const int rr = dir ? 63 - t : t;
                hout[(size_t)ml_grow(b, tb + rr) * D + 16 * bv + l15] = (bf16_t)f2bf(hv);
                C0L[(16 * bt + 4 * g + rg) * ML_LD + 16 * bv + l15] = (bf16_t)f2bf(Cst[x][rg]); }
        }
        m0 = mnew;
    }
    __syncthreads();
}
__device__ __forceinline__ void phase_ml_scan(Frame& F) {
    for (int task = F.vcu; task < NB * NH_ML * 4; task += F.G) {
        const int vh = task & 1, dir = (task >> 1) & 1, bh = task >> 2;
        ml_task(F, bh >> 3, bh & 7, dir, vh);
    }
}

__device__ __forceinline__ void phase_ml_final(Frame& F, int jm) {
    const int gw = F.vcu * NWAVES + F.wave, NGW = F.G * NWAVES, lane = F.lane;
    const bf16_t* hfw = (const bf16_t*)(wsp(F) + WS_HDIR); const bf16_t* hbw = hfw + (size_t)ROWS * D;
    const bf16_t* proj = (const bf16_t*)(wsp(F) + WS_PROJ);
    bf16_t* ao = (bf16_t*)(wsp(F) + WS_AO);
    const float* gain = inp(F, I_MHGAIN) + jm * D + lane * 16;
    for (int row = gw; row < ROWS; row += NGW) {
        const size_t off = (size_t)row * D + lane * 16;
        float a0[8], a1[8], b0[8], b1[8], g0[8], g1[8];
        unpack8(*(const u32x4*)(hfw + off), a0); unpack8(*(const u32x4*)(hfw + off + 8), a1);
        unpack8(*(const u32x4*)(hbw + off), b0); unpack8(*(const u32x4*)(hbw + off + 8), b1);
        const bf16_t* ogp = proj + (size_t)row * ML_INP + 2048 + lane * 16;
        unpack8(*(const u32x4*)ogp, g0); unpack8(*(const u32x4*)(ogp + 8), g1);
        float ss = 0.f;
#pragma unroll
        for (int e = 0; e < 8; ++e) { a0[e] += b0[e]; a1[e] += b1[e]; ss += a0[e] * a0[e] + a1[e] * a1[e]; }
        ss += __shfl_xor(ss, 1); ss += __shfl_xor(ss, 2); ss += __shfl_xor(ss, 4);
        const float rs = 1.0f / sqrtf(ss * (1.f / DV_ML) + EPS);
        float o0[8], o1[8];
#pragma unroll
        for (int e = 0; e < 8; ++e) { o0[e] = a0[e] * rs * gain[e] * sigmoidf_(g0[e]); o1[e] = a1[e] * rs * gain[8 + e] * sigmoidf_(g1[e]); }
        *(u32x4*)(ao + off) = pack8(o0); *(u32x4*)(ao + off + 8) = pack8(o1);
    }
}

constexpr int RT_LD = 1032;
constexpr int RT_HI = 0, RT_LO = NE * RT_LD * 2, RT_LG = 2 * NE * RT_LD * 2;
__device__ __forceinline__ int rows_per_block(int first_row, int G) { return (ROWS - first_row + G - 1) / G; }
__device__ __forceinline__ void phase_norm2_router(Frame& F, int l, int first_row) {
    const int tid = F.tid, lane = F.lane, wave = F.wave, l15 = lane & 15, g = lane >> 4;
    LAS bf16_t* whi = (LAS bf16_t*)(F.lds + RT_HI); LAS bf16_t* wlo = (LAS bf16_t*)(F.lds + RT_LO);
    LAS float* lgs = (LAS float*)(F.lds + RT_LG) + wave * (16 * 33);
    volatile LAS int* cntL = F.LCTL + 64;
    const float* wg = inp(F, I_WR) + (size_t)l * D * NE;
    for (int idx = tid; idx < D * NE; idx += NTHREADS) { const int k = idx >> 5, e = idx & 31; const float w = wg[idx];
        const unsigned hb16 = f2bf(w); const float hf = __builtin_bit_cast(float, hb16 << 16);
        whi[e * RT_LD + k] = (bf16_t)hb16; wlo[e * RT_LD + k] = (bf16_t)f2bf(w - hf); }
    if (tid < NE) cntL[tid] = 0;
    const float* xs = (const float*)(wsp(F) + WS_XS); bf16_t* hb = (bf16_t*)(wsp(F) + WS_HB);
    int* tope = (int*)(wsp(F) + WS_TOPE); float* topw = (float*)(wsp(F) + WS_TOPW);
    const f32x4* gm = (const f32x4*)(inp(F, I_GFFN) + l * D) + lane;
    const int RPB = rows_per_block(first_row, F.G);
    const int rbeg = first_row + F.vcu * RPB, rend = min(rbeg + RPB, ROWS);
    for (int row = rbeg + wave; row < rend; row += NWAVES) {
        const int mb = row_mb(row);
        const f32x4* xr = (const f32x4*)(xs + (size_t)row * D) + lane;
        f32x4 v[4]; float ss = 0.f;
#pragma unroll
        for (int j = 0; j < 4; ++j) { v[j] = xr[64 * j]; ss += (v[j][0] * v[j][0] + v[j][1] * v[j][1]) + (v[j][2] * v[j][2] + v[j][3] * v[j][3]); }
        const float rs = 1.0f / sqrtf(wave_sum(ss) * (1.f / D) + EPS);
        const f32x4* sh = (const f32x4*)modp(F, l, mb, 3) + lane; const f32x4* sc = (const f32x4*)modp(F, l, mb, 4) + lane;
        u32x2* o8 = (u32x2*)(hb + (size_t)row * D) + lane;
        unsigned* o4 = (unsigned*)(wsp(F) + WS_HB8 + (size_t)row * D) + lane;
#pragma unroll
        for (int j = 0; j < 4; ++j) { const f32x4 h = (v[j] * rs) * gm[64 * j] * (sc[64 * j] + 1.0f) + sh[64 * j];
            u32x2 wv; wv.x = pk2(h[0], h[1]); wv.y = pk2(h[2], h[3]); o8[64 * j] = wv;
            const f32x4 hq = __builtin_elementwise_min(__builtin_elementwise_max(h * 16.0f, (f32x4){-448.f, -448.f, -448.f, -448.f}), (f32x4){448.f, 448.f, 448.f, 448.f});
            o4[64 * j] = pk4_fp8(hq[0], hq[1], hq[2], hq[3]); }
    }
    VM_WAIT();
    __syncthreads();
    const float br0 = inp(F, I_BR)[l * NE + l15], br1 = inp(F, I_BR)[l * NE + 16 + l15];
    for (int g0 = rbeg + 16 * wave; g0 < rend; g0 += 16 * NWAVES) {
        const int arow = min(g0 + l15, rend - 1);
        const bf16_t* ap = hb + (size_t)arow * D + 8 * g;
        f32x4 acc0 = (f32x4){0.f, 0.f, 0.f, 0.f}, acc1 = (f32x4){0.f, 0.f, 0.f, 0.f};
#pragma unroll 8
        for (int ks = 0; ks < 32; ++ks) {
            const bf16x8 af = *(const bf16x8*)(ap + 32 * ks);
            const bf16x8 h0 = *(const LAS bf16x8*)(whi + l15 * RT_LD + 32 * ks + 8 * g), h1 = *(const LAS bf16x8*)(whi + (16 + l15) * RT_LD + 32 * ks + 8 * g);
            const bf16x8 l0 = *(const LAS bf16x8*)(wlo + l15 * RT_LD + 32 * ks + 8 * g), l1 = *(const LAS bf16x8*)(wlo + (16 + l15) * RT_LD + 32 * ks + 8 * g);
            acc0 = __builtin_amdgcn_mfma_f32_16x16x32_bf16(af, h0, acc0, 0, 0, 0); acc1 = __builtin_amdgcn_mfma_f32_16x16x32_bf16(af, h1, acc1, 0, 0, 0);
            acc0 = __builtin_amdgcn_mfma_f32_16x16x32_bf16(af, l0, acc0, 0, 0, 0); acc1 = __builtin_amdgcn_mfma_f32_16x16x32_bf16(af, l1, acc1, 0, 0, 0);
        }
#pragma unroll
        for (int rg = 0; rg < 4; ++rg) { lgs[(4 * g + rg) * 33 + l15] = acc0[rg] + br0; lgs[(4 * g + rg) * 33 + 16 + l15] = acc1[rg] + br1; }
        LDS_WAIT(); asm volatile("" ::: "memory");
        const int row = g0 + lane;
        if (lane < 16 && row < rend) {
            float lg[32];
#pragma unroll
            for (int e = 0; e < 32; ++e) lg[e] = lgs[lane * 33 + e];
            int sel[4]; float sv[4]; unsigned used = 0u;
#pragma unroll
            for (int k = 0; k < 4; ++k) { float best = -3.0e38f; int bi = 0;
#pragma unroll
                for (int e = 0; e < 32; ++e) { const bool take = !((used >> e) & 1u) && (lg[e] > best); best = take ? lg[e] : best; bi = take ? e : bi; }
                used |= 1u << bi; sel[k] = bi; sv[k] = best; }
            const float e1 = __expf(sv[1] - sv[0]), e2 = __expf(sv[2] - sv[0]), e3 = __expf(sv[3] - sv[0]);
            const float inv = 1.0f / (1.0f + e1 + e2 + e3);
            *(int4*)(tope + (size_t)row * 4) = make_int4(sel[0], sel[1], sel[2], sel[3]);
            *(float4*)(topw + (size_t)row * 4) = make_float4(inv, e1 * inv, e2 * inv, e3 * inv);
#pragma unroll
            for (int k = 0; k < 4; ++k) __hip_atomic_fetch_add((LAS int*)&cntL[sel[k]], 1, __ATOMIC_RELAXED, __HIP_MEMORY_SCOPE_WORKGROUP);
        }
        LDS_WAIT(); asm volatile("" ::: "memory");
    }
    __syncthreads();
    if (tid < NE) ((int*)(wsp(F) + WS_CNT))[F.vcu * NE + tid] = cntL[tid];
}

__device__ __forceinline__ void phase_positions(Frame& F, int first_row) {
    const int tid = F.tid, lane = F.lane;
    LAS int* tot = (LAS int*)F.lds;
    LAS int* bef = tot + 512;
    LAS int* baseL = bef + 512;
    LAS int* totL = baseL + 32;
    const int* cnt = (const int*)(wsp(F) + WS_CNT);
    {
        const int e = tid & 31, part = tid >> 5;
        int s = 0, sb = 0;
        for (int j = part; j < F.G; j += 16) { const int cv = cnt[j * NE + e]; s += cv; sb += (j < F.vcu) ? cv : 0; }
        tot[part * 32 + e] = s; bef[part * 32 + e] = sb;
    }
    __syncthreads();
    if (tid < NE) { int s = 0, sb = 0;
        for (int p = 0; p < 16; ++p) { s += tot[p * 32 + tid]; sb += bef[p * 32 + tid]; }
        totL[tid] = s; baseL[tid] = sb; }
    __syncthreads();
    if (tid == 0) { int acc = 0;
        for (int e = 0; e < NE; ++e) { F.LCTL[8 + e] = acc; acc += (totL[e] + 255) >> 8; }
        F.LCTL[8 + NE] = acc; F.LCTL[48] = acc; }
    __syncthreads();
    int* tokmap = (int*)(wsp(F) + WS_TOKMAP);
    if (F.vcu == 0) {
        int* meta = (int*)(wsp(F) + WS_META);
        if (tid <= NE) meta[tid] = F.LCTL[8 + tid];
        if (tid == 0) meta[33] = F.LCTL[48];
        for (int e = 0; e < NE; ++e) { const int rb = 256 * F.LCTL[8 + e], n = totL[e], cap = 256 * (F.LCTL[8 + e + 1] - F.LCTL[8 + e]);
            for (int rr = n + tid; rr < cap; rr += NTHREADS) tokmap[rb + rr] = first_row; }
    }
    if (F.wave == 0) {
        const int* tope = (const int*)(wsp(F) + WS_TOPE); int* pos = (int*)(wsp(F) + WS_POS);
        int basereg = (lane < NE) ? 256 * F.LCTL[8 + lane] + baseL[lane] : 0;
        const int RPB = rows_per_block(first_row, F.G);
        const int rbeg = first_row + F.vcu * RPB, rend = min(rbeg + RPB, ROWS);
        for (int r0 = rbeg; r0 < rend; r0 += 16) {
            const int row = r0 + (lane >> 2), k = lane & 3;
            const bool valid = row < rend;
            const int e = valid ? tope[(size_t)row * 4 + k] : -1;
            int p = 0;
#pragma unroll 1
            for (int ee = 0; ee < NE; ++ee) {
                const unsigned long long mask = __ballot(e == ee);
                const int b0 = __shfl(basereg, ee);
                if (e == ee) p = b0 + __popcll(mask & ((1ull << lane) - 1ull));
                if (lane == ee) basereg += __popcll(mask);
            }
            if (valid) { pos[(size_t)row * 4 + k] = p; tokmap[p] = row; }
        }
    }
}

#ifndef PMASK
#define PMASK 0xFFFF
#endif
#define PE(k) (((PMASK) >> (k)) & 1)
#ifndef RMASK
#define RMASK 0
#endif
#define RP(k) for (int rep_ = 0; rep_ < ((((RMASK) >> (k)) & 1) ? 2 : 1); ++rep_, __syncthreads())
constexpr int NPH_LAYER = 10, GP_FINAL = 1 + DEPTH * NPH_LAYER, NPHASES = GP_FINAL + 1;
__global__ void __launch_bounds__(NTHREADS, 2) mega_fwd(Args args) {
    extern __shared__ __attribute__((aligned(16))) unsigned char lds_raw[];
    Frame F0;
    Frame& F = F0;
    F.lds = (LAS unsigned char*)lds_raw;
    F.LCTL = (volatile LAS int*)(F.lds + LDS_CTL_OFF);
    F.tid = threadIdx.x; F.lane = F.tid & 63; F.wave = __builtin_amdgcn_readfirstlane(F.tid >> 6);
    F.G = gridDim.x; { const int bx = blockIdx.x; F.vcu = (F.G % 8 == 0) ? (bx % 8) * (F.G / 8) + bx / 8 : bx; }
    if (F.tid < 128) F.LCTL[F.tid] = 0;
    if (F.tid == 0) {
#pragma unroll
        for (int i = 0; i < 23; ++i) { const unsigned long long p = (unsigned long long)args.in[i]; F.LCTL[128 + 2 * i] = (int)(unsigned)p; F.LCTL[129 + 2 * i] = (int)(unsigned)(p >> 32); }
        { const unsigned long long p = (unsigned long long)args.ws; F.LCTL[128 + 46] = (int)(unsigned)p; F.LCTL[129 + 46] = (int)(unsigned)(p >> 32); }
        { const unsigned long long p = (unsigned long long)args.out; F.LCTL[128 + 48] = (int)(unsigned)p; F.LCTL[129 + 48] = (int)(unsigned)(p >> 32); }
    }
    __syncthreads();
    const int lo = args.ph_lo, hi = args.ph_hi;
    XcdBarrier bar; bar.bar = (unsigned*)(wsp(F) + WS_CTL) + CW_BAR; bar.x = 0; bar.st = nullptr;
    if (hi - lo > 1) bar = xcd_barrier_post((unsigned*)(wsp(F) + WS_CTL) + CW_BAR, (volatile LAS unsigned*)F.LCTL);
#define IN(k) (lo <= (k) && (k) < hi)
#define FRESH(FN) Frame FN = F0; { int tz_ = F0.tid, vc_ = F0.vcu, g_ = F0.G; asm volatile("" : "+v"(tz_)); asm volatile("" : "+s"(vc_), "+s"(g_)); FN.tid = tz_; FN.lane = tz_ & 63; FN.wave = __builtin_amdgcn_readfirstlane(tz_ >> 6); FN.vcu = vc_; FN.G = g_; }
#define SEAM(k) do { if (IN(k) && IN((k) + 1)) xcd_barrier(bar); } while (0)

    if (PE(0) && IN(0)) RP(0) { FRESH(P); phase0(P); }
    SEAM(0);
    for (int l = 0; l < DEPTH; ++l) {
        const int base = 1 + l * NPH_LAYER; const bool na = (l & 1) == 0, last = (l == DEPTH - 1); const int jj = l >> 1;
        if (PE(1) && IN(base + 0)) { FRESH(P); phase_norm1(P, l); }
        SEAM(base + 0);
        if (PE(2) && IN(base + 1)) RP(2) {
            FRESH(P);
            const int Np = na ? 3072 : ML_INP;
            const bf16_t* Bt = na ? (const bf16_t*)(wsp(P) + WS_WQKV) + (size_t)jj * 3072 * D : (const bf16_t*)(wsp(P) + WS_WIN) + (size_t)jj * ML_INP * D;
            DenseOrder S; S.init(0, ROWS / 256, Np / 256, P.G, (int)blockIdx.x, wsp(P) + WS_HB, Bt, D);
            EpiStoreBf16 E{(bf16_t*)(wsp(P) + WS_PROJ), Np};
            pg8::gemm_phase<EpiStoreBf16, DenseOrder, false>(P.lds, P.tid, D, S, E);
        }
        SEAM(base + 1);
        if (IN(base + 2)) { if (na) { if (PE(3)) RP(3) { FRESH(P); phase_na_post(P, jj); } } else { if (PE(4)) { FRESH(P); phase_ml_post(P, jj); } } }
        SEAM(base + 2);
        if (IN(base + 3)) { if (na) { if (PE(5)) RP(5) { FRESH(P); phase_na_attn(P, jj); } } else { if (PE(6)) RP(6) { FRESH(P); phase_ml_scan(P); } } }
        SEAM(base + 3);
        if (PE(7) && IN(base + 4)) { if (!na) RP(7) { FRESH(P); phase_ml_final(P, jj); } }
        if (!na) SEAM(base + 4);
        if (PE(8) && IN(base + 5)) {
            FRESH(P);
            const bf16_t* Bt = na ? (const bf16_t*)(wsp(P) + WS_WONA) + (size_t)jj * D * D : (const bf16_t*)(wsp(P) + WS_WOML) + (size_t)jj * D * D;
            DenseOrder S; S.init(last ? ROWS_CTX / 256 : 0, last ? (ROWS - ROWS_CTX) / 256 : ROWS / 256, D / 256, P.G, (int)blockIdx.x, wsp(P) + WS_AO, Bt, D);
            EpiResid E{(float*)(wsp(P) + WS_XS), (const float*)(wsp(P) + WS_MOD) + (size_t)l * 9 * 6144 + 2 * D};
            pg8::gemm_phase<EpiResid, DenseOrder, false>(P.lds, P.tid, D, S, E);
        }
        SEAM(base + 5);
        if (PE(9) && IN(base + 6)) RP(9) { FRESH(P); phase_norm2_router(P, l, last ? ROWS_CTX : 0); }
        SEAM(base + 6);
        if (PE(10) && IN(base + 7)) RP(10) { FRESH(P); phase_positions(P, last ? ROWS_CTX : 0); }
        SEAM(base + 7);
        if (PE(11) && IN(base + 8)) RP(11) {
            FRESH(P);
            if (P.tid < 34) P.LCTL[8 + P.tid] = ((const int*)(wsp(P) + WS_META))[P.tid];
            __syncthreads();
            const int ntiles = P.LCTL[8 + NE];
            MoeOrder S; S.NT = 8; S.nunits = ntiles * 8; S.G = P.G; S.c = (int)blockIdx.x; S.K = D / 2; S.A = (const char*)(wsp(P) + WS_HB8);
            S.W = (const char*)(wsp(P) + WS_W1T) + (size_t)l * NE * 2048 * D; S.estride = (size_t)2048 * D; S.tokmap = (const int*)(wsp(P) + WS_TOKMAP); S.prefix = P.LCTL + 8; S.gather = true;
            EpiSwiglu E{(bf16_t*)(wsp(P) + WS_ACT), inp(P, I_B1) + (size_t)l * NE * 2048};
            pg8::gemm_phase<EpiSwiglu, MoeOrder, true, true>(P.lds, P.tid, D / 2, S, E);
        }
        SEAM(base + 8);
        if (PE(12) && IN(base + 9)) RP(12) {
            FRESH(P);
            if (P.tid < 34) P.LCTL[8 + P.tid] = ((const int*)(wsp(P) + WS_META))[P.tid];
            __syncthreads();
            const int ntiles = P.LCTL[8 + NE];
            MoeOrder S; S.NT = 4; S.nunits = ntiles * 4; S.G = P.G; S.c = (int)blockIdx.x; S.K = D; S.A = (const char*)(wsp(P) + WS_ACT);
            S.W = (const char*)(wsp(P) + WS_W2T) + (size_t)l * NE * D * D * 2; S.estride = (size_t)D * D * 2; S.tokmap = (const int*)(wsp(P) + WS_TOKMAP); S.prefix = P.LCTL + 8; S.gather = false;
            EpiY E{(bf16_t*)(wsp(P) + WS_Y), inp(P, I_B2) + (size_t)l * NE * D};
            pg8::gemm_phase<EpiY, MoeOrder, false>(P.lds, P.tid, D, S, E);
        }
        SEAM(base + 9);
    }
    if (PE(13) && IN(GP_FINAL)) RP(13) { FRESH(P); phase_final(P); }
#undef IN
#undef SEAM
}

extern "C" void kernel_launch(void* const* d_in, const int* in_sizes, int n_in, void* d_out, int out_size, void* d_ws, size_t ws_size, hipStream_t stream) {
    static int grid = 0;
    if (grid == 0) {
        if (n_in != 23 || ws_size < WS_END) { fprintf(stderr, "kernel_launch: expected 23 inputs and >= %zu bytes of workspace (got %d, %zu)\n", (size_t)WS_END, n_in, ws_size); grid = -1; return; }
        int dev = 0, cus = 0, per_cu = 0;
        if (hipGetDevice(&dev) != hipSuccess || hipDeviceGetAttribute(&cus, hipDeviceAttributeMultiprocessorCount, dev) != hipSuccess) { grid = -1; return; }
        if (hipFuncSetAttribute((const void*)mega_fwd, hipFuncAttributeMaxDynamicSharedMemorySize, LDS_BYTES) != hipSuccess) { fprintf(stderr, "kernel_launch: hipFuncSetAttribute failed\n"); grid = -1; return; }
        if (hipOccupancyMaxActiveBlocksPerMultiprocessor(&per_cu, (const void*)mega_fwd, NTHREADS, LDS_BYTES) != hipSuccess || per_cu < 1)
            fprintf(stderr, "kernel_launch: occupancy query reports %d workgroups per CU\n", per_cu);
        (void)hipGetLastError();
        grid = cus;
        if (grid > 1024) grid = 1024;
    }
    if (grid < 0) return;
    (void)hipMemsetAsync((char*)d_ws + WS_CTL, 0, CTL_BYTES, stream);
    Args a{};
    for (int i = 0; i < 23; ++i) a.in[i] = (const float*)d_in[i];
    a.out = (float*)d_out; a.ws = (unsigned char*)d_ws;
#if MK_ONE_LAUNCH
    a.ph_lo = 0; a.ph_hi = NPHASES;
    hipLaunchKernelGGL(mega_fwd, dim3(grid), dim3(NTHREADS), LDS_BYTES, stream, a);
#else
    for (int gp = 0; gp < NPHASES; ++gp) {
        if (gp >= 1 && gp < GP_FINAL) { const int l = (gp - 1) / NPH_LAYER, p = (gp - 1) % NPH_LAYER; if (p == 4 && (l & 1) == 0) continue; }
        a.ph_lo = gp; a.ph_hi = gp + 1;
        hipLaunchKernelGGL(mega_fwd, dim3(grid), dim3(NTHREADS), LDS_BYTES, stream, a);
    }
#endif
    const hipError_t le = hipPeekAtLastError();
    if (le != hipSuccess) fprintf(stderr, "kernel_launch: launch failed: %s\n", hipGetErrorName(le));
}
```

```cpp
#include <hip/hip_runtime.h>
#include <cstdio>
#include <cstdint>

#ifndef MK_ONE_LAUNCH
#define MK_ONE_LAUNCH 1
#endif

#define LAS __attribute__((address_space(3)))
#define GAS __attribute__((address_space(1)))
typedef unsigned short bf16_t;
typedef short bf16x8 __attribute__((ext_vector_type(8)));
typedef short bf16x4 __attribute__((ext_vector_type(4)));
typedef float f32x4 __attribute__((ext_vector_type(4)));
typedef float f32x2 __attribute__((ext_vector_type(2)));
typedef unsigned u32x4 __attribute__((ext_vector_type(4)));
typedef unsigned u32x2 __attribute__((ext_vector_type(2)));

constexpr int D = 1024, NB = 8, SEQ = 4096, NCTX = 256, TT = NCTX + SEQ  , DEPTH = 4;
constexpr int ROWS_CTX = NB * NCTX  , ROWS = ROWS_CTX + NB * SEQ  ;
constexpr int NH_NA = 16, DH_NA = 64;
constexpr int NH_ML = 8, DV_ML = 128, DK_ML = 64, ML_IN = 3104, ML_INP = 3328;
constexpr int NE = 32, TOPK = 4, DFF = 1024;
constexpr int MAXTILES = (ROWS * TOPK) / 256 + NE  , MAXROWS = MAXTILES * 256;
constexpr float EPS = 1e-6f;
constexpr int NWAVES = 8, NTHREADS = 512;

constexpr size_t MiB = 1u << 20;
constexpr size_t al256(size_t x) { return (x + 255) & ~(size_t)255; }
constexpr size_t WS_CTL = 0, CTL_BYTES = 1 * MiB;
constexpr size_t WS_MOD = WS_CTL + CTL_BYTES;
constexpr size_t WS_ROPE = WS_MOD + al256((size_t)DEPTH * 9 * 6 * D * 4);
constexpr size_t WS_WQKV = WS_ROPE + al256(64 * 16 * 2 * 4);
constexpr size_t WS_WONA = WS_WQKV + (size_t)2 * 3072 * D * 2;
constexpr size_t WS_WIN = WS_WONA + (size_t)2 * D * D * 2;
constexpr size_t WS_WOML = WS_WIN + (size_t)2 * ML_INP * D * 2;
constexpr size_t WS_W1T = WS_WOML + (size_t)2 * D * D * 2;
constexpr size_t WS_W2T = WS_W1T + (size_t)DEPTH * NE * 2048 * D * 2;
constexpr size_t WS_XS = WS_W2T + (size_t)DEPTH * NE * D * D * 2;
constexpr size_t WS_HB = WS_XS + (size_t)ROWS * D * 4;
constexpr size_t WS_PROJ = WS_HB + (size_t)ROWS * D * 2;
constexpr size_t WS_QN = WS_PROJ + (size_t)ROWS * ML_INP * 2;
constexpr size_t WS_KN = WS_QN + (size_t)ROWS * D * 2;
constexpr size_t WS_VT = WS_KN + (size_t)ROWS * D * 2;
constexpr size_t WS_AO = WS_VT + (size_t)ROWS * D * 2;
constexpr size_t WS_HDIR = WS_QN;
constexpr size_t WS_GATES = WS_AO + (size_t)ROWS * D * 2;
constexpr size_t WS_TOPE = WS_GATES + al256((size_t)4 * NB * NH_ML * TT * 4);
constexpr size_t WS_TOPW = WS_TOPE + (size_t)ROWS * 4 * 4;
constexpr size_t WS_POS = WS_TOPW + (size_t)ROWS * 4 * 4;
constexpr size_t WS_TOKMAP = WS_POS + (size_t)ROWS * 4 * 4;
constexpr size_t WS_CNT = WS_TOKMAP + (size_t)MAXROWS * 4;
constexpr size_t WS_META = WS_CNT + (size_t)1024 * 32 * 4;
constexpr size_t WS_ACT = WS_META + 256;
constexpr size_t WS_Y = WS_ACT + (size_t)MAXROWS * D * 2;
constexpr size_t WS_HB8 = WS_Y + (size_t)MAXROWS * D * 2;
constexpr size_t WS_END = WS_HB8 + (size_t)ROWS * D;
static_assert(WS_XS % 256 == 0 && WS_ACT % 256 == 0 && WS_TOPE % 256 == 0, "ws alignment");

constexpr int CW_BAR = 4096;

constexpr int LDS_BYTES = 160 * 1024;
constexpr int LDS_CTL_OFF = LDS_BYTES - 1024;
constexpr int LDS_WORK = LDS_CTL_OFF;

#define LDS_WAIT() asm volatile("s_waitcnt lgkmcnt(0)" ::: "memory")
#define VM_WAIT() asm volatile("s_waitcnt vmcnt(0)" ::: "memory")
__device__ __forceinline__ unsigned f2bf(float f) { unsigned u = __builtin_bit_cast(unsigned, f); return (u + 0x7fffu + ((u >> 16) & 1u)) >> 16; }
__device__ __forceinline__ unsigned pk2(float lo, float hi) { unsigned r; asm volatile("v_cvt_pk_bf16_f32 %0, %1, %2" : "=v"(r) : "v"(lo), "v"(hi)); return r; }
__device__ __forceinline__ unsigned pk4_fp8(float a, float b, float c, float d) { int p = __builtin_amdgcn_cvt_pk_fp8_f32(a, b, 0, false); p = __builtin_amdgcn_cvt_pk_fp8_f32(c, d, p, true); return (unsigned)p; }
__device__ __forceinline__ float bf2f(unsigned short b) { return __builtin_bit_cast(float, ((unsigned)b) << 16); }
__device__ __forceinline__ float bflo(unsigned w) { return __builtin_bit_cast(float, w << 16); }
__device__ __forceinline__ float bfhi(unsigned w) { return __builtin_bit_cast(float, w & 0xffff0000u); }
__device__ __forceinline__ float wave_sum(float v) {
#pragma unroll
    for (int o = 1; o < 64; o <<= 1) v += __shfl_xor(v, o);
    return v;
}
__device__ __forceinline__ float wave_max(float v) {
#pragma unroll
    for (int o = 1; o < 64; o <<= 1) v = fmaxf(v, __shfl_xor(v, o));
    return v;
}
__device__ __forceinline__ float sigmoidf_(float x) { return __builtin_amdgcn_rcpf(1.f + __builtin_amdgcn_exp2f(-1.44269504f * x)); }

namespace pg8 {
constexpr int BM = 256, BK = 64, HALF = 128, HTB = HALF * BK * 2  , STAGE_BYTES = 8 * HTB;
__host__ __device__ __forceinline__ int lds_byte(int r, int c) { const int st = (r >> 4) * 2 + (c >> 5), rr = r & 15, cc = c & 31, ob = rr * 64 + cc * 2; return st * 1024 + (ob ^ (((ob >> 9) & 1) << 5)); }
__host__ __device__ __forceinline__ void stage_rc(int b, int& R, int& C) { const int st = b / 1024, sb = b % 1024, swz = sb ^ (((sb >> 9) & 1) << 5); R = (st >> 1) * 16 + swz / 64; C = (st & 1) * 32 + (swz % 64) / 2; }
__host__ __device__ __forceinline__ int perm32(int rho) { const int n = rho >> 4, i = rho & 15; return 8 * (i >> 2) + 4 * n + (i & 3); }

struct Unit { int pm, pn, e; };

typedef int v8i32 __attribute__((ext_vector_type(8)));
__device__ __forceinline__ v8i32 cat8(const bf16x8 a, const bf16x8 b) { union { bf16x8 h[2]; v8i32 v; } u; u.h[0] = a; u.h[1] = b; return u.v; }
__device__ __forceinline__ unsigned cvt_pk_bf16(float lo, float hi) { unsigned r; asm volatile("v_cvt_pk_bf16_f32 %0, %1, %2" : "=v"(r) : "v"(lo), "v"(hi)); return r; }

template <class Epi, class Sched, bool GATHER, bool FP8 = false>
__device__ __forceinline__ void gemm_phase(LAS unsigned char* lds, const int tid, const int K, const Sched& S, const Epi& E) {
    const int wid = __builtin_amdgcn_readfirstlane(tid >> 6), lane = tid & 63, wr = wid >> 2, wc = wid & 3, fr = lane & 15, fq = lane >> 4;
    const int nt = K / BK;
    int RA[2], CA[2];
    unsigned voffB[2], voffA[2][2];
#pragma unroll
    for (int i = 0; i < 2; ++i) { int R, C; stage_rc(tid * 16 + i * 8192, R, C); const int Rb = Epi::PERM ? ((R & ~31) + perm32(R & 31)) : R;
        RA[i] = R; CA[i] = C; voffB[i] = (unsigned)(Rb * K + C) * 2u; }
    const size_t kstep = (size_t)(BK * 2);
    const size_t hstep = (size_t)HALF * K * 2;
    const unsigned ldsw = (unsigned)wid * 1024u;
    const int aoff = lds_byte(wr * 64 + fr, fq * 8), boff = lds_byte(wc * 32 + fr, fq * 8);
#define PG8_SA(b, h) (((b) * 2 + (h)) * HTB)
#define PG8_SB(b, h) ((4 + (b) * 2 + (h)) * HTB)
#define PG8_STAGE(bufoff, gbase, voff) do { _Pragma("unroll") for (int _i = 0; _i < 2; ++_i) \
        __builtin_amdgcn_global_load_lds((const unsigned*)((const char*)(gbase) + (voff)[_i]), (LAS unsigned*)(lds + (bufoff) + ldsw + _i * 8192), 16, 0, 0); } while (0)
#define PG8_LDA(dst, b, h) do { _Pragma("unroll") for (int m = 0; m < 4; ++m) _Pragma("unroll") for (int k = 0; k < 2; ++k) dst[m][k] = *(const LAS bf16x8*)(lds + PG8_SA(b, h) + aoff + m * 2048 + k * 1024); } while (0)
#define PG8_LDB(dst, b, h) do { _Pragma("unroll") for (int n = 0; n < 2; ++n) _Pragma("unroll") for (int k = 0; k < 2; ++k) dst[n][k] = *(const LAS bf16x8*)(lds + PG8_SB(b, h) + boff + n * 2048 + k * 1024); } while (0)
#define PG8_MMA(ai, bj, At, Bt) do { __builtin_amdgcn_s_setprio(1); _Pragma("unroll") for (int m = 0; m < 4; ++m) _Pragma("unroll") for (int n = 0; n < 2; ++n) { \
        if constexpr (FP8) { acc[ai][bj][m][n] = __builtin_amdgcn_mfma_scale_f32_16x16x128_f8f6f4(cat8(Bt[n][0], Bt[n][1]), cat8(At[m][0], At[m][1]), acc[ai][bj][m][n], 0, 0, 0, 0x7f7f7f7f, 0, 0x7f7f7f7f); } \
        else { _Pragma("unroll") for (int k = 0; k < 2; ++k) acc[ai][bj][m][n] = __builtin_amdgcn_mfma_f32_16x16x32_bf16(Bt[n][k], At[m][k], acc[ai][bj][m][n], 0, 0, 0); } } \
        __builtin_amdgcn_s_setprio(0); } while (0)
#define PG8_WAIT_V(n) asm volatile("s_waitcnt vmcnt(" #n ")" ::: "memory")
#define PG8_WAIT_L(n) asm volatile("s_waitcnt lgkmcnt(" #n ")" ::: "memory")
#define PG8_BAR __builtin_amdgcn_s_barrier()
#define PG8_SCHED __builtin_amdgcn_sched_barrier(0)
#define PG8_SETVOFF(u) do { _Pragma("unroll") for (int _h = 0; _h < 2; ++_h) _Pragma("unroll") for (int _i = 0; _i < 2; ++_i) { \
        if constexpr (GATHER) voffA[_h][_i] = ((unsigned)S.a_row(u, _h * HALF + RA[_i]) * (unsigned)K + (unsigned)CA[_i]) * 2u; \
        else voffA[_h][_i] = ((unsigned)(_h * HALF + RA[_i]) * (unsigned)K + (unsigned)CA[_i]) * 2u; } } while (0)
    Unit cur, nxt; int ui = 0;
    if (!S.next(0, cur)) return;
    f32x4 acc[2][2][4][2];
#pragma unroll
    for (int a = 0; a < 2; ++a)
#pragma unroll
        for (int b = 0; b < 2; ++b)
#pragma unroll
            for (int m = 0; m < 4; ++m)
#pragma unroll
                for (int n = 0; n < 2; ++n) acc[a][b][m][n] = (f32x4){0.f, 0.f, 0.f, 0.f};
    bf16x8 At[4][2], B0[2][2], B1[2][2];
    const char* cA = S.a_base(cur); const char* cB = S.b_base(cur);
    PG8_SETVOFF(cur);
    PG8_STAGE(PG8_SB(0, 0), cB, voffB); PG8_STAGE(PG8_SB(0, 1), cB + hstep, voffB); PG8_STAGE(PG8_SA(0, 0), cA, voffA[0]); PG8_STAGE(PG8_SA(0, 1), cA, voffA[1]);
    if (wr == 1) PG8_BAR;
    PG8_WAIT_V(2); PG8_BAR;
    PG8_STAGE(PG8_SB(1, 0), cB + kstep, voffB); PG8_STAGE(PG8_SA(1, 0), cA + kstep, voffA[0]); PG8_STAGE(PG8_SB(1, 1), cB + hstep + kstep, voffB);
    PG8_WAIT_V(6); PG8_BAR;
    for (;;) {
        const bool has_next = S.next(ui + 1, nxt);
        const char* nA = has_next ? S.a_base(nxt) : cA; const char* nB = has_next ? S.b_base(nxt) : cB;
#pragma unroll 1
        for (int t = 0; t < nt; t += 2) {
            const bool last = (t == nt - 2);
            const char* a1 = cA + (size_t)(t + 1) * kstep;
            const char* a2 = last ? nA : cA + (size_t)(t + 2) * kstep; const char* b2 = last ? nB : cB + (size_t)(t + 2) * kstep;
            const char* a3 = a2 + kstep; const char* b3 = b2 + kstep;
            PG8_LDB(B0, 0, 0); PG8_LDB(B1, 0, 1); PG8_SCHED; PG8_LDA(At, 0, 0); PG8_STAGE(PG8_SA(1, 1), a1, voffA[1]);
            if constexpr (GATHER) { if (last && has_next) PG8_SETVOFF(nxt); }
            PG8_WAIT_V(8); PG8_WAIT_L(0); PG8_BAR; PG8_MMA(0, 0, At, B0); PG8_MMA(0, 1, At, B1); PG8_BAR; PG8_SCHED;
            PG8_LDA(At, 0, 1); PG8_STAGE(PG8_SB(0, 0), b2, voffB); PG8_STAGE(PG8_SB(0, 1), b2 + hstep, voffB); PG8_STAGE(PG8_SA(0, 0), a2, voffA[0]);
            PG8_WAIT_V(8); PG8_WAIT_L(0); PG8_BAR; PG8_MMA(1, 0, At, B0); PG8_MMA(1, 1, At, B1); PG8_BAR; PG8_SCHED;
            PG8_LDB(B0, 1, 0); PG8_LDB(B1, 1, 1); PG8_SCHED; PG8_LDA(At, 1, 0); PG8_STAGE(PG8_SA(0, 1), a2, voffA[1]);
            PG8_WAIT_V(8); PG8_WAIT_L(0); PG8_BAR; PG8_MMA(0, 0, At, B0); PG8_MMA(0, 1, At, B1); PG8_BAR; PG8_SCHED;
            PG8_LDA(At, 1, 1); PG8_STAGE(PG8_SB(1, 0), b3, voffB); PG8_STAGE(PG8_SB(1, 1), b3 + hstep, voffB); PG8_STAGE(PG8_SA(1, 0), a3, voffA[0]);
            PG8_WAIT_V(8); PG8_WAIT_L(0); PG8_BAR; PG8_MMA(1, 0, At, B0); PG8_MMA(1, 1, At, B1); PG8_BAR; PG8_SCHED;
        }
        if (wr == 0) PG8_BAR;
        E(acc, cur, wr, wc, fr, fq);
        if (!has_next) break;
#pragma unroll
        for (int a = 0; a < 2; ++a)
#pragma unroll
            for (int b = 0; b < 2; ++b)
#pragma unroll
                for (int m = 0; m < 4; ++m)
#pragma unroll
                    for (int n = 0; n < 2; ++n) acc[a][b][m][n] = (f32x4){0.f, 0.f, 0.f, 0.f};
        cur = nxt; cA = nA; cB = nB; ++ui;
        if (wr == 1) PG8_BAR;
    }
    PG8_WAIT_V(0);
    PG8_BAR;
#undef PG8_SA
#undef PG8_SB
#undef PG8_STAGE
#undef PG8_LDA
#undef PG8_LDB
#undef PG8_MMA
#undef PG8_WAIT_V
#undef PG8_WAIT_L
#undef PG8_BAR
#undef PG8_SCHED
#undef PG8_SETVOFF
}
}

#define XB_TMO      128
#define XB_XCNT(j)  (256  + 64 * (j))
#define XB_XSUB(j)  (1280 + 64 * (j))
#define XB_XGEN(j)  (2304 + 64 * (j))
#define XB_TOP      3328
#define XB_TOPGEN   3392
#define XCD_BAR_WORDS 3456
#define XB_SPIN_CAP (1u << 18)

__device__ __forceinline__ unsigned xb_ld(unsigned* p)              { return __hip_atomic_load(p, __ATOMIC_RELAXED, __HIP_MEMORY_SCOPE_AGENT); }
__device__ __forceinline__ unsigned xb_add(unsigned* p, unsigned v) { return __hip_atomic_fetch_add(p, v, __ATOMIC_RELAXED, __HIP_MEMORY_SCOPE_AGENT); }
__device__ __forceinline__ unsigned xb_xcc_id() { return (unsigned)__builtin_amdgcn_s_getreg((3 << 11) | 20) & 0xFu; }
#define XB_SPIN(cond, bar) do { unsigned _sp = 0; while (cond) { __builtin_amdgcn_s_sleep(1); \
    if ((++_sp & 255u) == 0u) { if (xb_ld(&(bar)[XB_TMO])) break; if (_sp > XB_SPIN_CAP) { atomicAdd(&(bar)[XB_TMO], 1u); break; } } } } while (0)

struct XcdBarrier {
    unsigned* bar; unsigned x;
    volatile LAS unsigned* st;
};

__device__ __forceinline__ XcdBarrier xcd_barrier_post(unsigned* bar, volatile LAS unsigned* st) {
    XcdBarrier b; b.bar = bar; b.x = xb_xcc_id(); b.st = st;
    if (threadIdx.x == 0) (void)xb_add(&bar[XB_XCNT(b.x)], 1u);
    return b;
}
__device__ __forceinline__ void xcd_barrier_complete(unsigned* bar, unsigned x, unsigned& nloc, unsigned& nx) {
    const unsigned G = gridDim.x * gridDim.y * gridDim.z;
    unsigned sum, cnt, mine, sp = 0u;
    for (;;) {
        sum = 0u; cnt = 0u; mine = 0u;
#pragma unroll
        for (unsigned j = 0; j < 16; ++j) { const unsigned c = xb_ld(&bar[XB_XCNT(j)]); sum += c; cnt += (c > 0u) ? 1u : 0u; mine = (j == x) ? c : mine; }
        if (sum == G) break;
        __builtin_amdgcn_s_sleep(1);
        if ((++sp & 255u) == 0u) { if (xb_ld(&bar[XB_TMO])) break; if (sp > XB_SPIN_CAP) { atomicAdd(&bar[XB_TMO], 1u); break; } }
    }
    nloc = mine > 0u ? mine : 1u; nx = cnt > 0u ? cnt : 1u;
}

__device__ __forceinline__ void xcd_barrier(const XcdBarrier& b) {
    asm volatile("s_waitcnt vmcnt(0)" ::: "memory");
    __syncthreads();
    if (threadIdx.x == 0) {
        unsigned* bar = b.bar;
        __builtin_amdgcn_s_waitcnt(0);
        unsigned nloc = b.st[0], nx = b.st[1];
        if (nloc == 0u) { xcd_barrier_complete(bar, b.x, nloc, nx); b.st[0] = nloc; b.st[1] = nx; }
        const unsigned old = xb_add(&bar[XB_XSUB(b.x)], 1u);
        const unsigned gen = old / nloc;
        if (old + 1u == (gen + 1u) * nloc) {
            __builtin_amdgcn_fence(__ATOMIC_RELEASE, "agent");
            asm volatile("s_waitcnt vmcnt(0)" ::: "memory");
            const unsigned og = xb_add(&bar[XB_TOP], 1u);
            const unsigned tg = og / nx;
            if (og + 1u == (tg + 1u) * nx) xb_add(&bar[XB_TOPGEN], 1u);
            else XB_SPIN(xb_ld(&bar[XB_TOPGEN]) == tg, bar);
            __builtin_amdgcn_fence(__ATOMIC_ACQUIRE, "agent");
            xb_add(&bar[XB_XGEN(b.x)], 1u);
            asm volatile("s_waitcnt vmcnt(0)" ::: "memory");
        } else {
            XB_SPIN(xb_ld(&bar[XB_XGEN(b.x)]) == gen, bar);
            __builtin_amdgcn_fence(__ATOMIC_ACQUIRE, "agent");
            asm volatile("s_waitcnt vmcnt(0)" ::: "memory");
        }
    }
    __syncthreads();
}

struct Args { const float* in[23]; float* out; unsigned char* ws; int ph_lo, ph_hi; };
struct Frame {
    LAS unsigned char* lds;
    volatile LAS int* LCTL;
    int tid, lane, wave, vcu, G;
};
__device__ __forceinline__ unsigned long long ptr_get(const Frame& F, int i) {
    const unsigned lo = (unsigned)F.LCTL[128 + 2 * i], hi = (unsigned)F.LCTL[129 + 2 * i];
    return ((unsigned long long)(unsigned)__builtin_amdgcn_readfirstlane((int)hi) << 32) | (unsigned long long)(unsigned)__builtin_amdgcn_readfirstlane((int)lo);
}
__device__ __forceinline__ const float* inp(const Frame& F, int i) { return (const float*)(GAS const float*)ptr_get(F, i); }
__device__ __forceinline__ unsigned char* wsp(const Frame& F) { return (unsigned char*)(GAS unsigned char*)ptr_get(F, 23); }
__device__ __forceinline__ float* outp(const Frame& F) { return (float*)(GAS float*)ptr_get(F, 24); }
enum { I_X = 0, I_C, I_CTX, I_CCTX, I_WADA, I_BADA, I_GMIX, I_GFFN, I_WQKV, I_QGAIN, I_KGAIN, I_RPB, I_WONA, I_WIN, I_BGATE, I_MHGAIN, I_WOML,
       I_WR, I_BR, I_W1, I_B1, I_W2, I_B2 };

struct DenseOrder {
    int nM, nN, nwg, G, c, pm0, K; const char* A; const char* Bt;
    __device__ __forceinline__ void init(int pm0_, int nM_, int nN_, int G_, int c_, const void* A_, const void* Bt_, int K_) { pm0 = pm0_; nM = nM_; nN = nN_; nwg = nM * nN; G = G_; c = c_; A = (const char*)A_; Bt = (const char*)Bt_; K = K_; }
    __device__ __forceinline__ bool next(int i, pg8::Unit& u) const {
        const long L = (long)i * G + c; if (L >= nwg) return false;
        int wgid = (int)L; { const int q = nwg / 8, r = nwg % 8, xcd = wgid % 8, off = wgid / 8; wgid = (xcd < r ? xcd * (q + 1) : r * (q + 1) + (xcd - r) * q) + off; }
        const int nig = 8 * nN, gid = wgid / nig, fm = gid * 8, gsz = (nM - fm) < 8 ? (nM - fm) : 8;
        u.pm = pm0 + fm + ((wgid % nig) % gsz); u.pn = (wgid % nig) / gsz; u.e = 0; return true;
    }
    __device__ __forceinline__ const char* a_base(const pg8::Unit& u) const { return A + (size_t)u.pm * 256 * K * 2; }
    __device__ __forceinline__ const char* b_base(const pg8::Unit& u) const { return Bt + (size_t)u.pn * 256 * K * 2; }
    __device__ __forceinline__ int a_row(const pg8::Unit&, int) const { return 0; }
};
struct MoeOrder {
    int NT, nunits, G, c, K; const char* A; const char* W; size_t estride; const int* tokmap; volatile LAS int* prefix; bool gather;
    __device__ __forceinline__ bool next(int i, pg8::Unit& u) const {
        const long L = (long)i * G + c; if (L >= nunits) return false;
        int wgid = (int)L; { const int q = nunits / 8, r = nunits % 8, xcd = wgid % 8, off = wgid / 8; wgid = (xcd < r ? xcd * (q + 1) : r * (q + 1) + (xcd - r) * q) + off; }
        const int tile = wgid / NT; u.pm = tile; u.pn = wgid - tile * NT;
        int e = 0;
#pragma unroll 1
        for (int j = 1; j < NE; ++j) e += (prefix[j] <= tile) ? 1 : 0;
        u.e = e; return true;
    }
    __device__ __forceinline__ const char* a_base(const pg8::Unit& u) const { return A; }
    __device__ __forceinline__ const char* b_base(const pg8::Unit& u) const { return W + (size_t)u.e * estride + (size_t)u.pn * 256 * K * 2; }
    __device__ __forceinline__ int a_row(const pg8::Unit& u, int r) const { return gather ? tokmap[u.pm * 256 + r] : u.pm * 256 + r; }
};

typedef f32x4 AccT[2][2][4][2];
struct EpiStoreBf16 {
    static constexpr bool PERM = true;
    bf16_t* O; int ldc;
    __device__ __forceinline__ void operator()(const AccT& acc, const pg8::Unit& u, int wr, int wc, int fr, int fq) const {
        const int row0 = u.pm * 256 + wr * 64 + fr, col0 = u.pn * 256 + wc * 32 + 8 * fq;
#pragma unroll
        for (int ai = 0; ai < 2; ++ai)
#pragma unroll
            for (int m = 0; m < 4; ++m) { bf16_t* rowp = O + (size_t)(row0 + ai * 128 + m * 16) * ldc + col0;
#pragma unroll
                for (int bj = 0; bj < 2; ++bj) { const f32x4 v0 = acc[ai][bj][m][0], v1 = acc[ai][bj][m][1];
                    u32x4 w; w.x = pg8::cvt_pk_bf16(v0[0], v0[1]); w.y = pg8::cvt_pk_bf16(v0[2], v0[3]); w.z = pg8::cvt_pk_bf16(v1[0], v1[1]); w.w = pg8::cvt_pk_bf16(v1[2], v1[3]);
                    *(u32x4*)(rowp + bj * 128) = w; } }
    }
};
struct EpiY {
    static constexpr bool PERM = true;
    bf16_t* O; const float* b2;
    __device__ __forceinline__ void operator()(const AccT& acc, const pg8::Unit& u, int wr, int wc, int fr, int fq) const {
        const int row0 = u.pm * 256 + wr * 64 + fr, col0 = u.pn * 256 + wc * 32 + 8 * fq;
        const float* bp = b2 + (size_t)u.e * D + col0;
#pragma unroll
        for (int bj = 0; bj < 2; ++bj) {
            const f32x4 b0 = *(const f32x4*)(bp + bj * 128), b1v = *(const f32x4*)(bp + bj * 128 + 4);
#pragma unroll
            for (int ai = 0; ai < 2; ++ai)
#pragma unroll
                for (int m = 0; m < 4; ++m) { bf16_t* rowp = O + (size_t)(row0 + ai * 128 + m * 16) * D + col0 + bj * 128;
                    const f32x4 v0 = acc[ai][bj][m][0] * (1.0f / 1024.0f) + b0, v1 = acc[ai][bj][m][1] * (1.0f / 1024.0f) + b1v;
                    u32x4 w; w.x = pg8::cvt_pk_bf16(v0[0], v0[1]); w.y = pg8::cvt_pk_bf16(v0[2], v0[3]); w.z = pg8::cvt_pk_bf16(v1[0], v1[1]); w.w = pg8::cvt_pk_bf16(v1[2], v1[3]);
                    *(u32x4*)rowp = w; } }
    }
};
struct EpiSwiglu {
    static constexpr bool PERM = true;
    unsigned char* O; const float* b1;
    __device__ __forceinline__ void operator()(const AccT& acc, const pg8::Unit& u, int wr, int wc, int fr, int fq) const {
        const int row0 = u.pm * 256 + wr * 64 + fr, cc0 = u.pn * 128 + wc * 32 + 8 * fq;
        const float* bp = b1 + (size_t)u.e * 2048 + cc0;
        f32x4 bg[2], bl[2];
#pragma unroll
        for (int n = 0; n < 2; ++n) { bg[n] = *(const f32x4*)(bp + 4 * n); bl[n] = *(const f32x4*)(bp + 1024 + 4 * n); }
#pragma unroll
        for (int ai = 0; ai < 2; ++ai)
#pragma unroll
            for (int m = 0; m < 4; ++m) { unsigned char* rowp = O + (size_t)(row0 + ai * 128 + m * 16) * D + cc0;
                float o[8];
#pragma unroll
                for (int n = 0; n < 2; ++n) { const f32x4 gl = acc[ai][0][m][n] * (1.0f / 2048.0f) + bg[n], li = acc[ai][1][m][n] * (1.0f / 2048.0f) + bl[n];
#pragma unroll
                    for (int j = 0; j < 4; ++j) { const float g = fminf(gl[j], 7.0f), l = fminf(fmaxf(li[j], -7.0f), 7.0f);
                        o[4 * n + j] = fminf(fmaxf(8.0f * g * sigmoidf_(1.702f * g) * (l + 1.0f), -448.0f), 448.0f); } }
                u32x2 w; w.x = pk4_fp8(o[0], o[1], o[2], o[3]); w.y = pk4_fp8(o[4], o[5], o[6], o[7]);
                *(u32x2*)rowp = w; }
    }
};
struct EpiResid {
    static constexpr bool PERM = false;
    float* xs; const float* g;
    __device__ __forceinline__ void operator()(const AccT& acc, const pg8::Unit& u, int wr, int wc, int fr, int fq) const {
        const int row0 = u.pm * 256 + wr * 64 + fr, col0 = u.pn * 256 + wc * 32 + 4 * fq;
        const int mb = u.pm < 8 ? 8 : ((u.pm - 8) >> 4);
        const float* gp = g + (size_t)mb * 6144 + col0;
        f32x4 gv[2][2];
#pragma unroll
        for (int bj = 0; bj < 2; ++bj)
#pragma unroll
            for (int n = 0; n < 2; ++n) gv[bj][n] = *(const f32x4*)(gp + bj * 128 + n * 16);
#pragma unroll
        for (int ai = 0; ai < 2; ++ai)
#pragma unroll
            for (int m = 0; m < 4; ++m) { float* rowp = xs + (size_t)(row0 + ai * 128 + m * 16) * D + col0;
#pragma unroll
                for (int bj = 0; bj < 2; ++bj)
#pragma unroll
                    for (int n = 0; n < 2; ++n) { f32x4* p = (f32x4*)(rowp + bj * 128 + n * 16); *p = *p + gv[bj][n] * acc[ai][bj][m][n]; } }
    }
};

__device__ __forceinline__ const float* modp(const Frame& F, int l, int mb, int chunk) { return (const float*)(wsp(F) + WS_MOD) + ((size_t)(l * 9 + mb) * 6 + chunk) * D; }
__device__ __forceinline__ int row_mb(int row) { return row < ROWS_CTX ? 8 : ((row - ROWS_CTX) >> 12); }

__device__ __forceinline__ void transpose_item(const float* W, int N, int Nvalid, bf16_t* WT, int k0, int n0, LAS float* scr, int lane) {
    const int nn = 4 * (lane & 15);
    const bool ok = (n0 + nn) < Nvalid;
    f32x4 v[16];
#pragma unroll
    for (int i = 0; i < 16; ++i) { const int kk = 4 * i + (lane >> 4);
        v[i] = ok ? *(const f32x4*)(W + (size_t)(k0 + kk) * N + n0 + nn) : (f32x4){0.f, 0.f, 0.f, 0.f}; }
#pragma unroll
    for (int i = 0; i < 16; ++i) { const int kk = 4 * i + (lane >> 4); LAS float* s = scr + kk * 65 + nn;
        s[0] = v[i][0]; s[1] = v[i][1]; s[2] = v[i][2]; s[3] = v[i][3]; }
    LDS_WAIT(); asm volatile("" ::: "memory");
    const int c = lane & 7;
#pragma unroll
    for (int j = 0; j < 8; ++j) { const int n = (lane >> 3) + 8 * j; const LAS float* s = scr + (8 * c) * 65 + n;
        u32x4 o; o.x = pk2(s[0 * 65], s[1 * 65]); o.y = pk2(s[2 * 65], s[3 * 65]); o.z = pk2(s[4 * 65], s[5 * 65]); o.w = pk2(s[6 * 65], s[7 * 65]);
        *(u32x4*)(WT + (size_t)n * D + k0 + 8 * c) = o; }
    LDS_WAIT(); asm volatile("" ::: "memory");
}
__device__ __forceinline__ void transpose_item_f8(const float* W, int N, unsigned char* WT, int k0, int n0, LAS float* scr, int lane, float scale) {
    const int nn = 4 * (lane & 15);
    f32x4 v[16];
#pragma unroll
    for (int i = 0; i < 16; ++i) { const int kk = 4 * i + (lane >> 4); v[i] = *(const f32x4*)(W + (size_t)(k0 + kk) * N + n0 + nn); }
#pragma unroll
    for (int i = 0; i < 16; ++i) { const int kk = 4 * i + (lane >> 4); LAS float* s = scr + kk * 65 + nn;
        s[0] = v[i][0] * scale; s[1] = v[i][1] * scale; s[2] = v[i][2] * scale; s[3] = v[i][3] * scale; }
    LDS_WAIT(); asm volatile("" ::: "memory");
    const int c = lane & 3;
#pragma unroll
    for (int j = 0; j < 4; ++j) { const int n = (lane >> 2) + 16 * j; const LAS float* s = scr + (16 * c) * 65 + n;
        u32x4 o; o.x = pk4_fp8(s[0 * 65], s[1 * 65], s[2 * 65], s[3 * 65]); o.y = pk4_fp8(s[4 * 65], s[5 * 65], s[6 * 65], s[7 * 65]);
        o.z = pk4_fp8(s[8 * 65], s[9 * 65], s[10 * 65], s[11 * 65]); o.w = pk4_fp8(s[12 * 65], s[13 * 65], s[14 * 65], s[15 * 65]);
        *(u32x4*)(WT + (size_t)n * D + k0 + 16 * c) = o; }
    LDS_WAIT(); asm volatile("" ::: "memory");
}
__device__ __forceinline__ void phase0(Frame& F) {
    const int tid = F.tid, lane = F.lane, wave = F.wave;
    {
        LAS float* sT = (LAS float*)F.lds;
        LAS float* red = (LAS float*)(F.lds + 40960);
        const float* c = inp(F, I_C); const float* cctx = inp(F, I_CCTX);
        for (int idx = tid; idx < 9 * D; idx += NTHREADS) { const int mb = idx >> 10, k = idx & 1023; const float cv = mb < 8 ? c[mb * D + k] : cctx[k]; sT[idx] = cv / (1.f + __expf(-cv)); }
        __syncthreads();
        float* mod = (float*)(wsp(F) + WS_MOD);
        for (int task = F.vcu; task < DEPTH * 96; task += F.G) {
            const int l = task / 96, cb = task % 96;
            const float* wp = inp(F, I_WADA) + ((size_t)l * D + wave * 128) * 6144 + cb * 64 + lane;
            float acc[9];
#pragma unroll
            for (int mb = 0; mb < 9; ++mb) acc[mb] = 0.f;
#pragma unroll 8
            for (int k = 0; k < 128; ++k) { const float wv = wp[(size_t)k * 6144];
#pragma unroll
                for (int mb = 0; mb < 9; ++mb) acc[mb] += sT[mb * D + wave * 128 + k] * wv; }
#pragma unroll
            for (int mb = 0; mb < 9; ++mb) red[(wave * 9 + mb) * 64 + lane] = acc[mb];
            __syncthreads();
            for (int idx = tid; idx < 9 * 64; idx += NTHREADS) { const int mb = idx >> 6, ln = idx & 63; float s = 0.f;
#pragma unroll
                for (int w = 0; w < 8; ++w) s += red[(w * 9 + mb) * 64 + ln];
                const int col = cb * 64 + ln;
                mod[(size_t)(l * 9 + mb) * 6144 + col] = s + inp(F, I_BADA)[l * 6144 + col]; }
            __syncthreads();
        }
        if (blockIdx.x == 0) {
            float* rope = (float*)(wsp(F) + WS_ROPE);
            for (int idx = tid; idx < 64 * 16; idx += NTHREADS) { const int pos = idx >> 4, i = idx & 15; const float inv = powf(10000.0f, -(float)i / 16.0f); const float ang = (float)pos * inv;
                rope[idx * 2] = cosf(ang); rope[idx * 2 + 1] = sinf(ang); }
        }
        __syncthreads();
    }
    {
        LAS float* scr = (LAS float*)(F.lds + wave * 16640);
        const int gw = F.vcu * NWAVES + wave, NGW = F.G * NWAVES;
        constexpr int I_QKV = 2 * 16 * 48, I_WO = 4 * 16 * 16, I_IN = 2 * 16 * 52, I_1 = DEPTH * NE * 16 * 32, I_2 = DEPTH * NE * 16 * 16;
        for (int it0 = gw; it0 < I_QKV + I_WO + I_IN + I_1 + I_2; it0 += NGW) {
            int it = it0;
            if (it < I_QKV) { const int j = it / 768, r = it % 768, kb = r / 48, nb = r % 48;
                transpose_item(inp(F, I_WQKV) + (size_t)j * D * 3072, 3072, 3072, (bf16_t*)(wsp(F) + WS_WQKV) + ((size_t)j * 3072 + nb * 64) * D, kb * 64, nb * 64, scr, lane); continue; }
            it -= I_QKV;
            if (it < I_WO) { const int m = it / 256, r = it % 256, kb = r / 16, nb = r % 16;
                const float* W = (m < 2) ? inp(F, I_WONA) + (size_t)m * D * D : inp(F, I_WOML) + (size_t)(m - 2) * D * D;
                bf16_t* dst = (m < 2) ? (bf16_t*)(wsp(F) + WS_WONA) + (size_t)m * D * D : (bf16_t*)(wsp(F) + WS_WOML) + (size_t)(m - 2) * D * D;
                transpose_item(W, D, D, dst + (size_t)nb * 64 * D, kb * 64, nb * 64, scr, lane); continue; }
            it -= I_WO;
            if (it < I_IN) { const int j = it / 832, r = it % 832, kb = r / 52, nb = r % 52;
                transpose_item(inp(F, I_WIN) + (size_t)j * D * ML_IN, ML_IN, ML_IN, (bf16_t*)(wsp(F) + WS_WIN) + ((size_t)j * ML_INP + nb * 64) * D, kb * 64, nb * 64, scr, lane); continue; }
            it -= I_IN;
            if (it < I_1) { const int le = it / 512, r = it % 512, kb = r / 32, nb = r % 32;
                const int n0 = nb * 64, bj = n0 >> 10, j0 = n0 & 1023, pn = j0 >> 7, jj0 = j0 & 127, drow = pn * 256 + bj * 128 + jj0;
                transpose_item_f8(inp(F, I_W1) + (size_t)le * D * 2048, 2048, (unsigned char*)(wsp(F) + WS_W1T) + ((size_t)le * 2048 + drow) * D, kb * 64, n0, scr, lane, 128.0f); continue; }
            it -= I_1;
            { const int le = it / 256, r = it % 256, kb = r / 16, nb = r % 16;
                transpose_item_f8(inp(F, I_W2) + (size_t)le * D * D, D, (unsigned char*)(wsp(F) + WS_W2T) + ((size_t)le * D + nb * 64) * D, kb * 64, nb * 64, scr, lane, 128.0f); }
        }
    }
}

__device__ __forceinline__ void moe_combine(const Frame& F, int row, int lprev, int mb, f32x4 (&v)[4]) {
    const int* pos = (const int*)(wsp(F) + WS_POS) + (size_t)row * 4;
    const float* tw = (const float*)(wsp(F) + WS_TOPW) + (size_t)row * 4;
    const bf16_t* Y = (const bf16_t*)(wsp(F) + WS_Y);
    f32x4 a[4];
#pragma unroll
    for (int j = 0; j < 4; ++j) a[j] = (f32x4){0.f, 0.f, 0.f, 0.f};
#pragma unroll
    for (int k = 0; k < 4; ++k) { const int p = pos[k]; const float w = tw[k]; const u32x2* yp = (const u32x2*)(Y + (size_t)p * D) + F.lane;
#pragma unroll
        for (int j = 0; j < 4; ++j) { const u32x2 y = yp[64 * j]; a[j] = a[j] + w * (f32x4){bflo(y.x), bfhi(y.x), bflo(y.y), bfhi(y.y)}; } }
    const f32x4* g2 = (const f32x4*)modp(F, lprev, mb, 5) + F.lane;
#pragma unroll
    for (int j = 0; j < 4; ++j) v[j] = v[j] + g2[64 * j] * a[j];
}

__device__ __forceinline__ void phase_norm1(Frame& F, int l) {
    const int gw = F.vcu * NWAVES + F.wave, NGW = F.G * NWAVES, lane = F.lane;
    float* xs = (float*)(wsp(F) + WS_XS); bf16_t* hb = (bf16_t*)(wsp(F) + WS_HB);
    const f32x4* gm = (const f32x4*)(inp(F, I_GMIX) + l * D) + lane;
    for (int row = gw; row < ROWS; row += NGW) {
        const int mb = row_mb(row);
        const float* src = (l == 0) ? (row < ROWS_CTX ? inp(F, I_CTX) + (size_t)row * D : inp(F, I_X) + (size_t)(row - ROWS_CTX) * D) : xs + (size_t)row * D;
        const f32x4* xr = (const f32x4*)src + lane;
        f32x4 v[4];
#pragma unroll
        for (int j = 0; j < 4; ++j) v[j] = xr[64 * j];
        if (l > 0) moe_combine(F, row, l - 1, mb, v);
        f32x4* xw = (f32x4*)(xs + (size_t)row * D) + lane;
        float ss = 0.f;
#pragma unroll
        for (int j = 0; j < 4; ++j) { xw[64 * j] = v[j]; ss += (v[j][0] * v[j][0] + v[j][1] * v[j][1]) + (v[j][2] * v[j][2] + v[j][3] * v[j][3]); }
        const float rs = 1.0f / sqrtf(wave_sum(ss) * (1.f / D) + EPS);
        const f32x4* sh = (const f32x4*)modp(F, l, mb, 0) + lane; const f32x4* sc = (const f32x4*)modp(F, l, mb, 1) + lane;
        u32x2* o8 = (u32x2*)(hb + (size_t)row * D) + lane;
#pragma unroll
        for (int j = 0; j < 4; ++j) { const f32x4 h = (v[j] * rs) * gm[64 * j] * (sc[64 * j] + 1.0f) + sh[64 * j];
            u32x2 w; w.x = pk2(h[0], h[1]); w.y = pk2(h[2], h[3]); o8[64 * j] = w; }
    }
}
__device__ __forceinline__ void phase_final(Frame& F) {
    const int gw = F.vcu * NWAVES + F.wave, NGW = F.G * NWAVES, lane = F.lane;
    const float* xs = (const float*)(wsp(F) + WS_XS);
    for (int row = ROWS_CTX + gw; row < ROWS; row += NGW) {
        const int mb = row_mb(row);
        const f32x4* xr = (const f32x4*)(xs + (size_t)row * D) + lane;
        f32x4 v[4];
#pragma unroll
        for (int j = 0; j < 4; ++j) v[j] = xr[64 * j];
        moe_combine(F, row, DEPTH - 1, mb, v);
        f32x4* o = (f32x4*)(outp(F) + (size_t)(row - ROWS_CTX) * D) + lane;
#pragma unroll
        for (int j = 0; j < 4; ++j) o[64 * j] = v[j];
    }
}

__device__ __forceinline__ void phase_na_post(Frame& F, int jn) {
    const int gw = F.vcu * NWAVES + F.wave, NGW = F.G * NWAVES, lane = F.lane;
    const bf16_t* proj = (const bf16_t*)(wsp(F) + WS_PROJ);
    bf16_t* QN = (bf16_t*)(wsp(F) + WS_QN); bf16_t* KN = (bf16_t*)(wsp(F) + WS_KN); bf16_t* VT = (bf16_t*)(wsp(F) + WS_VT);
    LAS bf16_t* vs = (LAS bf16_t*)(F.lds + F.wave * (64 * 72 * 2));
    const int c8 = lane & 7, rl = lane >> 3;
    float qg[8], kg[8];
#pragma unroll
    for (int e = 0; e < 8; ++e) { qg[e] = inp(F, I_QGAIN)[jn * 64 + c8 * 8 + e] * (0.125f * 1.44269504f); kg[e] = inp(F, I_KGAIN)[jn * 64 + c8 * 8 + e]; }
    for (int item = gw; item < (ROWS / 64) * NH_NA; item += NGW) {
        const int rb = item >> 4, h = item & 15, row0 = rb * 64;
        int b, tp0;
        if (row0 < ROWS_CTX) { b = row0 >> 8; tp0 = row0 & 255; } else { b = (row0 - ROWS_CTX) >> 12; tp0 = NCTX + ((row0 - ROWS_CTX) & 4095); }
        const size_t seqbase = ((size_t)(b * NH_NA + h) * TT + tp0) * 64;
#pragma unroll
        for (int i = 0; i < 8; ++i) {
            const int r = i * 8 + rl;
            const bf16_t* pr = proj + (size_t)(row0 + r) * 3072 + h * 64 + c8 * 8;
            const u32x4 qv = *(const u32x4*)pr, kv = *(const u32x4*)(pr + 1024), vv = *(const u32x4*)(pr + 2048);
            float q[8] = {bflo(qv.x), bfhi(qv.x), bflo(qv.y), bfhi(qv.y), bflo(qv.z), bfhi(qv.z), bflo(qv.w), bfhi(qv.w)};
            float k[8] = {bflo(kv.x), bfhi(kv.x), bflo(kv.y), bfhi(kv.y), bflo(kv.z), bfhi(kv.z), bflo(kv.w), bfhi(kv.w)};
            float sq = 0.f, sk = 0.f;
#pragma unroll
            for (int e = 0; e < 8; ++e) { sq += q[e] * q[e]; sk += k[e] * k[e]; }
            sq += __shfl_xor(sq, 1); sq += __shfl_xor(sq, 2); sq += __shfl_xor(sq, 4);
            sk += __shfl_xor(sk, 1); sk += __shfl_xor(sk, 2); sk += __shfl_xor(sk, 4);
            const float rq = 1.0f / sqrtf(sq * (1.f / 64) + EPS), rk = 1.0f / sqrtf(sk * (1.f / 64) + EPS);
            u32x4 qo, ko;
            qo.x = pk2(q[0] * rq * qg[0], q[1] * rq * qg[1]); qo.y = pk2(q[2] * rq * qg[2], q[3] * rq * qg[3]); qo.z = pk2(q[4] * rq * qg[4], q[5] * rq * qg[5]); qo.w = pk2(q[6] * rq * qg[6], q[7] * rq * qg[7]);
            ko.x = pk2(k[0] * rk * kg[0], k[1] * rk * kg[1]); ko.y = pk2(k[2] * rk * kg[2], k[3] * rk * kg[3]); ko.z = pk2(k[4] * rk * kg[4], k[5] * rk * kg[5]); ko.w = pk2(k[6] * rk * kg[6], k[7] * rk * kg[7]);
            *(u32x4*)(QN + seqbase + (size_t)r * 64 + c8 * 8) = qo;
            *(u32x4*)(KN + seqbase + (size_t)r * 64 + c8 * 8) = ko;
            *(LAS u32x4*)(vs + r * 72 + c8 * 8) = vv;
        }
        LDS_WAIT(); asm volatile("" ::: "memory");
#pragma unroll
        for (int j = 0; j < 8; ++j) {
            const int d = rl + 8 * j;
            const LAS bf16_t* s = vs + (8 * c8) * 72 + d;
            u32x4 o;
            o.x = (unsigned)s[0 * 72] | ((unsigned)s[1 * 72] << 16); o.y = (unsigned)s[2 * 72] | ((unsigned)s[3 * 72] << 16);
            o.z = (unsigned)s[4 * 72] | ((unsigned)s[5 * 72] << 16); o.w = (unsigned)s[6 * 72] | ((unsigned)s[7 * 72] << 16);
            *(u32x4*)(VT + ((size_t)(b * NH_NA + h) * 64 + d) * TT + tp0 + 8 * c8) = o;
        }
        LDS_WAIT(); asm volatile("" ::: "memory");
    }
}

__device__ __forceinline__ bf16x8 ld_bf16x8(const bf16_t* p) { return *(const bf16x8*)p; }
constexpr int NA_LD = 72;
constexpr int NA_TILE = 64 * NA_LD * 2;
struct NaState { f32x4 o[4]; f32x4 osum; };
constexpr int NA_RING = 2 * 2 * 64 * NA_LD * 2;
constexpr int NA_BT_LD = 128, NA_BT_OFF = 48;
template <bool H0, bool H1, bool WIN>
__device__ __forceinline__ void na_tile(NaState& st, const LAS bf16_t* KL, const LAS bf16_t* VL, const bf16x8 qf0, const bf16x8 qf1,
                                        const LAS float* brow, const float (&madd)[16], int q16, int g) {
    constexpr int NH = (H0 ? 1 : 0) + (H1 ? 1 : 0), HB = H0 ? 0 : 1;
    union { u32x4 u; bf16x8 v; } ones; ones.u = (u32x4){0x3F803F80u, 0x3F803F80u, 0x3F803F80u, 0x3F803F80u};
#pragma unroll
    for (int hh = 0; hh < NH; ++hh) { const int half = HB + hh;
        f32x4 s[2];
#pragma unroll
        for (int nb = 0; nb < 2; ++nb) { f32x4 init = (f32x4){0.f, 0.f, 0.f, 0.f};
            if (WIN) {
#pragma unroll
                for (int rg = 0; rg < 4; ++rg) init[rg] = brow[32 * half + 16 * nb + rg] + madd[8 * half + 4 * nb + rg]; }
            const LAS bf16_t* kp = KL + (half * 32 + 16 * nb + q16) * NA_LD + 8 * g;
            init = __builtin_amdgcn_mfma_f32_16x16x32_bf16(*(const LAS bf16x8*)kp, qf0, init, 0, 0, 0);
            s[nb] = __builtin_amdgcn_mfma_f32_16x16x32_bf16(*(const LAS bf16x8*)(kp + 32), qf1, init, 0, 0, 0); }
        bf16x8 vf[4];
#pragma unroll
        for (int j4 = 0; j4 < 4; ++j4) { const LAS bf16_t* vp = VL + (16 * j4 + q16) * NA_LD + half * 32 + 4 * g;
            const bf16x4 va = *(const LAS bf16x4*)vp, vb = *(const LAS bf16x4*)(vp + 16);
            vf[j4] = (bf16x8){va[0], va[1], va[2], va[3], vb[0], vb[1], vb[2], vb[3]}; }
#pragma unroll
        for (int nb = 0; nb < 2; ++nb)
#pragma unroll
            for (int rg = 0; rg < 4; ++rg) s[nb][rg] = __builtin_amdgcn_exp2f(fminf(s[nb][rg], 100.0f));
        union { u32x4 u; bf16x8 v; } pf;
        pf.u.x = pg8::cvt_pk_bf16(s[0][0], s[0][1]); pf.u.y = pg8::cvt_pk_bf16(s[0][2], s[0][3]); pf.u.z = pg8::cvt_pk_bf16(s[1][0], s[1][1]); pf.u.w = pg8::cvt_pk_bf16(s[1][2], s[1][3]);
#pragma unroll
        for (int j4 = 0; j4 < 4; ++j4) st.o[j4] = __builtin_amdgcn_mfma_f32_16x16x32_bf16(vf[j4], pf.v, st.o[j4], 0, 0, 0);
        st.osum = __builtin_amdgcn_mfma_f32_16x16x32_bf16(ones.v, pf.v, st.osum, 0, 0, 0);
    }
}
__device__ __forceinline__ void na_block_task(const Frame& F, int jn, int b, int h, bool ctxq, int p) {
    const int tid = F.tid, lane = F.lane, wave = F.wave, q16 = lane & 15, g = lane >> 4;
    const bf16_t* Qb = (const bf16_t*)(wsp(F) + WS_QN) + (size_t)(b * NH_NA + h) * TT * 64;
    const bf16_t* Kb = (const bf16_t*)(wsp(F) + WS_KN) + (size_t)(b * NH_NA + h) * TT * 64;
    const bf16_t* Vb = (const bf16_t*)(wsp(F) + WS_VT) + (size_t)(b * NH_NA + h) * 64 * TT;
    const int rw = 2 * p + (wave >> 2), qw = wave & 3, qc = qw * 16 + q16;
    const int qtp = ctxq ? p * 128 + wave * 16 + q16 : NCTX + rw * 64 + qc;
    const bf16x8 qf0 = ld_bf16x8(Qb + (size_t)qtp * 64 + 8 * g), qf1 = ld_bf16x8(Qb + (size_t)qtp * 64 + 32 + 8 * g);
    NaState st;
#pragma unroll
    for (int j = 0; j < 4; ++j) st.o[j] = (f32x4){0.f, 0.f, 0.f, 0.f};
    st.osum = (f32x4){0.f, 0.f, 0.f, 0.f};
    const int r0w = min(max(rw - 4, 0), 56), c0 = min(max(qc - 8, 0), 48);
    const int kr_lo = min(max(2 * p - 4, 0), 56), kr_hi = min(max(2 * p + 1 - 4, 0), 56) + 7;
    const int ntile = ctxq ? 4 : 4 + (kr_hi - kr_lo + 1);
    LAS bf16_t* ring = (LAS bf16_t*)F.lds;
    LAS float* btab = (LAS float*)(F.lds + NA_RING);
    float madd[16];
#pragma unroll
    for (int e = 0; e < 16; ++e) { const int kc = 32 * (e >> 3) + 16 * ((e >> 2) & 1) + 4 * g + (e & 3); madd[e] = (kc >= c0 && kc <= c0 + 15) ? 0.f : -1e30f; }
    const int bcol = NA_BT_OFF + 4 * g - qc + 15;
    const int r = tid >> 3, c8 = tid & 7;
    u32x4 kA, vA, kB, vB;
#define NA_TOK0(t) ((t) < 4 ? 64 * (t) : NCTX + 64 * (kr_lo + (t) - 4))
#define NA_LOAD(t, kk, vv) do { const int tok0_ = NA_TOK0(t); kk = *(const u32x4*)(Kb + (size_t)(tok0_ + r) * 64 + 8 * c8); vv = *(const u32x4*)(Vb + (size_t)r * TT + tok0_ + 8 * c8); } while (0)
#define NA_WRITE(bufi, kk, vv) do { LAS bf16_t* dst_ = ring + (bufi) * (2 * 64 * NA_LD); *(LAS u32x4*)(dst_ + r * NA_LD + 8 * c8) = kk; *(LAS u32x4*)(dst_ + 64 * NA_LD + r * NA_LD + 8 * c8) = vv; } while (0)
#define NA_TILE(t, bufi) do { const LAS bf16_t* KL = ring + (bufi) * (2 * 64 * NA_LD); const LAS bf16_t* VL = KL + 64 * NA_LD; \
        if ((t) < 4) na_tile<true, true, false>(st, KL, VL, qf0, qf1, btab, madd, q16, g); \
        else if (!ctxq) { const int kr = kr_lo + (t) - 4; \
            if (kr >= r0w && kr <= r0w + 7) { const LAS float* brow = btab + (kr - rw + 7) * NA_BT_LD + bcol; \
                if (qw == 0) na_tile<true, false, true>(st, KL, VL, qf0, qf1, brow, madd, q16, g); \
                else if (qw == 3) na_tile<false, true, true>(st, KL, VL, qf0, qf1, brow, madd, q16, g); \
                else na_tile<true, true, true>(st, KL, VL, qf0, qf1, brow, madd, q16, g); } } } while (0)
    NA_LOAD(0, kA, vA); NA_LOAD(1, kB, vB);
    NA_WRITE(0, kA, vA);
    __syncthreads();
    NA_LOAD(2, kA, vA);
    for (int t = 0; t < ntile; t += 2) {
        NA_TILE(t, 0);
        if (t + 1 < ntile) NA_WRITE(1, kB, vB);
        __syncthreads();
        if (t + 3 < ntile) NA_LOAD(t + 3, kB, vB);
        if (t + 1 >= ntile) break;
        NA_TILE(t + 1, 1);
        if (t + 2 < ntile) NA_WRITE(0, kA, vA);
        __syncthreads();
        if (t + 4 < ntile) NA_LOAD(t + 4, kA, vA);
    }
#undef NA_TOK0
#undef NA_LOAD
#undef NA_WRITE
#undef NA_TILE
    const float inv = 1.0f / st.osum[0];
    const int row = ctxq ? b * NCTX + p * 128 + wave * 16 + q16 : ROWS_CTX + b * SEQ + rw * 64 + qc;
    bf16_t* op = (bf16_t*)(wsp(F) + WS_AO) + (size_t)row * D + h * 64 + 4 * g;
#pragma unroll
    for (int j4 = 0; j4 < 4; ++j4) { u32x2 w; w.x = pk2(st.o[j4][0] * inv, st.o[j4][1] * inv); w.y = pk2(st.o[j4][2] * inv, st.o[j4][3] * inv); *(u32x2*)(op + 16 * j4) = w; }
}
__device__ __forceinline__ void phase_na_attn(Frame& F, int jn) {
    const int nbh = NB * NH_NA;
    for (int slot = F.vcu; slot < 2 * nbh; slot += F.G) {
        const int bh = slot >> 1, hf = slot & 1, b = bh >> 4, h = bh & 15;
        {
            LAS float* btab = (LAS float*)(F.lds + NA_RING);
            const float* rpb = inp(F, I_RPB) + (size_t)(jn * NH_NA + h) * 15 * 31;
            for (int i = F.tid; i < 15 * NA_BT_LD; i += NTHREADS) { const int dr = i >> 7, c = (i & 127) - NA_BT_OFF; btab[i] = (c >= 0 && c < 31) ? rpb[dr * 31 + c] * 1.44269504f : 0.f; }
            __syncthreads();
        }
        for (int n = 0; n < 16; ++n) na_block_task(F, jn, b, h, false, hf * 16 + n);
        na_block_task(F, jn, b, h, true, hf);
        __syncthreads();
    }
}

__device__ __forceinline__ void row_decode(int row, int& b, int& tp) {
    if (row < ROWS_CTX) { b = row >> 8; tp = row & 255; } else { b = (row - ROWS_CTX) >> 12; tp = NCTX + ((row - ROWS_CTX) & 4095); }
}
__device__ __forceinline__ void unpack8(const u32x4 v, float (&f)[8]) { f[0] = bflo(v.x); f[1] = bfhi(v.x); f[2] = bflo(v.y); f[3] = bfhi(v.y); f[4] = bflo(v.z); f[5] = bfhi(v.z); f[6] = bflo(v.w); f[7] = bfhi(v.w); }
__device__ __forceinline__ u32x4 pack8(const float (&f)[8]) { u32x4 o; o.x = pk2(f[0], f[1]); o.y = pk2(f[2], f[3]); o.z = pk2(f[4], f[5]); o.w = pk2(f[6], f[7]); return o; }
__device__ __forceinline__ void phase_ml_post(Frame& F, int jm) {
    const int gw = F.vcu * NWAVES + F.wave, NGW = F.G * NWAVES, lane = F.lane;
    bf16_t* proj = (bf16_t*)(wsp(F) + WS_PROJ);
    const float* rope = (const float*)(wsp(F) + WS_ROPE);
    float* gates = (float*)(wsp(F) + WS_GATES);
    const int t16 = lane >> 2, sub = lane & 3, hf = sub >> 1, i0 = 8 * (sub & 1), cbase = t16 * 64 + 32 * hf + i0;
    const float scale = t16 < 8 ? 0.125f : 1.0f;
    for (int row = gw; row < ROWS; row += NGW) {
        int b, tp; row_decode(row, b, tp);
        bf16_t* pr = proj + (size_t)row * ML_INP;
        float a[8], c[8], o1[8], o2[8];
        unpack8(*(const u32x4*)(pr + cbase), a); unpack8(*(const u32x4*)(pr + cbase + 16), c);
        if (tp >= NCTX) {
            const int s = tp - NCTX, pos = hf ? (s & 63) : (s >> 6);
            const float* rp = rope + (pos * 16 + i0) * 2;
#pragma unroll
            for (int e = 0; e < 8; ++e) { const float cs = rp[2 * e], sn = rp[2 * e + 1]; o1[e] = (a[e] * cs - c[e] * sn) * scale; o2[e] = (a[e] * sn + c[e] * cs) * scale; }
        } else {
#pragma unroll
            for (int e = 0; e < 8; ++e) { o1[e] = a[e] * scale; o2[e] = c[e] * scale; }
        }
        float gv = 0.f;
        if (lane < 32) gv = bf2f(pr[3072 + lane]);
        *(u32x4*)(pr + cbase) = pack8(o1); *(u32x4*)(pr + cbase + 16) = pack8(o2);
        if (lane < 32) {
            float v = gv + inp(F, I_BGATE)[jm * 32 + lane];
            v = 15.0f * tanhf(v * (1.0f / 15.0f));
            const int gi = lane >> 3, hh = lane & 7;
            if (gi & 1) v = fminf(v, 0.f) - log1pf(__expf(-fabsf(v)));
            gates[((size_t)(gi * NB + b) * NH_ML + hh) * TT + tp] = v;
        }
    }
}

constexpr int ML_LD = 72;
constexpr int ML_QL = 0, ML_KL = 9216, ML_KET = 18432, ML_VTL = 27648, ML_SDL = 36864, ML_C0L = 46080, ML_N0L = 55296, ML_DENL = 55552;
__device__ __forceinline__ float wave_prefix_sum(float v, int lane) {
#pragma unroll
    for (int o = 1; o < 64; o <<= 1) { const float t = __shfl_up(v, o); if (lane >= o) v += t; }
    return v;
}
__device__ __forceinline__ float wave_prefix_max(float v, int lane) {
#pragma unroll
    for (int o = 1; o < 64; o <<= 1) { const float t = __shfl_up(v, o); if (lane >= o) v = fmaxf(v, t); }
    return v;
}
__device__ __forceinline__ int ml_grow(int b, int tp) { return tp < NCTX ? b * NCTX + tp : ROWS_CTX + b * SEQ + (tp - NCTX); }
__device__ __forceinline__ void ml_task(Frame& F, int b, int hh, int dir, int vh) {
    const int tid = F.tid, lane = F.lane, w = F.wave, l15 = lane & 15, g = lane >> 4;
    LAS bf16_t* QL = (LAS bf16_t*)(F.lds + ML_QL); LAS bf16_t* KL = (LAS bf16_t*)(F.lds + ML_KL); LAS bf16_t* KET = (LAS bf16_t*)(F.lds + ML_KET);
    LAS bf16_t* VTL = (LAS bf16_t*)(F.lds + ML_VTL); LAS bf16_t* SDL = (LAS bf16_t*)(F.lds + ML_SDL); LAS bf16_t* C0L = (LAS bf16_t*)(F.lds + ML_C0L);
    LAS float* n0L = (LAS float*)(F.lds + ML_N0L); LAS float* denL = (LAS float*)(F.lds + ML_DENL);
    const bf16_t* proj = (const bf16_t*)(wsp(F) + WS_PROJ);
    const float* gI = (const float*)(wsp(F) + WS_GATES) + ((size_t)((dir * 2 + 0) * NB + b) * NH_ML + hh) * TT;
    const float* gF = (const float*)(wsp(F) + WS_GATES) + ((size_t)((dir * 2 + 1) * NB + b) * NH_ML + hh) * TT;
    bf16_t* hout = (bf16_t*)(wsp(F) + WS_HDIR) + (size_t)dir * ROWS * D + hh * DV_ML + vh * 64;
    const int r = tid >> 3, c8 = tid & 7, sr = dir ? 63 - r : r;
    const int bt = w >> 1, bc0 = 2 * (w & 1);
    for (int i = tid; i < 64 * ML_LD / 2; i += NTHREADS) ((LAS unsigned*)C0L)[i] = 0u;
    if (tid < 64) n0L[tid] = 0.f;
    f32x4 Cst[2]; Cst[0] = (f32x4){0.f, 0.f, 0.f, 0.f}; Cst[1] = (f32x4){0.f, 0.f, 0.f, 0.f};
    float nst = 0.f, m0 = 0.f;
    u32x4 qv, kv, vv; float igv, lfv;
    {
        const int tb = dir ? 192 : 0;
        const bf16_t* pr = proj + (size_t)ml_grow(b, tb + r) * ML_INP;
        qv = *(const u32x4*)(pr + hh * 64 + c8 * 8); kv = *(const u32x4*)(pr + 512 + hh * 64 + c8 * 8); vv = *(const u32x4*)(pr + 1024 + hh * DV_ML + vh * 64 + c8 * 8);
        const int tpg = dir ? tb + 63 - lane : tb + lane;
        igv = gI[tpg]; lfv = gF[tpg];
    }
    float cum, av, pmax, cl, ml, eend;
#define ML_GATES(IG, LF) do { cum = wave_prefix_sum(LF, lane); av = (IG) - cum; pmax = wave_prefix_max(av, lane); cl = __shfl(cum, 63); \
        { const float wend_ = cl - cum + (IG); ml = wave_max(wend_); eend = __expf(wend_ - ml); } } while (0)
    ML_GATES(igv, lfv);
    __syncthreads();
    for (int c = 0; c < TT / 64; ++c) {
        const int tb = dir ? (c < 4 ? 192 - 64 * c : 4544 - 64 * c) : 64 * c;
        const float Mv = fmaxf(m0, pmax);
        const float winter = __expf(m0 - Mv);
        const float floorv = __expf(-(cum + Mv));
        const float mnew = fmaxf(cl + m0, ml);
        const float Ac = __expf(cl + m0 - mnew), Gc = __expf(ml - mnew);
        *(LAS u32x4*)(QL + sr * ML_LD + c8 * 8) = qv;
        *(LAS u32x4*)(KL + sr * ML_LD + c8 * 8) = kv;
        {
            const float es = __shfl(eend, sr);
            float kf[8]; unpack8(kv, kf);
            const unsigned vw[4] = {vv.x, vv.y, vv.z, vv.w};
#pragma unroll
            for (int e = 0; e < 8; ++e) { KET[(c8 * 8 + e) * ML_LD + (sr ^ (8 * c8))] = (bf16_t)pk2(kf[e] * es, 0.f); VTL[(c8 * 8 + e) * ML_LD + (sr ^ (8 * c8))] = (bf16_t)((vw[e >> 1] >> (16 * (e & 1))) & 0xffffu); }
        }
        if (c + 1 < TT / 64) {
            const int cn = c + 1, tbn = dir ? (cn < 4 ? 192 - 64 * cn : 4544 - 64 * cn) : 64 * cn;
            const bf16_t* pr = proj + (size_t)ml_grow(b, tbn + r) * ML_INP;
            qv = *(const u32x4*)(pr + hh * 64 + c8 * 8); kv = *(const u32x4*)(pr + 512 + hh * 64 + c8 * 8); vv = *(const u32x4*)(pr + 1024 + hh * DV_ML + vh * 64 + c8 * 8);
            const int tpg = dir ? tbn + 63 - lane : tbn + lane;
            igv = gI[tpg]; lfv = gF[tpg];
        }
        __syncthreads();
#pragma unroll
        for (int x = 0; x < 2; ++x) {
            const int bs = bc0 + x;
            f32x4 acc = (f32x4){0.f, 0.f, 0.f, 0.f};
            if (bs <= bt) {
#pragma unroll
                for (int ks = 0; ks < 2; ++ks) { const bf16x8 af = *(const LAS bf16x8*)(QL + (16 * bt + l15) * ML_LD + 32 * ks + 8 * g), bfv = *(const LAS bf16x8*)(KL + (16 * bs + l15) * ML_LD + 32 * ks + 8 * g);
                    acc = __builtin_amdgcn_mfma_f32_16x16x32_bf16(af, bfv, acc, 0, 0, 0); }
            }
            const int s = 16 * bs + l15;
            const float a_s = __shfl(av, s);
#pragma unroll
            for (int rg = 0; rg < 4; ++rg) { const int t = 16 * bt + 4 * g + rg; const float M_t = __shfl(Mv, t);
                const float val = (s <= t) ? acc[rg] * __expf(a_s - M_t) : 0.f;
                SDL[t * ML_LD + s] = (bf16_t)pk2(val, 0.f); }
        }
        __syncthreads();
        {
            const int rr8 = 8 * w + (lane >> 3), part = lane & 7;
            float sd[8], qf[8], kf[8];
            unpack8(*(const LAS u32x4*)(SDL + rr8 * ML_LD + 8 * part), sd); unpack8(*(const LAS u32x4*)(QL + rr8 * ML_LD + 8 * part), qf);
            unpack8(*(const LAS u32x4*)(KET + rr8 * ML_LD + ((8 * part) ^ (8 * ((rr8 >> 3) & 7)))), kf);
            const f32x4 n0a = *(const LAS f32x4*)(n0L + 8 * part), n0b = *(const LAS f32x4*)(n0L + 8 * part + 4);
            float rs = ((sd[0] + sd[1]) + (sd[2] + sd[3])) + ((sd[4] + sd[5]) + (sd[6] + sd[7]));
            float qn = qf[0] * n0a[0] + qf[1] * n0a[1] + qf[2] * n0a[2] + qf[3] * n0a[3] + qf[4] * n0b[0] + qf[5] * n0b[1] + qf[6] * n0b[2] + qf[7] * n0b[3];
            float dn = ((kf[0] + kf[1]) + (kf[2] + kf[3])) + ((kf[4] + kf[5]) + (kf[6] + kf[7]));
            rs += __shfl_xor(rs, 1); qn += __shfl_xor(qn, 1); dn += __shfl_xor(dn, 1);
            rs += __shfl_xor(rs, 2); qn += __shfl_xor(qn, 2); dn += __shfl_xor(dn, 2);
            rs += __shfl_xor(rs, 4); qn += __shfl_xor(qn, 4); dn += __shfl_xor(dn, 4);
            const float w_r = __shfl(winter, rr8);
            if (part == 0) denL[rr8] = rs + w_r * qn;
            nst = Ac * nst + Gc * dn;
        }
        f32x4 nin[2], nit[2];
#pragma unroll
        for (int x = 0; x < 2; ++x) {
            const int bv = bc0 + x;
            f32x4 a1 = (f32x4){0.f, 0.f, 0.f, 0.f}, a2 = (f32x4){0.f, 0.f, 0.f, 0.f}, a3 = (f32x4){0.f, 0.f, 0.f, 0.f};
#pragma unroll
            for (int ks = 0; ks < 2; ++ks) {
                const bf16x8 sdf = *(const LAS bf16x8*)(SDL + (16 * bt + l15) * ML_LD + 32 * ks + 8 * g), vtf = *(const LAS bf16x8*)(VTL + (16 * bv + l15) * ML_LD + ((32 * ks + 8 * g) ^ (8 * (((16 * bv + l15) >> 3) & 7))));
                const bf16x8 qf = *(const LAS bf16x8*)(QL + (16 * bt + l15) * ML_LD + 32 * ks + 8 * g), c0f = *(const LAS bf16x8*)(C0L + (16 * bv + l15) * ML_LD + 32 * ks + 8 * g);
                const bf16x8 vt2 = *(const LAS bf16x8*)(VTL + (16 * bt + l15) * ML_LD + ((32 * ks + 8 * g) ^ (8 * (((16 * bt + l15) >> 3) & 7)))), kef = *(const LAS bf16x8*)(KET + (16 * bv + l15) * ML_LD + ((32 * ks + 8 * g) ^ (8 * (((16 * bv + l15) >> 3) & 7))));
                a1 = __builtin_amdgcn_mfma_f32_16x16x32_bf16(sdf, vtf, a1, 0, 0, 0);
                a2 = __builtin_amdgcn_mfma_f32_16x16x32_bf16(qf, c0f, a2, 0, 0, 0);
                a3 = __builtin_amdgcn_mfma_f32_16x16x32_bf16(vt2, kef, a3, 0, 0, 0);
            }
            nin[x] = a1; nit[x] = a2;
            Cst[x] = Cst[x] * Ac + a3 * Gc;
        }
        float cumN = cum, avN = av, pmaxN = pmax, clN = cl, mlN = ml, eendN = eend;
        if (c + 1 < TT / 64) {
            const float cum_ = wave_prefix_sum(lfv, lane); const float av_ = igv - cum_; const float pm_ = wave_prefix_max(av_, lane); const float cl_ = __shfl(cum_, 63);
            const float wend_ = cl_ - cum_ + igv; const float ml_ = wave_max(wend_);
            cumN = cum_; avN = av_; pmaxN = pm_; clN = cl_; mlN = ml_; eendN = __expf(wend_ - ml_);
        }
        __syncthreads();
        if ((lane & 7) == 0) n0L[8 * w + (lane >> 3)] = nst;
#pragma unroll
        for (int x = 0; x < 2; ++x) {
            const int bv = bc0 + x;
#pragma unroll
            for (int rg = 0; rg < 4; ++rg) { const int t = 16 * bt + 4 * g + rg;
                const float den = denL[t], w_t = __shfl(winter, t), fl_t = __shfl(floorv, t);
                const float hv = (nin[x][rg] + w_t * nit[x][rg]) * __builtin_amdgcn_rcpf(fmaxf(fabsf(den), fl_t));
                const int rr = dir ? 63 - t : t;
                hout[(size_t)ml_grow(b, tb + rr) * D + 16 * bv + l15] = (bf16_t)pk2(hv, 0.f);
                C0L[(16 * bt + 4 * g + rg) * ML_LD + 16 * bv + l15] = (bf16_t)pk2(Cst[x][rg], 0.f); }
        }
        m0 = mnew;
        cum = cumN; av = avN; pmax = pmaxN; cl = clN; ml = mlN; eend = eendN;
    }
#undef ML_GATES
    __syncthreads();
}
__device__ __forceinline__ void phase_ml_scan(Frame& F) {
    for (int task = F.vcu; task < NB * NH_ML * 4; task += F.G) {
        const int vh = task & 1, dir = (task >> 1) & 1, bh = task >> 2;
        ml_task(F, bh >> 3, bh & 7, dir, vh);
    }
}

__device__ __forceinline__ void phase_ml_final(Frame& F, int jm) {
    const int gw = F.vcu * NWAVES + F.wave, NGW = F.G * NWAVES, lane = F.lane;
    const bf16_t* hfw = (const bf16_t*)(wsp(F) + WS_HDIR); const bf16_t* hbw = hfw + (size_t)ROWS * D;
    const bf16_t* proj = (const bf16_t*)(wsp(F) + WS_PROJ);
    bf16_t* ao = (bf16_t*)(wsp(F) + WS_AO);
    const float* gain = inp(F, I_MHGAIN) + jm * D + lane * 16;
    for (int row = gw; row < ROWS; row += NGW) {
        const size_t off = (size_t)row * D + lane * 16;
        float a0[8], a1[8], b0[8], b1[8], g0[8], g1[8];
        unpack8(*(const u32x4*)(hfw + off), a0); unpack8(*(const u32x4*)(hfw + off + 8), a1);
        unpack8(*(const u32x4*)(hbw + off), b0); unpack8(*(const u32x4*)(hbw + off + 8), b1);
        const bf16_t* ogp = proj + (size_t)row * ML_INP + 2048 + lane * 16;
        unpack8(*(const u32x4*)ogp, g0); unpack8(*(const u32x4*)(ogp + 8), g1);
        float ss = 0.f;
#pragma unroll
        for (int e = 0; e < 8; ++e) { a0[e] += b0[e]; a1[e] += b1[e]; ss += a0[e] * a0[e] + a1[e] * a1[e]; }
        ss += __shfl_xor(ss, 1); ss += __shfl_xor(ss, 2); ss += __shfl_xor(ss, 4);
        const float rs = 1.0f / sqrtf(ss * (1.f / DV_ML) + EPS);
        float o0[8], o1[8];
#pragma unroll
        for (int e = 0; e < 8; ++e) { o0[e] = a0[e] * rs * gain[e] * sigmoidf_(g0[e]); o1[e] = a1[e] * rs * gain[8 + e] * sigmoidf_(g1[e]); }
        *(u32x4*)(ao + off) = pack8(o0); *(u32x4*)(ao + off + 8) = pack8(o1);
    }
}

constexpr int RT_LD = 1032;
constexpr int RT_HI = 0, RT_LO = NE * RT_LD * 2, RT_LG = 2 * NE * RT_LD * 2;
__device__ __forceinline__ int rows_per_block(int first_row, int G) { return (ROWS - first_row + G - 1) / G; }
__device__ __forceinline__ void phase_norm2_router(Frame& F, int l, int first_row) {
    const int tid = F.tid, lane = F.lane, wave = F.wave, l15 = lane & 15, g = lane >> 4;
    LAS bf16_t* whi = (LAS bf16_t*)(F.lds + RT_HI); LAS bf16_t* wlo = (LAS bf16_t*)(F.lds + RT_LO);
    LAS float* lgs = (LAS float*)(F.lds + RT_LG) + wave * (16 * 33);
    volatile LAS int* cntL = F.LCTL + 64;
    const float* wg = inp(F, I_WR) + (size_t)l * D * NE;
    for (int idx = tid; idx < D * NE; idx += NTHREADS) { const int k = idx >> 5, e = idx & 31; const float w = wg[idx];
        const unsigned hb16 = f2bf(w); const float hf = __builtin_bit_cast(float, hb16 << 16);
        whi[e * RT_LD + k] = (bf16_t)hb16; wlo[e * RT_LD + k] = (bf16_t)f2bf(w - hf); }
    if (tid < NE) cntL[tid] = 0;
    const float* xs = (const float*)(wsp(F) + WS_XS); bf16_t* hb = (bf16_t*)(wsp(F) + WS_HB);
    int* tope = (int*)(wsp(F) + WS_TOPE); float* topw = (float*)(wsp(F) + WS_TOPW);
    const f32x4* gm = (const f32x4*)(inp(F, I_GFFN) + l * D) + lane;
    const int RPB = rows_per_block(first_row, F.G);
    const int rbeg = first_row + F.vcu * RPB, rend = min(rbeg + RPB, ROWS);
    for (int row = rbeg + wave; row < rend; row += NWAVES) {
        const int mb = row_mb(row);
        const f32x4* xr = (const f32x4*)(xs + (size_t)row * D) + lane;
        f32x4 v[4]; float ss = 0.f;
#pragma unroll
        for (int j = 0; j < 4; ++j) { v[j] = xr[64 * j]; ss += (v[j][0] * v[j][0] + v[j][1] * v[j][1]) + (v[j][2] * v[j][2] + v[j][3] * v[j][3]); }
        const float rs = 1.0f / sqrtf(wave_sum(ss) * (1.f / D) + EPS);
        const f32x4* sh = (const f32x4*)modp(F, l, mb, 3) + lane; const f32x4* sc = (const f32x4*)modp(F, l, mb, 4) + lane;
        u32x2* o8 = (u32x2*)(hb + (size_t)row * D) + lane;
        unsigned* o4 = (unsigned*)(wsp(F) + WS_HB8 + (size_t)row * D) + lane;
#pragma unroll
        for (int j = 0; j < 4; ++j) { const f32x4 h = (v[j] * rs) * gm[64 * j] * (sc[64 * j] + 1.0f) + sh[64 * j];
            u32x2 wv; wv.x = pk2(h[0], h[1]); wv.y = pk2(h[2], h[3]); o8[64 * j] = wv;
            const f32x4 hq = __builtin_elementwise_min(__builtin_elementwise_max(h * 16.0f, (f32x4){-448.f, -448.f, -448.f, -448.f}), (f32x4){448.f, 448.f, 448.f, 448.f});
            o4[64 * j] = pk4_fp8(hq[0], hq[1], hq[2], hq[3]); }
    }
    VM_WAIT();
    __syncthreads();
    const float br0 = inp(F, I_BR)[l * NE + l15], br1 = inp(F, I_BR)[l * NE + 16 + l15];
    for (int g0 = rbeg + 16 * wave; g0 < rend; g0 += 16 * NWAVES) {
        const int arow = min(g0 + l15, rend - 1);
        const bf16_t* ap = hb + (size_t)arow * D + 8 * g;
        f32x4 acc0 = (f32x4){0.f, 0.f, 0.f, 0.f}, acc1 = (f32x4){0.f, 0.f, 0.f, 0.f};
#pragma unroll 8
        for (int ks = 0; ks < 32; ++ks) {
            const bf16x8 af = *(const bf16x8*)(ap + 32 * ks);
            const bf16x8 h0 = *(const LAS bf16x8*)(whi + l15 * RT_LD + 32 * ks + 8 * g), h1 = *(const LAS bf16x8*)(whi + (16 + l15) * RT_LD + 32 * ks + 8 * g);
            const bf16x8 l0 = *(const LAS bf16x8*)(wlo + l15 * RT_LD + 32 * ks + 8 * g), l1 = *(const LAS bf16x8*)(wlo + (16 + l15) * RT_LD + 32 * ks + 8 * g);
            acc0 = __builtin_amdgcn_mfma_f32_16x16x32_bf16(af, h0, acc0, 0, 0, 0); acc1 = __builtin_amdgcn_mfma_f32_16x16x32_bf16(af, h1, acc1, 0, 0, 0);
            acc0 = __builtin_amdgcn_mfma_f32_16x16x32_bf16(af, l0, acc0, 0, 0, 0); acc1 = __builtin_amdgcn_mfma_f32_16x16x32_bf16(af, l1, acc1, 0, 0, 0);
        }
#pragma unroll
        for (int rg = 0; rg < 4; ++rg) { lgs[(4 * g + rg) * 33 + l15] = acc0[rg] + br0; lgs[(4 * g + rg) * 33 + 16 + l15] = acc1[rg] + br1; }
        LDS_WAIT(); asm volatile("" ::: "memory");
        const int row = g0 + lane;
        if (lane < 16 && row < rend) {
            float lg[32];
#pragma unroll
            for (int e = 0; e < 32; ++e) lg[e] = lgs[lane * 33 + e];
            int sel[4]; float sv[4]; unsigned used = 0u;
#pragma unroll
            for (int k = 0; k < 4; ++k) { float best = -3.0e38f; int bi = 0;
#pragma unroll
                for (int e = 0; e < 32; ++e) { const bool take = !((used >> e) & 1u) && (lg[e] > best); best = take ? lg[e] : best; bi = take ? e : bi; }
                used |= 1u << bi; sel[k] = bi; sv[k] = best; }
            const float e1 = __expf(sv[1] - sv[0]), e2 = __expf(sv[2] - sv[0]), e3 = __expf(sv[3] - sv[0]);
            const float inv = 1.0f / (1.0f + e1 + e2 + e3);
            *(int4*)(tope + (size_t)row * 4) = make_int4(sel[0], sel[1], sel[2], sel[3]);
            *(float4*)(topw + (size_t)row * 4) = make_float4(inv, e1 * inv, e2 * inv, e3 * inv);
#pragma unroll
            for (int k = 0; k < 4; ++k) __hip_atomic_fetch_add((LAS int*)&cntL[sel[k]], 1, __ATOMIC_RELAXED, __HIP_MEMORY_SCOPE_WORKGROUP);
        }
        LDS_WAIT(); asm volatile("" ::: "memory");
    }
    __syncthreads();
    if (tid < NE) ((int*)(wsp(F) + WS_CNT))[F.vcu * NE + tid] = cntL[tid];
}

__device__ __forceinline__ void phase_positions(Frame& F, int first_row) {
    const int tid = F.tid, lane = F.lane;
    LAS int* tot = (LAS int*)F.lds;
    LAS int* bef = tot + 512;
    LAS int* baseL = bef + 512;
    LAS int* totL = baseL + 32;
    const int* cnt = (const int*)(wsp(F) + WS_CNT);
    {
        const int e = tid & 31, part = tid >> 5;
        int s = 0, sb = 0;
        for (int j = part; j < F.G; j += 16) { const int cv = cnt[j * NE + e]; s += cv; sb += (j < F.vcu) ? cv : 0; }
        tot[part * 32 + e] = s; bef[part * 32 + e] = sb;
    }
    __syncthreads();
    if (tid < NE) { int s = 0, sb = 0;
        for (int p = 0; p < 16; ++p) { s += tot[p * 32 + tid]; sb += bef[p * 32 + tid]; }
        totL[tid] = s; baseL[tid] = sb; }
    __syncthreads();
    if (tid == 0) { int acc = 0;
        for (int e = 0; e < NE; ++e) { F.LCTL[8 + e] = acc; acc += (totL[e] + 255) >> 8; }
        F.LCTL[8 + NE] = acc; F.LCTL[48] = acc; }
    __syncthreads();
    int* tokmap = (int*)(wsp(F) + WS_TOKMAP);
    if (F.vcu == 0) {
        int* meta = (int*)(wsp(F) + WS_META);
        if (tid <= NE) meta[tid] = F.LCTL[8 + tid];
        if (tid == 0) meta[33] = F.LCTL[48];
        for (int e = 0; e < NE; ++e) { const int rb = 256 * F.LCTL[8 + e], n = totL[e], cap = 256 * (F.LCTL[8 + e + 1] - F.LCTL[8 + e]);
            for (int rr = n + tid; rr < cap; rr += NTHREADS) tokmap[rb + rr] = first_row; }
    }
    if (F.wave == 0) {
        const int* tope = (const int*)(wsp(F) + WS_TOPE); int* pos = (int*)(wsp(F) + WS_POS);
        int basereg = (lane < NE) ? 256 * F.LCTL[8 + lane] + baseL[lane] : 0;
        const int RPB = rows_per_block(first_row, F.G);
        const int rbeg = first_row + F.vcu * RPB, rend = min(rbeg + RPB, ROWS);
        for (int r0 = rbeg; r0 < rend; r0 += 16) {
            const int row = r0 + (lane >> 2), k = lane & 3;
            const bool valid = row < rend;
            const int e = valid ? tope[(size_t)row * 4 + k] : -1;
            int p = 0;
#pragma unroll 1
            for (int ee = 0; ee < NE; ++ee) {
                const unsigned long long mask = __ballot(e == ee);
                const int b0 = __shfl(basereg, ee);
                if (e == ee) p = b0 + __popcll(mask & ((1ull << lane) - 1ull));
                if (lane == ee) basereg += __popcll(mask);
            }
            if (valid) { pos[(size_t)row * 4 + k] = p; tokmap[p] = row; }
        }
    }
}

#ifndef PMASK
#define PMASK 0xFFFF
#endif
#define PE(k) (((PMASK) >> (k)) & 1)
#ifndef RMASK
#define RMASK 0
#endif
#define RP(k) for (int rep_ = 0; rep_ < ((((RMASK) >> (k)) & 1) ? 2 : 1); ++rep_, __syncthreads())
constexpr int NPH_LAYER = 10, GP_FINAL = 1 + DEPTH * NPH_LAYER, NPHASES = GP_FINAL + 1;
__global__ void __launch_bounds__(NTHREADS, 2) mega_fwd(Args args) {
    extern __shared__ __attribute__((aligned(16))) unsigned char lds_raw[];
    Frame F0;
    Frame& F = F0;
    F.lds = (LAS unsigned char*)lds_raw;
    F.LCTL = (volatile LAS int*)(F.lds + LDS_CTL_OFF);
    F.tid = threadIdx.x; F.lane = F.tid & 63; F.wave = __builtin_amdgcn_readfirstlane(F.tid >> 6);
    F.G = gridDim.x; { const int bx = blockIdx.x; F.vcu = (F.G % 8 == 0) ? (bx % 8) * (F.G / 8) + bx / 8 : bx; }
    if (F.tid < 128) F.LCTL[F.tid] = 0;
    if (F.tid == 0) {
#pragma unroll
        for (int i = 0; i < 23; ++i) { const unsigned long long p = (unsigned long long)args.in[i]; F.LCTL[128 + 2 * i] = (int)(unsigned)p; F.LCTL[129 + 2 * i] = (int)(unsigned)(p >> 32); }
        { const unsigned long long p = (unsigned long long)args.ws; F.LCTL[128 + 46] = (int)(unsigned)p; F.LCTL[129 + 46] = (int)(unsigned)(p >> 32); }
        { const unsigned long long p = (unsigned long long)args.out; F.LCTL[128 + 48] = (int)(unsigned)p; F.LCTL[129 + 48] = (int)(unsigned)(p >> 32); }
    }
    __syncthreads();
    const int lo = args.ph_lo, hi = args.ph_hi;
    XcdBarrier bar; bar.bar = (unsigned*)(wsp(F) + WS_CTL) + CW_BAR; bar.x = 0; bar.st = nullptr;
    if (hi - lo > 1) bar = xcd_barrier_post((unsigned*)(wsp(F) + WS_CTL) + CW_BAR, (volatile LAS unsigned*)F.LCTL);
#define IN(k) (lo <= (k) && (k) < hi)
#define FRESH(FN) Frame FN = F0; { int tz_ = F0.tid, vc_ = F0.vcu, g_ = F0.G; asm volatile("" : "+v"(tz_)); asm volatile("" : "+s"(vc_), "+s"(g_)); FN.tid = tz_; FN.lane = tz_ & 63; FN.wave = __builtin_amdgcn_readfirstlane(tz_ >> 6); FN.vcu = vc_; FN.G = g_; }
#define SEAM(k) do { if (IN(k) && IN((k) + 1)) xcd_barrier(bar); } while (0)

    if (PE(0) && IN(0)) RP(0) { FRESH(P); phase0(P); }
    SEAM(0);
    for (int l = 0; l < DEPTH; ++l) {
        const int base = 1 + l * NPH_LAYER; const bool na = (l & 1) == 0, last = (l == DEPTH - 1); const int jj = l >> 1;
        if (PE(1) && IN(base + 0)) { FRESH(P); phase_norm1(P, l); }
        SEAM(base + 0);
        if (PE(2) && IN(base + 1)) RP(2) {
            FRESH(P);
            const int Np = na ? 3072 : ML_INP;
            const bf16_t* Bt = na ? (const bf16_t*)(wsp(P) + WS_WQKV) + (size_t)jj * 3072 * D : (const bf16_t*)(wsp(P) + WS_WIN) + (size_t)jj * ML_INP * D;
            DenseOrder S; S.init(0, ROWS / 256, Np / 256, P.G, (int)blockIdx.x, wsp(P) + WS_HB, Bt, D);
            EpiStoreBf16 E{(bf16_t*)(wsp(P) + WS_PROJ), Np};
            pg8::gemm_phase<EpiStoreBf16, DenseOrder, false>(P.lds, P.tid, D, S, E);
        }
        SEAM(base + 1);
        if (IN(base + 2)) { if (na) { if (PE(3)) RP(3) { FRESH(P); phase_na_post(P, jj); } } else { if (PE(4)) { FRESH(P); phase_ml_post(P, jj); } } }
        SEAM(base + 2);
        if (IN(base + 3)) { if (na) { if (PE(5)) RP(5) { FRESH(P); phase_na_attn(P, jj); } } else { if (PE(6)) RP(6) { FRESH(P); phase_ml_scan(P); } } }
        SEAM(base + 3);
        if (PE(7) && IN(base + 4)) { if (!na) RP(7) { FRESH(P); phase_ml_final(P, jj); } }
        if (!na) SEAM(base + 4);
        if (PE(8) && IN(base + 5)) {
            FRESH(P);
            const bf16_t* Bt = na ? (const bf16_t*)(wsp(P) + WS_WONA) + (size_t)jj * D * D : (const bf16_t*)(wsp(P) + WS_WOML) + (size_t)jj * D * D;
            DenseOrder S; S.init(last ? ROWS_CTX / 256 : 0, last ? (ROWS - ROWS_CTX) / 256 : ROWS / 256, D / 256, P.G, (int)blockIdx.x, wsp(P) + WS_AO, Bt, D);
            EpiResid E{(float*)(wsp(P) + WS_XS), (const float*)(wsp(P) + WS_MOD) + (size_t)l * 9 * 6144 + 2 * D};
            pg8::gemm_phase<EpiResid, DenseOrder, false>(P.lds, P.tid, D, S, E);
        }
        SEAM(base + 5);
        if (PE(9) && IN(base + 6)) RP(9) { FRESH(P); phase_norm2_router(P, l, last ? ROWS_CTX : 0); }
        SEAM(base + 6);
        if (PE(10) && IN(base + 7)) RP(10) { FRESH(P); phase_positions(P, last ? ROWS_CTX : 0); }
        SEAM(base + 7);
        if (PE(11) && IN(base + 8)) RP(11) {
            FRESH(P);
            if (P.tid < 34) P.LCTL[8 + P.tid] = ((const int*)(wsp(P) + WS_META))[P.tid];
            __syncthreads();
            const int ntiles = P.LCTL[8 + NE];
            MoeOrder S; S.NT = 8; S.nunits = ntiles * 8; S.G = P.G; S.c = (int)blockIdx.x; S.K = D / 2; S.A = (const char*)(wsp(P) + WS_HB8);
            S.W = (const char*)(wsp(P) + WS_W1T) + (size_t)l * NE * 2048 * D; S.estride = (size_t)2048 * D; S.tokmap = (const int*)(wsp(P) + WS_TOKMAP); S.prefix = P.LCTL + 8; S.gather = true;
            EpiSwiglu E{(unsigned char*)(wsp(P) + WS_ACT), inp(P, I_B1) + (size_t)l * NE * 2048};
            pg8::gemm_phase<EpiSwiglu, MoeOrder, true, true>(P.lds, P.tid, D / 2, S, E);
        }
        SEAM(base + 8);
        if (PE(12) && IN(base + 9)) RP(12) {
            FRESH(P);
            if (P.tid < 34) P.LCTL[8 + P.tid] = ((const int*)(wsp(P) + WS_META))[P.tid];
            __syncthreads();
            const int ntiles = P.LCTL[8 + NE];
            MoeOrder S; S.NT = 4; S.nunits = ntiles * 4; S.G = P.G; S.c = (int)blockIdx.x; S.K = D / 2; S.A = (const char*)(wsp(P) + WS_ACT);
            S.W = (const char*)(wsp(P) + WS_W2T) + (size_t)l * NE * D * D; S.estride = (size_t)D * D; S.tokmap = (const int*)(wsp(P) + WS_TOKMAP); S.prefix = P.LCTL + 8; S.gather = false;
            EpiY E{(bf16_t*)(wsp(P) + WS_Y), inp(P, I_B2) + (size_t)l * NE * D};
            pg8::gemm_phase<EpiY, MoeOrder, true, true>(P.lds, P.tid, D / 2, S, E);
        }
        SEAM(base + 9);
    }
    if (PE(13) && IN(GP_FINAL)) RP(13) { FRESH(P); phase_final(P); }
#undef IN
#undef SEAM
}

extern "C" void kernel_launch(void* const* d_in, const int* in_sizes, int n_in, void* d_out, int out_size, void* d_ws, size_t ws_size, hipStream_t stream) {
    static int grid = 0;
    if (grid == 0) {
        if (n_in != 23 || ws_size < WS_END) { fprintf(stderr, "kernel_launch: expected 23 inputs and >= %zu bytes of workspace (got %d, %zu)\n", (size_t)WS_END, n_in, ws_size); grid = -1; return; }
        int dev = 0, cus = 0, per_cu = 0;
        if (hipGetDevice(&dev) != hipSuccess || hipDeviceGetAttribute(&cus, hipDeviceAttributeMultiprocessorCount, dev) != hipSuccess) { grid = -1; return; }
        if (hipFuncSetAttribute((const void*)mega_fwd, hipFuncAttributeMaxDynamicSharedMemorySize, LDS_BYTES) != hipSuccess) { fprintf(stderr, "kernel_launch: hipFuncSetAttribute failed\n"); grid = -1; return; }
        if (hipOccupancyMaxActiveBlocksPerMultiprocessor(&per_cu, (const void*)mega_fwd, NTHREADS, LDS_BYTES) != hipSuccess || per_cu < 1)
            fprintf(stderr, "kernel_launch: occupancy query reports %d workgroups per CU\n", per_cu);
        (void)hipGetLastError();
        grid = cus;
        if (grid > 1024) grid = 1024;
    }
    if (grid < 0) return;
    (void)hipMemsetAsync((char*)d_ws + WS_CTL, 0, CTL_BYTES, stream);
    Args a{};
    for (int i = 0; i < 23; ++i) a.in[i] = (const float*)d_in[i];
    a.out = (float*)d_out; a.ws = (unsigned char*)d_ws;
#if MK_ONE_LAUNCH
    a.ph_lo = 0; a.ph_hi = NPHASES;
    hipLaunchKernelGGL(mega_fwd, dim3(grid), dim3(NTHREADS), LDS_BYTES, stream, a);
#else
    for (int gp = 0; gp < NPHASES; ++gp) {
        if (gp >= 1 && gp < GP_FINAL) { const int l = (gp - 1) / NPH_LAYER, p = (gp - 1) % NPH_LAYER; if (p == 4 && (l & 1) == 0) continue; }
        a.ph_lo = gp; a.ph_hi = gp + 1;
        hipLaunchKernelGGL(mega_fwd, dim3(grid), dim3(NTHREADS), LDS_BYTES, stream, a);
    }
#endif
    const hipError_t le = hipPeekAtLastError();
    if (le != hipSuccess) fprintf(stderr, "kernel_launch: launch failed: %s\n", hipGetErrorName(le));
}
```

```cpp
#include <hip/hip_runtime.h>
#include <cstdio>
#include <cstdint>

#ifndef MK_ONE_LAUNCH
#define MK_ONE_LAUNCH 1
#endif

#define LAS __attribute__((address_space(3)))
#define GAS __attribute__((address_space(1)))
typedef unsigned short bf16_t;
typedef short bf16x8 __attribute__((ext_vector_type(8)));
typedef short bf16x4 __attribute__((ext_vector_type(4)));
typedef float f32x4 __attribute__((ext_vector_type(4)));
typedef float f32x2 __attribute__((ext_vector_type(2)));
typedef unsigned u32x4 __attribute__((ext_vector_type(4)));
typedef unsigned u32x2 __attribute__((ext_vector_type(2)));

constexpr int D = 1024, NB = 8, SEQ = 4096, NCTX = 256, TT = NCTX + SEQ  , DEPTH = 4;
constexpr int ROWS_CTX = NB * NCTX  , ROWS = ROWS_CTX + NB * SEQ  ;
constexpr int NH_NA = 16, DH_NA = 64;
constexpr int NH_ML = 8, DV_ML = 128, DK_ML = 64, ML_IN = 3104, ML_INP = 3328;
constexpr int NE = 32, TOPK = 4, DFF = 1024;
constexpr int MAXTILES = (ROWS * TOPK) / 256 + NE  , MAXROWS = MAXTILES * 256;
constexpr float EPS = 1e-6f;
constexpr int NWAVES = 8, NTHREADS = 512;

constexpr size_t MiB = 1u << 20;
constexpr size_t al256(size_t x) { return (x + 255) & ~(size_t)255; }
constexpr size_t WS_CTL = 0, CTL_BYTES = 1 * MiB;
constexpr size_t WS_MOD = WS_CTL + CTL_BYTES;
constexpr size_t WS_ROPE = WS_MOD + al256((size_t)DEPTH * 9 * 6 * D * 4);
constexpr size_t WS_WQKV = WS_ROPE + al256(64 * 16 * 2 * 4);
constexpr size_t WS_WONA = WS_WQKV + (size_t)2 * 3072 * D * 2;
constexpr size_t WS_WIN = WS_WONA + (size_t)2 * D * D * 2;
constexpr size_t WS_WOML = WS_WIN + (size_t)2 * ML_INP * D * 2;
constexpr size_t WS_W1T = WS_WOML + (size_t)2 * D * D * 2;
constexpr size_t WS_W2T = WS_W1T + (size_t)DEPTH * NE * 2048 * D * 2;
constexpr size_t WS_XS = WS_W2T + (size_t)DEPTH * NE * D * D * 2;
constexpr size_t WS_HB = WS_XS + (size_t)ROWS * D * 4;
constexpr size_t WS_PROJ = WS_HB + (size_t)ROWS * D * 2;
constexpr size_t WS_QN = WS_PROJ + (size_t)ROWS * ML_INP * 2;
constexpr size_t WS_KN = WS_QN + (size_t)ROWS * D * 2;
constexpr size_t WS_VT = WS_KN + (size_t)ROWS * D * 2;
constexpr size_t WS_AO = WS_VT + (size_t)ROWS * D * 2;
constexpr size_t WS_HDIR = WS_QN;
constexpr size_t WS_GATES = WS_AO + (size_t)ROWS * D * 2;
constexpr size_t WS_TOPE = WS_GATES + al256((size_t)4 * NB * NH_ML * TT * 4);
constexpr size_t WS_TOPW = WS_TOPE + (size_t)ROWS * 4 * 4;
constexpr size_t WS_POS = WS_TOPW + (size_t)ROWS * 4 * 4;
constexpr size_t WS_TOKMAP = WS_POS + (size_t)ROWS * 4 * 4;
constexpr size_t WS_CNT = WS_TOKMAP + (size_t)MAXROWS * 4;
constexpr size_t WS_META = WS_CNT + (size_t)1024 * 32 * 4;
constexpr size_t WS_ACT = WS_META + 256;
constexpr size_t WS_Y = WS_ACT + (size_t)MAXROWS * D * 2;
constexpr size_t WS_HB8 = WS_Y + (size_t)MAXROWS * D * 2;
constexpr size_t WS_GS = WS_HB8 + (size_t)ROWS * D;
constexpr size_t WS_RT = WS_GS + (size_t)2 * NB * NH_ML * (TT / 64) * 5 * 64 * 4;
constexpr size_t WS_END = WS_RT + (size_t)DEPTH * 2 * NE * D * 2;
static_assert(WS_XS % 256 == 0 && WS_ACT % 256 == 0 && WS_TOPE % 256 == 0, "ws alignment");

constexpr int CW_BAR = 4096;
constexpr int CW_GSYNC = 8192;

constexpr int LDS_BYTES = 160 * 1024;
constexpr int LDS_CTL_OFF = LDS_BYTES - 1024;
constexpr int LDS_WORK = LDS_CTL_OFF;

__device__ __forceinline__ int lane_id_here() { int l; asm volatile("v_mbcnt_lo_u32_b32 %0, -1, 0\n\tv_mbcnt_hi_u32_b32 %0, -1, %0" : "=v"(l)); return l; }
#define LDS_WAIT() asm volatile("s_waitcnt lgkmcnt(0)" ::: "memory")
#define VM_WAIT() asm volatile("s_waitcnt vmcnt(0)" ::: "memory")
__device__ __forceinline__ unsigned f2bf(float f) { unsigned u = __builtin_bit_cast(unsigned, f); return (u + 0x7fffu + ((u >> 16) & 1u)) >> 16; }
__device__ __forceinline__ unsigned pk2(float lo, float hi) { unsigned r; asm volatile("v_cvt_pk_bf16_f32 %0, %1, %2" : "=v"(r) : "v"(lo), "v"(hi)); return r; }
__device__ __forceinline__ unsigned pk4_fp8(float a, float b, float c, float d) { int p = __builtin_amdgcn_cvt_pk_fp8_f32(a, b, 0, false); p = __builtin_amdgcn_cvt_pk_fp8_f32(c, d, p, true); return (unsigned)p; }
__device__ __forceinline__ float bf2f(unsigned short b) { return __builtin_bit_cast(float, ((unsigned)b) << 16); }
__device__ __forceinline__ float bflo(unsigned w) { return __builtin_bit_cast(float, w << 16); }
__device__ __forceinline__ float bfhi(unsigned w) { return __builtin_bit_cast(float, w & 0xffff0000u); }
template <int CTRL> __device__ __forceinline__ float dpp_f(float v) { return __builtin_bit_cast(float, __builtin_amdgcn_update_dpp(0, __builtin_bit_cast(int, v), CTRL, 0xF, 0xF, false)); }
__device__ __forceinline__ float sum8(float v) { v += dpp_f<0xB1>(v); v += dpp_f<0x4E>(v); v += dpp_f<0x141>(v); return v; }
__device__ __forceinline__ float max8(float v) { v = fmaxf(v, dpp_f<0xB1>(v)); v = fmaxf(v, dpp_f<0x4E>(v)); v = fmaxf(v, dpp_f<0x141>(v)); return v; }
__device__ __forceinline__ float rdl(float v, int l) { return __builtin_bit_cast(float, __builtin_amdgcn_readlane(__builtin_bit_cast(int, v), l)); }
__device__ __forceinline__ f32x4 bf4_to_f32(const u32x2 w) { return (f32x4){bflo(w.x), bfhi(w.x), bflo(w.y), bfhi(w.y)}; }
__device__ __forceinline__ float wave_sum(float v) {
    v = sum8(v); v += dpp_f<0x140>(v);
    return (rdl(v, 0) + rdl(v, 16)) + (rdl(v, 32) + rdl(v, 48));
}
__device__ __forceinline__ float wave_max(float v) {
    v = max8(v); v = fmaxf(v, dpp_f<0x140>(v));
    return fmaxf(fmaxf(rdl(v, 0), rdl(v, 16)), fmaxf(rdl(v, 32), rdl(v, 48)));
}
__device__ __forceinline__ int shfl_(int v, int src) { return __builtin_amdgcn_ds_bpermute(src << 2, v); }
__device__ __forceinline__ float shfl_(float v, int src) { return __builtin_bit_cast(float, __builtin_amdgcn_ds_bpermute(src << 2, __builtin_bit_cast(int, v))); }
__device__ __forceinline__ float sigmoidf_(float x) { return __builtin_amdgcn_rcpf(1.f + __builtin_amdgcn_exp2f(-1.44269504f * x)); }

namespace pg8 {
constexpr int BM = 256, BK = 64, HALF = 128, HTB = HALF * BK * 2  , STAGE_BYTES = 8 * HTB;
__host__ __device__ __forceinline__ int lds_byte(int r, int c) { const int st = (r >> 4) * 2 + (c >> 5), rr = r & 15, cc = c & 31, ob = rr * 64 + cc * 2; return st * 1024 + (ob ^ (((ob >> 9) & 1) << 5)); }
__host__ __device__ __forceinline__ void stage_rc(int b, int& R, int& C) { const int st = b / 1024, sb = b % 1024, swz = sb ^ (((sb >> 9) & 1) << 5); R = (st >> 1) * 16 + swz / 64; C = (st & 1) * 32 + (swz % 64) / 2; }
__host__ __device__ __forceinline__ int perm32(int rho) { const int n = rho >> 4, i = rho & 15; return 8 * (i >> 2) + 4 * n + (i & 3); }

struct Unit { int pm, pn, e, slot; };

typedef int v8i32 __attribute__((ext_vector_type(8)));
__device__ __forceinline__ v8i32 cat8(const bf16x8 a, const bf16x8 b) { union { bf16x8 h[2]; v8i32 v; } u; u.h[0] = a; u.h[1] = b; return u.v; }
__device__ __forceinline__ unsigned cvt_pk_bf16(float lo, float hi) { unsigned r; asm volatile("v_cvt_pk_bf16_f32 %0, %1, %2" : "=v"(r) : "v"(lo), "v"(hi)); return r; }

#ifndef PG8_ALIGN
#define PG8_ALIGN true
#endif
#ifndef FP8_PRIO
#define FP8_PRIO true
#endif
template <class Epi, class Sched, bool GATHER, bool FP8 = false, bool ALIGN_EPI = PG8_ALIGN, int KPROBE_ = 0>
__device__ __forceinline__ void gemm_phase(LAS unsigned char* lds, const int tid, const int K, const Sched& S, const Epi& E, const bool skip_epi = false) {
    const int wid = __builtin_amdgcn_readfirstlane(tid >> 6), lane = tid & 63, wr = wid >> 2, wc = wid & 3, fr = lane & 15, fq = lane >> 4;
    const int nt = K / BK;
    unsigned voffB[2], voffA[2][2];
#pragma unroll
    for (int i = 0; i < 2; ++i) { int R, C; stage_rc(tid * 16 + i * 8192, R, C); const int Rb = Epi::PERM ? ((R & ~31) + perm32(R & 31)) : R;
        voffB[i] = (unsigned)(Rb * K + C) * 2u; }
    const size_t kstep = (size_t)(BK * 2);
    const size_t hstep = (size_t)HALF * K * 2;
    const unsigned ldsw = (unsigned)wid * 1024u;
    const int aoff = lds_byte(wr * 64 + fr, fq * 8), boff = lds_byte(wc * 32 + fr, fq * 8);
#define PG8_SA(b, h) (((b) * 2 + (h)) * HTB)
#define PG8_SB(b, h) ((4 + (b) * 2 + (h)) * HTB)
#define PG8_STAGE(bufoff, gbase, voff) do { _Pragma("unroll") for (int _i = 0; _i < 2; ++_i) \
        __builtin_amdgcn_global_load_lds((const unsigned*)((const char*)(gbase) + (voff)[_i]), (LAS unsigned*)(lds + (bufoff) + ldsw + _i * 8192), 16, 0, 0); } while (0)
#define PG8_LDA(dst, b, h) do { if constexpr (KPROBE_ == 2) break; _Pragma("unroll") for (int m = 0; m < 4; ++m) _Pragma("unroll") for (int k = 0; k < 2; ++k) dst[m][k] = *(const LAS bf16x8*)(lds + PG8_SA(b, h) + aoff + m * 2048 + k * 1024); } while (0)
#define PG8_LDB(dst, b, h) do { if constexpr (KPROBE_ == 2) break; _Pragma("unroll") for (int n = 0; n < 2; ++n) _Pragma("unroll") for (int k = 0; k < 2; ++k) dst[n][k] = *(const LAS bf16x8*)(lds + PG8_SB(b, h) + boff + n * 2048 + k * 1024); } while (0)
#define PG8_MMA(ai, bj, At, Bt) do { if constexpr (!FP8 || FP8_PRIO) __builtin_amdgcn_s_setprio(1); else __builtin_amdgcn_s_setprio(0); _Pragma("unroll") for (int m = 0; m < 4; ++m) _Pragma("unroll") for (int n = 0; n < 2; ++n) { \
        if constexpr (KPROBE_ == 1) { asm volatile("" :: "v"(At[m][0]), "v"(At[m][1]), "v"(Bt[n][0]), "v"(Bt[n][1])); } else if constexpr (KPROBE_ == 2) { } else \
        if constexpr (FP8) { acc[ai][bj][m][n] = __builtin_amdgcn_mfma_scale_f32_16x16x128_f8f6f4(cat8(Bt[n][0], Bt[n][1]), cat8(At[m][0], At[m][1]), acc[ai][bj][m][n], 0, 0, 0, 0x7f7f7f7f, 0, 0x7f7f7f7f); } \
        else { _Pragma("unroll") for (int k = 0; k < 2; ++k) acc[ai][bj][m][n] = __builtin_amdgcn_mfma_f32_16x16x32_bf16(Bt[n][k], At[m][k], acc[ai][bj][m][n], 0, 0, 0); } } \
        __builtin_amdgcn_s_setprio(0); } while (0)
#define PG8_WAIT_V(n) asm volatile("s_waitcnt vmcnt(" #n ")" ::: "memory")
#define PG8_WAIT_VP do { if constexpr (Epi::PREFETCH) { if (pf) PG8_WAIT_V(10); else PG8_WAIT_V(8); } else PG8_WAIT_V(8); } while (0)
#define PG8_WAIT_L(n) asm volatile("s_waitcnt lgkmcnt(" #n ")" ::: "memory")
#define PG8_BAR __builtin_amdgcn_s_barrier()
#define PG8_SCHED __builtin_amdgcn_sched_barrier(0)
#define PG8_SETVOFF(u) do { _Pragma("unroll") for (int _i = 0; _i < 2; ++_i) { int RA_, CA_; stage_rc(tid * 16 + _i * 8192, RA_, CA_);     \
        _Pragma("unroll") for (int _h = 0; _h < 2; ++_h) { \
        if constexpr (GATHER) voffA[_h][_i] = ((unsigned)S.a_row(u, _h * HALF + RA_) * (unsigned)K + (unsigned)CA_) * 2u; \
        else voffA[_h][_i] = ((unsigned)(_h * HALF + RA_) * (unsigned)K + (unsigned)CA_) * 2u; } } } while (0)
    Unit cur, nxt; int ui = 0;
    if (!S.next(0, cur)) return;
    f32x4 acc[2][2][4][2];
#pragma unroll
    for (int a = 0; a < 2; ++a)
#pragma unroll
        for (int b = 0; b < 2; ++b)
#pragma unroll
            for (int m = 0; m < 4; ++m)
#pragma unroll
                for (int n = 0; n < 2; ++n) acc[a][b][m][n] = (f32x4){0.f, 0.f, 0.f, 0.f};
    bf16x8 At[4][2], B0[2][2], B1[2][2];
    const char* cA = S.a_base(cur); const char* cB = S.b_base(cur);
    PG8_SETVOFF(cur);
    PG8_STAGE(PG8_SB(0, 0), cB, voffB); PG8_STAGE(PG8_SB(0, 1), cB + hstep, voffB); PG8_STAGE(PG8_SA(0, 0), cA, voffA[0]); PG8_STAGE(PG8_SA(0, 1), cA, voffA[1]);
    if (wr == 1) PG8_BAR;
    PG8_WAIT_V(2); PG8_BAR;
    PG8_STAGE(PG8_SB(1, 0), cB + kstep, voffB); PG8_STAGE(PG8_SA(1, 0), cA + kstep, voffA[0]); PG8_STAGE(PG8_SB(1, 1), cB + hstep + kstep, voffB);
    PG8_WAIT_V(6); PG8_BAR;
    for (;;) {
        const bool has_next = S.next(ui + 1, nxt);
        const char* nA = has_next ? S.a_base(nxt) : cA; const char* nB = has_next ? S.b_base(nxt) : cB;
#pragma unroll 1
        for (int t = 0; t < nt; t += 2) {
            const bool last = (t == nt - 2);
            const char* a1 = cA + (size_t)(t + 1) * kstep;
            const char* a2 = last ? nA : cA + (size_t)(t + 2) * kstep; const char* b2 = last ? nB : cB + (size_t)(t + 2) * kstep;
            const char* a3 = a2 + kstep; const char* b3 = b2 + kstep;
            bool pf = false;
            if constexpr (Epi::PREFETCH) { pf = (t == ((nt / 2) & ~1)); if (pf) E.prefetch(cur, wid * 64 + lane_id_here(), lds); }
            PG8_LDB(B0, 0, 0); PG8_LDB(B1, 0, 1); PG8_SCHED; PG8_LDA(At, 0, 0); PG8_STAGE(PG8_SA(1, 1), a1, voffA[1]);
            if constexpr (GATHER) { if (last && has_next) PG8_SETVOFF(nxt); }
            PG8_WAIT_VP; PG8_WAIT_L(0); PG8_BAR; PG8_MMA(0, 0, At, B0); PG8_MMA(0, 1, At, B1); PG8_BAR; PG8_SCHED;
            PG8_LDA(At, 0, 1); PG8_STAGE(PG8_SB(0, 0), b2, voffB); PG8_STAGE(PG8_SB(0, 1), b2 + hstep, voffB); PG8_STAGE(PG8_SA(0, 0), a2, voffA[0]);
            PG8_WAIT_VP; PG8_WAIT_L(0); PG8_BAR; PG8_MMA(1, 0, At, B0); PG8_MMA(1, 1, At, B1); PG8_BAR; PG8_SCHED;
            PG8_LDB(B0, 1, 0); PG8_LDB(B1, 1, 1); PG8_SCHED; PG8_LDA(At, 1, 0); PG8_STAGE(PG8_SA(0, 1), a2, voffA[1]);
            PG8_WAIT_VP; PG8_WAIT_L(0); PG8_BAR; PG8_MMA(0, 0, At, B0); PG8_MMA(0, 1, At, B1); PG8_BAR; PG8_SCHED;
            PG8_LDA(At, 1, 1); PG8_STAGE(PG8_SB(1, 0), b3, voffB); PG8_STAGE(PG8_SB(1, 1), b3 + hstep, voffB); PG8_STAGE(PG8_SA(1, 0), a3, voffA[0]);
            PG8_WAIT_V(8); PG8_WAIT_L(0); PG8_BAR; PG8_MMA(1, 0, At, B0); PG8_MMA(1, 1, At, B1); PG8_BAR; PG8_SCHED;
        }
        if constexpr (ALIGN_EPI) { if (wr == 0) PG8_BAR; }
        if (!skip_epi) E(acc, cur, wr, wc, fr, fq);
        if (!has_next) break;
#pragma unroll
        for (int a = 0; a < 2; ++a)
#pragma unroll
            for (int b = 0; b < 2; ++b)
#pragma unroll
                for (int m = 0; m < 4; ++m)
#pragma unroll
                    for (int n = 0; n < 2; ++n) acc[a][b][m][n] = (f32x4){0.f, 0.f, 0.f, 0.f};
        cur = nxt; cA = nA; cB = nB; ++ui;
        if constexpr (ALIGN_EPI) { if (wr == 1) PG8_BAR; }
    }
    PG8_WAIT_V(0);
    if constexpr (!ALIGN_EPI) { if (wr == 0) PG8_BAR; }
    PG8_BAR;
#undef PG8_SA
#undef PG8_SB
#undef PG8_STAGE
#undef PG8_LDA
#undef PG8_LDB
#undef PG8_MMA
#undef PG8_WAIT_V
#undef PG8_WAIT_VP
#undef PG8_WAIT_L
#undef PG8_BAR
#undef PG8_SCHED
#undef PG8_SETVOFF
}
}

#define XB_TMO      128
#define XB_XCNT(j)  (256  + 64 * (j))
#define XB_XSUB(j)  (1280 + 64 * (j))
#define XB_XGEN(j)  (2304 + 64 * (j))
#define XB_TOP      3328
#define XB_TOPGEN   3392
#define XCD_BAR_WORDS 3456
#define XB_SPIN_CAP (1u << 18)

__device__ __forceinline__ unsigned xb_ld(unsigned* p)              { return __hip_atomic_load(p, __ATOMIC_RELAXED, __HIP_MEMORY_SCOPE_AGENT); }
__device__ __forceinline__ unsigned xb_add(unsigned* p, unsigned v) { return __hip_atomic_fetch_add(p, v, __ATOMIC_RELAXED, __HIP_MEMORY_SCOPE_AGENT); }
__device__ __forceinline__ unsigned xb_xcc_id() { return (unsigned)__builtin_amdgcn_s_getreg((3 << 11) | 20) & 0xFu; }
#define XB_SPIN(cond, bar) do { unsigned _sp = 0; while (cond) { __builtin_amdgcn_s_sleep(1); \
    if ((++_sp & 255u) == 0u) { if (xb_ld(&(bar)[XB_TMO])) break; if (_sp > XB_SPIN_CAP) { atomicAdd(&(bar)[XB_TMO], 1u); break; } } } } while (0)

struct XcdBarrier {
    unsigned* bar; unsigned x;
    unsigned w0;
    volatile LAS unsigned* st;
};

__device__ __forceinline__ XcdBarrier xcd_barrier_post(unsigned* bar, volatile LAS unsigned* st) {
    XcdBarrier b; b.bar = bar; b.x = xb_xcc_id(); b.st = st; b.w0 = ((unsigned)__builtin_amdgcn_readfirstlane((int)threadIdx.x) < 64u) ? 1u : 0u;
    if (threadIdx.x == 0) (void)xb_add(&bar[XB_XCNT(b.x)], 1u);
    return b;
}
__device__ __forceinline__ void xcd_barrier_complete(unsigned* bar, unsigned x, unsigned& nloc, unsigned& nx) {
    const unsigned G = gridDim.x * gridDim.y * gridDim.z;
    unsigned sum, cnt, mine, sp = 0u;
    for (;;) {
        sum = 0u; cnt = 0u; mine = 0u;
#pragma unroll
        for (unsigned j = 0; j < 16; ++j) { const unsigned c = xb_ld(&bar[XB_XCNT(j)]); sum += c; cnt += (c > 0u) ? 1u : 0u; mine = (j == x) ? c : mine; }
        if (sum == G) break;
        __builtin_amdgcn_s_sleep(1);
        if ((++sp & 255u) == 0u) { if (xb_ld(&bar[XB_TMO])) break; if (sp > XB_SPIN_CAP) { atomicAdd(&bar[XB_TMO], 1u); break; } }
    }
    nloc = mine > 0u ? mine : 1u; nx = cnt > 0u ? cnt : 1u;
}

__device__ __forceinline__ void xcd_barrier(const XcdBarrier& b) {
    asm volatile("s_waitcnt vmcnt(0)" ::: "memory");
    __syncthreads();
    if (b.w0 && lane_id_here() == 0) {
        unsigned* bar = b.bar;
        __builtin_amdgcn_s_waitcnt(0);
        unsigned nloc = b.st[0], nx = b.st[1];
        if (nloc == 0u) { xcd_barrier_complete(bar, b.x, nloc, nx); b.st[0] = nloc; b.st[1] = nx; }
        const unsigned old = xb_add(&bar[XB_XSUB(b.x)], 1u);
        const unsigned gen = old / nloc;
        if (old + 1u == (gen + 1u) * nloc) {
            __builtin_amdgcn_fence(__ATOMIC_RELEASE, "agent");
            asm volatile("s_waitcnt vmcnt(0)" ::: "memory");
            const unsigned og = xb_add(&bar[XB_TOP], 1u);
            const unsigned tg = og / nx;
            if (og + 1u == (tg + 1u) * nx) xb_add(&bar[XB_TOPGEN], 1u);
            else XB_SPIN(xb_ld(&bar[XB_TOPGEN]) == tg, bar);
            __builtin_amdgcn_fence(__ATOMIC_ACQUIRE, "agent");
            xb_add(&bar[XB_XGEN(b.x)], 1u);
            asm volatile("s_waitcnt vmcnt(0)" ::: "memory");
        } else {
            XB_SPIN(xb_ld(&bar[XB_XGEN(b.x)]) == gen, bar);
            __builtin_amdgcn_fence(__ATOMIC_ACQUIRE, "agent");
            asm volatile("s_waitcnt vmcnt(0)" ::: "memory");
        }
    }
    __syncthreads();
}

__device__ __forceinline__ void group_sync(unsigned* word, unsigned n, unsigned* bar, bool w0) {
    asm volatile("s_waitcnt vmcnt(0)" ::: "memory");
    __syncthreads();
    if (w0 && lane_id_here() == 0) {
        __builtin_amdgcn_s_waitcnt(0);
        __builtin_amdgcn_fence(__ATOMIC_RELEASE, "agent");
        asm volatile("s_waitcnt vmcnt(0)" ::: "memory");
        (void)xb_add(word, 1u);
        XB_SPIN(xb_ld(word) < n, bar);
        __builtin_amdgcn_fence(__ATOMIC_ACQUIRE, "agent");
        asm volatile("s_waitcnt vmcnt(0)" ::: "memory");
    }
    __syncthreads();
}

struct Args { const float* in[23]; float* out; unsigned char* ws; int ph_lo, ph_hi; };
struct Frame {
    LAS unsigned char* lds;
    volatile LAS int* LCTL;
    int tid, lane, wave, vcu, G;
};
__device__ __forceinline__ unsigned long long ptr_get(const Frame& F, int i) {
    const unsigned lo = (unsigned)F.LCTL[128 + 2 * i], hi = (unsigned)F.LCTL[129 + 2 * i];
    return ((unsigned long long)(unsigned)__builtin_amdgcn_readfirstlane((int)hi) << 32) | (unsigned long long)(unsigned)__builtin_amdgcn_readfirstlane((int)lo);
}
__device__ __forceinline__ const float* inp(const Frame& F, int i) { return (const float*)(GAS const float*)ptr_get(F, i); }
__device__ __forceinline__ unsigned char* wsp(const Frame& F) { return (unsigned char*)(GAS unsigned char*)ptr_get(F, 23); }
__device__ __forceinline__ float* outp(const Frame& F) { return (float*)(GAS float*)ptr_get(F, 24); }
enum { I_X = 0, I_C, I_CTX, I_CCTX, I_WADA, I_BADA, I_GMIX, I_GFFN, I_WQKV, I_QGAIN, I_KGAIN, I_RPB, I_WONA, I_WIN, I_BGATE, I_MHGAIN, I_WOML,
       I_WR, I_BR, I_W1, I_B1, I_W2, I_B2 };

struct DenseOrder {
    int nM, nN, nwg, G, c, pm0, K; const char* A; const char* Bt;
    __device__ __forceinline__ void init(int pm0_, int nM_, int nN_, int G_, int c_, const void* A_, const void* Bt_, int K_) { pm0 = pm0_; nM = nM_; nN = nN_; nwg = nM * nN; G = G_; c = c_; A = (const char*)A_; Bt = (const char*)Bt_; K = K_; }
    __device__ __forceinline__ bool next(int i, pg8::Unit& u) const {
        const long L = (long)i * G + c; if (L >= nwg) return false;
        int wgid = (int)L; { const int q = nwg / 8, r = nwg % 8, xcd = wgid % 8, off = wgid / 8; wgid = (xcd < r ? xcd * (q + 1) : r * (q + 1) + (xcd - r) * q) + off; }
        const int nig = 8 * nN, gid = wgid / nig, fm = gid * 8, gsz = (nM - fm) < 8 ? (nM - fm) : 8;
        u.pm = pm0 + fm + ((wgid % nig) % gsz); u.pn = (wgid % nig) / gsz; u.e = 0; u.slot = i; return true;
    }
    __device__ __forceinline__ const char* a_base(const pg8::Unit& u) const { return A + (size_t)u.pm * 256 * K * 2; }
    __device__ __forceinline__ const char* b_base(const pg8::Unit& u) const { return Bt + (size_t)u.pn * 256 * K * 2; }
    __device__ __forceinline__ int a_row(const pg8::Unit&, int) const { return 0; }
    __device__ __forceinline__ bool prefetchable() const { return false; }
    __device__ __forceinline__ const int* a_row_ptr(const pg8::Unit&, int) const { return nullptr; }
};
struct MoeOrder {
    int NT, nunits, G, c, K; const char* A; const char* W; size_t estride; const int* tokmap; volatile LAS int* prefix; volatile LAS int* tile_e; volatile LAS int* tokl; bool gather;
    __device__ __forceinline__ bool next(int i, pg8::Unit& u) const {
        const long L = (long)i * G + c; if (L >= nunits) return false;
        int wgid = (int)L; { const int q = nunits / 8, r = nunits % 8, xcd = wgid % 8, off = wgid / 8; wgid = (xcd < r ? xcd * (q + 1) : r * (q + 1) + (xcd - r) * q) + off; }
        const int tile = wgid / NT; u.pm = tile; u.pn = wgid - tile * NT;
        u.e = __builtin_amdgcn_readfirstlane(tile_e[tile]); u.slot = i; return true;
    }
    __device__ __forceinline__ const char* a_base(const pg8::Unit& u) const { return A; }
    __device__ __forceinline__ const char* b_base(const pg8::Unit& u) const { return W + (size_t)u.e * estride + (size_t)u.pn * 256 * K * 2; }
    __device__ __forceinline__ int a_row(const pg8::Unit& u, int r) const { return gather ? tokl[u.slot * 256 + r] : u.pm * 256 + r; }
    __device__ __forceinline__ bool prefetchable() const { return gather; }
    __device__ __forceinline__ const int* a_row_ptr(const pg8::Unit& u, int r) const { return tokmap + u.pm * 256 + r; }
};

#ifndef WO_PREFETCH
#define WO_PREFETCH false
#endif
typedef f32x4 AccT[2][2][4][2];
struct EpiStoreBf16 {
    static constexpr bool PERM = true; static constexpr bool PREFETCH = false;
    bf16_t* O; int ldc;
    __device__ __forceinline__ void operator()(const AccT& acc, const pg8::Unit& u, int wr, int wc, int fr, int fq) const {
        const int row0 = u.pm * 256 + wr * 64 + fr, col0 = u.pn * 256 + wc * 32 + 8 * fq;
#pragma unroll
        for (int ai = 0; ai < 2; ++ai)
#pragma unroll
            for (int m = 0; m < 4; ++m) { bf16_t* rowp = O + (size_t)(row0 + ai * 128 + m * 16) * ldc + col0;
#pragma unroll
                for (int bj = 0; bj < 2; ++bj) { const f32x4 v0 = acc[ai][bj][m][0], v1 = acc[ai][bj][m][1];
                    u32x4 w; w.x = pg8::cvt_pk_bf16(v0[0], v0[1]); w.y = pg8::cvt_pk_bf16(v0[2], v0[3]); w.z = pg8::cvt_pk_bf16(v1[0], v1[1]); w.w = pg8::cvt_pk_bf16(v1[2], v1[3]);
                    *(u32x4*)(rowp + bj * 128) = w; } }
    }
};
struct EpiProjML {
    static constexpr bool PERM = false; static constexpr bool PREFETCH = false;
    bf16_t* O; const float* rope;
    __device__ __forceinline__ void operator()(const AccT& acc, const pg8::Unit& u, int wr, int wc, int fr, int fq) const {
        const int row0 = u.pm * 256 + wr * 64 + fr, col0 = u.pn * 256 + wc * 32 + 4 * fq;
        const bool qk = u.pn < 4, lat = u.pm >= ROWS_CTX / 256;
        const float scale = u.pn < 2 ? 0.125f : 1.0f;
        const int hf = wc & 1;
#pragma unroll
        for (int ai = 0; ai < 2; ++ai) {
            f32x4 t0[4], t1[4];
            if (qk && lat) {
#pragma unroll
                for (int m = 0; m < 4; ++m) { const int row = row0 + ai * 128 + m * 16, s = (row - ROWS_CTX) & 4095, pos = hf ? (s & 63) : (s >> 6);
                    t0[m] = *(const f32x4*)(rope + (pos * 16 + 4 * fq) * 2); t1[m] = *(const f32x4*)(rope + (pos * 16 + 4 * fq) * 2 + 4); }
            }
#pragma unroll
            for (int m = 0; m < 4; ++m) { const int row = row0 + ai * 128 + m * 16; bf16_t* rowp = O + (size_t)row * ML_INP + col0;
                f32x4 c4 = (f32x4){1.f, 1.f, 1.f, 1.f}, s4 = (f32x4){0.f, 0.f, 0.f, 0.f};
                if (qk && lat) { c4 = (f32x4){t0[m][0], t0[m][2], t1[m][0], t1[m][2]}; s4 = (f32x4){t0[m][1], t0[m][3], t1[m][1], t1[m][3]}; }
#pragma unroll
                for (int bj = 0; bj < 2; ++bj) { f32x4 v0 = acc[ai][bj][m][0], v1 = acc[ai][bj][m][1];
                    if (qk) { const f32x4 o0 = (v0 * c4 - v1 * s4) * scale, o1 = (v0 * s4 + v1 * c4) * scale; v0 = o0; v1 = o1; }
                    u32x2 w0, w1; w0.x = pg8::cvt_pk_bf16(v0[0], v0[1]); w0.y = pg8::cvt_pk_bf16(v0[2], v0[3]); w1.x = pg8::cvt_pk_bf16(v1[0], v1[1]); w1.y = pg8::cvt_pk_bf16(v1[2], v1[3]);
                    *(u32x2*)(rowp + bj * 128) = w0; *(u32x2*)(rowp + bj * 128 + 16) = w1; } }
        }
    }
};
#ifndef Y_FP8
#define Y_FP8 1
#endif
struct EpiY {
    static constexpr bool PERM = true; static constexpr bool PREFETCH = false;
    bf16_t* O; const float* b2;
    __device__ __forceinline__ void operator()(const AccT& acc, const pg8::Unit& u, int wr, int wc, int fr, int fq) const {
        const int row0 = u.pm * 256 + wr * 64 + fr, col0 = u.pn * 256 + wc * 32 + 8 * fq;
        const float* bp = b2 + (size_t)u.e * D + col0;
#pragma unroll
        for (int bj = 0; bj < 2; ++bj) {
            const f32x4 b0 = *(const f32x4*)(bp + bj * 128), b1v = *(const f32x4*)(bp + bj * 128 + 4);
#pragma unroll
            for (int ai = 0; ai < 2; ++ai)
#pragma unroll
                for (int m = 0; m < 4; ++m) {
                    const f32x4 v0 = acc[ai][bj][m][0] * (1.0f / 1024.0f) + b0, v1 = acc[ai][bj][m][1] * (1.0f / 1024.0f) + b1v;
#if Y_FP8
                    unsigned char* rowp = (unsigned char*)O + (size_t)(row0 + ai * 128 + m * 16) * D + col0 + bj * 128;
                    const f32x4 lim = (f32x4){448.f, 448.f, 448.f, 448.f};
                    const f32x4 q0 = __builtin_elementwise_min(__builtin_elementwise_max(v0 * 16.0f, -lim), lim), q1 = __builtin_elementwise_min(__builtin_elementwise_max(v1 * 16.0f, -lim), lim);
                    u32x2 w; w.x = pk4_fp8(q0[0], q0[1], q0[2], q0[3]); w.y = pk4_fp8(q1[0], q1[1], q1[2], q1[3]);
                    *(u32x2*)rowp = w;
#else
                    bf16_t* rowp = O + (size_t)(row0 + ai * 128 + m * 16) * D + col0 + bj * 128;
                    u32x4 w; w.x = pg8::cvt_pk_bf16(v0[0], v0[1]); w.y = pg8::cvt_pk_bf16(v0[2], v0[3]); w.z = pg8::cvt_pk_bf16(v1[0], v1[1]); w.w = pg8::cvt_pk_bf16(v1[2], v1[3]);
                    *(u32x4*)rowp = w;
#endif
                } }
    }
};
struct EpiSwiglu {
    static constexpr bool PERM = true; static constexpr bool PREFETCH = false;
    unsigned char* O; const float* b1;
    __device__ __forceinline__ void operator()(const AccT& acc, const pg8::Unit& u, int wr, int wc, int fr, int fq) const {
        const int row0 = u.pm * 256 + wr * 64 + fr, cc0 = u.pn * 128 + wc * 32 + 8 * fq;
        const float* bp = b1 + (size_t)u.e * 2048 + cc0;
        f32x4 bg[2], bl[2];
#pragma unroll
        for (int n = 0; n < 2; ++n) { bg[n] = *(const f32x4*)(bp + 4 * n); bl[n] = *(const f32x4*)(bp + 1024 + 4 * n) + 1.0f; }
#pragma unroll
        for (int ai = 0; ai < 2; ++ai)
#pragma unroll
            for (int m = 0; m < 4; ++m) { unsigned char* rowp = O + (size_t)(row0 + ai * 128 + m * 16) * D + cc0;
                float o[8];
#pragma unroll
                for (int n = 0; n < 2; ++n) { const f32x4 gl = acc[ai][0][m][n] * (1.0f / 2048.0f) + bg[n], li1 = acc[ai][1][m][n] * (1.0f / 2048.0f) + bl[n];
#pragma unroll
                    for (int j = 0; j < 4; ++j) { const float g = fminf(gl[j], 7.0f), l1 = __builtin_amdgcn_fmed3f(li1[j], -6.0f, 8.0f);
                        const float sg = __builtin_amdgcn_rcpf(1.0f + __builtin_amdgcn_exp2f(-2.45545696f * g));
                        o[4 * n + j] = (8.0f * g) * sg * l1; } }
                u32x2 w; w.x = pk4_fp8(o[0], o[1], o[2], o[3]); w.y = pk4_fp8(o[4], o[5], o[6], o[7]);
                *(u32x2*)rowp = w; }
    }
};
struct EpiResid {
    static constexpr bool PERM = true; static constexpr bool PREFETCH = WO_PREFETCH;
    bf16_t* xs; const float* g;
    __device__ __forceinline__ void prefetch(const pg8::Unit& u, int tid, LAS unsigned char* lds) const {
        const char* base = (const char*)(xs + (size_t)(u.pm * 256 + (tid >> 1)) * D + u.pn * 256) + (tid & 1) * 256;
        LAS unsigned* dump = (LAS unsigned*)(lds + pg8::STAGE_BYTES + 16384 + (tid >> 6) * 256);
        __builtin_amdgcn_global_load_lds((const unsigned*)base, dump, 4, 0, 0);
        __builtin_amdgcn_global_load_lds((const unsigned*)(base + 128), dump, 4, 0, 0);
    }
    __device__ __forceinline__ void operator()(const AccT& acc, const pg8::Unit& u, int wr, int wc, int fr, int fq) const {
        const int row0 = u.pm * 256 + wr * 64 + fr, col0 = u.pn * 256 + wc * 32 + 8 * fq;
        const int mb = u.pm < 8 ? 8 : ((u.pm - 8) >> 4);
        const float* gp = g + (size_t)mb * 6144 + col0;
        f32x4 gv[2][2];
#pragma unroll
        for (int bj = 0; bj < 2; ++bj)
#pragma unroll
            for (int n = 0; n < 2; ++n) gv[bj][n] = *(const f32x4*)(gp + bj * 128 + 4 * n);
#pragma unroll
        for (int ai = 0; ai < 2; ++ai) {
            u32x4 xv[4][2];
#pragma unroll
            for (int m = 0; m < 4; ++m) { const bf16_t* rowp = xs + (size_t)(row0 + ai * 128 + m * 16) * D + col0;
#pragma unroll
                for (int bj = 0; bj < 2; ++bj) xv[m][bj] = *(const u32x4*)(rowp + bj * 128); }
#pragma unroll
            for (int m = 0; m < 4; ++m) { bf16_t* rowp = xs + (size_t)(row0 + ai * 128 + m * 16) * D + col0;
#pragma unroll
                for (int bj = 0; bj < 2; ++bj) { const u32x4 x = xv[m][bj];
                    const f32x4 x0 = (f32x4){bflo(x.x), bfhi(x.x), bflo(x.y), bfhi(x.y)}, x1 = (f32x4){bflo(x.z), bfhi(x.z), bflo(x.w), bfhi(x.w)};
                    const f32x4 v0 = x0 + gv[bj][0] * acc[ai][bj][m][0], v1 = x1 + gv[bj][1] * acc[ai][bj][m][1];
                    u32x4 w; w.x = pg8::cvt_pk_bf16(v0[0], v0[1]); w.y = pg8::cvt_pk_bf16(v0[2], v0[3]); w.z = pg8::cvt_pk_bf16(v1[0], v1[1]); w.w = pg8::cvt_pk_bf16(v1[2], v1[3]);
                    *(u32x4*)(rowp + bj * 128) = w; } }
        }
    }
};

__device__ __forceinline__ const float* modp(const Frame& F, int l, int mb, int chunk) { return (const float*)(wsp(F) + WS_MOD) + ((size_t)(l * 9 + mb) * 6 + chunk) * D; }
__device__ __forceinline__ int row_mb(int row) { return row < ROWS_CTX ? 8 : ((row - ROWS_CTX) >> 12); }

__device__ __forceinline__ void transpose_item(const float* W, int N, int Nvalid, bf16_t* WT, int k0, int n0, LAS float* scr, int lane, const bool nost = false) {
    const int nn = 4 * (lane & 15);
    const bool ok = (n0 + nn) < Nvalid;
    f32x4 v[16];
#pragma unroll
    for (int i = 0; i < 16; ++i) { const int kk = 4 * i + (lane >> 4);
        v[i] = ok ? __builtin_nontemporal_load((const f32x4*)(W + (size_t)(k0 + kk) * N + n0 + nn)) : (f32x4){0.f, 0.f, 0.f, 0.f}; }
#pragma unroll
    for (int i = 0; i < 16; ++i) { const int kk = 4 * i + (lane >> 4); LAS float* s = scr + kk * 65 + nn;
        s[0] = v[i][0]; s[1] = v[i][1]; s[2] = v[i][2]; s[3] = v[i][3]; }
    LDS_WAIT(); asm volatile("" ::: "memory");
    const int c = lane & 7;
#pragma unroll
    for (int j = 0; j < 8; ++j) { const int n = (lane >> 3) + 8 * j; const LAS float* s = scr + (8 * c) * 65 + n;
        u32x4 o; o.x = pk2(s[0 * 65], s[1 * 65]); o.y = pk2(s[2 * 65], s[3 * 65]); o.z = pk2(s[4 * 65], s[5 * 65]); o.w = pk2(s[6 * 65], s[7 * 65]);
        if (!nost) *(u32x4*)(WT + (size_t)n * D + k0 + 8 * c) = o; }
    LDS_WAIT(); asm volatile("" ::: "memory");
}
__device__ __forceinline__ void transpose_item_f8(const float* W, int N, unsigned char* WT, int k0, int n0, LAS float* scr, int lane, float scale, const bool nost = false) {
    const int nn = 4 * (lane & 15);
    f32x4 v[16];
#pragma unroll
    for (int i = 0; i < 16; ++i) { const int kk = 4 * i + (lane >> 4); v[i] = __builtin_nontemporal_load((const f32x4*)(W + (size_t)(k0 + kk) * N + n0 + nn)); }
#pragma unroll
    for (int i = 0; i < 16; ++i) { const int kk = 4 * i + (lane >> 4); LAS float* s = scr + kk * 65 + nn;
        s[0] = v[i][0] * scale; s[1] = v[i][1] * scale; s[2] = v[i][2] * scale; s[3] = v[i][3] * scale; }
    LDS_WAIT(); asm volatile("" ::: "memory");
    const int c = lane & 3;
#pragma unroll
    for (int j = 0; j < 4; ++j) { const int n = (lane >> 2) + 16 * j; const LAS float* s = scr + (16 * c) * 65 + n;
        u32x4 o; o.x = pk4_fp8(s[0 * 65], s[1 * 65], s[2 * 65], s[3 * 65]); o.y = pk4_fp8(s[4 * 65], s[5 * 65], s[6 * 65], s[7 * 65]);
        o.z = pk4_fp8(s[8 * 65], s[9 * 65], s[10 * 65], s[11 * 65]); o.w = pk4_fp8(s[12 * 65], s[13 * 65], s[14 * 65], s[15 * 65]);
        if (!nost) *(u32x4*)(WT + (size_t)n * D + k0 + 16 * c) = o; }
    LDS_WAIT(); asm volatile("" ::: "memory");
}
__device__ __forceinline__ void phase0(Frame& F, const int mode = 0) {
    const int tid = F.tid, lane = F.lane, wave = F.wave;
    if (mode != 2) {
        LAS float* sT = (LAS float*)F.lds;
        LAS float* red = (LAS float*)(F.lds + 40960);
        const float* c = inp(F, I_C); const float* cctx = inp(F, I_CCTX);
        for (int idx = tid; idx < 9 * D; idx += NTHREADS) { const int mb = idx >> 10, k = idx & 1023; const float cv = mb < 8 ? c[mb * D + k] : cctx[k]; sT[idx] = cv / (1.f + __expf(-cv)); }
        __syncthreads();
        float* mod = (float*)(wsp(F) + WS_MOD);
        for (int task = F.vcu; task < DEPTH * 64; task += F.G) {
            const int l = task >> 6, cb = task & 63, hk = lane >= 24 ? 1 : 0, ln = lane - 24 * hk; const bool act = lane < 48;
            const float* wp = inp(F, I_WADA) + ((size_t)l * D + wave * 128 + hk) * 6144 + cb * 96 + ln * 4;
            f32x4 acc[9];
#pragma unroll
            for (int mb = 0; mb < 9; ++mb) acc[mb] = (f32x4){0.f, 0.f, 0.f, 0.f};
#pragma unroll 8
            for (int k2 = 0; k2 < 64; ++k2) { const f32x4 wv = act ? __builtin_nontemporal_load((const f32x4*)(wp + (size_t)k2 * 2 * 6144)) : (f32x4){0.f, 0.f, 0.f, 0.f};
#pragma unroll
                for (int mb = 0; mb < 9; ++mb) acc[mb] += wv * sT[mb * D + wave * 128 + 2 * k2 + hk]; }
#pragma unroll
            for (int mb = 0; mb < 9; ++mb) {
#pragma unroll
                for (int c = 0; c < 4; ++c) acc[mb][c] += shfl_(acc[mb][c], lane + 24);
                if (lane < 24) *(LAS f32x4*)(red + (wave * 9 + mb) * 96 + lane * 4) = acc[mb]; }
            __syncthreads();
            for (int idx = tid; idx < 9 * 96; idx += NTHREADS) { const int mb = idx / 96, cc = idx % 96; float s = 0.f;
#pragma unroll
                for (int w = 0; w < 8; ++w) s += red[(w * 9 + mb) * 96 + cc];
                const int col = cb * 96 + cc;
                mod[(size_t)(l * 9 + mb) * 6144 + col] = s + inp(F, I_BADA)[l * 6144 + col]; }
            __syncthreads();
        }
        {
            bf16_t* rt = (bf16_t*)(wsp(F) + WS_RT); const float* wr = inp(F, I_WR);
            for (int idx = F.vcu * NTHREADS + tid; idx < DEPTH * D * NE; idx += F.G * NTHREADS) { const int l = idx >> 15, k = (idx >> 5) & 1023, e = idx & 31; const float w = wr[idx];
                const unsigned hb16 = f2bf(w); const float hf = __builtin_bit_cast(float, hb16 << 16);
                rt[((size_t)(l * 2 + 0) * NE + e) * D + k] = (bf16_t)hb16; rt[((size_t)(l * 2 + 1) * NE + e) * D + k] = (bf16_t)f2bf(w - hf); }
        }
        if (blockIdx.x == 0) {
            float* rope = (float*)(wsp(F) + WS_ROPE);
            for (int idx = tid; idx < 64 * 16; idx += NTHREADS) { const int pos = idx >> 4, i = idx & 15; const float inv = powf(10000.0f, -(float)i / 16.0f); const float ang = (float)pos * inv;
                rope[idx * 2] = cosf(ang); rope[idx * 2 + 1] = sinf(ang); }
        }
        __syncthreads();
    }
    if (mode != 1) {
        const bool nost = (mode == 3);
        LAS float* scr = (LAS float*)(F.lds + wave * 16640);
        const int gw = F.vcu * NWAVES + wave, NGW = F.G * NWAVES;
        constexpr int I_QKV = 2 * 16 * 48, I_WO = 4 * 16 * 16, I_IN = 2 * 16 * 52, I_1 = DEPTH * NE * 16 * 32, I_2 = DEPTH * NE * 16 * 16;
        for (int it0 = gw; it0 < I_QKV + I_WO + I_IN + I_1 + I_2; it0 += NGW) {
            int it = it0;
            if (it < I_QKV) { const int j = it / 768, r = it % 768, kb = r / 48, nb = r % 48;
                transpose_item(inp(F, I_WQKV) + (size_t)j * D * 3072, 3072, 3072, (bf16_t*)(wsp(F) + WS_WQKV) + ((size_t)j * 3072 + nb * 64) * D, kb * 64, nb * 64, scr, lane, nost); continue; }
            it -= I_QKV;
            if (it < I_WO) { const int m = it / 256, r = it % 256, kb = r / 16, nb = r % 16;
                const float* W = (m < 2) ? inp(F, I_WONA) + (size_t)m * D * D : inp(F, I_WOML) + (size_t)(m - 2) * D * D;
                bf16_t* dst = (m < 2) ? (bf16_t*)(wsp(F) + WS_WONA) + (size_t)m * D * D : (bf16_t*)(wsp(F) + WS_WOML) + (size_t)(m - 2) * D * D;
                transpose_item(W, D, D, dst + (size_t)nb * 64 * D, kb * 64, nb * 64, scr, lane, nost); continue; }
            it -= I_WO;
            if (it < I_IN) { const int j = it / 832, r = it % 832, kb = r / 52, nb = r % 52;
                transpose_item(inp(F, I_WIN) + (size_t)j * D * ML_IN, ML_IN, ML_IN, (bf16_t*)(wsp(F) + WS_WIN) + ((size_t)j * ML_INP + nb * 64) * D, kb * 64, nb * 64, scr, lane, nost); continue; }
            it -= I_IN;
            if (it < I_1) { const int le = it / 512, r = it % 512, kb = r / 32, nb = r % 32;
                const int n0 = nb * 64, bj = n0 >> 10, j0 = n0 & 1023, pn = j0 >> 7, jj0 = j0 & 127, drow = pn * 256 + bj * 128 + jj0;
                transpose_item_f8(inp(F, I_W1) + (size_t)le * D * 2048, 2048, (unsigned char*)(wsp(F) + WS_W1T) + ((size_t)le * 2048 + drow) * D, kb * 64, n0, scr, lane, 128.0f, nost); continue; }
            it -= I_1;
            { const int le = it / 256, r = it % 256, kb = r / 16, nb = r % 16;
                transpose_item_f8(inp(F, I_W2) + (size_t)le * D * D, D, (unsigned char*)(wsp(F) + WS_W2T) + ((size_t)le * D + nb * 64) * D, kb * 64, nb * 64, scr, lane, 128.0f, nost); }
        }
    }
}

__device__ __forceinline__ void moe_combine(const Frame& F, const int4 pos, const float4 tw, int lprev, int mb, f32x4 (&v)[4]) {
    const int p[4] = {pos.x, pos.y, pos.z, pos.w}; const float w[4] = {tw.x, tw.y, tw.z, tw.w};
    f32x4 a[4];
#pragma unroll
    for (int j = 0; j < 4; ++j) a[j] = (f32x4){0.f, 0.f, 0.f, 0.f};
#if Y_FP8
    const unsigned char* Y = (const unsigned char*)(wsp(F) + WS_Y);
    unsigned y[4][4];
#pragma unroll
    for (int k = 0; k < 4; ++k) { const unsigned* yp = (const unsigned*)(Y + (size_t)p[k] * D) + F.lane;
#pragma unroll
        for (int j = 0; j < 4; ++j) y[k][j] = yp[64 * j]; }
#pragma unroll
    for (int k = 0; k < 4; ++k) { const float wk = w[k] * (1.0f / 16.0f);
#pragma unroll
        for (int j = 0; j < 4; ++j) { const int yy = (int)y[k][j];
            a[j] = a[j] + wk * (f32x4){__builtin_amdgcn_cvt_f32_fp8(yy, 0), __builtin_amdgcn_cvt_f32_fp8(yy, 1), __builtin_amdgcn_cvt_f32_fp8(yy, 2), __builtin_amdgcn_cvt_f32_fp8(yy, 3)}; } }
#else
    const bf16_t* Y = (const bf16_t*)(wsp(F) + WS_Y);
    u32x2 y[4][4];
#pragma unroll
    for (int k = 0; k < 4; ++k) { const u32x2* yp = (const u32x2*)(Y + (size_t)p[k] * D) + F.lane;
#pragma unroll
        for (int j = 0; j < 4; ++j) y[k][j] = yp[64 * j]; }
#pragma unroll
    for (int k = 0; k < 4; ++k)
#pragma unroll
        for (int j = 0; j < 4; ++j) a[j] = a[j] + w[k] * (f32x4){bflo(y[k][j].x), bfhi(y[k][j].x), bflo(y[k][j].y), bfhi(y[k][j].y)};
#endif
    const f32x4* g2 = (const f32x4*)modp(F, lprev, mb, 5) + F.lane;
#pragma unroll
    for (int j = 0; j < 4; ++j) v[j] = v[j] + g2[64 * j] * a[j];
}

__device__ __forceinline__ void phase_norm1(Frame& F, int l, bool dummy = false) {
    const int gw = F.vcu * NWAVES + F.wave, NGW = F.G * NWAVES, lane = F.lane;
    bf16_t* xs = (bf16_t*)(wsp(F) + WS_XS); bf16_t* hb = (bf16_t*)(wsp(F) + WS_HB);
    bf16_t* xso = dummy ? (bf16_t*)(wsp(F) + WS_ACT) : xs;
    const f32x4* gm = (const f32x4*)(inp(F, I_GMIX) + l * D) + lane;
    const int4* posp = (const int4*)(wsp(F) + WS_POS); const float4* twp = (const float4*)(wsp(F) + WS_TOPW);
    int4 pn = make_int4(0, 0, 0, 0); float4 wn = make_float4(0.f, 0.f, 0.f, 0.f);
    if (l > 0 && gw < ROWS) { pn = posp[gw]; wn = twp[gw]; }
    for (int row = gw; row < ROWS; row += NGW) {
        const int mb = row_mb(row);
        f32x4 v[4];
        if (l == 0) { const float* src = row < ROWS_CTX ? inp(F, I_CTX) + (size_t)row * D : inp(F, I_X) + (size_t)(row - ROWS_CTX) * D; const f32x4* xr = (const f32x4*)src + lane;
#pragma unroll
            for (int j = 0; j < 4; ++j) v[j] = xr[64 * j]; }
        else { const u32x2* xr = (const u32x2*)(xs + (size_t)row * D) + lane;
#pragma unroll
            for (int j = 0; j < 4; ++j) v[j] = bf4_to_f32(xr[64 * j]); }
        if (l > 0) { const int4 pc = pn; const float4 wc = wn;
            if (row + NGW < ROWS) { pn = posp[row + NGW]; wn = twp[row + NGW]; }
            moe_combine(F, pc, wc, l - 1, mb, v); }
        u32x2* xw = (u32x2*)(xso + (size_t)row * D) + lane;
        float ss = 0.f;
#pragma unroll
        for (int j = 0; j < 4; ++j) { u32x2 xb; xb.x = pk2(v[j][0], v[j][1]); xb.y = pk2(v[j][2], v[j][3]); xw[64 * j] = xb; ss += (v[j][0] * v[j][0] + v[j][1] * v[j][1]) + (v[j][2] * v[j][2] + v[j][3] * v[j][3]); }
        const float rs = 1.0f / sqrtf(wave_sum(ss) * (1.f / D) + EPS);
        const f32x4* sh = (const f32x4*)modp(F, l, mb, 0) + lane; const f32x4* sc = (const f32x4*)modp(F, l, mb, 1) + lane;
        u32x2* o8 = (u32x2*)(hb + (size_t)row * D) + lane;
#pragma unroll
        for (int j = 0; j < 4; ++j) { const f32x4 h = (v[j] * rs) * gm[64 * j] * (sc[64 * j] + 1.0f) + sh[64 * j];
            u32x2 w; w.x = pk2(h[0], h[1]); w.y = pk2(h[2], h[3]); o8[64 * j] = w; }
    }
}
__device__ __forceinline__ void phase_final(Frame& F) {
    const int gw = F.vcu * NWAVES + F.wave, NGW = F.G * NWAVES, lane = F.lane;
    const bf16_t* xs = (const bf16_t*)(wsp(F) + WS_XS);
    const int4* posp = (const int4*)(wsp(F) + WS_POS); const float4* twp = (const float4*)(wsp(F) + WS_TOPW);
    int4 pn = make_int4(0, 0, 0, 0); float4 wn = make_float4(0.f, 0.f, 0.f, 0.f);
    if (ROWS_CTX + gw < ROWS) { pn = posp[ROWS_CTX + gw]; wn = twp[ROWS_CTX + gw]; }
    for (int row = ROWS_CTX + gw; row < ROWS; row += NGW) {
        const int mb = row_mb(row);
        const u32x2* xr = (const u32x2*)(xs + (size_t)row * D) + lane;
        f32x4 v[4];
#pragma unroll
        for (int j = 0; j < 4; ++j) v[j] = bf4_to_f32(xr[64 * j]);
        const int4 pc = pn; const float4 wc = wn;
        if (row + NGW < ROWS) { pn = posp[row + NGW]; wn = twp[row + NGW]; }
        moe_combine(F, pc, wc, DEPTH - 1, mb, v);
        f32x4* o = (f32x4*)(outp(F) + (size_t)(row - ROWS_CTX) * D) + lane;
#ifdef MLPROF
        { const unsigned long long* pp = (const unsigned long long*)(wsp(F) + WS_CTL + 524288); const float tot = (float)(pp[0] + pp[1] + pp[2] + pp[3] + pp[4] + pp[5]);
          const float f = MLPROF_SEL < 0 ? 0.f : (MLPROF_SEL == 6 ? tot * (1.0f / 1048576.0f) : (MLPROF_SEL > 5 ? 1.f : (float)pp[MLPROF_SEL < 0 ? 0 : (MLPROF_SEL > 5 ? 5 : MLPROF_SEL)] / tot)); const float sc = 2.f + 4.f * f;
          const f32x4* xin = (const f32x4*)(inp(F, I_X) + (size_t)(row - ROWS_CTX) * D) + lane;
#pragma unroll
          for (int j = 0; j < 4; ++j) v[j] = xin[64 * j] * sc; }
#endif
#pragma unroll
        for (int j = 0; j < 4; ++j) o[64 * j] = v[j];
    }
}

constexpr int NCBP = 96, NA_CTX_EXTRA = 3;
__device__ __forceinline__ bool proj_split(int G) { return false && G >= 2 * NCBP; }
__device__ __forceinline__ void phase_na_post(Frame& F, int jn, const bool split) {
    const int gw = F.vcu * NWAVES + F.wave, NGW = F.G * NWAVES, lane = F.lane;
    constexpr int NIT = (ROWS / 64) * NH_NA, NIT_CTX = (ROWS_CTX / 64) * NH_NA, NIT_IMG = NIT - NIT_CTX;
    const int nwc = NCBP * NWAVES, nwm = NGW - nwc, m1 = NIT_IMG - NA_CTX_EXTRA * nwc;
    const bf16_t* proj = (const bf16_t*)(wsp(F) + WS_PROJ);
    bf16_t* QN = (bf16_t*)(wsp(F) + WS_QN); bf16_t* KN = (bf16_t*)(wsp(F) + WS_KN); bf16_t* VT = (bf16_t*)(wsp(F) + WS_VT);
    LAS bf16_t* vs = (LAS bf16_t*)(F.lds + F.wave * (64 * 72 * 2));
    const int c8 = lane & 7, rl = lane >> 3;
    float qg[8], kg[8];
#pragma unroll
    for (int e = 0; e < 8; ++e) { qg[e] = inp(F, I_QGAIN)[jn * 64 + c8 * 8 + e] * (0.125f * 1.44269504f); kg[e] = inp(F, I_KGAIN)[jn * 64 + c8 * 8 + e]; }
    for (int v = 0; ; ++v) {
        int item;
        if (!split) { item = gw + v * NGW; if (item >= NIT) break; }
        else if (gw < nwc) { if (v == 0) { if (gw >= NIT_CTX) continue; item = gw; } else { if (v > NA_CTX_EXTRA) break; item = NIT_CTX + m1 + gw + (v - 1) * nwc; } }
        else { const int m = (gw - nwc) + v * nwm; if (m >= m1) break; item = NIT_CTX + m; }
        const int rb = item >> 4, h = item & 15, row0 = rb * 64;
        int b, tp0;
        if (row0 < ROWS_CTX) { b = row0 >> 8; tp0 = row0 & 255; } else { b = (row0 - ROWS_CTX) >> 12; tp0 = NCTX + ((row0 - ROWS_CTX) & 4095); }
        const size_t seqbase = ((size_t)(b * NH_NA + h) * TT + tp0) * 64;
#pragma unroll
        for (int i = 0; i < 8; ++i) {
            const int r = i * 8 + rl;
            const bf16_t* pr = proj + (size_t)(row0 + r) * 3072 + h * 64 + c8 * 8;
            const u32x4 qv = *(const u32x4*)pr, kv = *(const u32x4*)(pr + 1024), vv = *(const u32x4*)(pr + 2048);
            float q[8] = {bflo(qv.x), bfhi(qv.x), bflo(qv.y), bfhi(qv.y), bflo(qv.z), bfhi(qv.z), bflo(qv.w), bfhi(qv.w)};
            float k[8] = {bflo(kv.x), bfhi(kv.x), bflo(kv.y), bfhi(kv.y), bflo(kv.z), bfhi(kv.z), bflo(kv.w), bfhi(kv.w)};
            float sq = 0.f, sk = 0.f;
#pragma unroll
            for (int e = 0; e < 8; ++e) { sq += q[e] * q[e]; sk += k[e] * k[e]; }
            sq = sum8(sq); sk = sum8(sk);
            const float rq = 1.0f / sqrtf(sq * (1.f / 64) + EPS), rk = 1.0f / sqrtf(sk * (1.f / 64) + EPS);
            u32x4 qo, ko;
            qo.x = pk2(q[0] * rq * qg[0], q[1] * rq * qg[1]); qo.y = pk2(q[2] * rq * qg[2], q[3] * rq * qg[3]); qo.z = pk2(q[4] * rq * qg[4], q[5] * rq * qg[5]); qo.w = pk2(q[6] * rq * qg[6], q[7] * rq * qg[7]);
            ko.x = pk2(k[0] * rk * kg[0], k[1] * rk * kg[1]); ko.y = pk2(k[2] * rk * kg[2], k[3] * rk * kg[3]); ko.z = pk2(k[4] * rk * kg[4], k[5] * rk * kg[5]); ko.w = pk2(k[6] * rk * kg[6], k[7] * rk * kg[7]);
            *(u32x4*)(QN + seqbase + (size_t)r * 64 + c8 * 8) = qo;
            *(u32x4*)(KN + seqbase + (size_t)r * 64 + c8 * 8) = ko;
            *(LAS u32x4*)(vs + r * 72 + ((c8 ^ ((r >> 3) & 7)) * 8)) = vv;
        }
        LDS_WAIT(); asm volatile("" ::: "memory");
#pragma unroll
        for (int j = 0; j < 8; ++j) {
            const int d = rl + 8 * j;
            const LAS bf16_t* s = vs + (8 * c8) * 72 + (((d >> 3) ^ c8) * 8) + (d & 7);
            u32x4 o;
            o.x = (unsigned)s[0 * 72] | ((unsigned)s[1 * 72] << 16); o.y = (unsigned)s[2 * 72] | ((unsigned)s[3 * 72] << 16);
            o.z = (unsigned)s[4 * 72] | ((unsigned)s[5 * 72] << 16); o.w = (unsigned)s[6 * 72] | ((unsigned)s[7 * 72] << 16);
            *(u32x4*)(VT + ((size_t)(b * NH_NA + h) * 64 + d) * TT + tp0 + 8 * c8) = o;
        }
        LDS_WAIT(); asm volatile("" ::: "memory");
    }
}

__device__ __forceinline__ bf16x8 ld_bf16x8(const bf16_t* p) { return *(const bf16x8*)p; }
constexpr int NA_LD = 72;
constexpr int NA_TILE = 64 * NA_LD * 2;
struct NaState { f32x4 o[4]; f32x4 osum; };
constexpr int NA_RING = 2 * 2 * 64 * NA_LD * 2;
constexpr int NA_CTX_OFF = NA_RING + 15 * 128 * 4;
constexpr int NA_BT_LD = 128, NA_BT_OFF = 48;
constexpr int NA_GQK_OFF = NA_CTX_OFF + 4 * 2 * 64 * NA_LD * 2;
__device__ __forceinline__ int na_row(int b, int tp) { return tp < NCTX ? b * NCTX + tp : ROWS_CTX + b * SEQ + (tp - NCTX); }
__device__ __forceinline__ u32x4 na_knorm(const u32x4 kv) {
    const float k[8] = {bflo(kv.x), bfhi(kv.x), bflo(kv.y), bfhi(kv.y), bflo(kv.z), bfhi(kv.z), bflo(kv.w), bfhi(kv.w)};
    float sk = 0.f;
#pragma unroll
    for (int e = 0; e < 8; ++e) sk += k[e] * k[e];
    sk = sum8(sk);
    const float rk = 1.0f / sqrtf(sk * (1.f / 64) + EPS);
    u32x4 o; o.x = pk2(k[0] * rk, k[1] * rk); o.y = pk2(k[2] * rk, k[3] * rk); o.z = pk2(k[4] * rk, k[5] * rk); o.w = pk2(k[6] * rk, k[7] * rk);
    return o;
}
__device__ __forceinline__ void na_vscatter(LAS bf16_t* vimg, const u32x4 vv, int r, int c8) {
    const unsigned vw[4] = {vv.x, vv.y, vv.z, vv.w};
    LAS bf16_t* d = vimg + (8 * c8) * NA_LD + r;
#pragma unroll
    for (int e = 0; e < 8; ++e) d[e * NA_LD] = (bf16_t)((vw[e >> 1] >> (16 * (e & 1))) & 0xffffu);
}
__device__ __forceinline__ void na_qload(const bf16_t* qp, const LAS float* gqk, int lane, int g, bf16x8 (&q)[2]) {
    const u32x4 a = *(const u32x4*)(qp + 8 * g), c = *(const u32x4*)(qp + 32 + 8 * g);
    const float f0[8] = {bflo(a.x), bfhi(a.x), bflo(a.y), bfhi(a.y), bflo(a.z), bfhi(a.z), bflo(a.w), bfhi(a.w)};
    const float f1[8] = {bflo(c.x), bfhi(c.x), bflo(c.y), bfhi(c.y), bflo(c.z), bfhi(c.z), bflo(c.w), bfhi(c.w)};
    float ss = 0.f;
#pragma unroll
    for (int e = 0; e < 8; ++e) ss += f0[e] * f0[e] + f1[e] * f1[e];
    ss += shfl_(ss, lane ^ 16); ss += shfl_(ss, lane ^ 32);
    const float rq = 1.0f / sqrtf(ss * (1.f / 64) + EPS);
    const f32x4 g0 = *(const LAS f32x4*)(gqk + 8 * g), g1 = *(const LAS f32x4*)(gqk + 8 * g + 4), g2 = *(const LAS f32x4*)(gqk + 32 + 8 * g), g3 = *(const LAS f32x4*)(gqk + 32 + 8 * g + 4);
    union { u32x4 u; bf16x8 v; } o0, o1;
    o0.u.x = pk2(f0[0] * rq * g0[0], f0[1] * rq * g0[1]); o0.u.y = pk2(f0[2] * rq * g0[2], f0[3] * rq * g0[3]); o0.u.z = pk2(f0[4] * rq * g1[0], f0[5] * rq * g1[1]); o0.u.w = pk2(f0[6] * rq * g1[2], f0[7] * rq * g1[3]);
    o1.u.x = pk2(f1[0] * rq * g2[0], f1[1] * rq * g2[1]); o1.u.y = pk2(f1[2] * rq * g2[2], f1[3] * rq * g2[3]); o1.u.z = pk2(f1[4] * rq * g3[0], f1[5] * rq * g3[1]); o1.u.w = pk2(f1[6] * rq * g3[2], f1[7] * rq * g3[3]);
    q[0] = o0.v; q[1] = o1.v;
}
template <bool WIN, bool DOA, bool DOB>
__device__ __forceinline__ void na_half2(NaState& sa, NaState& sb, const LAS bf16_t* KL, const LAS bf16_t* VL, int half, const bf16x8 (&qa)[2], const bf16x8 (&qb)[2],
                                         const LAS float* browA, const unsigned (&mA)[4], const unsigned (&mB)[4], int q16, int g) {
    union { u32x4 u; bf16x8 v; } ones; ones.u = (u32x4){0x3F803F80u, 0x3F803F80u, 0x3F803F80u, 0x3F803F80u};
    const LAS bf16_t* kp = KL + (half * 32 + q16) * NA_LD + 8 * g;
    const bf16x8 kf[2][2] = {{*(const LAS bf16x8*)kp, *(const LAS bf16x8*)(kp + 32)}, {*(const LAS bf16x8*)(kp + 16 * NA_LD), *(const LAS bf16x8*)(kp + 16 * NA_LD + 32)}};
    bf16x8 vf[4];
#pragma unroll
    for (int j4 = 0; j4 < 4; ++j4) { const LAS bf16_t* vp = VL + (16 * j4 + q16) * NA_LD + half * 32 + 4 * g;
        const bf16x4 va = *(const LAS bf16x4*)vp, vb = *(const LAS bf16x4*)(vp + 16);
        vf[j4] = (bf16x8){va[0], va[1], va[2], va[3], vb[0], vb[1], vb[2], vb[3]}; }
#pragma unroll
    for (int grp = 0; grp < 2; ++grp) {
        if ((grp == 0 && !DOA) || (grp == 1 && !DOB)) continue;
        NaState& st = grp ? sb : sa;
        const LAS float* brow = browA - 16 * grp;
        f32x4 sv[2];
#pragma unroll
        for (int nb = 0; nb < 2; ++nb) { f32x4 init = (f32x4){0.f, 0.f, 0.f, 0.f};
            if (WIN) {
#pragma unroll
                for (int rg = 0; rg < 4; ++rg) init[rg] = brow[32 * half + 16 * nb + rg]; }
            init = __builtin_amdgcn_mfma_f32_16x16x32_bf16(kf[nb][0], grp ? qb[0] : qa[0], init, 0, 0, 0);
            sv[nb] = __builtin_amdgcn_mfma_f32_16x16x32_bf16(kf[nb][1], grp ? qb[1] : qa[1], init, 0, 0, 0); }
#pragma unroll
        for (int nb = 0; nb < 2; ++nb)
#pragma unroll
            for (int rg = 0; rg < 4; ++rg) sv[nb][rg] = __builtin_amdgcn_exp2f(__builtin_amdgcn_fmed3f(sv[nb][rg], -3.0e38f, 100.0f));
        union { u32x4 u; bf16x8 v; } pf;
        pf.u.x = pg8::cvt_pk_bf16(sv[0][0], sv[0][1]); pf.u.y = pg8::cvt_pk_bf16(sv[0][2], sv[0][3]); pf.u.z = pg8::cvt_pk_bf16(sv[1][0], sv[1][1]); pf.u.w = pg8::cvt_pk_bf16(sv[1][2], sv[1][3]);
        if (WIN) { const unsigned (&mk)[4] = grp ? mB : mA; pf.u.x &= mk[0]; pf.u.y &= mk[1]; pf.u.z &= mk[2]; pf.u.w &= mk[3]; }
#pragma unroll
        for (int j4 = 0; j4 < 4; ++j4) st.o[j4] = __builtin_amdgcn_mfma_f32_16x16x32_bf16(vf[j4], pf.v, st.o[j4], 0, 0, 0);
        st.osum = __builtin_amdgcn_mfma_f32_16x16x32_bf16(ones.v, pf.v, st.osum, 0, 0, 0);
    }
}
__device__ __forceinline__ void na_block_task(const Frame& F, int jn, int b, int h, bool ctxq, int p) {
    const int tid = F.tid, lane = F.lane, wave = F.wave, q16 = lane & 15, g = lane >> 4;
    const bf16_t* proj = (const bf16_t*)(wsp(F) + WS_PROJ) + h * 64;
    const LAS float* gqk = (const LAS float*)(F.lds + NA_GQK_OFF);
    const int rw = 4 * p + (wave >> 1), ch = wave & 1, qcA = 32 * ch + q16, qcB = qcA + 16;
    const int qtpA = ctxq ? p * 128 + wave * 16 + q16 : NCTX + rw * 64 + qcA, qtpB = ctxq ? qtpA : qtpA + 16;
    bf16x8 qa[2], qb[2];
    na_qload(proj + (size_t)na_row(b, qtpA) * 3072, gqk, lane, g, qa);
    na_qload(proj + (size_t)na_row(b, qtpB) * 3072, gqk, lane, g, qb);
    NaState sa, sb;
#pragma unroll
    for (int j = 0; j < 4; ++j) { sa.o[j] = (f32x4){0.f, 0.f, 0.f, 0.f}; sb.o[j] = (f32x4){0.f, 0.f, 0.f, 0.f}; }
    sa.osum = (f32x4){0.f, 0.f, 0.f, 0.f}; sb.osum = (f32x4){0.f, 0.f, 0.f, 0.f};
    const int r0w = min(max(rw - 4, 0), 56), c0A = min(max(qcA - 8, 0), 48), c0B = min(max(qcB - 8, 0), 48);
    const int kr_lo = min(max(4 * p - 4, 0), 56), kr_hi = min(max(4 * p + 3 - 4, 0), 56) + 7;
    const int nw = ctxq ? 0 : (kr_hi - kr_lo + 1);
    LAS bf16_t* ring = (LAS bf16_t*)F.lds;
    LAS float* btab = (LAS float*)(F.lds + NA_RING);
    const LAS bf16_t* cres = (const LAS bf16_t*)(F.lds + NA_CTX_OFF);
    const int dA = 4 * g - c0A, dB = 4 * g - c0B;
    unsigned mkA[2][4], mkB[2][4];
#pragma unroll
    for (int hh2 = 0; hh2 < 2; ++hh2)
#pragma unroll
        for (int w4 = 0; w4 < 4; ++w4) { const int cc = 32 * hh2 + 16 * (w4 >> 1) + 2 * (w4 & 1);
            mkA[hh2][w4] = (((unsigned)(cc + dA) < 16u) ? 0xFFFFu : 0u) | (((unsigned)(cc + 1 + dA) < 16u) ? 0xFFFF0000u : 0u);
            mkB[hh2][w4] = (((unsigned)(cc + dB) < 16u) ? 0xFFFFu : 0u) | (((unsigned)(cc + 1 + dB) < 16u) ? 0xFFFF0000u : 0u); }
    const int bcolA = NA_BT_OFF + 4 * g - qcA + 15;
    const int r = tid >> 3, c8 = tid & 7;
    u32x4 kA, vA, kB, vB;
#define NA_TOK0(t) (NCTX + 64 * (kr_lo + (t)))
#define NA_LOAD(t, kk, vv) do { const bf16_t* pr_ = proj + (size_t)(ROWS_CTX + b * SEQ + 64 * (kr_lo + (t)) + r) * 3072 + 8 * c8; kk = *(const u32x4*)(pr_ + 1024); vv = *(const u32x4*)(pr_ + 2048); } while (0)
#define NA_WRITE(bufi, kk, vv) do { LAS bf16_t* dst_ = ring + (bufi) * (2 * 64 * NA_LD); *(LAS u32x4*)(dst_ + r * NA_LD + 8 * c8) = na_knorm(kk); na_vscatter(dst_ + 64 * NA_LD, vv, r, c8); } while (0)
#define NA_TILE(t, bufi) do { const LAS bf16_t* KL = ring + (bufi) * (2 * 64 * NA_LD); const LAS bf16_t* VL = KL + 64 * NA_LD; \
        const int kr = kr_lo + (t); \
        if (kr >= r0w && kr <= r0w + 7) { const LAS float* brow = btab + (kr - rw + 7) * NA_BT_LD + bcolA; \
            if (ch == 0) { na_half2<true, true, true>(sa, sb, KL, VL, 0, qa, qb, brow, mkA[0], mkB[0], q16, g); na_half2<true, false, true>(sa, sb, KL, VL, 1, qa, qb, brow, mkA[1], mkB[1], q16, g); } \
            else { na_half2<true, true, false>(sa, sb, KL, VL, 0, qa, qb, brow, mkA[0], mkB[0], q16, g); na_half2<true, true, true>(sa, sb, KL, VL, 1, qa, qb, brow, mkA[1], mkB[1], q16, g); } } } while (0)
    if (!ctxq) { NA_LOAD(0, kA, vA); NA_LOAD(1, kB, vB); }
    if (ctxq) {
#pragma unroll 1
        for (int t = 0; t < 4; ++t) { const LAS bf16_t* KL = cres + t * (2 * 64 * NA_LD);
            na_half2<false, true, false>(sa, sb, KL, KL + 64 * NA_LD, 0, qa, qb, btab, mkA[0], mkB[0], q16, g); na_half2<false, true, false>(sa, sb, KL, KL + 64 * NA_LD, 1, qa, qb, btab, mkA[1], mkB[1], q16, g); }
    } else {
#pragma unroll 1
        for (int t = 0; t < 4; ++t) { const LAS bf16_t* KL = cres + t * (2 * 64 * NA_LD);
            na_half2<false, true, true>(sa, sb, KL, KL + 64 * NA_LD, 0, qa, qb, btab, mkA[0], mkB[0], q16, g); na_half2<false, true, true>(sa, sb, KL, KL + 64 * NA_LD, 1, qa, qb, btab, mkA[1], mkB[1], q16, g); }
        NA_WRITE(0, kA, vA);
        __syncthreads();
        NA_LOAD(2, kA, vA);
        for (int t = 0; t < nw; t += 2) {
            NA_TILE(t, 0);
            if (t + 1 < nw) NA_WRITE(1, kB, vB);
            __syncthreads();
            if (t + 3 < nw) NA_LOAD(t + 3, kB, vB);
            if (t + 1 >= nw) break;
            NA_TILE(t + 1, 1);
            if (t + 2 < nw) NA_WRITE(0, kA, vA);
            __syncthreads();
            if (t + 4 < nw) NA_LOAD(t + 4, kA, vA);
        }
    }
#undef NA_TOK0
#undef NA_LOAD
#undef NA_WRITE
#undef NA_TILE
    {
        const float inv = 1.0f / sa.osum[0];
        const int row = ctxq ? b * NCTX + p * 128 + wave * 16 + q16 : ROWS_CTX + b * SEQ + rw * 64 + qcA;
        bf16_t* op = (bf16_t*)(wsp(F) + WS_AO) + (size_t)row * D + h * 64 + 4 * g;
#pragma unroll
        for (int j4 = 0; j4 < 4; ++j4) { u32x2 w; w.x = pk2(sa.o[j4][0] * inv, sa.o[j4][1] * inv); w.y = pk2(sa.o[j4][2] * inv, sa.o[j4][3] * inv); *(u32x2*)(op + 16 * j4) = w; }
    }
    if (!ctxq) {
        const float inv = 1.0f / sb.osum[0];
        const int row = ROWS_CTX + b * SEQ + rw * 64 + qcB;
        bf16_t* op = (bf16_t*)(wsp(F) + WS_AO) + (size_t)row * D + h * 64 + 4 * g;
#pragma unroll
        for (int j4 = 0; j4 < 4; ++j4) { u32x2 w; w.x = pk2(sb.o[j4][0] * inv, sb.o[j4][1] * inv); w.y = pk2(sb.o[j4][2] * inv, sb.o[j4][3] * inv); *(u32x2*)(op + 16 * j4) = w; }
    }
}
__device__ __forceinline__ void phase_na_attn(Frame& F, int jn) {
    const int nbh = NB * NH_NA;
    for (int slot = F.vcu; slot < 2 * nbh; slot += F.G) {
        const int bh = slot >> 1, hf = slot & 1, b = bh >> 4, h = bh & 15;
        {
            LAS float* btab = (LAS float*)(F.lds + NA_RING);
            const float* rpb = inp(F, I_RPB) + (size_t)(jn * NH_NA + h) * 15 * 31;
            for (int i = F.tid; i < 15 * NA_BT_LD; i += NTHREADS) { const int dr = i >> 7, c = (i & 127) - NA_BT_OFF; btab[i] = (c >= 0 && c < 31) ? rpb[dr * 31 + c] * 1.44269504f : 0.f; }
            const bf16_t* proj = (const bf16_t*)(wsp(F) + WS_PROJ) + h * 64;
            LAS bf16_t* cres = (LAS bf16_t*)(F.lds + NA_CTX_OFF); const int r = F.tid >> 3, c8 = F.tid & 7;
            if (F.tid < 64) ((LAS float*)(F.lds + NA_GQK_OFF))[F.tid] = inp(F, I_QGAIN)[jn * 64 + F.tid] * inp(F, I_KGAIN)[jn * 64 + F.tid] * (0.125f * 1.44269504f);
            u32x4 ck[4], cv[4];
#pragma unroll
            for (int t = 0; t < 4; ++t) { const bf16_t* pr = proj + (size_t)(b * NCTX + 64 * t + r) * 3072 + 8 * c8; ck[t] = *(const u32x4*)(pr + 1024); cv[t] = *(const u32x4*)(pr + 2048); }
#pragma unroll
            for (int t = 0; t < 4; ++t) { LAS bf16_t* dst = cres + t * (2 * 64 * NA_LD);
                *(LAS u32x4*)(dst + r * NA_LD + 8 * c8) = na_knorm(ck[t]);
                na_vscatter(dst + 64 * NA_LD, cv[t], r, c8); }
            __syncthreads();
        }
        for (int n = 0; n < 8; ++n) na_block_task(F, jn, b, h, false, hf * 8 + n);
        na_block_task(F, jn, b, h, true, hf);
        __syncthreads();
    }
}

__device__ __forceinline__ void row_decode(int row, int& b, int& tp) {
    if (row < ROWS_CTX) { b = row >> 8; tp = row & 255; } else { b = (row - ROWS_CTX) >> 12; tp = NCTX + ((row - ROWS_CTX) & 4095); }
}
__device__ __forceinline__ void unpack8(const u32x4 v, float (&f)[8]) { f[0] = bflo(v.x); f[1] = bfhi(v.x); f[2] = bflo(v.y); f[3] = bfhi(v.y); f[4] = bflo(v.z); f[5] = bfhi(v.z); f[6] = bflo(v.w); f[7] = bfhi(v.w); }
__device__ __forceinline__ u32x4 pack8(const float (&f)[8]) { u32x4 o; o.x = pk2(f[0], f[1]); o.y = pk2(f[2], f[3]); o.z = pk2(f[4], f[5]); o.w = pk2(f[6], f[7]); return o; }
__device__ __forceinline__ float wave_prefix_sum(float v, int lane) {
#pragma unroll
    for (int o = 1; o < 64; o <<= 1) { const float t = shfl_(v, lane - o); if (lane >= o) v += t; }
    return v;
}
__device__ __forceinline__ float wave_prefix_max(float v, int lane) {
#pragma unroll
    for (int o = 1; o < 64; o <<= 1) { const float t = shfl_(v, lane - o); if (lane >= o) v = fmaxf(v, t); }
    return v;
}
__device__ __forceinline__ int ml_grow(int b, int tp) { return tp < NCTX ? b * NCTX + tp : ROWS_CTX + b * SEQ + (tp - NCTX); }
__device__ __forceinline__ void phase_ml_post(Frame& F, int jm) {
    const int gw = F.vcu * NWAVES + F.wave, NGW = F.G * NWAVES, lane = F.lane;
    const bf16_t* proj = (const bf16_t*)(wsp(F) + WS_PROJ);
    float* gs = (float*)(wsp(F) + WS_GS);
    for (int task = gw; task < NB * (TT / 64); task += NGW) {
        const int b = task / (TT / 64), mc = task % (TT / 64);
        const bf16_t* pr = proj + (size_t)ml_grow(b, mc * 64 + lane) * ML_INP + 3072;
        float gp[32];
        { float t8[8];
#pragma unroll
          for (int q = 0; q < 4; ++q) { unpack8(*(const u32x4*)(pr + 8 * q), t8);
#pragma unroll
              for (int e = 0; e < 8; ++e) gp[8 * q + e] = t8[e]; } }
#pragma unroll
        for (int i = 0; i < 32; ++i) { float v = gp[i] + inp(F, I_BGATE)[jm * 32 + i]; v = 15.0f * tanhf(v * (1.0f / 15.0f));
            if ((i >> 3) & 1) v = fminf(v, 0.f) - log1pf(__expf(-fabsf(v)));
            gp[i] = v; }
#pragma unroll
        for (int dir = 0; dir < 2; ++dir)
#pragma unroll
            for (int hh = 0; hh < NH_ML; ++hh) {
                float ig = gp[(2 * dir) * 8 + hh], lf = gp[(2 * dir + 1) * 8 + hh];
                if (dir) { ig = shfl_(ig, 63 - lane); lf = shfl_(lf, 63 - lane); }
                const float cum = wave_prefix_sum(lf, lane), av = ig - cum, pmax = wave_prefix_max(av, lane), cl = shfl_(cum, 63);
                const float wend = cl - cum + ig, ml = wave_max(wend), eend = __expf(wend - ml);
                float* o = gs + ((((size_t)(dir * NB + b) * NH_ML + hh) * (TT / 64) + mc) * 5) * 64;
                o[lane] = cum; o[64 + lane] = av; o[128 + lane] = pmax; o[192 + lane] = eend; if (lane == 0) { o[256] = cl; o[257] = ml; }
            }
    }
}

constexpr int ML_LD = 72;
constexpr int ML_QL = 0, ML_KL = 9216, ML_KET = 18432, ML_VTL = 27648, ML_SDL = 36864, ML_C0L = 46080, ML_N0L = 55296, ML_DENL = 55552;
constexpr int ML_HL = 55808, ML_GL = 65024;
constexpr int ML_ALT = 69632;
__device__ __forceinline__ void ml_task(Frame& F, int b, int hh, int dir, int vh) {
    const int tid = F.tid, lane = F.lane, w = F.wave, l15 = lane & 15, g = lane >> 4;
    LAS bf16_t* QL = (LAS bf16_t*)(F.lds + ML_QL); LAS bf16_t* KL = (LAS bf16_t*)(F.lds + ML_KL); LAS bf16_t* KET = (LAS bf16_t*)(F.lds + ML_KET);
    LAS bf16_t* VTL = (LAS bf16_t*)(F.lds + ML_VTL); LAS bf16_t* SDL = (LAS bf16_t*)(F.lds + ML_SDL); LAS bf16_t* C0L = (LAS bf16_t*)(F.lds + ML_C0L);
    LAS float* n0L = (LAS float*)(F.lds + ML_N0L); LAS float* denL = (LAS float*)(F.lds + ML_DENL);
    LAS bf16_t* HL = (LAS bf16_t*)(F.lds + ML_HL); LAS float* GL = (LAS float*)(F.lds + ML_GL);
    const bf16_t* proj = (const bf16_t*)(wsp(F) + WS_PROJ);
    const float* gsb = (const float*)(wsp(F) + WS_GS) + (((size_t)(dir * NB + b) * NH_ML + hh) * (TT / 64)) * 5 * 64;
    bf16_t* hout = (bf16_t*)(wsp(F) + WS_HDIR) + (size_t)dir * ROWS * D + hh * DV_ML + vh * 64;
    const bool loader = (0x2Bu >> w) & 1u;
    const int ridx = __builtin_popcount((loader ? 0x2Bu : 0xD4u) & ((1u << w) - 1u));
    const int c8 = lane & 7, r0 = ridx * 8 + (lane >> 3);
    const int bt = w >> 1, bc0 = 2 * (w & 1);
    for (int i = tid; i < 64 * ML_LD / 2; i += NTHREADS) { ((LAS unsigned*)C0L)[i] = 0u; ((LAS unsigned*)SDL)[i] = 0u; }
    if (tid < 64) n0L[tid] = 0.f;
    f32x4 Cst[2]; Cst[0] = (f32x4){0.f, 0.f, 0.f, 0.f}; Cst[1] = (f32x4){0.f, 0.f, 0.f, 0.f};
    float nst = 0.f, m0 = 0.f;
#ifdef MLPROF
    unsigned long long pa_[6] = {0, 0, 0, 0, 0, 0}, pt_; asm volatile("s_memtime %0\n\ts_waitcnt lgkmcnt(0)" : "=s"(pt_) :: "memory");
#define PROFPT(k) do { unsigned long long n_; __builtin_amdgcn_sched_barrier(0); asm volatile("s_memtime %0\n\ts_waitcnt lgkmcnt(0)" : "=s"(n_) :: "memory"); __builtin_amdgcn_sched_barrier(0); pa_[k] += n_ - pt_; pt_ = n_; } while (0)
#else
#define PROFPT(k) do {} while (0)
#endif
    u32x4 qA[2], kA[2], vA[2]; float gA[6];
#define ML_TB(c) (dir ? ((c) < 4 ? 192 - 64 * (c) : 4544 - 64 * (c)) : 64 * (c))
#ifdef MLHOT
#define ML_TBL(cn) ML_TB(0)
#else
#define ML_TBL(cn) ML_TB(cn)
#endif
#define ML_LOADSET(cn, QV, KV, VV, GG) do { const int tbn_ = ML_TBL(cn); \
        _Pragma("unroll") for (int h2 = 0; h2 < 2; ++h2) { const bf16_t* pr_ = proj + (size_t)ml_grow(b, tbn_ + r0 + 32 * h2) * ML_INP; \
            QV[h2] = *(const u32x4*)(pr_ + hh * 64 + c8 * 8); KV[h2] = *(const u32x4*)(pr_ + 512 + hh * 64 + c8 * 8); VV[h2] = *(const u32x4*)(pr_ + 1024 + hh * DV_ML + vh * 64 + c8 * 8); } \
        const float* gp_ = gsb + (size_t)(tbn_ >> 6) * 5 * 64; \
        GG[0] = gp_[lane]; GG[1] = gp_[64 + lane]; GG[2] = gp_[128 + lane]; GG[3] = gp_[192 + lane]; GG[4] = gp_[256]; GG[5] = gp_[257]; } while (0)
#define ML_WRITESET(PBW, QV, KV, VV, GG) do { LAS bf16_t* QLw = QL + (PBW) * (ML_ALT / 2); LAS bf16_t* KLw = KL + (PBW) * (ML_ALT / 2); LAS bf16_t* KETw = KET + (PBW) * (ML_ALT / 2); LAS bf16_t* VTLw = VTL + (PBW) * (ML_ALT / 2); LAS float* GLw = GL + (PBW) * (ML_ALT / 4); \
        _Pragma("unroll") for (int h2 = 0; h2 < 2; ++h2) { const int rr_ = r0 + 32 * h2, sr = dir ? 63 - rr_ : rr_; \
            *(LAS u32x4*)(QLw + sr * ML_LD + c8 * 8) = QV[h2]; *(LAS u32x4*)(KLw + sr * ML_LD + c8 * 8) = KV[h2]; \
            const float es = shfl_(GG[3], sr); float kf[8]; unpack8(KV[h2], kf); const unsigned vw[4] = {VV[h2].x, VV[h2].y, VV[h2].z, VV[h2].w}; \
            _Pragma("unroll") for (int e = 0; e < 8; ++e) { KETw[(c8 * 8 + e) * ML_LD + (sr ^ (8 * c8))] = (bf16_t)pk2(kf[e] * es, 0.f); VTLw[(c8 * 8 + e) * ML_LD + (sr ^ (8 * c8))] = (bf16_t)((vw[e >> 1] >> (16 * (e & 1))) & 0xffffu); } } \
        if (w == 0) { GLw[lane] = GG[0]; GLw[64 + lane] = GG[1]; GLw[128 + lane] = GG[2]; if (lane == 0) { GLw[192] = GG[4]; GLw[193] = GG[5]; } } } while (0)
#define ML_STOREH(cp) do { const int tbp_ = ML_TB(cp); \
        _Pragma("unroll") for (int h2 = 0; h2 < 2; ++h2) { const int rr_ = r0 + 32 * h2; \
            *(u32x4*)(hout + (size_t)ml_grow(b, tbp_ + rr_) * D + c8 * 8) = *(const LAS u32x4*)(HL + rr_ * ML_LD + c8 * 8); } } while (0)
#define ML_CHUNK(c, PB, QV, KV, VV, GG) do {     \
        const int tb = ML_TB(c); \
        LAS bf16_t* QLc = QL + (PB) * (ML_ALT / 2); LAS bf16_t* KLc = KL + (PB) * (ML_ALT / 2); LAS bf16_t* KETc = KET + (PB) * (ML_ALT / 2); LAS bf16_t* VTLc = VTL + (PB) * (ML_ALT / 2); LAS float* GLc = GL + (PB) * (ML_ALT / 4); \
        const float cum = GLc[lane], av = GLc[64 + lane], pmax = GLc[128 + lane], cl = GLc[192], ml = GLc[193]; \
        const float Mv = fmaxf(m0, pmax); \
        const float winter = __expf(m0 - Mv); \
        const float floorv = __expf(-(cum + Mv)); \
        const float mnew = fmaxf(cl + m0, ml); \
        const float Ac = __expf(cl + m0 - mnew), Gc = __expf(ml - mnew); \
        _Pragma("unroll") for (int x = 0; x < 2; ++x) { \
            const int bs = bc0 + x; \
            if (bs <= bt) {     \
                f32x4 acc = (f32x4){0.f, 0.f, 0.f, 0.f}; \
                _Pragma("unroll") for (int ks = 0; ks < 2; ++ks) { const bf16x8 af = *(const LAS bf16x8*)(QLc + (16 * bt + l15) * ML_LD + 32 * ks + 8 * g), bfv = *(const LAS bf16x8*)(KLc + (16 * bs + l15) * ML_LD + 32 * ks + 8 * g); \
                    acc = __builtin_amdgcn_mfma_f32_16x16x32_bf16(af, bfv, acc, 0, 0, 0); } \
                const int s = 16 * bs + l15; \
                const float a_s = shfl_(av, s); \
                _Pragma("unroll") for (int rg = 0; rg < 4; ++rg) { const int t = 16 * bt + 4 * g + rg; const float M_t = shfl_(Mv, t); \
                    const float val = (s <= t) ? acc[rg] * __expf(a_s - M_t) : 0.f; \
                    SDL[t * ML_LD + s] = (bf16_t)pk2(val, 0.f); } \
            } \
        } \
        if (loader) { if ((c) + 1 < TT / 64) ML_WRITESET(1 - (PB), QV, KV, VV, GG); if ((c) + 2 < TT / 64) ML_LOADSET((c) + 2, QV, KV, VV, GG); }     \
        PROFPT(2); __syncthreads(); PROFPT(3);                                                 \
        if (!loader && (c) > 0) ML_STOREH((c) - 1); \
        { \
            const int rr8 = 8 * w + (lane >> 3), part = lane & 7; \
            float sd[8], qf[8], kf[8]; \
            unpack8(*(const LAS u32x4*)(SDL + rr8 * ML_LD + 8 * part), sd); unpack8(*(const LAS u32x4*)(QLc + rr8 * ML_LD + 8 * part), qf); \
            unpack8(*(const LAS u32x4*)(KETc + rr8 * ML_LD + ((8 * part) ^ (8 * ((rr8 >> 3) & 7)))), kf); \
            const f32x4 n0a = *(const LAS f32x4*)(n0L + 8 * part), n0b = *(const LAS f32x4*)(n0L + 8 * part + 4); \
            float rs = ((sd[0] + sd[1]) + (sd[2] + sd[3])) + ((sd[4] + sd[5]) + (sd[6] + sd[7])); \
            float qn = qf[0] * n0a[0] + qf[1] * n0a[1] + qf[2] * n0a[2] + qf[3] * n0a[3] + qf[4] * n0b[0] + qf[5] * n0b[1] + qf[6] * n0b[2] + qf[7] * n0b[3]; \
            float dn = ((kf[0] + kf[1]) + (kf[2] + kf[3])) + ((kf[4] + kf[5]) + (kf[6] + kf[7])); \
            rs = sum8(rs); qn = sum8(qn); dn = sum8(dn); \
            const float w_r = shfl_(winter, rr8); \
            if (part == 0) denL[rr8] = rs + w_r * qn; \
            nst = Ac * nst + Gc * dn; \
        } \
        f32x4 nin[2], nit[2]; \
        _Pragma("unroll") for (int x = 0; x < 2; ++x) { \
            const int bv = bc0 + x; \
            f32x4 a1 = (f32x4){0.f, 0.f, 0.f, 0.f}, a2 = (f32x4){0.f, 0.f, 0.f, 0.f}, a3 = (f32x4){0.f, 0.f, 0.f, 0.f}; \
            _Pragma("unroll") for (int ks = 0; ks < 2; ++ks) { \
                const bf16x8 sdf = *(const LAS bf16x8*)(SDL + (16 * bt + l15) * ML_LD + 32 * ks + 8 * g), vtf = *(const LAS bf16x8*)(VTLc + (16 * bv + l15) * ML_LD + ((32 * ks + 8 * g) ^ (8 * (((16 * bv + l15) >> 3) & 7)))); \
                const bf16x8 qf = *(const LAS bf16x8*)(QLc + (16 * bt + l15) * ML_LD + 32 * ks + 8 * g), c0f = *(const LAS bf16x8*)(C0L + (16 * bv + l15) * ML_LD + 32 * ks + 8 * g); \
                const bf16x8 vt2 = *(const LAS bf16x8*)(VTLc + (16 * bt + l15) * ML_LD + ((32 * ks + 8 * g) ^ (8 * (((16 * bt + l15) >> 3) & 7)))), kef = *(const LAS bf16x8*)(KETc + (16 * bv + l15) * ML_LD + ((32 * ks + 8 * g) ^ (8 * (((16 * bv + l15) >> 3) & 7)))); \
                a1 = __builtin_amdgcn_mfma_f32_16x16x32_bf16(sdf, vtf, a1, 0, 0, 0); \
                a2 = __builtin_amdgcn_mfma_f32_16x16x32_bf16(qf, c0f, a2, 0, 0, 0); \
                a3 = __builtin_amdgcn_mfma_f32_16x16x32_bf16(vt2, kef, a3, 0, 0, 0); \
            } \
            nin[x] = a1; nit[x] = a2; \
            Cst[x] = Cst[x] * Ac + a3 * Gc; \
        } \
        PROFPT(4); __syncthreads(); PROFPT(3);                                                 \
        if ((lane & 7) == 0) n0L[8 * w + (lane >> 3)] = nst; \
        _Pragma("unroll") for (int x = 0; x < 2; ++x) { \
            const int bv = bc0 + x; \
            _Pragma("unroll") for (int rg = 0; rg < 4; ++rg) { const int t = 16 * bt + 4 * g + rg; \
                const float den = denL[t], w_t = shfl_(winter, t), fl_t = shfl_(floorv, t); \
                const float hv = (nin[x][rg] + w_t * nit[x][rg]) * __builtin_amdgcn_rcpf(fmaxf(fabsf(den), fl_t)); \
                const int rr = dir ? 63 - t : t; \
                HL[rr * ML_LD + 16 * bv + l15] = (bf16_t)pk2(hv, 0.f); \
                C0L[(16 * bt + 4 * g + rg) * ML_LD + 16 * bv + l15] = (bf16_t)pk2(Cst[x][rg], 0.f); } \
        } \
        m0 = mnew; \
        (void)tb; PROFPT(5); \
    } while (0)
    if (loader) { ML_LOADSET(0, qA, kA, vA, gA); ML_WRITESET(0, qA, kA, vA, gA); ML_LOADSET(1, qA, kA, vA, gA); }
    __syncthreads();
    for (int c = 0; c < TT / 64; c += 2) {
        ML_CHUNK(c, 0, qA, kA, vA, gA);
        ML_CHUNK(c + 1, 1, qA, kA, vA, gA);
    }
    __syncthreads();
    if (!loader) ML_STOREH(TT / 64 - 1);
#ifdef MLPROF
    if (F.vcu == MLPROF_BLK && tid == MLPROF_WAVE * 64) { unsigned long long* pp = (unsigned long long*)(wsp(F) + WS_CTL + 524288); pp[0] = pa_[0]; pp[1] = pa_[1]; pp[2] = pa_[2]; pp[3] = pa_[3]; pp[4] = pa_[4]; pp[5] = pa_[5]; }
#endif
#undef ML_CHUNK
#undef ML_STOREH
#undef ML_WRITESET
#undef ML_LOADSET
#undef ML_TB
    __syncthreads();
}
__device__ __forceinline__ void phase_ml_scan(Frame& F) {
    for (int task = F.vcu; task < NB * NH_ML * 4; task += F.G) {
        const int vh = task & 1, dir = (task >> 1) & 1, bh = task >> 2;
        ml_task(F, bh >> 3, bh & 7, dir, vh);
    }
}

__device__ __forceinline__ void phase_ml_final(Frame& F, int jm) {
    const int gw = F.vcu * NWAVES + F.wave, NGW = F.G * NWAVES, lane = F.lane;
    const bf16_t* hfw = (const bf16_t*)(wsp(F) + WS_HDIR); const bf16_t* hbw = hfw + (size_t)ROWS * D;
    const bf16_t* proj = (const bf16_t*)(wsp(F) + WS_PROJ);
    bf16_t* ao = (bf16_t*)(wsp(F) + WS_AO);
    const float* gain = inp(F, I_MHGAIN) + jm * D + lane * 16;
    for (int row = gw; row < ROWS; row += NGW) {
        const size_t off = (size_t)row * D + lane * 16;
        float a0[8], a1[8], b0[8], b1[8], g0[8], g1[8];
        unpack8(*(const u32x4*)(hfw + off), a0); unpack8(*(const u32x4*)(hfw + off + 8), a1);
        unpack8(*(const u32x4*)(hbw + off), b0); unpack8(*(const u32x4*)(hbw + off + 8), b1);
        const bf16_t* ogp = proj + (size_t)row * ML_INP + 2048 + lane * 16;
        unpack8(*(const u32x4*)ogp, g0); unpack8(*(const u32x4*)(ogp + 8), g1);
        float ss = 0.f;
#pragma unroll
        for (int e = 0; e < 8; ++e) { a0[e] += b0[e]; a1[e] += b1[e]; ss += a0[e] * a0[e] + a1[e] * a1[e]; }
        ss = sum8(ss);
        const float rs = 1.0f / sqrtf(ss * (1.f / DV_ML) + EPS);
        float o0[8], o1[8];
#pragma unroll
        for (int e = 0; e < 8; ++e) { o0[e] = a0[e] * rs * gain[e] * sigmoidf_(g0[e]); o1[e] = a1[e] * rs * gain[8 + e] * sigmoidf_(g1[e]); }
        *(u32x4*)(ao + off) = pack8(o0); *(u32x4*)(ao + off + 8) = pack8(o1);
    }
}

constexpr int RT_LD = 1032;
constexpr int RT_HI = 0, RT_LO = NE * RT_LD * 2, RT_LG = 2 * NE * RT_LD * 2;
__device__ __forceinline__ int rows_per_block(int first_row, int G) { return (ROWS - first_row + G - 1) / G; }
constexpr int NCB = 32;
__device__ __forceinline__ bool ctx_split(int first_row, int G) { return first_row == 0 && G > 2 * NCB; }
__device__ __forceinline__ void block_rows(int first_row, int vcu, int G, int& rbeg, int& rend) {
    if (ctx_split(first_row, G)) {
        if (vcu < NCB) { const int per = ROWS_CTX / NCB; rbeg = vcu * per; rend = rbeg + per; }
        else { const int per = (ROWS - ROWS_CTX + (G - NCB) - 1) / (G - NCB); rbeg = min(ROWS_CTX + (vcu - NCB) * per, ROWS); rend = min(rbeg + per, ROWS); }
    } else { const int RPB = rows_per_block(first_row, G); rbeg = min(first_row + vcu * RPB, ROWS); rend = min(rbeg + RPB, ROWS); }
}
__device__ __forceinline__ void phase_norm2_router(Frame& F, int l, int first_row) {
    const int tid = F.tid, lane = F.lane, wave = F.wave, l15 = lane & 15, g = lane >> 4;
    LAS bf16_t* whi = (LAS bf16_t*)(F.lds + RT_HI); LAS bf16_t* wlo = (LAS bf16_t*)(F.lds + RT_LO);
    LAS float* lgs = (LAS float*)(F.lds + RT_LG) + wave * (16 * 33);
    volatile LAS int* cntL = F.LCTL + 64;
    {
        const bf16_t* rt = (const bf16_t*)(wsp(F) + WS_RT) + (size_t)l * 2 * NE * D;
#pragma unroll 4
        for (int c = tid; c < 2 * NE * 128; c += NTHREADS) { const int tbl = c >> 12, e = (c >> 7) & 31, kc = c & 127;
            *(LAS u32x4*)((tbl ? wlo : whi) + e * RT_LD + kc * 8) = *(const u32x4*)(rt + ((size_t)tbl * NE + e) * D + kc * 8); }
    }
    if (tid < NE) cntL[tid] = 0;
    const bf16_t* xs = (const bf16_t*)(wsp(F) + WS_XS); bf16_t* hb = (bf16_t*)(wsp(F) + WS_HB);
    int* tope = (int*)(wsp(F) + WS_TOPE); float* topw = (float*)(wsp(F) + WS_TOPW);
    const f32x4* gm = (const f32x4*)(inp(F, I_GFFN) + l * D) + lane;
    int rbeg, rend; block_rows(first_row, F.vcu, F.G, rbeg, rend);
    for (int row = rbeg + wave; row < rend; row += NWAVES) {
        const int mb = row_mb(row);
        const u32x2* xr = (const u32x2*)(xs + (size_t)row * D) + lane;
        f32x4 v[4]; float ss = 0.f;
#pragma unroll
        for (int j = 0; j < 4; ++j) { v[j] = bf4_to_f32(xr[64 * j]); ss += (v[j][0] * v[j][0] + v[j][1] * v[j][1]) + (v[j][2] * v[j][2] + v[j][3] * v[j][3]); }
        const float rs = 1.0f / sqrtf(wave_sum(ss) * (1.f / D) + EPS);
        const f32x4* sh = (const f32x4*)modp(F, l, mb, 3) + lane; const f32x4* sc = (const f32x4*)modp(F, l, mb, 4) + lane;
        u32x2* o8 = (u32x2*)(hb + (size_t)row * D) + lane;
        unsigned* o4 = (unsigned*)(wsp(F) + WS_HB8 + (size_t)row * D) + lane;
#pragma unroll
        for (int j = 0; j < 4; ++j) { const f32x4 h = (v[j] * rs) * gm[64 * j] * (sc[64 * j] + 1.0f) + sh[64 * j];
            u32x2 wv; wv.x = pk2(h[0], h[1]); wv.y = pk2(h[2], h[3]); o8[64 * j] = wv;
            const f32x4 hq = __builtin_elementwise_min(__builtin_elementwise_max(h * 16.0f, (f32x4){-448.f, -448.f, -448.f, -448.f}), (f32x4){448.f, 448.f, 448.f, 448.f});
            o4[64 * j] = pk4_fp8(hq[0], hq[1], hq[2], hq[3]); }
    }
    VM_WAIT();
    __syncthreads();
    const float br0 = inp(F, I_BR)[l * NE + l15], br1 = inp(F, I_BR)[l * NE + 16 + l15];
    for (int g0 = rbeg + 16 * wave; g0 < rend; g0 += 16 * NWAVES) {
        const int arow = min(g0 + l15, rend - 1);
        const bf16_t* ap = hb + (size_t)arow * D + 8 * g;
        f32x4 acc0 = (f32x4){0.f, 0.f, 0.f, 0.f}, acc1 = (f32x4){0.f, 0.f, 0.f, 0.f};
        bf16x8 afr[32];
#pragma unroll
        for (int ks = 0; ks < 32; ++ks) afr[ks] = *(const bf16x8*)(ap + 32 * ks);
#pragma unroll
        for (int ks = 0; ks < 32; ++ks) {
            const bf16x8 af = afr[ks];
            const bf16x8 h0 = *(const LAS bf16x8*)(whi + l15 * RT_LD + 32 * ks + 8 * g), h1 = *(const LAS bf16x8*)(whi + (16 + l15) * RT_LD + 32 * ks + 8 * g);
            const bf16x8 l0 = *(const LAS bf16x8*)(wlo + l15 * RT_LD + 32 * ks + 8 * g), l1 = *(const LAS bf16x8*)(wlo + (16 + l15) * RT_LD + 32 * ks + 8 * g);
            acc0 = __builtin_amdgcn_mfma_f32_16x16x32_bf16(af, h0, acc0, 0, 0, 0); acc1 = __builtin_amdgcn_mfma_f32_16x16x32_bf16(af, h1, acc1, 0, 0, 0);
            acc0 = __builtin_amdgcn_mfma_f32_16x16x32_bf16(af, l0, acc0, 0, 0, 0); acc1 = __builtin_amdgcn_mfma_f32_16x16x32_bf16(af, l1, acc1, 0, 0, 0);
        }
#pragma unroll
        for (int rg = 0; rg < 4; ++rg) { lgs[(4 * g + rg) * 33 + l15] = acc0[rg] + br0; lgs[(4 * g + rg) * 33 + 16 + l15] = acc1[rg] + br1; }
        LDS_WAIT(); asm volatile("" ::: "memory");
        const int row = g0 + lane;
        if (lane < 16 && row < rend) {
            float lg[32];
#pragma unroll
            for (int e = 0; e < 32; ++e) lg[e] = lgs[lane * 33 + e];
            int sel[4]; float sv[4]; unsigned used = 0u;
#pragma unroll
            for (int k = 0; k < 4; ++k) { float best = -3.0e38f; int bi = 0;
#pragma unroll
                for (int e = 0; e < 32; ++e) { const bool take = !((used >> e) & 1u) && (lg[e] > best); best = take ? lg[e] : best; bi = take ? e : bi; }
                used |= 1u << bi; sel[k] = bi; sv[k] = best; }
            const float e1 = __expf(sv[1] - sv[0]), e2 = __expf(sv[2] - sv[0]), e3 = __expf(sv[3] - sv[0]);
            const float inv = 1.0f / (1.0f + e1 + e2 + e3);
            *(int4*)(tope + (size_t)row * 4) = make_int4(sel[0], sel[1], sel[2], sel[3]);
            *(float4*)(topw + (size_t)row * 4) = make_float4(inv, e1 * inv, e2 * inv, e3 * inv);
#pragma unroll
            for (int k = 0; k < 4; ++k) __hip_atomic_fetch_add((LAS int*)&cntL[sel[k]], 1, __ATOMIC_RELAXED, __HIP_MEMORY_SCOPE_WORKGROUP);
        }
        LDS_WAIT(); asm volatile("" ::: "memory");
    }
    __syncthreads();
    if (tid < NE) ((int*)(wsp(F) + WS_CNT))[F.vcu * NE + tid] = cntL[tid];
}

__device__ __forceinline__ void phase_positions(Frame& F, int first_row) {
    const int tid = F.tid, lane = F.lane;
    LAS int* tot = (LAS int*)F.lds;
    LAS int* bef = tot + 512;
    LAS int* baseL = bef + 512;
    LAS int* totL = baseL + 32;
    const int* cnt = (const int*)(wsp(F) + WS_CNT);
    {
        const int e = tid & 31, part = tid >> 5;
        int s = 0, sb = 0;
        for (int j = part; j < F.G; j += 16) { const int cv = cnt[j * NE + e]; s += cv; sb += (j < F.vcu) ? cv : 0; }
        tot[part * 32 + e] = s; bef[part * 32 + e] = sb;
    }
    __syncthreads();
    if (tid < NE) { int s = 0, sb = 0;
        for (int p = 0; p < 16; ++p) { s += tot[p * 32 + tid]; sb += bef[p * 32 + tid]; }
        totL[tid] = s; baseL[tid] = sb; }
    __syncthreads();
    if (F.wave == 0) {
        const int mine = (lane < NE) ? ((totL[lane & 31] + 255) >> 8) : 0;
        int inc = mine;
#pragma unroll
        for (int d = 1; d < 32; d <<= 1) { const int o = shfl_(inc, lane - d); inc += (lane >= d) ? o : 0; }
        if (lane < NE) F.LCTL[8 + lane] = inc - mine;
        if (lane == NE - 1) { F.LCTL[8 + NE] = inc; F.LCTL[48] = inc; }
    }
    __syncthreads();
    int* tokmap = (int*)(wsp(F) + WS_TOKMAP);
    if (F.vcu == 0) {
        int* meta = (int*)(wsp(F) + WS_META);
        if (tid <= NE) meta[tid] = F.LCTL[8 + tid];
        if (tid == 0) meta[33] = F.LCTL[48];
        { const int e = tid >> 4, rb = 256 * F.LCTL[8 + e], n = totL[e], cap = 256 * (F.LCTL[8 + e + 1] - F.LCTL[8 + e]);
            for (int rr = n + (tid & 15); rr < cap; rr += 16) tokmap[rb + rr] = first_row; }
    }
    {
        const int* tope = (const int*)(wsp(F) + WS_TOPE); int* pos = (int*)(wsp(F) + WS_POS);
        const int e0 = 4 * F.wave;
        int basereg = (lane < 4) ? 256 * F.LCTL[8 + e0 + lane] + baseL[e0 + lane] : 0;
        int rbeg, rend; block_rows(first_row, F.vcu, F.G, rbeg, rend);
        for (int r0 = rbeg; r0 < rend; r0 += 16) {
            const int row = r0 + (lane >> 2), k = lane & 3;
            const bool valid = row < rend;
            const int e = valid ? tope[(size_t)row * 4 + k] : -1;
            int p = -1;
#pragma unroll
            for (int j = 0; j < 4; ++j) {
                const unsigned long long mask = __ballot(e == e0 + j);
                const int b0 = shfl_(basereg, j);
                if (e == e0 + j) p = b0 + __popcll(mask & ((1ull << lane) - 1ull));
                if (lane == j) basereg += __popcll(mask);
            }
            if (p >= 0) { pos[(size_t)row * 4 + k] = p; tokmap[p] = row; }
        }
    }
}

#ifndef PMASK
#define PMASK 0xFFFF
#endif
#define PE(k) (((PMASK) >> (k)) & 1)
#ifndef RMASK
#define RMASK 0
#endif
#define RP(k) for (int rep_ = 0; rep_ < ((((RMASK) >> (k)) & 1) ? 2 : 1); ++rep_, __syncthreads())
#ifdef NOEPI
#define SKIPE(k) ((((RMASK) >> (k)) & 1) && rep_ == 0)
#else
#define SKIPE(k) false
#endif
#ifndef P0PROBE
#define P0PROBE 0
#endif
#ifndef MOE_ALIGN
#define MOE_ALIGN true
#endif
constexpr int LDS_TILE_E = pg8::STAGE_BYTES;
constexpr int LDS_TOKL = LDS_TILE_E + MAXTILES * 4;
static_assert(LDS_TOKL + 28 * 1024 <= LDS_CTL_OFF, "LDS map");
__device__ __forceinline__ void moe_tile_table(const Frame& P, const int ntiles) {
    volatile LAS int* te = (volatile LAS int*)(P.lds + LDS_TILE_E);
    for (int t = P.tid; t < ntiles; t += NTHREADS) { int e = 0;
#pragma unroll
        for (int j = 1; j < NE; ++j) e += (P.LCTL[8 + j] <= t) ? 1 : 0;
        te[t] = e; }
    __syncthreads();
}
constexpr int NPH_LAYER = 10, GP_FINAL = 1 + DEPTH * NPH_LAYER, NPHASES = GP_FINAL + 1;
__global__ void __launch_bounds__(NTHREADS, 2) mega_fwd(Args args) {
    extern __shared__ __attribute__((aligned(16))) unsigned char lds_raw[];
    Frame F0;
    Frame& F = F0;
    F.lds = (LAS unsigned char*)lds_raw;
    F.LCTL = (volatile LAS int*)(F.lds + LDS_CTL_OFF);
    F.tid = threadIdx.x; F.lane = F.tid & 63; F.wave = __builtin_amdgcn_readfirstlane(F.tid >> 6);
    F.G = gridDim.x; { const int bx = blockIdx.x; F.vcu = (F.G % 8 == 0) ? (bx % 8) * (F.G / 8) + bx / 8 : bx; }
    if (F.tid < 128) F.LCTL[F.tid] = 0;
    if (F.tid == 0) {
#pragma unroll
        for (int i = 0; i < 23; ++i) { const unsigned long long p = (unsigned long long)args.in[i]; F.LCTL[128 + 2 * i] = (int)(unsigned)p; F.LCTL[129 + 2 * i] = (int)(unsigned)(p >> 32); }
        { const unsigned long long p = (unsigned long long)args.ws; F.LCTL[128 + 46] = (int)(unsigned)p; F.LCTL[129 + 46] = (int)(unsigned)(p >> 32); }
        { const unsigned long long p = (unsigned long long)args.out; F.LCTL[128 + 48] = (int)(unsigned)p; F.LCTL[129 + 48] = (int)(unsigned)(p >> 32); }
    }
    __syncthreads();
    const int lo = args.ph_lo, hi = args.ph_hi;
    XcdBarrier bar; bar.bar = (unsigned*)(wsp(F) + WS_CTL) + CW_BAR; bar.x = 0; bar.st = nullptr; bar.w0 = 0;
    if (hi - lo > 1) bar = xcd_barrier_post((unsigned*)(wsp(F) + WS_CTL) + CW_BAR, (volatile LAS unsigned*)F.LCTL);
#define IN(k) (lo <= (k) && (k) < hi)
#define FRESH(FN) Frame FN = F0; { int tz_ = F0.wave * 64 + lane_id_here(), vc_ = F0.vcu, g_ = F0.G;     asm volatile("" : "+v"(tz_)); asm volatile("" : "+s"(vc_), "+s"(g_)); FN.tid = tz_; FN.lane = tz_ & 63; FN.wave = __builtin_amdgcn_readfirstlane(tz_ >> 6); FN.vcu = vc_; FN.G = g_; }
#ifdef DBLBAR
#define SEAM(k) do { if (IN(k) && IN((k) + 1)) { xcd_barrier(bar); xcd_barrier(bar); } } while (0)
#else
#define SEAM(k) do { if (IN(k) && IN((k) + 1)) xcd_barrier(bar); } while (0)
#endif

    if (PE(0) && IN(0)) RP(0) { FRESH(P); phase0(P, ((((RMASK) >> 0) & 1) && rep_ == 0) ? P0PROBE : 0); }
    SEAM(0);
    for (int l = 0; l < DEPTH; ++l) {
        const int base = 1 + l * NPH_LAYER; const bool na = (l & 1) == 0, last = (l == DEPTH - 1); const int jj = l >> 1;
        if (PE(1) && IN(base + 0)) RP(1) { FRESH(P); phase_norm1(P, l, (((RMASK) >> 1) & 1) && rep_ == 0); }
        SEAM(base + 0);
        if (PE(2) && IN(base + 1)) RP(2) {
            FRESH(P);
            if (na) {
                const bf16_t* Bt = (const bf16_t*)(wsp(P) + WS_WQKV) + (size_t)jj * 3072 * D;
                const bool img_only = proj_split(P.G);
                DenseOrder S; S.init(img_only ? ROWS_CTX / 256 : 0, img_only ? (ROWS - ROWS_CTX) / 256 : ROWS / 256, 3072 / 256, P.G, (int)blockIdx.x, wsp(P) + WS_HB, Bt, D);
                EpiStoreBf16 E{(bf16_t*)(wsp(P) + WS_PROJ), 3072};
                pg8::gemm_phase<EpiStoreBf16, DenseOrder, false>(P.lds, P.tid, D, S, E, SKIPE(2));
            } else {
                const bf16_t* Bt = (const bf16_t*)(wsp(P) + WS_WIN) + (size_t)jj * ML_INP * D;
                DenseOrder S; S.init(0, ROWS / 256, ML_INP / 256, P.G, (int)blockIdx.x, wsp(P) + WS_HB, Bt, D);
                EpiProjML E{(bf16_t*)(wsp(P) + WS_PROJ), (const float*)(wsp(P) + WS_ROPE)};
                pg8::gemm_phase<EpiProjML, DenseOrder, false>(P.lds, P.tid, D, S, E, SKIPE(2));
            }
        }
        SEAM(base + 1);
        if (IN(base + 2) && na && PE(3)) {
            FRESH(P);
            if (proj_split(P.G) && P.vcu < NCBP) {
                const bf16_t* Bt = (const bf16_t*)(wsp(P) + WS_WQKV) + (size_t)jj * 3072 * D;
                DenseOrder S; S.init(0, ROWS_CTX / 256, 3072 / 256, NCBP, P.vcu, wsp(P) + WS_HB, Bt, D);
                EpiStoreBf16 E{(bf16_t*)(wsp(P) + WS_PROJ), 3072};
                pg8::gemm_phase<EpiStoreBf16, DenseOrder, false>(P.lds, P.tid, D, S, E);
                group_sync((unsigned*)(wsp(P) + WS_CTL) + CW_GSYNC + 64 * (DEPTH + l), NCBP, (unsigned*)(wsp(P) + WS_CTL) + CW_BAR, P.wave == 0);
            }
        }
        if (IN(base + 2)) { if (na) {   } else { if (PE(4)) RP(4) { FRESH(P); phase_ml_post(P, jj); } } }
        if (!na) SEAM(base + 2);
        if (IN(base + 3)) { if (na) { if (PE(5)) RP(5) { FRESH(P); phase_na_attn(P, jj); } } else { if (PE(6)) RP(6) { FRESH(P); phase_ml_scan(P); } } }
        SEAM(base + 3);
        if (PE(7) && IN(base + 4)) { if (!na) RP(7) { FRESH(P); phase_ml_final(P, jj); } }
        if (!na) SEAM(base + 4);
        if (PE(8) && IN(base + 5)) RP(8) {
            FRESH(P);
            const bf16_t* Bt = na ? (const bf16_t*)(wsp(P) + WS_WONA) + (size_t)jj * D * D : (const bf16_t*)(wsp(P) + WS_WOML) + (size_t)jj * D * D;
            const bool img_only = last || ctx_split(0, P.G);
            DenseOrder S; S.init(img_only ? ROWS_CTX / 256 : 0, img_only ? (ROWS - ROWS_CTX) / 256 : ROWS / 256, D / 256, P.G, (int)blockIdx.x, wsp(P) + WS_AO, Bt, D);
            EpiResid E{((((RMASK) >> 8) & 1) && rep_ == 0) ? (bf16_t*)(wsp(P) + WS_Y) : (bf16_t*)(wsp(P) + WS_XS), (const float*)(wsp(P) + WS_MOD) + (size_t)l * 9 * 6144 + 2 * D};
            pg8::gemm_phase<EpiResid, DenseOrder, false>(P.lds, P.tid, D, S, E, SKIPE(8));
        }
        SEAM(base + 5);
        if (PE(9) && IN(base + 6) && !last) {
            FRESH(P);
            if (ctx_split(0, P.G) && P.vcu < NCB) {
                const bf16_t* Bt = na ? (const bf16_t*)(wsp(P) + WS_WONA) + (size_t)jj * D * D : (const bf16_t*)(wsp(P) + WS_WOML) + (size_t)jj * D * D;
                DenseOrder S; S.init(0, ROWS_CTX / 256, D / 256, NCB, P.vcu, wsp(P) + WS_AO, Bt, D);
                EpiResid E{(bf16_t*)(wsp(P) + WS_XS), (const float*)(wsp(P) + WS_MOD) + (size_t)l * 9 * 6144 + 2 * D};
                pg8::gemm_phase<EpiResid, DenseOrder, false>(P.lds, P.tid, D, S, E);
                group_sync((unsigned*)(wsp(P) + WS_CTL) + CW_GSYNC + 64 * l, NCB, (unsigned*)(wsp(P) + WS_CTL) + CW_BAR, P.wave == 0);
            }
        }
        if (PE(9) && IN(base + 6)) RP(9) { FRESH(P); phase_norm2_router(P, l, last ? ROWS_CTX : 0); }
        SEAM(base + 6);
        if (PE(10) && IN(base + 7)) RP(10) { FRESH(P); phase_positions(P, last ? ROWS_CTX : 0); }
        SEAM(base + 7);
        if (PE(11) && IN(base + 8)) RP(11) {
            FRESH(P);
            if (P.tid < 34) P.LCTL[8 + P.tid] = ((const int*)(wsp(P) + WS_META))[P.tid];
            __syncthreads();
            const int ntiles = P.LCTL[8 + NE];
            moe_tile_table(P, ntiles);
            MoeOrder S; S.NT = 8; S.nunits = ntiles * 8; S.G = P.G; S.c = (int)blockIdx.x; S.K = D / 2; S.A = (const char*)(wsp(P) + WS_HB8);
            S.W = (const char*)(wsp(P) + WS_W1T) + (size_t)l * NE * 2048 * D; S.estride = (size_t)2048 * D; S.tokmap = (const int*)(wsp(P) + WS_TOKMAP); S.prefix = P.LCTL + 8; S.tile_e = (volatile LAS int*)(P.lds + LDS_TILE_E); S.tokl = (volatile LAS int*)(P.lds + LDS_TOKL); S.gather = true;
            { const int half = P.wave >> 2, r = P.tid & 255;
              for (int i = half; i < 28; i += 2) { pg8::Unit u; if (!S.next(i, u)) break; S.tokl[i * 256 + r] = S.tokmap[u.pm * 256 + r]; }
              __syncthreads(); }
            EpiSwiglu E{(unsigned char*)(wsp(P) + WS_ACT), inp(P, I_B1) + (size_t)l * NE * 2048};
#ifdef KPROBE
            if (SKIPE(11)) pg8::gemm_phase<EpiSwiglu, MoeOrder, true, true, MOE_ALIGN, KPROBE>(P.lds, P.tid, D / 2, S, E, true); else
#endif
            pg8::gemm_phase<EpiSwiglu, MoeOrder, true, true, MOE_ALIGN>(P.lds, P.tid, D / 2, S, E, SKIPE(11));
        }
        SEAM(base + 8);
        if (PE(12) && IN(base + 9)) RP(12) {
            FRESH(P);
            if (P.tid < 34) P.LCTL[8 + P.tid] = ((const int*)(wsp(P) + WS_META))[P.tid];
            __syncthreads();
            const int ntiles = P.LCTL[8 + NE];
            moe_tile_table(P, ntiles);
            MoeOrder S; S.NT = 4; S.nunits = ntiles * 4; S.G = P.G; S.c = (int)blockIdx.x; S.K = D / 2; S.A = (const char*)(wsp(P) + WS_ACT);
            S.W = (const char*)(wsp(P) + WS_W2T) + (size_t)l * NE * D * D; S.estride = (size_t)D * D; S.tokmap = (const int*)(wsp(P) + WS_TOKMAP); S.prefix = P.LCTL + 8; S.tile_e = (volatile LAS int*)(P.lds + LDS_TILE_E); S.tokl = (volatile LAS int*)(P.lds + LDS_TOKL); S.gather = false;
            EpiY E{(bf16_t*)(wsp(P) + WS_Y), inp(P, I_B2) + (size_t)l * NE * D};
            pg8::gemm_phase<EpiY, MoeOrder, true, true, MOE_ALIGN>(P.lds, P.tid, D / 2, S, E, SKIPE(12));
        }
        SEAM(base + 9);
    }
    if (PE(13) && IN(GP_FINAL)) RP(13) { FRESH(P); phase_final(P); }
#undef IN
#undef SEAM
}

extern "C" void kernel_launch(void* const* d_in, const int* in_sizes, int n_in, void* d_out, int out_size, void* d_ws, size_t ws_size, hipStream_t stream) {
    static int grid = 0;
    if (grid == 0) {
        if (n_in != 23 || ws_size < WS_END) { fprintf(stderr, "kernel_launch: expected 23 inputs and >= %zu bytes of workspace (got %d, %zu)\n", (size_t)WS_END, n_in, ws_size); grid = -1; return; }
        int dev = 0, cus = 0, per_cu = 0;
        if (hipGetDevice(&dev) != hipSuccess || hipDeviceGetAttribute(&cus, hipDeviceAttributeMultiprocessorCount, dev) != hipSuccess) { grid = -1; return; }
        if (hipFuncSetAttribute((const void*)mega_fwd, hipFuncAttributeMaxDynamicSharedMemorySize, LDS_BYTES) != hipSuccess) { fprintf(stderr, "kernel_launch: hipFuncSetAttribute failed\n"); grid = -1; return; }
        if (hipOccupancyMaxActiveBlocksPerMultiprocessor(&per_cu, (const void*)mega_fwd, NTHREADS, LDS_BYTES) != hipSuccess || per_cu < 1)
            fprintf(stderr, "kernel_launch: occupancy query reports %d workgroups per CU\n", per_cu);
        (void)hipGetLastError();
        grid = cus;
        if (grid > 1024) grid = 1024;
    }
    if (grid < 0) return;
    (void)hipMemsetAsync((char*)d_ws + WS_CTL, 0, CTL_BYTES, stream);
    Args a{};
    for (int i = 0; i < 23; ++i) a.in[i] = (const float*)d_in[i];
    a.out = (float*)d_out; a.ws = (unsigned char*)d_ws;
#if MK_ONE_LAUNCH
    a.ph_lo = 0; a.ph_hi = NPHASES;
    hipLaunchKernelGGL(mega_fwd, dim3(grid), dim3(NTHREADS), LDS_BYTES, stream, a);
#else
    for (int gp = 0; gp < NPHASES; ++gp) {
        if (gp >= 1 && gp < GP_FINAL) { const int l = (gp - 1) / NPH_LAYER, p = (gp - 1) % NPH_LAYER; if (p == 4 && (l & 1) == 0) continue; }
        a.ph_lo = gp; a.ph_hi = gp + 1;
        hipLaunchKernelGGL(mega_fwd, dim3(grid), dim3(NTHREADS), LDS_BYTES, stream, a);
    }
#endif
    const hipError_t le = hipPeekAtLastError();
    if (le != hipSuccess) fprintf(stderr, "kernel_launch: launch failed: %s\n", hipGetErrorName(le));
}
```

```cpp
#include <hip/hip_runtime.h>
#include <cstdio>
#include <cstdint>

#ifndef MK_ONE_LAUNCH
#define MK_ONE_LAUNCH 1
#endif

#define LAS __attribute__((address_space(3)))
#define GAS __attribute__((address_space(1)))
typedef unsigned short bf16_t;
typedef short bf16x8 __attribute__((ext_vector_type(8)));
typedef short bf16x4 __attribute__((ext_vector_type(4)));
typedef float f32x4 __attribute__((ext_vector_type(4)));
typedef float f32x2 __attribute__((ext_vector_type(2)));
typedef unsigned u32x4 __attribute__((ext_vector_type(4)));
typedef unsigned u32x2 __attribute__((ext_vector_type(2)));

constexpr int D = 1024, NB = 8, SEQ = 4096, NCTX = 256, TT = NCTX + SEQ  , DEPTH = 4;
constexpr int ROWS_CTX = NB * NCTX  , ROWS = ROWS_CTX + NB * SEQ  ;
constexpr int NH_NA = 16, DH_NA = 64;
constexpr int NH_ML = 8, DV_ML = 128, DK_ML = 64, ML_IN = 3104, ML_INP = 3328;
constexpr int NE = 32, TOPK = 4, DFF = 1024;
constexpr int MAXTILES = (ROWS * TOPK) / 256 + NE  , MAXROWS = MAXTILES * 256;
constexpr float EPS = 1e-6f;
constexpr int NWAVES = 8, NTHREADS = 512;

constexpr size_t MiB = 1u << 20;
constexpr size_t al256(size_t x) { return (x + 255) & ~(size_t)255; }
constexpr size_t WS_CTL = 0, CTL_BYTES = 1 * MiB;
constexpr size_t WS_MOD = WS_CTL + CTL_BYTES;
constexpr size_t WS_ROPE = WS_MOD + al256((size_t)DEPTH * 9 * 6 * D * 4);
constexpr size_t WS_WQKV = WS_ROPE + al256(64 * 16 * 2 * 4);
constexpr size_t WS_WONA = WS_WQKV + (size_t)2 * 3072 * D * 2;
constexpr size_t WS_WIN = WS_WONA + (size_t)2 * D * D * 2;
constexpr size_t WS_WOML = WS_WIN + (size_t)2 * ML_INP * D * 2;
constexpr size_t WS_W1T = WS_WOML + (size_t)2 * D * D * 2;
constexpr size_t WS_W2T = WS_W1T + (size_t)DEPTH * NE * 2048 * D * 2;
constexpr size_t WS_XS = WS_W2T + (size_t)DEPTH * NE * D * D * 2;
constexpr size_t WS_HB = WS_XS + (size_t)ROWS * D * 4;
constexpr size_t WS_PROJ = WS_HB + (size_t)ROWS * D * 2;
constexpr size_t WS_QN = WS_PROJ + (size_t)ROWS * ML_INP * 2;
constexpr size_t WS_KN = WS_QN + (size_t)ROWS * D * 2;
constexpr size_t WS_VT = WS_KN + (size_t)ROWS * D * 2;
constexpr size_t WS_AO = WS_VT + (size_t)ROWS * D * 2;
constexpr size_t WS_HDIR = WS_QN;
constexpr size_t WS_GATES = WS_AO + (size_t)ROWS * D * 2;
constexpr size_t WS_TOPE = WS_GATES + al256((size_t)4 * NB * NH_ML * TT * 4);
constexpr size_t WS_TOPW = WS_TOPE + (size_t)ROWS * 4 * 4;
constexpr size_t WS_POS = WS_TOPW + (size_t)ROWS * 4 * 4;
constexpr size_t WS_TOKMAP = WS_POS + (size_t)ROWS * 4 * 4;
constexpr size_t WS_CNT = WS_TOKMAP + (size_t)MAXROWS * 4;
constexpr size_t WS_META = WS_CNT + (size_t)1024 * 32 * 4;
constexpr size_t WS_ACT = WS_META + 256;
constexpr size_t WS_Y = WS_ACT + (size_t)MAXROWS * D * 2;
constexpr size_t WS_HB8 = WS_Y + (size_t)MAXROWS * D * 2;
constexpr size_t WS_GS = WS_HB8 + (size_t)ROWS * D;
constexpr size_t WS_RT = WS_GS + (size_t)2 * NB * NH_ML * (TT / 64) * 5 * 64 * 4;
constexpr size_t WS_END = WS_RT + (size_t)DEPTH * 2 * NE * D * 2;
static_assert(WS_XS % 256 == 0 && WS_ACT % 256 == 0 && WS_TOPE % 256 == 0, "ws alignment");

constexpr int CW_BAR = 4096;
constexpr int CW_GSYNC = 8192;

constexpr int LDS_BYTES = 160 * 1024;
constexpr int LDS_CTL_OFF = LDS_BYTES - 1024;
constexpr int LDS_WORK = LDS_CTL_OFF;

__device__ __forceinline__ int lane_id_here() { int l; asm volatile("v_mbcnt_lo_u32_b32 %0, -1, 0\n\tv_mbcnt_hi_u32_b32 %0, -1, %0" : "=v"(l)); return l; }
#define LDS_WAIT() asm volatile("s_waitcnt lgkmcnt(0)" ::: "memory")
#define VM_WAIT() asm volatile("s_waitcnt vmcnt(0)" ::: "memory")
__device__ __forceinline__ unsigned f2bf(float f) { unsigned u = __builtin_bit_cast(unsigned, f); return (u + 0x7fffu + ((u >> 16) & 1u)) >> 16; }
__device__ __forceinline__ unsigned pk2(float lo, float hi) { unsigned r; asm volatile("v_cvt_pk_bf16_f32 %0, %1, %2" : "=v"(r) : "v"(lo), "v"(hi)); return r; }
__device__ __forceinline__ unsigned pk4_fp8(float a, float b, float c, float d) { int p = __builtin_amdgcn_cvt_pk_fp8_f32(a, b, 0, false); p = __builtin_amdgcn_cvt_pk_fp8_f32(c, d, p, true); return (unsigned)p; }
__device__ __forceinline__ float bf2f(unsigned short b) { return __builtin_bit_cast(float, ((unsigned)b) << 16); }
__device__ __forceinline__ float bflo(unsigned w) { return __builtin_bit_cast(float, w << 16); }
__device__ __forceinline__ float bfhi(unsigned w) { return __builtin_bit_cast(float, w & 0xffff0000u); }
template <int CTRL> __device__ __forceinline__ float dpp_f(float v) { return __builtin_bit_cast(float, __builtin_amdgcn_update_dpp(0, __builtin_bit_cast(int, v), CTRL, 0xF, 0xF, false)); }
__device__ __forceinline__ float sum8(float v) { v += dpp_f<0xB1>(v); v += dpp_f<0x4E>(v); v += dpp_f<0x141>(v); return v; }
__device__ __forceinline__ float max8(float v) { v = fmaxf(v, dpp_f<0xB1>(v)); v = fmaxf(v, dpp_f<0x4E>(v)); v = fmaxf(v, dpp_f<0x141>(v)); return v; }
__device__ __forceinline__ float rdl(float v, int l) { return __builtin_bit_cast(float, __builtin_amdgcn_readlane(__builtin_bit_cast(int, v), l)); }
__device__ __forceinline__ f32x4 bf4_to_f32(const u32x2 w) { return (f32x4){bflo(w.x), bfhi(w.x), bflo(w.y), bfhi(w.y)}; }
__device__ __forceinline__ float wave_sum(float v) {
    v = sum8(v); v += dpp_f<0x140>(v);
    return (rdl(v, 0) + rdl(v, 16)) + (rdl(v, 32) + rdl(v, 48));
}
__device__ __forceinline__ float wave_max(float v) {
    v = max8(v); v = fmaxf(v, dpp_f<0x140>(v));
    return fmaxf(fmaxf(rdl(v, 0), rdl(v, 16)), fmaxf(rdl(v, 32), rdl(v, 48)));
}
__device__ __forceinline__ int shfl_(int v, int src) { return __builtin_amdgcn_ds_bpermute(src << 2, v); }
__device__ __forceinline__ float shfl_(float v, int src) { return __builtin_bit_cast(float, __builtin_amdgcn_ds_bpermute(src << 2, __builtin_bit_cast(int, v))); }
__device__ __forceinline__ float sigmoidf_(float x) { return __builtin_amdgcn_rcpf(1.f + __builtin_amdgcn_exp2f(-1.44269504f * x)); }

namespace pg8 {
constexpr int BM = 256, BK = 64, HALF = 128, HTB = HALF * BK * 2  , STAGE_BYTES = 8 * HTB;
__host__ __device__ __forceinline__ int lds_byte(int r, int c) { const int st = (r >> 4) * 2 + (c >> 5), rr = r & 15, cc = c & 31, ob = rr * 64 + cc * 2; return st * 1024 + (ob ^ (((ob >> 9) & 1) << 5)); }
__host__ __device__ __forceinline__ void stage_rc(int b, int& R, int& C) { const int st = b / 1024, sb = b % 1024, swz = sb ^ (((sb >> 9) & 1) << 5); R = (st >> 1) * 16 + swz / 64; C = (st & 1) * 32 + (swz % 64) / 2; }
__host__ __device__ __forceinline__ int perm32(int rho) { const int n = rho >> 4, i = rho & 15; return 8 * (i >> 2) + 4 * n + (i & 3); }

struct Unit { int pm, pn, e, slot; };

typedef int v8i32 __attribute__((ext_vector_type(8)));
__device__ __forceinline__ v8i32 cat8(const bf16x8 a, const bf16x8 b) { union { bf16x8 h[2]; v8i32 v; } u; u.h[0] = a; u.h[1] = b; return u.v; }
__device__ __forceinline__ unsigned cvt_pk_bf16(float lo, float hi) { unsigned r; asm volatile("v_cvt_pk_bf16_f32 %0, %1, %2" : "=v"(r) : "v"(lo), "v"(hi)); return r; }

#ifndef PG8_ALIGN
#define PG8_ALIGN true
#endif
#ifndef FP8_PRIO
#define FP8_PRIO true
#endif
template <class Epi, class Sched, bool GATHER, bool FP8 = false, bool ALIGN_EPI = PG8_ALIGN, int KPROBE_ = 0>
__device__ __forceinline__ void gemm_phase(LAS unsigned char* lds, const int tid, const int K, const Sched& S, const Epi& E, const bool skip_epi = false) {
    const int wid = __builtin_amdgcn_readfirstlane(tid >> 6), lane = tid & 63, wr = wid >> 2, wc = wid & 3, fr = lane & 15, fq = lane >> 4;
    const int nt = K / BK;
    unsigned voffB[2], voffA[2][2];
#pragma unroll
    for (int i = 0; i < 2; ++i) { int R, C; stage_rc(tid * 16 + i * 8192, R, C); const int Rb = Epi::PERM ? ((R & ~31) + perm32(R & 31)) : R;
        voffB[i] = (unsigned)(Rb * K + C) * 2u; }
    const size_t kstep = (size_t)(BK * 2);
    const size_t hstep = (size_t)HALF * K * 2;
    const unsigned ldsw = (unsigned)wid * 1024u;
    const int aoff = lds_byte(wr * 64 + fr, fq * 8), boff = lds_byte(wc * 32 + fr, fq * 8);
#define PG8_SA(b, h) (((b) * 2 + (h)) * HTB)
#define PG8_SB(b, h) ((4 + (b) * 2 + (h)) * HTB)
#define PG8_STAGE(bufoff, gbase, voff) do { _Pragma("unroll") for (int _i = 0; _i < 2; ++_i) \
        __builtin_amdgcn_global_load_lds((const unsigned*)((const char*)(gbase) + (voff)[_i]), (LAS unsigned*)(lds + (bufoff) + ldsw + _i * 8192), 16, 0, 0); } while (0)
#define PG8_LDA(dst, b, h) do { if constexpr (KPROBE_ == 2) break; _Pragma("unroll") for (int m = 0; m < 4; ++m) _Pragma("unroll") for (int k = 0; k < 2; ++k) dst[m][k] = *(const LAS bf16x8*)(lds + PG8_SA(b, h) + aoff + m * 2048 + k * 1024); } while (0)
#define PG8_LDB(dst, b, h) do { if constexpr (KPROBE_ == 2) break; _Pragma("unroll") for (int n = 0; n < 2; ++n) _Pragma("unroll") for (int k = 0; k < 2; ++k) dst[n][k] = *(const LAS bf16x8*)(lds + PG8_SB(b, h) + boff + n * 2048 + k * 1024); } while (0)
#define PG8_MMA(ai, bj, At, Bt) do { if constexpr (!FP8 || FP8_PRIO) __builtin_amdgcn_s_setprio(1); else __builtin_amdgcn_s_setprio(0); _Pragma("unroll") for (int m = 0; m < 4; ++m) _Pragma("unroll") for (int n = 0; n < 2; ++n) { \
        if constexpr (KPROBE_ == 1) { asm volatile("" :: "v"(At[m][0]), "v"(At[m][1]), "v"(Bt[n][0]), "v"(Bt[n][1])); } else if constexpr (KPROBE_ == 2) { } else \
        if constexpr (FP8) { acc[ai][bj][m][n] = __builtin_amdgcn_mfma_scale_f32_16x16x128_f8f6f4(cat8(Bt[n][0], Bt[n][1]), cat8(At[m][0], At[m][1]), acc[ai][bj][m][n], 0, 0, 0, 0x7f7f7f7f, 0, 0x7f7f7f7f); } \
        else { _Pragma("unroll") for (int k = 0; k < 2; ++k) acc[ai][bj][m][n] = __builtin_amdgcn_mfma_f32_16x16x32_bf16(Bt[n][k], At[m][k], acc[ai][bj][m][n], 0, 0, 0); } } \
        __builtin_amdgcn_s_setprio(0); } while (0)
#define PG8_WAIT_V(n) asm volatile("s_waitcnt vmcnt(" #n ")" ::: "memory")
#define PG8_WAIT_VP do { if constexpr (Epi::PREFETCH) { if (pf) PG8_WAIT_V(10); else PG8_WAIT_V(8); } else PG8_WAIT_V(8); } while (0)
#define PG8_WAIT_L(n) asm volatile("s_waitcnt lgkmcnt(" #n ")" ::: "memory")
#define PG8_BAR __builtin_amdgcn_s_barrier()
#define PG8_SCHED __builtin_amdgcn_sched_barrier(0)
#define PG8_SETVOFF(u) do { _Pragma("unroll") for (int _i = 0; _i < 2; ++_i) { int RA_, CA_; stage_rc(tid * 16 + _i * 8192, RA_, CA_);     \
        _Pragma("unroll") for (int _h = 0; _h < 2; ++_h) { \
        if constexpr (GATHER) voffA[_h][_i] = ((unsigned)S.a_row(u, _h * HALF + RA_) * (unsigned)K + (unsigned)CA_) * 2u; \
        else voffA[_h][_i] = ((unsigned)(_h * HALF + RA_) * (unsigned)K + (unsigned)CA_) * 2u; } } } while (0)
    Unit cur, nxt; int ui = 0;
    if (!S.next(0, cur)) return;
    f32x4 acc[2][2][4][2];
#pragma unroll
    for (int a = 0; a < 2; ++a)
#pragma unroll
        for (int b = 0; b < 2; ++b)
#pragma unroll
            for (int m = 0; m < 4; ++m)
#pragma unroll
                for (int n = 0; n < 2; ++n) acc[a][b][m][n] = (f32x4){0.f, 0.f, 0.f, 0.f};
    bf16x8 At[4][2], B0[2][2], B1[2][2];
    const char* cA = S.a_base(cur); const char* cB = S.b_base(cur);
    PG8_SETVOFF(cur);
    PG8_STAGE(PG8_SB(0, 0), cB, voffB); PG8_STAGE(PG8_SB(0, 1), cB + hstep, voffB); PG8_STAGE(PG8_SA(0, 0), cA, voffA[0]); PG8_STAGE(PG8_SA(0, 1), cA, voffA[1]);
    if (wr == 1) PG8_BAR;
    PG8_WAIT_V(2); PG8_BAR;
    PG8_STAGE(PG8_SB(1, 0), cB + kstep, voffB); PG8_STAGE(PG8_SA(1, 0), cA + kstep, voffA[0]); PG8_STAGE(PG8_SB(1, 1), cB + hstep + kstep, voffB);
    PG8_WAIT_V(6); PG8_BAR;
    for (;;) {
        const bool has_next = S.next(ui + 1, nxt);
        const char* nA = has_next ? S.a_base(nxt) : cA; const char* nB = has_next ? S.b_base(nxt) : cB;
#pragma unroll 1
        for (int t = 0; t < nt; t += 2) {
            const bool last = (t == nt - 2);
            const char* a1 = cA + (size_t)(t + 1) * kstep;
            const char* a2 = last ? nA : cA + (size_t)(t + 2) * kstep; const char* b2 = last ? nB : cB + (size_t)(t + 2) * kstep;
            const char* a3 = a2 + kstep; const char* b3 = b2 + kstep;
            bool pf = false;
            if constexpr (Epi::PREFETCH) { pf = (t == ((nt / 2) & ~1)); if (pf) E.prefetch(cur, wid * 64 + lane_id_here(), lds); }
            PG8_LDB(B0, 0, 0); PG8_LDB(B1, 0, 1); PG8_SCHED; PG8_LDA(At, 0, 0); PG8_STAGE(PG8_SA(1, 1), a1, voffA[1]);
            if constexpr (GATHER) { if (last && has_next) PG8_SETVOFF(nxt); }
            PG8_WAIT_VP; PG8_WAIT_L(0); PG8_BAR; PG8_MMA(0, 0, At, B0); PG8_MMA(0, 1, At, B1); PG8_BAR; PG8_SCHED;
            PG8_LDA(At, 0, 1); PG8_STAGE(PG8_SB(0, 0), b2, voffB); PG8_STAGE(PG8_SB(0, 1), b2 + hstep, voffB); PG8_STAGE(PG8_SA(0, 0), a2, voffA[0]);
            PG8_WAIT_VP; PG8_WAIT_L(0); PG8_BAR; PG8_MMA(1, 0, At, B0); PG8_MMA(1, 1, At, B1); PG8_BAR; PG8_SCHED;
            PG8_LDB(B0, 1, 0); PG8_LDB(B1, 1, 1); PG8_SCHED; PG8_LDA(At, 1, 0); PG8_STAGE(PG8_SA(0, 1), a2, voffA[1]);
            PG8_WAIT_VP; PG8_WAIT_L(0); PG8_BAR; PG8_MMA(0, 0, At, B0); PG8_MMA(0, 1, At, B1); PG8_BAR; PG8_SCHED;
            PG8_LDA(At, 1, 1); PG8_STAGE(PG8_SB(1, 0), b3, voffB); PG8_STAGE(PG8_SB(1, 1), b3 + hstep, voffB); PG8_STAGE(PG8_SA(1, 0), a3, voffA[0]);
            PG8_WAIT_V(8); PG8_WAIT_L(0); PG8_BAR; PG8_MMA(1, 0, At, B0); PG8_MMA(1, 1, At, B1); PG8_BAR; PG8_SCHED;
        }
        if constexpr (ALIGN_EPI) { if (wr == 0) PG8_BAR; }
        if (!skip_epi) E(acc, cur, wr, wc, fr, fq);
        if (!has_next) break;
#pragma unroll
        for (int a = 0; a < 2; ++a)
#pragma unroll
            for (int b = 0; b < 2; ++b)
#pragma unroll
                for (int m = 0; m < 4; ++m)
#pragma unroll
                    for (int n = 0; n < 2; ++n) acc[a][b][m][n] = (f32x4){0.f, 0.f, 0.f, 0.f};
        cur = nxt; cA = nA; cB = nB; ++ui;
        if constexpr (ALIGN_EPI) { if (wr == 1) PG8_BAR; }
    }
    PG8_WAIT_V(0);
    if constexpr (!ALIGN_EPI) { if (wr == 0) PG8_BAR; }
    PG8_BAR;
#undef PG8_SA
#undef PG8_SB
#undef PG8_STAGE
#undef PG8_LDA
#undef PG8_LDB
#undef PG8_MMA
#undef PG8_WAIT_V
#undef PG8_WAIT_VP
#undef PG8_WAIT_L
#undef PG8_BAR
#undef PG8_SCHED
#undef PG8_SETVOFF
}
}

#define XB_TMO      128
#define XB_XCNT(j)  (256  + 64 * (j))
#define XB_XSUB(j)  (1280 + 64 * (j))
#define XB_XGEN(j)  (2304 + 64 * (j))
#define XB_TOP      3328
#define XB_TOPGEN   3392
#define XCD_BAR_WORDS 3456
#define XB_SPIN_CAP (1u << 18)

__device__ __forceinline__ unsigned xb_ld(unsigned* p)              { return __hip_atomic_load(p, __ATOMIC_RELAXED, __HIP_MEMORY_SCOPE_AGENT); }
__device__ __forceinline__ unsigned xb_add(unsigned* p, unsigned v) { return __hip_atomic_fetch_add(p, v, __ATOMIC_RELAXED, __HIP_MEMORY_SCOPE_AGENT); }
__device__ __forceinline__ unsigned xb_xcc_id() { return (unsigned)__builtin_amdgcn_s_getreg((3 << 11) | 20) & 0xFu; }
#define XB_SPIN(cond, bar) do { unsigned _sp = 0; while (cond) { __builtin_amdgcn_s_sleep(1); \
    if ((++_sp & 255u) == 0u) { if (xb_ld(&(bar)[XB_TMO])) break; if (_sp > XB_SPIN_CAP) { atomicAdd(&(bar)[XB_TMO], 1u); break; } } } } while (0)

struct XcdBarrier {
    unsigned* bar; unsigned x;
    unsigned w0;
    volatile LAS unsigned* st;
};

__device__ __forceinline__ XcdBarrier xcd_barrier_post(unsigned* bar, volatile LAS unsigned* st) {
    XcdBarrier b; b.bar = bar; b.x = xb_xcc_id(); b.st = st; b.w0 = ((unsigned)__builtin_amdgcn_readfirstlane((int)threadIdx.x) < 64u) ? 1u : 0u;
    if (threadIdx.x == 0) (void)xb_add(&bar[XB_XCNT(b.x)], 1u);
    return b;
}
__device__ __forceinline__ void xcd_barrier_complete(unsigned* bar, unsigned x, unsigned& nloc, unsigned& nx) {
    const unsigned G = gridDim.x * gridDim.y * gridDim.z;
    unsigned sum, cnt, mine, sp = 0u;
    for (;;) {
        sum = 0u; cnt = 0u; mine = 0u;
#pragma unroll
        for (unsigned j = 0; j < 16; ++j) { const unsigned c = xb_ld(&bar[XB_XCNT(j)]); sum += c; cnt += (c > 0u) ? 1u : 0u; mine = (j == x) ? c : mine; }
        if (sum == G) break;
        __builtin_amdgcn_s_sleep(1);
        if ((++sp & 255u) == 0u) { if (xb_ld(&bar[XB_TMO])) break; if (sp > XB_SPIN_CAP) { atomicAdd(&bar[XB_TMO], 1u); break; } }
    }
    nloc = mine > 0u ? mine : 1u; nx = cnt > 0u ? cnt : 1u;
}

__device__ __forceinline__ void xcd_barrier(const XcdBarrier& b) {
    asm volatile("s_waitcnt vmcnt(0)" ::: "memory");
    __syncthreads();
    if (b.w0 && lane_id_here() == 0) {
        unsigned* bar = b.bar;
        __builtin_amdgcn_s_waitcnt(0);
        unsigned nloc = b.st[0], nx = b.st[1];
        if (nloc == 0u) { xcd_barrier_complete(bar, b.x, nloc, nx); b.st[0] = nloc; b.st[1] = nx; }
        const unsigned old = xb_add(&bar[XB_XSUB(b.x)], 1u);
        const unsigned gen = old / nloc;
        if (old + 1u == (gen + 1u) * nloc) {
            __builtin_amdgcn_fence(__ATOMIC_RELEASE, "agent");
            asm volatile("s_waitcnt vmcnt(0)" ::: "memory");
            const unsigned og = xb_add(&bar[XB_TOP], 1u);
            const unsigned tg = og / nx;
            if (og + 1u == (tg + 1u) * nx) xb_add(&bar[XB_TOPGEN], 1u);
            else XB_SPIN(xb_ld(&bar[XB_TOPGEN]) == tg, bar);
            __builtin_amdgcn_fence(__ATOMIC_ACQUIRE, "agent");
            xb_add(&bar[XB_XGEN(b.x)], 1u);
            asm volatile("s_waitcnt vmcnt(0)" ::: "memory");
        } else {
            XB_SPIN(xb_ld(&bar[XB_XGEN(b.x)]) == gen, bar);
            __builtin_amdgcn_fence(__ATOMIC_ACQUIRE, "agent");
            asm volatile("s_waitcnt vmcnt(0)" ::: "memory");
        }
    }
    __syncthreads();
}

__device__ __forceinline__ void group_sync(unsigned* word, unsigned n, unsigned* bar, bool w0) {
    asm volatile("s_waitcnt vmcnt(0)" ::: "memory");
    __syncthreads();
    if (w0 && lane_id_here() == 0) {
        __builtin_amdgcn_s_waitcnt(0);
        __builtin_amdgcn_fence(__ATOMIC_RELEASE, "agent");
        asm volatile("s_waitcnt vmcnt(0)" ::: "memory");
        (void)xb_add(word, 1u);
        XB_SPIN(xb_ld(word) < n, bar);
        __builtin_amdgcn_fence(__ATOMIC_ACQUIRE, "agent");
        asm volatile("s_waitcnt vmcnt(0)" ::: "memory");
    }
    __syncthreads();
}

struct Args { const float* in[23]; float* out; unsigned char* ws; int ph_lo, ph_hi; };
struct Frame {
    LAS unsigned char* lds;
    volatile LAS int* LCTL;
    int tid, lane, wave, vcu, G;
};
__device__ __forceinline__ unsigned long long ptr_get(const Frame& F, int i) {
    const unsigned lo = (unsigned)F.LCTL[128 + 2 * i], hi = (unsigned)F.LCTL[129 + 2 * i];
    return ((unsigned long long)(unsigned)__builtin_amdgcn_readfirstlane((int)hi) << 32) | (unsigned long long)(unsigned)__builtin_amdgcn_readfirstlane((int)lo);
}
__device__ __forceinline__ const float* inp(const Frame& F, int i) { return (const float*)(GAS const float*)ptr_get(F, i); }
__device__ __forceinline__ unsigned char* wsp(const Frame& F) { return (unsigned char*)(GAS unsigned char*)ptr_get(F, 23); }
__device__ __forceinline__ float* outp(const Frame& F) { return (float*)(GAS float*)ptr_get(F, 24); }
enum { I_X = 0, I_C, I_CTX, I_CCTX, I_WADA, I_BADA, I_GMIX, I_GFFN, I_WQKV, I_QGAIN, I_KGAIN, I_RPB, I_WONA, I_WIN, I_BGATE, I_MHGAIN, I_WOML,
       I_WR, I_BR, I_W1, I_B1, I_W2, I_B2 };

struct DenseOrder {
    int nM, nN, nwg, G, c, pm0, K; const char* A; const char* Bt;
    __device__ __forceinline__ void init(int pm0_, int nM_, int nN_, int G_, int c_, const void* A_, const void* Bt_, int K_) { pm0 = pm0_; nM = nM_; nN = nN_; nwg = nM * nN; G = G_; c = c_; A = (const char*)A_; Bt = (const char*)Bt_; K = K_; }
    __device__ __forceinline__ bool next(int i, pg8::Unit& u) const {
        const long L = (long)i * G + c; if (L >= nwg) return false;
        int wgid = (int)L; { const int q = nwg / 8, r = nwg % 8, xcd = wgid % 8, off = wgid / 8; wgid = (xcd < r ? xcd * (q + 1) : r * (q + 1) + (xcd - r) * q) + off; }
        const int nig = 8 * nN, gid = wgid / nig, fm = gid * 8, gsz = (nM - fm) < 8 ? (nM - fm) : 8;
        u.pm = pm0 + fm + ((wgid % nig) % gsz); u.pn = (wgid % nig) / gsz; u.e = 0; u.slot = i; return true;
    }
    __device__ __forceinline__ const char* a_base(const pg8::Unit& u) const { return A + (size_t)u.pm * 256 * K * 2; }
    __device__ __forceinline__ const char* b_base(const pg8::Unit& u) const { return Bt + (size_t)u.pn * 256 * K * 2; }
    __device__ __forceinline__ int a_row(const pg8::Unit&, int) const { return 0; }
    __device__ __forceinline__ bool prefetchable() const { return false; }
    __device__ __forceinline__ const int* a_row_ptr(const pg8::Unit&, int) const { return nullptr; }
};
struct MoeOrder {
    int NT, nunits, G, c, K; const char* A; const char* W; size_t estride; const int* tokmap; volatile LAS int* prefix; volatile LAS int* tile_e; volatile LAS int* tokl; bool gather;
    __device__ __forceinline__ bool next(int i, pg8::Unit& u) const {
        const long L = (long)i * G + c; if (L >= nunits) return false;
        int wgid = (int)L; { const int q = nunits / 8, r = nunits % 8, xcd = wgid % 8, off = wgid / 8; wgid = (xcd < r ? xcd * (q + 1) : r * (q + 1) + (xcd - r) * q) + off; }
        const int tile = wgid / NT; u.pm = tile; u.pn = wgid - tile * NT;
        u.e = __builtin_amdgcn_readfirstlane(tile_e[tile]); u.slot = i; return true;
    }
    __device__ __forceinline__ const char* a_base(const pg8::Unit& u) const { return A; }
    __device__ __forceinline__ const char* b_base(const pg8::Unit& u) const { return W + (size_t)u.e * estride + (size_t)u.pn * 256 * K * 2; }
    __device__ __forceinline__ int a_row(const pg8::Unit& u, int r) const { return gather ? tokl[u.slot * 256 + r] : u.pm * 256 + r; }
    __device__ __forceinline__ bool prefetchable() const { return gather; }
    __device__ __forceinline__ const int* a_row_ptr(const pg8::Unit& u, int r) const { return tokmap + u.pm * 256 + r; }
};

#ifndef WO_PREFETCH
#define WO_PREFETCH false
#endif
typedef f32x4 AccT[2][2][4][2];
struct EpiStoreBf16 {
    static constexpr bool PERM = true; static constexpr bool PREFETCH = false;
    bf16_t* O; int ldc;
    __device__ __forceinline__ void operator()(const AccT& acc, const pg8::Unit& u, int wr, int wc, int fr, int fq) const {
        const int row0 = u.pm * 256 + wr * 64 + fr, col0 = u.pn * 256 + wc * 32 + 8 * fq;
#pragma unroll
        for (int ai = 0; ai < 2; ++ai)
#pragma unroll
            for (int m = 0; m < 4; ++m) { bf16_t* rowp = O + (size_t)(row0 + ai * 128 + m * 16) * ldc + col0;
#pragma unroll
                for (int bj = 0; bj < 2; ++bj) { const f32x4 v0 = acc[ai][bj][m][0], v1 = acc[ai][bj][m][1];
                    u32x4 w; w.x = pg8::cvt_pk_bf16(v0[0], v0[1]); w.y = pg8::cvt_pk_bf16(v0[2], v0[3]); w.z = pg8::cvt_pk_bf16(v1[0], v1[1]); w.w = pg8::cvt_pk_bf16(v1[2], v1[3]);
                    *(u32x4*)(rowp + bj * 128) = w; } }
    }
};
struct EpiProjML {
    static constexpr bool PERM = false; static constexpr bool PREFETCH = false;
    bf16_t* O; const float* rope;
    __device__ __forceinline__ void operator()(const AccT& acc, const pg8::Unit& u, int wr, int wc, int fr, int fq) const {
        const int row0 = u.pm * 256 + wr * 64 + fr, col0 = u.pn * 256 + wc * 32 + 4 * fq;
        const bool qk = u.pn < 4, lat = u.pm >= ROWS_CTX / 256;
        const float scale = u.pn < 2 ? 0.125f : 1.0f;
        const int hf = wc & 1;
#pragma unroll
        for (int ai = 0; ai < 2; ++ai) {
            f32x4 t0[4], t1[4];
            if (qk && lat) {
#pragma unroll
                for (int m = 0; m < 4; ++m) { const int row = row0 + ai * 128 + m * 16, s = (row - ROWS_CTX) & 4095, pos = hf ? (s & 63) : (s >> 6);
                    t0[m] = *(const f32x4*)(rope + (pos * 16 + 4 * fq) * 2); t1[m] = *(const f32x4*)(rope + (pos * 16 + 4 * fq) * 2 + 4); }
            }
#pragma unroll
            for (int m = 0; m < 4; ++m) { const int row = row0 + ai * 128 + m * 16; bf16_t* rowp = O + (size_t)row * ML_INP + col0;
                f32x4 c4 = (f32x4){1.f, 1.f, 1.f, 1.f}, s4 = (f32x4){0.f, 0.f, 0.f, 0.f};
                if (qk && lat) { c4 = (f32x4){t0[m][0], t0[m][2], t1[m][0], t1[m][2]}; s4 = (f32x4){t0[m][1], t0[m][3], t1[m][1], t1[m][3]}; }
#pragma unroll
                for (int bj = 0; bj < 2; ++bj) { f32x4 v0 = acc[ai][bj][m][0], v1 = acc[ai][bj][m][1];
                    if (qk) { const f32x4 o0 = (v0 * c4 - v1 * s4) * scale, o1 = (v0 * s4 + v1 * c4) * scale; v0 = o0; v1 = o1; }
                    u32x2 w0, w1; w0.x = pg8::cvt_pk_bf16(v0[0], v0[1]); w0.y = pg8::cvt_pk_bf16(v0[2], v0[3]); w1.x = pg8::cvt_pk_bf16(v1[0], v1[1]); w1.y = pg8::cvt_pk_bf16(v1[2], v1[3]);
                    *(u32x2*)(rowp + bj * 128) = w0; *(u32x2*)(rowp + bj * 128 + 16) = w1; } }
        }
    }
};
#ifndef Y_FP8
#define Y_FP8 1
#endif
struct EpiY {
    static constexpr bool PERM = true; static constexpr bool PREFETCH = false;
    bf16_t* O; const float* b2;
    __device__ __forceinline__ void operator()(const AccT& acc, const pg8::Unit& u, int wr, int wc, int fr, int fq) const {
        const int row0 = u.pm * 256 + wr * 64 + fr, col0 = u.pn * 256 + wc * 32 + 8 * fq;
        const float* bp = b2 + (size_t)u.e * D + col0;
#pragma unroll
        for (int bj = 0; bj < 2; ++bj) {
            const f32x4 b0 = *(const f32x4*)(bp + bj * 128), b1v = *(const f32x4*)(bp + bj * 128 + 4);
#pragma unroll
            for (int ai = 0; ai < 2; ++ai)
#pragma unroll
                for (int m = 0; m < 4; ++m) {
                    const f32x4 v0 = acc[ai][bj][m][0] * (1.0f / 1024.0f) + b0, v1 = acc[ai][bj][m][1] * (1.0f / 1024.0f) + b1v;
#if Y_FP8
                    unsigned char* rowp = (unsigned char*)O + (size_t)(row0 + ai * 128 + m * 16) * D + col0 + bj * 128;
                    const f32x4 lim = (f32x4){448.f, 448.f, 448.f, 448.f};
                    const f32x4 q0 = __builtin_elementwise_min(__builtin_elementwise_max(v0 * 16.0f, -lim), lim), q1 = __builtin_elementwise_min(__builtin_elementwise_max(v1 * 16.0f, -lim), lim);
                    u32x2 w; w.x = pk4_fp8(q0[0], q0[1], q0[2], q0[3]); w.y = pk4_fp8(q1[0], q1[1], q1[2], q1[3]);
                    *(u32x2*)rowp = w;
#else
                    bf16_t* rowp = O + (size_t)(row0 + ai * 128 + m * 16) * D + col0 + bj * 128;
                    u32x4 w; w.x = pg8::cvt_pk_bf16(v0[0], v0[1]); w.y = pg8::cvt_pk_bf16(v0[2], v0[3]); w.z = pg8::cvt_pk_bf16(v1[0], v1[1]); w.w = pg8::cvt_pk_bf16(v1[2], v1[3]);
                    *(u32x4*)rowp = w;
#endif
                } }
    }
};
struct EpiSwiglu {
    static constexpr bool PERM = true; static constexpr bool PREFETCH = false;
    unsigned char* O; const float* b1;
    __device__ __forceinline__ void operator()(const AccT& acc, const pg8::Unit& u, int wr, int wc, int fr, int fq) const {
        const int row0 = u.pm * 256 + wr * 64 + fr, cc0 = u.pn * 128 + wc * 32 + 8 * fq;
        const float* bp = b1 + (size_t)u.e * 2048 + cc0;
        f32x4 bg[2], bl[2];
#pragma unroll
        for (int n = 0; n < 2; ++n) { bg[n] = *(const f32x4*)(bp + 4 * n); bl[n] = *(const f32x4*)(bp + 1024 + 4 * n) + 1.0f; }
#pragma unroll
        for (int ai = 0; ai < 2; ++ai)
#pragma unroll
            for (int m = 0; m < 4; ++m) { unsigned char* rowp = O + (size_t)(row0 + ai * 128 + m * 16) * D + cc0;
                float o[8];
#pragma unroll
                for (int n = 0; n < 2; ++n) { const f32x4 gl = acc[ai][0][m][n] * (1.0f / 2048.0f) + bg[n], li1 = acc[ai][1][m][n] * (1.0f / 2048.0f) + bl[n];
#pragma unroll
                    for (int j = 0; j < 4; ++j) { const float g = fminf(gl[j], 7.0f), l1 = __builtin_amdgcn_fmed3f(li1[j], -6.0f, 8.0f);
                        const float sg = __builtin_amdgcn_rcpf(1.0f + __builtin_amdgcn_exp2f(-2.45545696f * g));
                        o[4 * n + j] = (8.0f * g) * sg * l1; } }
                u32x2 w; w.x = pk4_fp8(o[0], o[1], o[2], o[3]); w.y = pk4_fp8(o[4], o[5], o[6], o[7]);
                *(u32x2*)rowp = w; }
    }
};
struct EpiResid {
    static constexpr bool PERM = true; static constexpr bool PREFETCH = WO_PREFETCH;
    bf16_t* xs; const float* g;
    __device__ __forceinline__ void prefetch(const pg8::Unit& u, int tid, LAS unsigned char* lds) const {
        const char* base = (const char*)(xs + (size_t)(u.pm * 256 + (tid >> 1)) * D + u.pn * 256) + (tid & 1) * 256;
        LAS unsigned* dump = (LAS unsigned*)(lds + pg8::STAGE_BYTES + 16384 + (tid >> 6) * 256);
        __builtin_amdgcn_global_load_lds((const unsigned*)base, dump, 4, 0, 0);
        __builtin_amdgcn_global_load_lds((const unsigned*)(base + 128), dump, 4, 0, 0);
    }
    __device__ __forceinline__ void operator()(const AccT& acc, const pg8::Unit& u, int wr, int wc, int fr, int fq) const {
        const int row0 = u.pm * 256 + wr * 64 + fr, col0 = u.pn * 256 + wc * 32 + 8 * fq;
        const int mb = u.pm < 8 ? 8 : ((u.pm - 8) >> 4);
        const float* gp = g + (size_t)mb * 6144 + col0;
        f32x4 gv[2][2];
#pragma unroll
        for (int bj = 0; bj < 2; ++bj)
#pragma unroll
            for (int n = 0; n < 2; ++n) gv[bj][n] = *(const f32x4*)(gp + bj * 128 + 4 * n);
#pragma unroll
        for (int ai = 0; ai < 2; ++ai) {
            u32x4 xv[4][2];
#pragma unroll
            for (int m = 0; m < 4; ++m) { const bf16_t* rowp = xs + (size_t)(row0 + ai * 128 + m * 16) * D + col0;
#pragma unroll
                for (int bj = 0; bj < 2; ++bj) xv[m][bj] = *(const u32x4*)(rowp + bj * 128); }
#pragma unroll
            for (int m = 0; m < 4; ++m) { bf16_t* rowp = xs + (size_t)(row0 + ai * 128 + m * 16) * D + col0;
#pragma unroll
                for (int bj = 0; bj < 2; ++bj) { const u32x4 x = xv[m][bj];
                    const f32x4 x0 = (f32x4){bflo(x.x), bfhi(x.x), bflo(x.y), bfhi(x.y)}, x1 = (f32x4){bflo(x.z), bfhi(x.z), bflo(x.w), bfhi(x.w)};
                    const f32x4 v0 = x0 + gv[bj][0] * acc[ai][bj][m][0], v1 = x1 + gv[bj][1] * acc[ai][bj][m][1];
                    u32x4 w; w.x = pg8::cvt_pk_bf16(v0[0], v0[1]); w.y = pg8::cvt_pk_bf16(v0[2], v0[3]); w.z = pg8::cvt_pk_bf16(v1[0], v1[1]); w.w = pg8::cvt_pk_bf16(v1[2], v1[3]);
                    *(u32x4*)(rowp + bj * 128) = w; } }
        }
    }
};

__device__ __forceinline__ const float* modp(const Frame& F, int l, int mb, int chunk) { return (const float*)(wsp(F) + WS_MOD) + ((size_t)(l * 9 + mb) * 6 + chunk) * D; }
__device__ __forceinline__ int row_mb(int row) { return row < ROWS_CTX ? 8 : ((row - ROWS_CTX) >> 12); }

__device__ __forceinline__ void transpose_item(const float* W, int N, int Nvalid, bf16_t* WT, int k0, int n0, LAS float* scr, int lane, const bool nost = false) {
    const int nn = 4 * (lane & 15);
    const bool ok = (n0 + nn) < Nvalid;
    f32x4 v[16];
#pragma unroll
    for (int i = 0; i < 16; ++i) { const int kk = 4 * i + (lane >> 4);
        v[i] = ok ? __builtin_nontemporal_load((const f32x4*)(W + (size_t)(k0 + kk) * N + n0 + nn)) : (f32x4){0.f, 0.f, 0.f, 0.f}; }
#pragma unroll
    for (int i = 0; i < 16; ++i) { const int kk = 4 * i + (lane >> 4); LAS float* s = scr + kk * 65 + nn;
        s[0] = v[i][0]; s[1] = v[i][1]; s[2] = v[i][2]; s[3] = v[i][3]; }
    LDS_WAIT(); asm volatile("" ::: "memory");
    const int c = lane & 7;
#pragma unroll
    for (int j = 0; j < 8; ++j) { const int n = (lane >> 3) + 8 * j; const LAS float* s = scr + (8 * c) * 65 + n;
        u32x4 o; o.x = pk2(s[0 * 65], s[1 * 65]); o.y = pk2(s[2 * 65], s[3 * 65]); o.z = pk2(s[4 * 65], s[5 * 65]); o.w = pk2(s[6 * 65], s[7 * 65]);
        if (!nost) *(u32x4*)(WT + (size_t)n * D + k0 + 8 * c) = o; }
    LDS_WAIT(); asm volatile("" ::: "memory");
}
__device__ __forceinline__ void transpose_item_f8(const float* W, int N, unsigned char* WT, int k0, int n0, LAS float* scr, int lane, float scale, const bool nost = false) {
    const int nn = 4 * (lane & 15);
    f32x4 v[16];
#pragma unroll
    for (int i = 0; i < 16; ++i) { const int kk = 4 * i + (lane >> 4); v[i] = __builtin_nontemporal_load((const f32x4*)(W + (size_t)(k0 + kk) * N + n0 + nn)); }
#pragma unroll
    for (int i = 0; i < 16; ++i) { const int kk = 4 * i + (lane >> 4); LAS float* s = scr + kk * 65 + nn;
        s[0] = v[i][0] * scale; s[1] = v[i][1] * scale; s[2] = v[i][2] * scale; s[3] = v[i][3] * scale; }
    LDS_WAIT(); asm volatile("" ::: "memory");
    const int c = lane & 3;
#pragma unroll
    for (int j = 0; j < 4; ++j) { const int n = (lane >> 2) + 16 * j; const LAS float* s = scr + (16 * c) * 65 + n;
        u32x4 o; o.x = pk4_fp8(s[0 * 65], s[1 * 65], s[2 * 65], s[3 * 65]); o.y = pk4_fp8(s[4 * 65], s[5 * 65], s[6 * 65], s[7 * 65]);
        o.z = pk4_fp8(s[8 * 65], s[9 * 65], s[10 * 65], s[11 * 65]); o.w = pk4_fp8(s[12 * 65], s[13 * 65], s[14 * 65], s[15 * 65]);
        if (!nost) *(u32x4*)(WT + (size_t)n * D + k0 + 16 * c) = o; }
    LDS_WAIT(); asm volatile("" ::: "memory");
}
__device__ __forceinline__ void phase0(Frame& F, const int mode = 0) {
    const int tid = F.tid, lane = F.lane, wave = F.wave;
    if (mode != 2) {
        LAS float* sT = (LAS float*)F.lds;
        LAS float* red = (LAS float*)(F.lds + 40960);
        const float* c = inp(F, I_C); const float* cctx = inp(F, I_CCTX);
        for (int idx = tid; idx < 9 * D; idx += NTHREADS) { const int mb = idx >> 10, k = idx & 1023; const float cv = mb < 8 ? c[mb * D + k] : cctx[k]; sT[idx] = cv / (1.f + __expf(-cv)); }
        __syncthreads();
        float* mod = (float*)(wsp(F) + WS_MOD);
        for (int task = F.vcu; task < DEPTH * 64; task += F.G) {
            const int l = task >> 6, cb = task & 63, hk = lane >= 24 ? 1 : 0, ln = lane - 24 * hk; const bool act = lane < 48;
            const float* wp = inp(F, I_WADA) + ((size_t)l * D + wave * 128 + hk) * 6144 + cb * 96 + ln * 4;
            f32x4 acc[9];
#pragma unroll
            for (int mb = 0; mb < 9; ++mb) acc[mb] = (f32x4){0.f, 0.f, 0.f, 0.f};
#pragma unroll 8
            for (int k2 = 0; k2 < 64; ++k2) { const f32x4 wv = act ? __builtin_nontemporal_load((const f32x4*)(wp + (size_t)k2 * 2 * 6144)) : (f32x4){0.f, 0.f, 0.f, 0.f};
#pragma unroll
                for (int mb = 0; mb < 9; ++mb) acc[mb] += wv * sT[mb * D + wave * 128 + 2 * k2 + hk]; }
#pragma unroll
            for (int mb = 0; mb < 9; ++mb) {
#pragma unroll
                for (int c = 0; c < 4; ++c) acc[mb][c] += shfl_(acc[mb][c], lane + 24);
                if (lane < 24) *(LAS f32x4*)(red + (wave * 9 + mb) * 96 + lane * 4) = acc[mb]; }
            __syncthreads();
            for (int idx = tid; idx < 9 * 96; idx += NTHREADS) { const int mb = idx / 96, cc = idx % 96; float s = 0.f;
#pragma unroll
                for (int w = 0; w < 8; ++w) s += red[(w * 9 + mb) * 96 + cc];
                const int col = cb * 96 + cc;
                mod[(size_t)(l * 9 + mb) * 6144 + col] = s + inp(F, I_BADA)[l * 6144 + col]; }
            __syncthreads();
        }
        {
            bf16_t* rt = (bf16_t*)(wsp(F) + WS_RT); const float* wr = inp(F, I_WR);
            for (int idx = F.vcu * NTHREADS + tid; idx < DEPTH * D * NE; idx += F.G * NTHREADS) { const int l = idx >> 15, k = (idx >> 5) & 1023, e = idx & 31; const float w = wr[idx];
                const unsigned hb16 = f2bf(w); const float hf = __builtin_bit_cast(float, hb16 << 16);
                rt[((size_t)(l * 2 + 0) * NE + e) * D + k] = (bf16_t)hb16; rt[((size_t)(l * 2 + 1) * NE + e) * D + k] = (bf16_t)f2bf(w - hf); }
        }
        if (blockIdx.x == 0) {
            float* rope = (float*)(wsp(F) + WS_ROPE);
            for (int idx = tid; idx < 64 * 16; idx += NTHREADS) { const int pos = idx >> 4, i = idx & 15; const float inv = powf(10000.0f, -(float)i / 16.0f); const float ang = (float)pos * inv;
                rope[idx * 2] = cosf(ang); rope[idx * 2 + 1] = sinf(ang); }
        }
        __syncthreads();
    }
    if (mode != 1) {
        const bool nost = (mode == 3);
        LAS float* scr = (LAS float*)(F.lds + wave * 16640);
        const int gw = F.vcu * NWAVES + wave, NGW = F.G * NWAVES;
        constexpr int I_QKV = 2 * 16 * 48, I_WO = 4 * 16 * 16, I_IN = 2 * 16 * 52, I_1 = DEPTH * NE * 16 * 32, I_2 = DEPTH * NE * 16 * 16;
        for (int it0 = gw; it0 < I_QKV + I_WO + I_IN + I_1 + I_2; it0 += NGW) {
            int it = it0;
            if (it < I_QKV) { const int j = it / 768, r = it % 768, kb = r / 48, nb = r % 48;
                transpose_item(inp(F, I_WQKV) + (size_t)j * D * 3072, 3072, 3072, (bf16_t*)(wsp(F) + WS_WQKV) + ((size_t)j * 3072 + nb * 64) * D, kb * 64, nb * 64, scr, lane, nost); continue; }
            it -= I_QKV;
            if (it < I_WO) { const int m = it / 256, r = it % 256, kb = r / 16, nb = r % 16;
                const float* W = (m < 2) ? inp(F, I_WONA) + (size_t)m * D * D : inp(F, I_WOML) + (size_t)(m - 2) * D * D;
                bf16_t* dst = (m < 2) ? (bf16_t*)(wsp(F) + WS_WONA) + (size_t)m * D * D : (bf16_t*)(wsp(F) + WS_WOML) + (size_t)(m - 2) * D * D;
                transpose_item(W, D, D, dst + (size_t)nb * 64 * D, kb * 64, nb * 64, scr, lane, nost); continue; }
            it -= I_WO;
            if (it < I_IN) { const int j = it / 832, r = it % 832, kb = r / 52, nb = r % 52;
                transpose_item(inp(F, I_WIN) + (size_t)j * D * ML_IN, ML_IN, ML_IN, (bf16_t*)(wsp(F) + WS_WIN) + ((size_t)j * ML_INP + nb * 64) * D, kb * 64, nb * 64, scr, lane, nost); continue; }
            it -= I_IN;
            if (it < I_1) { const int le = it / 512, r = it % 512, kb = r / 32, nb = r % 32;
                const int n0 = nb * 64, bj = n0 >> 10, j0 = n0 & 1023, pn = j0 >> 7, jj0 = j0 & 127, drow = pn * 256 + bj * 128 + jj0;
                transpose_item_f8(inp(F, I_W1) + (size_t)le * D * 2048, 2048, (unsigned char*)(wsp(F) + WS_W1T) + ((size_t)le * 2048 + drow) * D, kb * 64, n0, scr, lane, 128.0f, nost); continue; }
            it -= I_1;
            { const int le = it / 256, r = it % 256, kb = r / 16, nb = r % 16;
                transpose_item_f8(inp(F, I_W2) + (size_t)le * D * D, D, (unsigned char*)(wsp(F) + WS_W2T) + ((size_t)le * D + nb * 64) * D, kb * 64, nb * 64, scr, lane, 128.0f, nost); }
        }
    }
}

__device__ __forceinline__ void moe_combine(const Frame& F, const int4 pos, const float4 tw, int lprev, int mb, f32x4 (&v)[4]) {
    const int p[4] = {pos.x, pos.y, pos.z, pos.w}; const float w[4] = {tw.x, tw.y, tw.z, tw.w};
    f32x4 a[4];
#pragma unroll
    for (int j = 0; j < 4; ++j) a[j] = (f32x4){0.f, 0.f, 0.f, 0.f};
#if Y_FP8
    const unsigned char* Y = (const unsigned char*)(wsp(F) + WS_Y);
    unsigned y[4][4];
#pragma unroll
    for (int k = 0; k < 4; ++k) { const unsigned* yp = (const unsigned*)(Y + (size_t)p[k] * D) + F.lane;
#pragma unroll
        for (int j = 0; j < 4; ++j) y[k][j] = yp[64 * j]; }
#pragma unroll
    for (int k = 0; k < 4; ++k) { const float wk = w[k] * (1.0f / 16.0f);
#pragma unroll
        for (int j = 0; j < 4; ++j) { const int yy = (int)y[k][j];
            a[j] = a[j] + wk * (f32x4){__builtin_amdgcn_cvt_f32_fp8(yy, 0), __builtin_amdgcn_cvt_f32_fp8(yy, 1), __builtin_amdgcn_cvt_f32_fp8(yy, 2), __builtin_amdgcn_cvt_f32_fp8(yy, 3)}; } }
#else
    const bf16_t* Y = (const bf16_t*)(wsp(F) + WS_Y);
    u32x2 y[4][4];
#pragma unroll
    for (int k = 0; k < 4; ++k) { const u32x2* yp = (const u32x2*)(Y + (size_t)p[k] * D) + F.lane;
#pragma unroll
        for (int j = 0; j < 4; ++j) y[k][j] = yp[64 * j]; }
#pragma unroll
    for (int k = 0; k < 4; ++k)
#pragma unroll
        for (int j = 0; j < 4; ++j) a[j] = a[j] + w[k] * (f32x4){bflo(y[k][j].x), bfhi(y[k][j].x), bflo(y[k][j].y), bfhi(y[k][j].y)};
#endif
    const f32x4* g2 = (const f32x4*)modp(F, lprev, mb, 5) + F.lane;
#pragma unroll
    for (int j = 0; j < 4; ++j) v[j] = v[j] + g2[64 * j] * a[j];
}

__device__ __forceinline__ void phase_norm1(Frame& F, int l, bool dummy = false) {
    const int gw = F.vcu * NWAVES + F.wave, NGW = F.G * NWAVES, lane = F.lane;
    bf16_t* xs = (bf16_t*)(wsp(F) + WS_XS); bf16_t* hb = (bf16_t*)(wsp(F) + WS_HB);
    bf16_t* xso = dummy ? (bf16_t*)(wsp(F) + WS_ACT) : xs;
    const f32x4* gm = (const f32x4*)(inp(F, I_GMIX) + l * D) + lane;
    const int4* posp = (const int4*)(wsp(F) + WS_POS); const float4* twp = (const float4*)(wsp(F) + WS_TOPW);
    int4 pn = make_int4(0, 0, 0, 0); float4 wn = make_float4(0.f, 0.f, 0.f, 0.f);
    if (l > 0 && gw < ROWS) { pn = posp[gw]; wn = twp[gw]; }
    for (int row = gw; row < ROWS; row += NGW) {
        const int mb = row_mb(row);
        f32x4 v[4];
        if (l == 0) { const float* src = row < ROWS_CTX ? inp(F, I_CTX) + (size_t)row * D : inp(F, I_X) + (size_t)(row - ROWS_CTX) * D; const f32x4* xr = (const f32x4*)src + lane;
#pragma unroll
            for (int j = 0; j < 4; ++j) v[j] = xr[64 * j]; }
        else { const u32x2* xr = (const u32x2*)(xs + (size_t)row * D) + lane;
#pragma unroll
            for (int j = 0; j < 4; ++j) v[j] = bf4_to_f32(xr[64 * j]); }
        if (l > 0) { const int4 pc = pn; const float4 wc = wn;
            if (row + NGW < ROWS) { pn = posp[row + NGW]; wn = twp[row + NGW]; }
            moe_combine(F, pc, wc, l - 1, mb, v); }
        u32x2* xw = (u32x2*)(xso + (size_t)row * D) + lane;
        float ss = 0.f;
#pragma unroll
        for (int j = 0; j < 4; ++j) { u32x2 xb; xb.x = pk2(v[j][0], v[j][1]); xb.y = pk2(v[j][2], v[j][3]); xw[64 * j] = xb; ss += (v[j][0] * v[j][0] + v[j][1] * v[j][1]) + (v[j][2] * v[j][2] + v[j][3] * v[j][3]); }
        const float rs = 1.0f / sqrtf(wave_sum(ss) * (1.f / D) + EPS);
        const f32x4* sh = (const f32x4*)modp(F, l, mb, 0) + lane; const f32x4* sc = (const f32x4*)modp(F, l, mb, 1) + lane;
        u32x2* o8 = (u32x2*)(hb + (size_t)row * D) + lane;
#pragma unroll
        for (int j = 0; j < 4; ++j) { const f32x4 h = (v[j] * rs) * gm[64 * j] * (sc[64 * j] + 1.0f) + sh[64 * j];
            u32x2 w; w.x = pk2(h[0], h[1]); w.y = pk2(h[2], h[3]); o8[64 * j] = w; }
    }
}
__device__ __forceinline__ void phase_final(Frame& F) {
    const int gw = F.vcu * NWAVES + F.wave, NGW = F.G * NWAVES, lane = F.lane;
    const bf16_t* xs = (const bf16_t*)(wsp(F) + WS_XS);
    const int4* posp = (const int4*)(wsp(F) + WS_POS); const float4* twp = (const float4*)(wsp(F) + WS_TOPW);
    int4 pn = make_int4(0, 0, 0, 0); float4 wn = make_float4(0.f, 0.f, 0.f, 0.f);
    if (ROWS_CTX + gw < ROWS) { pn = posp[ROWS_CTX + gw]; wn = twp[ROWS_CTX + gw]; }
    for (int row = ROWS_CTX + gw; row < ROWS; row += NGW) {
        const int mb = row_mb(row);
        const u32x2* xr = (const u32x2*)(xs + (size_t)row * D) + lane;
        f32x4 v[4];
#pragma unroll
        for (int j = 0; j < 4; ++j) v[j] = bf4_to_f32(xr[64 * j]);
        const int4 pc = pn; const float4 wc = wn;
        if (row + NGW < ROWS) { pn = posp[row + NGW]; wn = twp[row + NGW]; }
        moe_combine(F, pc, wc, DEPTH - 1, mb, v);
        f32x4* o = (f32x4*)(outp(F) + (size_t)(row - ROWS_CTX) * D) + lane;
#ifdef MLPROF
        { const unsigned long long* pp = (const unsigned long long*)(wsp(F) + WS_CTL + 524288); const float tot = (float)(pp[0] + pp[1] + pp[2] + pp[3] + pp[4] + pp[5]);
          const float f = MLPROF_SEL < 0 ? 0.f : (MLPROF_SEL == 6 ? tot * (1.0f / 1048576.0f) : (MLPROF_SEL > 5 ? 1.f : (float)pp[MLPROF_SEL < 0 ? 0 : (MLPROF_SEL > 5 ? 5 : MLPROF_SEL)] / tot)); const float sc = 2.f + 4.f * f;
          const f32x4* xin = (const f32x4*)(inp(F, I_X) + (size_t)(row - ROWS_CTX) * D) + lane;
#pragma unroll
          for (int j = 0; j < 4; ++j) v[j] = xin[64 * j] * sc; }
#endif
#pragma unroll
        for (int j = 0; j < 4; ++j) o[64 * j] = v[j];
    }
}

constexpr int NCBP = 96, NA_CTX_EXTRA = 3;
__device__ __forceinline__ bool proj_split(int G) { return false && G >= 2 * NCBP; }
__device__ __forceinline__ void phase_na_post(Frame& F, int jn, const bool split) {
    const int gw = F.vcu * NWAVES + F.wave, NGW = F.G * NWAVES, lane = F.lane;
    constexpr int NIT = (ROWS / 64) * NH_NA, NIT_CTX = (ROWS_CTX / 64) * NH_NA, NIT_IMG = NIT - NIT_CTX;
    const int nwc = NCBP * NWAVES, nwm = NGW - nwc, m1 = NIT_IMG - NA_CTX_EXTRA * nwc;
    const bf16_t* proj = (const bf16_t*)(wsp(F) + WS_PROJ);
    bf16_t* QN = (bf16_t*)(wsp(F) + WS_QN); bf16_t* KN = (bf16_t*)(wsp(F) + WS_KN); bf16_t* VT = (bf16_t*)(wsp(F) + WS_VT);
    LAS bf16_t* vs = (LAS bf16_t*)(F.lds + F.wave * (64 * 72 * 2));
    const int c8 = lane & 7, rl = lane >> 3;
    float qg[8], kg[8];
#pragma unroll
    for (int e = 0; e < 8; ++e) { qg[e] = inp(F, I_QGAIN)[jn * 64 + c8 * 8 + e] * (0.125f * 1.44269504f); kg[e] = inp(F, I_KGAIN)[jn * 64 + c8 * 8 + e]; }
    for (int v = 0; ; ++v) {
        int item;
        if (!split) { item = gw + v * NGW; if (item >= NIT) break; }
        else if (gw < nwc) { if (v == 0) { if (gw >= NIT_CTX) continue; item = gw; } else { if (v > NA_CTX_EXTRA) break; item = NIT_CTX + m1 + gw + (v - 1) * nwc; } }
        else { const int m = (gw - nwc) + v * nwm; if (m >= m1) break; item = NIT_CTX + m; }
        const int rb = item >> 4, h = item & 15, row0 = rb * 64;
        int b, tp0;
        if (row0 < ROWS_CTX) { b = row0 >> 8; tp0 = row0 & 255; } else { b = (row0 - ROWS_CTX) >> 12; tp0 = NCTX + ((row0 - ROWS_CTX) & 4095); }
        const size_t seqbase = ((size_t)(b * NH_NA + h) * TT + tp0) * 64;
#pragma unroll
        for (int i = 0; i < 8; ++i) {
            const int r = i * 8 + rl;
            const bf16_t* pr = proj + (size_t)(row0 + r) * 3072 + h * 64 + c8 * 8;
            const u32x4 qv = *(const u32x4*)pr, kv = *(const u32x4*)(pr + 1024), vv = *(const u32x4*)(pr + 2048);
            float q[8] = {bflo(qv.x), bfhi(qv.x), bflo(qv.y), bfhi(qv.y), bflo(qv.z), bfhi(qv.z), bflo(qv.w), bfhi(qv.w)};
            float k[8] = {bflo(kv.x), bfhi(kv.x), bflo(kv.y), bfhi(kv.y), bflo(kv.z), bfhi(kv.z), bflo(kv.w), bfhi(kv.w)};
            float sq = 0.f, sk = 0.f;
#pragma unroll
            for (int e = 0; e < 8; ++e) { sq += q[e] * q[e]; sk += k[e] * k[e]; }
            sq = sum8(sq); sk = sum8(sk);
            const float rq = 1.0f / sqrtf(sq * (1.f / 64) + EPS), rk = 1.0f / sqrtf(sk * (1.f / 64) + EPS);
            u32x4 qo, ko;
            qo.x = pk2(q[0] * rq * qg[0], q[1] * rq * qg[1]); qo.y = pk2(q[2] * rq * qg[2], q[3] * rq * qg[3]); qo.z = pk2(q[4] * rq * qg[4], q[5] * rq * qg[5]); qo.w = pk2(q[6] * rq * qg[6], q[7] * rq * qg[7]);
            ko.x = pk2(k[0] * rk * kg[0], k[1] * rk * kg[1]); ko.y = pk2(k[2] * rk * kg[2], k[3] * rk * kg[3]); ko.z = pk2(k[4] * rk * kg[4], k[5] * rk * kg[5]); ko.w = pk2(k[6] * rk * kg[6], k[7] * rk * kg[7]);
            *(u32x4*)(QN + seqbase + (size_t)r * 64 + c8 * 8) = qo;
            *(u32x4*)(KN + seqbase + (size_t)r * 64 + c8 * 8) = ko;
            *(LAS u32x4*)(vs + r * 72 + ((c8 ^ ((r >> 3) & 7)) * 8)) = vv;
        }
        LDS_WAIT(); asm volatile("" ::: "memory");
#pragma unroll
        for (int j = 0; j < 8; ++j) {
            const int d = rl + 8 * j;
            const LAS bf16_t* s = vs + (8 * c8) * 72 + (((d >> 3) ^ c8) * 8) + (d & 7);
            u32x4 o;
            o.x = (unsigned)s[0 * 72] | ((unsigned)s[1 * 72] << 16); o.y = (unsigned)s[2 * 72] | ((unsigned)s[3 * 72] << 16);
            o.z = (unsigned)s[4 * 72] | ((unsigned)s[5 * 72] << 16); o.w = (unsigned)s[6 * 72] | ((unsigned)s[7 * 72] << 16);
            *(u32x4*)(VT + ((size_t)(b * NH_NA + h) * 64 + d) * TT + tp0 + 8 * c8) = o;
        }
        LDS_WAIT(); asm volatile("" ::: "memory");
    }
}

__device__ __forceinline__ bf16x8 ld_bf16x8(const bf16_t* p) { return *(const bf16x8*)p; }
constexpr int NA_LD = 72;
constexpr int NA_TILE = 64 * NA_LD * 2;
struct NaState { f32x4 o[4]; f32x4 osum; };
constexpr int NA_RING = 2 * 2 * 64 * NA_LD * 2;
constexpr int NA_CTX_OFF = NA_RING + 15 * 128 * 4;
constexpr int NA_BT_LD = 128, NA_BT_OFF = 48;
constexpr int NA_GQK_OFF = NA_CTX_OFF + 4 * 2 * 64 * NA_LD * 2;
__device__ __forceinline__ int na_row(int b, int tp) { return tp < NCTX ? b * NCTX + tp : ROWS_CTX + b * SEQ + (tp - NCTX); }
__device__ __forceinline__ u32x4 na_knorm(const u32x4 kv) {
    const float k[8] = {bflo(kv.x), bfhi(kv.x), bflo(kv.y), bfhi(kv.y), bflo(kv.z), bfhi(kv.z), bflo(kv.w), bfhi(kv.w)};
    float sk = 0.f;
#pragma unroll
    for (int e = 0; e < 8; ++e) sk += k[e] * k[e];
    sk = sum8(sk);
    const float rk = 1.0f / sqrtf(sk * (1.f / 64) + EPS);
    u32x4 o; o.x = pk2(k[0] * rk, k[1] * rk); o.y = pk2(k[2] * rk, k[3] * rk); o.z = pk2(k[4] * rk, k[5] * rk); o.w = pk2(k[6] * rk, k[7] * rk);
    return o;
}
__device__ __forceinline__ void na_vscatter(LAS bf16_t* vimg, const u32x4 vv, int r, int c8) {
    const unsigned vw[4] = {vv.x, vv.y, vv.z, vv.w};
    LAS bf16_t* d = vimg + (8 * c8) * NA_LD + r;
#pragma unroll
    for (int e = 0; e < 8; ++e) d[e * NA_LD] = (bf16_t)((vw[e >> 1] >> (16 * (e & 1))) & 0xffffu);
}
__device__ __forceinline__ void na_qload(const bf16_t* qp, const LAS float* gqk, int lane, int g, bf16x8 (&q)[2]) {
    const u32x4 a = *(const u32x4*)(qp + 8 * g), c = *(const u32x4*)(qp + 32 + 8 * g);
    const float f0[8] = {bflo(a.x), bfhi(a.x), bflo(a.y), bfhi(a.y), bflo(a.z), bfhi(a.z), bflo(a.w), bfhi(a.w)};
    const float f1[8] = {bflo(c.x), bfhi(c.x), bflo(c.y), bfhi(c.y), bflo(c.z), bfhi(c.z), bflo(c.w), bfhi(c.w)};
    float ss = 0.f;
#pragma unroll
    for (int e = 0; e < 8; ++e) ss += f0[e] * f0[e] + f1[e] * f1[e];
    ss += shfl_(ss, lane ^ 16); ss += shfl_(ss, lane ^ 32);
    const float rq = 1.0f / sqrtf(ss * (1.f / 64) + EPS);
    const f32x4 g0 = *(const LAS f32x4*)(gqk + 8 * g), g1 = *(const LAS f32x4*)(gqk + 8 * g + 4), g2 = *(const LAS f32x4*)(gqk + 32 + 8 * g), g3 = *(const LAS f32x4*)(gqk + 32 + 8 * g + 4);
    union { u32x4 u; bf16x8 v; } o0, o1;
    o0.u.x = pk2(f0[0] * rq * g0[0], f0[1] * rq * g0[1]); o0.u.y = pk2(f0[2] * rq * g0[2], f0[3] * rq * g0[3]); o0.u.z = pk2(f0[4] * rq * g1[0], f0[5] * rq * g1[1]); o0.u.w = pk2(f0[6] * rq * g1[2], f0[7] * rq * g1[3]);
    o1.u.x = pk2(f1[0] * rq * g2[0], f1[1] * rq * g2[1]); o1.u.y = pk2(f1[2] * rq * g2[2], f1[3] * rq * g2[3]); o1.u.z = pk2(f1[4] * rq * g3[0], f1[5] * rq * g3[1]); o1.u.w = pk2(f1[6] * rq * g3[2], f1[7] * rq * g3[3]);
    q[0] = o0.v; q[1] = o1.v;
}
template <bool WIN, bool DOA, bool DOB>
__device__ __forceinline__ void na_half2(NaState& sa, NaState& sb, const LAS bf16_t* KL, const LAS bf16_t* VL, int half, const bf16x8 (&qa)[2], const bf16x8 (&qb)[2],
                                         const LAS float* browA, const unsigned (&mA)[4], const unsigned (&mB)[4], int q16, int g) {
    union { u32x4 u; bf16x8 v; } ones; ones.u = (u32x4){0x3F803F80u, 0x3F803F80u, 0x3F803F80u, 0x3F803F80u};
    const LAS bf16_t* kp = KL + (half * 32 + q16) * NA_LD + 8 * g;
    const bf16x8 kf[2][2] = {{*(const LAS bf16x8*)kp, *(const LAS bf16x8*)(kp + 32)}, {*(const LAS bf16x8*)(kp + 16 * NA_LD), *(const LAS bf16x8*)(kp + 16 * NA_LD + 32)}};
    bf16x8 vf[4];
#pragma unroll
    for (int j4 = 0; j4 < 4; ++j4) { const LAS bf16_t* vp = VL + (16 * j4 + q16) * NA_LD + half * 32 + 4 * g;
        const bf16x4 va = *(const LAS bf16x4*)vp, vb = *(const LAS bf16x4*)(vp + 16);
        vf[j4] = (bf16x8){va[0], va[1], va[2], va[3], vb[0], vb[1], vb[2], vb[3]}; }
#pragma unroll
    for (int grp = 0; grp < 2; ++grp) {
        if ((grp == 0 && !DOA) || (grp == 1 && !DOB)) continue;
        NaState& st = grp ? sb : sa;
        const LAS float* brow = browA - 16 * grp;
        f32x4 sv[2];
#pragma unroll
        for (int nb = 0; nb < 2; ++nb) { f32x4 init = (f32x4){0.f, 0.f, 0.f, 0.f};
            if (WIN) {
#pragma unroll
                for (int rg = 0; rg < 4; ++rg) init[rg] = brow[32 * half + 16 * nb + rg]; }
            init = __builtin_amdgcn_mfma_f32_16x16x32_bf16(kf[nb][0], grp ? qb[0] : qa[0], init, 0, 0, 0);
            sv[nb] = __builtin_amdgcn_mfma_f32_16x16x32_bf16(kf[nb][1], grp ? qb[1] : qa[1], init, 0, 0, 0); }
#pragma unroll
        for (int nb = 0; nb < 2; ++nb)
#pragma unroll
            for (int rg = 0; rg < 4; ++rg) sv[nb][rg] = __builtin_amdgcn_exp2f(__builtin_amdgcn_fmed3f(sv[nb][rg], -3.0e38f, 100.0f));
        union { u32x4 u; bf16x8 v; } pf;
        pf.u.x = pg8::cvt_pk_bf16(sv[0][0], sv[0][1]); pf.u.y = pg8::cvt_pk_bf16(sv[0][2], sv[0][3]); pf.u.z = pg8::cvt_pk_bf16(sv[1][0], sv[1][1]); pf.u.w = pg8::cvt_pk_bf16(sv[1][2], sv[1][3]);
        if (WIN) { const unsigned (&mk)[4] = grp ? mB : mA; pf.u.x &= mk[0]; pf.u.y &= mk[1]; pf.u.z &= mk[2]; pf.u.w &= mk[3]; }
#pragma unroll
        for (int j4 = 0; j4 < 4; ++j4) st.o[j4] = __builtin_amdgcn_mfma_f32_16x16x32_bf16(vf[j4], pf.v, st.o[j4], 0, 0, 0);
        st.osum = __builtin_amdgcn_mfma_f32_16x16x32_bf16(ones.v, pf.v, st.osum, 0, 0, 0);
    }
}
__device__ __forceinline__ void na_block_task(const Frame& F, int jn, int b, int h, bool ctxq, int p) {
    const int tid = F.tid, lane = F.lane, wave = F.wave, q16 = lane & 15, g = lane >> 4;
    const bf16_t* proj = (const bf16_t*)(wsp(F) + WS_PROJ) + h * 64;
    const LAS float* gqk = (const LAS float*)(F.lds + NA_GQK_OFF);
    const int rw = 4 * p + (wave >> 1), ch = wave & 1, qcA = 32 * ch + q16, qcB = qcA + 16;
    const int qtpA = ctxq ? p * 128 + wave * 16 + q16 : NCTX + rw * 64 + qcA, qtpB = ctxq ? qtpA : qtpA + 16;
    bf16x8 qa[2], qb[2];
    na_qload(proj + (size_t)na_row(b, qtpA) * 3072, gqk, lane, g, qa);
    na_qload(proj + (size_t)na_row(b, qtpB) * 3072, gqk, lane, g, qb);
    NaState sa, sb;
#pragma unroll
    for (int j = 0; j < 4; ++j) { sa.o[j] = (f32x4){0.f, 0.f, 0.f, 0.f}; sb.o[j] = (f32x4){0.f, 0.f, 0.f, 0.f}; }
    sa.osum = (f32x4){0.f, 0.f, 0.f, 0.f}; sb.osum = (f32x4){0.f, 0.f, 0.f, 0.f};
    const int r0w = min(max(rw - 4, 0), 56), c0A = min(max(qcA - 8, 0), 48), c0B = min(max(qcB - 8, 0), 48);
    const int kr_lo = min(max(4 * p - 4, 0), 56), kr_hi = min(max(4 * p + 3 - 4, 0), 56) + 7;
    const int nw = ctxq ? 0 : (kr_hi - kr_lo + 1);
    LAS bf16_t* ring = (LAS bf16_t*)F.lds;
    LAS float* btab = (LAS float*)(F.lds + NA_RING);
    const LAS bf16_t* cres = (const LAS bf16_t*)(F.lds + NA_CTX_OFF);
    const int dA = 4 * g - c0A, dB = 4 * g - c0B;
    unsigned mkA[2][4], mkB[2][4];
#pragma unroll
    for (int hh2 = 0; hh2 < 2; ++hh2)
#pragma unroll
        for (int w4 = 0; w4 < 4; ++w4) { const int cc = 32 * hh2 + 16 * (w4 >> 1) + 2 * (w4 & 1);
            mkA[hh2][w4] = (((unsigned)(cc + dA) < 16u) ? 0xFFFFu : 0u) | (((unsigned)(cc + 1 + dA) < 16u) ? 0xFFFF0000u : 0u);
            mkB[hh2][w4] = (((unsigned)(cc + dB) < 16u) ? 0xFFFFu : 0u) | (((unsigned)(cc + 1 + dB) < 16u) ? 0xFFFF0000u : 0u); }
    const int bcolA = NA_BT_OFF + 4 * g - qcA + 15;
    const int r = tid >> 3, c8 = tid & 7;
    u32x4 kA, vA, kB, vB;
#define NA_TOK0(t) (NCTX + 64 * (kr_lo + (t)))
#define NA_LOAD(t, kk, vv) do { const bf16_t* pr_ = proj + (size_t)(ROWS_CTX + b * SEQ + 64 * (kr_lo + (t)) + r) * 3072 + 8 * c8; kk = *(const u32x4*)(pr_ + 1024); vv = *(const u32x4*)(pr_ + 2048); } while (0)
#define NA_WRITE(bufi, kk, vv) do { LAS bf16_t* dst_ = ring + (bufi) * (2 * 64 * NA_LD); *(LAS u32x4*)(dst_ + r * NA_LD + 8 * c8) = na_knorm(kk); na_vscatter(dst_ + 64 * NA_LD, vv, r, c8); } while (0)
#define NA_TILE(t, bufi) do { const LAS bf16_t* KL = ring + (bufi) * (2 * 64 * NA_LD); const LAS bf16_t* VL = KL + 64 * NA_LD; \
        const int kr = kr_lo + (t); \
        if (kr >= r0w && kr <= r0w + 7) { const LAS float* brow = btab + (kr - rw + 7) * NA_BT_LD + bcolA; \
            if (ch == 0) { na_half2<true, true, true>(sa, sb, KL, VL, 0, qa, qb, brow, mkA[0], mkB[0], q16, g); na_half2<true, false, true>(sa, sb, KL, VL, 1, qa, qb, brow, mkA[1], mkB[1], q16, g); } \
            else { na_half2<true, true, false>(sa, sb, KL, VL, 0, qa, qb, brow, mkA[0], mkB[0], q16, g); na_half2<true, true, true>(sa, sb, KL, VL, 1, qa, qb, brow, mkA[1], mkB[1], q16, g); } } } while (0)
    if (!ctxq) { NA_LOAD(0, kA, vA); NA_LOAD(1, kB, vB); }
    if (ctxq) {
#pragma unroll 1
        for (int t = 0; t < 4; ++t) { const LAS bf16_t* KL = cres + t * (2 * 64 * NA_LD);
            na_half2<false, true, false>(sa, sb, KL, KL + 64 * NA_LD, 0, qa, qb, btab, mkA[0], mkB[0], q16, g); na_half2<false, true, false>(sa, sb, KL, KL + 64 * NA_LD, 1, qa, qb, btab, mkA[1], mkB[1], q16, g); }
    } else {
#pragma unroll 1
        for (int t = 0; t < 4; ++t) { const LAS bf16_t* KL = cres + t * (2 * 64 * NA_LD);
            na_half2<false, true, true>(sa, sb, KL, KL + 64 * NA_LD, 0, qa, qb, btab, mkA[0], mkB[0], q16, g); na_half2<false, true, true>(sa, sb, KL, KL + 64 * NA_LD, 1, qa, qb, btab, mkA[1], mkB[1], q16, g); }
        NA_WRITE(0, kA, vA);
        __syncthreads();
        NA_LOAD(2, kA, vA);
        for (int t = 0; t < nw; t += 2) {
            NA_TILE(t, 0);
            if (t + 1 < nw) NA_WRITE(1, kB, vB);
            __syncthreads();
            if (t + 3 < nw) NA_LOAD(t + 3, kB, vB);
            if (t + 1 >= nw) break;
            NA_TILE(t + 1, 1);
            if (t + 2 < nw) NA_WRITE(0, kA, vA);
            __syncthreads();
            if (t + 4 < nw) NA_LOAD(t + 4, kA, vA);
        }
    }
#undef NA_TOK0
#undef NA_LOAD
#undef NA_WRITE
#undef NA_TILE
    {
        const float inv = 1.0f / sa.osum[0];
        const int row = ctxq ? b * NCTX + p * 128 + wave * 16 + q16 : ROWS_CTX + b * SEQ + rw * 64 + qcA;
        bf16_t* op = (bf16_t*)(wsp(F) + WS_AO) + (size_t)row * D + h * 64 + 4 * g;
#pragma unroll
        for (int j4 = 0; j4 < 4; ++j4) { u32x2 w; w.x = pk2(sa.o[j4][0] * inv, sa.o[j4][1] * inv); w.y = pk2(sa.o[j4][2] * inv, sa.o[j4][3] * inv); *(u32x2*)(op + 16 * j4) = w; }
    }
    if (!ctxq) {
        const float inv = 1.0f / sb.osum[0];
        const int row = ROWS_CTX + b * SEQ + rw * 64 + qcB;
        bf16_t* op = (bf16_t*)(wsp(F) + WS_AO) + (size_t)row * D + h * 64 + 4 * g;
#pragma unroll
        for (int j4 = 0; j4 < 4; ++j4) { u32x2 w; w.x = pk2(sb.o[j4][0] * inv, sb.o[j4][1] * inv); w.y = pk2(sb.o[j4][2] * inv, sb.o[j4][3] * inv); *(u32x2*)(op + 16 * j4) = w; }
    }
}
__device__ __forceinline__ void phase_na_attn(Frame& F, int jn) {
    const int nbh = NB * NH_NA;
    for (int slot = F.vcu; slot < 2 * nbh; slot += F.G) {
        const int bh = slot >> 1, hf = slot & 1, b = bh >> 4, h = bh & 15;
        {
            LAS float* btab = (LAS float*)(F.lds + NA_RING);
            const float* rpb = inp(F, I_RPB) + (size_t)(jn * NH_NA + h) * 15 * 31;
            for (int i = F.tid; i < 15 * NA_BT_LD; i += NTHREADS) { const int dr = i >> 7, c = (i & 127) - NA_BT_OFF; btab[i] = (c >= 0 && c < 31) ? rpb[dr * 31 + c] * 1.44269504f : 0.f; }
            const bf16_t* proj = (const bf16_t*)(wsp(F) + WS_PROJ) + h * 64;
            LAS bf16_t* cres = (LAS bf16_t*)(F.lds + NA_CTX_OFF); const int r = F.tid >> 3, c8 = F.tid & 7;
            if (F.tid < 64) ((LAS float*)(F.lds + NA_GQK_OFF))[F.tid] = inp(F, I_QGAIN)[jn * 64 + F.tid] * inp(F, I_KGAIN)[jn * 64 + F.tid] * (0.125f * 1.44269504f);
            u32x4 ck[4], cv[4];
#pragma unroll
            for (int t = 0; t < 4; ++t) { const bf16_t* pr = proj + (size_t)(b * NCTX + 64 * t + r) * 3072 + 8 * c8; ck[t] = *(const u32x4*)(pr + 1024); cv[t] = *(const u32x4*)(pr + 2048); }
#pragma unroll
            for (int t = 0; t < 4; ++t) { LAS bf16_t* dst = cres + t * (2 * 64 * NA_LD);
                *(LAS u32x4*)(dst + r * NA_LD + 8 * c8) = na_knorm(ck[t]);
                na_vscatter(dst + 64 * NA_LD, cv[t], r, c8); }
            __syncthreads();
        }
        for (int n = 0; n < 8; ++n) na_block_task(F, jn, b, h, false, hf * 8 + n);
        na_block_task(F, jn, b, h, true, hf);
        __syncthreads();
    }
}

__device__ __forceinline__ void row_decode(int row, int& b, int& tp) {
    if (row < ROWS_CTX) { b = row >> 8; tp = row & 255; } else { b = (row - ROWS_CTX) >> 12; tp = NCTX + ((row - ROWS_CTX) & 4095); }
}
__device__ __forceinline__ void unpack8(const u32x4 v, float (&f)[8]) { f[0] = bflo(v.x); f[1] = bfhi(v.x); f[2] = bflo(v.y); f[3] = bfhi(v.y); f[4] = bflo(v.z); f[5] = bfhi(v.z); f[6] = bflo(v.w); f[7] = bfhi(v.w); }
__device__ __forceinline__ u32x4 pack8(const float (&f)[8]) { u32x4 o; o.x = pk2(f[0], f[1]); o.y = pk2(f[2], f[3]); o.z = pk2(f[4], f[5]); o.w = pk2(f[6], f[7]); return o; }
__device__ __forceinline__ float wave_prefix_sum(float v, int lane) {
#pragma unroll
    for (int o = 1; o < 64; o <<= 1) { const float t = shfl_(v, lane - o); if (lane >= o) v += t; }
    return v;
}
__device__ __forceinline__ float wave_prefix_max(float v, int lane) {
#pragma unroll
    for (int o = 1; o < 64; o <<= 1) { const float t = shfl_(v, lane - o); if (lane >= o) v = fmaxf(v, t); }
    return v;
}
__device__ __forceinline__ int ml_grow(int b, int tp) { return tp < NCTX ? b * NCTX + tp : ROWS_CTX + b * SEQ + (tp - NCTX); }
__device__ __forceinline__ void phase_ml_post(Frame& F, int jm) {
    const int gw = F.vcu * NWAVES + F.wave, NGW = F.G * NWAVES, lane = F.lane;
    const bf16_t* proj = (const bf16_t*)(wsp(F) + WS_PROJ);
    float* gs = (float*)(wsp(F) + WS_GS);
    for (int task = gw; task < NB * (TT / 64); task += NGW) {
        const int b = task / (TT / 64), mc = task % (TT / 64);
        const bf16_t* pr = proj + (size_t)ml_grow(b, mc * 64 + lane) * ML_INP + 3072;
        float gp[32];
        { float t8[8];
#pragma unroll
          for (int q = 0; q < 4; ++q) { unpack8(*(const u32x4*)(pr + 8 * q), t8);
#pragma unroll
              for (int e = 0; e < 8; ++e) gp[8 * q + e] = t8[e]; } }
#pragma unroll
        for (int i = 0; i < 32; ++i) { float v = gp[i] + inp(F, I_BGATE)[jm * 32 + i]; v = 15.0f * tanhf(v * (1.0f / 15.0f));
            if ((i >> 3) & 1) v = fminf(v, 0.f) - log1pf(__expf(-fabsf(v)));
            gp[i] = v; }
#pragma unroll
        for (int dir = 0; dir < 2; ++dir)
#pragma unroll
            for (int hh = 0; hh < NH_ML; ++hh) {
                float ig = gp[(2 * dir) * 8 + hh], lf = gp[(2 * dir + 1) * 8 + hh];
                if (dir) { ig = shfl_(ig, 63 - lane); lf = shfl_(lf, 63 - lane); }
                const float cum = wave_prefix_sum(lf, lane), av = ig - cum, pmax = wave_prefix_max(av, lane), cl = shfl_(cum, 63);
                const float wend = cl - cum + ig, ml = wave_max(wend), eend = __expf(wend - ml);
                float* o = gs + ((((size_t)(dir * NB + b) * NH_ML + hh) * (TT / 64) + mc) * 5) * 64;
                o[lane] = cum; o[64 + lane] = av; o[128 + lane] = pmax; o[192 + lane] = eend; if (lane == 0) { o[256] = cl; o[257] = ml; }
            }
    }
}

constexpr int ML_LD = 72;
constexpr int ML_QL = 0, ML_KL = 9216, ML_KET = 18432, ML_VTL = 27648, ML_SDL = 36864, ML_C0L = 46080, ML_N0L = 55296, ML_DENL = 55552;
constexpr int ML_HL = 55808, ML_GL = 65024;
constexpr int ML_ALT = 69632;
__device__ __forceinline__ void ml_task(Frame& F, int jm, int b, int hh, int dir, int vh) {
    const int tid = F.tid, lane = F.lane, w = F.wave, l15 = lane & 15, g = lane >> 4;
    LAS bf16_t* QL = (LAS bf16_t*)(F.lds + ML_QL); LAS bf16_t* KL = (LAS bf16_t*)(F.lds + ML_KL); LAS bf16_t* KET = (LAS bf16_t*)(F.lds + ML_KET);
    LAS bf16_t* VTL = (LAS bf16_t*)(F.lds + ML_VTL); LAS bf16_t* SDL = (LAS bf16_t*)(F.lds + ML_SDL); LAS bf16_t* C0L = (LAS bf16_t*)(F.lds + ML_C0L);
    LAS float* n0L = (LAS float*)(F.lds + ML_N0L); LAS float* denL = (LAS float*)(F.lds + ML_DENL);
    LAS bf16_t* HL = (LAS bf16_t*)(F.lds + ML_HL); LAS float* GL = (LAS float*)(F.lds + ML_GL);
    const bf16_t* proj = (const bf16_t*)(wsp(F) + WS_PROJ);
    const float* gsb = (const float*)(wsp(F) + WS_GS) + (((size_t)(dir * NB + b) * NH_ML + hh) * (TT / 64)) * 5 * 64;
    bf16_t* hout = (bf16_t*)(wsp(F) + WS_HDIR) + (size_t)dir * ROWS * D + hh * DV_ML + vh * 64;
    {
        const float bi = inp(F, I_BGATE)[jm * 32 + (2 * dir) * 8 + hh], bfg = inp(F, I_BGATE)[jm * 32 + (2 * dir + 1) * 8 + hh];
        float* gso = (float*)(wsp(F) + WS_GS) + (((size_t)(dir * NB + b) * NH_ML + hh) * (TT / 64)) * 5 * 64;
        for (int mc = w; mc < TT / 64; mc += NWAVES) {
            const bf16_t* pr = proj + (size_t)ml_grow(b, mc * 64 + lane) * ML_INP + 3072;
            float ig = bf2f(pr[(2 * dir) * 8 + hh]) + bi; ig = 15.0f * tanhf(ig * (1.0f / 15.0f));
            float lf = bf2f(pr[(2 * dir + 1) * 8 + hh]) + bfg; lf = 15.0f * tanhf(lf * (1.0f / 15.0f)); lf = fminf(lf, 0.f) - log1pf(__expf(-fabsf(lf)));
            if (dir) { ig = shfl_(ig, 63 - lane); lf = shfl_(lf, 63 - lane); }
            const float cum = wave_prefix_sum(lf, lane), av = ig - cum, pmax = wave_prefix_max(av, lane), cl = shfl_(cum, 63);
            const float wend = cl - cum + ig, ml = wave_max(wend), eend = __expf(wend - ml);
            float* o = gso + (size_t)mc * 5 * 64;
            o[lane] = cum; o[64 + lane] = av; o[128 + lane] = pmax; o[192 + lane] = eend; if (lane == 0) { o[256] = cl; o[257] = ml; }
        }
        VM_WAIT();
        __syncthreads();
    }
    const bool loader = (0x2Bu >> w) & 1u;
    const int ridx = __builtin_popcount((loader ? 0x2Bu : 0xD4u) & ((1u << w) - 1u));
    const int c8 = lane & 7, r0 = ridx * 8 + (lane >> 3);
    const int bt = w >> 1, bc0 = 2 * (w & 1);
    for (int i = tid; i < 64 * ML_LD / 2; i += NTHREADS) { ((LAS unsigned*)C0L)[i] = 0u; ((LAS unsigned*)SDL)[i] = 0u; }
    if (tid < 64) n0L[tid] = 0.f;
    f32x4 Cst[2]; Cst[0] = (f32x4){0.f, 0.f, 0.f, 0.f}; Cst[1] = (f32x4){0.f, 0.f, 0.f, 0.f};
    float nst = 0.f, m0 = 0.f;
#ifdef MLPROF
    unsigned long long pa_[6] = {0, 0, 0, 0, 0, 0}, pt_; asm volatile("s_memtime %0\n\ts_waitcnt lgkmcnt(0)" : "=s"(pt_) :: "memory");
#define PROFPT(k) do { unsigned long long n_; __builtin_amdgcn_sched_barrier(0); asm volatile("s_memtime %0\n\ts_waitcnt lgkmcnt(0)" : "=s"(n_) :: "memory"); __builtin_amdgcn_sched_barrier(0); pa_[k] += n_ - pt_; pt_ = n_; } while (0)
#else
#define PROFPT(k) do {} while (0)
#endif
    u32x4 qA[2], kA[2], vA[2]; float gA[6];
#define ML_TB(c) (dir ? ((c) < 4 ? 192 - 64 * (c) : 4544 - 64 * (c)) : 64 * (c))
#ifdef MLHOT
#define ML_TBL(cn) ML_TB(0)
#else
#define ML_TBL(cn) ML_TB(cn)
#endif
#define ML_LOADSET(cn, QV, KV, VV, GG) do { const int tbn_ = ML_TBL(cn); \
        _Pragma("unroll") for (int h2 = 0; h2 < 2; ++h2) { const bf16_t* pr_ = proj + (size_t)ml_grow(b, tbn_ + r0 + 32 * h2) * ML_INP; \
            QV[h2] = *(const u32x4*)(pr_ + hh * 64 + c8 * 8); KV[h2] = *(const u32x4*)(pr_ + 512 + hh * 64 + c8 * 8); VV[h2] = *(const u32x4*)(pr_ + 1024 + hh * DV_ML + vh * 64 + c8 * 8); } \
        const float* gp_ = gsb + (size_t)(tbn_ >> 6) * 5 * 64; \
        GG[0] = gp_[lane]; GG[1] = gp_[64 + lane]; GG[2] = gp_[128 + lane]; GG[3] = gp_[192 + lane]; GG[4] = gp_[256]; GG[5] = gp_[257]; } while (0)
#define ML_WRITESET(PBW, QV, KV, VV, GG) do { LAS bf16_t* QLw = QL + (PBW) * (ML_ALT / 2); LAS bf16_t* KLw = KL + (PBW) * (ML_ALT / 2); LAS bf16_t* KETw = KET + (PBW) * (ML_ALT / 2); LAS bf16_t* VTLw = VTL + (PBW) * (ML_ALT / 2); LAS float* GLw = GL + (PBW) * (ML_ALT / 4); \
        _Pragma("unroll") for (int h2 = 0; h2 < 2; ++h2) { const int rr_ = r0 + 32 * h2, sr = dir ? 63 - rr_ : rr_; \
            *(LAS u32x4*)(QLw + sr * ML_LD + c8 * 8) = QV[h2]; *(LAS u32x4*)(KLw + sr * ML_LD + c8 * 8) = KV[h2]; \
            const float es = shfl_(GG[3], sr); float kf[8]; unpack8(KV[h2], kf); const unsigned vw[4] = {VV[h2].x, VV[h2].y, VV[h2].z, VV[h2].w}; \
            _Pragma("unroll") for (int e = 0; e < 8; ++e) { KETw[(c8 * 8 + e) * ML_LD + (sr ^ (8 * c8))] = (bf16_t)pk2(kf[e] * es, 0.f); VTLw[(c8 * 8 + e) * ML_LD + (sr ^ (8 * c8))] = (bf16_t)((vw[e >> 1] >> (16 * (e & 1))) & 0xffffu); } } \
        if (w == 0) { GLw[lane] = GG[0]; GLw[64 + lane] = GG[1]; GLw[128 + lane] = GG[2]; if (lane == 0) { GLw[192] = GG[4]; GLw[193] = GG[5]; } } } while (0)
#define ML_STOREH(cp) do { const int tbp_ = ML_TB(cp); \
        _Pragma("unroll") for (int h2 = 0; h2 < 2; ++h2) { const int rr_ = r0 + 32 * h2; \
            *(u32x4*)(hout + (size_t)ml_grow(b, tbp_ + rr_) * D + c8 * 8) = *(const LAS u32x4*)(HL + rr_ * ML_LD + c8 * 8); } } while (0)
#define ML_CHUNK(c, PB, QV, KV, VV, GG) do {     \
        const int tb = ML_TB(c); \
        LAS bf16_t* QLc = QL + (PB) * (ML_ALT / 2); LAS bf16_t* KLc = KL + (PB) * (ML_ALT / 2); LAS bf16_t* KETc = KET + (PB) * (ML_ALT / 2); LAS bf16_t* VTLc = VTL + (PB) * (ML_ALT / 2); LAS float* GLc = GL + (PB) * (ML_ALT / 4); \
        const float cum = GLc[lane], av = GLc[64 + lane], pmax = GLc[128 + lane], cl = GLc[192], ml = GLc[193]; \
        const float Mv = fmaxf(m0, pmax); \
        const float winter = __expf(m0 - Mv); \
        const float floorv = __expf(-(cum + Mv)); \
        const float mnew = fmaxf(cl + m0, ml); \
        const float Ac = __expf(cl + m0 - mnew), Gc = __expf(ml - mnew); \
        _Pragma("unroll") for (int x = 0; x < 2; ++x) { \
            const int bs = bc0 + x; \
            if (bs <= bt) {     \
                f32x4 acc = (f32x4){0.f, 0.f, 0.f, 0.f}; \
                _Pragma("unroll") for (int ks = 0; ks < 2; ++ks) { const bf16x8 af = *(const LAS bf16x8*)(QLc + (16 * bt + l15) * ML_LD + 32 * ks + 8 * g), bfv = *(const LAS bf16x8*)(KLc + (16 * bs + l15) * ML_LD + 32 * ks + 8 * g); \
                    acc = __builtin_amdgcn_mfma_f32_16x16x32_bf16(af, bfv, acc, 0, 0, 0); } \
                const int s = 16 * bs + l15; \
                const float a_s = shfl_(av, s); \
                _Pragma("unroll") for (int rg = 0; rg < 4; ++rg) { const int t = 16 * bt + 4 * g + rg; const float M_t = shfl_(Mv, t); \
                    const float val = (s <= t) ? acc[rg] * __expf(a_s - M_t) : 0.f; \
                    SDL[t * ML_LD + s] = (bf16_t)pk2(val, 0.f); } \
            } \
        } \
        if (loader) { if ((c) + 1 < TT / 64) ML_WRITESET(1 - (PB), QV, KV, VV, GG); if ((c) + 2 < TT / 64) ML_LOADSET((c) + 2, QV, KV, VV, GG); }     \
        PROFPT(2); __syncthreads(); PROFPT(3);                                                 \
        if (!loader && (c) > 0) ML_STOREH((c) - 1); \
        { \
            const int rr8 = 8 * w + (lane >> 3), part = lane & 7; \
            float sd[8], qf[8], kf[8]; \
            unpack8(*(const LAS u32x4*)(SDL + rr8 * ML_LD + 8 * part), sd); unpack8(*(const LAS u32x4*)(QLc + rr8 * ML_LD + 8 * part), qf); \
            unpack8(*(const LAS u32x4*)(KETc + rr8 * ML_LD + ((8 * part) ^ (8 * ((rr8 >> 3) & 7)))), kf); \
            const f32x4 n0a = *(const LAS f32x4*)(n0L + 8 * part), n0b = *(const LAS f32x4*)(n0L + 8 * part + 4); \
            float rs = ((sd[0] + sd[1]) + (sd[2] + sd[3])) + ((sd[4] + sd[5]) + (sd[6] + sd[7])); \
            float qn = qf[0] * n0a[0] + qf[1] * n0a[1] + qf[2] * n0a[2] + qf[3] * n0a[3] + qf[4] * n0b[0] + qf[5] * n0b[1] + qf[6] * n0b[2] + qf[7] * n0b[3]; \
            float dn = ((kf[0] + kf[1]) + (kf[2] + kf[3])) + ((kf[4] + kf[5]) + (kf[6] + kf[7])); \
            rs = sum8(rs); qn = sum8(qn); dn = sum8(dn); \
            const float w_r = shfl_(winter, rr8); \
            if (part == 0) denL[rr8] = rs + w_r * qn; \
            nst = Ac * nst + Gc * dn; \
        } \
        f32x4 nin[2], nit[2]; \
        _Pragma("unroll") for (int x = 0; x < 2; ++x) { \
            const int bv = bc0 + x; \
            f32x4 a1 = (f32x4){0.f, 0.f, 0.f, 0.f}, a2 = (f32x4){0.f, 0.f, 0.f, 0.f}, a3 = (f32x4){0.f, 0.f, 0.f, 0.f}; \
            _Pragma("unroll") for (int ks = 0; ks < 2; ++ks) { \
                const bf16x8 sdf = *(const LAS bf16x8*)(SDL + (16 * bt + l15) * ML_LD + 32 * ks + 8 * g), vtf = *(const LAS bf16x8*)(VTLc + (16 * bv + l15) * ML_LD + ((32 * ks + 8 * g) ^ (8 * (((16 * bv + l15) >> 3) & 7)))); \
                const bf16x8 qf = *(const LAS bf16x8*)(QLc + (16 * bt + l15) * ML_LD + 32 * ks + 8 * g), c0f = *(const LAS bf16x8*)(C0L + (16 * bv + l15) * ML_LD + 32 * ks + 8 * g); \
                const bf16x8 vt2 = *(const LAS bf16x8*)(VTLc + (16 * bt + l15) * ML_LD + ((32 * ks + 8 * g) ^ (8 * (((16 * bt + l15) >> 3) & 7)))), kef = *(const LAS bf16x8*)(KETc + (16 * bv + l15) * ML_LD + ((32 * ks + 8 * g) ^ (8 * (((16 * bv + l15) >> 3) & 7)))); \
                a1 = __builtin_amdgcn_mfma_f32_16x16x32_bf16(sdf, vtf, a1, 0, 0, 0); \
                a2 = __builtin_amdgcn_mfma_f32_16x16x32_bf16(qf, c0f, a2, 0, 0, 0); \
                a3 = __builtin_amdgcn_mfma_f32_16x16x32_bf16(vt2, kef, a3, 0, 0, 0); \
            } \
            nin[x] = a1; nit[x] = a2; \
            Cst[x] = Cst[x] * Ac + a3 * Gc; \
        } \
        PROFPT(4); __syncthreads(); PROFPT(3);                                                 \
        if ((lane & 7) == 0) n0L[8 * w + (lane >> 3)] = nst; \
        _Pragma("unroll") for (int x = 0; x < 2; ++x) { \
            const int bv = bc0 + x; \
            _Pragma("unroll") for (int rg = 0; rg < 4; ++rg) { const int t = 16 * bt + 4 * g + rg; \
                const float den = denL[t], w_t = shfl_(winter, t), fl_t = shfl_(floorv, t); \
                const float hv = (nin[x][rg] + w_t * nit[x][rg]) * __builtin_amdgcn_rcpf(fmaxf(fabsf(den), fl_t)); \
                const int rr = dir ? 63 - t : t; \
                HL[rr * ML_LD + 16 * bv + l15] = (bf16_t)pk2(hv, 0.f); \
                C0L[(16 * bt + 4 * g + rg) * ML_LD + 16 * bv + l15] = (bf16_t)pk2(Cst[x][rg], 0.f); } \
        } \
        m0 = mnew; \
        (void)tb; PROFPT(5); \
    } while (0)
    if (loader) { ML_LOADSET(0, qA, kA, vA, gA); ML_WRITESET(0, qA, kA, vA, gA); ML_LOADSET(1, qA, kA, vA, gA); }
    __syncthreads();
    for (int c = 0; c < TT / 64; c += 2) {
        ML_CHUNK(c, 0, qA, kA, vA, gA);
        ML_CHUNK(c + 1, 1, qA, kA, vA, gA);
    }
    __syncthreads();
    if (!loader) ML_STOREH(TT / 64 - 1);
#ifdef MLPROF
    if (F.vcu == MLPROF_BLK && tid == MLPROF_WAVE * 64) { unsigned long long* pp = (unsigned long long*)(wsp(F) + WS_CTL + 524288); pp[0] = pa_[0]; pp[1] = pa_[1]; pp[2] = pa_[2]; pp[3] = pa_[3]; pp[4] = pa_[4]; pp[5] = pa_[5]; }
#endif
#undef ML_CHUNK
#undef ML_STOREH
#undef ML_WRITESET
#undef ML_LOADSET
#undef ML_TB
    __syncthreads();
}
__device__ __forceinline__ void phase_ml_scan(Frame& F, int jm) {
    for (int task = F.vcu; task < NB * NH_ML * 4; task += F.G) {
        const int vh = task & 1, dir = (task >> 1) & 1, bh = task >> 2;
        ml_task(F, jm, bh >> 3, bh & 7, dir, vh);
    }
}

__device__ __forceinline__ void phase_ml_final(Frame& F, int jm) {
    const int gw = F.vcu * NWAVES + F.wave, NGW = F.G * NWAVES, lane = F.lane;
    const bf16_t* hfw = (const bf16_t*)(wsp(F) + WS_HDIR); const bf16_t* hbw = hfw + (size_t)ROWS * D;
    const bf16_t* proj = (const bf16_t*)(wsp(F) + WS_PROJ);
    bf16_t* ao = (bf16_t*)(wsp(F) + WS_AO);
    const float* gain = inp(F, I_MHGAIN) + jm * D + lane * 16;
    for (int row = gw; row < ROWS; row += NGW) {
        const size_t off = (size_t)row * D + lane * 16;
        float a0[8], a1[8], b0[8], b1[8], g0[8], g1[8];
        unpack8(*(const u32x4*)(hfw + off), a0); unpack8(*(const u32x4*)(hfw + off + 8), a1);
        unpack8(*(const u32x4*)(hbw + off), b0); unpack8(*(const u32x4*)(hbw + off + 8), b1);
        const bf16_t* ogp = proj + (size_t)row * ML_INP + 2048 + lane * 16;
        unpack8(*(const u32x4*)ogp, g0); unpack8(*(const u32x4*)(ogp + 8), g1);
        float ss = 0.f;
#pragma unroll
        for (int e = 0; e < 8; ++e) { a0[e] += b0[e]; a1[e] += b1[e]; ss += a0[e] * a0[e] + a1[e] * a1[e]; }
        ss = sum8(ss);
        const float rs = 1.0f / sqrtf(ss * (1.f / DV_ML) + EPS);
        float o0[8], o1[8];
#pragma unroll
        for (int e = 0; e < 8; ++e) { o0[e] = a0[e] * rs * gain[e] * sigmoidf_(g0[e]); o1[e] = a1[e] * rs * gain[8 + e] * sigmoidf_(g1[e]); }
        *(u32x4*)(ao + off) = pack8(o0); *(u32x4*)(ao + off + 8) = pack8(o1);
    }
}

constexpr int RT_LD = 1032;
constexpr int RT_HI = 0, RT_LO = NE * RT_LD * 2, RT_LG = 2 * NE * RT_LD * 2;
__device__ __forceinline__ int rows_per_block(int first_row, int G) { return (ROWS - first_row + G - 1) / G; }
constexpr int NCB = 32;
__device__ __forceinline__ bool ctx_split(int first_row, int G) { return first_row == 0 && G > 2 * NCB; }
__device__ __forceinline__ void block_rows(int first_row, int vcu, int G, int& rbeg, int& rend) {
    if (ctx_split(first_row, G)) {
        if (vcu < NCB) { const int per = ROWS_CTX / NCB; rbeg = vcu * per; rend = rbeg + per; }
        else { const int per = (ROWS - ROWS_CTX + (G - NCB) - 1) / (G - NCB); rbeg = min(ROWS_CTX + (vcu - NCB) * per, ROWS); rend = min(rbeg + per, ROWS); }
    } else { const int RPB = rows_per_block(first_row, G); rbeg = min(first_row + vcu * RPB, ROWS); rend = min(rbeg + RPB, ROWS); }
}
__device__ __forceinline__ void phase_norm2_router(Frame& F, int l, int first_row) {
    const int tid = F.tid, lane = F.lane, wave = F.wave, l15 = lane & 15, g = lane >> 4;
    LAS bf16_t* whi = (LAS bf16_t*)(F.lds + RT_HI); LAS bf16_t* wlo = (LAS bf16_t*)(F.lds + RT_LO);
    LAS float* lgs = (LAS float*)(F.lds + RT_LG) + wave * (16 * 33);
    volatile LAS int* cntL = F.LCTL + 64;
    {
        const bf16_t* rt = (const bf16_t*)(wsp(F) + WS_RT) + (size_t)l * 2 * NE * D;
#pragma unroll 4
        for (int c = tid; c < 2 * NE * 128; c += NTHREADS) { const int tbl = c >> 12, e = (c >> 7) & 31, kc = c & 127;
            *(LAS u32x4*)((tbl ? wlo : whi) + e * RT_LD + kc * 8) = *(const u32x4*)(rt + ((size_t)tbl * NE + e) * D + kc * 8); }
    }
    if (tid < NE) cntL[tid] = 0;
    const bf16_t* xs = (const bf16_t*)(wsp(F) + WS_XS); bf16_t* hb = (bf16_t*)(wsp(F) + WS_HB);
    int* tope = (int*)(wsp(F) + WS_TOPE); float* topw = (float*)(wsp(F) + WS_TOPW);
    const f32x4* gm = (const f32x4*)(inp(F, I_GFFN) + l * D) + lane;
    int rbeg, rend; block_rows(first_row, F.vcu, F.G, rbeg, rend);
    for (int row = rbeg + wave; row < rend; row += NWAVES) {
        const int mb = row_mb(row);
        const u32x2* xr = (const u32x2*)(xs + (size_t)row * D) + lane;
        f32x4 v[4]; float ss = 0.f;
#pragma unroll
        for (int j = 0; j < 4; ++j) { v[j] = bf4_to_f32(xr[64 * j]); ss += (v[j][0] * v[j][0] + v[j][1] * v[j][1]) + (v[j][2] * v[j][2] + v[j][3] * v[j][3]); }
        const float rs = 1.0f / sqrtf(wave_sum(ss) * (1.f / D) + EPS);
        const f32x4* sh = (const f32x4*)modp(F, l, mb, 3) + lane; const f32x4* sc = (const f32x4*)modp(F, l, mb, 4) + lane;
        u32x2* o8 = (u32x2*)(hb + (size_t)row * D) + lane;
        unsigned* o4 = (unsigned*)(wsp(F) + WS_HB8 + (size_t)row * D) + lane;
#pragma unroll
        for (int j = 0; j < 4; ++j) { const f32x4 h = (v[j] * rs) * gm[64 * j] * (sc[64 * j] + 1.0f) + sh[64 * j];
            u32x2 wv; wv.x = pk2(h[0], h[1]); wv.y = pk2(h[2], h[3]); o8[64 * j] = wv;
            const f32x4 hq = __builtin_elementwise_min(__builtin_elementwise_max(h * 16.0f, (f32x4){-448.f, -448.f, -448.f, -448.f}), (f32x4){448.f, 448.f, 448.f, 448.f});
            o4[64 * j] = pk4_fp8(hq[0], hq[1], hq[2], hq[3]); }
    }
    VM_WAIT();
    __syncthreads();
    const float br0 = inp(F, I_BR)[l * NE + l15], br1 = inp(F, I_BR)[l * NE + 16 + l15];
    for (int g0 = rbeg + 16 * wave; g0 < rend; g0 += 16 * NWAVES) {
        const int arow = min(g0 + l15, rend - 1);
        const bf16_t* ap = hb + (size_t)arow * D + 8 * g;
        f32x4 acc0 = (f32x4){0.f, 0.f, 0.f, 0.f}, acc1 = (f32x4){0.f, 0.f, 0.f, 0.f};
        bf16x8 afr[32];
#pragma unroll
        for (int ks = 0; ks < 32; ++ks) afr[ks] = *(const bf16x8*)(ap + 32 * ks);
#pragma unroll
        for (int ks = 0; ks < 32; ++ks) {
            const bf16x8 af = afr[ks];
            const bf16x8 h0 = *(const LAS bf16x8*)(whi + l15 * RT_LD + 32 * ks + 8 * g), h1 = *(const LAS bf16x8*)(whi + (16 + l15) * RT_LD + 32 * ks + 8 * g);
            const bf16x8 l0 = *(const LAS bf16x8*)(wlo + l15 * RT_LD + 32 * ks + 8 * g), l1 = *(const LAS bf16x8*)(wlo + (16 + l15) * RT_LD + 32 * ks + 8 * g);
            acc0 = __builtin_amdgcn_mfma_f32_16x16x32_bf16(af, h0, acc0, 0, 0, 0); acc1 = __builtin_amdgcn_mfma_f32_16x16x32_bf16(af, h1, acc1, 0, 0, 0);
            acc0 = __builtin_amdgcn_mfma_f32_16x16x32_bf16(af, l0, acc0, 0, 0, 0); acc1 = __builtin_amdgcn_mfma_f32_16x16x32_bf16(af, l1, acc1, 0, 0, 0);
        }
#pragma unroll
        for (int rg = 0; rg < 4; ++rg) { lgs[(4 * g + rg) * 33 + l15] = acc0[rg] + br0; lgs[(4 * g + rg) * 33 + 16 + l15] = acc1[rg] + br1; }
        LDS_WAIT(); asm volatile("" ::: "memory");
        const int row = g0 + lane;
        if (lane < 16 && row < rend) {
            float lg[32];
#pragma unroll
            for (int e = 0; e < 32; ++e) lg[e] = lgs[lane * 33 + e];
            int sel[4]; float sv[4]; unsigned used = 0u;
#pragma unroll
            for (int k = 0; k < 4; ++k) { float best = -3.0e38f; int bi = 0;
#pragma unroll
                for (int e = 0; e < 32; ++e) { const bool take = !((used >> e) & 1u) && (lg[e] > best); best = take ? lg[e] : best; bi = take ? e : bi; }
                used |= 1u << bi; sel[k] = bi; sv[k] = best; }
            const float e1 = __expf(sv[1] - sv[0]), e2 = __expf(sv[2] - sv[0]), e3 = __expf(sv[3] - sv[0]);
            const float inv = 1.0f / (1.0f + e1 + e2 + e3);
            *(int4*)(tope + (size_t)row * 4) = make_int4(sel[0], sel[1], sel[2], sel[3]);
            *(float4*)(topw + (size_t)row * 4) = make_float4(inv, e1 * inv, e2 * inv, e3 * inv);
#pragma unroll
            for (int k = 0; k < 4; ++k) __hip_atomic_fetch_add((LAS int*)&cntL[sel[k]], 1, __ATOMIC_RELAXED, __HIP_MEMORY_SCOPE_WORKGROUP);
        }
        LDS_WAIT(); asm volatile("" ::: "memory");
    }
    __syncthreads();
    if (tid < NE) ((int*)(wsp(F) + WS_CNT))[F.vcu * NE + tid] = cntL[tid];
}

__device__ __forceinline__ void phase_positions(Frame& F, int first_row) {
    const int tid = F.tid, lane = F.lane;
    LAS int* tot = (LAS int*)F.lds;
    LAS int* bef = tot + 512;
    LAS int* baseL = bef + 512;
    LAS int* totL = baseL + 32;
    const int* cnt = (const int*)(wsp(F) + WS_CNT);
    {
        const int e = tid & 31, part = tid >> 5;
        int s = 0, sb = 0;
        for (int j = part; j < F.G; j += 16) { const int cv = cnt[j * NE + e]; s += cv; sb += (j < F.vcu) ? cv : 0; }
        tot[part * 32 + e] = s; bef[part * 32 + e] = sb;
    }
    __syncthreads();
    if (tid < NE) { int s = 0, sb = 0;
        for (int p = 0; p < 16; ++p) { s += tot[p * 32 + tid]; sb += bef[p * 32 + tid]; }
        totL[tid] = s; baseL[tid] = sb; }
    __syncthreads();
    if (F.wave == 0) {
        const int mine = (lane < NE) ? ((totL[lane & 31] + 255) >> 8) : 0;
        int inc = mine;
#pragma unroll
        for (int d = 1; d < 32; d <<= 1) { const int o = shfl_(inc, lane - d); inc += (lane >= d) ? o : 0; }
        if (lane < NE) F.LCTL[8 + lane] = inc - mine;
        if (lane == NE - 1) { F.LCTL[8 + NE] = inc; F.LCTL[48] = inc; }
    }
    __syncthreads();
    int* tokmap = (int*)(wsp(F) + WS_TOKMAP);
    if (F.vcu == 0) {
        int* meta = (int*)(wsp(F) + WS_META);
        if (tid <= NE) meta[tid] = F.LCTL[8 + tid];
        if (tid == 0) meta[33] = F.LCTL[48];
        { const int e = tid >> 4, rb = 256 * F.LCTL[8 + e], n = totL[e], cap = 256 * (F.LCTL[8 + e + 1] - F.LCTL[8 + e]);
            for (int rr = n + (tid & 15); rr < cap; rr += 16) tokmap[rb + rr] = first_row; }
    }
    {
        const int* tope = (const int*)(wsp(F) + WS_TOPE); int* pos = (int*)(wsp(F) + WS_POS);
        const int e0 = 4 * F.wave;
        int basereg = (lane < 4) ? 256 * F.LCTL[8 + e0 + lane] + baseL[e0 + lane] : 0;
        int rbeg, rend; block_rows(first_row, F.vcu, F.G, rbeg, rend);
        for (int r0 = rbeg; r0 < rend; r0 += 16) {
            const int row = r0 + (lane >> 2), k = lane & 3;
            const bool valid = row < rend;
            const int e = valid ? tope[(size_t)row * 4 + k] : -1;
            int p = -1;
#pragma unroll
            for (int j = 0; j < 4; ++j) {
                const unsigned long long mask = __ballot(e == e0 + j);
                const int b0 = shfl_(basereg, j);
                if (e == e0 + j) p = b0 + __popcll(mask & ((1ull << lane) - 1ull));
                if (lane == j) basereg += __popcll(mask);
            }
            if (p >= 0) { pos[(size_t)row * 4 + k] = p; tokmap[p] = row; }
        }
    }
}

#ifndef PMASK
#define PMASK 0xFFFF
#endif
#define PE(k) (((PMASK) >> (k)) & 1)
#ifndef RMASK
#define RMASK 0
#endif
#define RP(k) for (int rep_ = 0; rep_ < ((((RMASK) >> (k)) & 1) ? 2 : 1); ++rep_, __syncthreads())
#ifdef NOEPI
#define SKIPE(k) ((((RMASK) >> (k)) & 1) && rep_ == 0)
#else
#define SKIPE(k) false
#endif
#ifndef P0PROBE
#define P0PROBE 0
#endif
#ifndef MOE_ALIGN
#define MOE_ALIGN true
#endif
constexpr int LDS_TILE_E = pg8::STAGE_BYTES;
constexpr int LDS_TOKL = LDS_TILE_E + MAXTILES * 4;
static_assert(LDS_TOKL + 28 * 1024 <= LDS_CTL_OFF, "LDS map");
__device__ __forceinline__ void moe_tile_table(const Frame& P, const int ntiles) {
    volatile LAS int* te = (volatile LAS int*)(P.lds + LDS_TILE_E);
    for (int t = P.tid; t < ntiles; t += NTHREADS) { int e = 0;
#pragma unroll
        for (int j = 1; j < NE; ++j) e += (P.LCTL[8 + j] <= t) ? 1 : 0;
        te[t] = e; }
    __syncthreads();
}
constexpr int NPH_LAYER = 10, GP_FINAL = 1 + DEPTH * NPH_LAYER, NPHASES = GP_FINAL + 1;
__global__ void __launch_bounds__(NTHREADS, 2) mega_fwd(Args args) {
    extern __shared__ __attribute__((aligned(16))) unsigned char lds_raw[];
    Frame F0;
    Frame& F = F0;
    F.lds = (LAS unsigned char*)lds_raw;
    F.LCTL = (volatile LAS int*)(F.lds + LDS_CTL_OFF);
    F.tid = threadIdx.x; F.lane = F.tid & 63; F.wave = __builtin_amdgcn_readfirstlane(F.tid >> 6);
    F.G = gridDim.x; { const int bx = blockIdx.x; F.vcu = (F.G % 8 == 0) ? (bx % 8) * (F.G / 8) + bx / 8 : bx; }
    if (F.tid < 128) F.LCTL[F.tid] = 0;
    if (F.tid == 0) {
#pragma unroll
        for (int i = 0; i < 23; ++i) { const unsigned long long p = (unsigned long long)args.in[i]; F.LCTL[128 + 2 * i] = (int)(unsigned)p; F.LCTL[129 + 2 * i] = (int)(unsigned)(p >> 32); }
        { const unsigned long long p = (unsigned long long)args.ws; F.LCTL[128 + 46] = (int)(unsigned)p; F.LCTL[129 + 46] = (int)(unsigned)(p >> 32); }
        { const unsigned long long p = (unsigned long long)args.out; F.LCTL[128 + 48] = (int)(unsigned)p; F.LCTL[129 + 48] = (int)(unsigned)(p >> 32); }
    }
    __syncthreads();
    const int lo = args.ph_lo, hi = args.ph_hi;
    XcdBarrier bar; bar.bar = (unsigned*)(wsp(F) + WS_CTL) + CW_BAR; bar.x = 0; bar.st = nullptr; bar.w0 = 0;
    if (hi - lo > 1) bar = xcd_barrier_post((unsigned*)(wsp(F) + WS_CTL) + CW_BAR, (volatile LAS unsigned*)F.LCTL);
#define IN(k) (lo <= (k) && (k) < hi)
#define FRESH(FN) Frame FN = F0; { int tz_ = F0.wave * 64 + lane_id_here(), vc_ = F0.vcu, g_ = F0.G;     asm volatile("" : "+v"(tz_)); asm volatile("" : "+s"(vc_), "+s"(g_)); FN.tid = tz_; FN.lane = tz_ & 63; FN.wave = __builtin_amdgcn_readfirstlane(tz_ >> 6); FN.vcu = vc_; FN.G = g_; }
#ifdef DBLBAR
#define SEAM(k) do { if (IN(k) && IN((k) + 1)) { xcd_barrier(bar); xcd_barrier(bar); } } while (0)
#else
#define SEAM(k) do { if (IN(k) && IN((k) + 1)) xcd_barrier(bar); } while (0)
#endif

    if (PE(0) && IN(0)) RP(0) { FRESH(P); phase0(P, ((((RMASK) >> 0) & 1) && rep_ == 0) ? P0PROBE : 0); }
    SEAM(0);
    for (int l = 0; l < DEPTH; ++l) {
        const int base = 1 + l * NPH_LAYER; const bool na = (l & 1) == 0, last = (l == DEPTH - 1); const int jj = l >> 1;
        if (PE(1) && IN(base + 0)) RP(1) { FRESH(P); phase_norm1(P, l, (((RMASK) >> 1) & 1) && rep_ == 0); }
        SEAM(base + 0);
        if (PE(2) && IN(base + 1)) RP(2) {
            FRESH(P);
            if (na) {
                const bf16_t* Bt = (const bf16_t*)(wsp(P) + WS_WQKV) + (size_t)jj * 3072 * D;
                const bool img_only = proj_split(P.G);
                DenseOrder S; S.init(img_only ? ROWS_CTX / 256 : 0, img_only ? (ROWS - ROWS_CTX) / 256 : ROWS / 256, 3072 / 256, P.G, (int)blockIdx.x, wsp(P) + WS_HB, Bt, D);
                EpiStoreBf16 E{(bf16_t*)(wsp(P) + WS_PROJ), 3072};
                pg8::gemm_phase<EpiStoreBf16, DenseOrder, false>(P.lds, P.tid, D, S, E, SKIPE(2));
            } else {
                const bf16_t* Bt = (const bf16_t*)(wsp(P) + WS_WIN) + (size_t)jj * ML_INP * D;
                DenseOrder S; S.init(0, ROWS / 256, ML_INP / 256, P.G, (int)blockIdx.x, wsp(P) + WS_HB, Bt, D);
                EpiProjML E{(bf16_t*)(wsp(P) + WS_PROJ), (const float*)(wsp(P) + WS_ROPE)};
                pg8::gemm_phase<EpiProjML, DenseOrder, false>(P.lds, P.tid, D, S, E, SKIPE(2));
            }
        }
        SEAM(base + 1);
        if (IN(base + 2) && na && PE(3)) {
            FRESH(P);
            if (proj_split(P.G) && P.vcu < NCBP) {
                const bf16_t* Bt = (const bf16_t*)(wsp(P) + WS_WQKV) + (size_t)jj * 3072 * D;
                DenseOrder S; S.init(0, ROWS_CTX / 256, 3072 / 256, NCBP, P.vcu, wsp(P) + WS_HB, Bt, D);
                EpiStoreBf16 E{(bf16_t*)(wsp(P) + WS_PROJ), 3072};
                pg8::gemm_phase<EpiStoreBf16, DenseOrder, false>(P.lds, P.tid, D, S, E);
                group_sync((unsigned*)(wsp(P) + WS_CTL) + CW_GSYNC + 64 * (DEPTH + l), NCBP, (unsigned*)(wsp(P) + WS_CTL) + CW_BAR, P.wave == 0);
            }
        }
        if (IN(base + 2)) { if (na) {   } else {   } }
        if (IN(base + 3)) { if (na) { if (PE(5)) RP(5) { FRESH(P); phase_na_attn(P, jj); } } else { if (PE(6)) RP(6) { FRESH(P); phase_ml_scan(P, jj); } } }
        SEAM(base + 3);
        if (PE(7) && IN(base + 4)) { if (!na) RP(7) { FRESH(P); phase_ml_final(P, jj); } }
        if (!na) SEAM(base + 4);
        if (PE(8) && IN(base + 5)) RP(8) {
            FRESH(P);
            const bf16_t* Bt = na ? (const bf16_t*)(wsp(P) + WS_WONA) + (size_t)jj * D * D : (const bf16_t*)(wsp(P) + WS_WOML) + (size_t)jj * D * D;
            const bool img_only = last || ctx_split(0, P.G);
            DenseOrder S; S.init(img_only ? ROWS_CTX / 256 : 0, img_only ? (ROWS - ROWS_CTX) / 256 : ROWS / 256, D / 256, P.G, (int)blockIdx.x, wsp(P) + WS_AO, Bt, D);
            EpiResid E{((((RMASK) >> 8) & 1) && rep_ == 0) ? (bf16_t*)(wsp(P) + WS_Y) : (bf16_t*)(wsp(P) + WS_XS), (const float*)(wsp(P) + WS_MOD) + (size_t)l * 9 * 6144 + 2 * D};
            pg8::gemm_phase<EpiResid, DenseOrder, false>(P.lds, P.tid, D, S, E, SKIPE(8));
        }
        SEAM(base + 5);
        if (PE(9) && IN(base + 6) && !last) {
            FRESH(P);
            if (ctx_split(0, P.G) && P.vcu < NCB) {
                const bf16_t* Bt = na ? (const bf16_t*)(wsp(P) + WS_WONA) + (size_t)jj * D * D : (const bf16_t*)(wsp(P) + WS_WOML) + (size_t)jj * D * D;
                DenseOrder S; S.init(0, ROWS_CTX / 256, D / 256, NCB, P.vcu, wsp(P) + WS_AO, Bt, D);
                EpiResid E{(bf16_t*)(wsp(P) + WS_XS), (const float*)(wsp(P) + WS_MOD) + (size_t)l * 9 * 6144 + 2 * D};
                pg8::gemm_phase<EpiResid, DenseOrder, false>(P.lds, P.tid, D, S, E);
                group_sync((unsigned*)(wsp(P) + WS_CTL) + CW_GSYNC + 64 * l, NCB, (unsigned*)(wsp(P) + WS_CTL) + CW_BAR, P.wave == 0);
            }
        }
        if (PE(9) && IN(base + 6)) RP(9) { FRESH(P); phase_norm2_router(P, l, last ? ROWS_CTX : 0); }
        SEAM(base + 6);
        if (PE(10) && IN(base + 7)) RP(10) { FRESH(P); phase_positions(P, last ? ROWS_CTX : 0); }
        SEAM(base + 7);
        if (PE(11) && IN(base + 8)) RP(11) {
            FRESH(P);
            if (P.tid < 34) P.LCTL[8 + P.tid] = ((const int*)(wsp(P) + WS_META))[P.tid];
            __syncthreads();
            const int ntiles = P.LCTL[8 + NE];
            moe_tile_table(P, ntiles);
            MoeOrder S; S.NT = 8; S.nunits = ntiles * 8; S.G = P.G; S.c = (int)blockIdx.x; S.K = D / 2; S.A = (const char*)(wsp(P) + WS_HB8);
            S.W = (const char*)(wsp(P) + WS_W1T) + (size_t)l * NE * 2048 * D; S.estride = (size_t)2048 * D; S.tokmap = (const int*)(wsp(P) + WS_TOKMAP); S.prefix = P.LCTL + 8; S.tile_e = (volatile LAS int*)(P.lds + LDS_TILE_E); S.tokl = (volatile LAS int*)(P.lds + LDS_TOKL); S.gather = true;
            { const int half = P.wave >> 2, r = P.tid & 255;
              for (int i = half; i < 28; i += 2) { pg8::Unit u; if (!S.next(i, u)) break; S.tokl[i * 256 + r] = S.tokmap[u.pm * 256 + r]; }
              __syncthreads(); }
            EpiSwiglu E{(unsigned char*)(wsp(P) + WS_ACT), inp(P, I_B1) + (size_t)l * NE * 2048};
#ifdef KPROBE
            if (SKIPE(11)) pg8::gemm_phase<EpiSwiglu, MoeOrder, true, true, MOE_ALIGN, KPROBE>(P.lds, P.tid, D / 2, S, E, true); else
#endif
            pg8::gemm_phase<EpiSwiglu, MoeOrder, true, true, MOE_ALIGN>(P.lds, P.tid, D / 2, S, E, SKIPE(11));
        }
        SEAM(base + 8);
        if (PE(12) && IN(base + 9)) RP(12) {
            FRESH(P);
            if (P.tid < 34) P.LCTL[8 + P.tid] = ((const int*)(wsp(P) + WS_META))[P.tid];
            __syncthreads();
            const int ntiles = P.LCTL[8 + NE];
            moe_tile_table(P, ntiles);
            MoeOrder S; S.NT = 4; S.nunits = ntiles * 4; S.G = P.G; S.c = (int)blockIdx.x; S.K = D / 2; S.A = (const char*)(wsp(P) + WS_ACT);
            S.W = (const char*)(wsp(P) + WS_W2T) + (size_t)l * NE * D * D; S.estride = (size_t)D * D; S.tokmap = (const int*)(wsp(P) + WS_TOKMAP); S.prefix = P.LCTL + 8; S.tile_e = (volatile LAS int*)(P.lds + LDS_TILE_E); S.tokl = (volatile LAS int*)(P.lds + LDS_TOKL); S.gather = false;
            EpiY E{(bf16_t*)(wsp(P) + WS_Y), inp(P, I_B2) + (size_t)l * NE * D};
            pg8::gemm_phase<EpiY, MoeOrder, true, true, MOE_ALIGN>(P.lds, P.tid, D / 2, S, E, SKIPE(12));
        }
        SEAM(base + 9);
    }
    if (PE(13) && IN(GP_FINAL)) RP(13) { FRESH(P); phase_final(P); }
#undef IN
#undef SEAM
}

extern "C" void kernel_launch(void* const* d_in, const int* in_sizes, int n_in, void* d_out, int out_size, void* d_ws, size_t ws_size, hipStream_t stream) {
    static int grid = 0;
    if (grid == 0) {
        if (n_in != 23 || ws_size < WS_END) { fprintf(stderr, "kernel_launch: expected 23 inputs and >= %zu bytes of workspace (got %d, %zu)\n", (size_t)WS_END, n_in, ws_size); grid = -1; return; }
        int dev = 0, cus = 0, per_cu = 0;
        if (hipGetDevice(&dev) != hipSuccess || hipDeviceGetAttribute(&cus, hipDeviceAttributeMultiprocessorCount, dev) != hipSuccess) { grid = -1; return; }
        if (hipFuncSetAttribute((const void*)mega_fwd, hipFuncAttributeMaxDynamicSharedMemorySize, LDS_BYTES) != hipSuccess) { fprintf(stderr, "kernel_launch: hipFuncSetAttribute failed\n"); grid = -1; return; }
        if (hipOccupancyMaxActiveBlocksPerMultiprocessor(&per_cu, (const void*)mega_fwd, NTHREADS, LDS_BYTES) != hipSuccess || per_cu < 1)
            fprintf(stderr, "kernel_launch: occupancy query reports %d workgroups per CU\n", per_cu);
        (void)hipGetLastError();
        grid = cus;
        if (grid > 1024) grid = 1024;
    }
    if (grid < 0) return;
    (void)hipMemsetAsync((char*)d_ws + WS_CTL, 0, CTL_BYTES, stream);
    Args a{};
    for (int i = 0; i < 23; ++i) a.in[i] = (const float*)d_in[i];
    a.out = (float*)d_out; a.ws = (unsigned char*)d_ws;
#if MK_ONE_LAUNCH
    a.ph_lo = 0; a.ph_hi = NPHASES;
    hipLaunchKernelGGL(mega_fwd, dim3(grid), dim3(NTHREADS), LDS_BYTES, stream, a);
#else
    for (int gp = 0; gp < NPHASES; ++gp) {
        if (gp >= 1 && gp < GP_FINAL) { const int l = (gp - 1) / NPH_LAYER, p = (gp - 1) % NPH_LAYER; if (p == 4 && (l & 1) == 0) continue; }
        a.ph_lo = gp; a.ph_hi = gp + 1;
        hipLaunchKernelGGL(mega_fwd, dim3(grid), dim3(NTHREADS), LDS_BYTES, stream, a);
    }
#endif
    const hipError_t le = hipPeekAtLastError();
    if (le != hipSuccess) fprintf(stderr, "kernel_launch: launch failed: %s\n", hipGetErrorName(le));
}
```

```cpp
#include <hip/hip_runtime.h>
#include <cstdio>
#include <cstdint>

#ifndef MK_ONE_LAUNCH
#define MK_ONE_LAUNCH 1
#endif

#define LAS __attribute__((address_space(3)))
#define GAS __attribute__((address_space(1)))
typedef unsigned short bf16_t;
typedef short bf16x8 __attribute__((ext_vector_type(8)));
typedef short bf16x4 __attribute__((ext_vector_type(4)));
typedef float f32x4 __attribute__((ext_vector_type(4)));
typedef float f32x2 __attribute__((ext_vector_type(2)));
typedef unsigned u32x4 __attribute__((ext_vector_type(4)));
typedef unsigned u32x2 __attribute__((ext_vector_type(2)));

constexpr int D = 1024, NB = 8, SEQ = 4096, NCTX = 256, TT = NCTX + SEQ  , DEPTH = 4;
constexpr int ROWS_CTX = NB * NCTX  , ROWS = ROWS_CTX + NB * SEQ  ;
constexpr int NH_NA = 16, DH_NA = 64;
constexpr int NH_ML = 8, DV_ML = 128, DK_ML = 64, ML_IN = 3104, ML_INP = 3328;
constexpr int NE = 32, TOPK = 4, DFF = 1024;
constexpr int MAXTILES = (ROWS * TOPK) / 256 + NE  , MAXROWS = MAXTILES * 256;
constexpr float EPS = 1e-6f;
constexpr int NWAVES = 8, NTHREADS = 512;

constexpr size_t MiB = 1u << 20;
constexpr size_t al256(size_t x) { return (x + 255) & ~(size_t)255; }
constexpr size_t WS_CTL = 0, CTL_BYTES = 1 * MiB;
constexpr size_t WS_MOD = WS_CTL + CTL_BYTES;
constexpr size_t WS_ROPE = WS_MOD + al256((size_t)DEPTH * 9 * 6 * D * 4);
constexpr size_t WS_WQKV = WS_ROPE + al256(64 * 16 * 2 * 4);
constexpr size_t WS_WONA = WS_WQKV + (size_t)2 * 3072 * D * 2;
constexpr size_t WS_WIN = WS_WONA + (size_t)2 * D * D * 2;
constexpr size_t WS_WOML = WS_WIN + (size_t)2 * ML_INP * D * 2;
constexpr size_t WS_W1T = WS_WOML + (size_t)2 * D * D * 2;
constexpr size_t WS_W2T = WS_W1T + (size_t)DEPTH * NE * 2048 * D * 2;
constexpr size_t WS_XS = WS_W2T + (size_t)DEPTH * NE * D * D * 2;
constexpr size_t WS_HB = WS_XS + (size_t)ROWS * D * 4;
constexpr size_t WS_PROJ = WS_HB + (size_t)ROWS * D * 2;
constexpr size_t WS_QN = WS_PROJ + (size_t)ROWS * ML_INP * 2;
constexpr size_t WS_KN = WS_QN + (size_t)ROWS * D * 2;
constexpr size_t WS_VT = WS_KN + (size_t)ROWS * D * 2;
constexpr size_t WS_AO = WS_VT + (size_t)ROWS * D * 2;
constexpr size_t WS_HDIR = WS_QN;
constexpr size_t WS_GATES = WS_AO + (size_t)ROWS * D * 2;
constexpr size_t WS_TOPE = WS_GATES + al256((size_t)4 * NB * NH_ML * TT * 4);
constexpr size_t WS_TOPW = WS_TOPE + (size_t)ROWS * 4 * 4;
constexpr size_t WS_POS = WS_TOPW + (size_t)ROWS * 4 * 4;
constexpr size_t WS_TOKMAP = WS_POS + (size_t)ROWS * 4 * 4;
constexpr size_t WS_CNT = WS_TOKMAP + (size_t)MAXROWS * 4;
constexpr size_t WS_META = WS_CNT + (size_t)1024 * 32 * 4;
constexpr size_t WS_ACT = WS_META + 256;
constexpr size_t WS_Y = WS_ACT + (size_t)MAXROWS * D * 2;
constexpr size_t WS_HB8 = WS_Y + (size_t)MAXROWS * D * 2;
constexpr size_t WS_GS = WS_HB8 + (size_t)ROWS * D;
constexpr size_t WS_RT = WS_GS + (size_t)2 * NB * NH_ML * (TT / 64) * 5 * 64 * 4;
constexpr size_t WS_END = WS_RT + (size_t)DEPTH * 2 * NE * D * 2;
static_assert(WS_XS % 256 == 0 && WS_ACT % 256 == 0 && WS_TOPE % 256 == 0, "ws alignment");

constexpr int CW_BAR = 4096;
constexpr int CW_GSYNC = 8192;

constexpr int LDS_BYTES = 160 * 1024;
constexpr int LDS_CTL_OFF = LDS_BYTES - 1024;
constexpr int LDS_WORK = LDS_CTL_OFF;

__device__ __forceinline__ int lane_id_here() { int l; asm volatile("v_mbcnt_lo_u32_b32 %0, -1, 0\n\tv_mbcnt_hi_u32_b32 %0, -1, %0" : "=v"(l)); return l; }
#define LDS_WAIT() asm volatile("s_waitcnt lgkmcnt(0)" ::: "memory")
#define VM_WAIT() asm volatile("s_waitcnt vmcnt(0)" ::: "memory")
__device__ __forceinline__ unsigned f2bf(float f) { unsigned u = __builtin_bit_cast(unsigned, f); return (u + 0x7fffu + ((u >> 16) & 1u)) >> 16; }
__device__ __forceinline__ unsigned pk2(float lo, float hi) { unsigned r; asm volatile("v_cvt_pk_bf16_f32 %0, %1, %2" : "=v"(r) : "v"(lo), "v"(hi)); return r; }
__device__ __forceinline__ unsigned pk4_fp8(float a, float b, float c, float d) { int p = __builtin_amdgcn_cvt_pk_fp8_f32(a, b, 0, false); p = __builtin_amdgcn_cvt_pk_fp8_f32(c, d, p, true); return (unsigned)p; }
__device__ __forceinline__ float bf2f(unsigned short b) { return __builtin_bit_cast(float, ((unsigned)b) << 16); }
__device__ __forceinline__ float bflo(unsigned w) { return __builtin_bit_cast(float, w << 16); }
__device__ __forceinline__ float bfhi(unsigned w) { return __builtin_bit_cast(float, w & 0xffff0000u); }
template <int CTRL> __device__ __forceinline__ float dpp_f(float v) { return __builtin_bit_cast(float, __builtin_amdgcn_update_dpp(0, __builtin_bit_cast(int, v), CTRL, 0xF, 0xF, false)); }
__device__ __forceinline__ float sum8(float v) { v += dpp_f<0xB1>(v); v += dpp_f<0x4E>(v); v += dpp_f<0x141>(v); return v; }
__device__ __forceinline__ float max8(float v) { v = fmaxf(v, dpp_f<0xB1>(v)); v = fmaxf(v, dpp_f<0x4E>(v)); v = fmaxf(v, dpp_f<0x141>(v)); return v; }
__device__ __forceinline__ float rdl(float v, int l) { return __builtin_bit_cast(float, __builtin_amdgcn_readlane(__builtin_bit_cast(int, v), l)); }
__device__ __forceinline__ f32x4 bf4_to_f32(const u32x2 w) { return (f32x4){bflo(w.x), bfhi(w.x), bflo(w.y), bfhi(w.y)}; }
__device__ __forceinline__ float wave_sum(float v) {
    v = sum8(v); v += dpp_f<0x140>(v);
    return (rdl(v, 0) + rdl(v, 16)) + (rdl(v, 32) + rdl(v, 48));
}
__device__ __forceinline__ float wave_max(float v) {
    v = max8(v); v = fmaxf(v, dpp_f<0x140>(v));
    return fmaxf(fmaxf(rdl(v, 0), rdl(v, 16)), fmaxf(rdl(v, 32), rdl(v, 48)));
}
__device__ __forceinline__ int shfl_(int v, int src) { return __builtin_amdgcn_ds_bpermute(src << 2, v); }
__device__ __forceinline__ float shfl_(float v, int src) { return __builtin_bit_cast(float, __builtin_amdgcn_ds_bpermute(src << 2, __builtin_bit_cast(int, v))); }
__device__ __forceinline__ float sigmoidf_(float x) { return __builtin_amdgcn_rcpf(1.f + __builtin_amdgcn_exp2f(-1.44269504f * x)); }

namespace pg8 {
constexpr int BM = 256, BK = 64, HALF = 128, HTB = HALF * BK * 2  , STAGE_BYTES = 8 * HTB;
__host__ __device__ __forceinline__ int lds_byte(int r, int c) { const int st = (r >> 4) * 2 + (c >> 5), rr = r & 15, cc = c & 31, ob = rr * 64 + cc * 2; return st * 1024 + (ob ^ (((ob >> 9) & 1) << 5)); }
__host__ __device__ __forceinline__ void stage_rc(int b, int& R, int& C) { const int st = b / 1024, sb = b % 1024, swz = sb ^ (((sb >> 9) & 1) << 5); R = (st >> 1) * 16 + swz / 64; C = (st & 1) * 32 + (swz % 64) / 2; }
__host__ __device__ __forceinline__ int perm32(int rho) { const int n = rho >> 4, i = rho & 15; return 8 * (i >> 2) + 4 * n + (i & 3); }

struct Unit { int pm, pn, e, slot; };

typedef int v8i32 __attribute__((ext_vector_type(8)));
__device__ __forceinline__ v8i32 cat8(const bf16x8 a, const bf16x8 b) { union { bf16x8 h[2]; v8i32 v; } u; u.h[0] = a; u.h[1] = b; return u.v; }
__device__ __forceinline__ unsigned cvt_pk_bf16(float lo, float hi) { unsigned r; asm volatile("v_cvt_pk_bf16_f32 %0, %1, %2" : "=v"(r) : "v"(lo), "v"(hi)); return r; }

#ifndef PG8_ALIGN
#define PG8_ALIGN true
#endif
#ifndef FP8_PRIO
#define FP8_PRIO true
#endif
template <class Epi, class Sched, bool GATHER, bool FP8 = false, bool ALIGN_EPI = PG8_ALIGN, int KPROBE_ = 0>
__device__ __forceinline__ void gemm_phase(LAS unsigned char* lds, const int tid, const int K, const Sched& S, const Epi& E, const bool skip_epi = false) {
    const int wid = __builtin_amdgcn_readfirstlane(tid >> 6), lane = tid & 63, wr = wid >> 2, wc = wid & 3, fr = lane & 15, fq = lane >> 4;
    const int nt = K / BK;
    unsigned voffB[2], voffA[2][2];
#pragma unroll
    for (int i = 0; i < 2; ++i) { int R, C; stage_rc(tid * 16 + i * 8192, R, C); const int Rb = Epi::PERM ? ((R & ~31) + perm32(R & 31)) : R;
        voffB[i] = (unsigned)(Rb * K + C) * 2u; }
    const size_t kstep = (size_t)(BK * 2);
    const size_t hstep = (size_t)HALF * K * 2;
    const unsigned ldsw = (unsigned)wid * 1024u;
    const int aoff = lds_byte(wr * 64 + fr, fq * 8), boff = lds_byte(wc * 32 + fr, fq * 8);
#define PG8_SA(b, h) (((b) * 2 + (h)) * HTB)
#define PG8_SB(b, h) ((4 + (b) * 2 + (h)) * HTB)
#define PG8_STAGE(bufoff, gbase, voff) do { _Pragma("unroll") for (int _i = 0; _i < 2; ++_i) \
        __builtin_amdgcn_global_load_lds((const unsigned*)((const char*)(gbase) + (voff)[_i]), (LAS unsigned*)(lds + (bufoff) + ldsw + _i * 8192), 16, 0, 0); } while (0)
#define PG8_LDA(dst, b, h) do { if constexpr (KPROBE_ == 2) break; _Pragma("unroll") for (int m = 0; m < 4; ++m) _Pragma("unroll") for (int k = 0; k < 2; ++k) dst[m][k] = *(const LAS bf16x8*)(lds + PG8_SA(b, h) + aoff + m * 2048 + k * 1024); } while (0)
#define PG8_LDB(dst, b, h) do { if constexpr (KPROBE_ == 2) break; _Pragma("unroll") for (int n = 0; n < 2; ++n) _Pragma("unroll") for (int k = 0; k < 2; ++k) dst[n][k] = *(const LAS bf16x8*)(lds + PG8_SB(b, h) + boff + n * 2048 + k * 1024); } while (0)
#define PG8_MMA(ai, bj, At, Bt) do { if constexpr (!FP8 || FP8_PRIO) __builtin_amdgcn_s_setprio(1); else __builtin_amdgcn_s_setprio(0); _Pragma("unroll") for (int m = 0; m < 4; ++m) _Pragma("unroll") for (int n = 0; n < 2; ++n) { \
        if constexpr (KPROBE_ == 1) { asm volatile("" :: "v"(At[m][0]), "v"(At[m][1]), "v"(Bt[n][0]), "v"(Bt[n][1])); } else if constexpr (KPROBE_ == 2) { } else \
        if constexpr (FP8) { acc[ai][bj][m][n] = __builtin_amdgcn_mfma_scale_f32_16x16x128_f8f6f4(cat8(Bt[n][0], Bt[n][1]), cat8(At[m][0], At[m][1]), acc[ai][bj][m][n], 0, 0, 0, 0x7f7f7f7f, 0, 0x7f7f7f7f); } \
        else { _Pragma("unroll") for (int k = 0; k < 2; ++k) acc[ai][bj][m][n] = __builtin_amdgcn_mfma_f32_16x16x32_bf16(Bt[n][k], At[m][k], acc[ai][bj][m][n], 0, 0, 0); } } \
        __builtin_amdgcn_s_setprio(0); } while (0)
#define PG8_WAIT_V(n) asm volatile("s_waitcnt vmcnt(" #n ")" ::: "memory")
#define PG8_WAIT_VP do { if constexpr (Epi::PREFETCH) { if (pf) PG8_WAIT_V(10); else PG8_WAIT_V(8); } else PG8_WAIT_V(8); } while (0)
#define PG8_WAIT_L(n) asm volatile("s_waitcnt lgkmcnt(" #n ")" ::: "memory")
#define PG8_BAR __builtin_amdgcn_s_barrier()
#define PG8_SCHED __builtin_amdgcn_sched_barrier(0)
#define PG8_SETVOFF(u) do { _Pragma("unroll") for (int _i = 0; _i < 2; ++_i) { int RA_, CA_; stage_rc(tid * 16 + _i * 8192, RA_, CA_);     \
        _Pragma("unroll") for (int _h = 0; _h < 2; ++_h) { \
        if constexpr (GATHER) voffA[_h][_i] = ((unsigned)S.a_row(u, _h * HALF + RA_) * (unsigned)K + (unsigned)CA_) * 2u; \
        else voffA[_h][_i] = ((unsigned)(_h * HALF + RA_) * (unsigned)K + (unsigned)CA_) * 2u; } } } while (0)
    Unit cur, nxt; int ui = 0;
    if (!S.next(0, cur)) return;
    f32x4 acc[2][2][4][2];
#pragma unroll
    for (int a = 0; a < 2; ++a)
#pragma unroll
        for (int b = 0; b < 2; ++b)
#pragma unroll
            for (int m = 0; m < 4; ++m)
#pragma unroll
                for (int n = 0; n < 2; ++n) acc[a][b][m][n] = (f32x4){0.f, 0.f, 0.f, 0.f};
    bf16x8 At[4][2], B0[2][2], B1[2][2];
    const char* cA = S.a_base(cur); const char* cB = S.b_base(cur);
    PG8_SETVOFF(cur);
    PG8_STAGE(PG8_SB(0, 0), cB, voffB); PG8_STAGE(PG8_SB(0, 1), cB + hstep, voffB); PG8_STAGE(PG8_SA(0, 0), cA, voffA[0]); PG8_STAGE(PG8_SA(0, 1), cA, voffA[1]);
    if (wr == 1) PG8_BAR;
    PG8_WAIT_V(2); PG8_BAR;
    PG8_STAGE(PG8_SB(1, 0), cB + kstep, voffB); PG8_STAGE(PG8_SA(1, 0), cA + kstep, voffA[0]); PG8_STAGE(PG8_SB(1, 1), cB + hstep + kstep, voffB);
    PG8_WAIT_V(6); PG8_BAR;
    for (;;) {
        const bool has_next = S.next(ui + 1, nxt);
        const char* nA = has_next ? S.a_base(nxt) : cA; const char* nB = has_next ? S.b_base(nxt) : cB;
#pragma unroll 1
        for (int t = 0; t < nt; t += 2) {
            const bool last = (t == nt - 2);
            const char* a1 = cA + (size_t)(t + 1) * kstep;
            const char* a2 = last ? nA : cA + (size_t)(t + 2) * kstep; const char* b2 = last ? nB : cB + (size_t)(t + 2) * kstep;
            const char* a3 = a2 + kstep; const char* b3 = b2 + kstep;
            bool pf = false;
            if constexpr (Epi::PREFETCH) { pf = (t == ((nt / 2) & ~1)); if (pf) E.prefetch(cur, wid * 64 + lane_id_here(), lds); }
            PG8_LDB(B0, 0, 0); PG8_LDB(B1, 0, 1); PG8_SCHED; PG8_LDA(At, 0, 0); PG8_STAGE(PG8_SA(1, 1), a1, voffA[1]);
            if constexpr (GATHER) { if (last && has_next) PG8_SETVOFF(nxt); }
            PG8_WAIT_VP; PG8_WAIT_L(0); PG8_BAR; PG8_MMA(0, 0, At, B0); PG8_MMA(0, 1, At, B1); PG8_BAR; PG8_SCHED;
            PG8_LDA(At, 0, 1); PG8_STAGE(PG8_SB(0, 0), b2, voffB); PG8_STAGE(PG8_SB(0, 1), b2 + hstep, voffB); PG8_STAGE(PG8_SA(0, 0), a2, voffA[0]);
            PG8_WAIT_VP; PG8_WAIT_L(0); PG8_BAR; PG8_MMA(1, 0, At, B0); PG8_MMA(1, 1, At, B1); PG8_BAR; PG8_SCHED;
            PG8_LDB(B0, 1, 0); PG8_LDB(B1, 1, 1); PG8_SCHED; PG8_LDA(At, 1, 0); PG8_STAGE(PG8_SA(0, 1), a2, voffA[1]);
            PG8_WAIT_VP; PG8_WAIT_L(0); PG8_BAR; PG8_MMA(0, 0, At, B0); PG8_MMA(0, 1, At, B1); PG8_BAR; PG8_SCHED;
            PG8_LDA(At, 1, 1); PG8_STAGE(PG8_SB(1, 0), b3, voffB); PG8_STAGE(PG8_SB(1, 1), b3 + hstep, voffB); PG8_STAGE(PG8_SA(1, 0), a3, voffA[0]);
            PG8_WAIT_V(8); PG8_WAIT_L(0); PG8_BAR; PG8_MMA(1, 0, At, B0); PG8_MMA(1, 1, At, B1); PG8_BAR; PG8_SCHED;
        }
        if constexpr (ALIGN_EPI) { if (wr == 0) PG8_BAR; }
        if (!skip_epi) E(acc, cur, wr, wc, fr, fq);
        if (!has_next) break;
#pragma unroll
        for (int a = 0; a < 2; ++a)
#pragma unroll
            for (int b = 0; b < 2; ++b)
#pragma unroll
                for (int m = 0; m < 4; ++m)
#pragma unroll
                    for (int n = 0; n < 2; ++n) acc[a][b][m][n] = (f32x4){0.f, 0.f, 0.f, 0.f};
        cur = nxt; cA = nA; cB = nB; ++ui;
        if constexpr (ALIGN_EPI) { if (wr == 1) PG8_BAR; }
    }
    PG8_WAIT_V(0);
    if constexpr (!ALIGN_EPI) { if (wr == 0) PG8_BAR; }
    PG8_BAR;
#undef PG8_SA
#undef PG8_SB
#undef PG8_STAGE
#undef PG8_LDA
#undef PG8_LDB
#undef PG8_MMA
#undef PG8_WAIT_V
#undef PG8_WAIT_VP
#undef PG8_WAIT_L
#undef PG8_BAR
#undef PG8_SCHED
#undef PG8_SETVOFF
}
}

#define XB_TMO      128
#define XB_XCNT(j)  (256  + 64 * (j))
#define XB_XSUB(j)  (1280 + 64 * (j))
#define XB_XGEN(j)  (2304 + 64 * (j))
#define XB_TOP      3328
#define XB_TOPGEN   3392
#define XCD_BAR_WORDS 3456
#define XB_SPIN_CAP (1u << 18)

__device__ __forceinline__ unsigned xb_ld(unsigned* p)              { return __hip_atomic_load(p, __ATOMIC_RELAXED, __HIP_MEMORY_SCOPE_AGENT); }
__device__ __forceinline__ unsigned xb_add(unsigned* p, unsigned v) { return __hip_atomic_fetch_add(p, v, __ATOMIC_RELAXED, __HIP_MEMORY_SCOPE_AGENT); }
__device__ __forceinline__ unsigned xb_xcc_id() { return (unsigned)__builtin_amdgcn_s_getreg((3 << 11) | 20) & 0xFu; }
#define XB_SPIN(cond, bar) do { unsigned _sp = 0; while (cond) { __builtin_amdgcn_s_sleep(1); \
    if ((++_sp & 255u) == 0u) { if (xb_ld(&(bar)[XB_TMO])) break; if (_sp > XB_SPIN_CAP) { atomicAdd(&(bar)[XB_TMO], 1u); break; } } } } while (0)

struct XcdBarrier {
    unsigned* bar; unsigned x;
    unsigned w0;
    volatile LAS unsigned* st;
};

__device__ __forceinline__ XcdBarrier xcd_barrier_post(unsigned* bar, volatile LAS unsigned* st) {
    XcdBarrier b; b.bar = bar; b.x = xb_xcc_id(); b.st = st; b.w0 = ((unsigned)__builtin_amdgcn_readfirstlane((int)threadIdx.x) < 64u) ? 1u : 0u;
    if (threadIdx.x == 0) (void)xb_add(&bar[XB_XCNT(b.x)], 1u);
    return b;
}
__device__ __forceinline__ void xcd_barrier_complete(unsigned* bar, unsigned x, unsigned& nloc, unsigned& nx) {
    const unsigned G = gridDim.x * gridDim.y * gridDim.z;
    unsigned sum, cnt, mine, sp = 0u;
    for (;;) {
        sum = 0u; cnt = 0u; mine = 0u;
#pragma unroll
        for (unsigned j = 0; j < 16; ++j) { const unsigned c = xb_ld(&bar[XB_XCNT(j)]); sum += c; cnt += (c > 0u) ? 1u : 0u; mine = (j == x) ? c : mine; }
        if (sum == G) break;
        __builtin_amdgcn_s_sleep(1);
        if ((++sp & 255u) == 0u) { if (xb_ld(&bar[XB_TMO])) break; if (sp > XB_SPIN_CAP) { atomicAdd(&bar[XB_TMO], 1u); break; } }
    }
    nloc = mine > 0u ? mine : 1u; nx = cnt > 0u ? cnt : 1u;
}

__device__ __forceinline__ void xcd_barrier(const XcdBarrier& b) {
    asm volatile("s_waitcnt vmcnt(0)" ::: "memory");
    __syncthreads();
    if (b.w0 && lane_id_here() == 0) {
        unsigned* bar = b.bar;
        __builtin_amdgcn_s_waitcnt(0);
        unsigned nloc = b.st[0], nx = b.st[1];
        if (nloc == 0u) { xcd_barrier_complete(bar, b.x, nloc, nx); b.st[0] = nloc; b.st[1] = nx; }
        const unsigned old = xb_add(&bar[XB_XSUB(b.x)], 1u);
        const unsigned gen = old / nloc;
        if (old + 1u == (gen + 1u) * nloc) {
            __builtin_amdgcn_fence(__ATOMIC_RELEASE, "agent");
            asm volatile("s_waitcnt vmcnt(0)" ::: "memory");
            const unsigned og = xb_add(&bar[XB_TOP], 1u);
            const unsigned tg = og / nx;
            if (og + 1u == (tg + 1u) * nx) xb_add(&bar[XB_TOPGEN], 1u);
            else XB_SPIN(xb_ld(&bar[XB_TOPGEN]) == tg, bar);
            __builtin_amdgcn_fence(__ATOMIC_ACQUIRE, "agent");
            xb_add(&bar[XB_XGEN(b.x)], 1u);
            asm volatile("s_waitcnt vmcnt(0)" ::: "memory");
        } else {
            XB_SPIN(xb_ld(&bar[XB_XGEN(b.x)]) == gen, bar);
            __builtin_amdgcn_fence(__ATOMIC_ACQUIRE, "agent");
            asm volatile("s_waitcnt vmcnt(0)" ::: "memory");
        }
    }
    __syncthreads();
}

__device__ __forceinline__ void group_sync(unsigned* word, unsigned n, unsigned* bar, bool w0) {
    asm volatile("s_waitcnt vmcnt(0)" ::: "memory");
    __syncthreads();
    if (w0 && lane_id_here() == 0) {
        __builtin_amdgcn_s_waitcnt(0);
        __builtin_amdgcn_fence(__ATOMIC_RELEASE, "agent");
        asm volatile("s_waitcnt vmcnt(0)" ::: "memory");
        (void)xb_add(word, 1u);
        XB_SPIN(xb_ld(word) < n, bar);
        __builtin_amdgcn_fence(__ATOMIC_ACQUIRE, "agent");
        asm volatile("s_waitcnt vmcnt(0)" ::: "memory");
    }
    __syncthreads();
}

struct Args { const float* in[23]; float* out; unsigned char* ws; int ph_lo, ph_hi; };
struct Frame {
    LAS unsigned char* lds;
    volatile LAS int* LCTL;
    int tid, lane, wave, vcu, G;
};
__device__ __forceinline__ unsigned long long ptr_get(const Frame& F, int i) {
    const unsigned lo = (unsigned)F.LCTL[128 + 2 * i], hi = (unsigned)F.LCTL[129 + 2 * i];
    return ((unsigned long long)(unsigned)__builtin_amdgcn_readfirstlane((int)hi) << 32) | (unsigned long long)(unsigned)__builtin_amdgcn_readfirstlane((int)lo);
}
__device__ __forceinline__ const float* inp(const Frame& F, int i) { return (const float*)(GAS const float*)ptr_get(F, i); }
__device__ __forceinline__ unsigned char* wsp(const Frame& F) { return (unsigned char*)(GAS unsigned char*)ptr_get(F, 23); }
__device__ __forceinline__ float* outp(const Frame& F) { return (float*)(GAS float*)ptr_get(F, 24); }
enum { I_X = 0, I_C, I_CTX, I_CCTX, I_WADA, I_BADA, I_GMIX, I_GFFN, I_WQKV, I_QGAIN, I_KGAIN, I_RPB, I_WONA, I_WIN, I_BGATE, I_MHGAIN, I_WOML,
       I_WR, I_BR, I_W1, I_B1, I_W2, I_B2 };

struct DenseOrder {
    int nM, nN, nwg, G, c, pm0, K; const char* A; const char* Bt;
    __device__ __forceinline__ void init(int pm0_, int nM_, int nN_, int G_, int c_, const void* A_, const void* Bt_, int K_) { pm0 = pm0_; nM = nM_; nN = nN_; nwg = nM * nN; G = G_; c = c_; A = (const char*)A_; Bt = (const char*)Bt_; K = K_; }
    __device__ __forceinline__ bool next(int i, pg8::Unit& u) const {
        const long L = (long)i * G + c; if (L >= nwg) return false;
        int wgid = (int)L; { const int q = nwg / 8, r = nwg % 8, xcd = wgid % 8, off = wgid / 8; wgid = (xcd < r ? xcd * (q + 1) : r * (q + 1) + (xcd - r) * q) + off; }
        const int nig = 8 * nN, gid = wgid / nig, fm = gid * 8, gsz = (nM - fm) < 8 ? (nM - fm) : 8;
        u.pm = pm0 + fm + ((wgid % nig) % gsz); u.pn = (wgid % nig) / gsz; u.e = 0; u.slot = i; return true;
    }
    __device__ __forceinline__ const char* a_base(const pg8::Unit& u) const { return A + (size_t)u.pm * 256 * K * 2; }
    __device__ __forceinline__ const char* b_base(const pg8::Unit& u) const { return Bt + (size_t)u.pn * 256 * K * 2; }
    __device__ __forceinline__ int a_row(const pg8::Unit&, int) const { return 0; }
    __device__ __forceinline__ bool prefetchable() const { return false; }
    __device__ __forceinline__ const int* a_row_ptr(const pg8::Unit&, int) const { return nullptr; }
};
struct MoeOrder {
    int NT, nunits, G, c, K; const char* A; const char* W; size_t estride; const int* tokmap; volatile LAS int* prefix; volatile LAS int* tile_e; volatile LAS int* tokl; bool gather;
    __device__ __forceinline__ bool next(int i, pg8::Unit& u) const {
        const long L = (long)i * G + c; if (L >= nunits) return false;
        int wgid = (int)L; { const int q = nunits / 8, r = nunits % 8, xcd = wgid % 8, off = wgid / 8; wgid = (xcd < r ? xcd * (q + 1) : r * (q + 1) + (xcd - r) * q) + off; }
        const int tile = wgid / NT; u.pm = tile; u.pn = wgid - tile * NT;
        u.e = __builtin_amdgcn_readfirstlane(tile_e[tile]); u.slot = i; return true;
    }
    __device__ __forceinline__ const char* a_base(const pg8::Unit& u) const { return A; }
    __device__ __forceinline__ const char* b_base(const pg8::Unit& u) const { return W + (size_t)u.e * estride + (size_t)u.pn * 256 * K * 2; }
    __device__ __forceinline__ int a_row(const pg8::Unit& u, int r) const { return gather ? tokl[u.slot * 256 + r] : u.pm * 256 + r; }
    __device__ __forceinline__ bool prefetchable() const { return gather; }
    __device__ __forceinline__ const int* a_row_ptr(const pg8::Unit& u, int r) const { return tokmap + u.pm * 256 + r; }
};

#ifndef WO_PREFETCH
#define WO_PREFETCH false
#endif
typedef f32x4 AccT[2][2][4][2];
struct EpiStoreBf16 {
    static constexpr bool PERM = true; static constexpr bool PREFETCH = false;
    bf16_t* O; int ldc;
    __device__ __forceinline__ void operator()(const AccT& acc, const pg8::Unit& u, int wr, int wc, int fr, int fq) const {
        const int row0 = u.pm * 256 + wr * 64 + fr, col0 = u.pn * 256 + wc * 32 + 8 * fq;
#pragma unroll
        for (int ai = 0; ai < 2; ++ai)
#pragma unroll
            for (int m = 0; m < 4; ++m) { bf16_t* rowp = O + (size_t)(row0 + ai * 128 + m * 16) * ldc + col0;
#pragma unroll
                for (int bj = 0; bj < 2; ++bj) { const f32x4 v0 = acc[ai][bj][m][0], v1 = acc[ai][bj][m][1];
                    u32x4 w; w.x = pg8::cvt_pk_bf16(v0[0], v0[1]); w.y = pg8::cvt_pk_bf16(v0[2], v0[3]); w.z = pg8::cvt_pk_bf16(v1[0], v1[1]); w.w = pg8::cvt_pk_bf16(v1[2], v1[3]);
                    *(u32x4*)(rowp + bj * 128) = w; } }
    }
};
struct EpiProjML {
    static constexpr bool PERM = false; static constexpr bool PREFETCH = false;
    bf16_t* O; const float* rope;
    __device__ __forceinline__ void operator()(const AccT& acc, const pg8::Unit& u, int wr, int wc, int fr, int fq) const {
        const int row0 = u.pm * 256 + wr * 64 + fr, col0 = u.pn * 256 + wc * 32 + 4 * fq;
        const bool qk = u.pn < 4, lat = u.pm >= ROWS_CTX / 256;
        const float scale = u.pn < 2 ? 0.125f : 1.0f;
        const int hf = wc & 1;
#pragma unroll
        for (int ai = 0; ai < 2; ++ai) {
            f32x4 t0[4], t1[4];
            if (qk && lat) {
#pragma unroll
                for (int m = 0; m < 4; ++m) { const int row = row0 + ai * 128 + m * 16, s = (row - ROWS_CTX) & 4095, pos = hf ? (s & 63) : (s >> 6);
                    t0[m] = *(const f32x4*)(rope + (pos * 16 + 4 * fq) * 2); t1[m] = *(const f32x4*)(rope + (pos * 16 + 4 * fq) * 2 + 4); }
            }
#pragma unroll
            for (int m = 0; m < 4; ++m) { const int row = row0 + ai * 128 + m * 16; bf16_t* rowp = O + (size_t)row * ML_INP + col0;
                f32x4 c4 = (f32x4){1.f, 1.f, 1.f, 1.f}, s4 = (f32x4){0.f, 0.f, 0.f, 0.f};
                if (qk && lat) { c4 = (f32x4){t0[m][0], t0[m][2], t1[m][0], t1[m][2]}; s4 = (f32x4){t0[m][1], t0[m][3], t1[m][1], t1[m][3]}; }
#pragma unroll
                for (int bj = 0; bj < 2; ++bj) { f32x4 v0 = acc[ai][bj][m][0], v1 = acc[ai][bj][m][1];
                    if (qk) { const f32x4 o0 = (v0 * c4 - v1 * s4) * scale, o1 = (v0 * s4 + v1 * c4) * scale; v0 = o0; v1 = o1; }
                    u32x2 w0, w1; w0.x = pg8::cvt_pk_bf16(v0[0], v0[1]); w0.y = pg8::cvt_pk_bf16(v0[2], v0[3]); w1.x = pg8::cvt_pk_bf16(v1[0], v1[1]); w1.y = pg8::cvt_pk_bf16(v1[2], v1[3]);
                    *(u32x2*)(rowp + bj * 128) = w0; *(u32x2*)(rowp + bj * 128 + 16) = w1; } }
        }
    }
};
#ifndef Y_FP8
#define Y_FP8 1
#endif
struct EpiY {
    static constexpr bool PERM = true; static constexpr bool PREFETCH = false;
    bf16_t* O; const float* b2;
    __device__ __forceinline__ void operator()(const AccT& acc, const pg8::Unit& u, int wr, int wc, int fr, int fq) const {
        const int row0 = u.pm * 256 + wr * 64 + fr, col0 = u.pn * 256 + wc * 32 + 8 * fq;
        const float* bp = b2 + (size_t)u.e * D + col0;
#pragma unroll
        for (int bj = 0; bj < 2; ++bj) {
            const f32x4 b0 = *(const f32x4*)(bp + bj * 128), b1v = *(const f32x4*)(bp + bj * 128 + 4);
#pragma unroll
            for (int ai = 0; ai < 2; ++ai)
#pragma unroll
                for (int m = 0; m < 4; ++m) {
                    const f32x4 v0 = acc[ai][bj][m][0] * (1.0f / 1024.0f) + b0, v1 = acc[ai][bj][m][1] * (1.0f / 1024.0f) + b1v;
#if Y_FP8
                    unsigned char* rowp = (unsigned char*)O + (size_t)(row0 + ai * 128 + m * 16) * D + col0 + bj * 128;
                    const f32x4 lim = (f32x4){448.f, 448.f, 448.f, 448.f};
                    const f32x4 q0 = __builtin_elementwise_min(__builtin_elementwise_max(v0 * 16.0f, -lim), lim), q1 = __builtin_elementwise_min(__builtin_elementwise_max(v1 * 16.0f, -lim), lim);
                    u32x2 w; w.x = pk4_fp8(q0[0], q0[1], q0[2], q0[3]); w.y = pk4_fp8(q1[0], q1[1], q1[2], q1[3]);
                    *(u32x2*)rowp = w;
#else
                    bf16_t* rowp = O + (size_t)(row0 + ai * 128 + m * 16) * D + col0 + bj * 128;
                    u32x4 w; w.x = pg8::cvt_pk_bf16(v0[0], v0[1]); w.y = pg8::cvt_pk_bf16(v0[2], v0[3]); w.z = pg8::cvt_pk_bf16(v1[0], v1[1]); w.w = pg8::cvt_pk_bf16(v1[2], v1[3]);
                    *(u32x4*)rowp = w;
#endif
                } }
    }
};
struct EpiSwiglu {
    static constexpr bool PERM = true; static constexpr bool PREFETCH = false;
    unsigned char* O; const float* b1;
    __device__ __forceinline__ void operator()(const AccT& acc, const pg8::Unit& u, int wr, int wc, int fr, int fq) const {
        const int row0 = u.pm * 256 + wr * 64 + fr, cc0 = u.pn * 128 + wc * 32 + 8 * fq;
        const float* bp = b1 + (size_t)u.e * 2048 + cc0;
        f32x4 bg[2], bl[2];
#pragma unroll
        for (int n = 0; n < 2; ++n) { bg[n] = *(const f32x4*)(bp + 4 * n); bl[n] = *(const f32x4*)(bp + 1024 + 4 * n) + 1.0f; }
#pragma unroll
        for (int ai = 0; ai < 2; ++ai)
#pragma unroll
            for (int m = 0; m < 4; ++m) { unsigned char* rowp = O + (size_t)(row0 + ai * 128 + m * 16) * D + cc0;
                float o[8];
#pragma unroll
                for (int n = 0; n < 2; ++n) { const f32x4 gl = acc[ai][0][m][n] * (1.0f / 2048.0f) + bg[n], li1 = acc[ai][1][m][n] * (1.0f / 2048.0f) + bl[n];
#pragma unroll
                    for (int j = 0; j < 4; ++j) { const float g = fminf(gl[j], 7.0f), l1 = __builtin_amdgcn_fmed3f(li1[j], -6.0f, 8.0f);
                        const float sg = __builtin_amdgcn_rcpf(1.0f + __builtin_amdgcn_exp2f(-2.45545696f * g));
                        o[4 * n + j] = (8.0f * g) * sg * l1; } }
                u32x2 w; w.x = pk4_fp8(o[0], o[1], o[2], o[3]); w.y = pk4_fp8(o[4], o[5], o[6], o[7]);
                *(u32x2*)rowp = w; }
    }
};
struct EpiResid {
    static constexpr bool PERM = true; static constexpr bool PREFETCH = WO_PREFETCH;
    bf16_t* xs; const float* g;
    __device__ __forceinline__ void prefetch(const pg8::Unit& u, int tid, LAS unsigned char* lds) const {
        const char* base = (const char*)(xs + (size_t)(u.pm * 256 + (tid >> 1)) * D + u.pn * 256) + (tid & 1) * 256;
        LAS unsigned* dump = (LAS unsigned*)(lds + pg8::STAGE_BYTES + 16384 + (tid >> 6) * 256);
        __builtin_amdgcn_global_load_lds((const unsigned*)base, dump, 4, 0, 0);
        __builtin_amdgcn_global_load_lds((const unsigned*)(base + 128), dump, 4, 0, 0);
    }
    __device__ __forceinline__ void operator()(const AccT& acc, const pg8::Unit& u, int wr, int wc, int fr, int fq) const {
        const int row0 = u.pm * 256 + wr * 64 + fr, col0 = u.pn * 256 + wc * 32 + 8 * fq;
        const int mb = u.pm < 8 ? 8 : ((u.pm - 8) >> 4);
        const float* gp = g + (size_t)mb * 6144 + col0;
        f32x4 gv[2][2];
#pragma unroll
        for (int bj = 0; bj < 2; ++bj)
#pragma unroll
            for (int n = 0; n < 2; ++n) gv[bj][n] = *(const f32x4*)(gp + bj * 128 + 4 * n);
#pragma unroll
        for (int ai = 0; ai < 2; ++ai) {
            u32x4 xv[4][2];
#pragma unroll
            for (int m = 0; m < 4; ++m) { const bf16_t* rowp = xs + (size_t)(row0 + ai * 128 + m * 16) * D + col0;
#pragma unroll
                for (int bj = 0; bj < 2; ++bj) xv[m][bj] = *(const u32x4*)(rowp + bj * 128); }
#pragma unroll
            for (int m = 0; m < 4; ++m) { bf16_t* rowp = xs + (size_t)(row0 + ai * 128 + m * 16) * D + col0;
#pragma unroll
                for (int bj = 0; bj < 2; ++bj) { const u32x4 x = xv[m][bj];
                    const f32x4 x0 = (f32x4){bflo(x.x), bfhi(x.x), bflo(x.y), bfhi(x.y)}, x1 = (f32x4){bflo(x.z), bfhi(x.z), bflo(x.w), bfhi(x.w)};
                    const f32x4 v0 = x0 + gv[bj][0] * acc[ai][bj][m][0], v1 = x1 + gv[bj][1] * acc[ai][bj][m][1];
                    u32x4 w; w.x = pg8::cvt_pk_bf16(v0[0], v0[1]); w.y = pg8::cvt_pk_bf16(v0[2], v0[3]); w.z = pg8::cvt_pk_bf16(v1[0], v1[1]); w.w = pg8::cvt_pk_bf16(v1[2], v1[3]);
                    *(u32x4*)(rowp + bj * 128) = w; } }
        }
    }
};

__device__ __forceinline__ const float* modp(const Frame& F, int l, int mb, int chunk) { return (const float*)(wsp(F) + WS_MOD) + ((size_t)(l * 9 + mb) * 6 + chunk) * D; }
__device__ __forceinline__ int row_mb(int row) { return row < ROWS_CTX ? 8 : ((row - ROWS_CTX) >> 12); }

__device__ __forceinline__ void transpose_item(const float* W, int N, int Nvalid, bf16_t* WT, int k0, int n0, LAS float* scr, int lane, const bool nost = false) {
    const int nn = 4 * (lane & 15);
    const bool ok = (n0 + nn) < Nvalid;
    f32x4 v[16];
#pragma unroll
    for (int i = 0; i < 16; ++i) { const int kk = 4 * i + (lane >> 4);
        v[i] = ok ? __builtin_nontemporal_load((const f32x4*)(W + (size_t)(k0 + kk) * N + n0 + nn)) : (f32x4){0.f, 0.f, 0.f, 0.f}; }
#pragma unroll
    for (int i = 0; i < 16; ++i) { const int kk = 4 * i + (lane >> 4); LAS float* s = scr + kk * 65 + nn;
        s[0] = v[i][0]; s[1] = v[i][1]; s[2] = v[i][2]; s[3] = v[i][3]; }
    LDS_WAIT(); asm volatile("" ::: "memory");
    const int c = lane & 7;
#pragma unroll
    for (int j = 0; j < 8; ++j) { const int n = (lane >> 3) + 8 * j; const LAS float* s = scr + (8 * c) * 65 + n;
        u32x4 o; o.x = pk2(s[0 * 65], s[1 * 65]); o.y = pk2(s[2 * 65], s[3 * 65]); o.z = pk2(s[4 * 65], s[5 * 65]); o.w = pk2(s[6 * 65], s[7 * 65]);
        if (!nost) *(u32x4*)(WT + (size_t)n * D + k0 + 8 * c) = o; }
    LDS_WAIT(); asm volatile("" ::: "memory");
}
__device__ __forceinline__ void transpose_item_f8(const float* W, int N, unsigned char* WT, int k0, int n0, LAS float* scr, int lane, float scale, const bool nost = false) {
    const int nn = 4 * (lane & 15);
    f32x4 v[16];
#pragma unroll
    for (int i = 0; i < 16; ++i) { const int kk = 4 * i + (lane >> 4); v[i] = __builtin_nontemporal_load((const f32x4*)(W + (size_t)(k0 + kk) * N + n0 + nn)); }
#pragma unroll
    for (int i = 0; i < 16; ++i) { const int kk = 4 * i + (lane >> 4); LAS float* s = scr + kk * 65 + nn;
        s[0] = v[i][0] * scale; s[1] = v[i][1] * scale; s[2] = v[i][2] * scale; s[3] = v[i][3] * scale; }
    LDS_WAIT(); asm volatile("" ::: "memory");
    const int c = lane & 3;
#pragma unroll
    for (int j = 0; j < 4; ++j) { const int n = (lane >> 2) + 16 * j; const LAS float* s = scr + (16 * c) * 65 + n;
        u32x4 o; o.x = pk4_fp8(s[0 * 65], s[1 * 65], s[2 * 65], s[3 * 65]); o.y = pk4_fp8(s[4 * 65], s[5 * 65], s[6 * 65], s[7 * 65]);
        o.z = pk4_fp8(s[8 * 65], s[9 * 65], s[10 * 65], s[11 * 65]); o.w = pk4_fp8(s[12 * 65], s[13 * 65], s[14 * 65], s[15 * 65]);
        if (!nost) *(u32x4*)(WT + (size_t)n * D + k0 + 16 * c) = o; }
    LDS_WAIT(); asm volatile("" ::: "memory");
}
struct CvItem { const float* W; unsigned char* dst; int N, Nvalid, k0, n0, f8; };
constexpr int CV_QKV = 2 * 16 * 48, CV_WO = 4 * 16 * 16, CV_IN = 2 * 16 * 52, CV_1 = DEPTH * NE * 16 * 32, CV_2 = DEPTH * NE * 16 * 16, CV_NIT = CV_QKV + CV_WO + CV_IN + CV_1 + CV_2;
#ifndef CV_SPLIT
#define CV_SPLIT 4
#endif
#ifndef CV_PERIOD
#define CV_PERIOD 0u
#endif
#ifndef CV_RD_END
#define CV_RD_END 500u
#endif
#ifndef CV_WR_BEG
#define CV_WR_BEG 950u
#endif
__device__ __forceinline__ void cv_window(const bool wr) {
#if CV_PERIOD > 0
    for (int spin = 0; spin < 4096; ++spin) {
        const unsigned t = (unsigned)__builtin_amdgcn_s_memrealtime() % CV_PERIOD;
        if (wr ? (t >= CV_WR_BEG) : (t < CV_RD_END)) break;
        __builtin_amdgcn_s_sleep(4);
    }
#endif
}
__device__ __forceinline__ CvItem cv_item(const Frame& F, int it) {
    CvItem I;
    if (it < CV_QKV) { const int j = it / 768, r = it % 768, kb = r / 48, nb = r % 48;
        I.W = inp(F, I_WQKV) + (size_t)j * D * 3072; I.N = 3072; I.Nvalid = 3072; I.dst = wsp(F) + WS_WQKV + (((size_t)j * 3072 + nb * 64) * D) * 2; I.k0 = kb * 64; I.n0 = nb * 64; I.f8 = 0; return I; }
    it -= CV_QKV;
    if (it < CV_WO) { const int m = it / 256, r = it % 256, kb = r / 16, nb = r % 16;
        I.W = (m < 2) ? inp(F, I_WONA) + (size_t)m * D * D : inp(F, I_WOML) + (size_t)(m - 2) * D * D;
        I.dst = ((m < 2) ? wsp(F) + WS_WONA + (size_t)m * D * D * 2 : wsp(F) + WS_WOML + (size_t)(m - 2) * D * D * 2) + (size_t)nb * 64 * D * 2;
        I.N = D; I.Nvalid = D; I.k0 = kb * 64; I.n0 = nb * 64; I.f8 = 0; return I; }
    it -= CV_WO;
    if (it < CV_IN) { const int j = it / 832, r = it % 832, kb = r / 52, nb = r % 52;
        I.W = inp(F, I_WIN) + (size_t)j * D * ML_IN; I.N = ML_IN; I.Nvalid = ML_IN; I.dst = wsp(F) + WS_WIN + (((size_t)j * ML_INP + nb * 64) * D) * 2; I.k0 = kb * 64; I.n0 = nb * 64; I.f8 = 0; return I; }
    it -= CV_IN;
    if (it < CV_1) { const int le = it / 512, r = it % 512, kb = r / 64, nb = r % 64;
        const int n0 = nb * 32, bj = n0 >> 10, j0 = n0 & 1023, pn = j0 >> 7, jj0 = j0 & 127, drow = pn * 256 + bj * 128 + jj0;
        I.W = inp(F, I_W1) + (size_t)le * D * 2048; I.N = 2048; I.Nvalid = 2048; I.dst = wsp(F) + WS_W1T + ((size_t)le * 2048 + drow) * D; I.k0 = kb * 128; I.n0 = n0; I.f8 = 1; return I; }
    it -= CV_1;
    { const int le = it / 256, r = it % 256, kb = r / 32, nb = r % 32;
        I.W = inp(F, I_W2) + (size_t)le * D * D; I.N = D; I.Nvalid = D; I.dst = wsp(F) + WS_W2T + ((size_t)le * D + nb * 32) * D; I.k0 = kb * 128; I.n0 = nb * 32; I.f8 = 1; return I; }
}
template <int NL>
__device__ __forceinline__ void cv_load(const CvItem& I, int lane, int i0, f32x4 (&v)[NL]) {
    const int rs = I.f8 ? 8 : 4, nn = I.f8 ? 4 * (lane & 7) : 4 * (lane & 15), kr = I.f8 ? (lane >> 3) : (lane >> 4);
    const bool ok = (I.n0 + nn) < I.Nvalid;
    const float* p = I.W + (size_t)(I.k0 + rs * i0 + kr) * I.N + I.n0 + nn;
#pragma unroll
    for (int i = 0; i < NL; ++i) v[i] = ok ? __builtin_nontemporal_load((const f32x4*)(p + (size_t)(rs * i) * I.N)) : (f32x4){0.f, 0.f, 0.f, 0.f};
}
template <int NL>
__device__ __forceinline__ void cv_lds(const CvItem& I, int lane, int i0, const f32x4 (&v)[NL], LAS float* scr) {
    const float scale = I.f8 ? 128.0f : 1.0f;
    LAS float* s0 = I.f8 ? scr + (8 * i0 + (lane >> 3)) * 33 + 4 * (lane & 7) : scr + (4 * i0 + (lane >> 4)) * 65 + 4 * (lane & 15);
    const int st = I.f8 ? 8 * 33 : 4 * 65;
#pragma unroll
    for (int i = 0; i < NL; ++i) { LAS float* s = s0 + i * st; s[0] = v[i][0] * scale; s[1] = v[i][1] * scale; s[2] = v[i][2] * scale; s[3] = v[i][3] * scale; }
}
__device__ __forceinline__ void cv_conv(const CvItem& I, int lane, LAS float* scr, u32x4 (&o)[8]) {
    LDS_WAIT(); asm volatile("" ::: "memory");
    if (I.f8) { const int c = lane & 7;
#pragma unroll
        for (int j = 0; j < 4; ++j) { const int n = (lane >> 3) + 8 * j; const LAS float* s = scr + (16 * c) * 33 + n;
            o[j].x = pk4_fp8(s[0 * 33], s[1 * 33], s[2 * 33], s[3 * 33]); o[j].y = pk4_fp8(s[4 * 33], s[5 * 33], s[6 * 33], s[7 * 33]);
            o[j].z = pk4_fp8(s[8 * 33], s[9 * 33], s[10 * 33], s[11 * 33]); o[j].w = pk4_fp8(s[12 * 33], s[13 * 33], s[14 * 33], s[15 * 33]); }
    } else { const int c = lane & 7;
#pragma unroll
        for (int j = 0; j < 8; ++j) { const int n = (lane >> 3) + 8 * j; const LAS float* s = scr + (8 * c) * 65 + n;
            o[j].x = pk2(s[0 * 65], s[1 * 65]); o[j].y = pk2(s[2 * 65], s[3 * 65]); o[j].z = pk2(s[4 * 65], s[5 * 65]); o[j].w = pk2(s[6 * 65], s[7 * 65]); }
    }
    LDS_WAIT(); asm volatile("" ::: "memory");
}
__device__ __forceinline__ void cv_put(const CvItem& I, int lane, const u32x4 (&o)[8]) {
    if (I.f8) { const int c = lane & 7;
#pragma unroll
        for (int j = 0; j < 4; ++j) { const int n = (lane >> 3) + 8 * j; *(u32x4*)(I.dst + (size_t)n * D + I.k0 + 16 * c) = o[j]; }
    } else { const int c = lane & 7;
#pragma unroll
        for (int j = 0; j < 8; ++j) { const int n = (lane >> 3) + 8 * j; *(u32x4*)(I.dst + ((size_t)n * D + I.k0 + 8 * c) * 2) = o[j]; }
    }
}
__device__ __forceinline__ void phase0(Frame& F, const int mode = 0) {
    const int tid = F.tid, lane = F.lane, wave = F.wave;
    if (mode != 2) {
        LAS float* sT = (LAS float*)F.lds;
        LAS float* red = (LAS float*)(F.lds + 40960);
        const float* c = inp(F, I_C); const float* cctx = inp(F, I_CCTX);
        for (int idx = tid; idx < 9 * D; idx += NTHREADS) { const int mb = idx >> 10, k = idx & 1023; const float cv = mb < 8 ? c[mb * D + k] : cctx[k]; sT[idx] = cv / (1.f + __expf(-cv)); }
        __syncthreads();
        float* mod = (float*)(wsp(F) + WS_MOD);
        for (int task = F.vcu; task < DEPTH * 64; task += F.G) {
            const int l = task >> 6, cb = task & 63, hk = lane >= 24 ? 1 : 0, ln = lane - 24 * hk; const bool act = lane < 48;
            const float* wp = inp(F, I_WADA) + ((size_t)l * D + wave * 128 + hk) * 6144 + cb * 96 + ln * 4;
            f32x4 acc[9];
#pragma unroll
            for (int mb = 0; mb < 9; ++mb) acc[mb] = (f32x4){0.f, 0.f, 0.f, 0.f};
#pragma unroll 8
            for (int k2 = 0; k2 < 64; ++k2) { const f32x4 wv = act ? __builtin_nontemporal_load((const f32x4*)(wp + (size_t)k2 * 2 * 6144)) : (f32x4){0.f, 0.f, 0.f, 0.f};
#pragma unroll
                for (int mb = 0; mb < 9; ++mb) acc[mb] += wv * sT[mb * D + wave * 128 + 2 * k2 + hk]; }
#pragma unroll
            for (int mb = 0; mb < 9; ++mb) {
#pragma unroll
                for (int c = 0; c < 4; ++c) acc[mb][c] += shfl_(acc[mb][c], lane + 24);
                if (lane < 24) *(LAS f32x4*)(red + (wave * 9 + mb) * 96 + lane * 4) = acc[mb]; }
            __syncthreads();
            for (int idx = tid; idx < 9 * 96; idx += NTHREADS) { const int mb = idx / 96, cc = idx % 96; float s = 0.f;
#pragma unroll
                for (int w = 0; w < 8; ++w) s += red[(w * 9 + mb) * 96 + cc];
                const int col = cb * 96 + cc;
                mod[(size_t)(l * 9 + mb) * 6144 + col] = s + inp(F, I_BADA)[l * 6144 + col]; }
            __syncthreads();
        }
        {
            bf16_t* rt = (bf16_t*)(wsp(F) + WS_RT); const float* wr = inp(F, I_WR);
            for (int idx = F.vcu * NTHREADS + tid; idx < DEPTH * D * NE; idx += F.G * NTHREADS) { const int l = idx >> 15, k = (idx >> 5) & 1023, e = idx & 31; const float w = wr[idx];
                const unsigned hb16 = f2bf(w); const float hf = __builtin_bit_cast(float, hb16 << 16);
                rt[((size_t)(l * 2 + 0) * NE + e) * D + k] = (bf16_t)hb16; rt[((size_t)(l * 2 + 1) * NE + e) * D + k] = (bf16_t)f2bf(w - hf); }
        }
        if (blockIdx.x == 0) {
            float* rope = (float*)(wsp(F) + WS_ROPE);
            for (int idx = tid; idx < 64 * 16; idx += NTHREADS) { const int pos = idx >> 4, i = idx & 15; const float inv = powf(10000.0f, -(float)i / 16.0f); const float ang = (float)pos * inv;
                rope[idx * 2] = cosf(ang); rope[idx * 2 + 1] = sinf(ang); }
        }
        __syncthreads();
    }
    if (mode != 1) {
        const bool nost = (mode == 3);
        LAS float* scr = (LAS float*)(F.lds + wave * 17024);
        const int gw = F.vcu * NWAVES + wave, NGW = F.G * NWAVES;
        for (int it0 = gw; it0 < CV_NIT; it0 += NGW) {
            const CvItem I0 = cv_item(F, it0);
            f32x4 v[16 / CV_SPLIT]; u32x4 o0[8];
#pragma unroll
            for (int h = 0; h < CV_SPLIT; ++h) { cv_load<16 / CV_SPLIT>(I0, lane, h * (16 / CV_SPLIT), v); cv_lds<16 / CV_SPLIT>(I0, lane, h * (16 / CV_SPLIT), v, scr); }
            cv_conv(I0, lane, scr, o0);
            if (!nost) cv_put(I0, lane, o0);
        }
    }
}

__device__ __forceinline__ void moe_combine(const Frame& F, const int4 pos, const float4 tw, int lprev, int mb, f32x4 (&v)[4]) {
    const int p[4] = {pos.x, pos.y, pos.z, pos.w}; const float w[4] = {tw.x, tw.y, tw.z, tw.w};
    f32x4 a[4];
#pragma unroll
    for (int j = 0; j < 4; ++j) a[j] = (f32x4){0.f, 0.f, 0.f, 0.f};
#if Y_FP8
    const unsigned char* Y = (const unsigned char*)(wsp(F) + WS_Y);
    unsigned y[4][4];
#pragma unroll
    for (int k = 0; k < 4; ++k) { const unsigned* yp = (const unsigned*)(Y + (size_t)p[k] * D) + F.lane;
#pragma unroll
        for (int j = 0; j < 4; ++j) y[k][j] = yp[64 * j]; }
#pragma unroll
    for (int k = 0; k < 4; ++k) { const float wk = w[k] * (1.0f / 16.0f);
#pragma unroll
        for (int j = 0; j < 4; ++j) { const int yy = (int)y[k][j];
            a[j] = a[j] + wk * (f32x4){__builtin_amdgcn_cvt_f32_fp8(yy, 0), __builtin_amdgcn_cvt_f32_fp8(yy, 1), __builtin_amdgcn_cvt_f32_fp8(yy, 2), __builtin_amdgcn_cvt_f32_fp8(yy, 3)}; } }
#else
    const bf16_t* Y = (const bf16_t*)(wsp(F) + WS_Y);
    u32x2 y[4][4];
#pragma unroll
    for (int k = 0; k < 4; ++k) { const u32x2* yp = (const u32x2*)(Y + (size_t)p[k] * D) + F.lane;
#pragma unroll
        for (int j = 0; j < 4; ++j) y[k][j] = yp[64 * j]; }
#pragma unroll
    for (int k = 0; k < 4; ++k)
#pragma unroll
        for (int j = 0; j < 4; ++j) a[j] = a[j] + w[k] * (f32x4){bflo(y[k][j].x), bfhi(y[k][j].x), bflo(y[k][j].y), bfhi(y[k][j].y)};
#endif
    const f32x4* g2 = (const f32x4*)modp(F, lprev, mb, 5) + F.lane;
#pragma unroll
    for (int j = 0; j < 4; ++j) v[j] = v[j] + g2[64 * j] * a[j];
}

__device__ __forceinline__ void phase_norm1(Frame& F, int l, bool dummy = false) {
    const int gw = F.vcu * NWAVES + F.wave, NGW = F.G * NWAVES, lane = F.lane;
    bf16_t* xs = (bf16_t*)(wsp(F) + WS_XS); bf16_t* hb = (bf16_t*)(wsp(F) + WS_HB);
    bf16_t* xso = dummy ? (bf16_t*)(wsp(F) + WS_ACT) : xs;
    const f32x4* gm = (const f32x4*)(inp(F, I_GMIX) + l * D) + lane;
    const int4* posp = (const int4*)(wsp(F) + WS_POS); const float4* twp = (const float4*)(wsp(F) + WS_TOPW);
    int4 pn = make_int4(0, 0, 0, 0); float4 wn = make_float4(0.f, 0.f, 0.f, 0.f);
    if (l > 0 && gw < ROWS) { pn = posp[gw]; wn = twp[gw]; }
    for (int row = gw; row < ROWS; row += NGW) {
        const int mb = row_mb(row);
        f32x4 v[4];
        if (l == 0) { const float* src = row < ROWS_CTX ? inp(F, I_CTX) + (size_t)row * D : inp(F, I_X) + (size_t)(row - ROWS_CTX) * D; const f32x4* xr = (const f32x4*)src + lane;
#pragma unroll
            for (int j = 0; j < 4; ++j) v[j] = xr[64 * j]; }
        else { const u32x2* xr = (const u32x2*)(xs + (size_t)row * D) + lane;
#pragma unroll
            for (int j = 0; j < 4; ++j) v[j] = bf4_to_f32(xr[64 * j]); }
        if (l > 0) { const int4 pc = pn; const float4 wc = wn;
            if (row + NGW < ROWS) { pn = posp[row + NGW]; wn = twp[row + NGW]; }
            moe_combine(F, pc, wc, l - 1, mb, v); }
        u32x2* xw = (u32x2*)(xso + (size_t)row * D) + lane;
        float ss = 0.f;
#pragma unroll
        for (int j = 0; j < 4; ++j) { u32x2 xb; xb.x = pk2(v[j][0], v[j][1]); xb.y = pk2(v[j][2], v[j][3]); xw[64 * j] = xb; ss += (v[j][0] * v[j][0] + v[j][1] * v[j][1]) + (v[j][2] * v[j][2] + v[j][3] * v[j][3]); }
        const float rs = 1.0f / sqrtf(wave_sum(ss) * (1.f / D) + EPS);
        const f32x4* sh = (const f32x4*)modp(F, l, mb, 0) + lane; const f32x4* sc = (const f32x4*)modp(F, l, mb, 1) + lane;
        u32x2* o8 = (u32x2*)(hb + (size_t)row * D) + lane;
#pragma unroll
        for (int j = 0; j < 4; ++j) { const f32x4 h = (v[j] * rs) * gm[64 * j] * (sc[64 * j] + 1.0f) + sh[64 * j];
            u32x2 w; w.x = pk2(h[0], h[1]); w.y = pk2(h[2], h[3]); o8[64 * j] = w; }
    }
}
__device__ __forceinline__ void phase_final(Frame& F) {
    const int gw = F.vcu * NWAVES + F.wave, NGW = F.G * NWAVES, lane = F.lane;
    const bf16_t* xs = (const bf16_t*)(wsp(F) + WS_XS);
    const int4* posp = (const int4*)(wsp(F) + WS_POS); const float4* twp = (const float4*)(wsp(F) + WS_TOPW);
    int4 pn = make_int4(0, 0, 0, 0); float4 wn = make_float4(0.f, 0.f, 0.f, 0.f);
    if (ROWS_CTX + gw < ROWS) { pn = posp[ROWS_CTX + gw]; wn = twp[ROWS_CTX + gw]; }
    for (int row = ROWS_CTX + gw; row < ROWS; row += NGW) {
        const int mb = row_mb(row);
        const u32x2* xr = (const u32x2*)(xs + (size_t)row * D) + lane;
        f32x4 v[4];
#pragma unroll
        for (int j = 0; j < 4; ++j) v[j] = bf4_to_f32(xr[64 * j]);
        const int4 pc = pn; const float4 wc = wn;
        if (row + NGW < ROWS) { pn = posp[row + NGW]; wn = twp[row + NGW]; }
        moe_combine(F, pc, wc, DEPTH - 1, mb, v);
        f32x4* o = (f32x4*)(outp(F) + (size_t)(row - ROWS_CTX) * D) + lane;
#ifdef MLPROF
        { const unsigned long long* pp = (const unsigned long long*)(wsp(F) + WS_CTL + 524288); const float tot = (float)(pp[0] + pp[1] + pp[2] + pp[3] + pp[4] + pp[5]);
          const float f = MLPROF_SEL < 0 ? 0.f : (MLPROF_SEL == 6 ? tot * (1.0f / 1048576.0f) : (MLPROF_SEL > 5 ? 1.f : (float)pp[MLPROF_SEL < 0 ? 0 : (MLPROF_SEL > 5 ? 5 : MLPROF_SEL)] / tot)); const float sc = 2.f + 4.f * f;
          const f32x4* xin = (const f32x4*)(inp(F, I_X) + (size_t)(row - ROWS_CTX) * D) + lane;
#pragma unroll
          for (int j = 0; j < 4; ++j) v[j] = xin[64 * j] * sc; }
#endif
#pragma unroll
        for (int j = 0; j < 4; ++j) o[64 * j] = v[j];
    }
}

constexpr int NCBP = 96, NA_CTX_EXTRA = 3;
__device__ __forceinline__ bool proj_split(int G) { return false && G >= 2 * NCBP; }
__device__ __forceinline__ void phase_na_post(Frame& F, int jn, const bool split) {
    const int gw = F.vcu * NWAVES + F.wave, NGW = F.G * NWAVES, lane = F.lane;
    constexpr int NIT = (ROWS / 64) * NH_NA, NIT_CTX = (ROWS_CTX / 64) * NH_NA, NIT_IMG = NIT - NIT_CTX;
    const int nwc = NCBP * NWAVES, nwm = NGW - nwc, m1 = NIT_IMG - NA_CTX_EXTRA * nwc;
    const bf16_t* proj = (const bf16_t*)(wsp(F) + WS_PROJ);
    bf16_t* QN = (bf16_t*)(wsp(F) + WS_QN); bf16_t* KN = (bf16_t*)(wsp(F) + WS_KN); bf16_t* VT = (bf16_t*)(wsp(F) + WS_VT);
    LAS bf16_t* vs = (LAS bf16_t*)(F.lds + F.wave * (64 * 72 * 2));
    const int c8 = lane & 7, rl = lane >> 3;
    float qg[8], kg[8];
#pragma unroll
    for (int e = 0; e < 8; ++e) { qg[e] = inp(F, I_QGAIN)[jn * 64 + c8 * 8 + e] * (0.125f * 1.44269504f); kg[e] = inp(F, I_KGAIN)[jn * 64 + c8 * 8 + e]; }
    for (int v = 0; ; ++v) {
        int item;
        if (!split) { item = gw + v * NGW; if (item >= NIT) break; }
        else if (gw < nwc) { if (v == 0) { if (gw >= NIT_CTX) continue; item = gw; } else { if (v > NA_CTX_EXTRA) break; item = NIT_CTX + m1 + gw + (v - 1) * nwc; } }
        else { const int m = (gw - nwc) + v * nwm; if (m >= m1) break; item = NIT_CTX + m; }
        const int rb = item >> 4, h = item & 15, row0 = rb * 64;
        int b, tp0;
        if (row0 < ROWS_CTX) { b = row0 >> 8; tp0 = row0 & 255; } else { b = (row0 - ROWS_CTX) >> 12; tp0 = NCTX + ((row0 - ROWS_CTX) & 4095); }
        const size_t seqbase = ((size_t)(b * NH_NA + h) * TT + tp0) * 64;
#pragma unroll
        for (int i = 0; i < 8; ++i) {
            const int r = i * 8 + rl;
            const bf16_t* pr = proj + (size_t)(row0 + r) * 3072 + h * 64 + c8 * 8;
            const u32x4 qv = *(const u32x4*)pr, kv = *(const u32x4*)(pr + 1024), vv = *(const u32x4*)(pr + 2048);
            float q[8] = {bflo(qv.x), bfhi(qv.x), bflo(qv.y), bfhi(qv.y), bflo(qv.z), bfhi(qv.z), bflo(qv.w), bfhi(qv.w)};
            float k[8] = {bflo(kv.x), bfhi(kv.x), bflo(kv.y), bfhi(kv.y), bflo(kv.z), bfhi(kv.z), bflo(kv.w), bfhi(kv.w)};
            float sq = 0.f, sk = 0.f;
#pragma unroll
            for (int e = 0; e < 8; ++e) { sq += q[e] * q[e]; sk += k[e] * k[e]; }
            sq = sum8(sq); sk = sum8(sk);
            const float rq = 1.0f / sqrtf(sq * (1.f / 64) + EPS), rk = 1.0f / sqrtf(sk * (1.f / 64) + EPS);
            u32x4 qo, ko;
            qo.x = pk2(q[0] * rq * qg[0], q[1] * rq * qg[1]); qo.y = pk2(q[2] * rq * qg[2], q[3] * rq * qg[3]); qo.z = pk2(q[4] * rq * qg[4], q[5] * rq * qg[5]); qo.w = pk2(q[6] * rq * qg[6], q[7] * rq * qg[7]);
            ko.x = pk2(k[0] * rk * kg[0], k[1] * rk * kg[1]); ko.y = pk2(k[2] * rk * kg[2], k[3] * rk * kg[3]); ko.z = pk2(k[4] * rk * kg[4], k[5] * rk * kg[5]); ko.w = pk2(k[6] * rk * kg[6], k[7] * rk * kg[7]);
            *(u32x4*)(QN + seqbase + (size_t)r * 64 + c8 * 8) = qo;
            *(u32x4*)(KN + seqbase + (size_t)r * 64 + c8 * 8) = ko;
            *(LAS u32x4*)(vs + r * 72 + ((c8 ^ ((r >> 3) & 7)) * 8)) = vv;
        }
        LDS_WAIT(); asm volatile("" ::: "memory");
#pragma unroll
        for (int j = 0; j < 8; ++j) {
            const int d = rl + 8 * j;
            const LAS bf16_t* s = vs + (8 * c8) * 72 + (((d >> 3) ^ c8) * 8) + (d & 7);
            u32x4 o;
            o.x = (unsigned)s[0 * 72] | ((unsigned)s[1 * 72] << 16); o.y = (unsigned)s[2 * 72] | ((unsigned)s[3 * 72] << 16);
            o.z = (unsigned)s[4 * 72] | ((unsigned)s[5 * 72] << 16); o.w = (unsigned)s[6 * 72] | ((unsigned)s[7 * 72] << 16);
            *(u32x4*)(VT + ((size_t)(b * NH_NA + h) * 64 + d) * TT + tp0 + 8 * c8) = o;
        }
        LDS_WAIT(); asm volatile("" ::: "memory");
    }
}

__device__ __forceinline__ bf16x8 ld_bf16x8(const bf16_t* p) { return *(const bf16x8*)p; }
constexpr int NA_LD = 72;
constexpr int NA_TILE = 64 * NA_LD * 2;
struct NaState { f32x4 o[4]; f32x4 osum; };
constexpr int NA_RING = 2 * 2 * 64 * NA_LD * 2;
constexpr int NA_CTX_OFF = NA_RING + 15 * 128 * 4;
constexpr int NA_BT_LD = 128, NA_BT_OFF = 48;
constexpr int NA_GQK_OFF = NA_CTX_OFF + 4 * 2 * 64 * NA_LD * 2;
__device__ __forceinline__ int na_row(int b, int tp) { return tp < NCTX ? b * NCTX + tp : ROWS_CTX + b * SEQ + (tp - NCTX); }
__device__ __forceinline__ u32x4 na_knorm(const u32x4 kv) {
    const float k[8] = {bflo(kv.x), bfhi(kv.x), bflo(kv.y), bfhi(kv.y), bflo(kv.z), bfhi(kv.z), bflo(kv.w), bfhi(kv.w)};
    float sk = 0.f;
#pragma unroll
    for (int e = 0; e < 8; ++e) sk += k[e] * k[e];
    sk = sum8(sk);
    const float rk = 1.0f / sqrtf(sk * (1.f / 64) + EPS);
    u32x4 o; o.x = pk2(k[0] * rk, k[1] * rk); o.y = pk2(k[2] * rk, k[3] * rk); o.z = pk2(k[4] * rk, k[5] * rk); o.w = pk2(k[6] * rk, k[7] * rk);
    return o;
}
__device__ __forceinline__ void na_vscatter(LAS bf16_t* vimg, const u32x4 vv, int r, int c8) {
    const unsigned vw[4] = {vv.x, vv.y, vv.z, vv.w};
    LAS bf16_t* d = vimg + (8 * c8) * NA_LD + r;
#pragma unroll
    for (int e = 0; e < 8; ++e) d[e * NA_LD] = (bf16_t)((vw[e >> 1] >> (16 * (e & 1))) & 0xffffu);
}
__device__ __forceinline__ void na_qload(const bf16_t* qp, const LAS float* gqk, int lane, int g, bf16x8 (&q)[2]) {
    const u32x4 a = *(const u32x4*)(qp + 8 * g), c = *(const u32x4*)(qp + 32 + 8 * g);
    const float f0[8] = {bflo(a.x), bfhi(a.x), bflo(a.y), bfhi(a.y), bflo(a.z), bfhi(a.z), bflo(a.w), bfhi(a.w)};
    const float f1[8] = {bflo(c.x), bfhi(c.x), bflo(c.y), bfhi(c.y), bflo(c.z), bfhi(c.z), bflo(c.w), bfhi(c.w)};
    float ss = 0.f;
#pragma unroll
    for (int e = 0; e < 8; ++e) ss += f0[e] * f0[e] + f1[e] * f1[e];
    ss += shfl_(ss, lane ^ 16); ss += shfl_(ss, lane ^ 32);
    const float rq = 1.0f / sqrtf(ss * (1.f / 64) + EPS);
    const f32x4 g0 = *(const LAS f32x4*)(gqk + 8 * g), g1 = *(const LAS f32x4*)(gqk + 8 * g + 4), g2 = *(const LAS f32x4*)(gqk + 32 + 8 * g), g3 = *(const LAS f32x4*)(gqk + 32 + 8 * g + 4);
    union { u32x4 u; bf16x8 v; } o0, o1;
    o0.u.x = pk2(f0[0] * rq * g0[0], f0[1] * rq * g0[1]); o0.u.y = pk2(f0[2] * rq * g0[2], f0[3] * rq * g0[3]); o0.u.z = pk2(f0[4] * rq * g1[0], f0[5] * rq * g1[1]); o0.u.w = pk2(f0[6] * rq * g1[2], f0[7] * rq * g1[3]);
    o1.u.x = pk2(f1[0] * rq * g2[0], f1[1] * rq * g2[1]); o1.u.y = pk2(f1[2] * rq * g2[2], f1[3] * rq * g2[3]); o1.u.z = pk2(f1[4] * rq * g3[0], f1[5] * rq * g3[1]); o1.u.w = pk2(f1[6] * rq * g3[2], f1[7] * rq * g3[3]);
    q[0] = o0.v; q[1] = o1.v;
}
template <bool WIN, bool DOA, bool DOB>
__device__ __forceinline__ void na_half2(NaState& sa, NaState& sb, const LAS bf16_t* KL, const LAS bf16_t* VL, int half, const bf16x8 (&qa)[2], const bf16x8 (&qb)[2],
                                         const LAS float* browA, const unsigned (&mA)[4], const unsigned (&mB)[4], int q16, int g) {
    union { u32x4 u; bf16x8 v; } ones; ones.u = (u32x4){0x3F803F80u, 0x3F803F80u, 0x3F803F80u, 0x3F803F80u};
    const LAS bf16_t* kp = KL + (half * 32 + q16) * NA_LD + 8 * g;
    const bf16x8 kf[2][2] = {{*(const LAS bf16x8*)kp, *(const LAS bf16x8*)(kp + 32)}, {*(const LAS bf16x8*)(kp + 16 * NA_LD), *(const LAS bf16x8*)(kp + 16 * NA_LD + 32)}};
    bf16x8 vf[4];
#pragma unroll
    for (int j4 = 0; j4 < 4; ++j4) { const LAS bf16_t* vp = VL + (16 * j4 + q16) * NA_LD + half * 32 + 4 * g;
        const bf16x4 va = *(const LAS bf16x4*)vp, vb = *(const LAS bf16x4*)(vp + 16);
        vf[j4] = (bf16x8){va[0], va[1], va[2], va[3], vb[0], vb[1], vb[2], vb[3]}; }
#pragma unroll
    for (int grp = 0; grp < 2; ++grp) {
        if ((grp == 0 && !DOA) || (grp == 1 && !DOB)) continue;
        NaState& st = grp ? sb : sa;
        const LAS float* brow = browA - 16 * grp;
        f32x4 sv[2];
#pragma unroll
        for (int nb = 0; nb < 2; ++nb) { f32x4 init = (f32x4){0.f, 0.f, 0.f, 0.f};
            if (WIN) {
#pragma unroll
                for (int rg = 0; rg < 4; ++rg) init[rg] = brow[32 * half + 16 * nb + rg]; }
            init = __builtin_amdgcn_mfma_f32_16x16x32_bf16(kf[nb][0], grp ? qb[0] : qa[0], init, 0, 0, 0);
            sv[nb] = __builtin_amdgcn_mfma_f32_16x16x32_bf16(kf[nb][1], grp ? qb[1] : qa[1], init, 0, 0, 0); }
#pragma unroll
        for (int nb = 0; nb < 2; ++nb)
#pragma unroll
            for (int rg = 0; rg < 4; ++rg) sv[nb][rg] = __builtin_amdgcn_exp2f(__builtin_amdgcn_fmed3f(sv[nb][rg], -3.0e38f, 100.0f));
        union { u32x4 u; bf16x8 v; } pf;
        pf.u.x = pg8::cvt_pk_bf16(sv[0][0], sv[0][1]); pf.u.y = pg8::cvt_pk_bf16(sv[0][2], sv[0][3]); pf.u.z = pg8::cvt_pk_bf16(sv[1][0], sv[1][1]); pf.u.w = pg8::cvt_pk_bf16(sv[1][2], sv[1][3]);
        if (WIN) { const unsigned (&mk)[4] = grp ? mB : mA; pf.u.x &= mk[0]; pf.u.y &= mk[1]; pf.u.z &= mk[2]; pf.u.w &= mk[3]; }
#pragma unroll
        for (int j4 = 0; j4 < 4; ++j4) st.o[j4] = __builtin_amdgcn_mfma_f32_16x16x32_bf16(vf[j4], pf.v, st.o[j4], 0, 0, 0);
        st.osum = __builtin_amdgcn_mfma_f32_16x16x32_bf16(ones.v, pf.v, st.osum, 0, 0, 0);
    }
}
__device__ __forceinline__ void na_block_task(const Frame& F, int jn, int b, int h, bool ctxq, int p) {
    const int tid = F.tid, lane = F.lane, wave = F.wave, q16 = lane & 15, g = lane >> 4;
    const bf16_t* proj = (const bf16_t*)(wsp(F) + WS_PROJ) + h * 64;
    const LAS float* gqk = (const LAS float*)(F.lds + NA_GQK_OFF);
    const int rw = 4 * p + (wave >> 1), ch = wave & 1, qcA = 32 * ch + q16, qcB = qcA + 16;
    const int qtpA = ctxq ? p * 128 + wave * 16 + q16 : NCTX + rw * 64 + qcA, qtpB = ctxq ? qtpA : qtpA + 16;
    bf16x8 qa[2], qb[2];
    na_qload(proj + (size_t)na_row(b, qtpA) * 3072, gqk, lane, g, qa);
    na_qload(proj + (size_t)na_row(b, qtpB) * 3072, gqk, lane, g, qb);
    NaState sa, sb;
#pragma unroll
    for (int j = 0; j < 4; ++j) { sa.o[j] = (f32x4){0.f, 0.f, 0.f, 0.f}; sb.o[j] = (f32x4){0.f, 0.f, 0.f, 0.f}; }
    sa.osum = (f32x4){0.f, 0.f, 0.f, 0.f}; sb.osum = (f32x4){0.f, 0.f, 0.f, 0.f};
    const int r0w = min(max(rw - 4, 0), 56), c0A = min(max(qcA - 8, 0), 48), c0B = min(max(qcB - 8, 0), 48);
    const int kr_lo = min(max(4 * p - 4, 0), 56), kr_hi = min(max(4 * p + 3 - 4, 0), 56) + 7;
    const int nw = ctxq ? 0 : (kr_hi - kr_lo + 1);
    LAS bf16_t* ring = (LAS bf16_t*)F.lds;
    LAS float* btab = (LAS float*)(F.lds + NA_RING);
    const LAS bf16_t* cres = (const LAS bf16_t*)(F.lds + NA_CTX_OFF);
    const int dA = 4 * g - c0A, dB = 4 * g - c0B;
    unsigned mkA[2][4], mkB[2][4];
#pragma unroll
    for (int hh2 = 0; hh2 < 2; ++hh2)
#pragma unroll
        for (int w4 = 0; w4 < 4; ++w4) { const int cc = 32 * hh2 + 16 * (w4 >> 1) + 2 * (w4 & 1);
            mkA[hh2][w4] = (((unsigned)(cc + dA) < 16u) ? 0xFFFFu : 0u) | (((unsigned)(cc + 1 + dA) < 16u) ? 0xFFFF0000u : 0u);
            mkB[hh2][w4] = (((unsigned)(cc + dB) < 16u) ? 0xFFFFu : 0u) | (((unsigned)(cc + 1 + dB) < 16u) ? 0xFFFF0000u : 0u); }
    const int bcolA = NA_BT_OFF + 4 * g - qcA + 15;
    const int r = tid >> 3, c8 = tid & 7;
    u32x4 kA, vA, kB, vB;
#define NA_TOK0(t) (NCTX + 64 * (kr_lo + (t)))
#define NA_LOAD(t, kk, vv) do { const bf16_t* pr_ = proj + (size_t)(ROWS_CTX + b * SEQ + 64 * (kr_lo + (t)) + r) * 3072 + 8 * c8; kk = *(const u32x4*)(pr_ + 1024); vv = *(const u32x4*)(pr_ + 2048); } while (0)
#define NA_WRITE(bufi, kk, vv) do { LAS bf16_t* dst_ = ring + (bufi) * (2 * 64 * NA_LD); *(LAS u32x4*)(dst_ + r * NA_LD + 8 * c8) = na_knorm(kk); na_vscatter(dst_ + 64 * NA_LD, vv, r, c8); } while (0)
#define NA_TILE(t, bufi) do { const LAS bf16_t* KL = ring + (bufi) * (2 * 64 * NA_LD); const LAS bf16_t* VL = KL + 64 * NA_LD; \
        const int kr = kr_lo + (t); \
        if (kr >= r0w && kr <= r0w + 7) { const LAS float* brow = btab + (kr - rw + 7) * NA_BT_LD + bcolA; \
            if (ch == 0) { na_half2<true, true, true>(sa, sb, KL, VL, 0, qa, qb, brow, mkA[0], mkB[0], q16, g); na_half2<true, false, true>(sa, sb, KL, VL, 1, qa, qb, brow, mkA[1], mkB[1], q16, g); } \
            else { na_half2<true, true, false>(sa, sb, KL, VL, 0, qa, qb, brow, mkA[0], mkB[0], q16, g); na_half2<true, true, true>(sa, sb, KL, VL, 1, qa, qb, brow, mkA[1], mkB[1], q16, g); } } } while (0)
    if (!ctxq) { NA_LOAD(0, kA, vA); NA_LOAD(1, kB, vB); }
    if (ctxq) {
#pragma unroll 1
        for (int t = 0; t < 4; ++t) { const LAS bf16_t* KL = cres + t * (2 * 64 * NA_LD);
            na_half2<false, true, false>(sa, sb, KL, KL + 64 * NA_LD, 0, qa, qb, btab, mkA[0], mkB[0], q16, g); na_half2<false, true, false>(sa, sb, KL, KL + 64 * NA_LD, 1, qa, qb, btab, mkA[1], mkB[1], q16, g); }
    } else {
#pragma unroll 1
        for (int t = 0; t < 4; ++t) { const LAS bf16_t* KL = cres + t * (2 * 64 * NA_LD);
            na_half2<false, true, true>(sa, sb, KL, KL + 64 * NA_LD, 0, qa, qb, btab, mkA[0], mkB[0], q16, g); na_half2<false, true, true>(sa, sb, KL, KL + 64 * NA_LD, 1, qa, qb, btab, mkA[1], mkB[1], q16, g); }
        NA_WRITE(0, kA, vA);
        __syncthreads();
        NA_LOAD(2, kA, vA);
        for (int t = 0; t < nw; t += 2) {
            NA_TILE(t, 0);
            if (t + 1 < nw) NA_WRITE(1, kB, vB);
            __syncthreads();
            if (t + 3 < nw) NA_LOAD(t + 3, kB, vB);
            if (t + 1 >= nw) break;
            NA_TILE(t + 1, 1);
            if (t + 2 < nw) NA_WRITE(0, kA, vA);
            __syncthreads();
            if (t + 4 < nw) NA_LOAD(t + 4, kA, vA);
        }
    }
#undef NA_TOK0
#undef NA_LOAD
#undef NA_WRITE
#undef NA_TILE
    {
        const float inv = 1.0f / sa.osum[0];
        const int row = ctxq ? b * NCTX + p * 128 + wave * 16 + q16 : ROWS_CTX + b * SEQ + rw * 64 + qcA;
        bf16_t* op = (bf16_t*)(wsp(F) + WS_AO) + (size_t)row * D + h * 64 + 4 * g;
#pragma unroll
        for (int j4 = 0; j4 < 4; ++j4) { u32x2 w; w.x = pk2(sa.o[j4][0] * inv, sa.o[j4][1] * inv); w.y = pk2(sa.o[j4][2] * inv, sa.o[j4][3] * inv); *(u32x2*)(op + 16 * j4) = w; }
    }
    if (!ctxq) {
        const float inv = 1.0f / sb.osum[0];
        const int row = ROWS_CTX + b * SEQ + rw * 64 + qcB;
        bf16_t* op = (bf16_t*)(wsp(F) + WS_AO) + (size_t)row * D + h * 64 + 4 * g;
#pragma unroll
        for (int j4 = 0; j4 < 4; ++j4) { u32x2 w; w.x = pk2(sb.o[j4][0] * inv, sb.o[j4][1] * inv); w.y = pk2(sb.o[j4][2] * inv, sb.o[j4][3] * inv); *(u32x2*)(op + 16 * j4) = w; }
    }
}
__device__ __forceinline__ void phase_na_attn(Frame& F, int jn) {
    const int nbh = NB * NH_NA;
    for (int slot = F.vcu; slot < 2 * nbh; slot += F.G) {
        const int bh = slot >> 1, hf = slot & 1, b = bh >> 4, h = bh & 15;
        {
            LAS float* btab = (LAS float*)(F.lds + NA_RING);
            const float* rpb = inp(F, I_RPB) + (size_t)(jn * NH_NA + h) * 15 * 31;
            for (int i = F.tid; i < 15 * NA_BT_LD; i += NTHREADS) { const int dr = i >> 7, c = (i & 127) - NA_BT_OFF; btab[i] = (c >= 0 && c < 31) ? rpb[dr * 31 + c] * 1.44269504f : 0.f; }
            const bf16_t* proj = (const bf16_t*)(wsp(F) + WS_PROJ) + h * 64;
            LAS bf16_t* cres = (LAS bf16_t*)(F.lds + NA_CTX_OFF); const int r = F.tid >> 3, c8 = F.tid & 7;
            if (F.tid < 64) ((LAS float*)(F.lds + NA_GQK_OFF))[F.tid] = inp(F, I_QGAIN)[jn * 64 + F.tid] * inp(F, I_KGAIN)[jn * 64 + F.tid] * (0.125f * 1.44269504f);
            u32x4 ck[4], cv[4];
#pragma unroll
            for (int t = 0; t < 4; ++t) { const bf16_t* pr = proj + (size_t)(b * NCTX + 64 * t + r) * 3072 + 8 * c8; ck[t] = *(const u32x4*)(pr + 1024); cv[t] = *(const u32x4*)(pr + 2048); }
#pragma unroll
            for (int t = 0; t < 4; ++t) { LAS bf16_t* dst = cres + t * (2 * 64 * NA_LD);
                *(LAS u32x4*)(dst + r * NA_LD + 8 * c8) = na_knorm(ck[t]);
                na_vscatter(dst + 64 * NA_LD, cv[t], r, c8); }
            __syncthreads();
        }
        for (int n = 0; n < 8; ++n) na_block_task(F, jn, b, h, false, hf * 8 + n);
        na_block_task(F, jn, b, h, true, hf);
        __syncthreads();
    }
}

__device__ __forceinline__ void row_decode(int row, int& b, int& tp) {
    if (row < ROWS_CTX) { b = row >> 8; tp = row & 255; } else { b = (row - ROWS_CTX) >> 12; tp = NCTX + ((row - ROWS_CTX) & 4095); }
}
__device__ __forceinline__ void unpack8(const u32x4 v, float (&f)[8]) { f[0] = bflo(v.x); f[1] = bfhi(v.x); f[2] = bflo(v.y); f[3] = bfhi(v.y); f[4] = bflo(v.z); f[5] = bfhi(v.z); f[6] = bflo(v.w); f[7] = bfhi(v.w); }
__device__ __forceinline__ u32x4 pack8(const float (&f)[8]) { u32x4 o; o.x = pk2(f[0], f[1]); o.y = pk2(f[2], f[3]); o.z = pk2(f[4], f[5]); o.w = pk2(f[6], f[7]); return o; }
__device__ __forceinline__ float wave_prefix_sum(float v, int lane) {
#pragma unroll
    for (int o = 1; o < 64; o <<= 1) { const float t = shfl_(v, lane - o); if (lane >= o) v += t; }
    return v;
}
__device__ __forceinline__ float wave_prefix_max(float v, int lane) {
#pragma unroll
    for (int o = 1; o < 64; o <<= 1) { const float t = shfl_(v, lane - o); if (lane >= o) v = fmaxf(v, t); }
    return v;
}
__device__ __forceinline__ int ml_grow(int b, int tp) { return tp < NCTX ? b * NCTX + tp : ROWS_CTX + b * SEQ + (tp - NCTX); }
__device__ __forceinline__ void phase_ml_post(Frame& F, int jm) {
    const int gw = F.vcu * NWAVES + F.wave, NGW = F.G * NWAVES, lane = F.lane;
    const bf16_t* proj = (const bf16_t*)(wsp(F) + WS_PROJ);
    float* gs = (float*)(wsp(F) + WS_GS);
    for (int task = gw; task < NB * (TT / 64); task += NGW) {
        const int b = task / (TT / 64), mc = task % (TT / 64);
        const bf16_t* pr = proj + (size_t)ml_grow(b, mc * 64 + lane) * ML_INP + 3072;
        float gp[32];
        { float t8[8];
#pragma unroll
          for (int q = 0; q < 4; ++q) { unpack8(*(const u32x4*)(pr + 8 * q), t8);
#pragma unroll
              for (int e = 0; e < 8; ++e) gp[8 * q + e] = t8[e]; } }
#pragma unroll
        for (int i = 0; i < 32; ++i) { float v = gp[i] + inp(F, I_BGATE)[jm * 32 + i]; v = 15.0f * tanhf(v * (1.0f / 15.0f));
            if ((i >> 3) & 1) v = fminf(v, 0.f) - log1pf(__expf(-fabsf(v)));
            gp[i] = v; }
#pragma unroll
        for (int dir = 0; dir < 2; ++dir)
#pragma unroll
            for (int hh = 0; hh < NH_ML; ++hh) {
                float ig = gp[(2 * dir) * 8 + hh], lf = gp[(2 * dir + 1) * 8 + hh];
                if (dir) { ig = shfl_(ig, 63 - lane); lf = shfl_(lf, 63 - lane); }
                const float cum = wave_prefix_sum(lf, lane), av = ig - cum, pmax = wave_prefix_max(av, lane), cl = shfl_(cum, 63);
                const float wend = cl - cum + ig, ml = wave_max(wend), eend = __expf(wend - ml);
                float* o = gs + ((((size_t)(dir * NB + b) * NH_ML + hh) * (TT / 64) + mc) * 5) * 64;
                o[lane] = cum; o[64 + lane] = av; o[128 + lane] = pmax; o[192 + lane] = eend; if (lane == 0) { o[256] = cl; o[257] = ml; }
            }
    }
}

constexpr int ML_LD = 72;
constexpr int ML_QL = 0, ML_KL = 9216, ML_KET = 18432, ML_VTL = 27648, ML_SDL = 36864, ML_C0L = 46080, ML_N0L = 55296, ML_DENL = 55552;
constexpr int ML_HL = 55808, ML_GL = 65024;
constexpr int ML_ALT = 69632;
__device__ __forceinline__ void ml_task(Frame& F, int jm, int b, int hh, int dir, int vh) {
    const int tid = F.tid, lane = F.lane, w = F.wave, l15 = lane & 15, g = lane >> 4;
    LAS bf16_t* QL = (LAS bf16_t*)(F.lds + ML_QL); LAS bf16_t* KL = (LAS bf16_t*)(F.lds + ML_KL); LAS bf16_t* KET = (LAS bf16_t*)(F.lds + ML_KET);
    LAS bf16_t* VTL = (LAS bf16_t*)(F.lds + ML_VTL); LAS bf16_t* SDL = (LAS bf16_t*)(F.lds + ML_SDL); LAS bf16_t* C0L = (LAS bf16_t*)(F.lds + ML_C0L);
    LAS float* n0L = (LAS float*)(F.lds + ML_N0L); LAS float* denL = (LAS float*)(F.lds + ML_DENL);
    LAS bf16_t* HL = (LAS bf16_t*)(F.lds + ML_HL); LAS float* GL = (LAS float*)(F.lds + ML_GL);
    const bf16_t* proj = (const bf16_t*)(wsp(F) + WS_PROJ);
    const float* gsb = (const float*)(wsp(F) + WS_GS) + (((size_t)(dir * NB + b) * NH_ML + hh) * (TT / 64)) * 5 * 64;
    bf16_t* hout = (bf16_t*)(wsp(F) + WS_HDIR) + (size_t)dir * ROWS * D + hh * DV_ML + vh * 64;
    {
        const float bi = inp(F, I_BGATE)[jm * 32 + (2 * dir) * 8 + hh], bfg = inp(F, I_BGATE)[jm * 32 + (2 * dir + 1) * 8 + hh];
        float* gso = (float*)(wsp(F) + WS_GS) + (((size_t)(dir * NB + b) * NH_ML + hh) * (TT / 64)) * 5 * 64;
        for (int mc = w; mc < TT / 64; mc += NWAVES) {
            const bf16_t* pr = proj + (size_t)ml_grow(b, mc * 64 + lane) * ML_INP + 3072;
            float ig = bf2f(pr[(2 * dir) * 8 + hh]) + bi; ig = 15.0f * tanhf(ig * (1.0f / 15.0f));
            float lf = bf2f(pr[(2 * dir + 1) * 8 + hh]) + bfg; lf = 15.0f * tanhf(lf * (1.0f / 15.0f)); lf = fminf(lf, 0.f) - log1pf(__expf(-fabsf(lf)));
            if (dir) { ig = shfl_(ig, 63 - lane); lf = shfl_(lf, 63 - lane); }
            const float cum = wave_prefix_sum(lf, lane), av = ig - cum, pmax = wave_prefix_max(av, lane), cl = shfl_(cum, 63);
            const float wend = cl - cum + ig, ml = wave_max(wend), eend = __expf(wend - ml);
            float* o = gso + (size_t)mc * 5 * 64;
            o[lane] = cum; o[64 + lane] = av; o[128 + lane] = pmax; o[192 + lane] = eend; if (lane == 0) { o[256] = cl; o[257] = ml; }
        }
        VM_WAIT();
        __syncthreads();
    }
    const bool loader = (0x2Bu >> w) & 1u;
    const int ridx = __builtin_popcount((loader ? 0x2Bu : 0xD4u) & ((1u << w) - 1u));
    const int c8 = lane & 7, r0 = ridx * 8 + (lane >> 3);
    const int bt = w >> 1, bc0 = 2 * (w & 1);
    for (int i = tid; i < 64 * ML_LD / 2; i += NTHREADS) { ((LAS unsigned*)C0L)[i] = 0u; ((LAS unsigned*)SDL)[i] = 0u; }
    if (tid < 64) n0L[tid] = 0.f;
    f32x4 Cst[2]; Cst[0] = (f32x4){0.f, 0.f, 0.f, 0.f}; Cst[1] = (f32x4){0.f, 0.f, 0.f, 0.f};
    float nst = 0.f, m0 = 0.f;
#ifdef MLPROF
    unsigned long long pa_[6] = {0, 0, 0, 0, 0, 0}, pt_; asm volatile("s_memtime %0\n\ts_waitcnt lgkmcnt(0)" : "=s"(pt_) :: "memory");
#define PROFPT(k) do { unsigned long long n_; __builtin_amdgcn_sched_barrier(0); asm volatile("s_memtime %0\n\ts_waitcnt lgkmcnt(0)" : "=s"(n_) :: "memory"); __builtin_amdgcn_sched_barrier(0); pa_[k] += n_ - pt_; pt_ = n_; } while (0)
#else
#define PROFPT(k) do {} while (0)
#endif
    u32x4 qA[2], kA[2], vA[2]; float gA[6];
#define ML_TB(c) (dir ? ((c) < 4 ? 192 - 64 * (c) : 4544 - 64 * (c)) : 64 * (c))
#ifdef MLHOT
#define ML_TBL(cn) ML_TB(0)
#else
#define ML_TBL(cn) ML_TB(cn)
#endif
#define ML_LOADSET(cn, QV, KV, VV, GG) do { const int tbn_ = ML_TBL(cn); \
        _Pragma("unroll") for (int h2 = 0; h2 < 2; ++h2) { const bf16_t* pr_ = proj + (size_t)ml_grow(b, tbn_ + r0 + 32 * h2) * ML_INP; \
            QV[h2] = *(const u32x4*)(pr_ + hh * 64 + c8 * 8); KV[h2] = *(const u32x4*)(pr_ + 512 + hh * 64 + c8 * 8); VV[h2] = *(const u32x4*)(pr_ + 1024 + hh * DV_ML + vh * 64 + c8 * 8); } \
        const float* gp_ = gsb + (size_t)(tbn_ >> 6) * 5 * 64; \
        GG[0] = gp_[lane]; GG[1] = gp_[64 + lane]; GG[2] = gp_[128 + lane]; GG[3] = gp_[192 + lane]; GG[4] = gp_[256]; GG[5] = gp_[257]; } while (0)
#define ML_WRITESET(PBW, QV, KV, VV, GG) do { LAS bf16_t* QLw = QL + (PBW) * (ML_ALT / 2); LAS bf16_t* KLw = KL + (PBW) * (ML_ALT / 2); LAS bf16_t* KETw = KET + (PBW) * (ML_ALT / 2); LAS bf16_t* VTLw = VTL + (PBW) * (ML_ALT / 2); LAS float* GLw = GL + (PBW) * (ML_ALT / 4); \
        _Pragma("unroll") for (int h2 = 0; h2 < 2; ++h2) { const int rr_ = r0 + 32 * h2, sr = dir ? 63 - rr_ : rr_; \
            *(LAS u32x4*)(QLw + sr * ML_LD + c8 * 8) = QV[h2]; *(LAS u32x4*)(KLw + sr * ML_LD + c8 * 8) = KV[h2]; \
            const float es = shfl_(GG[3], sr); float kf[8]; unpack8(KV[h2], kf); const unsigned vw[4] = {VV[h2].x, VV[h2].y, VV[h2].z, VV[h2].w}; \
            _Pragma("unroll") for (int e = 0; e < 8; ++e) { KETw[(c8 * 8 + e) * ML_LD + (sr ^ (8 * c8))] = (bf16_t)pk2(kf[e] * es, 0.f); VTLw[(c8 * 8 + e) * ML_LD + (sr ^ (8 * c8))] = (bf16_t)((vw[e >> 1] >> (16 * (e & 1))) & 0xffffu); } } \
        if (w == 0) { GLw[lane] = GG[0]; GLw[64 + lane] = GG[1]; GLw[128 + lane] = GG[2]; if (lane == 0) { GLw[192] = GG[4]; GLw[193] = GG[5]; } } } while (0)
#define ML_STOREH(cp) do { const int tbp_ = ML_TB(cp); \
        _Pragma("unroll") for (int h2 = 0; h2 < 2; ++h2) { const int rr_ = r0 + 32 * h2; \
            *(u32x4*)(hout + (size_t)ml_grow(b, tbp_ + rr_) * D + c8 * 8) = *(const LAS u32x4*)(HL + rr_ * ML_LD + c8 * 8); } } while (0)
#define ML_CHUNK(c, PB, QV, KV, VV, GG) do {     \
        const int tb = ML_TB(c); \
        LAS bf16_t* QLc = QL + (PB) * (ML_ALT / 2); LAS bf16_t* KLc = KL + (PB) * (ML_ALT / 2); LAS bf16_t* KETc = KET + (PB) * (ML_ALT / 2); LAS bf16_t* VTLc = VTL + (PB) * (ML_ALT / 2); LAS float* GLc = GL + (PB) * (ML_ALT / 4); \
        const float cum = GLc[lane], av = GLc[64 + lane], pmax = GLc[128 + lane], cl = GLc[192], ml = GLc[193]; \
        const float Mv = fmaxf(m0, pmax); \
        const float winter = __expf(m0 - Mv); \
        const float floorv = __expf(-(cum + Mv)); \
        const float mnew = fmaxf(cl + m0, ml); \
        const float Ac = __expf(cl + m0 - mnew), Gc = __expf(ml - mnew); \
        _Pragma("unroll") for (int x = 0; x < 2; ++x) { \
            const int bs = bc0 + x; \
            if (bs <= bt) {     \
                f32x4 acc = (f32x4){0.f, 0.f, 0.f, 0.f}; \
                _Pragma("unroll") for (int ks = 0; ks < 2; ++ks) { const bf16x8 af = *(const LAS bf16x8*)(QLc + (16 * bt + l15) * ML_LD + 32 * ks + 8 * g), bfv = *(const LAS bf16x8*)(KLc + (16 * bs + l15) * ML_LD + 32 * ks + 8 * g); \
                    acc = __builtin_amdgcn_mfma_f32_16x16x32_bf16(af, bfv, acc, 0, 0, 0); } \
                const int s = 16 * bs + l15; \
                const float a_s = shfl_(av, s); \
                _Pragma("unroll") for (int rg = 0; rg < 4; ++rg) { const int t = 16 * bt + 4 * g + rg; const float M_t = shfl_(Mv, t); \
                    const float val = (s <= t) ? acc[rg] * __expf(a_s - M_t) : 0.f; \
                    SDL[t * ML_LD + s] = (bf16_t)pk2(val, 0.f); } \
            } \
        } \
        if (loader) { if ((c) + 1 < TT / 64) ML_WRITESET(1 - (PB), QV, KV, VV, GG); if ((c) + 2 < TT / 64) ML_LOADSET((c) + 2, QV, KV, VV, GG); }     \
        PROFPT(2); __syncthreads(); PROFPT(3);                                                 \
        if (!loader && (c) > 0) ML_STOREH((c) - 1); \
        { \
            const int rr8 = 8 * w + (lane >> 3), part = lane & 7; \
            float sd[8], qf[8], kf[8]; \
            unpack8(*(const LAS u32x4*)(SDL + rr8 * ML_LD + 8 * part), sd); unpack8(*(const LAS u32x4*)(QLc + rr8 * ML_LD + 8 * part), qf); \
            unpack8(*(const LAS u32x4*)(KETc + rr8 * ML_LD + ((8 * part) ^ (8 * ((rr8 >> 3) & 7)))), kf); \
            const f32x4 n0a = *(const LAS f32x4*)(n0L + 8 * part), n0b = *(const LAS f32x4*)(n0L + 8 * part + 4); \
            float rs = ((sd[0] + sd[1]) + (sd[2] + sd[3])) + ((sd[4] + sd[5]) + (sd[6] + sd[7])); \
            float qn = qf[0] * n0a[0] + qf[1] * n0a[1] + qf[2] * n0a[2] + qf[3] * n0a[3] + qf[4] * n0b[0] + qf[5] * n0b[1] + qf[6] * n0b[2] + qf[7] * n0b[3]; \
            float dn = ((kf[0] + kf[1]) + (kf[2] + kf[3])) + ((kf[4] + kf[5]) + (kf[6] + kf[7])); \
            rs = sum8(rs); qn = sum8(qn); dn = sum8(dn); \
            const float w_r = shfl_(winter, rr8); \
            if (part == 0) denL[rr8] = rs + w_r * qn; \
            nst = Ac * nst + Gc * dn; \
        } \
        f32x4 nin[2], nit[2]; \
        _Pragma("unroll") for (int x = 0; x < 2; ++x) { \
            const int bv = bc0 + x; \
            f32x4 a1 = (f32x4){0.f, 0.f, 0.f, 0.f}, a2 = (f32x4){0.f, 0.f, 0.f, 0.f}, a3 = (f32x4){0.f, 0.f, 0.f, 0.f}; \
            _Pragma("unroll") for (int ks = 0; ks < 2; ++ks) { \
                const bf16x8 sdf = *(const LAS bf16x8*)(SDL + (16 * bt + l15) * ML_LD + 32 * ks + 8 * g), vtf = *(const LAS bf16x8*)(VTLc + (16 * bv + l15) * ML_LD + ((32 * ks + 8 * g) ^ (8 * (((16 * bv + l15) >> 3) & 7)))); \
                const bf16x8 qf = *(const LAS bf16x8*)(QLc + (16 * bt + l15) * ML_LD + 32 * ks + 8 * g), c0f = *(const LAS bf16x8*)(C0L + (16 * bv + l15) * ML_LD + 32 * ks + 8 * g); \
                const bf16x8 vt2 = *(const LAS bf16x8*)(VTLc + (16 * bt + l15) * ML_LD + ((32 * ks + 8 * g) ^ (8 * (((16 * bt + l15) >> 3) & 7)))), kef = *(const LAS bf16x8*)(KETc + (16 * bv + l15) * ML_LD + ((32 * ks + 8 * g) ^ (8 * (((16 * bv + l15) >> 3) & 7)))); \
                a1 = __builtin_amdgcn_mfma_f32_16x16x32_bf16(sdf, vtf, a1, 0, 0, 0); \
                a2 = __builtin_amdgcn_mfma_f32_16x16x32_bf16(qf, c0f, a2, 0, 0, 0); \
                a3 = __builtin_amdgcn_mfma_f32_16x16x32_bf16(vt2, kef, a3, 0, 0, 0); \
            } \
            nin[x] = a1; nit[x] = a2; \
            Cst[x] = Cst[x] * Ac + a3 * Gc; \
        } \
        PROFPT(4); __syncthreads(); PROFPT(3);                                                 \
        if ((lane & 7) == 0) n0L[8 * w + (lane >> 3)] = nst; \
        _Pragma("unroll") for (int x = 0; x < 2; ++x) { \
            const int bv = bc0 + x; \
            _Pragma("unroll") for (int rg = 0; rg < 4; ++rg) { const int t = 16 * bt + 4 * g + rg; \
                const float den = denL[t], w_t = shfl_(winter, t), fl_t = shfl_(floorv, t); \
                const float hv = (nin[x][rg] + w_t * nit[x][rg]) * __builtin_amdgcn_rcpf(fmaxf(fabsf(den), fl_t)); \
                const int rr = dir ? 63 - t : t; \
                HL[rr * ML_LD + 16 * bv + l15] = (bf16_t)pk2(hv, 0.f); \
                C0L[(16 * bt + 4 * g + rg) * ML_LD + 16 * bv + l15] = (bf16_t)pk2(Cst[x][rg], 0.f); } \
        } \
        m0 = mnew; \
        (void)tb; PROFPT(5); \
    } while (0)
    if (loader) { ML_LOADSET(0, qA, kA, vA, gA); ML_WRITESET(0, qA, kA, vA, gA); ML_LOADSET(1, qA, kA, vA, gA); }
    __syncthreads();
    for (int c = 0; c < TT / 64; c += 2) {
        ML_CHUNK(c, 0, qA, kA, vA, gA);
        ML_CHUNK(c + 1, 1, qA, kA, vA, gA);
    }
    __syncthreads();
    if (!loader) ML_STOREH(TT / 64 - 1);
#ifdef MLPROF
    if (F.vcu == MLPROF_BLK && tid == MLPROF_WAVE * 64) { unsigned long long* pp = (unsigned long long*)(wsp(F) + WS_CTL + 524288); pp[0] = pa_[0]; pp[1] = pa_[1]; pp[2] = pa_[2]; pp[3] = pa_[3]; pp[4] = pa_[4]; pp[5] = pa_[5]; }
#endif
#undef ML_CHUNK
#undef ML_STOREH
#undef ML_WRITESET
#undef ML_LOADSET
#undef ML_TB
    __syncthreads();
}
__device__ __forceinline__ void phase_ml_scan(Frame& F, int jm) {
    for (int task = F.vcu; task < NB * NH_ML * 4; task += F.G) {
        const int vh = task & 1, dir = (task >> 1) & 1, bh = task >> 2;
        ml_task(F, jm, bh >> 3, bh & 7, dir, vh);
    }
}

__device__ __forceinline__ void phase_ml_final(Frame& F, int jm) {
    const int gw = F.vcu * NWAVES + F.wave, NGW = F.G * NWAVES, lane = F.lane;
    const bf16_t* hfw = (const bf16_t*)(wsp(F) + WS_HDIR); const bf16_t* hbw = hfw + (size_t)ROWS * D;
    const bf16_t* proj = (const bf16_t*)(wsp(F) + WS_PROJ);
    bf16_t* ao = (bf16_t*)(wsp(F) + WS_AO);
    const float* gain = inp(F, I_MHGAIN) + jm * D + lane * 16;
    for (int row = gw; row < ROWS; row += NGW) {
        const size_t off = (size_t)row * D + lane * 16;
        float a0[8], a1[8], b0[8], b1[8], g0[8], g1[8];
        unpack8(*(const u32x4*)(hfw + off), a0); unpack8(*(const u32x4*)(hfw + off + 8), a1);
        unpack8(*(const u32x4*)(hbw + off), b0); unpack8(*(const u32x4*)(hbw + off + 8), b1);
        const bf16_t* ogp = proj + (size_t)row * ML_INP + 2048 + lane * 16;
        unpack8(*(const u32x4*)ogp, g0); unpack8(*(const u32x4*)(ogp + 8), g1);
        float ss = 0.f;
#pragma unroll
        for (int e = 0; e < 8; ++e) { a0[e] += b0[e]; a1[e] += b1[e]; ss += a0[e] * a0[e] + a1[e] * a1[e]; }
        ss = sum8(ss);
        const float rs = 1.0f / sqrtf(ss * (1.f / DV_ML) + EPS);
        float o0[8], o1[8];
#pragma unroll
        for (int e = 0; e < 8; ++e) { o0[e] = a0[e] * rs * gain[e] * sigmoidf_(g0[e]); o1[e] = a1[e] * rs * gain[8 + e] * sigmoidf_(g1[e]); }
        *(u32x4*)(ao + off) = pack8(o0); *(u32x4*)(ao + off + 8) = pack8(o1);
    }
}

constexpr int RT_LD = 1032;
constexpr int RT_HI = 0, RT_LO = NE * RT_LD * 2, RT_LG = 2 * NE * RT_LD * 2;
__device__ __forceinline__ int rows_per_block(int first_row, int G) { return (ROWS - first_row + G - 1) / G; }
constexpr int NCB = 32;
__device__ __forceinline__ bool ctx_split(int first_row, int G) { return first_row == 0 && G > 2 * NCB; }
__device__ __forceinline__ void block_rows(int first_row, int vcu, int G, int& rbeg, int& rend) {
    if (ctx_split(first_row, G)) {
        if (vcu < NCB) { const int per = ROWS_CTX / NCB; rbeg = vcu * per; rend = rbeg + per; }
        else { const int per = (ROWS - ROWS_CTX + (G - NCB) - 1) / (G - NCB); rbeg = min(ROWS_CTX + (vcu - NCB) * per, ROWS); rend = min(rbeg + per, ROWS); }
    } else { const int RPB = rows_per_block(first_row, G); rbeg = min(first_row + vcu * RPB, ROWS); rend = min(rbeg + RPB, ROWS); }
}
__device__ __forceinline__ void phase_norm2_router(Frame& F, int l, int first_row) {
    const int tid = F.tid, lane = F.lane, wave = F.wave, l15 = lane & 15, g = lane >> 4;
    LAS bf16_t* whi = (LAS bf16_t*)(F.lds + RT_HI); LAS bf16_t* wlo = (LAS bf16_t*)(F.lds + RT_LO);
    LAS float* lgs = (LAS float*)(F.lds + RT_LG) + wave * (16 * 33);
    volatile LAS int* cntL = F.LCTL + 64;
    {
        const bf16_t* rt = (const bf16_t*)(wsp(F) + WS_RT) + (size_t)l * 2 * NE * D;
#pragma unroll 4
        for (int c = tid; c < 2 * NE * 128; c += NTHREADS) { const int tbl = c >> 12, e = (c >> 7) & 31, kc = c & 127;
            *(LAS u32x4*)((tbl ? wlo : whi) + e * RT_LD + kc * 8) = *(const u32x4*)(rt + ((size_t)tbl * NE + e) * D + kc * 8); }
    }
    if (tid < NE) cntL[tid] = 0;
    const bf16_t* xs = (const bf16_t*)(wsp(F) + WS_XS); bf16_t* hb = (bf16_t*)(wsp(F) + WS_HB);
    int* tope = (int*)(wsp(F) + WS_TOPE); float* topw = (float*)(wsp(F) + WS_TOPW);
    const f32x4* gm = (const f32x4*)(inp(F, I_GFFN) + l * D) + lane;
    int rbeg, rend; block_rows(first_row, F.vcu, F.G, rbeg, rend);
    for (int row = rbeg + wave; row < rend; row += NWAVES) {
        const int mb = row_mb(row);
        const u32x2* xr = (const u32x2*)(xs + (size_t)row * D) + lane;
        f32x4 v[4]; float ss = 0.f;
#pragma unroll
        for (int j = 0; j < 4; ++j) { v[j] = bf4_to_f32(xr[64 * j]); ss += (v[j][0] * v[j][0] + v[j][1] * v[j][1]) + (v[j][2] * v[j][2] + v[j][3] * v[j][3]); }
        const float rs = 1.0f / sqrtf(wave_sum(ss) * (1.f / D) + EPS);
        const f32x4* sh = (const f32x4*)modp(F, l, mb, 3) + lane; const f32x4* sc = (const f32x4*)modp(F, l, mb, 4) + lane;
        u32x2* o8 = (u32x2*)(hb + (size_t)row * D) + lane;
        unsigned* o4 = (unsigned*)(wsp(F) + WS_HB8 + (size_t)row * D) + lane;
#pragma unroll
        for (int j = 0; j < 4; ++j) { const f32x4 h = (v[j] * rs) * gm[64 * j] * (sc[64 * j] + 1.0f) + sh[64 * j];
            u32x2 wv; wv.x = pk2(h[0], h[1]); wv.y = pk2(h[2], h[3]); o8[64 * j] = wv;
            const f32x4 hq = __builtin_elementwise_min(__builtin_elementwise_max(h * 16.0f, (f32x4){-448.f, -448.f, -448.f, -448.f}), (f32x4){448.f, 448.f, 448.f, 448.f});
            o4[64 * j] = pk4_fp8(hq[0], hq[1], hq[2], hq[3]); }
    }
    VM_WAIT();
    __syncthreads();
    const float br0 = inp(F, I_BR)[l * NE + l15], br1 = inp(F, I_BR)[l * NE + 16 + l15];
    for (int g0 = rbeg + 16 * wave; g0 < rend; g0 += 16 * NWAVES) {
        const int arow = min(g0 + l15, rend - 1);
        const bf16_t* ap = hb + (size_t)arow * D + 8 * g;
        f32x4 acc0 = (f32x4){0.f, 0.f, 0.f, 0.f}, acc1 = (f32x4){0.f, 0.f, 0.f, 0.f};
        bf16x8 afr[32];
#pragma unroll
        for (int ks = 0; ks < 32; ++ks) afr[ks] = *(const bf16x8*)(ap + 32 * ks);
#pragma unroll
        for (int ks = 0; ks < 32; ++ks) {
            const bf16x8 af = afr[ks];
            const bf16x8 h0 = *(const LAS bf16x8*)(whi + l15 * RT_LD + 32 * ks + 8 * g), h1 = *(const LAS bf16x8*)(whi + (16 + l15) * RT_LD + 32 * ks + 8 * g);
            const bf16x8 l0 = *(const LAS bf16x8*)(wlo + l15 * RT_LD + 32 * ks + 8 * g), l1 = *(const LAS bf16x8*)(wlo + (16 + l15) * RT_LD + 32 * ks + 8 * g);
            acc0 = __builtin_amdgcn_mfma_f32_16x16x32_bf16(af, h0, acc0, 0, 0, 0); acc1 = __builtin_amdgcn_mfma_f32_16x16x32_bf16(af, h1, acc1, 0, 0, 0);
            acc0 = __builtin_amdgcn_mfma_f32_16x16x32_bf16(af, l0, acc0, 0, 0, 0); acc1 = __builtin_amdgcn_mfma_f32_16x16x32_bf16(af, l1, acc1, 0, 0, 0);
        }
#pragma unroll
        for (int rg = 0; rg < 4; ++rg) { lgs[(4 * g + rg) * 33 + l15] = acc0[rg] + br0; lgs[(4 * g + rg) * 33 + 16 + l15] = acc1[rg] + br1; }
        LDS_WAIT(); asm volatile("" ::: "memory");
        const int row = g0 + lane;
        if (lane < 16 && row < rend) {
            float lg[32];
#pragma unroll
            for (int e = 0; e < 32; ++e) lg[e] = lgs[lane * 33 + e];
            int sel[4]; float sv[4]; unsigned used = 0u;
#pragma unroll
            for (int k = 0; k < 4; ++k) { float best = -3.0e38f; int bi = 0;
#pragma unroll
                for (int e = 0; e < 32; ++e) { const bool take = !((used >> e) & 1u) && (lg[e] > best); best = take ? lg[e] : best; bi = take ? e : bi; }
                used |= 1u << bi; sel[k] = bi; sv[k] = best; }
            const float e1 = __expf(sv[1] - sv[0]), e2 = __expf(sv[2] - sv[0]), e3 = __expf(sv[3] - sv[0]);
            const float inv = 1.0f / (1.0f + e1 + e2 + e3);
            *(int4*)(tope + (size_t)row * 4) = make_int4(sel[0], sel[1], sel[2], sel[3]);
            *(float4*)(topw + (size_t)row * 4) = make_float4(inv, e1 * inv, e2 * inv, e3 * inv);
#pragma unroll
            for (int k = 0; k < 4; ++k) __hip_atomic_fetch_add((LAS int*)&cntL[sel[k]], 1, __ATOMIC_RELAXED, __HIP_MEMORY_SCOPE_WORKGROUP);
        }
        LDS_WAIT(); asm volatile("" ::: "memory");
    }
    __syncthreads();
    if (tid < NE) ((int*)(wsp(F) + WS_CNT))[F.vcu * NE + tid] = cntL[tid];
}

__device__ __forceinline__ void phase_positions(Frame& F, int first_row) {
    const int tid = F.tid, lane = F.lane;
    LAS int* tot = (LAS int*)F.lds;
    LAS int* bef = tot + 512;
    LAS int* baseL = bef + 512;
    LAS int* totL = baseL + 32;
    const int* cnt = (const int*)(wsp(F) + WS_CNT);
    {
        const int e = tid & 31, part = tid >> 5;
        int s = 0, sb = 0;
        for (int j = part; j < F.G; j += 16) { const int cv = cnt[j * NE + e]; s += cv; sb += (j < F.vcu) ? cv : 0; }
        tot[part * 32 + e] = s; bef[part * 32 + e] = sb;
    }
    __syncthreads();
    if (tid < NE) { int s = 0, sb = 0;
        for (int p = 0; p < 16; ++p) { s += tot[p * 32 + tid]; sb += bef[p * 32 + tid]; }
        totL[tid] = s; baseL[tid] = sb; }
    __syncthreads();
    if (F.wave == 0) {
        const int mine = (lane < NE) ? ((totL[lane & 31] + 255) >> 8) : 0;
        int inc = mine;
#pragma unroll
        for (int d = 1; d < 32; d <<= 1) { const int o = shfl_(inc, lane - d); inc += (lane >= d) ? o : 0; }
        if (lane < NE) F.LCTL[8 + lane] = inc - mine;
        if (lane == NE - 1) { F.LCTL[8 + NE] = inc; F.LCTL[48] = inc; }
    }
    __syncthreads();
    int* tokmap = (int*)(wsp(F) + WS_TOKMAP);
    if (F.vcu == 0) {
        int* meta = (int*)(wsp(F) + WS_META);
        if (tid <= NE) meta[tid] = F.LCTL[8 + tid];
        if (tid == 0) meta[33] = F.LCTL[48];
        { const int e = tid >> 4, rb = 256 * F.LCTL[8 + e], n = totL[e], cap = 256 * (F.LCTL[8 + e + 1] - F.LCTL[8 + e]);
            for (int rr = n + (tid & 15); rr < cap; rr += 16) tokmap[rb + rr] = first_row; }
    }
    {
        const int* tope = (const int*)(wsp(F) + WS_TOPE); int* pos = (int*)(wsp(F) + WS_POS);
        const int e0 = 4 * F.wave;
        int basereg = (lane < 4) ? 256 * F.LCTL[8 + e0 + lane] + baseL[e0 + lane] : 0;
        int rbeg, rend; block_rows(first_row, F.vcu, F.G, rbeg, rend);
        for (int r0 = rbeg; r0 < rend; r0 += 16) {
            const int row = r0 + (lane >> 2), k = lane & 3;
            const bool valid = row < rend;
            const int e = valid ? tope[(size_t)row * 4 + k] : -1;
            int p = -1;
#pragma unroll
            for (int j = 0; j < 4; ++j) {
                const unsigned long long mask = __ballot(e == e0 + j);
                const int b0 = shfl_(basereg, j);
                if (e == e0 + j) p = b0 + __popcll(mask & ((1ull << lane) - 1ull));
                if (lane == j) basereg += __popcll(mask);
            }
            if (p >= 0) { pos[(size_t)row * 4 + k] = p; tokmap[p] = row; }
        }
    }
}

#ifndef PMASK
#define PMASK 0xFFFF
#endif
#define PE(k) (((PMASK) >> (k)) & 1)
#ifndef RMASK
#define RMASK 0
#endif
#define RP(k) for (int rep_ = 0; rep_ < ((((RMASK) >> (k)) & 1) ? 2 : 1); ++rep_, __syncthreads())
#ifdef NOEPI
#define SKIPE(k) ((((RMASK) >> (k)) & 1) && rep_ == 0)
#else
#define SKIPE(k) false
#endif
#ifndef P0PROBE
#define P0PROBE 0
#endif
#ifndef MOE_ALIGN
#define MOE_ALIGN true
#endif
constexpr int LDS_TILE_E = pg8::STAGE_BYTES;
constexpr int LDS_TOKL = LDS_TILE_E + MAXTILES * 4;
static_assert(LDS_TOKL + 28 * 1024 <= LDS_CTL_OFF, "LDS map");
__device__ __forceinline__ void moe_tile_table(const Frame& P, const int ntiles) {
    volatile LAS int* te = (volatile LAS int*)(P.lds + LDS_TILE_E);
    for (int t = P.tid; t < ntiles; t += NTHREADS) { int e = 0;
#pragma unroll
        for (int j = 1; j < NE; ++j) e += (P.LCTL[8 + j] <= t) ? 1 : 0;
        te[t] = e; }
    __syncthreads();
}
constexpr int NPH_LAYER = 10, GP_FINAL = 1 + DEPTH * NPH_LAYER, NPHASES = GP_FINAL + 1;
__global__ void __launch_bounds__(NTHREADS, 2) mega_fwd(Args args) {
    extern __shared__ __attribute__((aligned(16))) unsigned char lds_raw[];
    Frame F0;
    Frame& F = F0;
    F.lds = (LAS unsigned char*)lds_raw;
    F.LCTL = (volatile LAS int*)(F.lds + LDS_CTL_OFF);
    F.tid = threadIdx.x; F.lane = F.tid & 63; F.wave = __builtin_amdgcn_readfirstlane(F.tid >> 6);
    F.G = gridDim.x; { const int bx = blockIdx.x; F.vcu = (F.G % 8 == 0) ? (bx % 8) * (F.G / 8) + bx / 8 : bx; }
    if (F.tid < 128) F.LCTL[F.tid] = 0;
    if (F.tid == 0) {
#pragma unroll
        for (int i = 0; i < 23; ++i) { const unsigned long long p = (unsigned long long)args.in[i]; F.LCTL[128 + 2 * i] = (int)(unsigned)p; F.LCTL[129 + 2 * i] = (int)(unsigned)(p >> 32); }
        { const unsigned long long p = (unsigned long long)args.ws; F.LCTL[128 + 46] = (int)(unsigned)p; F.LCTL[129 + 46] = (int)(unsigned)(p >> 32); }
        { const unsigned long long p = (unsigned long long)args.out; F.LCTL[128 + 48] = (int)(unsigned)p; F.LCTL[129 + 48] = (int)(unsigned)(p >> 32); }
    }
    __syncthreads();
    const int lo = args.ph_lo, hi = args.ph_hi;
    XcdBarrier bar; bar.bar = (unsigned*)(wsp(F) + WS_CTL) + CW_BAR; bar.x = 0; bar.st = nullptr; bar.w0 = 0;
    if (hi - lo > 1) bar = xcd_barrier_post((unsigned*)(wsp(F) + WS_CTL) + CW_BAR, (volatile LAS unsigned*)F.LCTL);
#define IN(k) (lo <= (k) && (k) < hi)
#define FRESH(FN) Frame FN = F0; { int tz_ = F0.wave * 64 + lane_id_here(), vc_ = F0.vcu, g_ = F0.G;     asm volatile("" : "+v"(tz_)); asm volatile("" : "+s"(vc_), "+s"(g_)); FN.tid = tz_; FN.lane = tz_ & 63; FN.wave = __builtin_amdgcn_readfirstlane(tz_ >> 6); FN.vcu = vc_; FN.G = g_; }
#ifdef DBLBAR
#define SEAM(k) do { if (IN(k) && IN((k) + 1)) { xcd_barrier(bar); xcd_barrier(bar); } } while (0)
#else
#define SEAM(k) do { if (IN(k) && IN((k) + 1)) xcd_barrier(bar); } while (0)
#endif

    if (PE(0) && IN(0)) RP(0) { FRESH(P); phase0(P, ((((RMASK) >> 0) & 1) && rep_ == 0) ? P0PROBE : 0); }
    SEAM(0);
    for (int l = 0; l < DEPTH; ++l) {
        const int base = 1 + l * NPH_LAYER; const bool na = (l & 1) == 0, last = (l == DEPTH - 1); const int jj = l >> 1;
        if (PE(1) && IN(base + 0)) RP(1) { FRESH(P); phase_norm1(P, l, (((RMASK) >> 1) & 1) && rep_ == 0); }
        SEAM(base + 0);
        if (PE(2) && IN(base + 1)) RP(2) {
            FRESH(P);
            if (na) {
                const bf16_t* Bt = (const bf16_t*)(wsp(P) + WS_WQKV) + (size_t)jj * 3072 * D;
                const bool img_only = proj_split(P.G);
                DenseOrder S; S.init(img_only ? ROWS_CTX / 256 : 0, img_only ? (ROWS - ROWS_CTX) / 256 : ROWS / 256, 3072 / 256, P.G, (int)blockIdx.x, wsp(P) + WS_HB, Bt, D);
                EpiStoreBf16 E{(bf16_t*)(wsp(P) + WS_PROJ), 3072};
                pg8::gemm_phase<EpiStoreBf16, DenseOrder, false>(P.lds, P.tid, D, S, E, SKIPE(2));
            } else {
                const bf16_t* Bt = (const bf16_t*)(wsp(P) + WS_WIN) + (size_t)jj * ML_INP * D;
                DenseOrder S; S.init(0, ROWS / 256, ML_INP / 256, P.G, (int)blockIdx.x, wsp(P) + WS_HB, Bt, D);
                EpiProjML E{(bf16_t*)(wsp(P) + WS_PROJ), (const float*)(wsp(P) + WS_ROPE)};
                pg8::gemm_phase<EpiProjML, DenseOrder, false>(P.lds, P.tid, D, S, E, SKIPE(2));
            }
        }
        SEAM(base + 1);
        if (IN(base + 2) && na && PE(3)) {
            FRESH(P);
            if (proj_split(P.G) && P.vcu < NCBP) {
                const bf16_t* Bt = (const bf16_t*)(wsp(P) + WS_WQKV) + (size_t)jj * 3072 * D;
                DenseOrder S; S.init(0, ROWS_CTX / 256, 3072 / 256, NCBP, P.vcu, wsp(P) + WS_HB, Bt, D);
                EpiStoreBf16 E{(bf16_t*)(wsp(P) + WS_PROJ), 3072};
                pg8::gemm_phase<EpiStoreBf16, DenseOrder, false>(P.lds, P.tid, D, S, E);
                group_sync((unsigned*)(wsp(P) + WS_CTL) + CW_GSYNC + 64 * (DEPTH + l), NCBP, (unsigned*)(wsp(P) + WS_CTL) + CW_BAR, P.wave == 0);
            }
        }
        if (IN(base + 2)) { if (na) {   } else {   } }
        if (IN(base + 3)) { if (na) { if (PE(5)) RP(5) { FRESH(P); phase_na_attn(P, jj); } } else { if (PE(6)) RP(6) { FRESH(P); phase_ml_scan(P, jj); } } }
        SEAM(base + 3);
        if (PE(7) && IN(base + 4)) { if (!na) RP(7) { FRESH(P); phase_ml_final(P, jj); } }
        if (!na) SEAM(base + 4);
        if (PE(8) && IN(base + 5)) RP(8) {
            FRESH(P);
            const bf16_t* Bt = na ? (const bf16_t*)(wsp(P) + WS_WONA) + (size_t)jj * D * D : (const bf16_t*)(wsp(P) + WS_WOML) + (size_t)jj * D * D;
            const bool img_only = last || ctx_split(0, P.G);
            DenseOrder S; S.init(img_only ? ROWS_CTX / 256 : 0, img_only ? (ROWS - ROWS_CTX) / 256 : ROWS / 256, D / 256, P.G, (int)blockIdx.x, wsp(P) + WS_AO, Bt, D);
            EpiResid E{((((RMASK) >> 8) & 1) && rep_ == 0) ? (bf16_t*)(wsp(P) + WS_Y) : (bf16_t*)(wsp(P) + WS_XS), (const float*)(wsp(P) + WS_MOD) + (size_t)l * 9 * 6144 + 2 * D};
            pg8::gemm_phase<EpiResid, DenseOrder, false>(P.lds, P.tid, D, S, E, SKIPE(8));
        }
        SEAM(base + 5);
        if (PE(9) && IN(base + 6) && !last) {
            FRESH(P);
            if (ctx_split(0, P.G) && P.vcu < NCB) {
                const bf16_t* Bt = na ? (const bf16_t*)(wsp(P) + WS_WONA) + (size_t)jj * D * D : (const bf16_t*)(wsp(P) + WS_WOML) + (size_t)jj * D * D;
                DenseOrder S; S.init(0, ROWS_CTX / 256, D / 256, NCB, P.vcu, wsp(P) + WS_AO, Bt, D);
                EpiResid E{(bf16_t*)(wsp(P) + WS_XS), (const float*)(wsp(P) + WS_MOD) + (size_t)l * 9 * 6144 + 2 * D};
                pg8::gemm_phase<EpiResid, DenseOrder, false>(P.lds, P.tid, D, S, E);
                group_sync((unsigned*)(wsp(P) + WS_CTL) + CW_GSYNC + 64 * l, NCB, (unsigned*)(wsp(P) + WS_CTL) + CW_BAR, P.wave == 0);
            }
        }
        if (PE(9) && IN(base + 6)) RP(9) { FRESH(P); phase_norm2_router(P, l, last ? ROWS_CTX : 0); }
        SEAM(base + 6);
        if (PE(10) && IN(base + 7)) RP(10) { FRESH(P); phase_positions(P, last ? ROWS_CTX : 0); }
        SEAM(base + 7);
        if (PE(11) && IN(base + 8)) RP(11) {
            FRESH(P);
            if (P.tid < 34) P.LCTL[8 + P.tid] = ((const int*)(wsp(P) + WS_META))[P.tid];
            __syncthreads();
            const int ntiles = P.LCTL[8 + NE];
            moe_tile_table(P, ntiles);
            MoeOrder S; S.NT = 8; S.nunits = ntiles * 8; S.G = P.G; S.c = (int)blockIdx.x; S.K = D / 2; S.A = (const char*)(wsp(P) + WS_HB8);
            S.W = (const char*)(wsp(P) + WS_W1T) + (size_t)l * NE * 2048 * D; S.estride = (size_t)2048 * D; S.tokmap = (const int*)(wsp(P) + WS_TOKMAP); S.prefix = P.LCTL + 8; S.tile_e = (volatile LAS int*)(P.lds + LDS_TILE_E); S.tokl = (volatile LAS int*)(P.lds + LDS_TOKL); S.gather = true;
            { const int half = P.wave >> 2, r = P.tid & 255;
              for (int i = half; i < 28; i += 2) { pg8::Unit u; if (!S.next(i, u)) break; S.tokl[i * 256 + r] = S.tokmap[u.pm * 256 + r]; }
              __syncthreads(); }
            EpiSwiglu E{(unsigned char*)(wsp(P) + WS_ACT), inp(P, I_B1) + (size_t)l * NE * 2048};
#ifdef KPROBE
            if (SKIPE(11)) pg8::gemm_phase<EpiSwiglu, MoeOrder, true, true, MOE_ALIGN, KPROBE>(P.lds, P.tid, D / 2, S, E, true); else
#endif
            pg8::gemm_phase<EpiSwiglu, MoeOrder, true, true, MOE_ALIGN>(P.lds, P.tid, D / 2, S, E, SKIPE(11));
        }
        SEAM(base + 8);
        if (PE(12) && IN(base + 9)) RP(12) {
            FRESH(P);
            if (P.tid < 34) P.LCTL[8 + P.tid] = ((const int*)(wsp(P) + WS_META))[P.tid];
            __syncthreads();
            const int ntiles = P.LCTL[8 + NE];
            moe_tile_table(P, ntiles);
            MoeOrder S; S.NT = 4; S.nunits = ntiles * 4; S.G = P.G; S.c = (int)blockIdx.x; S.K = D / 2; S.A = (const char*)(wsp(P) + WS_ACT);
            S.W = (const char*)(wsp(P) + WS_W2T) + (size_t)l * NE * D * D; S.estride = (size_t)D * D; S.tokmap = (const int*)(wsp(P) + WS_TOKMAP); S.prefix = P.LCTL + 8; S.tile_e = (volatile LAS int*)(P.lds + LDS_TILE_E); S.tokl = (volatile LAS int*)(P.lds + LDS_TOKL); S.gather = false;
            EpiY E{(bf16_t*)(wsp(P) + WS_Y), inp(P, I_B2) + (size_t)l * NE * D};
            pg8::gemm_phase<EpiY, MoeOrder, true, true, MOE_ALIGN>(P.lds, P.tid, D / 2, S, E, SKIPE(12));
        }
        SEAM(base + 9);
    }
    if (PE(13) && IN(GP_FINAL)) RP(13) { FRESH(P); phase_final(P); }
#undef IN
#undef SEAM
}

extern "C" void kernel_launch(void* const* d_in, const int* in_sizes, int n_in, void* d_out, int out_size, void* d_ws, size_t ws_size, hipStream_t stream) {
    static int grid = 0;
    if (grid == 0) {
        if (n_in != 23 || ws_size < WS_END) { fprintf(stderr, "kernel_launch: expected 23 inputs and >= %zu bytes of workspace (got %d, %zu)\n", (size_t)WS_END, n_in, ws_size); grid = -1; return; }
        int dev = 0, cus = 0, per_cu = 0;
        if (hipGetDevice(&dev) != hipSuccess || hipDeviceGetAttribute(&cus, hipDeviceAttributeMultiprocessorCount, dev) != hipSuccess) { grid = -1; return; }
        if (hipFuncSetAttribute((const void*)mega_fwd, hipFuncAttributeMaxDynamicSharedMemorySize, LDS_BYTES) != hipSuccess) { fprintf(stderr, "kernel_launch: hipFuncSetAttribute failed\n"); grid = -1; return; }
        if (hipOccupancyMaxActiveBlocksPerMultiprocessor(&per_cu, (const void*)mega_fwd, NTHREADS, LDS_BYTES) != hipSuccess || per_cu < 1)
            fprintf(stderr, "kernel_launch: occupancy query reports %d workgroups per CU\n", per_cu);
        (void)hipGetLastError();
        grid = cus;
        if (grid > 1024) grid = 1024;
    }
    if (grid < 0) return;
    (void)hipMemsetAsync((char*)d_ws + WS_CTL, 0, CTL_BYTES, stream);
    Args a{};
    for (int i = 0; i < 23; ++i) a.in[i] = (const float*)d_in[i];
    a.out = (float*)d_out; a.ws = (unsigned char*)d_ws;
#if MK_ONE_LAUNCH
    a.ph_lo = 0; a.ph_hi = NPHASES;
    hipLaunchKernelGGL(mega_fwd, dim3(grid), dim3(NTHREADS), LDS_BYTES, stream, a);
#else
    for (int gp = 0; gp < NPHASES; ++gp) {
        if (gp >= 1 && gp < GP_FINAL) { const int l = (gp - 1) / NPH_LAYER, p = (gp - 1) % NPH_LAYER; if (p == 4 && (l & 1) == 0) continue; }
        a.ph_lo = gp; a.ph_hi = gp + 1;
        hipLaunchKernelGGL(mega_fwd, dim3(grid), dim3(NTHREADS), LDS_BYTES, stream, a);
    }
#endif
    const hipError_t le = hipPeekAtLastError();
    if (le != hipSuccess) fprintf(stderr, "kernel_launch: launch failed: %s\n", hipGetErrorName(le));
}
```

```cpp
#include <hip/hip_runtime.h>
#include <cstdio>
#include <cstdint>

#ifndef MK_ONE_LAUNCH
#define MK_ONE_LAUNCH 1
#endif

#define LAS __attribute__((address_space(3)))
#define GAS __attribute__((address_space(1)))
typedef unsigned short bf16_t;
typedef short bf16x8 __attribute__((ext_vector_type(8)));
typedef short bf16x4 __attribute__((ext_vector_type(4)));
typedef float f32x4 __attribute__((ext_vector_type(4)));
typedef float f32x2 __attribute__((ext_vector_type(2)));
typedef unsigned u32x4 __attribute__((ext_vector_type(4)));
typedef unsigned u32x2 __attribute__((ext_vector_type(2)));

constexpr int D = 1024, NB = 8, SEQ = 4096, NCTX = 256, TT = NCTX + SEQ  , DEPTH = 4;
constexpr int ROWS_CTX = NB * NCTX  , ROWS = ROWS_CTX + NB * SEQ  ;
constexpr int NH_NA = 16, DH_NA = 64;
constexpr int NH_ML = 8, DV_ML = 128, DK_ML = 64, ML_IN = 3104, ML_INP = 3328;
constexpr int NE = 32, TOPK = 4, DFF = 1024;
constexpr int MAXTILES = (ROWS * TOPK) / 256 + NE  , MAXROWS = MAXTILES * 256;
constexpr float EPS = 1e-6f;
constexpr int NWAVES = 8, NTHREADS = 512;

constexpr size_t MiB = 1u << 20;
constexpr size_t al256(size_t x) { return (x + 255) & ~(size_t)255; }
constexpr size_t WS_CTL = 0, CTL_BYTES = 1 * MiB;
constexpr size_t WS_MOD = WS_CTL + CTL_BYTES;
constexpr size_t WS_ROPE = WS_MOD + al256((size_t)DEPTH * 9 * 6 * D * 4);
constexpr size_t WS_WQKV = WS_ROPE + al256(64 * 16 * 2 * 4);
constexpr size_t WS_WONA = WS_WQKV + (size_t)2 * 3072 * D * 2;
constexpr size_t WS_WIN = WS_WONA + (size_t)2 * D * D * 2;
constexpr size_t WS_WOML = WS_WIN + (size_t)2 * ML_INP * D * 2;
constexpr size_t WS_W1T = WS_WOML + (size_t)2 * D * D * 2;
constexpr size_t WS_W2T = WS_W1T + (size_t)DEPTH * NE * 2048 * D * 2;
constexpr size_t WS_XS = WS_W2T + (size_t)DEPTH * NE * D * D * 2;
constexpr size_t WS_HB = WS_XS + (size_t)ROWS * D * 4;
constexpr size_t WS_PROJ = WS_HB + (size_t)ROWS * D * 2;
constexpr size_t WS_QN = WS_PROJ + (size_t)ROWS * ML_INP * 2;
constexpr size_t WS_KN = WS_QN + (size_t)ROWS * D * 2;
constexpr size_t WS_VT = WS_KN + (size_t)ROWS * D * 2;
constexpr size_t WS_AO = WS_VT + (size_t)ROWS * D * 2;
constexpr size_t WS_HDIR = WS_QN;
constexpr size_t WS_GATES = WS_AO + (size_t)ROWS * D * 2;
constexpr size_t WS_TOPE = WS_GATES + al256((size_t)4 * NB * NH_ML * TT * 4);
constexpr size_t WS_TOPW = WS_TOPE + (size_t)ROWS * 4 * 4;
constexpr size_t WS_POS = WS_TOPW + (size_t)ROWS * 4 * 4;
constexpr size_t WS_TOKMAP = WS_POS + (size_t)ROWS * 4 * 4;
constexpr size_t WS_CNT = WS_TOKMAP + (size_t)MAXROWS * 4;
constexpr size_t WS_META = WS_CNT + (size_t)1024 * 32 * 4;
constexpr size_t WS_ACT = WS_META + 256;
constexpr size_t WS_Y = WS_ACT + (size_t)MAXROWS * D * 2;
constexpr size_t WS_HB8 = WS_Y + (size_t)MAXROWS * D * 2;
constexpr size_t WS_GS = WS_HB8 + (size_t)ROWS * D;
constexpr size_t WS_RT = WS_GS + (size_t)2 * NB * NH_ML * (TT / 64) * 5 * 64 * 4;
constexpr size_t WS_END = WS_RT + (size_t)DEPTH * 2 * NE * D * 2;
static_assert(WS_XS % 256 == 0 && WS_ACT % 256 == 0 && WS_TOPE % 256 == 0, "ws alignment");

constexpr int CW_BAR = 4096;
constexpr int CW_GSYNC = 8192;

constexpr int LDS_BYTES = 160 * 1024;
constexpr int LDS_CTL_OFF = LDS_BYTES - 1024;
constexpr int LDS_WORK = LDS_CTL_OFF;

__device__ __forceinline__ int lane_id_here() { int l; asm volatile("v_mbcnt_lo_u32_b32 %0, -1, 0\n\tv_mbcnt_hi_u32_b32 %0, -1, %0" : "=v"(l)); return l; }
#define LDS_WAIT() asm volatile("s_waitcnt lgkmcnt(0)" ::: "memory")
#define VM_WAIT() asm volatile("s_waitcnt vmcnt(0)" ::: "memory")
__device__ __forceinline__ unsigned f2bf(float f) { unsigned u = __builtin_bit_cast(unsigned, f); return (u + 0x7fffu + ((u >> 16) & 1u)) >> 16; }
__device__ __forceinline__ unsigned pk2(float lo, float hi) { unsigned r; asm volatile("v_cvt_pk_bf16_f32 %0, %1, %2" : "=v"(r) : "v"(lo), "v"(hi)); return r; }
__device__ __forceinline__ unsigned pk4_fp8(float a, float b, float c, float d) { int p = __builtin_amdgcn_cvt_pk_fp8_f32(a, b, 0, false); p = __builtin_amdgcn_cvt_pk_fp8_f32(c, d, p, true); return (unsigned)p; }
__device__ __forceinline__ float bf2f(unsigned short b) { return __builtin_bit_cast(float, ((unsigned)b) << 16); }
__device__ __forceinline__ float bflo(unsigned w) { return __builtin_bit_cast(float, w << 16); }
__device__ __forceinline__ float bfhi(unsigned w) { return __builtin_bit_cast(float, w & 0xffff0000u); }
template <int CTRL> __device__ __forceinline__ float dpp_f(float v) { return __builtin_bit_cast(float, __builtin_amdgcn_update_dpp(0, __builtin_bit_cast(int, v), CTRL, 0xF, 0xF, false)); }
__device__ __forceinline__ float sum8(float v) { v += dpp_f<0xB1>(v); v += dpp_f<0x4E>(v); v += dpp_f<0x141>(v); return v; }
__device__ __forceinline__ float max8(float v) { v = fmaxf(v, dpp_f<0xB1>(v)); v = fmaxf(v, dpp_f<0x4E>(v)); v = fmaxf(v, dpp_f<0x141>(v)); return v; }
__device__ __forceinline__ float rdl(float v, int l) { return __builtin_bit_cast(float, __builtin_amdgcn_readlane(__builtin_bit_cast(int, v), l)); }
__device__ __forceinline__ f32x4 bf4_to_f32(const u32x2 w) { return (f32x4){bflo(w.x), bfhi(w.x), bflo(w.y), bfhi(w.y)}; }
__device__ __forceinline__ float wave_sum(float v) {
    v = sum8(v); v += dpp_f<0x140>(v);
    return (rdl(v, 0) + rdl(v, 16)) + (rdl(v, 32) + rdl(v, 48));
}
__device__ __forceinline__ float wave_max(float v) {
    v = max8(v); v = fmaxf(v, dpp_f<0x140>(v));
    return fmaxf(fmaxf(rdl(v, 0), rdl(v, 16)), fmaxf(rdl(v, 32), rdl(v, 48)));
}
__device__ __forceinline__ int shfl_(int v, int src) { return __builtin_amdgcn_ds_bpermute(src << 2, v); }
__device__ __forceinline__ float shfl_(float v, int src) { return __builtin_bit_cast(float, __builtin_amdgcn_ds_bpermute(src << 2, __builtin_bit_cast(int, v))); }
__device__ __forceinline__ float sigmoidf_(float x) { return __builtin_amdgcn_rcpf(1.f + __builtin_amdgcn_exp2f(-1.44269504f * x)); }

namespace pg8 {
constexpr int BM = 256, BK = 64, HALF = 128, HTB = HALF * BK * 2  , STAGE_BYTES = 8 * HTB;
__host__ __device__ __forceinline__ int lds_byte(int r, int c) { const int st = (r >> 4) * 2 + (c >> 5), rr = r & 15, cc = c & 31, ob = rr * 64 + cc * 2; return st * 1024 + (ob ^ (((ob >> 9) & 1) << 5)); }
__host__ __device__ __forceinline__ void stage_rc(int b, int& R, int& C) { const int st = b / 1024, sb = b % 1024, swz = sb ^ (((sb >> 9) & 1) << 5); R = (st >> 1) * 16 + swz / 64; C = (st & 1) * 32 + (swz % 64) / 2; }
__host__ __device__ __forceinline__ int perm32(int rho) { const int n = rho >> 4, i = rho & 15; return 8 * (i >> 2) + 4 * n + (i & 3); }

struct Unit { int pm, pn, e, slot; };

typedef int v8i32 __attribute__((ext_vector_type(8)));
__device__ __forceinline__ v8i32 cat8(const bf16x8 a, const bf16x8 b) { union { bf16x8 h[2]; v8i32 v; } u; u.h[0] = a; u.h[1] = b; return u.v; }
__device__ __forceinline__ unsigned cvt_pk_bf16(float lo, float hi) { unsigned r; asm volatile("v_cvt_pk_bf16_f32 %0, %1, %2" : "=v"(r) : "v"(lo), "v"(hi)); return r; }

#ifndef PG8_ALIGN
#define PG8_ALIGN true
#endif
#ifndef FP8_PRIO
#define FP8_PRIO true
#endif
template <class Epi, class Sched, bool GATHER, bool FP8 = false, bool ALIGN_EPI = PG8_ALIGN, int KPROBE_ = 0>
__device__ __forceinline__ void gemm_phase(LAS unsigned char* lds, const int tid, const int K, const Sched& S, const Epi& E, const bool skip_epi = false) {
    const int wid = __builtin_amdgcn_readfirstlane(tid >> 6), lane = tid & 63, wr = wid >> 2, wc = wid & 3, fr = lane & 15, fq = lane >> 4;
    const int nt = K / BK;
    unsigned voffB[2], voffA[2][2];
#pragma unroll
    for (int i = 0; i < 2; ++i) { int R, C; stage_rc(tid * 16 + i * 8192, R, C); const int Rb = Epi::PERM ? ((R & ~31) + perm32(R & 31)) : R;
        voffB[i] = (unsigned)(Rb * K + C) * 2u; }
    const size_t kstep = (size_t)(BK * 2);
    const size_t hstep = (size_t)HALF * K * 2;
    const unsigned ldsw = (unsigned)wid * 1024u;
    const int aoff = lds_byte(wr * 64 + fr, fq * 8), boff = lds_byte(wc * 32 + fr, fq * 8);
#define PG8_SA(b, h) (((b) * 2 + (h)) * HTB)
#define PG8_SB(b, h) ((4 + (b) * 2 + (h)) * HTB)
#define PG8_STAGE(bufoff, gbase, voff) do { _Pragma("unroll") for (int _i = 0; _i < 2; ++_i) \
        __builtin_amdgcn_global_load_lds((const unsigned*)((const char*)(gbase) + (voff)[_i]), (LAS unsigned*)(lds + (bufoff) + ldsw + _i * 8192), 16, 0, 0); } while (0)
#define PG8_LDA(dst, b, h) do { if constexpr (KPROBE_ == 2) break; _Pragma("unroll") for (int m = 0; m < 4; ++m) _Pragma("unroll") for (int k = 0; k < 2; ++k) dst[m][k] = *(const LAS bf16x8*)(lds + PG8_SA(b, h) + aoff + m * 2048 + k * 1024); } while (0)
#define PG8_LDB(dst, b, h) do { if constexpr (KPROBE_ == 2) break; _Pragma("unroll") for (int n = 0; n < 2; ++n) _Pragma("unroll") for (int k = 0; k < 2; ++k) dst[n][k] = *(const LAS bf16x8*)(lds + PG8_SB(b, h) + boff + n * 2048 + k * 1024); } while (0)
#define PG8_MMA(ai, bj, At, Bt) do { if constexpr (!FP8 || FP8_PRIO) __builtin_amdgcn_s_setprio(1); else __builtin_amdgcn_s_setprio(0); _Pragma("unroll") for (int m = 0; m < 4; ++m) _Pragma("unroll") for (int n = 0; n < 2; ++n) { \
        if constexpr (KPROBE_ == 1) { asm volatile("" :: "v"(At[m][0]), "v"(At[m][1]), "v"(Bt[n][0]), "v"(Bt[n][1])); } else if constexpr (KPROBE_ == 2) { } else \
        if constexpr (FP8) { acc[ai][bj][m][n] = __builtin_amdgcn_mfma_scale_f32_16x16x128_f8f6f4(cat8(Bt[n][0], Bt[n][1]), cat8(At[m][0], At[m][1]), acc[ai][bj][m][n], 0, 0, 0, 0x7f7f7f7f, 0, 0x7f7f7f7f); } \
        else { _Pragma("unroll") for (int k = 0; k < 2; ++k) acc[ai][bj][m][n] = __builtin_amdgcn_mfma_f32_16x16x32_bf16(Bt[n][k], At[m][k], acc[ai][bj][m][n], 0, 0, 0); } } \
        __builtin_amdgcn_s_setprio(0); } while (0)
#define PG8_WAIT_V(n) asm volatile("s_waitcnt vmcnt(" #n ")" ::: "memory")
#define PG8_WAIT_VP do { if constexpr (Epi::PREFETCH) { if (pf) PG8_WAIT_V(10); else PG8_WAIT_V(8); } else PG8_WAIT_V(8); } while (0)
#define PG8_WAIT_L(n) asm volatile("s_waitcnt lgkmcnt(" #n ")" ::: "memory")
#define PG8_BAR __builtin_amdgcn_s_barrier()
#define PG8_SCHED __builtin_amdgcn_sched_barrier(0)
#define PG8_SETVOFF(u) do { _Pragma("unroll") for (int _i = 0; _i < 2; ++_i) { int RA_, CA_; stage_rc(tid * 16 + _i * 8192, RA_, CA_);     \
        _Pragma("unroll") for (int _h = 0; _h < 2; ++_h) { \
        if constexpr (GATHER) voffA[_h][_i] = ((unsigned)S.a_row(u, _h * HALF + RA_) * (unsigned)K + (unsigned)CA_) * 2u; \
        else voffA[_h][_i] = ((unsigned)(_h * HALF + RA_) * (unsigned)K + (unsigned)CA_) * 2u; } } } while (0)
    Unit cur, nxt; int ui = 0;
    if (!S.next(0, cur)) return;
    f32x4 acc[2][2][4][2];
#pragma unroll
    for (int a = 0; a < 2; ++a)
#pragma unroll
        for (int b = 0; b < 2; ++b)
#pragma unroll
            for (int m = 0; m < 4; ++m)
#pragma unroll
                for (int n = 0; n < 2; ++n) acc[a][b][m][n] = (f32x4){0.f, 0.f, 0.f, 0.f};
    bf16x8 At[4][2], B0[2][2], B1[2][2];
    const char* cA = S.a_base(cur); const char* cB = S.b_base(cur);
    PG8_SETVOFF(cur);
    PG8_STAGE(PG8_SB(0, 0), cB, voffB); PG8_STAGE(PG8_SB(0, 1), cB + hstep, voffB); PG8_STAGE(PG8_SA(0, 0), cA, voffA[0]); PG8_STAGE(PG8_SA(0, 1), cA, voffA[1]);
    if (wr == 1) PG8_BAR;
    PG8_WAIT_V(2); PG8_BAR;
    PG8_STAGE(PG8_SB(1, 0), cB + kstep, voffB); PG8_STAGE(PG8_SA(1, 0), cA + kstep, voffA[0]); PG8_STAGE(PG8_SB(1, 1), cB + hstep + kstep, voffB);
    PG8_WAIT_V(6); PG8_BAR;
    for (;;) {
        const bool has_next = S.next(ui + 1, nxt);
        const char* nA = has_next ? S.a_base(nxt) : cA; const char* nB = has_next ? S.b_base(nxt) : cB;
#pragma unroll 1
        for (int t = 0; t < nt; t += 2) {
            const bool last = (t == nt - 2);
            const char* a1 = cA + (size_t)(t + 1) * kstep;
            const char* a2 = last ? nA : cA + (size_t)(t + 2) * kstep; const char* b2 = last ? nB : cB + (size_t)(t + 2) * kstep;
            const char* a3 = a2 + kstep; const char* b3 = b2 + kstep;
            bool pf = false;
            if constexpr (Epi::PREFETCH) { pf = (t == ((nt / 2) & ~1)); if (pf) E.prefetch(cur, wid * 64 + lane_id_here(), lds); }
            PG8_LDB(B0, 0, 0); PG8_LDB(B1, 0, 1); PG8_SCHED; PG8_LDA(At, 0, 0); PG8_STAGE(PG8_SA(1, 1), a1, voffA[1]);
            if constexpr (GATHER) { if (last && has_next) PG8_SETVOFF(nxt); }
            PG8_WAIT_VP; PG8_WAIT_L(0); PG8_BAR; PG8_MMA(0, 0, At, B0); PG8_MMA(0, 1, At, B1); PG8_BAR; PG8_SCHED;
            PG8_LDA(At, 0, 1); PG8_STAGE(PG8_SB(0, 0), b2, voffB); PG8_STAGE(PG8_SB(0, 1), b2 + hstep, voffB); PG8_STAGE(PG8_SA(0, 0), a2, voffA[0]);
            PG8_WAIT_VP; PG8_WAIT_L(0); PG8_BAR; PG8_MMA(1, 0, At, B0); PG8_MMA(1, 1, At, B1); PG8_BAR; PG8_SCHED;
            PG8_LDB(B0, 1, 0); PG8_LDB(B1, 1, 1); PG8_SCHED; PG8_LDA(At, 1, 0); PG8_STAGE(PG8_SA(0, 1), a2, voffA[1]);
            PG8_WAIT_VP; PG8_WAIT_L(0); PG8_BAR; PG8_MMA(0, 0, At, B0); PG8_MMA(0, 1, At, B1); PG8_BAR; PG8_SCHED;
            PG8_LDA(At, 1, 1); PG8_STAGE(PG8_SB(1, 0), b3, voffB); PG8_STAGE(PG8_SB(1, 1), b3 + hstep, voffB); PG8_STAGE(PG8_SA(1, 0), a3, voffA[0]);
            PG8_WAIT_V(8); PG8_WAIT_L(0); PG8_BAR; PG8_MMA(1, 0, At, B0); PG8_MMA(1, 1, At, B1); PG8_BAR; PG8_SCHED;
        }
        if constexpr (ALIGN_EPI) { if (wr == 0) PG8_BAR; }
        if (!skip_epi) E(acc, cur, wr, wc, fr, fq);
        if (!has_next) break;
#pragma unroll
        for (int a = 0; a < 2; ++a)
#pragma unroll
            for (int b = 0; b < 2; ++b)
#pragma unroll
                for (int m = 0; m < 4; ++m)
#pragma unroll
                    for (int n = 0; n < 2; ++n) acc[a][b][m][n] = (f32x4){0.f, 0.f, 0.f, 0.f};
        cur = nxt; cA = nA; cB = nB; ++ui;
        if constexpr (ALIGN_EPI) { if (wr == 1) PG8_BAR; }
    }
    PG8_WAIT_V(0);
    if constexpr (!ALIGN_EPI) { if (wr == 0) PG8_BAR; }
    PG8_BAR;
#undef PG8_SA
#undef PG8_SB
#undef PG8_STAGE
#undef PG8_LDA
#undef PG8_LDB
#undef PG8_MMA
#undef PG8_WAIT_V
#undef PG8_WAIT_VP
#undef PG8_WAIT_L
#undef PG8_BAR
#undef PG8_SCHED
#undef PG8_SETVOFF
}
}

#define XB_TMO      128
#define XB_XCNT(j)  (256  + 64 * (j))
#define XB_XSUB(j)  (1280 + 64 * (j))
#define XB_XGEN(j)  (2304 + 64 * (j))
#define XB_TOP      3328
#define XB_TOPGEN   3392
#define XCD_BAR_WORDS 3456
#define XB_SPIN_CAP (1u << 18)

__device__ __forceinline__ unsigned xb_ld(unsigned* p)              { return __hip_atomic_load(p, __ATOMIC_RELAXED, __HIP_MEMORY_SCOPE_AGENT); }
__device__ __forceinline__ unsigned xb_add(unsigned* p, unsigned v) { return __hip_atomic_fetch_add(p, v, __ATOMIC_RELAXED, __HIP_MEMORY_SCOPE_AGENT); }
__device__ __forceinline__ unsigned xb_xcc_id() { return (unsigned)__builtin_amdgcn_s_getreg((3 << 11) | 20) & 0xFu; }
#define XB_SPIN(cond, bar) do { unsigned _sp = 0; while (cond) { __builtin_amdgcn_s_sleep(1); \
    if ((++_sp & 255u) == 0u) { if (xb_ld(&(bar)[XB_TMO])) break; if (_sp > XB_SPIN_CAP) { atomicAdd(&(bar)[XB_TMO], 1u); break; } } } } while (0)

struct XcdBarrier {
    unsigned* bar; unsigned x;
    unsigned w0;
    volatile LAS unsigned* st;
};

__device__ __forceinline__ XcdBarrier xcd_barrier_post(unsigned* bar, volatile LAS unsigned* st) {
    XcdBarrier b; b.bar = bar; b.x = xb_xcc_id(); b.st = st; b.w0 = ((unsigned)__builtin_amdgcn_readfirstlane((int)threadIdx.x) < 64u) ? 1u : 0u;
    if (threadIdx.x == 0) (void)xb_add(&bar[XB_XCNT(b.x)], 1u);
    return b;
}
__device__ __forceinline__ void xcd_barrier_complete(unsigned* bar, unsigned x, unsigned& nloc, unsigned& nx) {
    const unsigned G = gridDim.x * gridDim.y * gridDim.z;
    unsigned sum, cnt, mine, sp = 0u;
    for (;;) {
        sum = 0u; cnt = 0u; mine = 0u;
#pragma unroll
        for (unsigned j = 0; j < 16; ++j) { const unsigned c = xb_ld(&bar[XB_XCNT(j)]); sum += c; cnt += (c > 0u) ? 1u : 0u; mine = (j == x) ? c : mine; }
        if (sum == G) break;
        __builtin_amdgcn_s_sleep(1);
        if ((++sp & 255u) == 0u) { if (xb_ld(&bar[XB_TMO])) break; if (sp > XB_SPIN_CAP) { atomicAdd(&bar[XB_TMO], 1u); break; } }
    }
    nloc = mine > 0u ? mine : 1u; nx = cnt > 0u ? cnt : 1u;
}

__device__ __forceinline__ void xcd_barrier(const XcdBarrier& b) {
    asm volatile("s_waitcnt vmcnt(0)" ::: "memory");
    __syncthreads();
    if (b.w0 && lane_id_here() == 0) {
        unsigned* bar = b.bar;
        __builtin_amdgcn_s_waitcnt(0);
        unsigned nloc = b.st[0], nx = b.st[1];
        if (nloc == 0u) { xcd_barrier_complete(bar, b.x, nloc, nx); b.st[0] = nloc; b.st[1] = nx; }
        const unsigned old = xb_add(&bar[XB_XSUB(b.x)], 1u);
        const unsigned gen = old / nloc;
        if (old + 1u == (gen + 1u) * nloc) {
            __builtin_amdgcn_fence(__ATOMIC_RELEASE, "agent");
            asm volatile("s_waitcnt vmcnt(0)" ::: "memory");
            const unsigned og = xb_add(&bar[XB_TOP], 1u);
            const unsigned tg = og / nx;
            if (og + 1u == (tg + 1u) * nx) xb_add(&bar[XB_TOPGEN], 1u);
            else XB_SPIN(xb_ld(&bar[XB_TOPGEN]) == tg, bar);
            __builtin_amdgcn_fence(__ATOMIC_ACQUIRE, "agent");
            xb_add(&bar[XB_XGEN(b.x)], 1u);
            asm volatile("s_waitcnt vmcnt(0)" ::: "memory");
        } else {
            XB_SPIN(xb_ld(&bar[XB_XGEN(b.x)]) == gen, bar);
            __builtin_amdgcn_fence(__ATOMIC_ACQUIRE, "agent");
            asm volatile("s_waitcnt vmcnt(0)" ::: "memory");
        }
    }
    __syncthreads();
}

__device__ __forceinline__ void group_sync(unsigned* word, unsigned n, unsigned* bar, bool w0) {
    asm volatile("s_waitcnt vmcnt(0)" ::: "memory");
    __syncthreads();
    if (w0 && lane_id_here() == 0) {
        __builtin_amdgcn_s_waitcnt(0);
        __builtin_amdgcn_fence(__ATOMIC_RELEASE, "agent");
        asm volatile("s_waitcnt vmcnt(0)" ::: "memory");
        (void)xb_add(word, 1u);
        XB_SPIN(xb_ld(word) < n, bar);
        __builtin_amdgcn_fence(__ATOMIC_ACQUIRE, "agent");
        asm volatile("s_waitcnt vmcnt(0)" ::: "memory");
    }
    __syncthreads();
}

struct Args { const float* in[23]; float* out; unsigned char* ws; int ph_lo, ph_hi; };
struct Frame {
    LAS unsigned char* lds;
    volatile LAS int* LCTL;
    int tid, lane, wave, vcu, G;
};
__device__ __forceinline__ unsigned long long ptr_get(const Frame& F, int i) {
    const unsigned lo = (unsigned)F.LCTL[128 + 2 * i], hi = (unsigned)F.LCTL[129 + 2 * i];
    return ((unsigned long long)(unsigned)__builtin_amdgcn_readfirstlane((int)hi) << 32) | (unsigned long long)(unsigned)__builtin_amdgcn_readfirstlane((int)lo);
}
__device__ __forceinline__ const float* inp(const Frame& F, int i) { return (const float*)(GAS const float*)ptr_get(F, i); }
__device__ __forceinline__ unsigned char* wsp(const Frame& F) { return (unsigned char*)(GAS unsigned char*)ptr_get(F, 23); }
__device__ __forceinline__ float* outp(const Frame& F) { return (float*)(GAS float*)ptr_get(F, 24); }
enum { I_X = 0, I_C, I_CTX, I_CCTX, I_WADA, I_BADA, I_GMIX, I_GFFN, I_WQKV, I_QGAIN, I_KGAIN, I_RPB, I_WONA, I_WIN, I_BGATE, I_MHGAIN, I_WOML,
       I_WR, I_BR, I_W1, I_B1, I_W2, I_B2 };

struct DenseOrder {
    int nM, nN, nwg, G, c, pm0, K; const char* A; const char* Bt;
    __device__ __forceinline__ void init(int pm0_, int nM_, int nN_, int G_, int c_, const void* A_, const void* Bt_, int K_) { pm0 = pm0_; nM = nM_; nN = nN_; nwg = nM * nN; G = G_; c = c_; A = (const char*)A_; Bt = (const char*)Bt_; K = K_; }
    __device__ __forceinline__ bool next(int i, pg8::Unit& u) const {
        const long L = (long)i * G + c; if (L >= nwg) return false;
        int wgid = (int)L; { const int q = nwg / 8, r = nwg % 8, xcd = wgid % 8, off = wgid / 8; wgid = (xcd < r ? xcd * (q + 1) : r * (q + 1) + (xcd - r) * q) + off; }
        const int nig = 8 * nN, gid = wgid / nig, fm = gid * 8, gsz = (nM - fm) < 8 ? (nM - fm) : 8;
        u.pm = pm0 + fm + ((wgid % nig) % gsz); u.pn = (wgid % nig) / gsz; u.e = 0; u.slot = i; return true;
    }
    __device__ __forceinline__ const char* a_base(const pg8::Unit& u) const { return A + (size_t)u.pm * 256 * K * 2; }
    __device__ __forceinline__ const char* b_base(const pg8::Unit& u) const { return Bt + (size_t)u.pn * 256 * K * 2; }
    __device__ __forceinline__ int a_row(const pg8::Unit&, int) const { return 0; }
    __device__ __forceinline__ bool prefetchable() const { return false; }
    __device__ __forceinline__ const int* a_row_ptr(const pg8::Unit&, int) const { return nullptr; }
};
struct MoeOrder {
    int NT, nunits, G, c, K; const char* A; const char* W; size_t estride; const int* tokmap; volatile LAS int* prefix; volatile LAS int* tile_e; volatile LAS int* tokl; bool gather;
    __device__ __forceinline__ bool next(int i, pg8::Unit& u) const {
        const long L = (long)i * G + c; if (L >= nunits) return false;
        int wgid = (int)L; { const int q = nunits / 8, r = nunits % 8, xcd = wgid % 8, off = wgid / 8; wgid = (xcd < r ? xcd * (q + 1) : r * (q + 1) + (xcd - r) * q) + off; }
        const int tile = wgid / NT; u.pm = tile; u.pn = wgid - tile * NT;
        u.e = __builtin_amdgcn_readfirstlane(tile_e[tile]); u.slot = i; return true;
    }
    __device__ __forceinline__ const char* a_base(const pg8::Unit& u) const { return A; }
    __device__ __forceinline__ const char* b_base(const pg8::Unit& u) const { return W + (size_t)u.e * estride + (size_t)u.pn * 256 * K * 2; }
    __device__ __forceinline__ int a_row(const pg8::Unit& u, int r) const { return gather ? tokl[u.slot * 256 + r] : u.pm * 256 + r; }
    __device__ __forceinline__ bool prefetchable() const { return gather; }
    __device__ __forceinline__ const int* a_row_ptr(const pg8::Unit& u, int r) const { return tokmap + u.pm * 256 + r; }
};

#ifndef WO_PREFETCH
#define WO_PREFETCH false
#endif
typedef f32x4 AccT[2][2][4][2];
struct EpiStoreBf16 {
    static constexpr bool PERM = true; static constexpr bool PREFETCH = false;
    bf16_t* O; int ldc;
    __device__ __forceinline__ void operator()(const AccT& acc, const pg8::Unit& u, int wr, int wc, int fr, int fq) const {
        const int row0 = u.pm * 256 + wr * 64 + fr, col0 = u.pn * 256 + wc * 32 + 8 * fq;
#pragma unroll
        for (int ai = 0; ai < 2; ++ai)
#pragma unroll
            for (int m = 0; m < 4; ++m) { bf16_t* rowp = O + (size_t)(row0 + ai * 128 + m * 16) * ldc + col0;
#pragma unroll
                for (int bj = 0; bj < 2; ++bj) { const f32x4 v0 = acc[ai][bj][m][0], v1 = acc[ai][bj][m][1];
                    u32x4 w; w.x = pg8::cvt_pk_bf16(v0[0], v0[1]); w.y = pg8::cvt_pk_bf16(v0[2], v0[3]); w.z = pg8::cvt_pk_bf16(v1[0], v1[1]); w.w = pg8::cvt_pk_bf16(v1[2], v1[3]);
                    *(u32x4*)(rowp + bj * 128) = w; } }
    }
};
struct EpiProjML {
    static constexpr bool PERM = false; static constexpr bool PREFETCH = false;
    bf16_t* O; const float* rope;
    __device__ __forceinline__ void operator()(const AccT& acc, const pg8::Unit& u, int wr, int wc, int fr, int fq) const {
        const int row0 = u.pm * 256 + wr * 64 + fr, col0 = u.pn * 256 + wc * 32 + 4 * fq;
        const bool qk = u.pn < 4, lat = u.pm >= ROWS_CTX / 256;
        const float scale = u.pn < 2 ? 0.125f : 1.0f;
        const int hf = wc & 1;
#pragma unroll
        for (int ai = 0; ai < 2; ++ai) {
            f32x4 t0[4], t1[4];
            if (qk && lat) {
#pragma unroll
                for (int m = 0; m < 4; ++m) { const int row = row0 + ai * 128 + m * 16, s = (row - ROWS_CTX) & 4095, pos = hf ? (s & 63) : (s >> 6);
                    t0[m] = *(const f32x4*)(rope + (pos * 16 + 4 * fq) * 2); t1[m] = *(const f32x4*)(rope + (pos * 16 + 4 * fq) * 2 + 4); }
            }
#pragma unroll
            for (int m = 0; m < 4; ++m) { const int row = row0 + ai * 128 + m * 16; bf16_t* rowp = O + (size_t)row * ML_INP + col0;
                f32x4 c4 = (f32x4){1.f, 1.f, 1.f, 1.f}, s4 = (f32x4){0.f, 0.f, 0.f, 0.f};
                if (qk && lat) { c4 = (f32x4){t0[m][0], t0[m][2], t1[m][0], t1[m][2]}; s4 = (f32x4){t0[m][1], t0[m][3], t1[m][1], t1[m][3]}; }
#pragma unroll
                for (int bj = 0; bj < 2; ++bj) { f32x4 v0 = acc[ai][bj][m][0], v1 = acc[ai][bj][m][1];
                    if (qk) { const f32x4 o0 = (v0 * c4 - v1 * s4) * scale, o1 = (v0 * s4 + v1 * c4) * scale; v0 = o0; v1 = o1; }
                    u32x2 w0, w1; w0.x = pg8::cvt_pk_bf16(v0[0], v0[1]); w0.y = pg8::cvt_pk_bf16(v0[2], v0[3]); w1.x = pg8::cvt_pk_bf16(v1[0], v1[1]); w1.y = pg8::cvt_pk_bf16(v1[2], v1[3]);
                    *(u32x2*)(rowp + bj * 128) = w0; *(u32x2*)(rowp + bj * 128 + 16) = w1; } }
        }
    }
};
#ifndef Y_FP8
#define Y_FP8 1
#endif
struct EpiY {
    static constexpr bool PERM = true; static constexpr bool PREFETCH = false;
    bf16_t* O; const float* b2;
    __device__ __forceinline__ void operator()(const AccT& acc, const pg8::Unit& u, int wr, int wc, int fr, int fq) const {
        const int row0 = u.pm * 256 + wr * 64 + fr, col0 = u.pn * 256 + wc * 32 + 8 * fq;
        const float* bp = b2 + (size_t)u.e * D + col0;
#pragma unroll
        for (int bj = 0; bj < 2; ++bj) {
            const f32x4 b0 = *(const f32x4*)(bp + bj * 128), b1v = *(const f32x4*)(bp + bj * 128 + 4);
#pragma unroll
            for (int ai = 0; ai < 2; ++ai)
#pragma unroll
                for (int m = 0; m < 4; ++m) {
                    const f32x4 v0 = acc[ai][bj][m][0] * (1.0f / 1024.0f) + b0, v1 = acc[ai][bj][m][1] * (1.0f / 1024.0f) + b1v;
#if Y_FP8
                    unsigned char* rowp = (unsigned char*)O + (size_t)(row0 + ai * 128 + m * 16) * D + col0 + bj * 128;
                    const f32x4 lim = (f32x4){448.f, 448.f, 448.f, 448.f};
                    const f32x4 q0 = __builtin_elementwise_min(__builtin_elementwise_max(v0 * 16.0f, -lim), lim), q1 = __builtin_elementwise_min(__builtin_elementwise_max(v1 * 16.0f, -lim), lim);
                    u32x2 w; w.x = pk4_fp8(q0[0], q0[1], q0[2], q0[3]); w.y = pk4_fp8(q1[0], q1[1], q1[2], q1[3]);
                    *(u32x2*)rowp = w;
#else
                    bf16_t* rowp = O + (size_t)(row0 + ai * 128 + m * 16) * D + col0 + bj * 128;
                    u32x4 w; w.x = pg8::cvt_pk_bf16(v0[0], v0[1]); w.y = pg8::cvt_pk_bf16(v0[2], v0[3]); w.z = pg8::cvt_pk_bf16(v1[0], v1[1]); w.w = pg8::cvt_pk_bf16(v1[2], v1[3]);
                    *(u32x4*)rowp = w;
#endif
                } }
    }
};
struct EpiSwiglu {
    static constexpr bool PERM = true; static constexpr bool PREFETCH = false;
    unsigned char* O; const float* b1;
    __device__ __forceinline__ void operator()(const AccT& acc, const pg8::Unit& u, int wr, int wc, int fr, int fq) const {
        const int row0 = u.pm * 256 + wr * 64 + fr, cc0 = u.pn * 128 + wc * 32 + 8 * fq;
        const float* bp = b1 + (size_t)u.e * 2048 + cc0;
        f32x4 bg[2], bl[2];
#pragma unroll
        for (int n = 0; n < 2; ++n) { bg[n] = *(const f32x4*)(bp + 4 * n); bl[n] = *(const f32x4*)(bp + 1024 + 4 * n) + 1.0f; }
#pragma unroll
        for (int ai = 0; ai < 2; ++ai)
#pragma unroll
            for (int m = 0; m < 4; ++m) { unsigned char* rowp = O + (size_t)(row0 + ai * 128 + m * 16) * D + cc0;
                float o[8];
#pragma unroll
                for (int n = 0; n < 2; ++n) { const f32x4 gl = acc[ai][0][m][n] * (1.0f / 2048.0f) + bg[n], li1 = acc[ai][1][m][n] * (1.0f / 2048.0f) + bl[n];
#pragma unroll
                    for (int j = 0; j < 4; ++j) { const float g = fminf(gl[j], 7.0f), l1 = __builtin_amdgcn_fmed3f(li1[j], -6.0f, 8.0f);
                        const float sg = __builtin_amdgcn_rcpf(1.0f + __builtin_amdgcn_exp2f(-2.45545696f * g));
                        o[4 * n + j] = (8.0f * g) * sg * l1; } }
                u32x2 w; w.x = pk4_fp8(o[0], o[1], o[2], o[3]); w.y = pk4_fp8(o[4], o[5], o[6], o[7]);
                *(u32x2*)rowp = w; }
    }
};
struct EpiResid {
    static constexpr bool PERM = true; static constexpr bool PREFETCH = WO_PREFETCH;
    bf16_t* xs; const float* g;
    __device__ __forceinline__ void prefetch(const pg8::Unit& u, int tid, LAS unsigned char* lds) const {
        const char* base = (const char*)(xs + (size_t)(u.pm * 256 + (tid >> 1)) * D + u.pn * 256) + (tid & 1) * 256;
        LAS unsigned* dump = (LAS unsigned*)(lds + pg8::STAGE_BYTES + 16384 + (tid >> 6) * 256);
        __builtin_amdgcn_global_load_lds((const unsigned*)base, dump, 4, 0, 0);
        __builtin_amdgcn_global_load_lds((const unsigned*)(base + 128), dump, 4, 0, 0);
    }
    __device__ __forceinline__ void operator()(const AccT& acc, const pg8::Unit& u, int wr, int wc, int fr, int fq) const {
        const int row0 = u.pm * 256 + wr * 64 + fr, col0 = u.pn * 256 + wc * 32 + 8 * fq;
        const int mb = u.pm < 8 ? 8 : ((u.pm - 8) >> 4);
        const float* gp = g + (size_t)mb * 6144 + col0;
        f32x4 gv[2][2];
#pragma unroll
        for (int bj = 0; bj < 2; ++bj)
#pragma unroll
            for (int n = 0; n < 2; ++n) gv[bj][n] = *(const f32x4*)(gp + bj * 128 + 4 * n);
#pragma unroll
        for (int ai = 0; ai < 2; ++ai) {
            u32x4 xv[4][2];
#pragma unroll
            for (int m = 0; m < 4; ++m) { const bf16_t* rowp = xs + (size_t)(row0 + ai * 128 + m * 16) * D + col0;
#pragma unroll
                for (int bj = 0; bj < 2; ++bj) xv[m][bj] = *(const u32x4*)(rowp + bj * 128); }
#pragma unroll
            for (int m = 0; m < 4; ++m) { bf16_t* rowp = xs + (size_t)(row0 + ai * 128 + m * 16) * D + col0;
#pragma unroll
                for (int bj = 0; bj < 2; ++bj) { const u32x4 x = xv[m][bj];
                    const f32x4 x0 = (f32x4){bflo(x.x), bfhi(x.x), bflo(x.y), bfhi(x.y)}, x1 = (f32x4){bflo(x.z), bfhi(x.z), bflo(x.w), bfhi(x.w)};
                    const f32x4 v0 = x0 + gv[bj][0] * acc[ai][bj][m][0], v1 = x1 + gv[bj][1] * acc[ai][bj][m][1];
                    u32x4 w; w.x = pg8::cvt_pk_bf16(v0[0], v0[1]); w.y = pg8::cvt_pk_bf16(v0[2], v0[3]); w.z = pg8::cvt_pk_bf16(v1[0], v1[1]); w.w = pg8::cvt_pk_bf16(v1[2], v1[3]);
                    *(u32x4*)(rowp + bj * 128) = w; } }
        }
    }
};

__device__ __forceinline__ const float* modp(const Frame& F, int l, int mb, int chunk) { return (const float*)(wsp(F) + WS_MOD) + ((size_t)(l * 9 + mb) * 6 + chunk) * D; }
__device__ __forceinline__ int row_mb(int row) { return row < ROWS_CTX ? 8 : ((row - ROWS_CTX) >> 12); }

__device__ __forceinline__ void transpose_item(const float* W, int N, int Nvalid, bf16_t* WT, int k0, int n0, LAS float* scr, int lane, const bool nost = false) {
    const int nn = 4 * (lane & 15);
    const bool ok = (n0 + nn) < Nvalid;
    f32x4 v[16];
#pragma unroll
    for (int i = 0; i < 16; ++i) { const int kk = 4 * i + (lane >> 4);
        v[i] = ok ? __builtin_nontemporal_load((const f32x4*)(W + (size_t)(k0 + kk) * N + n0 + nn)) : (f32x4){0.f, 0.f, 0.f, 0.f}; }
#pragma unroll
    for (int i = 0; i < 16; ++i) { const int kk = 4 * i + (lane >> 4); LAS float* s = scr + kk * 65 + nn;
        s[0] = v[i][0]; s[1] = v[i][1]; s[2] = v[i][2]; s[3] = v[i][3]; }
    LDS_WAIT(); asm volatile("" ::: "memory");
    const int c = lane & 7;
#pragma unroll
    for (int j = 0; j < 8; ++j) { const int n = (lane >> 3) + 8 * j; const LAS float* s = scr + (8 * c) * 65 + n;
        u32x4 o; o.x = pk2(s[0 * 65], s[1 * 65]); o.y = pk2(s[2 * 65], s[3 * 65]); o.z = pk2(s[4 * 65], s[5 * 65]); o.w = pk2(s[6 * 65], s[7 * 65]);
        if (!nost) *(u32x4*)(WT + (size_t)n * D + k0 + 8 * c) = o; }
    LDS_WAIT(); asm volatile("" ::: "memory");
}
__device__ __forceinline__ void transpose_item_f8(const float* W, int N, unsigned char* WT, int k0, int n0, LAS float* scr, int lane, float scale, const bool nost = false) {
    const int nn = 4 * (lane & 15);
    f32x4 v[16];
#pragma unroll
    for (int i = 0; i < 16; ++i) { const int kk = 4 * i + (lane >> 4); v[i] = __builtin_nontemporal_load((const f32x4*)(W + (size_t)(k0 + kk) * N + n0 + nn)); }
#pragma unroll
    for (int i = 0; i < 16; ++i) { const int kk = 4 * i + (lane >> 4); LAS float* s = scr + kk * 65 + nn;
        s[0] = v[i][0] * scale; s[1] = v[i][1] * scale; s[2] = v[i][2] * scale; s[3] = v[i][3] * scale; }
    LDS_WAIT(); asm volatile("" ::: "memory");
    const int c = lane & 3;
#pragma unroll
    for (int j = 0; j < 4; ++j) { const int n = (lane >> 2) + 16 * j; const LAS float* s = scr + (16 * c) * 65 + n;
        u32x4 o; o.x = pk4_fp8(s[0 * 65], s[1 * 65], s[2 * 65], s[3 * 65]); o.y = pk4_fp8(s[4 * 65], s[5 * 65], s[6 * 65], s[7 * 65]);
        o.z = pk4_fp8(s[8 * 65], s[9 * 65], s[10 * 65], s[11 * 65]); o.w = pk4_fp8(s[12 * 65], s[13 * 65], s[14 * 65], s[15 * 65]);
        if (!nost) *(u32x4*)(WT + (size_t)n * D + k0 + 16 * c) = o; }
    LDS_WAIT(); asm volatile("" ::: "memory");
}
struct CvItem { const float* W; unsigned char* dst; int N, Nvalid, k0, n0, f8; };
constexpr int CV_QKV = 2 * 16 * 48, CV_WO = 4 * 16 * 16, CV_IN = 2 * 16 * 52, CV_1 = DEPTH * NE * 16 * 32, CV_2 = DEPTH * NE * 16 * 16, CV_NIT = CV_QKV + CV_WO + CV_IN + CV_1 + CV_2;
#ifndef CV_SPLIT
#define CV_SPLIT 4
#endif
#ifndef CV_PERIOD
#define CV_PERIOD 0u
#endif
#ifndef CV_RD_END
#define CV_RD_END 500u
#endif
#ifndef CV_WR_BEG
#define CV_WR_BEG 950u
#endif
__device__ __forceinline__ void cv_window(const bool wr) {
#if CV_PERIOD > 0
    for (int spin = 0; spin < 4096; ++spin) {
        const unsigned t = (unsigned)__builtin_amdgcn_s_memrealtime() % CV_PERIOD;
        if (wr ? (t >= CV_WR_BEG) : (t < CV_RD_END)) break;
        __builtin_amdgcn_s_sleep(4);
    }
#endif
}
__device__ __forceinline__ CvItem cv_item(const Frame& F, int it) {
    CvItem I;
    if (it < CV_QKV) { const int j = it / 768, r = it % 768, kb = r / 48, nb = r % 48;
        I.W = inp(F, I_WQKV) + (size_t)j * D * 3072; I.N = 3072; I.Nvalid = 3072; I.dst = wsp(F) + WS_WQKV + (((size_t)j * 3072 + nb * 64) * D) * 2; I.k0 = kb * 64; I.n0 = nb * 64; I.f8 = 0; return I; }
    it -= CV_QKV;
    if (it < CV_WO) { const int m = it / 256, r = it % 256, kb = r / 16, nb = r % 16;
        I.W = (m < 2) ? inp(F, I_WONA) + (size_t)m * D * D : inp(F, I_WOML) + (size_t)(m - 2) * D * D;
        I.dst = ((m < 2) ? wsp(F) + WS_WONA + (size_t)m * D * D * 2 : wsp(F) + WS_WOML + (size_t)(m - 2) * D * D * 2) + (size_t)nb * 64 * D * 2;
        I.N = D; I.Nvalid = D; I.k0 = kb * 64; I.n0 = nb * 64; I.f8 = 0; return I; }
    it -= CV_WO;
    if (it < CV_IN) { const int j = it / 832, r = it % 832, kb = r / 52, nb = r % 52;
        I.W = inp(F, I_WIN) + (size_t)j * D * ML_IN; I.N = ML_IN; I.Nvalid = ML_IN; I.dst = wsp(F) + WS_WIN + (((size_t)j * ML_INP + nb * 64) * D) * 2; I.k0 = kb * 64; I.n0 = nb * 64; I.f8 = 0; return I; }
    it -= CV_IN;
    if (it < CV_1) { const int le = it / 512, r = it % 512, kb = r / 64, nb = r % 64;
        const int n0 = nb * 32, bj = n0 >> 10, j0 = n0 & 1023, pn = j0 >> 7, jj0 = j0 & 127, drow = pn * 256 + bj * 128 + jj0;
        I.W = inp(F, I_W1) + (size_t)le * D * 2048; I.N = 2048; I.Nvalid = 2048; I.dst = wsp(F) + WS_W1T + ((size_t)le * 2048 + drow) * D; I.k0 = kb * 128; I.n0 = n0; I.f8 = 1; return I; }
    it -= CV_1;
    { const int le = it / 256, r = it % 256, kb = r / 32, nb = r % 32;
        I.W = inp(F, I_W2) + (size_t)le * D * D; I.N = D; I.Nvalid = D; I.dst = wsp(F) + WS_W2T + ((size_t)le * D + nb * 32) * D; I.k0 = kb * 128; I.n0 = nb * 32; I.f8 = 1; return I; }
}
template <int NL>
__device__ __forceinline__ void cv_load(const CvItem& I, int lane, int i0, f32x4 (&v)[NL]) {
    const int rs = I.f8 ? 8 : 4, nn = I.f8 ? 4 * (lane & 7) : 4 * (lane & 15), kr = I.f8 ? (lane >> 3) : (lane >> 4);
    const bool ok = (I.n0 + nn) < I.Nvalid;
    const float* p = I.W + (size_t)(I.k0 + rs * i0 + kr) * I.N + I.n0 + nn;
#pragma unroll
    for (int i = 0; i < NL; ++i) v[i] = ok ? __builtin_nontemporal_load((const f32x4*)(p + (size_t)(rs * i) * I.N)) : (f32x4){0.f, 0.f, 0.f, 0.f};
}
template <int NL>
__device__ __forceinline__ void cv_lds(const CvItem& I, int lane, int i0, const f32x4 (&v)[NL], LAS float* scr) {
    const float scale = I.f8 ? 128.0f : 1.0f;
    LAS float* s0 = I.f8 ? scr + (8 * i0 + (lane >> 3)) * 33 + 4 * (lane & 7) : scr + (4 * i0 + (lane >> 4)) * 65 + 4 * (lane & 15);
    const int st = I.f8 ? 8 * 33 : 4 * 65;
#pragma unroll
    for (int i = 0; i < NL; ++i) { LAS float* s = s0 + i * st; s[0] = v[i][0] * scale; s[1] = v[i][1] * scale; s[2] = v[i][2] * scale; s[3] = v[i][3] * scale; }
}
__device__ __forceinline__ void cv_conv(const CvItem& I, int lane, LAS float* scr, u32x4 (&o)[8]) {
    LDS_WAIT(); asm volatile("" ::: "memory");
    if (I.f8) { const int c = lane & 7;
#pragma unroll
        for (int j = 0; j < 4; ++j) { const int n = (lane >> 3) + 8 * j; const LAS float* s = scr + (16 * c) * 33 + n;
            o[j].x = pk4_fp8(s[0 * 33], s[1 * 33], s[2 * 33], s[3 * 33]); o[j].y = pk4_fp8(s[4 * 33], s[5 * 33], s[6 * 33], s[7 * 33]);
            o[j].z = pk4_fp8(s[8 * 33], s[9 * 33], s[10 * 33], s[11 * 33]); o[j].w = pk4_fp8(s[12 * 33], s[13 * 33], s[14 * 33], s[15 * 33]); }
    } else { const int c = lane & 7;
#pragma unroll
        for (int j = 0; j < 8; ++j) { const int n = (lane >> 3) + 8 * j; const LAS float* s = scr + (8 * c) * 65 + n;
            o[j].x = pk2(s[0 * 65], s[1 * 65]); o[j].y = pk2(s[2 * 65], s[3 * 65]); o[j].z = pk2(s[4 * 65], s[5 * 65]); o[j].w = pk2(s[6 * 65], s[7 * 65]); }
    }
    LDS_WAIT(); asm volatile("" ::: "memory");
}
__device__ __forceinline__ void cv_put(const CvItem& I, int lane, const u32x4 (&o)[8]) {
    if (I.f8) { const int c = lane & 7;
#pragma unroll
        for (int j = 0; j < 4; ++j) { const int n = (lane >> 3) + 8 * j; *(u32x4*)(I.dst + (size_t)n * D + I.k0 + 16 * c) = o[j]; }
    } else { const int c = lane & 7;
#pragma unroll
        for (int j = 0; j < 8; ++j) { const int n = (lane >> 3) + 8 * j; *(u32x4*)(I.dst + ((size_t)n * D + I.k0 + 8 * c) * 2) = o[j]; }
    }
}
__device__ __forceinline__ void phase0(Frame& F, const int mode = 0) {
    const int tid = F.tid, lane = F.lane, wave = F.wave;
    if (mode != 2) {
        LAS float* sT = (LAS float*)F.lds;
        LAS float* red = (LAS float*)(F.lds + 40960);
        const float* c = inp(F, I_C); const float* cctx = inp(F, I_CCTX);
        for (int idx = tid; idx < 9 * D; idx += NTHREADS) { const int mb = idx >> 10, k = idx & 1023; const float cv = mb < 8 ? c[mb * D + k] : cctx[k]; sT[idx] = cv / (1.f + __expf(-cv)); }
        __syncthreads();
        float* mod = (float*)(wsp(F) + WS_MOD);
        for (int task = F.vcu; task < DEPTH * 64; task += F.G) {
            const int l = task >> 6, cb = task & 63, hk = lane >= 24 ? 1 : 0, ln = lane - 24 * hk; const bool act = lane < 48;
            const float* wp = inp(F, I_WADA) + ((size_t)l * D + wave * 128 + hk) * 6144 + cb * 96 + ln * 4;
            f32x4 acc[9];
#pragma unroll
            for (int mb = 0; mb < 9; ++mb) acc[mb] = (f32x4){0.f, 0.f, 0.f, 0.f};
#pragma unroll 8
            for (int k2 = 0; k2 < 64; ++k2) { const f32x4 wv = act ? __builtin_nontemporal_load((const f32x4*)(wp + (size_t)k2 * 2 * 6144)) : (f32x4){0.f, 0.f, 0.f, 0.f};
#pragma unroll
                for (int mb = 0; mb < 9; ++mb) acc[mb] += wv * sT[mb * D + wave * 128 + 2 * k2 + hk]; }
#pragma unroll
            for (int mb = 0; mb < 9; ++mb) {
#pragma unroll
                for (int c = 0; c < 4; ++c) acc[mb][c] += shfl_(acc[mb][c], lane + 24);
                if (lane < 24) *(LAS f32x4*)(red + (wave * 9 + mb) * 96 + lane * 4) = acc[mb]; }
            __syncthreads();
            for (int idx = tid; idx < 9 * 96; idx += NTHREADS) { const int mb = idx / 96, cc = idx % 96; float s = 0.f;
#pragma unroll
                for (int w = 0; w < 8; ++w) s += red[(w * 9 + mb) * 96 + cc];
                const int col = cb * 96 + cc;
                mod[(size_t)(l * 9 + mb) * 6144 + col] = s + inp(F, I_BADA)[l * 6144 + col]; }
            __syncthreads();
        }
        {
            bf16_t* rt = (bf16_t*)(wsp(F) + WS_RT); const float* wr = inp(F, I_WR);
            for (int idx = F.vcu * NTHREADS + tid; idx < DEPTH * D * NE; idx += F.G * NTHREADS) { const int l = idx >> 15, k = (idx >> 5) & 1023, e = idx & 31; const float w = wr[idx];
                const unsigned hb16 = f2bf(w); const float hf = __builtin_bit_cast(float, hb16 << 16);
                rt[((size_t)(l * 2 + 0) * NE + e) * D + k] = (bf16_t)hb16; rt[((size_t)(l * 2 + 1) * NE + e) * D + k] = (bf16_t)f2bf(w - hf); }
        }
        if (blockIdx.x == 0) {
            float* rope = (float*)(wsp(F) + WS_ROPE);
            for (int idx = tid; idx < 64 * 16; idx += NTHREADS) { const int pos = idx >> 4, i = idx & 15; const float inv = powf(10000.0f, -(float)i / 16.0f); const float ang = (float)pos * inv;
                rope[idx * 2] = cosf(ang); rope[idx * 2 + 1] = sinf(ang); }
        }
        __syncthreads();
    }
    if (mode != 1) {
        const bool nost = (mode == 3);
        LAS float* scr = (LAS float*)(F.lds + wave * 17024);
        const int gw = F.vcu * NWAVES + wave, NGW = F.G * NWAVES;
        for (int it0 = gw; it0 < CV_NIT; it0 += NGW) {
            const CvItem I0 = cv_item(F, it0);
            f32x4 v[16 / CV_SPLIT]; u32x4 o0[8];
#pragma unroll
            for (int h = 0; h < CV_SPLIT; ++h) { cv_load<16 / CV_SPLIT>(I0, lane, h * (16 / CV_SPLIT), v); cv_lds<16 / CV_SPLIT>(I0, lane, h * (16 / CV_SPLIT), v, scr); }
            cv_conv(I0, lane, scr, o0);
            if (!nost) cv_put(I0, lane, o0);
        }
    }
}

__device__ __forceinline__ void moe_combine(const Frame& F, const int4 pos, const float4 tw, int lprev, int mb, f32x4 (&v)[4]) {
    const int p[4] = {pos.x, pos.y, pos.z, pos.w}; const float w[4] = {tw.x, tw.y, tw.z, tw.w};
    f32x4 a[4];
#pragma unroll
    for (int j = 0; j < 4; ++j) a[j] = (f32x4){0.f, 0.f, 0.f, 0.f};
#if Y_FP8
    const unsigned char* Y = (const unsigned char*)(wsp(F) + WS_Y);
    unsigned y[4][4];
#pragma unroll
    for (int k = 0; k < 4; ++k) { const unsigned* yp = (const unsigned*)(Y + (size_t)p[k] * D) + F.lane;
#pragma unroll
        for (int j = 0; j < 4; ++j) y[k][j] = __builtin_nontemporal_load(yp + 64 * j); }
#pragma unroll
    for (int k = 0; k < 4; ++k) { const float wk = w[k] * (1.0f / 16.0f);
#pragma unroll
        for (int j = 0; j < 4; ++j) { const int yy = (int)y[k][j];
            a[j] = a[j] + wk * (f32x4){__builtin_amdgcn_cvt_f32_fp8(yy, 0), __builtin_amdgcn_cvt_f32_fp8(yy, 1), __builtin_amdgcn_cvt_f32_fp8(yy, 2), __builtin_amdgcn_cvt_f32_fp8(yy, 3)}; } }
#else
    const bf16_t* Y = (const bf16_t*)(wsp(F) + WS_Y);
    u32x2 y[4][4];
#pragma unroll
    for (int k = 0; k < 4; ++k) { const u32x2* yp = (const u32x2*)(Y + (size_t)p[k] * D) + F.lane;
#pragma unroll
        for (int j = 0; j < 4; ++j) y[k][j] = yp[64 * j]; }
#pragma unroll
    for (int k = 0; k < 4; ++k)
#pragma unroll
        for (int j = 0; j < 4; ++j) a[j] = a[j] + w[k] * (f32x4){bflo(y[k][j].x), bfhi(y[k][j].x), bflo(y[k][j].y), bfhi(y[k][j].y)};
#endif
    const f32x4* g2 = (const f32x4*)modp(F, lprev, mb, 5) + F.lane;
#pragma unroll
    for (int j = 0; j < 4; ++j) v[j] = v[j] + g2[64 * j] * a[j];
}

__device__ __forceinline__ void phase_norm1(Frame& F, int l, bool dummy = false) {
    const int gw = F.vcu * NWAVES + F.wave, NGW = F.G * NWAVES, lane = F.lane;
    bf16_t* xs = (bf16_t*)(wsp(F) + WS_XS); bf16_t* hb = (bf16_t*)(wsp(F) + WS_HB);
    bf16_t* xso = dummy ? (bf16_t*)(wsp(F) + WS_ACT) : xs;
    const f32x4* gm = (const f32x4*)(inp(F, I_GMIX) + l * D) + lane;
    const int4* posp = (const int4*)(wsp(F) + WS_POS); const float4* twp = (const float4*)(wsp(F) + WS_TOPW);
    int4 pn = make_int4(0, 0, 0, 0); float4 wn = make_float4(0.f, 0.f, 0.f, 0.f);
    if (l > 0 && gw < ROWS) { pn = posp[gw]; wn = twp[gw]; }
    for (int row = gw; row < ROWS; row += NGW) {
        const int mb = row_mb(row);
        f32x4 v[4];
        if (l == 0) { const float* src = row < ROWS_CTX ? inp(F, I_CTX) + (size_t)row * D : inp(F, I_X) + (size_t)(row - ROWS_CTX) * D; const f32x4* xr = (const f32x4*)src + lane;
#pragma unroll
            for (int j = 0; j < 4; ++j) v[j] = xr[64 * j]; }
        else { const u32x2* xr = (const u32x2*)(xs + (size_t)row * D) + lane;
#pragma unroll
            for (int j = 0; j < 4; ++j) v[j] = bf4_to_f32(xr[64 * j]); }
        if (l > 0) { const int4 pc = pn; const float4 wc = wn;
            if (row + NGW < ROWS) { pn = posp[row + NGW]; wn = twp[row + NGW]; }
            moe_combine(F, pc, wc, l - 1, mb, v); }
        u32x2* xw = (u32x2*)(xso + (size_t)row * D) + lane;
        float ss = 0.f;
#pragma unroll
        for (int j = 0; j < 4; ++j) { u32x2 xb; xb.x = pk2(v[j][0], v[j][1]); xb.y = pk2(v[j][2], v[j][3]); xw[64 * j] = xb; ss += (v[j][0] * v[j][0] + v[j][1] * v[j][1]) + (v[j][2] * v[j][2] + v[j][3] * v[j][3]); }
        const float rs = 1.0f / sqrtf(wave_sum(ss) * (1.f / D) + EPS);
        const f32x4* sh = (const f32x4*)modp(F, l, mb, 0) + lane; const f32x4* sc = (const f32x4*)modp(F, l, mb, 1) + lane;
        u32x2* o8 = (u32x2*)(hb + (size_t)row * D) + lane;
#pragma unroll
        for (int j = 0; j < 4; ++j) { const f32x4 h = (v[j] * rs) * gm[64 * j] * (sc[64 * j] + 1.0f) + sh[64 * j];
            u32x2 w; w.x = pk2(h[0], h[1]); w.y = pk2(h[2], h[3]); o8[64 * j] = w; }
    }
}
__device__ __forceinline__ void phase_final(Frame& F) {
    const int gw = F.vcu * NWAVES + F.wave, NGW = F.G * NWAVES, lane = F.lane;
    const bf16_t* xs = (const bf16_t*)(wsp(F) + WS_XS);
    const int4* posp = (const int4*)(wsp(F) + WS_POS); const float4* twp = (const float4*)(wsp(F) + WS_TOPW);
    int4 pn = make_int4(0, 0, 0, 0); float4 wn = make_float4(0.f, 0.f, 0.f, 0.f);
    if (ROWS_CTX + gw < ROWS) { pn = posp[ROWS_CTX + gw]; wn = twp[ROWS_CTX + gw]; }
    for (int row = ROWS_CTX + gw; row < ROWS; row += NGW) {
        const int mb = row_mb(row);
        const u32x2* xr = (const u32x2*)(xs + (size_t)row * D) + lane;
        f32x4 v[4];
#pragma unroll
        for (int j = 0; j < 4; ++j) v[j] = bf4_to_f32(xr[64 * j]);
        const int4 pc = pn; const float4 wc = wn;
        if (row + NGW < ROWS) { pn = posp[row + NGW]; wn = twp[row + NGW]; }
        moe_combine(F, pc, wc, DEPTH - 1, mb, v);
        f32x4* o = (f32x4*)(outp(F) + (size_t)(row - ROWS_CTX) * D) + lane;
#ifdef MLPROF
        { const unsigned long long* pp = (const unsigned long long*)(wsp(F) + WS_CTL + 524288); const float tot = (float)(pp[0] + pp[1] + pp[2] + pp[3] + pp[4] + pp[5]);
          const float f = MLPROF_SEL < 0 ? 0.f : (MLPROF_SEL == 6 ? tot * (1.0f / 1048576.0f) : (MLPROF_SEL > 5 ? 1.f : (float)pp[MLPROF_SEL < 0 ? 0 : (MLPROF_SEL > 5 ? 5 : MLPROF_SEL)] / tot)); const float sc = 2.f + 4.f * f;
          const f32x4* xin = (const f32x4*)(inp(F, I_X) + (size_t)(row - ROWS_CTX) * D) + lane;
#pragma unroll
          for (int j = 0; j < 4; ++j) v[j] = xin[64 * j] * sc; }
#endif
#pragma unroll
        for (int j = 0; j < 4; ++j) o[64 * j] = v[j];
    }
}

constexpr int NCBP = 96, NA_CTX_EXTRA = 3;
__device__ __forceinline__ bool proj_split(int G) { return false && G >= 2 * NCBP; }
__device__ __forceinline__ void phase_na_post(Frame& F, int jn, const bool split) {
    const int gw = F.vcu * NWAVES + F.wave, NGW = F.G * NWAVES, lane = F.lane;
    constexpr int NIT = (ROWS / 64) * NH_NA, NIT_CTX = (ROWS_CTX / 64) * NH_NA, NIT_IMG = NIT - NIT_CTX;
    const int nwc = NCBP * NWAVES, nwm = NGW - nwc, m1 = NIT_IMG - NA_CTX_EXTRA * nwc;
    const bf16_t* proj = (const bf16_t*)(wsp(F) + WS_PROJ);
    bf16_t* QN = (bf16_t*)(wsp(F) + WS_QN); bf16_t* KN = (bf16_t*)(wsp(F) + WS_KN); bf16_t* VT = (bf16_t*)(wsp(F) + WS_VT);
    LAS bf16_t* vs = (LAS bf16_t*)(F.lds + F.wave * (64 * 72 * 2));
    const int c8 = lane & 7, rl = lane >> 3;
    float qg[8], kg[8];
#pragma unroll
    for (int e = 0; e < 8; ++e) { qg[e] = inp(F, I_QGAIN)[jn * 64 + c8 * 8 + e] * (0.125f * 1.44269504f); kg[e] = inp(F, I_KGAIN)[jn * 64 + c8 * 8 + e]; }
    for (int v = 0; ; ++v) {
        int item;
        if (!split) { item = gw + v * NGW; if (item >= NIT) break; }
        else if (gw < nwc) { if (v == 0) { if (gw >= NIT_CTX) continue; item = gw; } else { if (v > NA_CTX_EXTRA) break; item = NIT_CTX + m1 + gw + (v - 1) * nwc; } }
        else { const int m = (gw - nwc) + v * nwm; if (m >= m1) break; item = NIT_CTX + m; }
        const int rb = item >> 4, h = item & 15, row0 = rb * 64;
        int b, tp0;
        if (row0 < ROWS_CTX) { b = row0 >> 8; tp0 = row0 & 255; } else { b = (row0 - ROWS_CTX) >> 12; tp0 = NCTX + ((row0 - ROWS_CTX) & 4095); }
        const size_t seqbase = ((size_t)(b * NH_NA + h) * TT + tp0) * 64;
#pragma unroll
        for (int i = 0; i < 8; ++i) {
            const int r = i * 8 + rl;
            const bf16_t* pr = proj + (size_t)(row0 + r) * 3072 + h * 64 + c8 * 8;
            const u32x4 qv = *(const u32x4*)pr, kv = *(const u32x4*)(pr + 1024), vv = *(const u32x4*)(pr + 2048);
            float q[8] = {bflo(qv.x), bfhi(qv.x), bflo(qv.y), bfhi(qv.y), bflo(qv.z), bfhi(qv.z), bflo(qv.w), bfhi(qv.w)};
            float k[8] = {bflo(kv.x), bfhi(kv.x), bflo(kv.y), bfhi(kv.y), bflo(kv.z), bfhi(kv.z), bflo(kv.w), bfhi(kv.w)};
            float sq = 0.f, sk = 0.f;
#pragma unroll
            for (int e = 0; e < 8; ++e) { sq += q[e] * q[e]; sk += k[e] * k[e]; }
            sq = sum8(sq); sk = sum8(sk);
            const float rq = 1.0f / sqrtf(sq * (1.f / 64) + EPS), rk = 1.0f / sqrtf(sk * (1.f / 64) + EPS);
            u32x4 qo, ko;
            qo.x = pk2(q[0] * rq * qg[0], q[1] * rq * qg[1]); qo.y = pk2(q[2] * rq * qg[2], q[3] * rq * qg[3]); qo.z = pk2(q[4] * rq * qg[4], q[5] * rq * qg[5]); qo.w = pk2(q[6] * rq * qg[6], q[7] * rq * qg[7]);
            ko.x = pk2(k[0] * rk * kg[0], k[1] * rk * kg[1]); ko.y = pk2(k[2] * rk * kg[2], k[3] * rk * kg[3]); ko.z = pk2(k[4] * rk * kg[4], k[5] * rk * kg[5]); ko.w = pk2(k[6] * rk * kg[6], k[7] * rk * kg[7]);
            *(u32x4*)(QN + seqbase + (size_t)r * 64 + c8 * 8) = qo;
            *(u32x4*)(KN + seqbase + (size_t)r * 64 + c8 * 8) = ko;
            *(LAS u32x4*)(vs + r * 72 + ((c8 ^ ((r >> 3) & 7)) * 8)) = vv;
        }
        LDS_WAIT(); asm volatile("" ::: "memory");
#pragma unroll
        for (int j = 0; j < 8; ++j) {
            const int d = rl + 8 * j;
            const LAS bf16_t* s = vs + (8 * c8) * 72 + (((d >> 3) ^ c8) * 8) + (d & 7);
            u32x4 o;
            o.x = (unsigned)s[0 * 72] | ((unsigned)s[1 * 72] << 16); o.y = (unsigned)s[2 * 72] | ((unsigned)s[3 * 72] << 16);
            o.z = (unsigned)s[4 * 72] | ((unsigned)s[5 * 72] << 16); o.w = (unsigned)s[6 * 72] | ((unsigned)s[7 * 72] << 16);
            *(u32x4*)(VT + ((size_t)(b * NH_NA + h) * 64 + d) * TT + tp0 + 8 * c8) = o;
        }
        LDS_WAIT(); asm volatile("" ::: "memory");
    }
}

__device__ __forceinline__ bf16x8 ld_bf16x8(const bf16_t* p) { return *(const bf16x8*)p; }
constexpr int NA_LD = 72;
constexpr int NA_TILE = 64 * NA_LD * 2;
struct NaState { f32x4 o[4]; f32x4 osum; };
constexpr int NA_RING = 2 * 2 * 64 * NA_LD * 2;
constexpr int NA_CTX_OFF = NA_RING + 15 * 128 * 4;
constexpr int NA_BT_LD = 128, NA_BT_OFF = 48;
constexpr int NA_GQK_OFF = NA_CTX_OFF + 4 * 2 * 64 * NA_LD * 2;
__device__ __forceinline__ int na_row(int b, int tp) { return tp < NCTX ? b * NCTX + tp : ROWS_CTX + b * SEQ + (tp - NCTX); }
__device__ __forceinline__ u32x4 na_knorm(const u32x4 kv) {
    const float k[8] = {bflo(kv.x), bfhi(kv.x), bflo(kv.y), bfhi(kv.y), bflo(kv.z), bfhi(kv.z), bflo(kv.w), bfhi(kv.w)};
    float sk = 0.f;
#pragma unroll
    for (int e = 0; e < 8; ++e) sk += k[e] * k[e];
    sk = sum8(sk);
    const float rk = 1.0f / sqrtf(sk * (1.f / 64) + EPS);
    u32x4 o; o.x = pk2(k[0] * rk, k[1] * rk); o.y = pk2(k[2] * rk, k[3] * rk); o.z = pk2(k[4] * rk, k[5] * rk); o.w = pk2(k[6] * rk, k[7] * rk);
    return o;
}
__device__ __forceinline__ void na_vscatter(LAS bf16_t* vimg, const u32x4 vv, int r, int c8) {
    const unsigned vw[4] = {vv.x, vv.y, vv.z, vv.w};
    LAS bf16_t* d = vimg + (8 * c8) * NA_LD + r;
#pragma unroll
    for (int e = 0; e < 8; ++e) d[e * NA_LD] = (bf16_t)((vw[e >> 1] >> (16 * (e & 1))) & 0xffffu);
}
__device__ __forceinline__ void na_qload(const bf16_t* qp, const LAS float* gqk, int lane, int g, bf16x8 (&q)[2]) {
    const u32x4 a = *(const u32x4*)(qp + 8 * g), c = *(const u32x4*)(qp + 32 + 8 * g);
    const float f0[8] = {bflo(a.x), bfhi(a.x), bflo(a.y), bfhi(a.y), bflo(a.z), bfhi(a.z), bflo(a.w), bfhi(a.w)};
    const float f1[8] = {bflo(c.x), bfhi(c.x), bflo(c.y), bfhi(c.y), bflo(c.z), bfhi(c.z), bflo(c.w), bfhi(c.w)};
    float ss = 0.f;
#pragma unroll
    for (int e = 0; e < 8; ++e) ss += f0[e] * f0[e] + f1[e] * f1[e];
    ss += shfl_(ss, lane ^ 16); ss += shfl_(ss, lane ^ 32);
    const float rq = 1.0f / sqrtf(ss * (1.f / 64) + EPS);
    const f32x4 g0 = *(const LAS f32x4*)(gqk + 8 * g), g1 = *(const LAS f32x4*)(gqk + 8 * g + 4), g2 = *(const LAS f32x4*)(gqk + 32 + 8 * g), g3 = *(const LAS f32x4*)(gqk + 32 + 8 * g + 4);
    union { u32x4 u; bf16x8 v; } o0, o1;
    o0.u.x = pk2(f0[0] * rq * g0[0], f0[1] * rq * g0[1]); o0.u.y = pk2(f0[2] * rq * g0[2], f0[3] * rq * g0[3]); o0.u.z = pk2(f0[4] * rq * g1[0], f0[5] * rq * g1[1]); o0.u.w = pk2(f0[6] * rq * g1[2], f0[7] * rq * g1[3]);
    o1.u.x = pk2(f1[0] * rq * g2[0], f1[1] * rq * g2[1]); o1.u.y = pk2(f1[2] * rq * g2[2], f1[3] * rq * g2[3]); o1.u.z = pk2(f1[4] * rq * g3[0], f1[5] * rq * g3[1]); o1.u.w = pk2(f1[6] * rq * g3[2], f1[7] * rq * g3[3]);
    q[0] = o0.v; q[1] = o1.v;
}
template <bool WIN, bool DOA, bool DOB>
__device__ __forceinline__ void na_half2(NaState& sa, NaState& sb, const LAS bf16_t* KL, const LAS bf16_t* VL, int half, const bf16x8 (&qa)[2], const bf16x8 (&qb)[2],
                                         const LAS float* browA, const unsigned (&mA)[4], const unsigned (&mB)[4], int q16, int g) {
    union { u32x4 u; bf16x8 v; } ones; ones.u = (u32x4){0x3F803F80u, 0x3F803F80u, 0x3F803F80u, 0x3F803F80u};
    const LAS bf16_t* kp = KL + (half * 32 + q16) * NA_LD + 8 * g;
    const bf16x8 kf[2][2] = {{*(const LAS bf16x8*)kp, *(const LAS bf16x8*)(kp + 32)}, {*(const LAS bf16x8*)(kp + 16 * NA_LD), *(const LAS bf16x8*)(kp + 16 * NA_LD + 32)}};
    bf16x8 vf[4];
#pragma unroll
    for (int j4 = 0; j4 < 4; ++j4) { const LAS bf16_t* vp = VL + (16 * j4 + q16) * NA_LD + half * 32 + 4 * g;
        const bf16x4 va = *(const LAS bf16x4*)vp, vb = *(const LAS bf16x4*)(vp + 16);
        vf[j4] = (bf16x8){va[0], va[1], va[2], va[3], vb[0], vb[1], vb[2], vb[3]}; }
#pragma unroll
    for (int grp = 0; grp < 2; ++grp) {
        if ((grp == 0 && !DOA) || (grp == 1 && !DOB)) continue;
        NaState& st = grp ? sb : sa;
        const LAS float* brow = browA - 16 * grp;
        f32x4 sv[2];
#pragma unroll
        for (int nb = 0; nb < 2; ++nb) { f32x4 init = (f32x4){0.f, 0.f, 0.f, 0.f};
            if (WIN) {
#pragma unroll
                for (int rg = 0; rg < 4; ++rg) init[rg] = brow[32 * half + 16 * nb + rg]; }
            init = __builtin_amdgcn_mfma_f32_16x16x32_bf16(kf[nb][0], grp ? qb[0] : qa[0], init, 0, 0, 0);
            sv[nb] = __builtin_amdgcn_mfma_f32_16x16x32_bf16(kf[nb][1], grp ? qb[1] : qa[1], init, 0, 0, 0); }
#pragma unroll
        for (int nb = 0; nb < 2; ++nb)
#pragma unroll
            for (int rg = 0; rg < 4; ++rg) sv[nb][rg] = __builtin_amdgcn_exp2f(__builtin_amdgcn_fmed3f(sv[nb][rg], -3.0e38f, 100.0f));
        union { u32x4 u; bf16x8 v; } pf;
        pf.u.x = pg8::cvt_pk_bf16(sv[0][0], sv[0][1]); pf.u.y = pg8::cvt_pk_bf16(sv[0][2], sv[0][3]); pf.u.z = pg8::cvt_pk_bf16(sv[1][0], sv[1][1]); pf.u.w = pg8::cvt_pk_bf16(sv[1][2], sv[1][3]);
        if (WIN) { const unsigned (&mk)[4] = grp ? mB : mA; pf.u.x &= mk[0]; pf.u.y &= mk[1]; pf.u.z &= mk[2]; pf.u.w &= mk[3]; }
#pragma unroll
        for (int j4 = 0; j4 < 4; ++j4) st.o[j4] = __builtin_amdgcn_mfma_f32_16x16x32_bf16(vf[j4], pf.v, st.o[j4], 0, 0, 0);
        st.osum = __builtin_amdgcn_mfma_f32_16x16x32_bf16(ones.v, pf.v, st.osum, 0, 0, 0);
    }
}
__device__ __forceinline__ void na_block_task(const Frame& F, int jn, int b, int h, bool ctxq, int p) {
    const int tid = F.tid, lane = F.lane, wave = F.wave, q16 = lane & 15, g = lane >> 4;
    const bf16_t* proj = (const bf16_t*)(wsp(F) + WS_PROJ) + h * 64;
    const LAS float* gqk = (const LAS float*)(F.lds + NA_GQK_OFF);
    const int rw = 4 * p + (wave >> 1), ch = wave & 1, qcA = 32 * ch + q16, qcB = qcA + 16;
    const int qtpA = ctxq ? p * 128 + wave * 16 + q16 : NCTX + rw * 64 + qcA, qtpB = ctxq ? qtpA : qtpA + 16;
    bf16x8 qa[2], qb[2];
    na_qload(proj + (size_t)na_row(b, qtpA) * 3072, gqk, lane, g, qa);
    na_qload(proj + (size_t)na_row(b, qtpB) * 3072, gqk, lane, g, qb);
    NaState sa, sb;
#pragma unroll
    for (int j = 0; j < 4; ++j) { sa.o[j] = (f32x4){0.f, 0.f, 0.f, 0.f}; sb.o[j] = (f32x4){0.f, 0.f, 0.f, 0.f}; }
    sa.osum = (f32x4){0.f, 0.f, 0.f, 0.f}; sb.osum = (f32x4){0.f, 0.f, 0.f, 0.f};
    const int r0w = min(max(rw - 4, 0), 56), c0A = min(max(qcA - 8, 0), 48), c0B = min(max(qcB - 8, 0), 48);
    const int kr_lo = min(max(4 * p - 4, 0), 56), kr_hi = min(max(4 * p + 3 - 4, 0), 56) + 7;
    const int nw = ctxq ? 0 : (kr_hi - kr_lo + 1);
    LAS bf16_t* ring = (LAS bf16_t*)F.lds;
    LAS float* btab = (LAS float*)(F.lds + NA_RING);
    const LAS bf16_t* cres = (const LAS bf16_t*)(F.lds + NA_CTX_OFF);
    const int dA = 4 * g - c0A, dB = 4 * g - c0B;
    unsigned mkA[2][4], mkB[2][4];
#pragma unroll
    for (int hh2 = 0; hh2 < 2; ++hh2)
#pragma unroll
        for (int w4 = 0; w4 < 4; ++w4) { const int cc = 32 * hh2 + 16 * (w4 >> 1) + 2 * (w4 & 1);
            mkA[hh2][w4] = (((unsigned)(cc + dA) < 16u) ? 0xFFFFu : 0u) | (((unsigned)(cc + 1 + dA) < 16u) ? 0xFFFF0000u : 0u);
            mkB[hh2][w4] = (((unsigned)(cc + dB) < 16u) ? 0xFFFFu : 0u) | (((unsigned)(cc + 1 + dB) < 16u) ? 0xFFFF0000u : 0u); }
    const int bcolA = NA_BT_OFF + 4 * g - qcA + 15;
    const int r = tid >> 3, c8 = tid & 7;
    u32x4 kA, vA, kB, vB;
#define NA_TOK0(t) (NCTX + 64 * (kr_lo + (t)))
#define NA_LOAD(t, kk, vv) do { const bf16_t* pr_ = proj + (size_t)(ROWS_CTX + b * SEQ + 64 * (kr_lo + (t)) + r) * 3072 + 8 * c8; kk = *(const u32x4*)(pr_ + 1024); vv = *(const u32x4*)(pr_ + 2048); } while (0)
#define NA_WRITE(bufi, kk, vv) do { LAS bf16_t* dst_ = ring + (bufi) * (2 * 64 * NA_LD); *(LAS u32x4*)(dst_ + r * NA_LD + 8 * c8) = na_knorm(kk); na_vscatter(dst_ + 64 * NA_LD, vv, r, c8); } while (0)
#define NA_TILE(t, bufi) do { const LAS bf16_t* KL = ring + (bufi) * (2 * 64 * NA_LD); const LAS bf16_t* VL = KL + 64 * NA_LD; \
        const int kr = kr_lo + (t); \
        if (kr >= r0w && kr <= r0w + 7) { const LAS float* brow = btab + (kr - rw + 7) * NA_BT_LD + bcolA; \
            if (ch == 0) { na_half2<true, true, true>(sa, sb, KL, VL, 0, qa, qb, brow, mkA[0], mkB[0], q16, g); na_half2<true, false, true>(sa, sb, KL, VL, 1, qa, qb, brow, mkA[1], mkB[1], q16, g); } \
            else { na_half2<true, true, false>(sa, sb, KL, VL, 0, qa, qb, brow, mkA[0], mkB[0], q16, g); na_half2<true, true, true>(sa, sb, KL, VL, 1, qa, qb, brow, mkA[1], mkB[1], q16, g); } } } while (0)
    if (!ctxq) { NA_LOAD(0, kA, vA); NA_LOAD(1, kB, vB); }
    if (ctxq) {
#pragma unroll 1
        for (int t = 0; t < 4; ++t) { const LAS bf16_t* KL = cres + t * (2 * 64 * NA_LD);
            na_half2<false, true, false>(sa, sb, KL, KL + 64 * NA_LD, 0, qa, qb, btab, mkA[0], mkB[0], q16, g); na_half2<false, true, false>(sa, sb, KL, KL + 64 * NA_LD, 1, qa, qb, btab, mkA[1], mkB[1], q16, g); }
    } else {
#pragma unroll 1
        for (int t = 0; t < 4; ++t) { const LAS bf16_t* KL = cres + t * (2 * 64 * NA_LD);
            na_half2<false, true, true>(sa, sb, KL, KL + 64 * NA_LD, 0, qa, qb, btab, mkA[0], mkB[0], q16, g); na_half2<false, true, true>(sa, sb, KL, KL + 64 * NA_LD, 1, qa, qb, btab, mkA[1], mkB[1], q16, g); }
        NA_WRITE(0, kA, vA);
        __syncthreads();
        NA_LOAD(2, kA, vA);
        for (int t = 0; t < nw; t += 2) {
            NA_TILE(t, 0);
            if (t + 1 < nw) NA_WRITE(1, kB, vB);
            __syncthreads();
            if (t + 3 < nw) NA_LOAD(t + 3, kB, vB);
            if (t + 1 >= nw) break;
            NA_TILE(t + 1, 1);
            if (t + 2 < nw) NA_WRITE(0, kA, vA);
            __syncthreads();
            if (t + 4 < nw) NA_LOAD(t + 4, kA, vA);
        }
    }
#undef NA_TOK0
#undef NA_LOAD
#undef NA_WRITE
#undef NA_TILE
    {
        const float inv = 1.0f / sa.osum[0];
        const int row = ctxq ? b * NCTX + p * 128 + wave * 16 + q16 : ROWS_CTX + b * SEQ + rw * 64 + qcA;
        bf16_t* op = (bf16_t*)(wsp(F) + WS_AO) + (size_t)row * D + h * 64 + 4 * g;
#pragma unroll
        for (int j4 = 0; j4 < 4; ++j4) { u32x2 w; w.x = pk2(sa.o[j4][0] * inv, sa.o[j4][1] * inv); w.y = pk2(sa.o[j4][2] * inv, sa.o[j4][3] * inv); *(u32x2*)(op + 16 * j4) = w; }
    }
    if (!ctxq) {
        const float inv = 1.0f / sb.osum[0];
        const int row = ROWS_CTX + b * SEQ + rw * 64 + qcB;
        bf16_t* op = (bf16_t*)(wsp(F) + WS_AO) + (size_t)row * D + h * 64 + 4 * g;
#pragma unroll
        for (int j4 = 0; j4 < 4; ++j4) { u32x2 w; w.x = pk2(sb.o[j4][0] * inv, sb.o[j4][1] * inv); w.y = pk2(sb.o[j4][2] * inv, sb.o[j4][3] * inv); *(u32x2*)(op + 16 * j4) = w; }
    }
}
__device__ __forceinline__ void phase_na_attn(Frame& F, int jn) {
    const int nbh = NB * NH_NA;
    for (int slot = F.vcu; slot < 2 * nbh; slot += F.G) {
        const int bh = slot >> 1, hf = slot & 1, b = bh >> 4, h = bh & 15;
        {
            LAS float* btab = (LAS float*)(F.lds + NA_RING);
            const float* rpb = inp(F, I_RPB) + (size_t)(jn * NH_NA + h) * 15 * 31;
            for (int i = F.tid; i < 15 * NA_BT_LD; i += NTHREADS) { const int dr = i >> 7, c = (i & 127) - NA_BT_OFF; btab[i] = (c >= 0 && c < 31) ? rpb[dr * 31 + c] * 1.44269504f : 0.f; }
            const bf16_t* proj = (const bf16_t*)(wsp(F) + WS_PROJ) + h * 64;
            LAS bf16_t* cres = (LAS bf16_t*)(F.lds + NA_CTX_OFF); const int r = F.tid >> 3, c8 = F.tid & 7;
            if (F.tid < 64) ((LAS float*)(F.lds + NA_GQK_OFF))[F.tid] = inp(F, I_QGAIN)[jn * 64 + F.tid] * inp(F, I_KGAIN)[jn * 64 + F.tid] * (0.125f * 1.44269504f);
            u32x4 ck[4], cv[4];
#pragma unroll
            for (int t = 0; t < 4; ++t) { const bf16_t* pr = proj + (size_t)(b * NCTX + 64 * t + r) * 3072 + 8 * c8; ck[t] = *(const u32x4*)(pr + 1024); cv[t] = *(const u32x4*)(pr + 2048); }
#pragma unroll
            for (int t = 0; t < 4; ++t) { LAS bf16_t* dst = cres + t * (2 * 64 * NA_LD);
                *(LAS u32x4*)(dst + r * NA_LD + 8 * c8) = na_knorm(ck[t]);
                na_vscatter(dst + 64 * NA_LD, cv[t], r, c8); }
            __syncthreads();
        }
        for (int n = 0; n < 8; ++n) na_block_task(F, jn, b, h, false, hf * 8 + n);
        na_block_task(F, jn, b, h, true, hf);
        __syncthreads();
    }
}

__device__ __forceinline__ void row_decode(int row, int& b, int& tp) {
    if (row < ROWS_CTX) { b = row >> 8; tp = row & 255; } else { b = (row - ROWS_CTX) >> 12; tp = NCTX + ((row - ROWS_CTX) & 4095); }
}
__device__ __forceinline__ void unpack8(const u32x4 v, float (&f)[8]) { f[0] = bflo(v.x); f[1] = bfhi(v.x); f[2] = bflo(v.y); f[3] = bfhi(v.y); f[4] = bflo(v.z); f[5] = bfhi(v.z); f[6] = bflo(v.w); f[7] = bfhi(v.w); }
__device__ __forceinline__ u32x4 pack8(const float (&f)[8]) { u32x4 o; o.x = pk2(f[0], f[1]); o.y = pk2(f[2], f[3]); o.z = pk2(f[4], f[5]); o.w = pk2(f[6], f[7]); return o; }
__device__ __forceinline__ float wave_prefix_sum(float v, int lane) {
#pragma unroll
    for (int o = 1; o < 64; o <<= 1) { const float t = shfl_(v, lane - o); if (lane >= o) v += t; }
    return v;
}
__device__ __forceinline__ float wave_prefix_max(float v, int lane) {
#pragma unroll
    for (int o = 1; o < 64; o <<= 1) { const float t = shfl_(v, lane - o); if (lane >= o) v = fmaxf(v, t); }
    return v;
}
__device__ __forceinline__ int ml_grow(int b, int tp) { return tp < NCTX ? b * NCTX + tp : ROWS_CTX + b * SEQ + (tp - NCTX); }
__device__ __forceinline__ void phase_ml_post(Frame& F, int jm) {
    const int gw = F.vcu * NWAVES + F.wave, NGW = F.G * NWAVES, lane = F.lane;
    const bf16_t* proj = (const bf16_t*)(wsp(F) + WS_PROJ);
    float* gs = (float*)(wsp(F) + WS_GS);
    for (int task = gw; task < NB * (TT / 64); task += NGW) {
        const int b = task / (TT / 64), mc = task % (TT / 64);
        const bf16_t* pr = proj + (size_t)ml_grow(b, mc * 64 + lane) * ML_INP + 3072;
        float gp[32];
        { float t8[8];
#pragma unroll
          for (int q = 0; q < 4; ++q) { unpack8(*(const u32x4*)(pr + 8 * q), t8);
#pragma unroll
              for (int e = 0; e < 8; ++e) gp[8 * q + e] = t8[e]; } }
#pragma unroll
        for (int i = 0; i < 32; ++i) { float v = gp[i] + inp(F, I_BGATE)[jm * 32 + i]; v = 15.0f * tanhf(v * (1.0f / 15.0f));
            if ((i >> 3) & 1) v = fminf(v, 0.f) - log1pf(__expf(-fabsf(v)));
            gp[i] = v; }
#pragma unroll
        for (int dir = 0; dir < 2; ++dir)
#pragma unroll
            for (int hh = 0; hh < NH_ML; ++hh) {
                float ig = gp[(2 * dir) * 8 + hh], lf = gp[(2 * dir + 1) * 8 + hh];
                if (dir) { ig = shfl_(ig, 63 - lane); lf = shfl_(lf, 63 - lane); }
                const float cum = wave_prefix_sum(lf, lane), av = ig - cum, pmax = wave_prefix_max(av, lane), cl = shfl_(cum, 63);
                const float wend = cl - cum + ig, ml = wave_max(wend), eend = __expf(wend - ml);
                float* o = gs + ((((size_t)(dir * NB + b) * NH_ML + hh) * (TT / 64) + mc) * 5) * 64;
                o[lane] = cum; o[64 + lane] = av; o[128 + lane] = pmax; o[192 + lane] = eend; if (lane == 0) { o[256] = cl; o[257] = ml; }
            }
    }
}

constexpr int ML_LD = 72;
constexpr int ML_QL = 0, ML_KL = 9216, ML_KET = 18432, ML_VTL = 27648, ML_SDL = 36864, ML_C0L = 46080, ML_N0L = 55296, ML_DENL = 55552;
constexpr int ML_HL = 55808, ML_GL = 65024;
constexpr int ML_ALT = 69632;
__device__ __forceinline__ void ml_task(Frame& F, int jm, int b, int hh, int dir, int vh) {
    const int tid = F.tid, lane = F.lane, w = F.wave, l15 = lane & 15, g = lane >> 4;
    LAS bf16_t* QL = (LAS bf16_t*)(F.lds + ML_QL); LAS bf16_t* KL = (LAS bf16_t*)(F.lds + ML_KL); LAS bf16_t* KET = (LAS bf16_t*)(F.lds + ML_KET);
    LAS bf16_t* VTL = (LAS bf16_t*)(F.lds + ML_VTL); LAS bf16_t* SDL = (LAS bf16_t*)(F.lds + ML_SDL); LAS bf16_t* C0L = (LAS bf16_t*)(F.lds + ML_C0L);
    LAS float* n0L = (LAS float*)(F.lds + ML_N0L); LAS float* denL = (LAS float*)(F.lds + ML_DENL);
    LAS bf16_t* HL = (LAS bf16_t*)(F.lds + ML_HL); LAS float* GL = (LAS float*)(F.lds + ML_GL);
    const bf16_t* proj = (const bf16_t*)(wsp(F) + WS_PROJ);
    const float* gsb = (const float*)(wsp(F) + WS_GS) + (((size_t)(dir * NB + b) * NH_ML + hh) * (TT / 64)) * 5 * 64;
    bf16_t* hout = (bf16_t*)(wsp(F) + WS_HDIR) + (size_t)dir * ROWS * D + hh * DV_ML + vh * 64;
    {
        const float bi = inp(F, I_BGATE)[jm * 32 + (2 * dir) * 8 + hh], bfg = inp(F, I_BGATE)[jm * 32 + (2 * dir + 1) * 8 + hh];
        float* gso = (float*)(wsp(F) + WS_GS) + (((size_t)(dir * NB + b) * NH_ML + hh) * (TT / 64)) * 5 * 64;
        for (int mc = w; mc < TT / 64; mc += NWAVES) {
            const bf16_t* pr = proj + (size_t)ml_grow(b, mc * 64 + lane) * ML_INP + 3072;
            float ig = bf2f(pr[(2 * dir) * 8 + hh]) + bi; ig = 15.0f * tanhf(ig * (1.0f / 15.0f));
            float lf = bf2f(pr[(2 * dir + 1) * 8 + hh]) + bfg; lf = 15.0f * tanhf(lf * (1.0f / 15.0f)); lf = fminf(lf, 0.f) - log1pf(__expf(-fabsf(lf)));
            if (dir) { ig = shfl_(ig, 63 - lane); lf = shfl_(lf, 63 - lane); }
            const float cum = wave_prefix_sum(lf, lane), av = ig - cum, pmax = wave_prefix_max(av, lane), cl = shfl_(cum, 63);
            const float wend = cl - cum + ig, ml = wave_max(wend), eend = __expf(wend - ml);
            float* o = gso + (size_t)mc * 5 * 64;
            o[lane] = cum; o[64 + lane] = av; o[128 + lane] = pmax; o[192 + lane] = eend; if (lane == 0) { o[256] = cl; o[257] = ml; }
        }
        VM_WAIT();
        __syncthreads();
    }
    const bool loader = (0x2Bu >> w) & 1u;
    const int ridx = __builtin_popcount((loader ? 0x2Bu : 0xD4u) & ((1u << w) - 1u));
    const int c8 = lane & 7, r0 = ridx * 8 + (lane >> 3);
    const int bt = w >> 1, bc0 = 2 * (w & 1);
    for (int i = tid; i < 64 * ML_LD / 2; i += NTHREADS) { ((LAS unsigned*)C0L)[i] = 0u; ((LAS unsigned*)SDL)[i] = 0u; }
    if (tid < 64) n0L[tid] = 0.f;
    f32x4 Cst[2]; Cst[0] = (f32x4){0.f, 0.f, 0.f, 0.f}; Cst[1] = (f32x4){0.f, 0.f, 0.f, 0.f};
    float nst = 0.f, m0 = 0.f;
#ifdef MLPROF
    unsigned long long pa_[6] = {0, 0, 0, 0, 0, 0}, pt_; asm volatile("s_memtime %0\n\ts_waitcnt lgkmcnt(0)" : "=s"(pt_) :: "memory");
#define PROFPT(k) do { unsigned long long n_; __builtin_amdgcn_sched_barrier(0); asm volatile("s_memtime %0\n\ts_waitcnt lgkmcnt(0)" : "=s"(n_) :: "memory"); __builtin_amdgcn_sched_barrier(0); pa_[k] += n_ - pt_; pt_ = n_; } while (0)
#else
#define PROFPT(k) do {} while (0)
#endif
    u32x4 qA[2], kA[2], vA[2]; float gA[6];
#define ML_TB(c) (dir ? ((c) < 4 ? 192 - 64 * (c) : 4544 - 64 * (c)) : 64 * (c))
#ifdef MLHOT
#define ML_TBL(cn) ML_TB(0)
#else
#define ML_TBL(cn) ML_TB(cn)
#endif
#define ML_LOADSET(cn, QV, KV, VV, GG) do { const int tbn_ = ML_TBL(cn); \
        _Pragma("unroll") for (int h2 = 0; h2 < 2; ++h2) { const bf16_t* pr_ = proj + (size_t)ml_grow(b, tbn_ + r0 + 32 * h2) * ML_INP; \
            QV[h2] = *(const u32x4*)(pr_ + hh * 64 + c8 * 8); KV[h2] = *(const u32x4*)(pr_ + 512 + hh * 64 + c8 * 8); VV[h2] = *(const u32x4*)(pr_ + 1024 + hh * DV_ML + vh * 64 + c8 * 8); } \
        const float* gp_ = gsb + (size_t)(tbn_ >> 6) * 5 * 64; \
        GG[0] = gp_[lane]; GG[1] = gp_[64 + lane]; GG[2] = gp_[128 + lane]; GG[3] = gp_[192 + lane]; GG[4] = gp_[256]; GG[5] = gp_[257]; } while (0)
#define ML_WRITESET(PBW, QV, KV, VV, GG) do { LAS bf16_t* QLw = QL + (PBW) * (ML_ALT / 2); LAS bf16_t* KLw = KL + (PBW) * (ML_ALT / 2); LAS bf16_t* KETw = KET + (PBW) * (ML_ALT / 2); LAS bf16_t* VTLw = VTL + (PBW) * (ML_ALT / 2); LAS float* GLw = GL + (PBW) * (ML_ALT / 4); \
        _Pragma("unroll") for (int h2 = 0; h2 < 2; ++h2) { const int rr_ = r0 + 32 * h2, sr = dir ? 63 - rr_ : rr_; \
            *(LAS u32x4*)(QLw + sr * ML_LD + c8 * 8) = QV[h2]; *(LAS u32x4*)(KLw + sr * ML_LD + c8 * 8) = KV[h2]; \
            const float es = shfl_(GG[3], sr); float kf[8]; unpack8(KV[h2], kf); const unsigned vw[4] = {VV[h2].x, VV[h2].y, VV[h2].z, VV[h2].w}; \
            _Pragma("unroll") for (int e = 0; e < 8; ++e) { KETw[(c8 * 8 + e) * ML_LD + (sr ^ (8 * c8))] = (bf16_t)pk2(kf[e] * es, 0.f); VTLw[(c8 * 8 + e) * ML_LD + (sr ^ (8 * c8))] = (bf16_t)((vw[e >> 1] >> (16 * (e & 1))) & 0xffffu); } } \
        if (w == 0) { GLw[lane] = GG[0]; GLw[64 + lane] = GG[1]; GLw[128 + lane] = GG[2]; if (lane == 0) { GLw[192] = GG[4]; GLw[193] = GG[5]; } } } while (0)
#define ML_STOREH(cp) do { const int tbp_ = ML_TB(cp); \
        _Pragma("unroll") for (int h2 = 0; h2 < 2; ++h2) { const int rr_ = r0 + 32 * h2; \
            *(u32x4*)(hout + (size_t)ml_grow(b, tbp_ + rr_) * D + c8 * 8) = *(const LAS u32x4*)(HL + rr_ * ML_LD + c8 * 8); } } while (0)
#define ML_CHUNK(c, PB, QV, KV, VV, GG) do {     \
        const int tb = ML_TB(c); \
        LAS bf16_t* QLc = QL + (PB) * (ML_ALT / 2); LAS bf16_t* KLc = KL + (PB) * (ML_ALT / 2); LAS bf16_t* KETc = KET + (PB) * (ML_ALT / 2); LAS bf16_t* VTLc = VTL + (PB) * (ML_ALT / 2); LAS float* GLc = GL + (PB) * (ML_ALT / 4); \
        const float cum = GLc[lane], av = GLc[64 + lane], pmax = GLc[128 + lane], cl = GLc[192], ml = GLc[193]; \
        const float Mv = fmaxf(m0, pmax); \
        const float winter = __expf(m0 - Mv); \
        const float floorv = __expf(-(cum + Mv)); \
        const float mnew = fmaxf(cl + m0, ml); \
        const float Ac = __expf(cl + m0 - mnew), Gc = __expf(ml - mnew); \
        _Pragma("unroll") for (int x = 0; x < 2; ++x) { \
            const int bs = bc0 + x; \
            if (bs <= bt) {     \
                f32x4 acc = (f32x4){0.f, 0.f, 0.f, 0.f}; \
                _Pragma("unroll") for (int ks = 0; ks < 2; ++ks) { const bf16x8 af = *(const LAS bf16x8*)(QLc + (16 * bt + l15) * ML_LD + 32 * ks + 8 * g), bfv = *(const LAS bf16x8*)(KLc + (16 * bs + l15) * ML_LD + 32 * ks + 8 * g); \
                    acc = __builtin_amdgcn_mfma_f32_16x16x32_bf16(af, bfv, acc, 0, 0, 0); } \
                const int s = 16 * bs + l15; \
                const float a_s = shfl_(av, s); \
                _Pragma("unroll") for (int rg = 0; rg < 4; ++rg) { const int t = 16 * bt + 4 * g + rg; const float M_t = shfl_(Mv, t); \
                    const float val = (s <= t) ? acc[rg] * __expf(a_s - M_t) : 0.f; \
                    SDL[t * ML_LD + s] = (bf16_t)pk2(val, 0.f); } \
            } \
        } \
        if (loader) { if ((c) + 1 < TT / 64) ML_WRITESET(1 - (PB), QV, KV, VV, GG); if ((c) + 2 < TT / 64) ML_LOADSET((c) + 2, QV, KV, VV, GG); }     \
        PROFPT(2); __syncthreads(); PROFPT(3);                                                 \
        if (!loader && (c) > 0) ML_STOREH((c) - 1); \
        { \
            const int rr8 = 8 * w + (lane >> 3), part = lane & 7; \
            float sd[8], qf[8], kf[8]; \
            unpack8(*(const LAS u32x4*)(SDL + rr8 * ML_LD + 8 * part), sd); unpack8(*(const LAS u32x4*)(QLc + rr8 * ML_LD + 8 * part), qf); \
            unpack8(*(const LAS u32x4*)(KETc + rr8 * ML_LD + ((8 * part) ^ (8 * ((rr8 >> 3) & 7)))), kf); \
            const f32x4 n0a = *(const LAS f32x4*)(n0L + 8 * part), n0b = *(const LAS f32x4*)(n0L + 8 * part + 4); \
            float rs = ((sd[0] + sd[1]) + (sd[2] + sd[3])) + ((sd[4] + sd[5]) + (sd[6] + sd[7])); \
            float qn = qf[0] * n0a[0] + qf[1] * n0a[1] + qf[2] * n0a[2] + qf[3] * n0a[3] + qf[4] * n0b[0] + qf[5] * n0b[1] + qf[6] * n0b[2] + qf[7] * n0b[3]; \
            float dn = ((kf[0] + kf[1]) + (kf[2] + kf[3])) + ((kf[4] + kf[5]) + (kf[6] + kf[7])); \
            rs = sum8(rs); qn = sum8(qn); dn = sum8(dn); \
            const float w_r = shfl_(winter, rr8); \
            if (part == 0) denL[rr8] = rs + w_r * qn; \
            nst = Ac * nst + Gc * dn; \
        } \
        f32x4 nin[2], nit[2]; \
        _Pragma("unroll") for (int x = 0; x < 2; ++x) { \
            const int bv = bc0 + x; \
            f32x4 a1 = (f32x4){0.f, 0.f, 0.f, 0.f}, a2 = (f32x4){0.f, 0.f, 0.f, 0.f}, a3 = (f32x4){0.f, 0.f, 0.f, 0.f}; \
            _Pragma("unroll") for (int ks = 0; ks < 2; ++ks) { \
                const bf16x8 sdf = *(const LAS bf16x8*)(SDL + (16 * bt + l15) * ML_LD + 32 * ks + 8 * g), vtf = *(const LAS bf16x8*)(VTLc + (16 * bv + l15) * ML_LD + ((32 * ks + 8 * g) ^ (8 * (((16 * bv + l15) >> 3) & 7)))); \
                const bf16x8 qf = *(const LAS bf16x8*)(QLc + (16 * bt + l15) * ML_LD + 32 * ks + 8 * g), c0f = *(const LAS bf16x8*)(C0L + (16 * bv + l15) * ML_LD + 32 * ks + 8 * g); \
                const bf16x8 vt2 = *(const LAS bf16x8*)(VTLc + (16 * bt + l15) * ML_LD + ((32 * ks + 8 * g) ^ (8 * (((16 * bt + l15) >> 3) & 7)))), kef = *(const LAS bf16x8*)(KETc + (16 * bv + l15) * ML_LD + ((32 * ks + 8 * g) ^ (8 * (((16 * bv + l15) >> 3) & 7)))); \
                a1 = __builtin_amdgcn_mfma_f32_16x16x32_bf16(sdf, vtf, a1, 0, 0, 0); \
                a2 = __builtin_amdgcn_mfma_f32_16x16x32_bf16(qf, c0f, a2, 0, 0, 0); \
                a3 = __builtin_amdgcn_mfma_f32_16x16x32_bf16(vt2, kef, a3, 0, 0, 0); \
            } \
            nin[x] = a1; nit[x] = a2; \
            Cst[x] = Cst[x] * Ac + a3 * Gc; \
        } \
        PROFPT(4); __syncthreads(); PROFPT(3);                                                 \
        if ((lane & 7) == 0) n0L[8 * w + (lane >> 3)] = nst; \
        _Pragma("unroll") for (int x = 0; x < 2; ++x) { \
            const int bv = bc0 + x; \
            _Pragma("unroll") for (int rg = 0; rg < 4; ++rg) { const int t = 16 * bt + 4 * g + rg; \
                const float den = denL[t], w_t = shfl_(winter, t), fl_t = shfl_(floorv, t); \
                const float hv = (nin[x][rg] + w_t * nit[x][rg]) * __builtin_amdgcn_rcpf(fmaxf(fabsf(den), fl_t)); \
                const int rr = dir ? 63 - t : t; \
                HL[rr * ML_LD + 16 * bv + l15] = (bf16_t)pk2(hv, 0.f); \
                C0L[(16 * bt + 4 * g + rg) * ML_LD + 16 * bv + l15] = (bf16_t)pk2(Cst[x][rg], 0.f); } \
        } \
        m0 = mnew; \
        (void)tb; PROFPT(5); \
    } while (0)
    if (loader) { ML_LOADSET(0, qA, kA, vA, gA); ML_WRITESET(0, qA, kA, vA, gA); ML_LOADSET(1, qA, kA, vA, gA); }
    __syncthreads();
    for (int c = 0; c < TT / 64; c += 2) {
        ML_CHUNK(c, 0, qA, kA, vA, gA);
        ML_CHUNK(c + 1, 1, qA, kA, vA, gA);
    }
    __syncthreads();
    if (!loader) ML_STOREH(TT / 64 - 1);
#ifdef MLPROF
    if (F.vcu == MLPROF_BLK && tid == MLPROF_WAVE * 64) { unsigned long long* pp = (unsigned long long*)(wsp(F) + WS_CTL + 524288); pp[0] = pa_[0]; pp[1] = pa_[1]; pp[2] = pa_[2]; pp[3] = pa_[3]; pp[4] = pa_[4]; pp[5] = pa_[5]; }
#endif
#undef ML_CHUNK
#undef ML_STOREH
#undef ML_WRITESET
#undef ML_LOADSET
#undef ML_TB
    __syncthreads();
}
__device__ __forceinline__ void phase_ml_scan(Frame& F, int jm) {
    for (int task = F.vcu; task < NB * NH_ML * 4; task += F.G) {
        const int vh = task & 1, dir = (task >> 1) & 1, bh = task >> 2;
        ml_task(F, jm, bh >> 3, bh & 7, dir, vh);
    }
}

__device__ __forceinline__ void phase_ml_final(Frame& F, int jm) {
    const int gw = F.vcu * NWAVES + F.wave, NGW = F.G * NWAVES, lane = F.lane;
    const bf16_t* hfw = (const bf16_t*)(wsp(F) + WS_HDIR); const bf16_t* hbw = hfw + (size_t)ROWS * D;
    const bf16_t* proj = (const bf16_t*)(wsp(F) + WS_PROJ);
    bf16_t* ao = (bf16_t*)(wsp(F) + WS_AO);
    const float* gain = inp(F, I_MHGAIN) + jm * D + lane * 16;
    for (int row = gw; row < ROWS; row += NGW) {
        const size_t off = (size_t)row * D + lane * 16;
        float a0[8], a1[8], b0[8], b1[8], g0[8], g1[8];
        unpack8(*(const u32x4*)(hfw + off), a0); unpack8(*(const u32x4*)(hfw + off + 8), a1);
        unpack8(*(const u32x4*)(hbw + off), b0); unpack8(*(const u32x4*)(hbw + off + 8), b1);
        const bf16_t* ogp = proj + (size_t)row * ML_INP + 2048 + lane * 16;
        unpack8(*(const u32x4*)ogp, g0); unpack8(*(const u32x4*)(ogp + 8), g1);
        float ss = 0.f;
#pragma unroll
        for (int e = 0; e < 8; ++e) { a0[e] += b0[e]; a1[e] += b1[e]; ss += a0[e] * a0[e] + a1[e] * a1[e]; }
        ss = sum8(ss);
        const float rs = 1.0f / sqrtf(ss * (1.f / DV_ML) + EPS);
        float o0[8], o1[8];
#pragma unroll
        for (int e = 0; e < 8; ++e) { o0[e] = a0[e] * rs * gain[e] * sigmoidf_(g0[e]); o1[e] = a1[e] * rs * gain[8 + e] * sigmoidf_(g1[e]); }
        *(u32x4*)(ao + off) = pack8(o0); *(u32x4*)(ao + off + 8) = pack8(o1);
    }
}

constexpr int RT_LD = 1032;
constexpr int RT_HI = 0, RT_LO = NE * RT_LD * 2, RT_LG = 2 * NE * RT_LD * 2;
__device__ __forceinline__ int rows_per_block(int first_row, int G) { return (ROWS - first_row + G - 1) / G; }
constexpr int NCB = 32;
__device__ __forceinline__ bool ctx_split(int first_row, int G) { return first_row == 0 && G > 2 * NCB; }
__device__ __forceinline__ void block_rows(int first_row, int vcu, int G, int& rbeg, int& rend) {
    if (ctx_split(first_row, G)) {
        if (vcu < NCB) { const int per = ROWS_CTX / NCB; rbeg = vcu * per; rend = rbeg + per; }
        else { const int per = (ROWS - ROWS_CTX + (G - NCB) - 1) / (G - NCB); rbeg = min(ROWS_CTX + (vcu - NCB) * per, ROWS); rend = min(rbeg + per, ROWS); }
    } else { const int RPB = rows_per_block(first_row, G); rbeg = min(first_row + vcu * RPB, ROWS); rend = min(rbeg + RPB, ROWS); }
}
__device__ __forceinline__ void phase_norm2_router(Frame& F, int l, int first_row) {
    const int tid = F.tid, lane = F.lane, wave = F.wave, l15 = lane & 15, g = lane >> 4;
    LAS bf16_t* whi = (LAS bf16_t*)(F.lds + RT_HI); LAS bf16_t* wlo = (LAS bf16_t*)(F.lds + RT_LO);
    LAS float* lgs = (LAS float*)(F.lds + RT_LG) + wave * (16 * 33);
    volatile LAS int* cntL = F.LCTL + 64;
    {
        const bf16_t* rt = (const bf16_t*)(wsp(F) + WS_RT) + (size_t)l * 2 * NE * D;
#pragma unroll 4
        for (int c = tid; c < 2 * NE * 128; c += NTHREADS) { const int tbl = c >> 12, e = (c >> 7) & 31, kc = c & 127;
            *(LAS u32x4*)((tbl ? wlo : whi) + e * RT_LD + kc * 8) = *(const u32x4*)(rt + ((size_t)tbl * NE + e) * D + kc * 8); }
    }
    if (tid < NE) cntL[tid] = 0;
    const bf16_t* xs = (const bf16_t*)(wsp(F) + WS_XS); bf16_t* hb = (bf16_t*)(wsp(F) + WS_HB);
    int* tope = (int*)(wsp(F) + WS_TOPE); float* topw = (float*)(wsp(F) + WS_TOPW);
    const f32x4* gm = (const f32x4*)(inp(F, I_GFFN) + l * D) + lane;
    int rbeg, rend; block_rows(first_row, F.vcu, F.G, rbeg, rend);
    for (int row = rbeg + wave; row < rend; row += NWAVES) {
        const int mb = row_mb(row);
        const u32x2* xr = (const u32x2*)(xs + (size_t)row * D) + lane;
        f32x4 v[4]; float ss = 0.f;
#pragma unroll
        for (int j = 0; j < 4; ++j) { v[j] = bf4_to_f32(xr[64 * j]); ss += (v[j][0] * v[j][0] + v[j][1] * v[j][1]) + (v[j][2] * v[j][2] + v[j][3] * v[j][3]); }
        const float rs = 1.0f / sqrtf(wave_sum(ss) * (1.f / D) + EPS);
        const f32x4* sh = (const f32x4*)modp(F, l, mb, 3) + lane; const f32x4* sc = (const f32x4*)modp(F, l, mb, 4) + lane;
        u32x2* o8 = (u32x2*)(hb + (size_t)row * D) + lane;
        unsigned* o4 = (unsigned*)(wsp(F) + WS_HB8 + (size_t)row * D) + lane;
#pragma unroll
        for (int j = 0; j < 4; ++j) { const f32x4 h = (v[j] * rs) * gm[64 * j] * (sc[64 * j] + 1.0f) + sh[64 * j];
            u32x2 wv; wv.x = pk2(h[0], h[1]); wv.y = pk2(h[2], h[3]); o8[64 * j] = wv;
            const f32x4 hq = __builtin_elementwise_min(__builtin_elementwise_max(h * 16.0f, (f32x4){-448.f, -448.f, -448.f, -448.f}), (f32x4){448.f, 448.f, 448.f, 448.f});
            o4[64 * j] = pk4_fp8(hq[0], hq[1], hq[2], hq[3]); }
    }
    VM_WAIT();
    __syncthreads();
    const float br0 = inp(F, I_BR)[l * NE + l15], br1 = inp(F, I_BR)[l * NE + 16 + l15];
    for (int g0 = rbeg + 16 * wave; g0 < rend; g0 += 16 * NWAVES) {
        const int arow = min(g0 + l15, rend - 1);
        const bf16_t* ap = hb + (size_t)arow * D + 8 * g;
        f32x4 acc0 = (f32x4){0.f, 0.f, 0.f, 0.f}, acc1 = (f32x4){0.f, 0.f, 0.f, 0.f};
        bf16x8 afr[32];
#pragma unroll
        for (int ks = 0; ks < 32; ++ks) afr[ks] = *(const bf16x8*)(ap + 32 * ks);
#pragma unroll
        for (int ks = 0; ks < 32; ++ks) {
            const bf16x8 af = afr[ks];
            const bf16x8 h0 = *(const LAS bf16x8*)(whi + l15 * RT_LD + 32 * ks + 8 * g), h1 = *(const LAS bf16x8*)(whi + (16 + l15) * RT_LD + 32 * ks + 8 * g);
            const bf16x8 l0 = *(const LAS bf16x8*)(wlo + l15 * RT_LD + 32 * ks + 8 * g), l1 = *(const LAS bf16x8*)(wlo + (16 + l15) * RT_LD + 32 * ks + 8 * g);
            acc0 = __builtin_amdgcn_mfma_f32_16x16x32_bf16(af, h0, acc0, 0, 0, 0); acc1 = __builtin_amdgcn_mfma_f32_16x16x32_bf16(af, h1, acc1, 0, 0, 0);
            acc0 = __builtin_amdgcn_mfma_f32_16x16x32_bf16(af, l0, acc0, 0, 0, 0); acc1 = __builtin_amdgcn_mfma_f32_16x16x32_bf16(af, l1, acc1, 0, 0, 0);
        }
#pragma unroll
        for (int rg = 0; rg < 4; ++rg) { lgs[(4 * g + rg) * 33 + l15] = acc0[rg] + br0; lgs[(4 * g + rg) * 33 + 16 + l15] = acc1[rg] + br1; }
        LDS_WAIT(); asm volatile("" ::: "memory");
        const int row = g0 + lane;
        if (lane < 16 && row < rend) {
            float lg[32];
#pragma unroll
            for (int e = 0; e < 32; ++e) lg[e] = lgs[lane * 33 + e];
            int sel[4]; float sv[4]; unsigned used = 0u;
#pragma unroll
            for (int k = 0; k < 4; ++k) { float best = -3.0e38f; int bi = 0;
#pragma unroll
                for (int e = 0; e < 32; ++e) { const bool take = !((used >> e) & 1u) && (lg[e] > best); best = take ? lg[e] : best; bi = take ? e : bi; }
                used |= 1u << bi; sel[k] = bi; sv[k] = best; }
            const float e1 = __expf(sv[1] - sv[0]), e2 = __expf(sv[2] - sv[0]), e3 = __expf(sv[3] - sv[0]);
            const float inv = 1.0f / (1.0f + e1 + e2 + e3);
            *(int4*)(tope + (size_t)row * 4) = make_int4(sel[0], sel[1], sel[2], sel[3]);
            *(float4*)(topw + (size_t)row * 4) = make_float4(inv, e1 * inv, e2 * inv, e3 * inv);
#pragma unroll
            for (int k = 0; k < 4; ++k) __hip_atomic_fetch_add((LAS int*)&cntL[sel[k]], 1, __ATOMIC_RELAXED, __HIP_MEMORY_SCOPE_WORKGROUP);
        }
        LDS_WAIT(); asm volatile("" ::: "memory");
    }
    __syncthreads();
    if (tid < NE) ((int*)(wsp(F) + WS_CNT))[F.vcu * NE + tid] = cntL[tid];
}

__device__ __forceinline__ void phase_positions(Frame& F, int first_row) {
    const int tid = F.tid, lane = F.lane;
    LAS int* tot = (LAS int*)F.lds;
    LAS int* bef = tot + 512;
    LAS int* baseL = bef + 512;
    LAS int* totL = baseL + 32;
    const int* cnt = (const int*)(wsp(F) + WS_CNT);
    {
        const int e = tid & 31, part = tid >> 5;
        int s = 0, sb = 0;
        for (int j = part; j < F.G; j += 16) { const int cv = cnt[j * NE + e]; s += cv; sb += (j < F.vcu) ? cv : 0; }
        tot[part * 32 + e] = s; bef[part * 32 + e] = sb;
    }
    __syncthreads();
    if (tid < NE) { int s = 0, sb = 0;
        for (int p = 0; p < 16; ++p) { s += tot[p * 32 + tid]; sb += bef[p * 32 + tid]; }
        totL[tid] = s; baseL[tid] = sb; }
    __syncthreads();
    if (F.wave == 0) {
        const int mine = (lane < NE) ? ((totL[lane & 31] + 255) >> 8) : 0;
        int inc = mine;
#pragma unroll
        for (int d = 1; d < 32; d <<= 1) { const int o = shfl_(inc, lane - d); inc += (lane >= d) ? o : 0; }
        if (lane < NE) F.LCTL[8 + lane] = inc - mine;
        if (lane == NE - 1) { F.LCTL[8 + NE] = inc; F.LCTL[48] = inc; }
    }
    __syncthreads();
    int* tokmap = (int*)(wsp(F) + WS_TOKMAP);
    if (F.vcu == 0) {
        int* meta = (int*)(wsp(F) + WS_META);
        if (tid <= NE) meta[tid] = F.LCTL[8 + tid];
        if (tid == 0) meta[33] = F.LCTL[48];
        { const int e = tid >> 4, rb = 256 * F.LCTL[8 + e], n = totL[e], cap = 256 * (F.LCTL[8 + e + 1] - F.LCTL[8 + e]);
            for (int rr = n + (tid & 15); rr < cap; rr += 16) tokmap[rb + rr] = first_row; }
    }
    {
        const int* tope = (const int*)(wsp(F) + WS_TOPE); int* pos = (int*)(wsp(F) + WS_POS);
        const int e0 = 4 * F.wave;
        int basereg = (lane < 4) ? 256 * F.LCTL[8 + e0 + lane] + baseL[e0 + lane] : 0;
        int rbeg, rend; block_rows(first_row, F.vcu, F.G, rbeg, rend);
        for (int r0 = rbeg; r0 < rend; r0 += 16) {
            const int row = r0 + (lane >> 2), k = lane & 3;
            const bool valid = row < rend;
            const int e = valid ? tope[(size_t)row * 4 + k] : -1;
            int p = -1;
#pragma unroll
            for (int j = 0; j < 4; ++j) {
                const unsigned long long mask = __ballot(e == e0 + j);
                const int b0 = shfl_(basereg, j);
                if (e == e0 + j) p = b0 + __popcll(mask & ((1ull << lane) - 1ull));
                if (lane == j) basereg += __popcll(mask);
            }
            if (p >= 0) { pos[(size_t)row * 4 + k] = p; tokmap[p] = row; }
        }
    }
}

#ifndef PMASK
#define PMASK 0xFFFF
#endif
#define PE(k) (((PMASK) >> (k)) & 1)
#ifndef RMASK
#define RMASK 0
#endif
#define RP(k) for (int rep_ = 0; rep_ < ((((RMASK) >> (k)) & 1) ? 2 : 1); ++rep_, __syncthreads())
#ifdef NOEPI
#define SKIPE(k) ((((RMASK) >> (k)) & 1) && rep_ == 0)
#else
#define SKIPE(k) false
#endif
#ifndef P0PROBE
#define P0PROBE 0
#endif
#ifndef MOE_ALIGN
#define MOE_ALIGN true
#endif
constexpr int LDS_TILE_E = pg8::STAGE_BYTES;
constexpr int LDS_TOKL = LDS_TILE_E + MAXTILES * 4;
static_assert(LDS_TOKL + 28 * 1024 <= LDS_CTL_OFF, "LDS map");
__device__ __forceinline__ void moe_tile_table(const Frame& P, const int ntiles) {
    volatile LAS int* te = (volatile LAS int*)(P.lds + LDS_TILE_E);
    for (int t = P.tid; t < ntiles; t += NTHREADS) { int e = 0;
#pragma unroll
        for (int j = 1; j < NE; ++j) e += (P.LCTL[8 + j] <= t) ? 1 : 0;
        te[t] = e; }
    __syncthreads();
}
constexpr int NPH_LAYER = 10, GP_FINAL = 1 + DEPTH * NPH_LAYER, NPHASES = GP_FINAL + 1;
__global__ void __launch_bounds__(NTHREADS, 2) mega_fwd(Args args) {
    extern __shared__ __attribute__((aligned(16))) unsigned char lds_raw[];
    Frame F0;
    Frame& F = F0;
    F.lds = (LAS unsigned char*)lds_raw;
    F.LCTL = (volatile LAS int*)(F.lds + LDS_CTL_OFF);
    F.tid = threadIdx.x; F.lane = F.tid & 63; F.wave = __builtin_amdgcn_readfirstlane(F.tid >> 6);
    F.G = gridDim.x; { const int bx = blockIdx.x; F.vcu = (F.G % 8 == 0) ? (bx % 8) * (F.G / 8) + bx / 8 : bx; }
    if (F.tid < 128) F.LCTL[F.tid] = 0;
    if (F.tid == 0) {
#pragma unroll
        for (int i = 0; i < 23; ++i) { const unsigned long long p = (unsigned long long)args.in[i]; F.LCTL[128 + 2 * i] = (int)(unsigned)p; F.LCTL[129 + 2 * i] = (int)(unsigned)(p >> 32); }
        { const unsigned long long p = (unsigned long long)args.ws; F.LCTL[128 + 46] = (int)(unsigned)p; F.LCTL[129 + 46] = (int)(unsigned)(p >> 32); }
        { const unsigned long long p = (unsigned long long)args.out; F.LCTL[128 + 48] = (int)(unsigned)p; F.LCTL[129 + 48] = (int)(unsigned)(p >> 32); }
    }
    __syncthreads();
    const int lo = args.ph_lo, hi = args.ph_hi;
    XcdBarrier bar; bar.bar = (unsigned*)(wsp(F) + WS_CTL) + CW_BAR; bar.x = 0; bar.st = nullptr; bar.w0 = 0;
    if (hi - lo > 1) bar = xcd_barrier_post((unsigned*)(wsp(F) + WS_CTL) + CW_BAR, (volatile LAS unsigned*)F.LCTL);
#define IN(k) (lo <= (k) && (k) < hi)
#define FRESH(FN) Frame FN = F0; { int tz_ = F0.wave * 64 + lane_id_here(), vc_ = F0.vcu, g_ = F0.G;     asm volatile("" : "+v"(tz_)); asm volatile("" : "+s"(vc_), "+s"(g_)); FN.tid = tz_; FN.lane = tz_ & 63; FN.wave = __builtin_amdgcn_readfirstlane(tz_ >> 6); FN.vcu = vc_; FN.G = g_; }
#ifdef DBLBAR
#define SEAM(k) do { if (IN(k) && IN((k) + 1)) { xcd_barrier(bar); xcd_barrier(bar); } } while (0)
#else
#define SEAM(k) do { if (IN(k) && IN((k) + 1)) xcd_barrier(bar); } while (0)
#endif

    if (PE(0) && IN(0)) RP(0) { FRESH(P); phase0(P, ((((RMASK) >> 0) & 1) && rep_ == 0) ? P0PROBE : 0); }
    SEAM(0);
    for (int l = 0; l < DEPTH; ++l) {
        const int base = 1 + l * NPH_LAYER; const bool na = (l & 1) == 0, last = (l == DEPTH - 1); const int jj = l >> 1;
        if (PE(1) && IN(base + 0)) RP(1) { FRESH(P); phase_norm1(P, l, (((RMASK) >> 1) & 1) && rep_ == 0); }
        SEAM(base + 0);
        if (PE(2) && IN(base + 1)) RP(2) {
            FRESH(P);
            if (na) {
                const bf16_t* Bt = (const bf16_t*)(wsp(P) + WS_WQKV) + (size_t)jj * 3072 * D;
                const bool img_only = proj_split(P.G);
                DenseOrder S; S.init(img_only ? ROWS_CTX / 256 : 0, img_only ? (ROWS - ROWS_CTX) / 256 : ROWS / 256, 3072 / 256, P.G, (int)blockIdx.x, wsp(P) + WS_HB, Bt, D);
                EpiStoreBf16 E{(bf16_t*)(wsp(P) + WS_PROJ), 3072};
                pg8::gemm_phase<EpiStoreBf16, DenseOrder, false>(P.lds, P.tid, D, S, E, SKIPE(2));
            } else {
                const bf16_t* Bt = (const bf16_t*)(wsp(P) + WS_WIN) + (size_t)jj * ML_INP * D;
                DenseOrder S; S.init(0, ROWS / 256, ML_INP / 256, P.G, (int)blockIdx.x, wsp(P) + WS_HB, Bt, D);
                EpiProjML E{(bf16_t*)(wsp(P) + WS_PROJ), (const float*)(wsp(P) + WS_ROPE)};
                pg8::gemm_phase<EpiProjML, DenseOrder, false>(P.lds, P.tid, D, S, E, SKIPE(2));
            }
        }
        SEAM(base + 1);
        if (IN(base + 2) && na && PE(3)) {
            FRESH(P);
            if (proj_split(P.G) && P.vcu < NCBP) {
                const bf16_t* Bt = (const bf16_t*)(wsp(P) + WS_WQKV) + (size_t)jj * 3072 * D;
                DenseOrder S; S.init(0, ROWS_CTX / 256, 3072 / 256, NCBP, P.vcu, wsp(P) + WS_HB, Bt, D);
                EpiStoreBf16 E{(bf16_t*)(wsp(P) + WS_PROJ), 3072};
                pg8::gemm_phase<EpiStoreBf16, DenseOrder, false>(P.lds, P.tid, D, S, E);
                group_sync((unsigned*)(wsp(P) + WS_CTL) + CW_GSYNC + 64 * (DEPTH + l), NCBP, (unsigned*)(wsp(P) + WS_CTL) + CW_BAR, P.wave == 0);
            }
        }
        if (IN(base + 2)) { if (na) {   } else {   } }
        if (IN(base + 3)) { if (na) { if (PE(5)) RP(5) { FRESH(P); phase_na_attn(P, jj); } } else { if (PE(6)) RP(6) { FRESH(P); phase_ml_scan(P, jj); } } }
        SEAM(base + 3);
        if (PE(7) && IN(base + 4)) { if (!na) RP(7) { FRESH(P); phase_ml_final(P, jj); } }
        if (!na) SEAM(base + 4);
        if (PE(8) && IN(base + 5)) RP(8) {
            FRESH(P);
            const bf16_t* Bt = na ? (const bf16_t*)(wsp(P) + WS_WONA) + (size_t)jj * D * D : (const bf16_t*)(wsp(P) + WS_WOML) + (size_t)jj * D * D;
            const bool img_only = last || ctx_split(0, P.G);
            DenseOrder S; S.init(img_only ? ROWS_CTX / 256 : 0, img_only ? (ROWS - ROWS_CTX) / 256 : ROWS / 256, D / 256, P.G, (int)blockIdx.x, wsp(P) + WS_AO, Bt, D);
            EpiResid E{((((RMASK) >> 8) & 1) && rep_ == 0) ? (bf16_t*)(wsp(P) + WS_Y) : (bf16_t*)(wsp(P) + WS_XS), (const float*)(wsp(P) + WS_MOD) + (size_t)l * 9 * 6144 + 2 * D};
            pg8::gemm_phase<EpiResid, DenseOrder, false>(P.lds, P.tid, D, S, E, SKIPE(8));
        }
        SEAM(base + 5);
        if (PE(9) && IN(base + 6) && !last) {
            FRESH(P);
            if (ctx_split(0, P.G) && P.vcu < NCB) {
                const bf16_t* Bt = na ? (const bf16_t*)(wsp(P) + WS_WONA) + (size_t)jj * D * D : (const bf16_t*)(wsp(P) + WS_WOML) + (size_t)jj * D * D;
                DenseOrder S; S.init(0, ROWS_CTX / 256, D / 256, NCB, P.vcu, wsp(P) + WS_AO, Bt, D);
                EpiResid E{(bf16_t*)(wsp(P) + WS_XS), (const float*)(wsp(P) + WS_MOD) + (size_t)l * 9 * 6144 + 2 * D};
                pg8::gemm_phase<EpiResid, DenseOrder, false>(P.lds, P.tid, D, S, E);
                group_sync((unsigned*)(wsp(P) + WS_CTL) + CW_GSYNC + 64 * l, NCB, (unsigned*)(wsp(P) + WS_CTL) + CW_BAR, P.wave == 0);
            }
        }
        if (PE(9) && IN(base + 6)) RP(9) { FRESH(P); phase_norm2_router(P, l, last ? ROWS_CTX : 0); }
        SEAM(base + 6);
        if (PE(10) && IN(base + 7)) RP(10) { FRESH(P); phase_positions(P, last ? ROWS_CTX : 0); }
        SEAM(base + 7);
        if (PE(11) && IN(base + 8)) RP(11) {
            FRESH(P);
            if (P.tid < 34) P.LCTL[8 + P.tid] = ((const int*)(wsp(P) + WS_META))[P.tid];
            __syncthreads();
            const int ntiles = P.LCTL[8 + NE];
            moe_tile_table(P, ntiles);
            MoeOrder S; S.NT = 8; S.nunits = ntiles * 8; S.G = P.G; S.c = (int)blockIdx.x; S.K = D / 2; S.A = (const char*)(wsp(P) + WS_HB8);
            S.W = (const char*)(wsp(P) + WS_W1T) + (size_t)l * NE * 2048 * D; S.estride = (size_t)2048 * D; S.tokmap = (const int*)(wsp(P) + WS_TOKMAP); S.prefix = P.LCTL + 8; S.tile_e = (volatile LAS int*)(P.lds + LDS_TILE_E); S.tokl = (volatile LAS int*)(P.lds + LDS_TOKL); S.gather = true;
            { const int half = P.wave >> 2, r = P.tid & 255;
              for (int i = half; i < 28; i += 2) { pg8::Unit u; if (!S.next(i, u)) break; S.tokl[i * 256 + r] = S.tokmap[u.pm * 256 + r]; }
              __syncthreads(); }
            EpiSwiglu E{(unsigned char*)(wsp(P) + WS_ACT), inp(P, I_B1) + (size_t)l * NE * 2048};
#ifdef KPROBE
            if (SKIPE(11)) pg8::gemm_phase<EpiSwiglu, MoeOrder, true, true, MOE_ALIGN, KPROBE>(P.lds, P.tid, D / 2, S, E, true); else
#endif
            pg8::gemm_phase<EpiSwiglu, MoeOrder, true, true, MOE_ALIGN>(P.lds, P.tid, D / 2, S, E, SKIPE(11));
        }
        SEAM(base + 8);
        if (PE(12) && IN(base + 9)) RP(12) {
            FRESH(P);
            if (P.tid < 34) P.LCTL[8 + P.tid] = ((const int*)(wsp(P) + WS_META))[P.tid];
            __syncthreads();
            const int ntiles = P.LCTL[8 + NE];
            moe_tile_table(P, ntiles);
            MoeOrder S; S.NT = 4; S.nunits = ntiles * 4; S.G = P.G; S.c = (int)blockIdx.x; S.K = D / 2; S.A = (const char*)(wsp(P) + WS_ACT);
            S.W = (const char*)(wsp(P) + WS_W2T) + (size_t)l * NE * D * D; S.estride = (size_t)D * D; S.tokmap = (const int*)(wsp(P) + WS_TOKMAP); S.prefix = P.LCTL + 8; S.tile_e = (volatile LAS int*)(P.lds + LDS_TILE_E); S.tokl = (volatile LAS int*)(P.lds + LDS_TOKL); S.gather = false;
            EpiY E{(bf16_t*)(wsp(P) + WS_Y), inp(P, I_B2) + (size_t)l * NE * D};
            pg8::gemm_phase<EpiY, MoeOrder, true, true, MOE_ALIGN>(P.lds, P.tid, D / 2, S, E, SKIPE(12));
        }
        SEAM(base + 9);
    }
    if (PE(13) && IN(GP_FINAL)) RP(13) { FRESH(P); phase_final(P); }
#undef IN
#undef SEAM
}

extern "C" void kernel_launch(void* const* d_in, const int* in_sizes, int n_in, void* d_out, int out_size, void* d_ws, size_t ws_size, hipStream_t stream) {
    static int grid = 0;
    if (grid == 0) {
        if (n_in != 23 || ws_size < WS_END) { fprintf(stderr, "kernel_launch: expected 23 inputs and >= %zu bytes of workspace (got %d, %zu)\n", (size_t)WS_END, n_in, ws_size); grid = -1; return; }
        int dev = 0, cus = 0, per_cu = 0;
        if (hipGetDevice(&dev) != hipSuccess || hipDeviceGetAttribute(&cus, hipDeviceAttributeMultiprocessorCount, dev) != hipSuccess) { grid = -1; return; }
        if (hipFuncSetAttribute((const void*)mega_fwd, hipFuncAttributeMaxDynamicSharedMemorySize, LDS_BYTES) != hipSuccess) { fprintf(stderr, "kernel_launch: hipFuncSetAttribute failed\n"); grid = -1; return; }
        if (hipOccupancyMaxActiveBlocksPerMultiprocessor(&per_cu, (const void*)mega_fwd, NTHREADS, LDS_BYTES) != hipSuccess || per_cu < 1)
            fprintf(stderr, "kernel_launch: occupancy query reports %d workgroups per CU\n", per_cu);
        (void)hipGetLastError();
        grid = cus;
        if (grid > 1024) grid = 1024;
    }
    if (grid < 0) return;
    (void)hipMemsetAsync((char*)d_ws + WS_CTL, 0, CTL_BYTES, stream);
    Args a{};
    for (int i = 0; i < 23; ++i) a.in[i] = (const float*)d_in[i];
    a.out = (float*)d_out; a.ws = (unsigned char*)d_ws;
#if MK_ONE_LAUNCH
    a.ph_lo = 0; a.ph_hi = NPHASES;
    hipLaunchKernelGGL(mega_fwd, dim3(grid), dim3(NTHREADS), LDS_BYTES, stream, a);
#else
    for (int gp = 0; gp < NPHASES; ++gp) {
        if (gp >= 1 && gp < GP_FINAL) { const int l = (gp - 1) / NPH_LAYER, p = (gp - 1) % NPH_LAYER; if (p == 4 && (l & 1) == 0) continue; }
        a.ph_lo = gp; a.ph_hi = gp + 1;
        hipLaunchKernelGGL(mega_fwd, dim3(grid), dim3(NTHREADS), LDS_BYTES, stream, a);
    }
#endif
    const hipError_t le = hipPeekAtLastError();
    if (le != hipSuccess) fprintf(stderr, "kernel_launch: launch failed: %s\n", hipGetErrorName(le));
}
```

```cpp
#include <hip/hip_runtime.h>
#include <cstdio>
#include <cstdint>

#ifndef MK_ONE_LAUNCH
#define MK_ONE_LAUNCH 1
#endif

#define LAS __attribute__((address_space(3)))
#define GAS __attribute__((address_space(1)))
typedef unsigned short bf16_t;
typedef short bf16x8 __attribute__((ext_vector_type(8)));
typedef short bf16x4 __attribute__((ext_vector_type(4)));
typedef float f32x4 __attribute__((ext_vector_type(4)));
typedef float f32x2 __attribute__((ext_vector_type(2)));
typedef unsigned u32x4 __attribute__((ext_vector_type(4)));
typedef unsigned u32x2 __attribute__((ext_vector_type(2)));

constexpr int D = 1024, NB = 8, SEQ = 4096, NCTX = 256, TT = NCTX + SEQ  , DEPTH = 4;
constexpr int ROWS_CTX = NB * NCTX  , ROWS = ROWS_CTX + NB * SEQ  ;
constexpr int NH_NA = 16, DH_NA = 64;
constexpr int NH_ML = 8, DV_ML = 128, DK_ML = 64, ML_IN = 3104, ML_INP = 3328;
constexpr int NE = 32, TOPK = 4, DFF = 1024;
constexpr int MAXTILES = (ROWS * TOPK) / 256 + NE  , MAXROWS = MAXTILES * 256;
constexpr float EPS = 1e-6f;
constexpr int NWAVES = 8, NTHREADS = 512;

constexpr size_t MiB = 1u << 20;
constexpr size_t al256(size_t x) { return (x + 255) & ~(size_t)255; }
constexpr size_t WS_CTL = 0, CTL_BYTES = 1 * MiB;
constexpr size_t WS_MOD = WS_CTL + CTL_BYTES;
constexpr size_t WS_ROPE = WS_MOD + al256((size_t)DEPTH * 9 * 6 * D * 4);
constexpr size_t WS_WQKV = WS_ROPE + al256(64 * 16 * 2 * 4);
constexpr size_t WS_WONA = WS_WQKV + (size_t)2 * 3072 * D * 2;
constexpr size_t WS_WIN = WS_WONA + (size_t)2 * D * D * 2;
constexpr size_t WS_WOML = WS_WIN + (size_t)2 * ML_INP * D * 2;
constexpr size_t WS_W1T = WS_WOML + (size_t)2 * D * D * 2;
constexpr size_t WS_W2T = WS_W1T + (size_t)DEPTH * NE * 2048 * D * 2;
constexpr size_t WS_XS = WS_W2T + (size_t)DEPTH * NE * D * D * 2;
constexpr size_t WS_HB = WS_XS + (size_t)ROWS * D * 4;
constexpr size_t WS_PROJ = WS_HB + (size_t)ROWS * D * 2;
constexpr size_t WS_QN = WS_PROJ + (size_t)ROWS * ML_INP * 2;
constexpr size_t WS_KN = WS_QN + (size_t)ROWS * D * 2;
constexpr size_t WS_VT = WS_KN + (size_t)ROWS * D * 2;
constexpr size_t WS_AO = WS_VT + (size_t)ROWS * D * 2;
constexpr size_t WS_HDIR = WS_QN;
constexpr size_t WS_GATES = WS_AO + (size_t)ROWS * D * 2;
constexpr size_t WS_TOPE = WS_GATES + al256((size_t)4 * NB * NH_ML * TT * 4);
constexpr size_t WS_TOPW = WS_TOPE + (size_t)ROWS * 4 * 4;
constexpr size_t WS_POS = WS_TOPW + (size_t)ROWS * 4 * 4;
constexpr size_t WS_TOKMAP = WS_POS + (size_t)ROWS * 4 * 4;
constexpr size_t WS_CNT = WS_TOKMAP + (size_t)MAXROWS * 4;
constexpr size_t WS_META = WS_CNT + (size_t)1024 * 32 * 4;
constexpr size_t WS_ACT = WS_META + 256;
constexpr size_t WS_Y = WS_ACT + (size_t)MAXROWS * D * 2;
constexpr size_t WS_HB8 = WS_Y + (size_t)MAXROWS * D * 2;
constexpr size_t WS_GS = WS_HB8 + (size_t)ROWS * D;
constexpr size_t WS_RT = WS_GS + (size_t)2 * NB * NH_ML * (TT / 64) * 5 * 64 * 4;
constexpr size_t WS_END = WS_RT + (size_t)DEPTH * 2 * NE * D * 2;
static_assert(WS_XS % 256 == 0 && WS_ACT % 256 == 0 && WS_TOPE % 256 == 0, "ws alignment");

constexpr int CW_BAR = 4096;
constexpr int CW_GSYNC = 8192;

constexpr int LDS_BYTES = 160 * 1024;
constexpr int LDS_CTL_OFF = LDS_BYTES - 1024;
constexpr int LDS_WORK = LDS_CTL_OFF;

__device__ __forceinline__ int lane_id_here() { int l; asm volatile("v_mbcnt_lo_u32_b32 %0, -1, 0\n\tv_mbcnt_hi_u32_b32 %0, -1, %0" : "=v"(l)); return l; }
#define LDS_WAIT() asm volatile("s_waitcnt lgkmcnt(0)" ::: "memory")
#define VM_WAIT() asm volatile("s_waitcnt vmcnt(0)" ::: "memory")
__device__ __forceinline__ unsigned f2bf(float f) { unsigned u = __builtin_bit_cast(unsigned, f); return (u + 0x7fffu + ((u >> 16) & 1u)) >> 16; }
__device__ __forceinline__ unsigned pk2(float lo, float hi) { unsigned r; asm volatile("v_cvt_pk_bf16_f32 %0, %1, %2" : "=v"(r) : "v"(lo), "v"(hi)); return r; }
__device__ __forceinline__ unsigned pk4_fp8(float a, float b, float c, float d) { int p = __builtin_amdgcn_cvt_pk_fp8_f32(a, b, 0, false); p = __builtin_amdgcn_cvt_pk_fp8_f32(c, d, p, true); return (unsigned)p; }
__device__ __forceinline__ float bf2f(unsigned short b) { return __builtin_bit_cast(float, ((unsigned)b) << 16); }
__device__ __forceinline__ float bflo(unsigned w) { return __builtin_bit_cast(float, w << 16); }
__device__ __forceinline__ float bfhi(unsigned w) { return __builtin_bit_cast(float, w & 0xffff0000u); }
template <int CTRL> __device__ __forceinline__ float dpp_f(float v) { return __builtin_bit_cast(float, __builtin_amdgcn_update_dpp(0, __builtin_bit_cast(int, v), CTRL, 0xF, 0xF, false)); }
__device__ __forceinline__ float sum8(float v) { v += dpp_f<0xB1>(v); v += dpp_f<0x4E>(v); v += dpp_f<0x141>(v); return v; }
__device__ __forceinline__ float max8(float v) { v = fmaxf(v, dpp_f<0xB1>(v)); v = fmaxf(v, dpp_f<0x4E>(v)); v = fmaxf(v, dpp_f<0x141>(v)); return v; }
__device__ __forceinline__ float rdl(float v, int l) { return __builtin_bit_cast(float, __builtin_amdgcn_readlane(__builtin_bit_cast(int, v), l)); }
__device__ __forceinline__ f32x4 bf4_to_f32(const u32x2 w) { return (f32x4){bflo(w.x), bfhi(w.x), bflo(w.y), bfhi(w.y)}; }
__device__ __forceinline__ float wave_sum(float v) {
    v = sum8(v); v += dpp_f<0x140>(v);
    return (rdl(v, 0) + rdl(v, 16)) + (rdl(v, 32) + rdl(v, 48));
}
__device__ __forceinline__ float wave_max(float v) {
    v = max8(v); v = fmaxf(v, dpp_f<0x140>(v));
    return fmaxf(fmaxf(rdl(v, 0), rdl(v, 16)), fmaxf(rdl(v, 32), rdl(v, 48)));
}
__device__ __forceinline__ int shfl_(int v, int src) { return __builtin_amdgcn_ds_bpermute(src << 2, v); }
__device__ __forceinline__ float shfl_(float v, int src) { return __builtin_bit_cast(float, __builtin_amdgcn_ds_bpermute(src << 2, __builtin_bit_cast(int, v))); }
__device__ __forceinline__ float sigmoidf_(float x) { return __builtin_amdgcn_rcpf(1.f + __builtin_amdgcn_exp2f(-1.44269504f * x)); }

namespace pg8 {
constexpr int BM = 256, BK = 64, HALF = 128, HTB = HALF * BK * 2  , STAGE_BYTES = 8 * HTB;
__host__ __device__ __forceinline__ int lds_byte(int r, int c) { const int st = (r >> 4) * 2 + (c >> 5), rr = r & 15, cc = c & 31, ob = rr * 64 + cc * 2; return st * 1024 + (ob ^ (((ob >> 9) & 1) << 5)); }
__host__ __device__ __forceinline__ void stage_rc(int b, int& R, int& C) { const int st = b / 1024, sb = b % 1024, swz = sb ^ (((sb >> 9) & 1) << 5); R = (st >> 1) * 16 + swz / 64; C = (st & 1) * 32 + (swz % 64) / 2; }
__host__ __device__ __forceinline__ int perm32(int rho) { const int n = rho >> 4, i = rho & 15; return 8 * (i >> 2) + 4 * n + (i & 3); }

struct Unit { int pm, pn, e, slot; };

typedef int v8i32 __attribute__((ext_vector_type(8)));
__device__ __forceinline__ v8i32 cat8(const bf16x8 a, const bf16x8 b) { union { bf16x8 h[2]; v8i32 v; } u; u.h[0] = a; u.h[1] = b; return u.v; }
__device__ __forceinline__ unsigned cvt_pk_bf16(float lo, float hi) { unsigned r; asm volatile("v_cvt_pk_bf16_f32 %0, %1, %2" : "=v"(r) : "v"(lo), "v"(hi)); return r; }

#ifndef PG8_ALIGN
#define PG8_ALIGN true
#endif
#ifndef FP8_PRIO
#define FP8_PRIO true
#endif
template <class Epi, class Sched, bool GATHER, bool FP8 = false, bool ALIGN_EPI = PG8_ALIGN, int KPROBE_ = 0>
__device__ __forceinline__ void gemm_phase(LAS unsigned char* lds, const int tid, const int K, const Sched& S, const Epi& E, const bool skip_epi = false) {
    const int wid = __builtin_amdgcn_readfirstlane(tid >> 6), lane = tid & 63, wr = wid >> 2, wc = wid & 3, fr = lane & 15, fq = lane >> 4;
    const int nt = K / BK;
    unsigned voffB[2], voffA[2][2];
#pragma unroll
    for (int i = 0; i < 2; ++i) { int R, C; stage_rc(tid * 16 + i * 8192, R, C); const int Rb = Epi::PERM ? ((R & ~31) + perm32(R & 31)) : R;
        voffB[i] = (unsigned)(Rb * K + C) * 2u; }
    const size_t kstep = (size_t)(BK * 2);
    const size_t hstep = (size_t)HALF * K * 2;
    const unsigned ldsw = (unsigned)wid * 1024u;
    const int aoff = lds_byte(wr * 64 + fr, fq * 8), boff = lds_byte(wc * 32 + fr, fq * 8);
#define PG8_SA(b, h) (((b) * 2 + (h)) * HTB)
#define PG8_SB(b, h) ((4 + (b) * 2 + (h)) * HTB)
#define PG8_STAGE(bufoff, gbase, voff) do { _Pragma("unroll") for (int _i = 0; _i < 2; ++_i) \
        __builtin_amdgcn_global_load_lds((const unsigned*)((const char*)(gbase) + (voff)[_i]), (LAS unsigned*)(lds + (bufoff) + ldsw + _i * 8192), 16, 0, 0); } while (0)
#define PG8_LDA(dst, b, h) do { if constexpr (KPROBE_ == 2) break; _Pragma("unroll") for (int m = 0; m < 4; ++m) _Pragma("unroll") for (int k = 0; k < 2; ++k) dst[m][k] = *(const LAS bf16x8*)(lds + PG8_SA(b, h) + aoff + m * 2048 + k * 1024); } while (0)
#define PG8_LDB(dst, b, h) do { if constexpr (KPROBE_ == 2) break; _Pragma("unroll") for (int n = 0; n < 2; ++n) _Pragma("unroll") for (int k = 0; k < 2; ++k) dst[n][k] = *(const LAS bf16x8*)(lds + PG8_SB(b, h) + boff + n * 2048 + k * 1024); } while (0)
#define PG8_MMA(ai, bj, At, Bt) do { if constexpr (!FP8 || FP8_PRIO) __builtin_amdgcn_s_setprio(1); else __builtin_amdgcn_s_setprio(0); _Pragma("unroll") for (int m = 0; m < 4; ++m) _Pragma("unroll") for (int n = 0; n < 2; ++n) { \
        if constexpr (KPROBE_ == 1) { asm volatile("" :: "v"(At[m][0]), "v"(At[m][1]), "v"(Bt[n][0]), "v"(Bt[n][1])); } else if constexpr (KPROBE_ == 2) { } else \
        if constexpr (FP8) { acc[ai][bj][m][n] = __builtin_amdgcn_mfma_scale_f32_16x16x128_f8f6f4(cat8(Bt[n][0], Bt[n][1]), cat8(At[m][0], At[m][1]), acc[ai][bj][m][n], 0, 0, 0, 0x7f7f7f7f, 0, 0x7f7f7f7f); } \
        else { _Pragma("unroll") for (int k = 0; k < 2; ++k) acc[ai][bj][m][n] = __builtin_amdgcn_mfma_f32_16x16x32_bf16(Bt[n][k], At[m][k], acc[ai][bj][m][n], 0, 0, 0); } } \
        __builtin_amdgcn_s_setprio(0); } while (0)
#define PG8_WAIT_V(n) asm volatile("s_waitcnt vmcnt(" #n ")" ::: "memory")
#define PG8_WAIT_VP do { if constexpr (Epi::PREFETCH) { if (pf) PG8_WAIT_V(10); else PG8_WAIT_V(8); } else PG8_WAIT_V(8); } while (0)
#define PG8_WAIT_L(n) asm volatile("s_waitcnt lgkmcnt(" #n ")" ::: "memory")
#define PG8_BAR __builtin_amdgcn_s_barrier()
#define PG8_SCHED __builtin_amdgcn_sched_barrier(0)
#define PG8_SETVOFF(u) do { _Pragma("unroll") for (int _i = 0; _i < 2; ++_i) { int RA_, CA_; stage_rc(tid * 16 + _i * 8192, RA_, CA_);     \
        _Pragma("unroll") for (int _h = 0; _h < 2; ++_h) { \
        if constexpr (GATHER) voffA[_h][_i] = ((unsigned)S.a_row(u, _h * HALF + RA_) * (unsigned)K + (unsigned)CA_) * 2u; \
        else voffA[_h][_i] = ((unsigned)(_h * HALF + RA_) * (unsigned)K + (unsigned)CA_) * 2u; } } } while (0)
    Unit cur, nxt; int ui = 0;
    if (!S.next(0, cur)) return;
    f32x4 acc[2][2][4][2];
#pragma unroll
    for (int a = 0; a < 2; ++a)
#pragma unroll
        for (int b = 0; b < 2; ++b)
#pragma unroll
            for (int m = 0; m < 4; ++m)
#pragma unroll
                for (int n = 0; n < 2; ++n) acc[a][b][m][n] = (f32x4){0.f, 0.f, 0.f, 0.f};
    bf16x8 At[4][2], B0[2][2], B1[2][2];
    const char* cA = S.a_base(cur); const char* cB = S.b_base(cur);
    PG8_SETVOFF(cur);
    PG8_STAGE(PG8_SB(0, 0), cB, voffB); PG8_STAGE(PG8_SB(0, 1), cB + hstep, voffB); PG8_STAGE(PG8_SA(0, 0), cA, voffA[0]); PG8_STAGE(PG8_SA(0, 1), cA, voffA[1]);
    if (wr == 1) PG8_BAR;
    PG8_WAIT_V(2); PG8_BAR;
    PG8_STAGE(PG8_SB(1, 0), cB + kstep, voffB); PG8_STAGE(PG8_SA(1, 0), cA + kstep, voffA[0]); PG8_STAGE(PG8_SB(1, 1), cB + hstep + kstep, voffB);
    PG8_WAIT_V(6); PG8_BAR;
    for (;;) {
        const bool has_next = S.next(ui + 1, nxt);
        const char* nA = has_next ? S.a_base(nxt) : cA; const char* nB = has_next ? S.b_base(nxt) : cB;
#pragma unroll 1
        for (int t = 0; t < nt; t += 2) {
            const bool last = (t == nt - 2);
            const char* a1 = cA + (size_t)(t + 1) * kstep;
            const char* a2 = last ? nA : cA + (size_t)(t + 2) * kstep; const char* b2 = last ? nB : cB + (size_t)(t + 2) * kstep;
            const char* a3 = a2 + kstep; const char* b3 = b2 + kstep;
            bool pf = false;
            if constexpr (Epi::PREFETCH) { pf = (t == ((nt / 2) & ~1)); if (pf) E.prefetch(cur, wid * 64 + lane_id_here(), lds); }
            PG8_LDB(B0, 0, 0); PG8_LDB(B1, 0, 1); PG8_SCHED; PG8_LDA(At, 0, 0); PG8_STAGE(PG8_SA(1, 1), a1, voffA[1]);
            if constexpr (GATHER) { if (last && has_next) PG8_SETVOFF(nxt); }
            PG8_WAIT_VP; PG8_WAIT_L(0); PG8_BAR; PG8_MMA(0, 0, At, B0); PG8_MMA(0, 1, At, B1); PG8_BAR; PG8_SCHED;
            PG8_LDA(At, 0, 1); PG8_STAGE(PG8_SB(0, 0), b2, voffB); PG8_STAGE(PG8_SB(0, 1), b2 + hstep, voffB); PG8_STAGE(PG8_SA(0, 0), a2, voffA[0]);
            PG8_WAIT_VP; PG8_WAIT_L(0); PG8_BAR; PG8_MMA(1, 0, At, B0); PG8_MMA(1, 1, At, B1); PG8_BAR; PG8_SCHED;
            PG8_LDB(B0, 1, 0); PG8_LDB(B1, 1, 1); PG8_SCHED; PG8_LDA(At, 1, 0); PG8_STAGE(PG8_SA(0, 1), a2, voffA[1]);
            PG8_WAIT_VP; PG8_WAIT_L(0); PG8_BAR; PG8_MMA(0, 0, At, B0); PG8_MMA(0, 1, At, B1); PG8_BAR; PG8_SCHED;
            PG8_LDA(At, 1, 1); PG8_STAGE(PG8_SB(1, 0), b3, voffB); PG8_STAGE(PG8_SB(1, 1), b3 + hstep, voffB); PG8_STAGE(PG8_SA(1, 0), a3, voffA[0]);
            PG8_WAIT_V(8); PG8_WAIT_L(0); PG8_BAR; PG8_MMA(1, 0, At, B0); PG8_MMA(1, 1, At, B1); PG8_BAR; PG8_SCHED;
        }
        if constexpr (ALIGN_EPI) { if (wr == 0) PG8_BAR; }
        if (!skip_epi) E(acc, cur, wr, wc, fr, fq);
        if (!has_next) break;
#pragma unroll
        for (int a = 0; a < 2; ++a)
#pragma unroll
            for (int b = 0; b < 2; ++b)
#pragma unroll
                for (int m = 0; m < 4; ++m)
#pragma unroll
                    for (int n = 0; n < 2; ++n) acc[a][b][m][n] = (f32x4){0.f, 0.f, 0.f, 0.f};
        cur = nxt; cA = nA; cB = nB; ++ui;
        if constexpr (ALIGN_EPI) { if (wr == 1) PG8_BAR; }
    }
    PG8_WAIT_V(0);
    if constexpr (!ALIGN_EPI) { if (wr == 0) PG8_BAR; }
    PG8_BAR;
#undef PG8_SA
#undef PG8_SB
#undef PG8_STAGE
#undef PG8_LDA
#undef PG8_LDB
#undef PG8_MMA
#undef PG8_WAIT_V
#undef PG8_WAIT_VP
#undef PG8_WAIT_L
#undef PG8_BAR
#undef PG8_SCHED
#undef PG8_SETVOFF
}
}

#define XB_TMO      128
#define XB_XCNT(j)  (256  + 64 * (j))
#define XB_XSUB(j)  (1280 + 64 * (j))
#define XB_XGEN(j)  (2304 + 64 * (j))
#define XB_TOP      3328
#define XB_TOPGEN   3392
#define XCD_BAR_WORDS 3456
#define XB_SPIN_CAP (1u << 18)

__device__ __forceinline__ unsigned xb_ld(unsigned* p)              { return __hip_atomic_load(p, __ATOMIC_RELAXED, __HIP_MEMORY_SCOPE_AGENT); }
__device__ __forceinline__ unsigned xb_add(unsigned* p, unsigned v) { return __hip_atomic_fetch_add(p, v, __ATOMIC_RELAXED, __HIP_MEMORY_SCOPE_AGENT); }
__device__ __forceinline__ unsigned xb_xcc_id() { return (unsigned)__builtin_amdgcn_s_getreg((3 << 11) | 20) & 0xFu; }
#define XB_SPIN(cond, bar) do { unsigned _sp = 0; while (cond) { __builtin_amdgcn_s_sleep(1); \
    if ((++_sp & 255u) == 0u) { if (xb_ld(&(bar)[XB_TMO])) break; if (_sp > XB_SPIN_CAP) { atomicAdd(&(bar)[XB_TMO], 1u); break; } } } } while (0)

struct XcdBarrier {
    unsigned* bar; unsigned x;
    unsigned w0;
    volatile LAS unsigned* st;
};

__device__ __forceinline__ XcdBarrier xcd_barrier_post(unsigned* bar, volatile LAS unsigned* st) {
    XcdBarrier b; b.bar = bar; b.x = xb_xcc_id(); b.st = st; b.w0 = ((unsigned)__builtin_amdgcn_readfirstlane((int)threadIdx.x) < 64u) ? 1u : 0u;
    if (threadIdx.x == 0) (void)xb_add(&bar[XB_XCNT(b.x)], 1u);
    return b;
}
__device__ __forceinline__ void xcd_barrier_complete(unsigned* bar, unsigned x, unsigned& nloc, unsigned& nx) {
    const unsigned G = gridDim.x * gridDim.y * gridDim.z;
    unsigned sum, cnt, mine, sp = 0u;
    for (;;) {
        sum = 0u; cnt = 0u; mine = 0u;
#pragma unroll
        for (unsigned j = 0; j < 16; ++j) { const unsigned c = xb_ld(&bar[XB_XCNT(j)]); sum += c; cnt += (c > 0u) ? 1u : 0u; mine = (j == x) ? c : mine; }
        if (sum == G) break;
        __builtin_amdgcn_s_sleep(1);
        if ((++sp & 255u) == 0u) { if (xb_ld(&bar[XB_TMO])) break; if (sp > XB_SPIN_CAP) { atomicAdd(&bar[XB_TMO], 1u); break; } }
    }
    nloc = mine > 0u ? mine : 1u; nx = cnt > 0u ? cnt : 1u;
}

__device__ __forceinline__ void xcd_barrier(const XcdBarrier& b) {
    asm volatile("s_waitcnt vmcnt(0)" ::: "memory");
    __syncthreads();
    if (b.w0 && lane_id_here() == 0) {
        unsigned* bar = b.bar;
        __builtin_amdgcn_s_waitcnt(0);
        unsigned nloc = b.st[0], nx = b.st[1];
        if (nloc == 0u) { xcd_barrier_complete(bar, b.x, nloc, nx); b.st[0] = nloc; b.st[1] = nx; }
        const unsigned old = xb_add(&bar[XB_XSUB(b.x)], 1u);
        const unsigned gen = old / nloc;
        if (old + 1u == (gen + 1u) * nloc) {
            __builtin_amdgcn_fence(__ATOMIC_RELEASE, "agent");
            asm volatile("s_waitcnt vmcnt(0)" ::: "memory");
            const unsigned og = xb_add(&bar[XB_TOP], 1u);
            const unsigned tg = og / nx;
            if (og + 1u == (tg + 1u) * nx) xb_add(&bar[XB_TOPGEN], 1u);
            else XB_SPIN(xb_ld(&bar[XB_TOPGEN]) == tg, bar);
            __builtin_amdgcn_fence(__ATOMIC_ACQUIRE, "agent");
            xb_add(&bar[XB_XGEN(b.x)], 1u);
            asm volatile("s_waitcnt vmcnt(0)" ::: "memory");
        } else {
            XB_SPIN(xb_ld(&bar[XB_XGEN(b.x)]) == gen, bar);
            __builtin_amdgcn_fence(__ATOMIC_ACQUIRE, "agent");
            asm volatile("s_waitcnt vmcnt(0)" ::: "memory");
        }
    }
    __syncthreads();
}

__device__ __forceinline__ void group_sync(unsigned* word, unsigned n, unsigned* bar, bool w0) {
    asm volatile("s_waitcnt vmcnt(0)" ::: "memory");
    __syncthreads();
    if (w0 && lane_id_here() == 0) {
        __builtin_amdgcn_s_waitcnt(0);
        __builtin_amdgcn_fence(__ATOMIC_RELEASE, "agent");
        asm volatile("s_waitcnt vmcnt(0)" ::: "memory");
        (void)xb_add(word, 1u);
        XB_SPIN(xb_ld(word) < n, bar);
        __builtin_amdgcn_fence(__ATOMIC_ACQUIRE, "agent");
        asm volatile("s_waitcnt vmcnt(0)" ::: "memory");
    }
    __syncthreads();
}

struct Args { const float* in[23]; float* out; unsigned char* ws; int ph_lo, ph_hi; };
struct Frame {
    LAS unsigned char* lds;
    volatile LAS int* LCTL;
    int tid, lane, wave, vcu, G;
};
__device__ __forceinline__ unsigned long long ptr_get(const Frame& F, int i) {
    const unsigned lo = (unsigned)F.LCTL[128 + 2 * i], hi = (unsigned)F.LCTL[129 + 2 * i];
    return ((unsigned long long)(unsigned)__builtin_amdgcn_readfirstlane((int)hi) << 32) | (unsigned long long)(unsigned)__builtin_amdgcn_readfirstlane((int)lo);
}
__device__ __forceinline__ const float* inp(const Frame& F, int i) { return (const float*)(GAS const float*)ptr_get(F, i); }
__device__ __forceinline__ unsigned char* wsp(const Frame& F) { return (unsigned char*)(GAS unsigned char*)ptr_get(F, 23); }
__device__ __forceinline__ float* outp(const Frame& F) { return (float*)(GAS float*)ptr_get(F, 24); }
enum { I_X = 0, I_C, I_CTX, I_CCTX, I_WADA, I_BADA, I_GMIX, I_GFFN, I_WQKV, I_QGAIN, I_KGAIN, I_RPB, I_WONA, I_WIN, I_BGATE, I_MHGAIN, I_WOML,
       I_WR, I_BR, I_W1, I_B1, I_W2, I_B2 };

struct DenseOrder {
    int nM, nN, nwg, G, c, pm0, K; const char* A; const char* Bt;
    __device__ __forceinline__ void init(int pm0_, int nM_, int nN_, int G_, int c_, const void* A_, const void* Bt_, int K_) { pm0 = pm0_; nM = nM_; nN = nN_; nwg = nM * nN; G = G_; c = c_; A = (const char*)A_; Bt = (const char*)Bt_; K = K_; }
    __device__ __forceinline__ bool next(int i, pg8::Unit& u) const {
        const long L = (long)i * G + c; if (L >= nwg) return false;
        int wgid = (int)L; { const int q = nwg / 8, r = nwg % 8, xcd = wgid % 8, off = wgid / 8; wgid = (xcd < r ? xcd * (q + 1) : r * (q + 1) + (xcd - r) * q) + off; }
        const int nig = 8 * nN, gid = wgid / nig, fm = gid * 8, gsz = (nM - fm) < 8 ? (nM - fm) : 8;
        u.pm = pm0 + fm + ((wgid % nig) % gsz); u.pn = (wgid % nig) / gsz; u.e = 0; u.slot = i; return true;
    }
    __device__ __forceinline__ const char* a_base(const pg8::Unit& u) const { return A + (size_t)u.pm * 256 * K * 2; }
    __device__ __forceinline__ const char* b_base(const pg8::Unit& u) const { return Bt + (size_t)u.pn * 256 * K * 2; }
    __device__ __forceinline__ int a_row(const pg8::Unit&, int) const { return 0; }
    __device__ __forceinline__ bool prefetchable() const { return false; }
    __device__ __forceinline__ const int* a_row_ptr(const pg8::Unit&, int) const { return nullptr; }
};
struct MoeOrder {
    int NT, nunits, G, c, K; const char* A; const char* W; size_t estride; const int* tokmap; volatile LAS int* prefix; volatile LAS int* tile_e; volatile LAS int* tokl; bool gather;
    __device__ __forceinline__ bool next(int i, pg8::Unit& u) const {
        const long L = (long)i * G + c; if (L >= nunits) return false;
        int wgid = (int)L; { const int q = nunits / 8, r = nunits % 8, xcd = wgid % 8, off = wgid / 8; wgid = (xcd < r ? xcd * (q + 1) : r * (q + 1) + (xcd - r) * q) + off; }
        const int tile = wgid / NT; u.pm = tile; u.pn = wgid - tile * NT;
        u.e = __builtin_amdgcn_readfirstlane(tile_e[tile]); u.slot = i; return true;
    }
    __device__ __forceinline__ const char* a_base(const pg8::Unit& u) const { return A; }
    __device__ __forceinline__ const char* b_base(const pg8::Unit& u) const { return W + (size_t)u.e * estride + (size_t)u.pn * 256 * K * 2; }
    __device__ __forceinline__ int a_row(const pg8::Unit& u, int r) const { return gather ? tokl[u.slot * 256 + r] : u.pm * 256 + r; }
    __device__ __forceinline__ bool prefetchable() const { return gather; }
    __device__ __forceinline__ const int* a_row_ptr(const pg8::Unit& u, int r) const { return tokmap + u.pm * 256 + r; }
};

#ifndef WO_PREFETCH
#define WO_PREFETCH false
#endif
typedef f32x4 AccT[2][2][4][2];
struct EpiStoreBf16 {
    static constexpr bool PERM = true; static constexpr bool PREFETCH = false;
    bf16_t* O; int ldc;
    __device__ __forceinline__ void operator()(const AccT& acc, const pg8::Unit& u, int wr, int wc, int fr, int fq) const {
        const int row0 = u.pm * 256 + wr * 64 + fr, col0 = u.pn * 256 + wc * 32 + 8 * fq;
#pragma unroll
        for (int ai = 0; ai < 2; ++ai)
#pragma unroll
            for (int m = 0; m < 4; ++m) { bf16_t* rowp = O + (size_t)(row0 + ai * 128 + m * 16) * ldc + col0;
#pragma unroll
                for (int bj = 0; bj < 2; ++bj) { const f32x4 v0 = acc[ai][bj][m][0], v1 = acc[ai][bj][m][1];
                    u32x4 w; w.x = pg8::cvt_pk_bf16(v0[0], v0[1]); w.y = pg8::cvt_pk_bf16(v0[2], v0[3]); w.z = pg8::cvt_pk_bf16(v1[0], v1[1]); w.w = pg8::cvt_pk_bf16(v1[2], v1[3]);
                    *(u32x4*)(rowp + bj * 128) = w; } }
    }
};
struct EpiProjML {
    static constexpr bool PERM = false; static constexpr bool PREFETCH = false;
    bf16_t* O; const float* rope;
    __device__ __forceinline__ void operator()(const AccT& acc, const pg8::Unit& u, int wr, int wc, int fr, int fq) const {
        const int row0 = u.pm * 256 + wr * 64 + fr, col0 = u.pn * 256 + wc * 32 + 4 * fq;
        const bool qk = u.pn < 4, lat = u.pm >= ROWS_CTX / 256;
        const float scale = u.pn < 2 ? 0.125f : 1.0f;
        const int hf = wc & 1;
#pragma unroll
        for (int ai = 0; ai < 2; ++ai) {
            f32x4 t0[4], t1[4];
            if (qk && lat) {
#pragma unroll
                for (int m = 0; m < 4; ++m) { const int row = row0 + ai * 128 + m * 16, s = (row - ROWS_CTX) & 4095, pos = hf ? (s & 63) : (s >> 6);
                    t0[m] = *(const f32x4*)(rope + (pos * 16 + 4 * fq) * 2); t1[m] = *(const f32x4*)(rope + (pos * 16 + 4 * fq) * 2 + 4); }
            }
#pragma unroll
            for (int m = 0; m < 4; ++m) { const int row = row0 + ai * 128 + m * 16; bf16_t* rowp = O + (size_t)row * ML_INP + col0;
                f32x4 c4 = (f32x4){1.f, 1.f, 1.f, 1.f}, s4 = (f32x4){0.f, 0.f, 0.f, 0.f};
                if (qk && lat) { c4 = (f32x4){t0[m][0], t0[m][2], t1[m][0], t1[m][2]}; s4 = (f32x4){t0[m][1], t0[m][3], t1[m][1], t1[m][3]}; }
#pragma unroll
                for (int bj = 0; bj < 2; ++bj) { f32x4 v0 = acc[ai][bj][m][0], v1 = acc[ai][bj][m][1];
                    if (qk) { const f32x4 o0 = (v0 * c4 - v1 * s4) * scale, o1 = (v0 * s4 + v1 * c4) * scale; v0 = o0; v1 = o1; }
                    u32x2 w0, w1; w0.x = pg8::cvt_pk_bf16(v0[0], v0[1]); w0.y = pg8::cvt_pk_bf16(v0[2], v0[3]); w1.x = pg8::cvt_pk_bf16(v1[0], v1[1]); w1.y = pg8::cvt_pk_bf16(v1[2], v1[3]);
                    *(u32x2*)(rowp + bj * 128) = w0; *(u32x2*)(rowp + bj * 128 + 16) = w1; } }
        }
    }
};
#ifndef Y_FP8
#define Y_FP8 1
#endif
struct EpiY {
    static constexpr bool PERM = true; static constexpr bool PREFETCH = false;
    bf16_t* O; const float* b2;
    __device__ __forceinline__ void operator()(const AccT& acc, const pg8::Unit& u, int wr, int wc, int fr, int fq) const {
        const int row0 = u.pm * 256 + wr * 64 + fr, col0 = u.pn * 256 + wc * 32 + 8 * fq;
        const float* bp = b2 + (size_t)u.e * D + col0;
#pragma unroll
        for (int bj = 0; bj < 2; ++bj) {
            const f32x4 b0 = *(const f32x4*)(bp + bj * 128), b1v = *(const f32x4*)(bp + bj * 128 + 4);
#pragma unroll
            for (int ai = 0; ai < 2; ++ai)
#pragma unroll
                for (int m = 0; m < 4; ++m) {
                    const f32x4 v0 = acc[ai][bj][m][0] * (1.0f / 1024.0f) + b0, v1 = acc[ai][bj][m][1] * (1.0f / 1024.0f) + b1v;
#if Y_FP8
                    unsigned char* rowp = (unsigned char*)O + (size_t)(row0 + ai * 128 + m * 16) * D + col0 + bj * 128;
                    const f32x4 lim = (f32x4){448.f, 448.f, 448.f, 448.f};
                    const f32x4 q0 = __builtin_elementwise_min(__builtin_elementwise_max(v0 * 16.0f, -lim), lim), q1 = __builtin_elementwise_min(__builtin_elementwise_max(v1 * 16.0f, -lim), lim);
                    u32x2 w; w.x = pk4_fp8(q0[0], q0[1], q0[2], q0[3]); w.y = pk4_fp8(q1[0], q1[1], q1[2], q1[3]);
                    *(u32x2*)rowp = w;
#else
                    bf16_t* rowp = O + (size_t)(row0 + ai * 128 + m * 16) * D + col0 + bj * 128;
                    u32x4 w; w.x = pg8::cvt_pk_bf16(v0[0], v0[1]); w.y = pg8::cvt_pk_bf16(v0[2], v0[3]); w.z = pg8::cvt_pk_bf16(v1[0], v1[1]); w.w = pg8::cvt_pk_bf16(v1[2], v1[3]);
                    *(u32x4*)rowp = w;
#endif
                } }
    }
};
struct EpiSwiglu {
    static constexpr bool PERM = true; static constexpr bool PREFETCH = false;
    unsigned char* O; const float* b1;
    __device__ __forceinline__ void operator()(const AccT& acc, const pg8::Unit& u, int wr, int wc, int fr, int fq) const {
        const int row0 = u.pm * 256 + wr * 64 + fr, cc0 = u.pn * 128 + wc * 32 + 8 * fq;
        const float* bp = b1 + (size_t)u.e * 2048 + cc0;
        f32x4 bg[2], bl[2];
#pragma unroll
        for (int n = 0; n < 2; ++n) { bg[n] = *(const f32x4*)(bp + 4 * n); bl[n] = *(const f32x4*)(bp + 1024 + 4 * n) + 1.0f; }
#pragma unroll
        for (int ai = 0; ai < 2; ++ai)
#pragma unroll
            for (int m = 0; m < 4; ++m) { unsigned char* rowp = O + (size_t)(row0 + ai * 128 + m * 16) * D + cc0;
                float o[8];
#pragma unroll
                for (int n = 0; n < 2; ++n) { const f32x4 gl = acc[ai][0][m][n] * (1.0f / 2048.0f) + bg[n], li1 = acc[ai][1][m][n] * (1.0f / 2048.0f) + bl[n];
#pragma unroll
                    for (int j = 0; j < 4; ++j) { const float g = fminf(gl[j], 7.0f), l1 = __builtin_amdgcn_fmed3f(li1[j], -6.0f, 8.0f);
                        const float sg = __builtin_amdgcn_rcpf(1.0f + __builtin_amdgcn_exp2f(-2.45545696f * g));
                        o[4 * n + j] = (8.0f * g) * sg * l1; } }
                u32x2 w; w.x = pk4_fp8(o[0], o[1], o[2], o[3]); w.y = pk4_fp8(o[4], o[5], o[6], o[7]);
                *(u32x2*)rowp = w; }
    }
};
struct EpiResid {
    static constexpr bool PERM = true; static constexpr bool PREFETCH = WO_PREFETCH;
    bf16_t* xs; const float* g;
    __device__ __forceinline__ void prefetch(const pg8::Unit& u, int tid, LAS unsigned char* lds) const {
        const char* base = (const char*)(xs + (size_t)(u.pm * 256 + (tid >> 1)) * D + u.pn * 256) + (tid & 1) * 256;
        LAS unsigned* dump = (LAS unsigned*)(lds + pg8::STAGE_BYTES + 16384 + (tid >> 6) * 256);
        __builtin_amdgcn_global_load_lds((const unsigned*)base, dump, 4, 0, 0);
        __builtin_amdgcn_global_load_lds((const unsigned*)(base + 128), dump, 4, 0, 0);
    }
    __device__ __forceinline__ void operator()(const AccT& acc, const pg8::Unit& u, int wr, int wc, int fr, int fq) const {
        const int row0 = u.pm * 256 + wr * 64 + fr, col0 = u.pn * 256 + wc * 32 + 8 * fq;
        const int mb = u.pm < 8 ? 8 : ((u.pm - 8) >> 4);
        const float* gp = g + (size_t)mb * 6144 + col0;
        f32x4 gv[2][2];
#pragma unroll
        for (int bj = 0; bj < 2; ++bj)
#pragma unroll
            for (int n = 0; n < 2; ++n) gv[bj][n] = *(const f32x4*)(gp + bj * 128 + 4 * n);
#pragma unroll
        for (int ai = 0; ai < 2; ++ai) {
            u32x4 xv[4][2];
#pragma unroll
            for (int m = 0; m < 4; ++m) { const bf16_t* rowp = xs + (size_t)(row0 + ai * 128 + m * 16) * D + col0;
#pragma unroll
                for (int bj = 0; bj < 2; ++bj) xv[m][bj] = *(const u32x4*)(rowp + bj * 128); }
#pragma unroll
            for (int m = 0; m < 4; ++m) { bf16_t* rowp = xs + (size_t)(row0 + ai * 128 + m * 16) * D + col0;
#pragma unroll
                for (int bj = 0; bj < 2; ++bj) { const u32x4 x = xv[m][bj];
                    const f32x4 x0 = (f32x4){bflo(x.x), bfhi(x.x), bflo(x.y), bfhi(x.y)}, x1 = (f32x4){bflo(x.z), bfhi(x.z), bflo(x.w), bfhi(x.w)};
                    const f32x4 v0 = x0 + gv[bj][0] * acc[ai][bj][m][0], v1 = x1 + gv[bj][1] * acc[ai][bj][m][1];
                    u32x4 w; w.x = pg8::cvt_pk_bf16(v0[0], v0[1]); w.y = pg8::cvt_pk_bf16(v0[2], v0[3]); w.z = pg8::cvt_pk_bf16(v1[0], v1[1]); w.w = pg8::cvt_pk_bf16(v1[2], v1[3]);
                    *(u32x4*)(rowp + bj * 128) = w; } }
        }
    }
};

__device__ __forceinline__ const float* modp(const Frame& F, int l, int mb, int chunk) { return (const float*)(wsp(F) + WS_MOD) + ((size_t)(l * 9 + mb) * 6 + chunk) * D; }
__device__ __forceinline__ int row_mb(int row) { return row < ROWS_CTX ? 8 : ((row - ROWS_CTX) >> 12); }

__device__ __forceinline__ void transpose_item(const float* W, int N, int Nvalid, bf16_t* WT, int k0, int n0, LAS float* scr, int lane, const bool nost = false) {
    const int nn = 4 * (lane & 15);
    const bool ok = (n0 + nn) < Nvalid;
    f32x4 v[16];
#pragma unroll
    for (int i = 0; i < 16; ++i) { const int kk = 4 * i + (lane >> 4);
        v[i] = ok ? __builtin_nontemporal_load((const f32x4*)(W + (size_t)(k0 + kk) * N + n0 + nn)) : (f32x4){0.f, 0.f, 0.f, 0.f}; }
#pragma unroll
    for (int i = 0; i < 16; ++i) { const int kk = 4 * i + (lane >> 4); LAS float* s = scr + kk * 65 + nn;
        s[0] = v[i][0]; s[1] = v[i][1]; s[2] = v[i][2]; s[3] = v[i][3]; }
    LDS_WAIT(); asm volatile("" ::: "memory");
    const int c = lane & 7;
#pragma unroll
    for (int j = 0; j < 8; ++j) { const int n = (lane >> 3) + 8 * j; const LAS float* s = scr + (8 * c) * 65 + n;
        u32x4 o; o.x = pk2(s[0 * 65], s[1 * 65]); o.y = pk2(s[2 * 65], s[3 * 65]); o.z = pk2(s[4 * 65], s[5 * 65]); o.w = pk2(s[6 * 65], s[7 * 65]);
        if (!nost) *(u32x4*)(WT + (size_t)n * D + k0 + 8 * c) = o; }
    LDS_WAIT(); asm volatile("" ::: "memory");
}
__device__ __forceinline__ void transpose_item_f8(const float* W, int N, unsigned char* WT, int k0, int n0, LAS float* scr, int lane, float scale, const bool nost = false) {
    const int nn = 4 * (lane & 15);
    f32x4 v[16];
#pragma unroll
    for (int i = 0; i < 16; ++i) { const int kk = 4 * i + (lane >> 4); v[i] = __builtin_nontemporal_load((const f32x4*)(W + (size_t)(k0 + kk) * N + n0 + nn)); }
#pragma unroll
    for (int i = 0; i < 16; ++i) { const int kk = 4 * i + (lane >> 4); LAS float* s = scr + kk * 65 + nn;
        s[0] = v[i][0] * scale; s[1] = v[i][1] * scale; s[2] = v[i][2] * scale; s[3] = v[i][3] * scale; }
    LDS_WAIT(); asm volatile("" ::: "memory");
    const int c = lane & 3;
#pragma unroll
    for (int j = 0; j < 4; ++j) { const int n = (lane >> 2) + 16 * j; const LAS float* s = scr + (16 * c) * 65 + n;
        u32x4 o; o.x = pk4_fp8(s[0 * 65], s[1 * 65], s[2 * 65], s[3 * 65]); o.y = pk4_fp8(s[4 * 65], s[5 * 65], s[6 * 65], s[7 * 65]);
        o.z = pk4_fp8(s[8 * 65], s[9 * 65], s[10 * 65], s[11 * 65]); o.w = pk4_fp8(s[12 * 65], s[13 * 65], s[14 * 65], s[15 * 65]);
        if (!nost) *(u32x4*)(WT + (size_t)n * D + k0 + 16 * c) = o; }
    LDS_WAIT(); asm volatile("" ::: "memory");
}
struct CvItem { const float* W; unsigned char* dst; int N, Nvalid, k0, n0, f8; };
constexpr int CV_QKV = 2 * 16 * 48, CV_WO = 4 * 16 * 16, CV_IN = 2 * 16 * 52, CV_1 = DEPTH * NE * 16 * 32, CV_2 = DEPTH * NE * 16 * 16, CV_NIT = CV_QKV + CV_WO + CV_IN + CV_1 + CV_2;
#ifndef CV_SPLIT
#define CV_SPLIT 4
#endif
#ifndef CV_PERIOD
#define CV_PERIOD 0u
#endif
#ifndef CV_RD_END
#define CV_RD_END 500u
#endif
#ifndef CV_WR_BEG
#define CV_WR_BEG 950u
#endif
__device__ __forceinline__ void cv_window(const bool wr) {
#if CV_PERIOD > 0
    for (int spin = 0; spin < 4096; ++spin) {
        const unsigned t = (unsigned)__builtin_amdgcn_s_memrealtime() % CV_PERIOD;
        if (wr ? (t >= CV_WR_BEG) : (t < CV_RD_END)) break;
        __builtin_amdgcn_s_sleep(4);
    }
#endif
}
__device__ __forceinline__ CvItem cv_item(const Frame& F, int it) {
    CvItem I;
    if (it < CV_QKV) { const int j = it / 768, r = it % 768, kb = r / 48, nb = r % 48;
        I.W = inp(F, I_WQKV) + (size_t)j * D * 3072; I.N = 3072; I.Nvalid = 3072; I.dst = wsp(F) + WS_WQKV + (((size_t)j * 3072 + nb * 64) * D) * 2; I.k0 = kb * 64; I.n0 = nb * 64; I.f8 = 0; return I; }
    it -= CV_QKV;
    if (it < CV_WO) { const int m = it / 256, r = it % 256, kb = r / 16, nb = r % 16;
        I.W = (m < 2) ? inp(F, I_WONA) + (size_t)m * D * D : inp(F, I_WOML) + (size_t)(m - 2) * D * D;
        I.dst = ((m < 2) ? wsp(F) + WS_WONA + (size_t)m * D * D * 2 : wsp(F) + WS_WOML + (size_t)(m - 2) * D * D * 2) + (size_t)nb * 64 * D * 2;
        I.N = D; I.Nvalid = D; I.k0 = kb * 64; I.n0 = nb * 64; I.f8 = 0; return I; }
    it -= CV_WO;
    if (it < CV_IN) { const int j = it / 832, r = it % 832, kb = r / 52, nb = r % 52;
        I.W = inp(F, I_WIN) + (size_t)j * D * ML_IN; I.N = ML_IN; I.Nvalid = ML_IN; I.dst = wsp(F) + WS_WIN + (((size_t)j * ML_INP + nb * 64) * D) * 2; I.k0 = kb * 64; I.n0 = nb * 64; I.f8 = 0; return I; }
    it -= CV_IN;
    if (it < CV_1) { const int le = it / 512, r = it % 512, kb = r / 64, nb = r % 64;
        const int n0 = nb * 32, bj = n0 >> 10, j0 = n0 & 1023, pn = j0 >> 7, jj0 = j0 & 127, drow = pn * 256 + bj * 128 + jj0;
        I.W = inp(F, I_W1) + (size_t)le * D * 2048; I.N = 2048; I.Nvalid = 2048; I.dst = wsp(F) + WS_W1T + ((size_t)le * 2048 + drow) * D; I.k0 = kb * 128; I.n0 = n0; I.f8 = 1; return I; }
    it -= CV_1;
    { const int le = it / 256, r = it % 256, kb = r / 32, nb = r % 32;
        I.W = inp(F, I_W2) + (size_t)le * D * D; I.N = D; I.Nvalid = D; I.dst = wsp(F) + WS_W2T + ((size_t)le * D + nb * 32) * D; I.k0 = kb * 128; I.n0 = nb * 32; I.f8 = 1; return I; }
}
template <int NL>
__device__ __forceinline__ void cv_load(const CvItem& I, int lane, int i0, f32x4 (&v)[NL]) {
    const int rs = I.f8 ? 8 : 4, nn = I.f8 ? 4 * (lane & 7) : 4 * (lane & 15), kr = I.f8 ? (lane >> 3) : (lane >> 4);
    const bool ok = (I.n0 + nn) < I.Nvalid;
    const float* p = I.W + (size_t)(I.k0 + rs * i0 + kr) * I.N + I.n0 + nn;
#pragma unroll
    for (int i = 0; i < NL; ++i) v[i] = ok ? __builtin_nontemporal_load((const f32x4*)(p + (size_t)(rs * i) * I.N)) : (f32x4){0.f, 0.f, 0.f, 0.f};
}
template <int NL>
__device__ __forceinline__ void cv_lds(const CvItem& I, int lane, int i0, const f32x4 (&v)[NL], LAS float* scr) {
    const float scale = I.f8 ? 128.0f : 1.0f;
    LAS float* s0 = I.f8 ? scr + (8 * i0 + (lane >> 3)) * 33 + 4 * (lane & 7) : scr + (4 * i0 + (lane >> 4)) * 65 + 4 * (lane & 15);
    const int st = I.f8 ? 8 * 33 : 4 * 65;
#pragma unroll
    for (int i = 0; i < NL; ++i) { LAS float* s = s0 + i * st; s[0] = v[i][0] * scale; s[1] = v[i][1] * scale; s[2] = v[i][2] * scale; s[3] = v[i][3] * scale; }
}
__device__ __forceinline__ void cv_conv(const CvItem& I, int lane, LAS float* scr, u32x4 (&o)[8]) {
    LDS_WAIT(); asm volatile("" ::: "memory");
    if (I.f8) { const int c = lane & 7;
#pragma unroll
        for (int j = 0; j < 4; ++j) { const int n = (lane >> 3) + 8 * j; const LAS float* s = scr + (16 * c) * 33 + n;
            o[j].x = pk4_fp8(s[0 * 33], s[1 * 33], s[2 * 33], s[3 * 33]); o[j].y = pk4_fp8(s[4 * 33], s[5 * 33], s[6 * 33], s[7 * 33]);
            o[j].z = pk4_fp8(s[8 * 33], s[9 * 33], s[10 * 33], s[11 * 33]); o[j].w = pk4_fp8(s[12 * 33], s[13 * 33], s[14 * 33], s[15 * 33]); }
    } else { const int c = lane & 7;
#pragma unroll
        for (int j = 0; j < 8; ++j) { const int n = (lane >> 3) + 8 * j; const LAS float* s = scr + (8 * c) * 65 + n;
            o[j].x = pk2(s[0 * 65], s[1 * 65]); o[j].y = pk2(s[2 * 65], s[3 * 65]); o[j].z = pk2(s[4 * 65], s[5 * 65]); o[j].w = pk2(s[6 * 65], s[7 * 65]); }
    }
    LDS_WAIT(); asm volatile("" ::: "memory");
}
__device__ __forceinline__ void cv_put(const CvItem& I, int lane, const u32x4 (&o)[8]) {
    if (I.f8) { const int c = lane & 7;
#pragma unroll
        for (int j = 0; j < 4; ++j) { const int n = (lane >> 3) + 8 * j; *(u32x4*)(I.dst + (size_t)n * D + I.k0 + 16 * c) = o[j]; }
    } else { const int c = lane & 7;
#pragma unroll
        for (int j = 0; j < 8; ++j) { const int n = (lane >> 3) + 8 * j; *(u32x4*)(I.dst + ((size_t)n * D + I.k0 + 8 * c) * 2) = o[j]; }
    }
}
__device__ __forceinline__ void phase0(Frame& F, const int mode = 0) {
    const int tid = F.tid, lane = F.lane, wave = F.wave;
    if (mode != 2) {
        LAS float* sT = (LAS float*)F.lds;
        LAS float* red = (LAS float*)(F.lds + 40960);
        const float* c = inp(F, I_C); const float* cctx = inp(F, I_CCTX);
        for (int idx = tid; idx < 9 * D; idx += NTHREADS) { const int mb = idx >> 10, k = idx & 1023; const float cv = mb < 8 ? c[mb * D + k] : cctx[k]; sT[idx] = cv / (1.f + __expf(-cv)); }
        __syncthreads();
        float* mod = (float*)(wsp(F) + WS_MOD);
        for (int task = F.vcu; task < DEPTH * 64; task += F.G) {
            const int l = task >> 6, cb = task & 63, hk = lane >= 24 ? 1 : 0, ln = lane - 24 * hk; const bool act = lane < 48;
            const float* wp = inp(F, I_WADA) + ((size_t)l * D + wave * 128 + hk) * 6144 + cb * 96 + ln * 4;
            f32x4 acc[9];
#pragma unroll
            for (int mb = 0; mb < 9; ++mb) acc[mb] = (f32x4){0.f, 0.f, 0.f, 0.f};
#pragma unroll 8
            for (int k2 = 0; k2 < 64; ++k2) { const f32x4 wv = act ? __builtin_nontemporal_load((const f32x4*)(wp + (size_t)k2 * 2 * 6144)) : (f32x4){0.f, 0.f, 0.f, 0.f};
#pragma unroll
                for (int mb = 0; mb < 9; ++mb) acc[mb] += wv * sT[mb * D + wave * 128 + 2 * k2 + hk]; }
#pragma unroll
            for (int mb = 0; mb < 9; ++mb) {
#pragma unroll
                for (int c = 0; c < 4; ++c) acc[mb][c] += shfl_(acc[mb][c], lane + 24);
                if (lane < 24) *(LAS f32x4*)(red + (wave * 9 + mb) * 96 + lane * 4) = acc[mb]; }
            __syncthreads();
            for (int idx = tid; idx < 9 * 96; idx += NTHREADS) { const int mb = idx / 96, cc = idx % 96; float s = 0.f;
#pragma unroll
                for (int w = 0; w < 8; ++w) s += red[(w * 9 + mb) * 96 + cc];
                const int col = cb * 96 + cc;
                mod[(size_t)(l * 9 + mb) * 6144 + col] = s + inp(F, I_BADA)[l * 6144 + col]; }
            __syncthreads();
        }
        {
            bf16_t* rt = (bf16_t*)(wsp(F) + WS_RT); const float* wr = inp(F, I_WR);
            for (int idx = F.vcu * NTHREADS + tid; idx < DEPTH * D * NE; idx += F.G * NTHREADS) { const int l = idx >> 15, k = (idx >> 5) & 1023, e = idx & 31; const float w = wr[idx];
                const unsigned hb16 = f2bf(w); const float hf = __builtin_bit_cast(float, hb16 << 16);
                rt[((size_t)(l * 2 + 0) * NE + e) * D + k] = (bf16_t)hb16; rt[((size_t)(l * 2 + 1) * NE + e) * D + k] = (bf16_t)f2bf(w - hf); }
        }
        if (blockIdx.x == 0) {
            float* rope = (float*)(wsp(F) + WS_ROPE);
            for (int idx = tid; idx < 64 * 16; idx += NTHREADS) { const int pos = idx >> 4, i = idx & 15; const float inv = powf(10000.0f, -(float)i / 16.0f); const float ang = (float)pos * inv;
                rope[idx * 2] = cosf(ang); rope[idx * 2 + 1] = sinf(ang); }
        }
        __syncthreads();
    }
    if (mode != 1) {
        const bool nost = (mode == 3);
        LAS float* scr = (LAS float*)(F.lds + wave * 17024);
        const int gw = F.vcu * NWAVES + wave, NGW = F.G * NWAVES;
        for (int it0 = gw; it0 < CV_NIT; it0 += NGW) {
            const CvItem I0 = cv_item(F, it0);
            f32x4 v[16 / CV_SPLIT]; u32x4 o0[8];
#pragma unroll
            for (int h = 0; h < CV_SPLIT; ++h) { cv_load<16 / CV_SPLIT>(I0, lane, h * (16 / CV_SPLIT), v); cv_lds<16 / CV_SPLIT>(I0, lane, h * (16 / CV_SPLIT), v, scr); }
            cv_conv(I0, lane, scr, o0);
            if (!nost) cv_put(I0, lane, o0);
        }
    }
}

__device__ __forceinline__ void moe_combine(const Frame& F, const int4 pos, const float4 tw, int lprev, int mb, f32x4 (&v)[4]) {
    const int p[4] = {pos.x, pos.y, pos.z, pos.w}; const float w[4] = {tw.x, tw.y, tw.z, tw.w};
    f32x4 a[4];
#pragma unroll
    for (int j = 0; j < 4; ++j) a[j] = (f32x4){0.f, 0.f, 0.f, 0.f};
#if Y_FP8
    const unsigned char* Y = (const unsigned char*)(wsp(F) + WS_Y);
    unsigned y[4][4];
#pragma unroll
    for (int k = 0; k < 4; ++k) { const unsigned* yp = (const unsigned*)(Y + (size_t)p[k] * D) + F.lane;
#pragma unroll
        for (int j = 0; j < 4; ++j) y[k][j] = __builtin_nontemporal_load(yp + 64 * j); }
#pragma unroll
    for (int k = 0; k < 4; ++k) { const float wk = w[k] * (1.0f / 16.0f);
#pragma unroll
        for (int j = 0; j < 4; ++j) { const int yy = (int)y[k][j];
            a[j] = a[j] + wk * (f32x4){__builtin_amdgcn_cvt_f32_fp8(yy, 0), __builtin_amdgcn_cvt_f32_fp8(yy, 1), __builtin_amdgcn_cvt_f32_fp8(yy, 2), __builtin_amdgcn_cvt_f32_fp8(yy, 3)}; } }
#else
    const bf16_t* Y = (const bf16_t*)(wsp(F) + WS_Y);
    u32x2 y[4][4];
#pragma unroll
    for (int k = 0; k < 4; ++k) { const u32x2* yp = (const u32x2*)(Y + (size_t)p[k] * D) + F.lane;
#pragma unroll
        for (int j = 0; j < 4; ++j) y[k][j] = yp[64 * j]; }
#pragma unroll
    for (int k = 0; k < 4; ++k)
#pragma unroll
        for (int j = 0; j < 4; ++j) a[j] = a[j] + w[k] * (f32x4){bflo(y[k][j].x), bfhi(y[k][j].x), bflo(y[k][j].y), bfhi(y[k][j].y)};
#endif
    const f32x4* g2 = (const f32x4*)modp(F, lprev, mb, 5) + F.lane;
#pragma unroll
    for (int j = 0; j < 4; ++j) v[j] = v[j] + g2[64 * j] * a[j];
}

__device__ __forceinline__ void phase_norm1(Frame& F, int l, bool dummy = false) {
    const int gw = F.vcu * NWAVES + F.wave, NGW = F.G * NWAVES, lane = F.lane;
    bf16_t* xs = (bf16_t*)(wsp(F) + WS_XS); bf16_t* hb = (bf16_t*)(wsp(F) + WS_HB);
    bf16_t* xso = dummy ? (bf16_t*)(wsp(F) + WS_ACT) : xs;
    const f32x4* gm = (const f32x4*)(inp(F, I_GMIX) + l * D) + lane;
    const int4* posp = (const int4*)(wsp(F) + WS_POS); const float4* twp = (const float4*)(wsp(F) + WS_TOPW);
    int4 pn = make_int4(0, 0, 0, 0); float4 wn = make_float4(0.f, 0.f, 0.f, 0.f);
    if (l > 0 && gw < ROWS) { pn = posp[gw]; wn = twp[gw]; }
    for (int row = gw; row < ROWS; row += NGW) {
        const int mb = row_mb(row);
        f32x4 v[4];
        if (l == 0) { const float* src = row < ROWS_CTX ? inp(F, I_CTX) + (size_t)row * D : inp(F, I_X) + (size_t)(row - ROWS_CTX) * D; const f32x4* xr = (const f32x4*)src + lane;
#pragma unroll
            for (int j = 0; j < 4; ++j) v[j] = __builtin_nontemporal_load(xr + 64 * j); }
        else { const u32x2* xr = (const u32x2*)(xs + (size_t)row * D) + lane;
#pragma unroll
            for (int j = 0; j < 4; ++j) v[j] = bf4_to_f32(xr[64 * j]); }
        if (l > 0) { const int4 pc = pn; const float4 wc = wn;
            if (row + NGW < ROWS) { pn = posp[row + NGW]; wn = twp[row + NGW]; }
            moe_combine(F, pc, wc, l - 1, mb, v); }
        u32x2* xw = (u32x2*)(xso + (size_t)row * D) + lane;
        float ss = 0.f;
#pragma unroll
        for (int j = 0; j < 4; ++j) { u32x2 xb; xb.x = pk2(v[j][0], v[j][1]); xb.y = pk2(v[j][2], v[j][3]); xw[64 * j] = xb; ss += (v[j][0] * v[j][0] + v[j][1] * v[j][1]) + (v[j][2] * v[j][2] + v[j][3] * v[j][3]); }
        const float rs = 1.0f / sqrtf(wave_sum(ss) * (1.f / D) + EPS);
        const f32x4* sh = (const f32x4*)modp(F, l, mb, 0) + lane; const f32x4* sc = (const f32x4*)modp(F, l, mb, 1) + lane;
        u32x2* o8 = (u32x2*)(hb + (size_t)row * D) + lane;
#pragma unroll
        for (int j = 0; j < 4; ++j) { const f32x4 h = (v[j] * rs) * gm[64 * j] * (sc[64 * j] + 1.0f) + sh[64 * j];
            u32x2 w; w.x = pk2(h[0], h[1]); w.y = pk2(h[2], h[3]); o8[64 * j] = w; }
    }
}
__device__ __forceinline__ void phase_final(Frame& F) {
    const int gw = F.vcu * NWAVES + F.wave, NGW = F.G * NWAVES, lane = F.lane;
    const bf16_t* xs = (const bf16_t*)(wsp(F) + WS_XS);
    const int4* posp = (const int4*)(wsp(F) + WS_POS); const float4* twp = (const float4*)(wsp(F) + WS_TOPW);
    int4 pn = make_int4(0, 0, 0, 0); float4 wn = make_float4(0.f, 0.f, 0.f, 0.f);
    if (ROWS_CTX + gw < ROWS) { pn = posp[ROWS_CTX + gw]; wn = twp[ROWS_CTX + gw]; }
    for (int row = ROWS_CTX + gw; row < ROWS; row += NGW) {
        const int mb = row_mb(row);
        const u32x2* xr = (const u32x2*)(xs + (size_t)row * D) + lane;
        f32x4 v[4];
#pragma unroll
        for (int j = 0; j < 4; ++j) v[j] = bf4_to_f32(__builtin_nontemporal_load(xr + 64 * j));
        const int4 pc = pn; const float4 wc = wn;
        if (row + NGW < ROWS) { pn = posp[row + NGW]; wn = twp[row + NGW]; }
        moe_combine(F, pc, wc, DEPTH - 1, mb, v);
        f32x4* o = (f32x4*)(outp(F) + (size_t)(row - ROWS_CTX) * D) + lane;
#ifdef MLPROF
        { const unsigned long long* pp = (const unsigned long long*)(wsp(F) + WS_CTL + 524288); const float tot = (float)(pp[0] + pp[1] + pp[2] + pp[3] + pp[4] + pp[5]);
          const float f = MLPROF_SEL < 0 ? 0.f : (MLPROF_SEL == 6 ? tot * (1.0f / 1048576.0f) : (MLPROF_SEL > 5 ? 1.f : (float)pp[MLPROF_SEL < 0 ? 0 : (MLPROF_SEL > 5 ? 5 : MLPROF_SEL)] / tot)); const float sc = 2.f + 4.f * f;
          const f32x4* xin = (const f32x4*)(inp(F, I_X) + (size_t)(row - ROWS_CTX) * D) + lane;
#pragma unroll
          for (int j = 0; j < 4; ++j) v[j] = xin[64 * j] * sc; }
#endif
#pragma unroll
        for (int j = 0; j < 4; ++j) __builtin_nontemporal_store(v[j], o + 64 * j);
    }
}

constexpr int NCBP = 96, NA_CTX_EXTRA = 3;
__device__ __forceinline__ bool proj_split(int G) { return false && G >= 2 * NCBP; }
__device__ __forceinline__ void phase_na_post(Frame& F, int jn, const bool split) {
    const int gw = F.vcu * NWAVES + F.wave, NGW = F.G * NWAVES, lane = F.lane;
    constexpr int NIT = (ROWS / 64) * NH_NA, NIT_CTX = (ROWS_CTX / 64) * NH_NA, NIT_IMG = NIT - NIT_CTX;
    const int nwc = NCBP * NWAVES, nwm = NGW - nwc, m1 = NIT_IMG - NA_CTX_EXTRA * nwc;
    const bf16_t* proj = (const bf16_t*)(wsp(F) + WS_PROJ);
    bf16_t* QN = (bf16_t*)(wsp(F) + WS_QN); bf16_t* KN = (bf16_t*)(wsp(F) + WS_KN); bf16_t* VT = (bf16_t*)(wsp(F) + WS_VT);
    LAS bf16_t* vs = (LAS bf16_t*)(F.lds + F.wave * (64 * 72 * 2));
    const int c8 = lane & 7, rl = lane >> 3;
    float qg[8], kg[8];
#pragma unroll
    for (int e = 0; e < 8; ++e) { qg[e] = inp(F, I_QGAIN)[jn * 64 + c8 * 8 + e] * (0.125f * 1.44269504f); kg[e] = inp(F, I_KGAIN)[jn * 64 + c8 * 8 + e]; }
    for (int v = 0; ; ++v) {
        int item;
        if (!split) { item = gw + v * NGW; if (item >= NIT) break; }
        else if (gw < nwc) { if (v == 0) { if (gw >= NIT_CTX) continue; item = gw; } else { if (v > NA_CTX_EXTRA) break; item = NIT_CTX + m1 + gw + (v - 1) * nwc; } }
        else { const int m = (gw - nwc) + v * nwm; if (m >= m1) break; item = NIT_CTX + m; }
        const int rb = item >> 4, h = item & 15, row0 = rb * 64;
        int b, tp0;
        if (row0 < ROWS_CTX) { b = row0 >> 8; tp0 = row0 & 255; } else { b = (row0 - ROWS_CTX) >> 12; tp0 = NCTX + ((row0 - ROWS_CTX) & 4095); }
        const size_t seqbase = ((size_t)(b * NH_NA + h) * TT + tp0) * 64;
#pragma unroll
        for (int i = 0; i < 8; ++i) {
            const int r = i * 8 + rl;
            const bf16_t* pr = proj + (size_t)(row0 + r) * 3072 + h * 64 + c8 * 8;
            const u32x4 qv = *(const u32x4*)pr, kv = *(const u32x4*)(pr + 1024), vv = *(const u32x4*)(pr + 2048);
            float q[8] = {bflo(qv.x), bfhi(qv.x), bflo(qv.y), bfhi(qv.y), bflo(qv.z), bfhi(qv.z), bflo(qv.w), bfhi(qv.w)};
            float k[8] = {bflo(kv.x), bfhi(kv.x), bflo(kv.y), bfhi(kv.y), bflo(kv.z), bfhi(kv.z), bflo(kv.w), bfhi(kv.w)};
            float sq = 0.f, sk = 0.f;
#pragma unroll
            for (int e = 0; e < 8; ++e) { sq += q[e] * q[e]; sk += k[e] * k[e]; }
            sq = sum8(sq); sk = sum8(sk);
            const float rq = 1.0f / sqrtf(sq * (1.f / 64) + EPS), rk = 1.0f / sqrtf(sk * (1.f / 64) + EPS);
            u32x4 qo, ko;
            qo.x = pk2(q[0] * rq * qg[0], q[1] * rq * qg[1]); qo.y = pk2(q[2] * rq * qg[2], q[3] * rq * qg[3]); qo.z = pk2(q[4] * rq * qg[4], q[5] * rq * qg[5]); qo.w = pk2(q[6] * rq * qg[6], q[7] * rq * qg[7]);
            ko.x = pk2(k[0] * rk * kg[0], k[1] * rk * kg[1]); ko.y = pk2(k[2] * rk * kg[2], k[3] * rk * kg[3]); ko.z = pk2(k[4] * rk * kg[4], k[5] * rk * kg[5]); ko.w = pk2(k[6] * rk * kg[6], k[7] * rk * kg[7]);
            *(u32x4*)(QN + seqbase + (size_t)r * 64 + c8 * 8) = qo;
            *(u32x4*)(KN + seqbase + (size_t)r * 64 + c8 * 8) = ko;
            *(LAS u32x4*)(vs + r * 72 + ((c8 ^ ((r >> 3) & 7)) * 8)) = vv;
        }
        LDS_WAIT(); asm volatile("" ::: "memory");
#pragma unroll
        for (int j = 0; j < 8; ++j) {
            const int d = rl + 8 * j;
            const LAS bf16_t* s = vs + (8 * c8) * 72 + (((d >> 3) ^ c8) * 8) + (d & 7);
            u32x4 o;
            o.x = (unsigned)s[0 * 72] | ((unsigned)s[1 * 72] << 16); o.y = (unsigned)s[2 * 72] | ((unsigned)s[3 * 72] << 16);
            o.z = (unsigned)s[4 * 72] | ((unsigned)s[5 * 72] << 16); o.w = (unsigned)s[6 * 72] | ((unsigned)s[7 * 72] << 16);
            *(u32x4*)(VT + ((size_t)(b * NH_NA + h) * 64 + d) * TT + tp0 + 8 * c8) = o;
        }
        LDS_WAIT(); asm volatile("" ::: "memory");
    }
}

__device__ __forceinline__ bf16x8 ld_bf16x8(const bf16_t* p) { return *(const bf16x8*)p; }
constexpr int NA_LD = 72;
constexpr int NA_TILE = 64 * NA_LD * 2;
struct NaState { f32x4 o[4]; f32x4 osum; };
constexpr int NA_RING = 2 * 2 * 64 * NA_LD * 2;
constexpr int NA_CTX_OFF = NA_RING + 15 * 128 * 4;
constexpr int NA_BT_LD = 128, NA_BT_OFF = 48;
constexpr int NA_GQK_OFF = NA_CTX_OFF + 4 * 2 * 64 * NA_LD * 2;
__device__ __forceinline__ int na_row(int b, int tp) { return tp < NCTX ? b * NCTX + tp : ROWS_CTX + b * SEQ + (tp - NCTX); }
__device__ __forceinline__ u32x4 na_knorm(const u32x4 kv) {
    const float k[8] = {bflo(kv.x), bfhi(kv.x), bflo(kv.y), bfhi(kv.y), bflo(kv.z), bfhi(kv.z), bflo(kv.w), bfhi(kv.w)};
    float sk = 0.f;
#pragma unroll
    for (int e = 0; e < 8; ++e) sk += k[e] * k[e];
    sk = sum8(sk);
    const float rk = 1.0f / sqrtf(sk * (1.f / 64) + EPS);
    u32x4 o; o.x = pk2(k[0] * rk, k[1] * rk); o.y = pk2(k[2] * rk, k[3] * rk); o.z = pk2(k[4] * rk, k[5] * rk); o.w = pk2(k[6] * rk, k[7] * rk);
    return o;
}
__device__ __forceinline__ void na_vscatter(LAS bf16_t* vimg, const u32x4 vv, int r, int c8) {
    const unsigned vw[4] = {vv.x, vv.y, vv.z, vv.w};
    LAS bf16_t* d = vimg + (8 * c8) * NA_LD + r;
#pragma unroll
    for (int e = 0; e < 8; ++e) d[e * NA_LD] = (bf16_t)((vw[e >> 1] >> (16 * (e & 1))) & 0xffffu);
}
__device__ __forceinline__ void na_qload(const bf16_t* qp, const LAS float* gqk, int lane, int g, bf16x8 (&q)[2]) {
    const u32x4 a = *(const u32x4*)(qp + 8 * g), c = *(const u32x4*)(qp + 32 + 8 * g);
    const float f0[8] = {bflo(a.x), bfhi(a.x), bflo(a.y), bfhi(a.y), bflo(a.z), bfhi(a.z), bflo(a.w), bfhi(a.w)};
    const float f1[8] = {bflo(c.x), bfhi(c.x), bflo(c.y), bfhi(c.y), bflo(c.z), bfhi(c.z), bflo(c.w), bfhi(c.w)};
    float ss = 0.f;
#pragma unroll
    for (int e = 0; e < 8; ++e) ss += f0[e] * f0[e] + f1[e] * f1[e];
    ss += shfl_(ss, lane ^ 16); ss += shfl_(ss, lane ^ 32);
    const float rq = 1.0f / sqrtf(ss * (1.f / 64) + EPS);
    const f32x4 g0 = *(const LAS f32x4*)(gqk + 8 * g), g1 = *(const LAS f32x4*)(gqk + 8 * g + 4), g2 = *(const LAS f32x4*)(gqk + 32 + 8 * g), g3 = *(const LAS f32x4*)(gqk + 32 + 8 * g + 4);
    union { u32x4 u; bf16x8 v; } o0, o1;
    o0.u.x = pk2(f0[0] * rq * g0[0], f0[1] * rq * g0[1]); o0.u.y = pk2(f0[2] * rq * g0[2], f0[3] * rq * g0[3]); o0.u.z = pk2(f0[4] * rq * g1[0], f0[5] * rq * g1[1]); o0.u.w = pk2(f0[6] * rq * g1[2], f0[7] * rq * g1[3]);
    o1.u.x = pk2(f1[0] * rq * g2[0], f1[1] * rq * g2[1]); o1.u.y = pk2(f1[2] * rq * g2[2], f1[3] * rq * g2[3]); o1.u.z = pk2(f1[4] * rq * g3[0], f1[5] * rq * g3[1]); o1.u.w = pk2(f1[6] * rq * g3[2], f1[7] * rq * g3[3]);
    q[0] = o0.v; q[1] = o1.v;
}
template <bool WIN, bool DOA, bool DOB>
__device__ __forceinline__ void na_half2(NaState& sa, NaState& sb, const LAS bf16_t* KL, const LAS bf16_t* VL, int half, const bf16x8 (&qa)[2], const bf16x8 (&qb)[2],
                                         const LAS float* browA, const unsigned (&mA)[4], const unsigned (&mB)[4], int q16, int g) {
    union { u32x4 u; bf16x8 v; } ones; ones.u = (u32x4){0x3F803F80u, 0x3F803F80u, 0x3F803F80u, 0x3F803F80u};
    const LAS bf16_t* kp = KL + (half * 32 + q16) * NA_LD + 8 * g;
    const bf16x8 kf[2][2] = {{*(const LAS bf16x8*)kp, *(const LAS bf16x8*)(kp + 32)}, {*(const LAS bf16x8*)(kp + 16 * NA_LD), *(const LAS bf16x8*)(kp + 16 * NA_LD + 32)}};
    bf16x8 vf[4];
#pragma unroll
    for (int j4 = 0; j4 < 4; ++j4) { const LAS bf16_t* vp = VL + (16 * j4 + q16) * NA_LD + half * 32 + 4 * g;
        const bf16x4 va = *(const LAS bf16x4*)vp, vb = *(const LAS bf16x4*)(vp + 16);
        vf[j4] = (bf16x8){va[0], va[1], va[2], va[3], vb[0], vb[1], vb[2], vb[3]}; }
#pragma unroll
    for (int grp = 0; grp < 2; ++grp) {
        if ((grp == 0 && !DOA) || (grp == 1 && !DOB)) continue;
        NaState& st = grp ? sb : sa;
        const LAS float* brow = browA - 16 * grp;
        f32x4 sv[2];
#pragma unroll
        for (int nb = 0; nb < 2; ++nb) { f32x4 init = (f32x4){0.f, 0.f, 0.f, 0.f};
            if (WIN) {
#pragma unroll
                for (int rg = 0; rg < 4; ++rg) init[rg] = brow[32 * half + 16 * nb + rg]; }
            init = __builtin_amdgcn_mfma_f32_16x16x32_bf16(kf[nb][0], grp ? qb[0] : qa[0], init, 0, 0, 0);
            sv[nb] = __builtin_amdgcn_mfma_f32_16x16x32_bf16(kf[nb][1], grp ? qb[1] : qa[1], init, 0, 0, 0); }
#pragma unroll
        for (int nb = 0; nb < 2; ++nb)
#pragma unroll
            for (int rg = 0; rg < 4; ++rg) sv[nb][rg] = __builtin_amdgcn_exp2f(__builtin_amdgcn_fmed3f(sv[nb][rg], -3.0e38f, 100.0f));
        union { u32x4 u; bf16x8 v; } pf;
        pf.u.x = pg8::cvt_pk_bf16(sv[0][0], sv[0][1]); pf.u.y = pg8::cvt_pk_bf16(sv[0][2], sv[0][3]); pf.u.z = pg8::cvt_pk_bf16(sv[1][0], sv[1][1]); pf.u.w = pg8::cvt_pk_bf16(sv[1][2], sv[1][3]);
        if (WIN) { const unsigned (&mk)[4] = grp ? mB : mA; pf.u.x &= mk[0]; pf.u.y &= mk[1]; pf.u.z &= mk[2]; pf.u.w &= mk[3]; }
#pragma unroll
        for (int j4 = 0; j4 < 4; ++j4) st.o[j4] = __builtin_amdgcn_mfma_f32_16x16x32_bf16(vf[j4], pf.v, st.o[j4], 0, 0, 0);
        st.osum = __builtin_amdgcn_mfma_f32_16x16x32_bf16(ones.v, pf.v, st.osum, 0, 0, 0);
    }
}
__device__ __forceinline__ void na_block_task(const Frame& F, int jn, int b, int h, bool ctxq, int p) {
    const int tid = F.tid, lane = F.lane, wave = F.wave, q16 = lane & 15, g = lane >> 4;
    const bf16_t* proj = (const bf16_t*)(wsp(F) + WS_PROJ) + h * 64;
    const LAS float* gqk = (const LAS float*)(F.lds + NA_GQK_OFF);
    const int rw = 4 * p + (wave >> 1), ch = wave & 1, qcA = 32 * ch + q16, qcB = qcA + 16;
    const int qtpA = ctxq ? p * 128 + wave * 16 + q16 : NCTX + rw * 64 + qcA, qtpB = ctxq ? qtpA : qtpA + 16;
    bf16x8 qa[2], qb[2];
    na_qload(proj + (size_t)na_row(b, qtpA) * 3072, gqk, lane, g, qa);
    na_qload(proj + (size_t)na_row(b, qtpB) * 3072, gqk, lane, g, qb);
    NaState sa, sb;
#pragma unroll
    for (int j = 0; j < 4; ++j) { sa.o[j] = (f32x4){0.f, 0.f, 0.f, 0.f}; sb.o[j] = (f32x4){0.f, 0.f, 0.f, 0.f}; }
    sa.osum = (f32x4){0.f, 0.f, 0.f, 0.f}; sb.osum = (f32x4){0.f, 0.f, 0.f, 0.f};
    const int r0w = min(max(rw - 4, 0), 56), c0A = min(max(qcA - 8, 0), 48), c0B = min(max(qcB - 8, 0), 48);
    const int kr_lo = min(max(4 * p - 4, 0), 56), kr_hi = min(max(4 * p + 3 - 4, 0), 56) + 7;
    const int nw = ctxq ? 0 : (kr_hi - kr_lo + 1);
    LAS bf16_t* ring = (LAS bf16_t*)F.lds;
    LAS float* btab = (LAS float*)(F.lds + NA_RING);
    const LAS bf16_t* cres = (const LAS bf16_t*)(F.lds + NA_CTX_OFF);
    const int dA = 4 * g - c0A, dB = 4 * g - c0B;
    unsigned mkA[2][4], mkB[2][4];
#pragma unroll
    for (int hh2 = 0; hh2 < 2; ++hh2)
#pragma unroll
        for (int w4 = 0; w4 < 4; ++w4) { const int cc = 32 * hh2 + 16 * (w4 >> 1) + 2 * (w4 & 1);
            mkA[hh2][w4] = (((unsigned)(cc + dA) < 16u) ? 0xFFFFu : 0u) | (((unsigned)(cc + 1 + dA) < 16u) ? 0xFFFF0000u : 0u);
            mkB[hh2][w4] = (((unsigned)(cc + dB) < 16u) ? 0xFFFFu : 0u) | (((unsigned)(cc + 1 + dB) < 16u) ? 0xFFFF0000u : 0u); }
    const int bcolA = NA_BT_OFF + 4 * g - qcA + 15;
    const int r = tid >> 3, c8 = tid & 7;
    u32x4 kA, vA, kB, vB;
#define NA_TOK0(t) (NCTX + 64 * (kr_lo + (t)))
#define NA_LOAD(t, kk, vv) do { const bf16_t* pr_ = proj + (size_t)(ROWS_CTX + b * SEQ + 64 * (kr_lo + (t)) + r) * 3072 + 8 * c8; kk = *(const u32x4*)(pr_ + 1024); vv = *(const u32x4*)(pr_ + 2048); } while (0)
#define NA_WRITE(bufi, kk, vv) do { LAS bf16_t* dst_ = ring + (bufi) * (2 * 64 * NA_LD); *(LAS u32x4*)(dst_ + r * NA_LD + 8 * c8) = na_knorm(kk); na_vscatter(dst_ + 64 * NA_LD, vv, r, c8); } while (0)
#define NA_TILE(t, bufi) do { const LAS bf16_t* KL = ring + (bufi) * (2 * 64 * NA_LD); const LAS bf16_t* VL = KL + 64 * NA_LD; \
        const int kr = kr_lo + (t); \
        if (kr >= r0w && kr <= r0w + 7) { const LAS float* brow = btab + (kr - rw + 7) * NA_BT_LD + bcolA; \
            if (ch == 0) { na_half2<true, true, true>(sa, sb, KL, VL, 0, qa, qb, brow, mkA[0], mkB[0], q16, g); na_half2<true, false, true>(sa, sb, KL, VL, 1, qa, qb, brow, mkA[1], mkB[1], q16, g); } \
            else { na_half2<true, true, false>(sa, sb, KL, VL, 0, qa, qb, brow, mkA[0], mkB[0], q16, g); na_half2<true, true, true>(sa, sb, KL, VL, 1, qa, qb, brow, mkA[1], mkB[1], q16, g); } } } while (0)
    if (!ctxq) { NA_LOAD(0, kA, vA); NA_LOAD(1, kB, vB); }
    if (ctxq) {
#pragma unroll 1
        for (int t = 0; t < 4; ++t) { const LAS bf16_t* KL = cres + t * (2 * 64 * NA_LD);
            na_half2<false, true, false>(sa, sb, KL, KL + 64 * NA_LD, 0, qa, qb, btab, mkA[0], mkB[0], q16, g); na_half2<false, true, false>(sa, sb, KL, KL + 64 * NA_LD, 1, qa, qb, btab, mkA[1], mkB[1], q16, g); }
    } else {
#pragma unroll 1
        for (int t = 0; t < 4; ++t) { const LAS bf16_t* KL = cres + t * (2 * 64 * NA_LD);
            na_half2<false, true, true>(sa, sb, KL, KL + 64 * NA_LD, 0, qa, qb, btab, mkA[0], mkB[0], q16, g); na_half2<false, true, true>(sa, sb, KL, KL + 64 * NA_LD, 1, qa, qb, btab, mkA[1], mkB[1], q16, g); }
        NA_WRITE(0, kA, vA);
        __syncthreads();
        NA_LOAD(2, kA, vA);
        for (int t = 0; t < nw; t += 2) {
            NA_TILE(t, 0);
            if (t + 1 < nw) NA_WRITE(1, kB, vB);
            __syncthreads();
            if (t + 3 < nw) NA_LOAD(t + 3, kB, vB);
            if (t + 1 >= nw) break;
            NA_TILE(t + 1, 1);
            if (t + 2 < nw) NA_WRITE(0, kA, vA);
            __syncthreads();
            if (t + 4 < nw) NA_LOAD(t + 4, kA, vA);
        }
    }
#undef NA_TOK0
#undef NA_LOAD
#undef NA_WRITE
#undef NA_TILE
    {
        const float inv = 1.0f / sa.osum[0];
        const int row = ctxq ? b * NCTX + p * 128 + wave * 16 + q16 : ROWS_CTX + b * SEQ + rw * 64 + qcA;
        bf16_t* op = (bf16_t*)(wsp(F) + WS_AO) + (size_t)row * D + h * 64 + 4 * g;
#pragma unroll
        for (int j4 = 0; j4 < 4; ++j4) { u32x2 w; w.x = pk2(sa.o[j4][0] * inv, sa.o[j4][1] * inv); w.y = pk2(sa.o[j4][2] * inv, sa.o[j4][3] * inv); *(u32x2*)(op + 16 * j4) = w; }
    }
    if (!ctxq) {
        const float inv = 1.0f / sb.osum[0];
        const int row = ROWS_CTX + b * SEQ + rw * 64 + qcB;
        bf16_t* op = (bf16_t*)(wsp(F) + WS_AO) + (size_t)row * D + h * 64 + 4 * g;
#pragma unroll
        for (int j4 = 0; j4 < 4; ++j4) { u32x2 w; w.x = pk2(sb.o[j4][0] * inv, sb.o[j4][1] * inv); w.y = pk2(sb.o[j4][2] * inv, sb.o[j4][3] * inv); *(u32x2*)(op + 16 * j4) = w; }
    }
}
__device__ __forceinline__ void phase_na_attn(Frame& F, int jn) {
    const int nbh = NB * NH_NA;
    for (int slot = F.vcu; slot < 2 * nbh; slot += F.G) {
        const int bh = slot >> 1, hf = slot & 1, b = bh >> 4, h = bh & 15;
        {
            LAS float* btab = (LAS float*)(F.lds + NA_RING);
            const float* rpb = inp(F, I_RPB) + (size_t)(jn * NH_NA + h) * 15 * 31;
            for (int i = F.tid; i < 15 * NA_BT_LD; i += NTHREADS) { const int dr = i >> 7, c = (i & 127) - NA_BT_OFF; btab[i] = (c >= 0 && c < 31) ? rpb[dr * 31 + c] * 1.44269504f : 0.f; }
            const bf16_t* proj = (const bf16_t*)(wsp(F) + WS_PROJ) + h * 64;
            LAS bf16_t* cres = (LAS bf16_t*)(F.lds + NA_CTX_OFF); const int r = F.tid >> 3, c8 = F.tid & 7;
            if (F.tid < 64) ((LAS float*)(F.lds + NA_GQK_OFF))[F.tid] = inp(F, I_QGAIN)[jn * 64 + F.tid] * inp(F, I_KGAIN)[jn * 64 + F.tid] * (0.125f * 1.44269504f);
            u32x4 ck[4], cv[4];
#pragma unroll
            for (int t = 0; t < 4; ++t) { const bf16_t* pr = proj + (size_t)(b * NCTX + 64 * t + r) * 3072 + 8 * c8; ck[t] = *(const u32x4*)(pr + 1024); cv[t] = *(const u32x4*)(pr + 2048); }
#pragma unroll
            for (int t = 0; t < 4; ++t) { LAS bf16_t* dst = cres + t * (2 * 64 * NA_LD);
                *(LAS u32x4*)(dst + r * NA_LD + 8 * c8) = na_knorm(ck[t]);
                na_vscatter(dst + 64 * NA_LD, cv[t], r, c8); }
            __syncthreads();
        }
        for (int n = 0; n < 8; ++n) na_block_task(F, jn, b, h, false, hf * 8 + n);
        na_block_task(F, jn, b, h, true, hf);
        __syncthreads();
    }
}

__device__ __forceinline__ void row_decode(int row, int& b, int& tp) {
    if (row < ROWS_CTX) { b = row >> 8; tp = row & 255; } else { b = (row - ROWS_CTX) >> 12; tp = NCTX + ((row - ROWS_CTX) & 4095); }
}
__device__ __forceinline__ void unpack8(const u32x4 v, float (&f)[8]) { f[0] = bflo(v.x); f[1] = bfhi(v.x); f[2] = bflo(v.y); f[3] = bfhi(v.y); f[4] = bflo(v.z); f[5] = bfhi(v.z); f[6] = bflo(v.w); f[7] = bfhi(v.w); }
__device__ __forceinline__ u32x4 pack8(const float (&f)[8]) { u32x4 o; o.x = pk2(f[0], f[1]); o.y = pk2(f[2], f[3]); o.z = pk2(f[4], f[5]); o.w = pk2(f[6], f[7]); return o; }
__device__ __forceinline__ float wave_prefix_sum(float v, int lane) {
#pragma unroll
    for (int o = 1; o < 64; o <<= 1) { const float t = shfl_(v, lane - o); if (lane >= o) v += t; }
    return v;
}
__device__ __forceinline__ float wave_prefix_max(float v, int lane) {
#pragma unroll
    for (int o = 1; o < 64; o <<= 1) { const float t = shfl_(v, lane - o); if (lane >= o) v = fmaxf(v, t); }
    return v;
}
__device__ __forceinline__ int ml_grow(int b, int tp) { return tp < NCTX ? b * NCTX + tp : ROWS_CTX + b * SEQ + (tp - NCTX); }
__device__ __forceinline__ void phase_ml_post(Frame& F, int jm) {
    const int gw = F.vcu * NWAVES + F.wave, NGW = F.G * NWAVES, lane = F.lane;
    const bf16_t* proj = (const bf16_t*)(wsp(F) + WS_PROJ);
    float* gs = (float*)(wsp(F) + WS_GS);
    for (int task = gw; task < NB * (TT / 64); task += NGW) {
        const int b = task / (TT / 64), mc = task % (TT / 64);
        const bf16_t* pr = proj + (size_t)ml_grow(b, mc * 64 + lane) * ML_INP + 3072;
        float gp[32];
        { float t8[8];
#pragma unroll
          for (int q = 0; q < 4; ++q) { unpack8(*(const u32x4*)(pr + 8 * q), t8);
#pragma unroll
              for (int e = 0; e < 8; ++e) gp[8 * q + e] = t8[e]; } }
#pragma unroll
        for (int i = 0; i < 32; ++i) { float v = gp[i] + inp(F, I_BGATE)[jm * 32 + i]; v = 15.0f * tanhf(v * (1.0f / 15.0f));
            if ((i >> 3) & 1) v = fminf(v, 0.f) - log1pf(__expf(-fabsf(v)));
            gp[i] = v; }
#pragma unroll
        for (int dir = 0; dir < 2; ++dir)
#pragma unroll
            for (int hh = 0; hh < NH_ML; ++hh) {
                float ig = gp[(2 * dir) * 8 + hh], lf = gp[(2 * dir + 1) * 8 + hh];
                if (dir) { ig = shfl_(ig, 63 - lane); lf = shfl_(lf, 63 - lane); }
                const float cum = wave_prefix_sum(lf, lane), av = ig - cum, pmax = wave_prefix_max(av, lane), cl = shfl_(cum, 63);
                const float wend = cl - cum + ig, ml = wave_max(wend), eend = __expf(wend - ml);
                float* o = gs + ((((size_t)(dir * NB + b) * NH_ML + hh) * (TT / 64) + mc) * 5) * 64;
                o[lane] = cum; o[64 + lane] = av; o[128 + lane] = pmax; o[192 + lane] = eend; if (lane == 0) { o[256] = cl; o[257] = ml; }
            }
    }
}

constexpr int ML_LD = 72;
constexpr int ML_QL = 0, ML_KL = 9216, ML_KET = 18432, ML_VTL = 27648, ML_SDL = 36864, ML_C0L = 46080, ML_N0L = 55296, ML_DENL = 55552;
constexpr int ML_HL = 55808, ML_GL = 65024;
constexpr int ML_ALT = 69632;
__device__ __forceinline__ void ml_task(Frame& F, int jm, int b, int hh, int dir, int vh) {
    const int tid = F.tid, lane = F.lane, w = F.wave, l15 = lane & 15, g = lane >> 4;
    LAS bf16_t* QL = (LAS bf16_t*)(F.lds + ML_QL); LAS bf16_t* KL = (LAS bf16_t*)(F.lds + ML_KL); LAS bf16_t* KET = (LAS bf16_t*)(F.lds + ML_KET);
    LAS bf16_t* VTL = (LAS bf16_t*)(F.lds + ML_VTL); LAS bf16_t* SDL = (LAS bf16_t*)(F.lds + ML_SDL); LAS bf16_t* C0L = (LAS bf16_t*)(F.lds + ML_C0L);
    LAS float* n0L = (LAS float*)(F.lds + ML_N0L); LAS float* denL = (LAS float*)(F.lds + ML_DENL);
    LAS bf16_t* HL = (LAS bf16_t*)(F.lds + ML_HL); LAS float* GL = (LAS float*)(F.lds + ML_GL);
    const bf16_t* proj = (const bf16_t*)(wsp(F) + WS_PROJ);
    const float* gsb = (const float*)(wsp(F) + WS_GS) + (((size_t)(dir * NB + b) * NH_ML + hh) * (TT / 64)) * 5 * 64;
    bf16_t* hout = (bf16_t*)(wsp(F) + WS_HDIR) + (size_t)dir * ROWS * D + hh * DV_ML + vh * 64;
    {
        const float bi = inp(F, I_BGATE)[jm * 32 + (2 * dir) * 8 + hh], bfg = inp(F, I_BGATE)[jm * 32 + (2 * dir + 1) * 8 + hh];
        float* gso = (float*)(wsp(F) + WS_GS) + (((size_t)(dir * NB + b) * NH_ML + hh) * (TT / 64)) * 5 * 64;
        for (int mc = w; mc < TT / 64; mc += NWAVES) {
            const bf16_t* pr = proj + (size_t)ml_grow(b, mc * 64 + lane) * ML_INP + 3072;
            float ig = bf2f(pr[(2 * dir) * 8 + hh]) + bi; ig = 15.0f * tanhf(ig * (1.0f / 15.0f));
            float lf = bf2f(pr[(2 * dir + 1) * 8 + hh]) + bfg; lf = 15.0f * tanhf(lf * (1.0f / 15.0f)); lf = fminf(lf, 0.f) - log1pf(__expf(-fabsf(lf)));
            if (dir) { ig = shfl_(ig, 63 - lane); lf = shfl_(lf, 63 - lane); }
            const float cum = wave_prefix_sum(lf, lane), av = ig - cum, pmax = wave_prefix_max(av, lane), cl = shfl_(cum, 63);
            const float wend = cl - cum + ig, ml = wave_max(wend), eend = __expf(wend - ml);
            float* o = gso + (size_t)mc * 5 * 64;
            o[lane] = cum; o[64 + lane] = av; o[128 + lane] = pmax; o[192 + lane] = eend; if (lane == 0) { o[256] = cl; o[257] = ml; }
        }
        VM_WAIT();
        __syncthreads();
    }
    const bool loader = (0x2Bu >> w) & 1u;
    const int ridx = __builtin_popcount((loader ? 0x2Bu : 0xD4u) & ((1u << w) - 1u));
    const int c8 = lane & 7, r0 = ridx * 8 + (lane >> 3);
    const int bt = w >> 1, bc0 = 2 * (w & 1);
    for (int i = tid; i < 64 * ML_LD / 2; i += NTHREADS) { ((LAS unsigned*)C0L)[i] = 0u; ((LAS unsigned*)SDL)[i] = 0u; }
    if (tid < 64) n0L[tid] = 0.f;
    f32x4 Cst[2]; Cst[0] = (f32x4){0.f, 0.f, 0.f, 0.f}; Cst[1] = (f32x4){0.f, 0.f, 0.f, 0.f};
    float nst = 0.f, m0 = 0.f;
#ifdef MLPROF
    unsigned long long pa_[6] = {0, 0, 0, 0, 0, 0}, pt_; asm volatile("s_memtime %0\n\ts_waitcnt lgkmcnt(0)" : "=s"(pt_) :: "memory");
#define PROFPT(k) do { unsigned long long n_; __builtin_amdgcn_sched_barrier(0); asm volatile("s_memtime %0\n\ts_waitcnt lgkmcnt(0)" : "=s"(n_) :: "memory"); __builtin_amdgcn_sched_barrier(0); pa_[k] += n_ - pt_; pt_ = n_; } while (0)
#else
#define PROFPT(k) do {} while (0)
#endif
    u32x4 qA[2], kA[2], vA[2]; float gA[6];
#define ML_TB(c) (dir ? ((c) < 4 ? 192 - 64 * (c) : 4544 - 64 * (c)) : 64 * (c))
#ifdef MLHOT
#define ML_TBL(cn) ML_TB(0)
#else
#define ML_TBL(cn) ML_TB(cn)
#endif
#define ML_LOADSET(cn, QV, KV, VV, GG) do { const int tbn_ = ML_TBL(cn); \
        _Pragma("unroll") for (int h2 = 0; h2 < 2; ++h2) { const bf16_t* pr_ = proj + (size_t)ml_grow(b, tbn_ + r0 + 32 * h2) * ML_INP; \
            QV[h2] = *(const u32x4*)(pr_ + hh * 64 + c8 * 8); KV[h2] = *(const u32x4*)(pr_ + 512 + hh * 64 + c8 * 8); VV[h2] = *(const u32x4*)(pr_ + 1024 + hh * DV_ML + vh * 64 + c8 * 8); } \
        const float* gp_ = gsb + (size_t)(tbn_ >> 6) * 5 * 64; \
        GG[0] = gp_[lane]; GG[1] = gp_[64 + lane]; GG[2] = gp_[128 + lane]; GG[3] = gp_[192 + lane]; GG[4] = gp_[256]; GG[5] = gp_[257]; } while (0)
#define ML_WRITESET(PBW, QV, KV, VV, GG) do { LAS bf16_t* QLw = QL + (PBW) * (ML_ALT / 2); LAS bf16_t* KLw = KL + (PBW) * (ML_ALT / 2); LAS bf16_t* KETw = KET + (PBW) * (ML_ALT / 2); LAS bf16_t* VTLw = VTL + (PBW) * (ML_ALT / 2); LAS float* GLw = GL + (PBW) * (ML_ALT / 4); \
        _Pragma("unroll") for (int h2 = 0; h2 < 2; ++h2) { const int rr_ = r0 + 32 * h2, sr = dir ? 63 - rr_ : rr_; \
            *(LAS u32x4*)(QLw + sr * ML_LD + c8 * 8) = QV[h2]; *(LAS u32x4*)(KLw + sr * ML_LD + c8 * 8) = KV[h2]; \
            const float es = shfl_(GG[3], sr); float kf[8]; unpack8(KV[h2], kf); const unsigned vw[4] = {VV[h2].x, VV[h2].y, VV[h2].z, VV[h2].w}; \
            _Pragma("unroll") for (int e = 0; e < 8; ++e) { KETw[(c8 * 8 + e) * ML_LD + (sr ^ (8 * c8))] = (bf16_t)pk2(kf[e] * es, 0.f); VTLw[(c8 * 8 + e) * ML_LD + (sr ^ (8 * c8))] = (bf16_t)((vw[e >> 1] >> (16 * (e & 1))) & 0xffffu); } } \
        if (w == 0) { GLw[lane] = GG[0]; GLw[64 + lane] = GG[1]; GLw[128 + lane] = GG[2]; if (lane == 0) { GLw[192] = GG[4]; GLw[193] = GG[5]; } } } while (0)
#define ML_STOREH(cp) do { const int tbp_ = ML_TB(cp); \
        _Pragma("unroll") for (int h2 = 0; h2 < 2; ++h2) { const int rr_ = r0 + 32 * h2; \
            *(u32x4*)(hout + (size_t)ml_grow(b, tbp_ + rr_) * D + c8 * 8) = *(const LAS u32x4*)(HL + rr_ * ML_LD + c8 * 8); } } while (0)
#define ML_CHUNK(c, PB, QV, KV, VV, GG) do {     \
        const int tb = ML_TB(c); \
        LAS bf16_t* QLc = QL + (PB) * (ML_ALT / 2); LAS bf16_t* KLc = KL + (PB) * (ML_ALT / 2); LAS bf16_t* KETc = KET + (PB) * (ML_ALT / 2); LAS bf16_t* VTLc = VTL + (PB) * (ML_ALT / 2); LAS float* GLc = GL + (PB) * (ML_ALT / 4); \
        const float cum = GLc[lane], av = GLc[64 + lane], pmax = GLc[128 + lane], cl = GLc[192], ml = GLc[193]; \
        const float Mv = fmaxf(m0, pmax); \
        const float winter = __expf(m0 - Mv); \
        const float floorv = __expf(-(cum + Mv)); \
        const float mnew = fmaxf(cl + m0, ml); \
        const float Ac = __expf(cl + m0 - mnew), Gc = __expf(ml - mnew); \
        _Pragma("unroll") for (int x = 0; x < 2; ++x) { \
            const int bs = bc0 + x; \
            if (bs <= bt) {     \
                f32x4 acc = (f32x4){0.f, 0.f, 0.f, 0.f}; \
                _Pragma("unroll") for (int ks = 0; ks < 2; ++ks) { const bf16x8 af = *(const LAS bf16x8*)(QLc + (16 * bt + l15) * ML_LD + 32 * ks + 8 * g), bfv = *(const LAS bf16x8*)(KLc + (16 * bs + l15) * ML_LD + 32 * ks + 8 * g); \
                    acc = __builtin_amdgcn_mfma_f32_16x16x32_bf16(af, bfv, acc, 0, 0, 0); } \
                const int s = 16 * bs + l15; \
                const float a_s = shfl_(av, s); \
                _Pragma("unroll") for (int rg = 0; rg < 4; ++rg) { const int t = 16 * bt + 4 * g + rg; const float M_t = shfl_(Mv, t); \
                    const float val = (s <= t) ? acc[rg] * __expf(a_s - M_t) : 0.f; \
                    SDL[t * ML_LD + s] = (bf16_t)pk2(val, 0.f); } \
            } \
        } \
        if (loader) { if ((c) + 1 < TT / 64) ML_WRITESET(1 - (PB), QV, KV, VV, GG); if ((c) + 2 < TT / 64) ML_LOADSET((c) + 2, QV, KV, VV, GG); }     \
        PROFPT(2); __syncthreads(); PROFPT(3);                                                 \
        if (!loader && (c) > 0) ML_STOREH((c) - 1); \
        { \
            const int rr8 = 8 * w + (lane >> 3), part = lane & 7; \
            float sd[8], qf[8], kf[8]; \
            unpack8(*(const LAS u32x4*)(SDL + rr8 * ML_LD + 8 * part), sd); unpack8(*(const LAS u32x4*)(QLc + rr8 * ML_LD + 8 * part), qf); \
            unpack8(*(const LAS u32x4*)(KETc + rr8 * ML_LD + ((8 * part) ^ (8 * ((rr8 >> 3) & 7)))), kf); \
            const f32x4 n0a = *(const LAS f32x4*)(n0L + 8 * part), n0b = *(const LAS f32x4*)(n0L + 8 * part + 4); \
            float rs = ((sd[0] + sd[1]) + (sd[2] + sd[3])) + ((sd[4] + sd[5]) + (sd[6] + sd[7])); \
            float qn = qf[0] * n0a[0] + qf[1] * n0a[1] + qf[2] * n0a[2] + qf[3] * n0a[3] + qf[4] * n0b[0] + qf[5] * n0b[1] + qf[6] * n0b[2] + qf[7] * n0b[3]; \
            float dn = ((kf[0] + kf[1]) + (kf[2] + kf[3])) + ((kf[4] + kf[5]) + (kf[6] + kf[7])); \
            rs = sum8(rs); qn = sum8(qn); dn = sum8(dn); \
            const float w_r = shfl_(winter, rr8); \
            if (part == 0) denL[rr8] = rs + w_r * qn; \
            nst = Ac * nst + Gc * dn; \
        } \
        f32x4 nin[2], nit[2]; \
        _Pragma("unroll") for (int x = 0; x < 2; ++x) { \
            const int bv = bc0 + x; \
            f32x4 a1 = (f32x4){0.f, 0.f, 0.f, 0.f}, a2 = (f32x4){0.f, 0.f, 0.f, 0.f}, a3 = (f32x4){0.f, 0.f, 0.f, 0.f}; \
            _Pragma("unroll") for (int ks = 0; ks < 2; ++ks) { \
                const bf16x8 sdf = *(const LAS bf16x8*)(SDL + (16 * bt + l15) * ML_LD + 32 * ks + 8 * g), vtf = *(const LAS bf16x8*)(VTLc + (16 * bv + l15) * ML_LD + ((32 * ks + 8 * g) ^ (8 * (((16 * bv + l15) >> 3) & 7)))); \
                const bf16x8 qf = *(const LAS bf16x8*)(QLc + (16 * bt + l15) * ML_LD + 32 * ks + 8 * g), c0f = *(const LAS bf16x8*)(C0L + (16 * bv + l15) * ML_LD + 32 * ks + 8 * g); \
                const bf16x8 vt2 = *(const LAS bf16x8*)(VTLc + (16 * bt + l15) * ML_LD + ((32 * ks + 8 * g) ^ (8 * (((16 * bt + l15) >> 3) & 7)))), kef = *(const LAS bf16x8*)(KETc + (16 * bv + l15) * ML_LD + ((32 * ks + 8 * g) ^ (8 * (((16 * bv + l15) >> 3) & 7)))); \
                a1 = __builtin_amdgcn_mfma_f32_16x16x32_bf16(sdf, vtf, a1, 0, 0, 0); \
                a2 = __builtin_amdgcn_mfma_f32_16x16x32_bf16(qf, c0f, a2, 0, 0, 0); \
                a3 = __builtin_amdgcn_mfma_f32_16x16x32_bf16(vt2, kef, a3, 0, 0, 0); \
            } \
            nin[x] = a1; nit[x] = a2; \
            Cst[x] = Cst[x] * Ac + a3 * Gc; \
        } \
        PROFPT(4); __syncthreads(); PROFPT(3);                                                 \
        if ((lane & 7) == 0) n0L[8 * w + (lane >> 3)] = nst; \
        _Pragma("unroll") for (int x = 0; x < 2; ++x) { \
            const int bv = bc0 + x; \
            _Pragma("unroll") for (int rg = 0; rg < 4; ++rg) { const int t = 16 * bt + 4 * g + rg; \
                const float den = denL[t], w_t = shfl_(winter, t), fl_t = shfl_(floorv, t); \
                const float hv = (nin[x][rg] + w_t * nit[x][rg]) * __builtin_amdgcn_rcpf(fmaxf(fabsf(den), fl_t)); \
                const int rr = dir ? 63 - t : t; \
                HL[rr * ML_LD + 16 * bv + l15] = (bf16_t)pk2(hv, 0.f); \
                C0L[(16 * bt + 4 * g + rg) * ML_LD + 16 * bv + l15] = (bf16_t)pk2(Cst[x][rg], 0.f); } \
        } \
        m0 = mnew; \
        (void)tb; PROFPT(5); \
    } while (0)
    if (loader) { ML_LOADSET(0, qA, kA, vA, gA); ML_WRITESET(0, qA, kA, vA, gA); ML_LOADSET(1, qA, kA, vA, gA); }
    __syncthreads();
    for (int c = 0; c < TT / 64; c += 2) {
        ML_CHUNK(c, 0, qA, kA, vA, gA);
        ML_CHUNK(c + 1, 1, qA, kA, vA, gA);
    }
    __syncthreads();
    if (!loader) ML_STOREH(TT / 64 - 1);
#ifdef MLPROF
    if (F.vcu == MLPROF_BLK && tid == MLPROF_WAVE * 64) { unsigned long long* pp = (unsigned long long*)(wsp(F) + WS_CTL + 524288); pp[0] = pa_[0]; pp[1] = pa_[1]; pp[2] = pa_[2]; pp[3] = pa_[3]; pp[4] = pa_[4]; pp[5] = pa_[5]; }
#endif
#undef ML_CHUNK
#undef ML_STOREH
#undef ML_WRITESET
#undef ML_LOADSET
#undef ML_TB
    __syncthreads();
}
__device__ __forceinline__ void phase_ml_scan(Frame& F, int jm) {
    for (int task = F.vcu; task < NB * NH_ML * 4; task += F.G) {
        const int vh = task & 1, dir = (task >> 1) & 1, bh = task >> 2;
        ml_task(F, jm, bh >> 3, bh & 7, dir, vh);
    }
}

__device__ __forceinline__ void phase_ml_final(Frame& F, int jm) {
    const int gw = F.vcu * NWAVES + F.wave, NGW = F.G * NWAVES, lane = F.lane;
    const bf16_t* hfw = (const bf16_t*)(wsp(F) + WS_HDIR); const bf16_t* hbw = hfw + (size_t)ROWS * D;
    const bf16_t* proj = (const bf16_t*)(wsp(F) + WS_PROJ);
    bf16_t* ao = (bf16_t*)(wsp(F) + WS_AO);
    const float* gain = inp(F, I_MHGAIN) + jm * D + lane * 16;
    for (int row = gw; row < ROWS; row += NGW) {
        const size_t off = (size_t)row * D + lane * 16;
        float a0[8], a1[8], b0[8], b1[8], g0[8], g1[8];
        unpack8(*(const u32x4*)(hfw + off), a0); unpack8(*(const u32x4*)(hfw + off + 8), a1);
        unpack8(*(const u32x4*)(hbw + off), b0); unpack8(*(const u32x4*)(hbw + off + 8), b1);
        const bf16_t* ogp = proj + (size_t)row * ML_INP + 2048 + lane * 16;
        unpack8(*(const u32x4*)ogp, g0); unpack8(*(const u32x4*)(ogp + 8), g1);
        float ss = 0.f;
#pragma unroll
        for (int e = 0; e < 8; ++e) { a0[e] += b0[e]; a1[e] += b1[e]; ss += a0[e] * a0[e] + a1[e] * a1[e]; }
        ss = sum8(ss);
        const float rs = 1.0f / sqrtf(ss * (1.f / DV_ML) + EPS);
        float o0[8], o1[8];
#pragma unroll
        for (int e = 0; e < 8; ++e) { o0[e] = a0[e] * rs * gain[e] * sigmoidf_(g0[e]); o1[e] = a1[e] * rs * gain[8 + e] * sigmoidf_(g1[e]); }
        *(u32x4*)(ao + off) = pack8(o0); *(u32x4*)(ao + off + 8) = pack8(o1);
    }
}

constexpr int RT_LD = 1032;
constexpr int RT_HI = 0, RT_LO = NE * RT_LD * 2, RT_LG = 2 * NE * RT_LD * 2;
__device__ __forceinline__ int rows_per_block(int first_row, int G) { return (ROWS - first_row + G - 1) / G; }
constexpr int NCB = 32;
__device__ __forceinline__ bool ctx_split(int first_row, int G) { return first_row == 0 && G > 2 * NCB; }
__device__ __forceinline__ void block_rows(int first_row, int vcu, int G, int& rbeg, int& rend) {
    if (ctx_split(first_row, G)) {
        if (vcu < NCB) { const int per = ROWS_CTX / NCB; rbeg = vcu * per; rend = rbeg + per; }
        else { const int per = (ROWS - ROWS_CTX + (G - NCB) - 1) / (G - NCB); rbeg = min(ROWS_CTX + (vcu - NCB) * per, ROWS); rend = min(rbeg + per, ROWS); }
    } else { const int RPB = rows_per_block(first_row, G); rbeg = min(first_row + vcu * RPB, ROWS); rend = min(rbeg + RPB, ROWS); }
}
__device__ __forceinline__ void phase_norm2_router(Frame& F, int l, int first_row) {
    const int tid = F.tid, lane = F.lane, wave = F.wave, l15 = lane & 15, g = lane >> 4;
    LAS bf16_t* whi = (LAS bf16_t*)(F.lds + RT_HI); LAS bf16_t* wlo = (LAS bf16_t*)(F.lds + RT_LO);
    LAS float* lgs = (LAS float*)(F.lds + RT_LG) + wave * (16 * 33);
    volatile LAS int* cntL = F.LCTL + 64;
    {
        const bf16_t* rt = (const bf16_t*)(wsp(F) + WS_RT) + (size_t)l * 2 * NE * D;
#pragma unroll 4
        for (int c = tid; c < 2 * NE * 128; c += NTHREADS) { const int tbl = c >> 12, e = (c >> 7) & 31, kc = c & 127;
            *(LAS u32x4*)((tbl ? wlo : whi) + e * RT_LD + kc * 8) = *(const u32x4*)(rt + ((size_t)tbl * NE + e) * D + kc * 8); }
    }
    if (tid < NE) cntL[tid] = 0;
    const bf16_t* xs = (const bf16_t*)(wsp(F) + WS_XS); bf16_t* hb = (bf16_t*)(wsp(F) + WS_HB);
    int* tope = (int*)(wsp(F) + WS_TOPE); float* topw = (float*)(wsp(F) + WS_TOPW);
    const f32x4* gm = (const f32x4*)(inp(F, I_GFFN) + l * D) + lane;
    int rbeg, rend; block_rows(first_row, F.vcu, F.G, rbeg, rend);
    for (int row = rbeg + wave; row < rend; row += NWAVES) {
        const int mb = row_mb(row);
        const u32x2* xr = (const u32x2*)(xs + (size_t)row * D) + lane;
        f32x4 v[4]; float ss = 0.f;
#pragma unroll
        for (int j = 0; j < 4; ++j) { v[j] = bf4_to_f32(xr[64 * j]); ss += (v[j][0] * v[j][0] + v[j][1] * v[j][1]) + (v[j][2] * v[j][2] + v[j][3] * v[j][3]); }
        const float rs = 1.0f / sqrtf(wave_sum(ss) * (1.f / D) + EPS);
        const f32x4* sh = (const f32x4*)modp(F, l, mb, 3) + lane; const f32x4* sc = (const f32x4*)modp(F, l, mb, 4) + lane;
        u32x2* o8 = (u32x2*)(hb + (size_t)row * D) + lane;
        unsigned* o4 = (unsigned*)(wsp(F) + WS_HB8 + (size_t)row * D) + lane;
#pragma unroll
        for (int j = 0; j < 4; ++j) { const f32x4 h = (v[j] * rs) * gm[64 * j] * (sc[64 * j] + 1.0f) + sh[64 * j];
            u32x2 wv; wv.x = pk2(h[0], h[1]); wv.y = pk2(h[2], h[3]); o8[64 * j] = wv;
            const f32x4 hq = __builtin_elementwise_min(__builtin_elementwise_max(h * 16.0f, (f32x4){-448.f, -448.f, -448.f, -448.f}), (f32x4){448.f, 448.f, 448.f, 448.f});
            o4[64 * j] = pk4_fp8(hq[0], hq[1], hq[2], hq[3]); }
    }
    VM_WAIT();
    __syncthreads();
    const float br0 = inp(F, I_BR)[l * NE + l15], br1 = inp(F, I_BR)[l * NE + 16 + l15];
    for (int g0 = rbeg + 16 * wave; g0 < rend; g0 += 16 * NWAVES) {
        const int arow = min(g0 + l15, rend - 1);
        const bf16_t* ap = hb + (size_t)arow * D + 8 * g;
        f32x4 acc0 = (f32x4){0.f, 0.f, 0.f, 0.f}, acc1 = (f32x4){0.f, 0.f, 0.f, 0.f};
        bf16x8 afr[32];
#pragma unroll
        for (int ks = 0; ks < 32; ++ks) afr[ks] = *(const bf16x8*)(ap + 32 * ks);
#pragma unroll
        for (int ks = 0; ks < 32; ++ks) {
            const bf16x8 af = afr[ks];
            const bf16x8 h0 = *(const LAS bf16x8*)(whi + l15 * RT_LD + 32 * ks + 8 * g), h1 = *(const LAS bf16x8*)(whi + (16 + l15) * RT_LD + 32 * ks + 8 * g);
            const bf16x8 l0 = *(const LAS bf16x8*)(wlo + l15 * RT_LD + 32 * ks + 8 * g), l1 = *(const LAS bf16x8*)(wlo + (16 + l15) * RT_LD + 32 * ks + 8 * g);
            acc0 = __builtin_amdgcn_mfma_f32_16x16x32_bf16(af, h0, acc0, 0, 0, 0); acc1 = __builtin_amdgcn_mfma_f32_16x16x32_bf16(af, h1, acc1, 0, 0, 0);
            acc0 = __builtin_amdgcn_mfma_f32_16x16x32_bf16(af, l0, acc0, 0, 0, 0); acc1 = __builtin_amdgcn_mfma_f32_16x16x32_bf16(af, l1, acc1, 0, 0, 0);
        }
#pragma unroll
        for (int rg = 0; rg < 4; ++rg) { lgs[(4 * g + rg) * 33 + l15] = acc0[rg] + br0; lgs[(4 * g + rg) * 33 + 16 + l15] = acc1[rg] + br1; }
        LDS_WAIT(); asm volatile("" ::: "memory");
        const int row = g0 + lane;
        if (lane < 16 && row < rend) {
            float lg[32];
#pragma unroll
            for (int e = 0; e < 32; ++e) lg[e] = lgs[lane * 33 + e];
            int sel[4]; float sv[4]; unsigned used = 0u;
#pragma unroll
            for (int k = 0; k < 4; ++k) { float best = -3.0e38f; int bi = 0;
#pragma unroll
                for (int e = 0; e < 32; ++e) { const bool take = !((used >> e) & 1u) && (lg[e] > best); best = take ? lg[e] : best; bi = take ? e : bi; }
                used |= 1u << bi; sel[k] = bi; sv[k] = best; }
            const float e1 = __expf(sv[1] - sv[0]), e2 = __expf(sv[2] - sv[0]), e3 = __expf(sv[3] - sv[0]);
            const float inv = 1.0f / (1.0f + e1 + e2 + e3);
            *(int4*)(tope + (size_t)row * 4) = make_int4(sel[0], sel[1], sel[2], sel[3]);
            *(float4*)(topw + (size_t)row * 4) = make_float4(inv, e1 * inv, e2 * inv, e3 * inv);
#pragma unroll
            for (int k = 0; k < 4; ++k) __hip_atomic_fetch_add((LAS int*)&cntL[sel[k]], 1, __ATOMIC_RELAXED, __HIP_MEMORY_SCOPE_WORKGROUP);
        }
        LDS_WAIT(); asm volatile("" ::: "memory");
    }
    __syncthreads();
    if (tid < NE) ((int*)(wsp(F) + WS_CNT))[F.vcu * NE + tid] = cntL[tid];
}

__device__ __forceinline__ void phase_positions(Frame& F, int first_row) {
    const int tid = F.tid, lane = F.lane;
    LAS int* tot = (LAS int*)F.lds;
    LAS int* bef = tot + 512;
    LAS int* baseL = bef + 512;
    LAS int* totL = baseL + 32;
    const int* cnt = (const int*)(wsp(F) + WS_CNT);
    {
        const int e = tid & 31, part = tid >> 5;
        int s = 0, sb = 0;
        for (int j = part; j < F.G; j += 16) { const int cv = cnt[j * NE + e]; s += cv; sb += (j < F.vcu) ? cv : 0; }
        tot[part * 32 + e] = s; bef[part * 32 + e] = sb;
    }
    __syncthreads();
    if (tid < NE) { int s = 0, sb = 0;
        for (int p = 0; p < 16; ++p) { s += tot[p * 32 + tid]; sb += bef[p * 32 + tid]; }
        totL[tid] = s; baseL[tid] = sb; }
    __syncthreads();
    if (F.wave == 0) {
        const int mine = (lane < NE) ? ((totL[lane & 31] + 255) >> 8) : 0;
        int inc = mine;
#pragma unroll
        for (int d = 1; d < 32; d <<= 1) { const int o = shfl_(inc, lane - d); inc += (lane >= d) ? o : 0; }
        if (lane < NE) F.LCTL[8 + lane] = inc - mine;
        if (lane == NE - 1) { F.LCTL[8 + NE] = inc; F.LCTL[48] = inc; }
    }
    __syncthreads();
    int* tokmap = (int*)(wsp(F) + WS_TOKMAP);
    if (F.vcu == 0) {
        int* meta = (int*)(wsp(F) + WS_META);
        if (tid <= NE) meta[tid] = F.LCTL[8 + tid];
        if (tid == 0) meta[33] = F.LCTL[48];
        { const int e = tid >> 4, rb = 256 * F.LCTL[8 + e], n = totL[e], cap = 256 * (F.LCTL[8 + e + 1] - F.LCTL[8 + e]);
            for (int rr = n + (tid & 15); rr < cap; rr += 16) tokmap[rb + rr] = first_row; }
    }
    {
        const int* tope = (const int*)(wsp(F) + WS_TOPE); int* pos = (int*)(wsp(F) + WS_POS);
        const int e0 = 4 * F.wave;
        int basereg = (lane < 4) ? 256 * F.LCTL[8 + e0 + lane] + baseL[e0 + lane] : 0;
        int rbeg, rend; block_rows(first_row, F.vcu, F.G, rbeg, rend);
        for (int r0 = rbeg; r0 < rend; r0 += 16) {
            const int row = r0 + (lane >> 2), k = lane & 3;
            const bool valid = row < rend;
            const int e = valid ? tope[(size_t)row * 4 + k] : -1;
            int p = -1;
#pragma unroll
            for (int j = 0; j < 4; ++j) {
                const unsigned long long mask = __ballot(e == e0 + j);
                const int b0 = shfl_(basereg, j);
                if (e == e0 + j) p = b0 + __popcll(mask & ((1ull << lane) - 1ull));
                if (lane == j) basereg += __popcll(mask);
            }
            if (p >= 0) { pos[(size_t)row * 4 + k] = p; tokmap[p] = row; }
        }
    }
}

#ifndef PMASK
#define PMASK 0xFFFF
#endif
#define PE(k) (((PMASK) >> (k)) & 1)
#ifndef RMASK
#define RMASK 0
#endif
#define RP(k) for (int rep_ = 0; rep_ < ((((RMASK) >> (k)) & 1) ? 2 : 1); ++rep_, __syncthreads())
#ifdef NOEPI
#define SKIPE(k) ((((RMASK) >> (k)) & 1) && rep_ == 0)
#else
#define SKIPE(k) false
#endif
#ifndef P0PROBE
#define P0PROBE 0
#endif
#ifndef MOE_ALIGN
#define MOE_ALIGN true
#endif
constexpr int LDS_TILE_E = pg8::STAGE_BYTES;
constexpr int LDS_TOKL = LDS_TILE_E + MAXTILES * 4;
static_assert(LDS_TOKL + 28 * 1024 <= LDS_CTL_OFF, "LDS map");
__device__ __forceinline__ void moe_tile_table(const Frame& P, const int ntiles) {
    volatile LAS int* te = (volatile LAS int*)(P.lds + LDS_TILE_E);
    for (int t = P.tid; t < ntiles; t += NTHREADS) { int e = 0;
#pragma unroll
        for (int j = 1; j < NE; ++j) e += (P.LCTL[8 + j] <= t) ? 1 : 0;
        te[t] = e; }
    __syncthreads();
}
constexpr int NPH_LAYER = 10, GP_FINAL = 1 + DEPTH * NPH_LAYER, NPHASES = GP_FINAL + 1;
__global__ void __launch_bounds__(NTHREADS, 2) mega_fwd(Args args) {
    extern __shared__ __attribute__((aligned(16))) unsigned char lds_raw[];
    Frame F0;
    Frame& F = F0;
    F.lds = (LAS unsigned char*)lds_raw;
    F.LCTL = (volatile LAS int*)(F.lds + LDS_CTL_OFF);
    F.tid = threadIdx.x; F.lane = F.tid & 63; F.wave = __builtin_amdgcn_readfirstlane(F.tid >> 6);
    F.G = gridDim.x; { const int bx = blockIdx.x; F.vcu = (F.G % 8 == 0) ? (bx % 8) * (F.G / 8) + bx / 8 : bx; }
    if (F.tid < 128) F.LCTL[F.tid] = 0;
    if (F.tid == 0) {
#pragma unroll
        for (int i = 0; i < 23; ++i) { const unsigned long long p = (unsigned long long)args.in[i]; F.LCTL[128 + 2 * i] = (int)(unsigned)p; F.LCTL[129 + 2 * i] = (int)(unsigned)(p >> 32); }
        { const unsigned long long p = (unsigned long long)args.ws; F.LCTL[128 + 46] = (int)(unsigned)p; F.LCTL[129 + 46] = (int)(unsigned)(p >> 32); }
        { const unsigned long long p = (unsigned long long)args.out; F.LCTL[128 + 48] = (int)(unsigned)p; F.LCTL[129 + 48] = (int)(unsigned)(p >> 32); }
    }
    __syncthreads();
    const int lo = args.ph_lo, hi = args.ph_hi;
    XcdBarrier bar; bar.bar = (unsigned*)(wsp(F) + WS_CTL) + CW_BAR; bar.x = 0; bar.st = nullptr; bar.w0 = 0;
    if (hi - lo > 1) bar = xcd_barrier_post((unsigned*)(wsp(F) + WS_CTL) + CW_BAR, (volatile LAS unsigned*)F.LCTL);
#define IN(k) (lo <= (k) && (k) < hi)
#define FRESH(FN) Frame FN = F0; { int tz_ = F0.wave * 64 + lane_id_here(), vc_ = F0.vcu, g_ = F0.G;     asm volatile("" : "+v"(tz_)); asm volatile("" : "+s"(vc_), "+s"(g_)); FN.tid = tz_; FN.lane = tz_ & 63; FN.wave = __builtin_amdgcn_readfirstlane(tz_ >> 6); FN.vcu = vc_; FN.G = g_; }
#ifdef DBLBAR
#define SEAM(k) do { if (IN(k) && IN((k) + 1)) { xcd_barrier(bar); xcd_barrier(bar); } } while (0)
#else
#define SEAM(k) do { if (IN(k) && IN((k) + 1)) xcd_barrier(bar); } while (0)
#endif

    if (PE(0) && IN(0)) RP(0) { FRESH(P); phase0(P, ((((RMASK) >> 0) & 1) && rep_ == 0) ? P0PROBE : 0); }
    SEAM(0);
    for (int l = 0; l < DEPTH; ++l) {
        const int base = 1 + l * NPH_LAYER; const bool na = (l & 1) == 0, last = (l == DEPTH - 1); const int jj = l >> 1;
        if (PE(1) && IN(base + 0)) RP(1) { FRESH(P); phase_norm1(P, l, (((RMASK) >> 1) & 1) && rep_ == 0); }
        SEAM(base + 0);
        if (PE(2) && IN(base + 1)) RP(2) {
            FRESH(P);
            if (na) {
                const bf16_t* Bt = (const bf16_t*)(wsp(P) + WS_WQKV) + (size_t)jj * 3072 * D;
                const bool img_only = proj_split(P.G);
                DenseOrder S; S.init(img_only ? ROWS_CTX / 256 : 0, img_only ? (ROWS - ROWS_CTX) / 256 : ROWS / 256, 3072 / 256, P.G, (int)blockIdx.x, wsp(P) + WS_HB, Bt, D);
                EpiStoreBf16 E{(bf16_t*)(wsp(P) + WS_PROJ), 3072};
                pg8::gemm_phase<EpiStoreBf16, DenseOrder, false>(P.lds, P.tid, D, S, E, SKIPE(2));
            } else {
                const bf16_t* Bt = (const bf16_t*)(wsp(P) + WS_WIN) + (size_t)jj * ML_INP * D;
                DenseOrder S; S.init(0, ROWS / 256, ML_INP / 256, P.G, (int)blockIdx.x, wsp(P) + WS_HB, Bt, D);
                EpiProjML E{(bf16_t*)(wsp(P) + WS_PROJ), (const float*)(wsp(P) + WS_ROPE)};
                pg8::gemm_phase<EpiProjML, DenseOrder, false>(P.lds, P.tid, D, S, E, SKIPE(2));
            }
        }
        SEAM(base + 1);
        if (IN(base + 2) && na && PE(3)) {
            FRESH(P);
            if (proj_split(P.G) && P.vcu < NCBP) {
                const bf16_t* Bt = (const bf16_t*)(wsp(P) + WS_WQKV) + (size_t)jj * 3072 * D;
                DenseOrder S; S.init(0, ROWS_CTX / 256, 3072 / 256, NCBP, P.vcu, wsp(P) + WS_HB, Bt, D);
                EpiStoreBf16 E{(bf16_t*)(wsp(P) + WS_PROJ), 3072};
                pg8::gemm_phase<EpiStoreBf16, DenseOrder, false>(P.lds, P.tid, D, S, E);
                group_sync((unsigned*)(wsp(P) + WS_CTL) + CW_GSYNC + 64 * (DEPTH + l), NCBP, (unsigned*)(wsp(P) + WS_CTL) + CW_BAR, P.wave == 0);
            }
        }
        if (IN(base + 2)) { if (na) {   } else {   } }
        if (IN(base + 3)) { if (na) { if (PE(5)) RP(5) { FRESH(P); phase_na_attn(P, jj); } } else { if (PE(6)) RP(6) { FRESH(P); phase_ml_scan(P, jj); } } }
        SEAM(base + 3);
        if (PE(7) && IN(base + 4)) { if (!na) RP(7) { FRESH(P); phase_ml_final(P, jj); } }
        if (!na) SEAM(base + 4);
        if (PE(8) && IN(base + 5)) RP(8) {
            FRESH(P);
            const bf16_t* Bt = na ? (const bf16_t*)(wsp(P) + WS_WONA) + (size_t)jj * D * D : (const bf16_t*)(wsp(P) + WS_WOML) + (size_t)jj * D * D;
            const bool img_only = last || ctx_split(0, P.G);
            DenseOrder S; S.init(img_only ? ROWS_CTX / 256 : 0, img_only ? (ROWS - ROWS_CTX) / 256 : ROWS / 256, D / 256, P.G, (int)blockIdx.x, wsp(P) + WS_AO, Bt, D);
            EpiResid E{((((RMASK) >> 8) & 1) && rep_ == 0) ? (bf16_t*)(wsp(P) + WS_Y) : (bf16_t*)(wsp(P) + WS_XS), (const float*)(wsp(P) + WS_MOD) + (size_t)l * 9 * 6144 + 2 * D};
            pg8::gemm_phase<EpiResid, DenseOrder, false>(P.lds, P.tid, D, S, E, SKIPE(8));
        }
        SEAM(base + 5);
        if (PE(9) && IN(base + 6) && !last) {
            FRESH(P);
            if (ctx_split(0, P.G) && P.vcu < NCB) {
                const bf16_t* Bt = na ? (const bf16_t*)(wsp(P) + WS_WONA) + (size_t)jj * D * D : (const bf16_t*)(wsp(P) + WS_WOML) + (size_t)jj * D * D;
                DenseOrder S; S.init(0, ROWS_CTX / 256, D / 256, NCB, P.vcu, wsp(P) + WS_AO, Bt, D);
                EpiResid E{(bf16_t*)(wsp(P) + WS_XS), (const float*)(wsp(P) + WS_MOD) + (size_t)l * 9 * 6144 + 2 * D};
                pg8::gemm_phase<EpiResid, DenseOrder, false>(P.lds, P.tid, D, S, E);
                group_sync((unsigned*)(wsp(P) + WS_CTL) + CW_GSYNC + 64 * l, NCB, (unsigned*)(wsp(P) + WS_CTL) + CW_BAR, P.wave == 0);
            }
        }
        if (PE(9) && IN(base + 6)) RP(9) { FRESH(P); phase_norm2_router(P, l, last ? ROWS_CTX : 0); }
        SEAM(base + 6);
        if (PE(10) && IN(base + 7)) RP(10) { FRESH(P); phase_positions(P, last ? ROWS_CTX : 0); }
        SEAM(base + 7);
        if (PE(11) && IN(base + 8)) RP(11) {
            FRESH(P);
            if (P.tid < 34) P.LCTL[8 + P.tid] = ((const int*)(wsp(P) + WS_META))[P.tid];
            __syncthreads();
            const int ntiles = P.LCTL[8 + NE];
            moe_tile_table(P, ntiles);
            MoeOrder S; S.NT = 8; S.nunits = ntiles * 8; S.G = P.G; S.c = (int)blockIdx.x; S.K = D / 2; S.A = (const char*)(wsp(P) + WS_HB8);
            S.W = (const char*)(wsp(P) + WS_W1T) + (size_t)l * NE * 2048 * D; S.estride = (size_t)2048 * D; S.tokmap = (const int*)(wsp(P) + WS_TOKMAP); S.prefix = P.LCTL + 8; S.tile_e = (volatile LAS int*)(P.lds + LDS_TILE_E); S.tokl = (volatile LAS int*)(P.lds + LDS_TOKL); S.gather = true;
            { const int half = P.wave >> 2, r = P.tid & 255;
              for (int i = half; i < 28; i += 2) { pg8::Unit u; if (!S.next(i, u)) break; S.tokl[i * 256 + r] = S.tokmap[u.pm * 256 + r]; }
              __syncthreads(); }
            EpiSwiglu E{(unsigned char*)(wsp(P) + WS_ACT), inp(P, I_B1) + (size_t)l * NE * 2048};
#ifdef KPROBE
            if (SKIPE(11)) pg8::gemm_phase<EpiSwiglu, MoeOrder, true, true, MOE_ALIGN, KPROBE>(P.lds, P.tid, D / 2, S, E, true); else
#endif
            pg8::gemm_phase<EpiSwiglu, MoeOrder, true, true, MOE_ALIGN>(P.lds, P.tid, D / 2, S, E, SKIPE(11));
        }
        SEAM(base + 8);
        if (PE(12) && IN(base + 9)) RP(12) {
            FRESH(P);
            if (P.tid < 34) P.LCTL[8 + P.tid] = ((const int*)(wsp(P) + WS_META))[P.tid];
            __syncthreads();
            const int ntiles = P.LCTL[8 + NE];
            moe_tile_table(P, ntiles);
            MoeOrder S; S.NT = 4; S.nunits = ntiles * 4; S.G = P.G; S.c = (int)blockIdx.x; S.K = D / 2; S.A = (const char*)(wsp(P) + WS_ACT);
            S.W = (const char*)(wsp(P) + WS_W2T) + (size_t)l * NE * D * D; S.estride = (size_t)D * D; S.tokmap = (const int*)(wsp(P) + WS_TOKMAP); S.prefix = P.LCTL + 8; S.tile_e = (volatile LAS int*)(P.lds + LDS_TILE_E); S.tokl = (volatile LAS int*)(P.lds + LDS_TOKL); S.gather = false;
            EpiY E{(bf16_t*)(wsp(P) + WS_Y), inp(P, I_B2) + (size_t)l * NE * D};
            pg8::gemm_phase<EpiY, MoeOrder, true, true, MOE_ALIGN>(P.lds, P.tid, D / 2, S, E, SKIPE(12));
        }
        SEAM(base + 9);
    }
    if (PE(13) && IN(GP_FINAL)) RP(13) { FRESH(P); phase_final(P); }
#undef IN
#undef SEAM
}

extern "C" void kernel_launch(void* const* d_in, const int* in_sizes, int n_in, void* d_out, int out_size, void* d_ws, size_t ws_size, hipStream_t stream) {
    static int grid = 0;
    if (grid == 0) {
        if (n_in != 23 || ws_size < WS_END) { fprintf(stderr, "kernel_launch: expected 23 inputs and >= %zu bytes of workspace (got %d, %zu)\n", (size_t)WS_END, n_in, ws_size); grid = -1; return; }
        int dev = 0, cus = 0, per_cu = 0;
        if (hipGetDevice(&dev) != hipSuccess || hipDeviceGetAttribute(&cus, hipDeviceAttributeMultiprocessorCount, dev) != hipSuccess) { grid = -1; return; }
        if (hipFuncSetAttribute((const void*)mega_fwd, hipFuncAttributeMaxDynamicSharedMemorySize, LDS_BYTES) != hipSuccess) { fprintf(stderr, "kernel_launch: hipFuncSetAttribute failed\n"); grid = -1; return; }
        if (hipOccupancyMaxActiveBlocksPerMultiprocessor(&per_cu, (const void*)mega_fwd, NTHREADS, LDS_BYTES) != hipSuccess || per_cu < 1)
            fprintf(stderr, "kernel_launch: occupancy query reports %d workgroups per CU\n", per_cu);
        (void)hipGetLastError();
        grid = cus;
        if (grid > 1024) grid = 1024;
    }
    if (grid < 0) return;
    (void)hipMemsetAsync((char*)d_ws + WS_CTL, 0, CTL_BYTES, stream);
    Args a{};
    for (int i = 0; i < 23; ++i) a.in[i] = (const float*)d_in[i];
    a.out = (float*)d_out; a.ws = (unsigned char*)d_ws;
#if MK_ONE_LAUNCH
    a.ph_lo = 0; a.ph_hi = NPHASES;
    hipLaunchKernelGGL(mega_fwd, dim3(grid), dim3(NTHREADS), LDS_BYTES, stream, a);
#else
    for (int gp = 0; gp < NPHASES; ++gp) {
        if (gp >= 1 && gp < GP_FINAL) { const int l = (gp - 1) / NPH_LAYER, p = (gp - 1) % NPH_LAYER; if (p == 4 && (l & 1) == 0) continue; }
        a.ph_lo = gp; a.ph_hi = gp + 1;
        hipLaunchKernelGGL(mega_fwd, dim3(grid), dim3(NTHREADS), LDS_BYTES, stream, a);
    }
#endif
    const hipError_t le = hipPeekAtLastError();
    if (le != hipSuccess) fprintf(stderr, "kernel_launch: launch failed: %s\n", hipGetErrorName(le));
}
```
